# Optimizing an MI355X kernel written in HIP

```python
import jax, jax.numpy as jnp
from jax import lax
import numpy as np

D_MODEL = 1024
BATCH = 8
SEQ = 4096
DEPTH = 1

HEAD_DIM = 64
MOBA_HEADS = 8
RET_HEADS = 4
MEM_HEADS = 4
MOBA_WIDTH = MOBA_HEADS * HEAD_DIM
RET_WIDTH = RET_HEADS * HEAD_DIM
MEM_WIDTH = MEM_HEADS * HEAD_DIM
MIX_WIDTH = MOBA_WIDTH + RET_WIDTH + MEM_WIDTH
IN_WIDTH = 3 * MOBA_WIDTH + 4 * RET_WIDTH + MEM_WIDTH
MOBA_BLOCK = 256
MOBA_TOPK = 3
MOBA_QCHUNK = 32
RET_CHUNK = 128
RET_ROPE_BASE = 10000.0
MEM_LEN = 256
N_EXPERTS = 32
TOP_K = 4
D_FF = D_MODEL
SWIGLU_ALPHA = 1.702
SWIGLU_LIMIT = 7.0
MOE_BLOCK = 512
EPS = 1e-6
NEG = -1e30

kernel_name = 'hybrid_moba_retention_memory_moe'


def rms_norm(x, gain):
    xf = x.astype(jnp.float32)
    y = xf * lax.rsqrt(jnp.mean(xf * xf, axis=-1, keepdims=True) + EPS)
    return (y * gain.astype(jnp.float32)).astype(x.dtype)


def split_heads(t, n_heads):
    b, s, _ = t.shape
    return t.reshape(b, s, n_heads, HEAD_DIM).transpose(0, 2, 1, 3)


def merge_heads(t):
    b, h, s, d = t.shape
    return t.transpose(0, 2, 1, 3).reshape(b, s, h * d)


def rotate(t, cos, sin):
    t1, t2 = jnp.split(t, 2, axis=-1)
    return jnp.concatenate([t1 * cos - t2 * sin, t2 * cos + t1 * sin], axis=-1)


def moba_attention(q, k, v):
    b, nh, s, dh = q.shape
    n_blk = -(-s // MOBA_BLOCK)
    sp = n_blk * MOBA_BLOCK
    pad = ((0, 0), (0, 0), (0, sp - s), (0, 0))
    q, k, v = (jnp.pad(t.astype(jnp.float32), pad) for t in (q, k, v))
    scale = dh ** -0.5
    qb = q.reshape(b, nh, n_blk, MOBA_BLOCK, dh)
    kb = k.reshape(b, nh, n_blk, MOBA_BLOCK, dh)
    vb = v.reshape(b, nh, n_blk, MOBA_BLOCK, dh)
    causal = jnp.tril(jnp.ones((MOBA_BLOCK, MOBA_BLOCK), dtype=bool))
    s_own = jnp.where(causal, jnp.einsum('bhnqd,bhnkd->bhnqk', qb, kb) * scale, NEG)
    lse_own = jax.nn.logsumexp(s_own, axis=-1)
    o_own = jnp.einsum('bhnqk,bhnkd->bhnqd', jnp.exp(s_own - lse_own[..., None]), vb)
    o_own = o_own.reshape(b, nh, sp, dh)
    lse_own = lse_own.reshape(b, nh, sp)
    k_mean = kb.mean(axis=3)
    own_blk = jnp.arange(sp) // MOBA_BLOCK
    past = jnp.arange(n_blk)[None, :] < own_blk[:, None]
    gate = jnp.where(past, jnp.einsum('bhsd,bhnd->bhsn', q, k_mean), NEG)
    n_sel = min(MOBA_TOPK, n_blk)
    _, sel = lax.top_k(gate, n_sel)
    valid = sel < own_blk[:, None]
    n_qc = sp // MOBA_QCHUNK

    def to_chunks(t):
        return jnp.moveaxis(t.reshape(b, nh, n_qc, MOBA_QCHUNK, *t.shape[3:]), 2, 0)

    bidx = jnp.arange(b)[:, None, None, None]
    hidx = jnp.arange(nh)[None, :, None, None]

    def chunk(args):
        qq, ii, vv = args
        ks = kb[bidx, hidx, ii]
        vs = vb[bidx, hidx, ii]
        sc = jnp.einsum('bhqd,bhqjkd->bhqjk', qq, ks) * scale
        sc = jnp.where(vv[..., None], sc, NEG).reshape(b, nh, MOBA_QCHUNK, n_sel * MOBA_BLOCK)
        lse = jax.nn.logsumexp(sc, axis=-1)
        p = jnp.exp(sc - lse[..., None])
        o = jnp.einsum('bhqm,bhqmd->bhqd', p, vs.reshape(b, nh, MOBA_QCHUNK, n_sel * MOBA_BLOCK, dh))
        return o, lse

    o_past, lse_past = lax.map(chunk, (to_chunks(q), to_chunks(sel), to_chunks(valid)))
    o_past = jnp.moveaxis(o_past, 0, 2).reshape(b, nh, sp, dh)
    lse_past = jnp.moveaxis(lse_past, 0, 2).reshape(b, nh, sp)
    m = jnp.maximum(lse_own, lse_past)
    w_own = jnp.exp(lse_own - m)[..., None]
    w_past = jnp.exp(lse_past - m)[..., None]
    o = (w_own * o_own + w_past * o_past) / (w_own + w_past)
    return o[:, :, :s]


def retention(q, k, v, g, out_gain):
    b, s, _ = q.shape
    dh = HEAD_DIM
    q, k, v = (split_heads(t.astype(jnp.float32), RET_HEADS) for t in (q, k, v))
    inv_freq = 1.0 / (RET_ROPE_BASE ** jnp.linspace(0.0, 1.0, dh // 2, dtype=jnp.float32))
    ang = jnp.arange(s, dtype=jnp.float32)[:, None] * inv_freq[None, :]
    cos, sin = jnp.cos(ang), jnp.sin(ang)
    q = rotate(q, cos, sin)
    k = rotate(k, cos, sin) * dh ** -0.5
    log_gamma = jnp.log1p(-jnp.exp2(-5.0 - jnp.arange(RET_HEADS, dtype=jnp.float32)))
    n_ch = s // RET_CHUNK
    qc, kc, vc = (t.reshape(b, RET_HEADS, n_ch, RET_CHUNK, dh) for t in (q, k, v))
    idx = jnp.arange(RET_CHUNK, dtype=jnp.float32)
    diff = idx[:, None] - idx[None, :]
    intra = jnp.where(diff >= 0, jnp.exp(log_gamma[:, None, None] * jnp.maximum(diff, 0.0)), 0.0)
    scores = jnp.einsum('bhnid,bhnjd->bhnij', qc, kc) * intra[None, :, None]
    o_intra = jnp.einsum('bhnij,bhnje->bhnie', scores, vc)
    k_decay = jnp.exp(log_gamma[:, None] * (RET_CHUNK - 1.0 - idx)[None, :])
    chunk_kv = jnp.einsum('bhnjd,bhnje->bhnde', kc * k_decay[None, :, None, :, None], vc)
    chunk_decay = jnp.exp(log_gamma * RET_CHUNK)[None, :, None, None]

    def step(state, kv):
        return chunk_decay * state + kv, state

    _, states = lax.scan(step, jnp.zeros((b, RET_HEADS, dh, dh), jnp.float32), jnp.moveaxis(chunk_kv, 2, 0))
    states = jnp.moveaxis(states, 0, 2)
    q_decay = jnp.exp(log_gamma[:, None] * (idx + 1.0)[None, :])
    o_cross = jnp.einsum('bhnid,bhnde->bhnie', qc, states) * q_decay[None, :, None, :, None]
    o = (o_intra + o_cross).reshape(b, RET_HEADS, s, dh)
    o = o * lax.rsqrt(jnp.mean(o * o, axis=-1, keepdims=True) + EPS)
    o = merge_heads(o) * out_gain.astype(jnp.float32)
    return jax.nn.silu(g.astype(jnp.float32)) * o


def memory_attention(q, mem_h, w_mem_kv, q_gain, k_gain):
    kv = jnp.einsum('bmd,de->bme', mem_h, w_mem_kv)
    k_m, v_m = jnp.split(kv, 2, axis=-1)
    q = rms_norm(split_heads(q, MEM_HEADS), q_gain).astype(jnp.float32)
    k_m = rms_norm(split_heads(k_m, MEM_HEADS), k_gain).astype(jnp.float32)
    v_m = split_heads(v_m, MEM_HEADS).astype(jnp.float32)
    p = jax.nn.softmax(jnp.einsum('bhsd,bhmd->bhsm', q, k_m) * HEAD_DIM ** -0.5, axis=-1)
    return merge_heads(jnp.einsum('bhsm,bhmd->bhsd', p, v_m))


def mixer_block(x, mem, g_attn, w_in, moba_q_gain, moba_k_gain, ret_out_gain, g_mem, w_mem_kv,
                mem_q_gain, mem_k_gain, w_out):
    h = rms_norm(x, g_attn)
    proj = jnp.einsum('bsd,de->bse', h, w_in)
    sizes = [MOBA_WIDTH] * 3 + [RET_WIDTH] * 4 + [MEM_WIDTH]
    cuts = [sum(sizes[:i + 1]) for i in range(len(sizes) - 1)]
    qa, ka, va, qr, kr, vr, gr, qm = jnp.split(proj, cuts, axis=-1)
    qa = rms_norm(split_heads(qa, MOBA_HEADS), moba_q_gain)
    ka = rms_norm(split_heads(ka, MOBA_HEADS), moba_k_gain)
    oa = merge_heads(moba_attention(qa, ka, split_heads(va, MOBA_HEADS)))
    orr = retention(qr, kr, vr, gr, ret_out_gain)
    om = memory_attention(qm, rms_norm(mem, g_mem), w_mem_kv, mem_q_gain, mem_k_gain)
    y = jnp.concatenate([oa, orr, om], axis=-1).astype(x.dtype)
    return x + jnp.einsum('bse,ed->bsd', y, w_out)


def clamped_swiglu(z):
    x_glu = jnp.minimum(z[..., ::2], SWIGLU_LIMIT)
    x_lin = jnp.clip(z[..., 1::2], -SWIGLU_LIMIT, SWIGLU_LIMIT)
    return x_glu * jax.nn.sigmoid(SWIGLU_ALPHA * x_glu) * (x_lin + 1.0)


def routed_experts(h, expert_idx, expert_w, w1, b1, w2, b2):
    t, d = h.shape
    a = t * TOP_K
    e_flat = expert_idx.reshape(a)
    tok = jnp.arange(a, dtype=jnp.int32) // TOP_K
    order = jnp.argsort(e_flat)
    e_sorted = e_flat[order]
    counts = jnp.bincount(e_flat, length=N_EXPERTS)
    padded = ((counts + MOE_BLOCK - 1) // MOE_BLOCK) * MOE_BLOCK
    starts = jnp.cumsum(counts) - counts
    pends = jnp.cumsum(padded)
    pstarts = pends - padded
    dest = pstarts[e_sorted] + (jnp.arange(a, dtype=jnp.int32) - starts[e_sorted])
    n_blocks = -(-(a + N_EXPERTS * (MOE_BLOCK - 1)) // MOE_BLOCK)
    p_rows = n_blocks * MOE_BLOCK
    row_tok = jnp.zeros((p_rows,), jnp.int32).at[dest].set(tok[order])
    row_w = jnp.zeros((p_rows,), jnp.float32).at[dest].set(expert_w.reshape(a)[order])
    blk_start = jnp.arange(n_blocks, dtype=jnp.int32) * MOE_BLOCK
    blk_exp = jnp.minimum(jnp.searchsorted(pends, blk_start, side='right'), N_EXPERTS - 1)

    def block(args):
        toks, wts, e = args
        xb = jnp.take(h, toks, axis=0)
        z = xb @ w1[e] + b1[e]
        y = clamped_swiglu(z) @ w2[e] + b2[e]
        return (y.astype(jnp.float32) * wts[:, None]).astype(h.dtype)

    ys = lax.map(block, (row_tok.reshape(n_blocks, MOE_BLOCK), row_w.reshape(n_blocks, MOE_BLOCK), blk_exp))
    return jnp.zeros((t, d), h.dtype).at[row_tok].add(ys.reshape(p_rows, d))


def moe_block(x, g_ffn, w_router, b_router, w1, b1, w2, b2):
    b, s, d = x.shape
    h = rms_norm(x, g_ffn).reshape(b * s, d)
    logits = (h @ w_router).astype(jnp.float32) + b_router.astype(jnp.float32)
    top_vals, top_idx = lax.top_k(logits, TOP_K)
    weights = jax.nn.softmax(top_vals, axis=-1)
    out = routed_experts(h, top_idx, weights, w1, b1, w2, b2)
    return x + out.reshape(b, s, d)


def setup_inputs(seed: int = 0) -> dict:
    key = jax.random.key(seed)
    ks = jax.random.split(key, 20)
    f32 = jnp.float32

    def nrm(k, shape, scale):
        return jax.random.normal(k, shape, f32) * scale

    def gain(k, shape):
        return 1.0 + 0.02 * jax.random.normal(k, shape, f32)

    L = DEPTH
    return {
        'x': nrm(ks[0], (BATCH, SEQ, D_MODEL), 1.0),
        'mem': nrm(ks[1], (BATCH, MEM_LEN, D_MODEL), 1.0),
        'g_attn': gain(ks[2], (L, D_MODEL)),
        'w_in': nrm(ks[3], (L, D_MODEL, IN_WIDTH), D_MODEL ** -0.5),
        'moba_q_gain': gain(ks[4], (L, HEAD_DIM)),
        'moba_k_gain': gain(ks[5], (L, HEAD_DIM)),
        'ret_out_gain': gain(ks[6], (L, RET_WIDTH)),
        'g_mem': gain(ks[7], (L, D_MODEL)),
        'w_mem_kv': nrm(ks[8], (L, D_MODEL, 2 * MEM_WIDTH), D_MODEL ** -0.5),
        'mem_q_gain': gain(ks[9], (L, HEAD_DIM)),
        'mem_k_gain': gain(ks[10], (L, HEAD_DIM)),
        'w_out': nrm(ks[11], (L, MIX_WIDTH, D_MODEL), MIX_WIDTH ** -0.5),
        'g_ffn': gain(ks[12], (L, D_MODEL)),
        'w_router': nrm(ks[13], (L, D_MODEL, N_EXPERTS), D_MODEL ** -0.5),
        'b_router': nrm(ks[14], (L, N_EXPERTS), 0.01),
        'w1': nrm(ks[15], (L, N_EXPERTS, D_MODEL, 2 * D_FF), D_MODEL ** -0.5),
        'b1': nrm(ks[16], (L, N_EXPERTS, 2 * D_FF), 0.01),
        'w2': nrm(ks[17], (L, N_EXPERTS, D_FF, D_MODEL), D_FF ** -0.5),
        'b2': nrm(ks[18], (L, N_EXPERTS, D_MODEL), 0.01),
    }


def reference(x, mem, g_attn, w_in, moba_q_gain, moba_k_gain, ret_out_gain, g_mem, w_mem_kv,
              mem_q_gain, mem_k_gain, w_out, g_ffn, w_router, b_router, w1, b1, w2, b2):
    for l in range(DEPTH):
        x = mixer_block(x, mem, g_attn[l], w_in[l], moba_q_gain[l], moba_k_gain[l], ret_out_gain[l],
                        g_mem[l], w_mem_kv[l], mem_q_gain[l], mem_k_gain[l], w_out[l])
        x = moe_block(x, g_ffn[l], w_router[l], b_router[l], w1[l], b1[l], w2[l], b2[l])
    return x
```

```cpp
#include <hip/hip_runtime.h>
#include <hip/hip_cooperative_groups.h>
#include <cstdio>
#include <cstdint>
namespace cg = cooperative_groups;

#define GAS __attribute__((address_space(1)))
#define LAS __attribute__((address_space(3)))
typedef unsigned short bf16;
typedef short bf16x8 __attribute__((ext_vector_type(8)));
typedef float f32x4 __attribute__((ext_vector_type(4)));
typedef float f32x2 __attribute__((ext_vector_type(2)));
typedef unsigned u32x4 __attribute__((ext_vector_type(4)));
typedef unsigned u32x2 __attribute__((ext_vector_type(2)));
typedef __bf16 bf16x2_t __attribute__((ext_vector_type(2)));

constexpr int NB = 8, SEQ = 4096, DM = 1024, T = NB * SEQ;
constexpr int NIN = 2816, NEXP = 32, TOPK = 4;
constexpr int MEMLEN = 256, MROWS = NB * MEMLEN;
constexpr float EPS = 1e-6f;
constexpr float C2 = 0.125f * 1.4426950408889634f;
constexpr int MAXTILES = 544, PROWS = MAXTILES * 256;
constexpr int NWAVES = 8, NTHREADS = 512;
constexpr int LDS_BYTES = 147456;

constexpr size_t MiB = 1u << 20;
constexpr size_t WS_CTL = 0, CTL_ZERO_BYTES = 2 * MiB;
constexpr size_t WS_KMEAN = 1 * MiB;
constexpr size_t WS_WRG = 2 * MiB;
constexpr size_t WS_SSQ = 3 * MiB;
constexpr size_t WS_TOPI = 5 * MiB, WS_TOPW = 5 * MiB + 512 * 1024, WS_LRANK = 6 * MiB, WS_POS = 6 * MiB + 512 * 1024;
constexpr size_t WS_ROWW = 7 * MiB;
constexpr size_t WS_LCOUNT = 8 * MiB, WS_PSTART = 8 * MiB + 65536, WS_TILEEXP = 8 * MiB + 131072;
constexpr size_t WS_WIN = 16 * MiB, WS_WMEM = 22 * MiB, WS_WOUT = 24 * MiB, WS_W1 = 32 * MiB, WS_W2 = 160 * MiB;
constexpr size_t WS_XN = 224 * MiB, WS_MEMN = 288 * MiB;
constexpr size_t WS_QA = 292 * MiB, WS_KA = 324 * MiB, WS_VA = 356 * MiB;
constexpr size_t WS_QR = 388 * MiB, WS_KR = 404 * MiB, WS_VR = 420 * MiB, WS_GR = 436 * MiB, WS_QM = 452 * MiB;
constexpr size_t WS_MK = 468 * MiB, WS_MV = 469 * MiB;
constexpr size_t WS_Y = 470 * MiB, WS_RET = 534 * MiB;
constexpr size_t WS_XG = 224 * MiB;
constexpr size_t WS_H = 566 * MiB;
constexpr size_t WS_END = 838 * MiB;

struct Args {
    const float* in[19]; float* out; unsigned char* ws; int pad0, pad1;
};

__device__ __forceinline__ unsigned cvtpk(float lo, float hi) { f32x2 v = {lo, hi}; bf16x2_t b = __builtin_convertvector(v, bf16x2_t); return __builtin_bit_cast(unsigned, b); }
__device__ __forceinline__ float bf2f(unsigned short b) { return __uint_as_float(((unsigned)b) << 16); }
__device__ __forceinline__ float bflo(unsigned w) { return __uint_as_float(w << 16); }
__device__ __forceinline__ float bfhi(unsigned w) { return __uint_as_float(w & 0xffff0000u); }
__device__ __forceinline__ float wave_sum(float v) {
#pragma unroll
    for (int o = 1; o < 64; o <<= 1) v += __shfl_xor(v, o);
    return v;
}
#define LDS_WAIT() asm volatile("s_waitcnt lgkmcnt(0)" ::: "memory")
__device__ __forceinline__ int opaque(int v) { asm volatile("" : "+v"(v)); return v; }

namespace pg8 {
constexpr int BM = 256, BK = 64, HALF = 128, HTB = HALF * BK * 2, STAGE_BYTES = 8 * HTB, NXCD = 8, WGM = 8, K = 1024;
__host__ __device__ __forceinline__ int lds_byte(int r, int c) { const int st = (r >> 4) * 2 + (c >> 5), rr = r & 15, cc = c & 31, ob = rr * 64 + cc * 2; return st * 1024 + (ob ^ (((ob >> 9) & 1) << 5)); }
__host__ __device__ __forceinline__ void stage_rc(int b, int& R, int& C) { const int st = b / 1024, sb = b % 1024, swz = sb ^ (((sb >> 9) & 1) << 5); R = (st >> 1) * 16 + swz / 64; C = (st & 1) * 32 + (swz % 64) / 2; }
__host__ __device__ __forceinline__ int perm32(int rho) { const int n = rho >> 4, i = rho & 15; return 8 * (i >> 2) + 4 * n + (i & 3); }
struct Unit { int pm, pn, aux; };

__device__ __forceinline__ bool static_order(int L, int nM, int nN, int& pm, int& pn) {
    const int nwg = nM * nN; if (L >= nwg) return false;
    int wgid = L; { const int q = nwg / NXCD, r = nwg % NXCD, xcd = wgid % NXCD, off = wgid / NXCD; wgid = (xcd < r ? xcd * (q + 1) : r * (q + 1) + (xcd - r) * q) + off; }
    const int nig = WGM * nN, gid = wgid / nig, fm = gid * WGM, gsz = (nM - fm) < WGM ? (nM - fm) : WGM;
    pm = fm + ((wgid % nig) % gsz); pn = (wgid % nig) / gsz; return true;
}

template <class Epi, class Sched>
__device__ __forceinline__ void gemm_phase(LAS unsigned char* lds, const Sched& S, const Epi& E) {
    const int tid = opaque((int)threadIdx.x), wid = __builtin_amdgcn_readfirstlane(tid >> 6), lane = tid & 63, wr = wid >> 2, wc = wid & 3, fr = lane & 15, fq = lane >> 4;
    constexpr int nt = K / BK;
    unsigned voffA[2], voffB[2];
#pragma unroll
    for (int i = 0; i < 2; ++i) { int R, C; stage_rc(tid * 16 + i * 8192, R, C); const int Rb = (R & ~31) + perm32(R & 31);
        voffA[i] = (unsigned)(R * K + C) * 2u; voffB[i] = (unsigned)(Rb * K + C) * 2u; }
    const size_t kstep = (size_t)(BK * 2);
    const size_t hstep = (size_t)HALF * K * 2;
    const unsigned ldsw = (unsigned)wid * 1024u;
    const int aoff = lds_byte(wr * 64 + fr, fq * 8), boff = lds_byte(wc * 32 + fr, fq * 8);
#define PG8_SA(b, h) (((b) * 2 + (h)) * HTB)
#define PG8_SB(b, h) ((4 + (b) * 2 + (h)) * HTB)
#define PG8_STAGE(bufoff, gbase, voff) do { _Pragma("unroll") for (int _i = 0; _i < 2; ++_i) \
        __builtin_amdgcn_global_load_lds((const unsigned*)((const char*)(gbase) + (voff)[_i]), (LAS unsigned*)(lds + (bufoff) + ldsw + _i * 8192), 16, 0, 0); } while (0)
#define PG8_LDA(dst, b, h) do { _Pragma("unroll") for (int m = 0; m < 4; ++m) _Pragma("unroll") for (int k = 0; k < 2; ++k) dst[m][k] = *(const LAS bf16x8*)(lds + PG8_SA(b, h) + aoff + m * 2048 + k * 1024); } while (0)
#define PG8_LDB(dst, b, h) do { _Pragma("unroll") for (int n = 0; n < 2; ++n) _Pragma("unroll") for (int k = 0; k < 2; ++k) dst[n][k] = *(const LAS bf16x8*)(lds + PG8_SB(b, h) + boff + n * 2048 + k * 1024); } while (0)
#define PG8_MMA(ai, bj, At, Bt) do { __builtin_amdgcn_s_setprio(1); _Pragma("unroll") for (int m = 0; m < 4; ++m) _Pragma("unroll") for (int n = 0; n < 2; ++n) _Pragma("unroll") for (int k = 0; k < 2; ++k) \
        acc[ai][bj][m][n] = __builtin_amdgcn_mfma_f32_16x16x32_bf16(Bt[n][k], At[m][k], acc[ai][bj][m][n], 0, 0, 0); __builtin_amdgcn_s_setprio(0); } while (0)
#define PG8_WAIT_V(n) asm volatile("s_waitcnt vmcnt(" #n ")" ::: "memory")
#define PG8_WAIT_L(n) asm volatile("s_waitcnt lgkmcnt(" #n ")" ::: "memory")
#define PG8_BAR __builtin_amdgcn_s_barrier()
#define PG8_SCHED __builtin_amdgcn_sched_barrier(0)
    Unit cur, nxt; int ui = 0;
    if (!S.next(0, cur)) return;
    f32x4 acc[2][2][4][2];
#pragma unroll
    for (int a = 0; a < 2; ++a)
#pragma unroll
        for (int b = 0; b < 2; ++b)
#pragma unroll
            for (int m = 0; m < 4; ++m)
#pragma unroll
                for (int n = 0; n < 2; ++n) acc[a][b][m][n] = (f32x4){0.f, 0.f, 0.f, 0.f};
    bf16x8 At[4][2], B0[2][2], B1[2][2];
    const char* cA = S.aptr(cur); const char* cB = S.bptr(cur);
    {
        PG8_STAGE(PG8_SB(0, 0), cB, voffB); PG8_STAGE(PG8_SB(0, 1), cB + hstep, voffB); PG8_STAGE(PG8_SA(0, 0), cA, voffA); PG8_STAGE(PG8_SA(0, 1), cA + hstep, voffA);
        if (wr == 1) PG8_BAR;
        PG8_WAIT_V(2); PG8_BAR;
        PG8_STAGE(PG8_SB(1, 0), cB + kstep, voffB); PG8_STAGE(PG8_SA(1, 0), cA + kstep, voffA); PG8_STAGE(PG8_SB(1, 1), cB + hstep + kstep, voffB);
        PG8_WAIT_V(6); PG8_BAR;
    }
    for (;;) {
        const bool has_next = S.next(ui + 1, nxt);
        const char* nA = has_next ? S.aptr(nxt) : cA; const char* nB = has_next ? S.bptr(nxt) : cB;
        for (int t = 0; t < nt; t += 2) {
            const bool last = (t == nt - 2);
            const char* a1 = cA + (size_t)(t + 1) * kstep;
            const char* a2 = last ? nA : cA + (size_t)(t + 2) * kstep; const char* b2 = last ? nB : cB + (size_t)(t + 2) * kstep;
            const char* a3 = a2 + kstep; const char* b3 = b2 + kstep;
            PG8_LDB(B0, 0, 0); PG8_LDB(B1, 0, 1); PG8_SCHED; PG8_LDA(At, 0, 0); PG8_STAGE(PG8_SA(1, 1), a1 + hstep, voffA);
            PG8_WAIT_V(8); PG8_WAIT_L(0); PG8_BAR; PG8_MMA(0, 0, At, B0); PG8_MMA(0, 1, At, B1); PG8_BAR; PG8_SCHED;
            PG8_LDA(At, 0, 1); PG8_STAGE(PG8_SB(0, 0), b2, voffB); PG8_STAGE(PG8_SB(0, 1), b2 + hstep, voffB); PG8_STAGE(PG8_SA(0, 0), a2, voffA);
            PG8_WAIT_V(8); PG8_WAIT_L(0); PG8_BAR; PG8_MMA(1, 0, At, B0); PG8_MMA(1, 1, At, B1); PG8_BAR; PG8_SCHED;
            PG8_LDB(B0, 1, 0); PG8_LDB(B1, 1, 1); PG8_SCHED; PG8_LDA(At, 1, 0); PG8_STAGE(PG8_SA(0, 1), a2 + hstep, voffA);
            PG8_WAIT_V(8); PG8_WAIT_L(0); PG8_BAR; PG8_MMA(0, 0, At, B0); PG8_MMA(0, 1, At, B1); PG8_BAR; PG8_SCHED;
            PG8_LDA(At, 1, 1); PG8_STAGE(PG8_SB(1, 0), b3, voffB); PG8_STAGE(PG8_SB(1, 1), b3 + hstep, voffB); PG8_STAGE(PG8_SA(1, 0), a3, voffA);
            PG8_WAIT_V(8); PG8_WAIT_L(0); PG8_BAR; PG8_MMA(1, 0, At, B0); PG8_MMA(1, 1, At, B1); PG8_BAR; PG8_SCHED;
        }
        if (wr == 0) PG8_BAR;
        E(acc, cur, wr, wc, fr, fq);
        if (!has_next) break;
#pragma unroll
        for (int a = 0; a < 2; ++a)
#pragma unroll
            for (int b = 0; b < 2; ++b)
#pragma unroll
                for (int m = 0; m < 4; ++m)
#pragma unroll
                    for (int n = 0; n < 2; ++n) acc[a][b][m][n] = (f32x4){0.f, 0.f, 0.f, 0.f};
        cur = nxt; cA = nA; cB = nB; ++ui;
        if (wr == 1) PG8_BAR;
    }
    PG8_WAIT_V(0);
    PG8_BAR;
#undef PG8_SA
#undef PG8_SB
#undef PG8_STAGE
#undef PG8_LDA
#undef PG8_LDB
#undef PG8_MMA
#undef PG8_WAIT_V
#undef PG8_WAIT_L
#undef PG8_BAR
#undef PG8_SCHED
}
}
using pg8::Unit;

struct SchedProj {
    int G, c; const char *XN, *MEMN, *WIN, *WMEM;
    __device__ __forceinline__ bool next(int i, Unit& u) const {
        const int L = i * G + c;
        if (L < 1408) { u.aux = 0; return pg8::static_order(L, 128, 11, u.pm, u.pn); }
        if (L < 1424) { const int j = L - 1408; u.pm = j >> 1; u.pn = j & 1; u.aux = 1; return true; }
        return false;
    }
    __device__ __forceinline__ const char* aptr(const Unit& u) const { return (u.aux ? MEMN : XN) + (size_t)u.pm * (256 * 2048); }
    __device__ __forceinline__ const char* bptr(const Unit& u) const { return (u.aux ? WMEM : WIN) + (size_t)u.pn * (256 * 2048); }
};
struct SchedPlain {
    int G, c, nM, nN; const char *A, *B;
    __device__ __forceinline__ bool next(int i, Unit& u) const { u.aux = 0; return pg8::static_order(i * G + c, nM, nN, u.pm, u.pn); }
    __device__ __forceinline__ const char* aptr(const Unit& u) const { return A + (size_t)u.pm * (256 * 2048); }
    __device__ __forceinline__ const char* bptr(const Unit& u) const { return B + (size_t)u.pn * (256 * 2048); }
};
struct SchedMoe {
    int G, vcu, npn, ntiles; const int* tile_exp; const char *A, *B; size_t bexp;
    __device__ __forceinline__ bool next(int i, Unit& u) const {
        const int L = i * G + vcu, tile = L / npn; if (tile >= ntiles) return false;
        u.pm = tile; u.pn = L - tile * npn; u.aux = __builtin_amdgcn_readfirstlane(tile_exp[tile]); return true;
    }
    __device__ __forceinline__ const char* aptr(const Unit& u) const { return A + (size_t)u.pm * (256 * 2048); }
    __device__ __forceinline__ const char* bptr(const Unit& u) const { return B + (size_t)u.aux * bexp + (size_t)u.pn * (256 * 2048); }
};

struct EpiProj {
    unsigned char* ws;
    const float *gq, *gk, *gmq, *gmk;
    __device__ __forceinline__ void operator()(const f32x4 (&acc)[2][2][4][2], const Unit& u, int wr, int wc, int fr, int fq) const {
        int mode = 0; bf16* out; int ld = 256, coff = 0; const float* gain = nullptr; float scale = 1.f; bool kmean = false;
        if (u.aux == 0) {
            switch (u.pn) {
                case 0: case 1: out = (bf16*)(ws + WS_QA); ld = 512; coff = u.pn * 256; mode = 1; gain = gq; scale = C2; break;
                case 2: case 3: out = (bf16*)(ws + WS_KA); ld = 512; coff = (u.pn - 2) * 256; mode = 1; gain = gk; kmean = true; break;
                case 4: case 5: out = (bf16*)(ws + WS_VA); ld = 512; coff = (u.pn - 4) * 256; break;
                case 6: out = (bf16*)(ws + WS_QR); mode = 2; break;
                case 7: out = (bf16*)(ws + WS_KR); mode = 2; scale = 0.125f; break;
                case 8: out = (bf16*)(ws + WS_VR); break;
                case 9: out = (bf16*)(ws + WS_GR); mode = 3; break;
                default: out = (bf16*)(ws + WS_QM); mode = 1; gain = gmq; scale = C2; break;
            }
        } else {
            if (u.pn == 0) { out = (bf16*)(ws + WS_MK); mode = 1; gain = gmk; } else { out = (bf16*)(ws + WS_MV); }
        }
        const int row0 = u.pm * 256 + wr * 64 + fr;
        const int colb = coff + wc * 64 + 8 * fq;
        if (gain == nullptr) gain = gq;
        f32x4 ks[2][2];
#pragma unroll
        for (int bj = 0; bj < 2; ++bj)
#pragma unroll
            for (int n = 0; n < 2; ++n) ks[bj][n] = (f32x4){0.f, 0.f, 0.f, 0.f};
#pragma unroll
        for (int ai = 0; ai < 2; ++ai)
#pragma unroll
            for (int m = 0; m < 4; ++m) {
                const int row = row0 + ai * 128 + m * 16;
                f32x4 v[2][2];
#pragma unroll
                for (int bj = 0; bj < 2; ++bj)
#pragma unroll
                    for (int n = 0; n < 2; ++n) v[bj][n] = acc[ai][bj][m][n];
                if (mode == 1) {
                    float ss = 0.f;
#pragma unroll
                    for (int bj = 0; bj < 2; ++bj)
#pragma unroll
                        for (int n = 0; n < 2; ++n) { const f32x4 x = v[bj][n]; ss += (x[0] * x[0] + x[1] * x[1]) + (x[2] * x[2] + x[3] * x[3]); }
                    ss += __shfl_xor(ss, 16); ss += __shfl_xor(ss, 32);
                    const float r = scale / sqrtf(ss * (1.0f / 64.0f) + EPS);
#pragma unroll
                    for (int bj = 0; bj < 2; ++bj)
#pragma unroll
                        for (int n = 0; n < 2; ++n) v[bj][n] = v[bj][n] * r * *(const f32x4*)(gain + bj * 32 + 8 * fq + 4 * n);
                } else if (mode == 2) {
                    const float pos = (float)(row & (SEQ - 1));
#pragma unroll
                    for (int n = 0; n < 2; ++n)
#pragma unroll
                        for (int j = 0; j < 4; ++j) {
                            const float fre = __builtin_amdgcn_exp2f((float)(8 * fq + 4 * n + j) * (-13.287712379549449f / 31.0f)) * 0.15915494309189535f;
                            float tt = pos * fre; tt = tt - floorf(tt);
                            const float sn = __builtin_amdgcn_sinf(tt), cs = __builtin_amdgcn_cosf(tt);
                            const float t1 = v[0][n][j], t2 = v[1][n][j];
                            v[0][n][j] = (t1 * cs - t2 * sn) * scale; v[1][n][j] = (t2 * cs + t1 * sn) * scale;
                        }
                } else if (mode == 3) {
#pragma unroll
                    for (int bj = 0; bj < 2; ++bj)
#pragma unroll
                        for (int n = 0; n < 2; ++n)
#pragma unroll
                            for (int j = 0; j < 4; ++j) { const float x = v[bj][n][j]; v[bj][n][j] = x / (1.0f + __expf(-x)); }
                }
                if (kmean) {
#pragma unroll
                    for (int bj = 0; bj < 2; ++bj)
#pragma unroll
                        for (int n = 0; n < 2; ++n) ks[bj][n] += v[bj][n];
                }
                bf16* rowp = out + (size_t)row * ld + colb;
#pragma unroll
                for (int bj = 0; bj < 2; ++bj) { u32x4 w; w.x = cvtpk(v[bj][0][0], v[bj][0][1]); w.y = cvtpk(v[bj][0][2], v[bj][0][3]); w.z = cvtpk(v[bj][1][0], v[bj][1][1]); w.w = cvtpk(v[bj][1][2], v[bj][1][3]);
                    *(u32x4*)(rowp + bj * 32) = w; }
            }
        if (kmean) {
            float* kp = (float*)(ws + WS_KMEAN) + ((size_t)u.pm * 8 + (u.pn - 2) * 4 + wc) * 64 + 8 * fq;
#pragma unroll
            for (int bj = 0; bj < 2; ++bj)
#pragma unroll
                for (int n = 0; n < 2; ++n)
#pragma unroll
                    for (int j = 0; j < 4; ++j) {
                        float s = ks[bj][n][j];
                        s += __shfl_xor(s, 1); s += __shfl_xor(s, 2); s += __shfl_xor(s, 4); s += __shfl_xor(s, 8);
                        if (fr == 0) atomicAdd(kp + bj * 32 + 4 * n + j, s * (1.0f / 256.0f));
                    }
        }
    }
};

struct EpiOut {
    const float* x; float* out; float* ssq;
    __device__ __forceinline__ void operator()(const f32x4 (&acc)[2][2][4][2], const Unit& u, int wr, int wc, int fr, int fq) const {
        const int row0 = u.pm * 256 + wr * 64 + fr, col0 = u.pn * 256 + wc * 32 + 8 * fq;
#pragma unroll
        for (int ai = 0; ai < 2; ++ai)
#pragma unroll
            for (int m = 0; m < 4; ++m) {
                const int row = row0 + ai * 128 + m * 16; const size_t off = (size_t)row * DM + col0; float ss = 0.f;
#pragma unroll
                for (int bj = 0; bj < 2; ++bj)
#pragma unroll
                    for (int n = 0; n < 2; ++n) { const f32x4 xv = *(const f32x4*)(x + off + bj * 128 + 4 * n); const f32x4 o = xv + acc[ai][bj][m][n];
                        ss += (o[0] * o[0] + o[1] * o[1]) + (o[2] * o[2] + o[3] * o[3]); *(f32x4*)(out + off + bj * 128 + 4 * n) = o; }
                ss += __shfl_xor(ss, 16); ss += __shfl_xor(ss, 32);
                if (fq == 0) ssq[(size_t)row * 16 + u.pn * 4 + wc] = ss;
            }
    }
};

struct EpiSwiglu {
    const float* b1; bf16* H;
    __device__ __forceinline__ void operator()(const f32x4 (&acc)[2][2][4][2], const Unit& u, int wr, int wc, int fr, int fq) const {
        const int row0 = u.pm * 256 + wr * 64 + fr, zc0 = u.pn * 256 + wc * 32 + 8 * fq;
        const float* bp = b1 + (size_t)u.aux * 2048 + zc0;
        f32x4 bv[2][2];
#pragma unroll
        for (int bj = 0; bj < 2; ++bj)
#pragma unroll
            for (int n = 0; n < 2; ++n) bv[bj][n] = *(const f32x4*)(bp + bj * 128 + 4 * n);
#pragma unroll
        for (int ai = 0; ai < 2; ++ai)
#pragma unroll
            for (int m = 0; m < 4; ++m) {
                const int row = row0 + ai * 128 + m * 16;
#pragma unroll
                for (int bj = 0; bj < 2; ++bj) {
                    const f32x4 z0 = acc[ai][bj][m][0] + bv[bj][0], z1 = acc[ai][bj][m][1] + bv[bj][1];
                    float h[4];
                    const float gl[4] = {z0[0], z0[2], z1[0], z1[2]}, li[4] = {z0[1], z0[3], z1[1], z1[3]};
#pragma unroll
                    for (int p = 0; p < 4; ++p) { const float g = fminf(gl[p], 7.0f); const float l = fminf(fmaxf(li[p], -7.0f), 7.0f);
                        h[p] = g * __builtin_amdgcn_rcpf(1.0f + __builtin_amdgcn_exp2f(-1.702f * 1.4426950408889634f * g)) * (l + 1.0f); }
                    u32x2 w; w.x = cvtpk(h[0], h[1]); w.y = cvtpk(h[2], h[3]);
                    *(u32x2*)(H + (size_t)row * 1024 + (zc0 + bj * 128) / 2) = w;
                }
            }
    }
};

struct EpiDown {
    const float* b2; const float* roww; bf16* YE;
    __device__ __forceinline__ void operator()(const f32x4 (&acc)[2][2][4][2], const Unit& u, int wr, int wc, int fr, int fq) const {
        const int row0 = u.pm * 256 + wr * 64 + fr, c0 = u.pn * 256 + wc * 32 + 8 * fq;
        const float* bp = b2 + (size_t)u.aux * 1024 + c0;
        f32x4 bv[2][2];
#pragma unroll
        for (int bj = 0; bj < 2; ++bj)
#pragma unroll
            for (int n = 0; n < 2; ++n) bv[bj][n] = *(const f32x4*)(bp + bj * 128 + 4 * n);
#pragma unroll
        for (int ai = 0; ai < 2; ++ai)
#pragma unroll
            for (int m = 0; m < 4; ++m) {
                const int row = row0 + ai * 128 + m * 16; const float w8 = roww[row];
#pragma unroll
                for (int bj = 0; bj < 2; ++bj) {
                    const f32x4 y0 = (acc[ai][bj][m][0] + bv[bj][0]) * w8, y1 = (acc[ai][bj][m][1] + bv[bj][1]) * w8;
                    u32x4 w; w.x = cvtpk(y0[0], y0[1]); w.y = cvtpk(y0[2], y0[3]); w.z = cvtpk(y1[0], y1[1]); w.w = cvtpk(y1[2], y1[3]);
                    *(u32x4*)(YE + (size_t)row * 1024 + c0 + bj * 128) = w;
                }
            }
    }
};

__device__ __forceinline__ void transpose_item(const float* W, int N, bf16* WT, int drow0, LAS float* scr, int k0, int n0, int lane) {
#pragma unroll 8
    for (int i = 0; i < 32; ++i) { const int kk = 2 * i + (lane >> 5); scr[kk * 33 + (lane & 31)] = W[(size_t)(k0 + kk) * N + n0 + (lane & 31)]; }
    LDS_WAIT(); asm volatile("" ::: "memory");
    const int c = lane & 7;
#pragma unroll
    for (int j = 0; j < 4; ++j) { const int n = (lane >> 3) + 8 * j; const LAS float* s = scr + (8 * c) * 33 + n;
        u32x4 o; o.x = cvtpk(s[0 * 33], s[1 * 33]); o.y = cvtpk(s[2 * 33], s[3 * 33]); o.z = cvtpk(s[4 * 33], s[5 * 33]); o.w = cvtpk(s[6 * 33], s[7 * 33]);
        *(u32x4*)(WT + (size_t)(drow0 + n) * 1024 + k0 + 8 * c) = o; }
    LDS_WAIT(); asm volatile("" ::: "memory");
}
__device__ __forceinline__ int headperm_row(int n0) { const int pn = n0 >> 8, c = n0 & 255, hh = c >> 6, dh = (c & 63) >> 5; return pn * 256 + dh * 128 + hh * 32; }
__device__ __forceinline__ void rms_row_to_bf16(const float* xrow, const float* gain, bf16* orow, int lane) {
    const f32x4* xr = (const f32x4*)xrow + lane; const f32x4* gr = (const f32x4*)gain + lane;
    f32x4 v[4]; float s = 0.f;
#pragma unroll
    for (int j = 0; j < 4; ++j) { v[j] = xr[64 * j]; s += (v[j].x * v[j].x + v[j].y * v[j].y) + (v[j].z * v[j].z + v[j].w * v[j].w); }
    const float rstd = 1.0f / sqrtf(wave_sum(s) * (1.f / DM) + EPS);
    u32x2* o8 = (u32x2*)orow + lane;
#pragma unroll
    for (int j = 0; j < 4; ++j) { const f32x4 gg = gr[64 * j]; u32x2 w; w.x = cvtpk(v[j].x * rstd * gg.x, v[j].y * rstd * gg.y); w.y = cvtpk(v[j].z * rstd * gg.z, v[j].w * rstd * gg.w); o8[64 * j] = w; }
}

__device__ __forceinline__ void load64(const bf16* p, float (&d)[64]) {
    const u32x4* q = (const u32x4*)p;
#pragma unroll
    for (int i = 0; i < 8; ++i) { const u32x4 w = q[i]; d[8 * i + 0] = bflo(w.x); d[8 * i + 1] = bfhi(w.x); d[8 * i + 2] = bflo(w.y); d[8 * i + 3] = bfhi(w.y); d[8 * i + 4] = bflo(w.z); d[8 * i + 5] = bfhi(w.z); d[8 * i + 6] = bflo(w.w); d[8 * i + 7] = bfhi(w.w); }
}
__device__ __forceinline__ void store64(bf16* p, const float (&d)[64]) {
    u32x4* q = (u32x4*)p;
#pragma unroll
    for (int i = 0; i < 8; ++i) { u32x4 w; w.x = cvtpk(d[8 * i], d[8 * i + 1]); w.y = cvtpk(d[8 * i + 2], d[8 * i + 3]); w.z = cvtpk(d[8 * i + 4], d[8 * i + 5]); w.w = cvtpk(d[8 * i + 6], d[8 * i + 7]); q[i] = w; }
}
__device__ __forceinline__ float dothalf(const float (&a)[64], const bf16* p, int h) {
    const u32x4* q = (const u32x4*)(p + 32 * h); float s0 = 0.f, s1 = 0.f;
#pragma unroll
    for (int i = 0; i < 4; ++i) { const u32x4 w = q[i]; const int o = 32 * h + 8 * i;
        s0 += a[o] * bflo(w.x) + a[o + 2] * bflo(w.y) + a[o + 4] * bflo(w.z) + a[o + 6] * bflo(w.w);
        s1 += a[o + 1] * bfhi(w.x) + a[o + 3] * bfhi(w.y) + a[o + 5] * bfhi(w.z) + a[o + 7] * bfhi(w.w); }
    return s0 + s1;
}
__device__ __forceinline__ float dotbf(const float (&a)[64], const bf16* p) { return dothalf(a, p, 0) + dothalf(a, p, 1); }
__device__ __forceinline__ void axpy_bf(float (&acc)[64], float al, float pw, const bf16* vp) {
    const u32x4* q = (const u32x4*)vp;
#pragma unroll
    for (int i = 0; i < 8; ++i) { const u32x4 w = q[i]; const int o = 8 * i;
        acc[o] = acc[o] * al + pw * bflo(w.x); acc[o + 1] = acc[o + 1] * al + pw * bfhi(w.x); acc[o + 2] = acc[o + 2] * al + pw * bflo(w.y); acc[o + 3] = acc[o + 3] * al + pw * bfhi(w.y);
        acc[o + 4] = acc[o + 4] * al + pw * bflo(w.z); acc[o + 5] = acc[o + 5] * al + pw * bfhi(w.z); acc[o + 6] = acc[o + 6] * al + pw * bflo(w.w); acc[o + 7] = acc[o + 7] * al + pw * bfhi(w.w); }
}
__device__ __forceinline__ float dot64(const float (&a)[64], const float (&b)[64]) {
    float s0 = 0.f, s1 = 0.f, s2 = 0.f, s3 = 0.f;
#pragma unroll
    for (int i = 0; i < 64; i += 4) { s0 += a[i] * b[i]; s1 += a[i + 1] * b[i + 1]; s2 += a[i + 2] * b[i + 2]; s3 += a[i + 3] * b[i + 3]; }
    return (s0 + s1) + (s2 + s3);
}

__device__ __forceinline__ void naive_moba(const bf16* QA, const bf16* KA, const bf16* VA, const float* KMEAN, bf16* Y, int gw, int NGW, int lane_) {
    const int lane = opaque(lane_);
    for (int wi = gw; wi < (NB * 8 * SEQ) / 64; wi += NGW) {
        const int idx0 = wi * 64, bh = idx0 / SEQ, s0 = idx0 % SEQ, b = bh >> 3, h = bh & 7, s = s0 + lane, n = s0 >> 8;
        float q[64]; load64(QA + ((size_t)(b * SEQ + s)) * 512 + h * 64, q);
        float g0 = -3e38f, g1 = -3e38f, g2 = -3e38f; int i0 = -1, i1 = -1, i2 = -1;
        for (int j = 0; j < n; ++j) {
            const float* km = KMEAN + (((size_t)(b * 16 + j)) * 8 + h) * 64;
            float g = 0.f;
#pragma unroll
            for (int d = 0; d < 64; ++d) g += q[d] * km[d];
            if (g > g0) { g2 = g1; i2 = i1; g1 = g0; i1 = i0; g0 = g; i0 = j; }
            else if (g > g1) { g2 = g1; i2 = i1; g1 = g; i1 = j; }
            else if (g > g2) { g2 = g; i2 = j; }
        }
        unsigned mask = 0; if (i0 >= 0) mask |= 1u << i0; if (i1 >= 0) mask |= 1u << i1; if (i2 >= 0) mask |= 1u << i2;
        float m = -3e38f, l = 0.f, acc[64];
#pragma unroll
        for (int d = 0; d < 64; ++d) acc[d] = 0.f;
        for (int jb = 0; jb <= n; ++jb) {
            const bool act = (jb == n) || ((mask >> jb) & 1u);
            if (!__any(act)) continue;
            const int nk = (jb == n) ? (s0 + 64 - n * 256) : 256;
            for (int kk = 0; kk < nk; ++kk) {
                const int key = jb * 256 + kk;
                const float sc = dotbf(q, KA + ((size_t)(b * SEQ + key)) * 512 + h * 64);
                const bool valid = act && (key <= s);
                if (valid) {
                    const float mn = fmaxf(m, sc), al = __builtin_amdgcn_exp2f(m - mn), p = __builtin_amdgcn_exp2f(sc - mn);
                    l = l * al + p; m = mn;
                    axpy_bf(acc, al, p, VA + ((size_t)(b * SEQ + key)) * 512 + h * 64);
                }
            }
        }
        const float il = 1.0f / l;
#pragma unroll
        for (int d = 0; d < 64; ++d) acc[d] *= il;
        store64(Y + ((size_t)(b * SEQ + s)) * DM + h * 64, acc);
    }
}

__device__ __forceinline__ void naive_ret(const bf16* QR, const bf16* KR, const bf16* VR, const bf16* GR, const float* rgain, bf16* Y, int gw, int NGW, int lane_) {
    const int lane = opaque(lane_);
    for (int wi = gw; wi < (NB * 4 * SEQ) / 64; wi += NGW) {
        const int idx0 = wi * 64, bh = idx0 / SEQ, s0 = idx0 % SEQ, b = bh >> 2, h = bh & 3, s = s0 + lane;
        const float lg = log2f(1.0f - exp2f(-5.0f - (float)h));
        float q[64]; load64(QR + ((size_t)(b * SEQ + s)) * 256 + h * 64, q);
        float acc[64];
#pragma unroll
        for (int d = 0; d < 64; ++d) acc[d] = 0.f;
        int jlo = s0 - (int)(80.0f / (-lg)); if (jlo < 0) jlo = 0;
        for (int j = jlo; j < s0 + 64; ++j) {
            const float sc = dotbf(q, KR + ((size_t)(b * SEQ + j)) * 256 + h * 64);
            const float w = (j <= s) ? sc * __builtin_amdgcn_exp2f(lg * (float)(s - j)) : 0.f;
            axpy_bf(acc, 1.0f, w, VR + ((size_t)(b * SEQ + j)) * 256 + h * 64);
        }
        float ss = 0.f;
#pragma unroll
        for (int d = 0; d < 64; ++d) ss += acc[d] * acc[d];
        const float r = 1.0f / sqrtf(ss * (1.0f / 64.0f) + EPS);
        load64(GR + ((size_t)(b * SEQ + s)) * 256 + h * 64, q);
#pragma unroll
        for (int d = 0; d < 64; ++d) acc[d] = acc[d] * r * rgain[h * 64 + d] * q[d];
        store64(Y + ((size_t)(b * SEQ + s)) * DM + 512 + h * 64, acc);
    }
}

__device__ __forceinline__ void naive_mem(const bf16* QM, const bf16* MK, const bf16* MV, bf16* Y, int gw, int NGW, int lane_) {
    const int lane = opaque(lane_);
    for (int wi = gw; wi < (NB * 4 * SEQ) / 64; wi += NGW) {
        const int idx0 = wi * 64, bh = idx0 / SEQ, s0 = idx0 % SEQ, b = bh >> 2, h = bh & 3, s = s0 + lane;
        float q[64]; load64(QM + ((size_t)(b * SEQ + s)) * 256 + h * 64, q);
        float m = -3e38f, l = 0.f, acc[64];
#pragma unroll
        for (int d = 0; d < 64; ++d) acc[d] = 0.f;
        for (int j = 0; j < MEMLEN; ++j) {
            const float sc = dotbf(q, MK + ((size_t)(b * MEMLEN + j)) * 256 + h * 64);
            const float mn = fmaxf(m, sc), al = __builtin_amdgcn_exp2f(m - mn), p = __builtin_amdgcn_exp2f(sc - mn);
            l = l * al + p; m = mn;
            axpy_bf(acc, al, p, MV + ((size_t)(b * MEMLEN + j)) * 256 + h * 64);
        }
        const float il = 1.0f / l;
#pragma unroll
        for (int d = 0; d < 64; ++d) acc[d] *= il;
        store64(Y + ((size_t)(b * SEQ + s)) * DM + 768 + h * 64, acc);
    }
}

__global__ void __launch_bounds__(NTHREADS, 2) fwd_kernel(Args args) {
    extern __shared__ __attribute__((aligned(16))) unsigned char lds_raw[];
    LAS unsigned char* lds = (LAS unsigned char*)lds_raw;
    cg::grid_group grid = cg::this_grid();
    const int tid0 = threadIdx.x, wave = __builtin_amdgcn_readfirstlane(tid0 >> 6);
#define PHASE_LANES const int tid = opaque(tid0), lane = tid & 63; (void)lane; (void)tid
    const int G = gridDim.x, bx = blockIdx.x;
    const int vcu = (G % 8 == 0) ? (bx % 8) * (G / 8) + bx / 8 : bx;
    const int gw = vcu * NWAVES + wave, NGW = G * NWAVES;
    unsigned char* const ws = args.ws;
#define WSP(type, off) ((type*)(ws + (off)))
    {
        PHASE_LANES;
        LAS float* scr = (LAS float*)(lds + wave * 16384);
        const float* x = args.in[0]; const float* mem = args.in[1]; const float* g_attn = args.in[2]; const float* w_in = args.in[3]; const float* g_mem = args.in[7];
        const float* w_mem_kv = args.in[8]; const float* w_out = args.in[11]; const float* g_ffn = args.in[12]; const float* w_router = args.in[13]; const float* w1 = args.in[15]; const float* w2 = args.in[17];
        bf16* WIN_T = WSP(bf16, WS_WIN); bf16* WMEM_T = WSP(bf16, WS_WMEM); bf16* WOUT_T = WSP(bf16, WS_WOUT); bf16* W1_T = WSP(bf16, WS_W1); bf16* W2_T = WSP(bf16, WS_W2);
        bf16* XN = WSP(bf16, WS_XN); bf16* MEMN = WSP(bf16, WS_MEMN); float* WRG = WSP(float, WS_WRG);
        constexpr int I0 = 16 * 88, I1 = 16 * 16, I2 = 16 * 32, I3 = 32 * 16 * 64, I4 = 32 * 16 * 32, NIT = I0 + I1 + I2 + I3 + I4;
        for (int it = gw; it < NIT; it += NGW) {
            int r = it;
            if (r < I0) { const int nb = r % 88, kb = r / 88; transpose_item(w_in, NIN, WIN_T, headperm_row(nb * 32), scr, kb * 64, nb * 32, lane); continue; } r -= I0;
            if (r < I1) { const int nb = r % 16, kb = r / 16; transpose_item(w_mem_kv, 512, WMEM_T, headperm_row(nb * 32), scr, kb * 64, nb * 32, lane); continue; } r -= I1;
            if (r < I2) { const int nb = r % 32, kb = r / 32; transpose_item(w_out, 1024, WOUT_T, nb * 32, scr, kb * 64, nb * 32, lane); continue; } r -= I2;
            if (r < I3) { const int e = r / 1024, rr = r % 1024, nb = rr % 64, kb = rr / 64; transpose_item(w1 + (size_t)e * 1024 * 2048, 2048, W1_T + (size_t)e * 2048 * 1024, nb * 32, scr, kb * 64, nb * 32, lane); continue; } r -= I3;
            { const int e = r / 512, rr = r % 512, nb = rr % 32, kb = rr / 32; transpose_item(w2 + (size_t)e * 1024 * 1024, 1024, W2_T + (size_t)e * 1024 * 1024, nb * 32, scr, kb * 64, nb * 32, lane); }
        }
        for (int m = gw; m < T + MROWS; m += NGW) {
            if (m < T) rms_row_to_bf16(x + (size_t)m * DM, g_attn, XN + (size_t)m * DM, lane);
            else rms_row_to_bf16(mem + (size_t)(m - T) * DM, g_mem, MEMN + (size_t)(m - T) * DM, lane);
        }
        for (int i = bx * NTHREADS + tid; i < DM * NEXP; i += G * NTHREADS) WRG[i] = g_ffn[i >> 5] * w_router[i];
    }
    grid.sync();

    {
        SchedProj S{G, bx, (const char*)(ws + WS_XN), (const char*)(ws + WS_MEMN), (const char*)(ws + WS_WIN), (const char*)(ws + WS_WMEM)};
        EpiProj E{ws, args.in[4], args.in[5], args.in[9], args.in[10]};
#ifndef NO_G1
        pg8::gemm_phase<EpiProj, SchedProj>(lds, S, E);
#endif
    }
    grid.sync();

    { PHASE_LANES;
#ifndef NO_MOBA
    naive_moba(WSP(bf16, WS_QA), WSP(bf16, WS_KA), WSP(bf16, WS_VA), WSP(float, WS_KMEAN), WSP(bf16, WS_Y), gw, NGW, lane);
#endif
#ifndef NO_RET
    naive_ret(WSP(bf16, WS_QR), WSP(bf16, WS_KR), WSP(bf16, WS_VR), WSP(bf16, WS_GR), args.in[6], WSP(bf16, WS_Y), gw, NGW, lane);
#endif
#ifndef NO_MEM
    naive_mem(WSP(bf16, WS_QM), WSP(bf16, WS_MK), WSP(bf16, WS_MV), WSP(bf16, WS_Y), gw, NGW, lane);
#endif
    }
    grid.sync();

    {
        SchedPlain S{G, bx, 128, 4, (const char*)(ws + WS_Y), (const char*)(ws + WS_WOUT)};
        EpiOut E{args.in[0], args.out, WSP(float, WS_SSQ)};
#ifndef NO_G2
        pg8::gemm_phase<EpiOut, SchedPlain>(lds, S, E);
#endif
    }
    grid.sync();

    {
        PHASE_LANES;
        float* out = args.out; const float* b_router = args.in[14];
        float* WRG = WSP(float, WS_WRG); float* SSQ = WSP(float, WS_SSQ); int* TOPI = WSP(int, WS_TOPI); float* TOPW = WSP(float, WS_TOPW); int* LRANK = WSP(int, WS_LRANK); int* LCOUNT = WSP(int, WS_LCOUNT);
        LAS float* lg = (LAS float*)(lds) + wave * (16 * 33);
        LAS int* hist = (LAS int*)(lds + 32768);
        if (tid < 32) hist[tid] = 0;
        __syncthreads();
        const int tpw = T / (G * NWAVES);
        for (int tb = 0; tb < tpw; tb += 16) {
            const int t0 = (bx * NWAVES + wave) * tpw + tb;
            const int i = lane & 15, kq = lane >> 4;
            f32x4 a0 = {0.f, 0.f, 0.f, 0.f}, a1 = {0.f, 0.f, 0.f, 0.f};
            const float* xr = out + (size_t)(t0 + i) * DM + 4 * kq;
            const float* wb = WRG + (size_t)(4 * kq) * 32 + i;
#pragma unroll 4
            for (int c = 0; c < 64; ++c) {
                const f32x4 av = *(const f32x4*)(xr + 16 * c);
#pragma unroll
                for (int q = 0; q < 4; ++q) {
                    const float b0 = wb[(size_t)(16 * c + q) * 32], b1v = wb[(size_t)(16 * c + q) * 32 + 16];
                    a0 = __builtin_amdgcn_mfma_f32_16x16x4f32(av[q], b0, a0, 0, 0, 0);
                    a1 = __builtin_amdgcn_mfma_f32_16x16x4f32(av[q], b1v, a1, 0, 0, 0);
                }
            }
#pragma unroll
            for (int r = 0; r < 4; ++r) { lg[(4 * kq + r) * 33 + i] = a0[r]; lg[(4 * kq + r) * 33 + 16 + i] = a1[r]; }
            LDS_WAIT(); asm volatile("" ::: "memory");
            if (lane < 16) {
                const int t = t0 + lane;
                float ss = 0.f;
#pragma unroll
                for (int j = 0; j < 16; ++j) ss += SSQ[(size_t)t * 16 + j];
                const float rstd = 1.0f / sqrtf(ss * (1.0f / DM) + EPS);
                float v[32];
#pragma unroll
                for (int e = 0; e < 32; ++e) v[e] = lg[lane * 33 + e] * rstd + b_router[e];
                int bi[4]; float bvv[4];
#pragma unroll
                for (int k = 0; k < 4; ++k) {
                    float best = -3e38f; int be = 0;
#pragma unroll
                    for (int e = 0; e < 32; ++e) { const bool take = v[e] > best; best = take ? v[e] : best; be = take ? e : be; }
                    bi[k] = be; bvv[k] = best;
#pragma unroll
                    for (int e = 0; e < 32; ++e) v[e] = (e == be) ? -3e38f : v[e];
                }
                const float e1 = __expf(bvv[1] - bvv[0]), e2 = __expf(bvv[2] - bvv[0]), e3 = __expf(bvv[3] - bvv[0]);
                const float inv = 1.0f / (1.0f + e1 + e2 + e3);
                const float wv[4] = {inv, e1 * inv, e2 * inv, e3 * inv};
#pragma unroll
                for (int k = 0; k < 4; ++k) {
                    const int rk = atomicAdd((int*)&hist[bi[k]], 1);
                    TOPI[t * 4 + k] = bi[k]; TOPW[t * 4 + k] = wv[k]; LRANK[t * 4 + k] = rk;
                }
            }
            LDS_WAIT(); asm volatile("" ::: "memory");
        }
        __syncthreads();
        if (tid < 32) LCOUNT[bx * 32 + tid] = hist[tid];
    }
    grid.sync();

    {
        PHASE_LANES;
        float* out = args.out; const float* g_ffn = args.in[12];
        float* SSQ = WSP(float, WS_SSQ); int* TOPI = WSP(int, WS_TOPI); float* TOPW = WSP(float, WS_TOPW); int* LRANK = WSP(int, WS_LRANK); int* LCOUNT = WSP(int, WS_LCOUNT);
        int* POS = WSP(int, WS_POS); float* ROWW = WSP(float, WS_ROWW); int* PSTART = WSP(int, WS_PSTART); int* TILEEXP = WSP(int, WS_TILEEXP); bf16* XG = WSP(bf16, WS_XG);
        LAS int* part = (LAS int*)(lds);
        LAS int* base = (LAS int*)(lds + 8192);
        {
            const int e = tid & 31, p = tid >> 5; int c = 0, pre = 0;
            const int wpp = (G + 15) / 16;
            for (int w = p * wpp; w < (p + 1) * wpp && w < G; ++w) { const int v = LCOUNT[w * 32 + e]; c += v; pre += (w < bx) ? v : 0; }
            part[p * 32 + e] = c; part[512 + p * 32 + e] = pre;
        }
        __syncthreads();
        if (tid < 32) { int c = 0, pre = 0; for (int p = 0; p < 16; ++p) { c += part[p * 32 + tid]; pre += part[512 + p * 32 + tid]; } part[1024 + tid] = c; part[1056 + tid] = pre; }
        __syncthreads();
        if (tid == 0) {
            int ps = 0;
            for (int e = 0; e < 32; ++e) {
                const int c = part[1024 + e], nt_ = (c + 255) >> 8;
                base[32 + e] = ps; base[e] = ps + part[1056 + e];
                if (bx == 0) { PSTART[e] = ps; for (int tt = 0; tt < nt_; ++tt) TILEEXP[(ps >> 8) + tt] = e; }
                ps += nt_ * 256;
            }
            base[64] = ps; if (bx == 0) PSTART[32] = ps;
        }
        __syncthreads();
        if (bx < 32) {
            const int c = part[1024 + bx], r0 = base[32 + bx] + c, r1 = base[32 + bx] + (((c + 255) >> 8) << 8);
            for (int r = r0 + wave; r < r1; r += NWAVES) { u32x4* p = (u32x4*)(XG + (size_t)r * 1024); p[lane] = (u32x4){0u, 0u, 0u, 0u}; p[64 + lane] = (u32x4){0u, 0u, 0u, 0u}; if (lane == 0) ROWW[r] = 0.f; }
        }
        const int tpw = T / (G * NWAVES);
        for (int tb = 0; tb < tpw; ++tb) {
            const int t = (bx * NWAVES + wave) * tpw + tb;
            float ss = 0.f; if (lane < 16) ss = SSQ[(size_t)t * 16 + lane];
            ss += __shfl_xor(ss, 1); ss += __shfl_xor(ss, 2); ss += __shfl_xor(ss, 4); ss += __shfl_xor(ss, 8);
            ss = __shfl(ss, 0);
            const float rstd = 1.0f / sqrtf(ss * (1.0f / DM) + EPS);
            const f32x4* xr = (const f32x4*)(out + (size_t)t * DM) + lane; const f32x4* gr = (const f32x4*)g_ffn + lane;
            u32x2 w[4];
#pragma unroll
            for (int j = 0; j < 4; ++j) { const f32x4 v = xr[64 * j], gg = gr[64 * j]; w[j].x = cvtpk(v.x * rstd * gg.x, v.y * rstd * gg.y); w[j].y = cvtpk(v.z * rstd * gg.z, v.w * rstd * gg.w); }
#pragma unroll
            for (int k = 0; k < 4; ++k) {
                const int e = TOPI[t * 4 + k]; const int pos = base[e] + LRANK[t * 4 + k];
                u32x2* o8 = (u32x2*)(XG + (size_t)pos * 1024) + lane;
#pragma unroll
                for (int j = 0; j < 4; ++j) o8[64 * j] = w[j];
                if (lane == 0) { POS[t * 4 + k] = pos; ROWW[pos] = TOPW[t * 4 + k]; }
            }
        }
    }
    grid.sync();

    const int ntiles = WSP(int, WS_PSTART)[32] >> 8;
    {
        SchedMoe S{G, vcu, 8, ntiles, WSP(int, WS_TILEEXP), (const char*)(ws + WS_XG), (const char*)(ws + WS_W1), (size_t)2048 * 2048};
        EpiSwiglu E{args.in[16], WSP(bf16, WS_H)};
#ifndef NO_G3
        pg8::gemm_phase<EpiSwiglu, SchedMoe>(lds, S, E);
#endif
    }
    grid.sync();
    {
        SchedMoe S{G, vcu, 4, ntiles, WSP(int, WS_TILEEXP), (const char*)(ws + WS_H), (const char*)(ws + WS_W2), (size_t)1024 * 2048};
        EpiDown E{args.in[18], WSP(float, WS_ROWW), WSP(bf16, WS_XG)};
#ifndef NO_G4
        pg8::gemm_phase<EpiDown, SchedMoe>(lds, S, E);
#endif
    }
    grid.sync();
    { PHASE_LANES;
    for (int t = gw; t < T; t += NGW) {
        float* out = args.out; const int* POS = WSP(int, WS_POS); const bf16* YE = WSP(bf16, WS_XG);
        f32x4* orow = (f32x4*)(out + (size_t)t * DM) + lane;
        f32x4 v[4];
#pragma unroll
        for (int j = 0; j < 4; ++j) v[j] = orow[64 * j];
#pragma unroll
        for (int k = 0; k < 4; ++k) {
            const int pos = POS[t * 4 + k]; const u32x2* yr = (const u32x2*)(YE + (size_t)pos * 1024) + lane;
#pragma unroll
            for (int j = 0; j < 4; ++j) { const u32x2 w = yr[64 * j]; v[j].x += bflo(w.x); v[j].y += bfhi(w.x); v[j].z += bflo(w.y); v[j].w += bfhi(w.y); }
        }
#pragma unroll
        for (int j = 0; j < 4; ++j) orow[64 * j] = v[j];
    }
    }
}

extern "C" void kernel_launch(void* const* d_in, const int* in_sizes, int n_in, void* d_out, int out_size, void* d_ws, size_t ws_size, hipStream_t stream) {
    static int grid = 0;
    if (grid == 0) {
        if (n_in != 19 || out_size != T * DM || ws_size < WS_END) { fprintf(stderr, "kernel_launch: unexpected shapes (n_in %d out %d ws %zu)\n", n_in, out_size, ws_size); grid = -1; return; }
        int dev = 0, cus = 0, per_cu = 0;
        hipGetDevice(&dev); hipDeviceGetAttribute(&cus, hipDeviceAttributeMultiprocessorCount, dev);
        hipFuncSetAttribute((const void*)fwd_kernel, hipFuncAttributeMaxDynamicSharedMemorySize, LDS_BYTES);
        hipOccupancyMaxActiveBlocksPerMultiprocessor(&per_cu, (const void*)fwd_kernel, NTHREADS, LDS_BYTES);
        if (per_cu < 1) { fprintf(stderr, "kernel_launch: occupancy query says %d blocks per CU\n", per_cu); per_cu = 1; }
        (void)hipGetLastError();
        grid = cus * 1;
        if (grid % 8 != 0 || T % (grid * NWAVES * 16) != 0) { fprintf(stderr, "kernel_launch: grid %d unsupported\n", grid); grid = -1; return; }
    }
    if (grid < 0) return;
    hipMemsetAsync((char*)d_ws + WS_CTL, 0, CTL_ZERO_BYTES, stream);
    Args a{};
    for (int i = 0; i < 19; ++i) a.in[i] = (const float*)d_in[i];
    a.out = (float*)d_out; a.ws = (unsigned char*)d_ws;
    void* kargs[] = {&a};
    hipError_t e = hipLaunchCooperativeKernel((const void*)fwd_kernel, dim3(grid), dim3(NTHREADS), kargs, LDS_BYTES, stream);
    if (e != hipSuccess) fprintf(stderr, "cooperative launch failed: %s (grid %d)\n", hipGetErrorString(e), grid);
}
```

```cpp
#include <hip/hip_runtime.h>
#include <hip/hip_cooperative_groups.h>
#include <cstdio>
#include <cstdint>
namespace cg = cooperative_groups;

#define GAS __attribute__((address_space(1)))
#define LAS __attribute__((address_space(3)))
typedef unsigned short bf16;
typedef short bf16x8 __attribute__((ext_vector_type(8)));
typedef float f32x4 __attribute__((ext_vector_type(4)));
typedef float f32x2 __attribute__((ext_vector_type(2)));
typedef unsigned u32x4 __attribute__((ext_vector_type(4)));
typedef unsigned u32x2 __attribute__((ext_vector_type(2)));
typedef __bf16 bf16x2_t __attribute__((ext_vector_type(2)));

constexpr int NB = 8, SEQ = 4096, DM = 1024, T = NB * SEQ;
constexpr int NIN = 2816, NEXP = 32, TOPK = 4;
constexpr int MEMLEN = 256, MROWS = NB * MEMLEN;
constexpr float EPS = 1e-6f;
constexpr float C2 = 0.125f * 1.4426950408889634f;
constexpr int MAXTILES = 544, PROWS = MAXTILES * 256;
constexpr int NWAVES = 8, NTHREADS = 512;
constexpr int LDS_BYTES = 147456;

constexpr size_t MiB = 1u << 20;
constexpr size_t WS_CTL = 0, CTL_ZERO_BYTES = 2 * MiB;
constexpr size_t WS_KMEAN = 1 * MiB;
constexpr size_t WS_WRG = 2 * MiB;
constexpr size_t WS_SSQ = 3 * MiB;
constexpr size_t WS_TOPI = 5 * MiB, WS_TOPW = 5 * MiB + 512 * 1024, WS_LRANK = 6 * MiB, WS_POS = 6 * MiB + 512 * 1024;
constexpr size_t WS_ROWW = 7 * MiB;
constexpr size_t WS_LCOUNT = 8 * MiB, WS_PSTART = 8 * MiB + 65536, WS_TILEEXP = 8 * MiB + 131072;
constexpr size_t WS_WIN = 16 * MiB, WS_WMEM = 22 * MiB, WS_WOUT = 24 * MiB, WS_W1 = 32 * MiB, WS_W2 = 160 * MiB;
constexpr size_t WS_XN = 224 * MiB, WS_MEMN = 288 * MiB;
constexpr size_t WS_QA = 292 * MiB, WS_KA = 324 * MiB, WS_VA = 356 * MiB;
constexpr size_t WS_QR = 388 * MiB, WS_KR = 404 * MiB, WS_VR = 420 * MiB, WS_GR = 436 * MiB, WS_QM = 452 * MiB;
constexpr size_t WS_MK = 468 * MiB, WS_MV = 469 * MiB;
constexpr size_t WS_Y = 470 * MiB, WS_RET = 534 * MiB;
constexpr size_t WS_XG = 224 * MiB;
constexpr size_t WS_H = 566 * MiB;
constexpr size_t WS_END = 838 * MiB;

struct Args {
    const float* in[19]; float* out; unsigned char* ws; int pad0, pad1;
};

__device__ __forceinline__ unsigned cvtpk(float lo, float hi) { f32x2 v = {lo, hi}; bf16x2_t b = __builtin_convertvector(v, bf16x2_t); return __builtin_bit_cast(unsigned, b); }
__device__ __forceinline__ float bf2f(unsigned short b) { return __uint_as_float(((unsigned)b) << 16); }
__device__ __forceinline__ float bflo(unsigned w) { return __uint_as_float(w << 16); }
__device__ __forceinline__ float bfhi(unsigned w) { return __uint_as_float(w & 0xffff0000u); }
__device__ __forceinline__ float wave_sum(float v) {
#pragma unroll
    for (int o = 1; o < 64; o <<= 1) v += __shfl_xor(v, o);
    return v;
}
#define LDS_WAIT() asm volatile("s_waitcnt lgkmcnt(0)" ::: "memory")
__device__ __forceinline__ int opaque(int v) { asm volatile("" : "+v"(v)); return v; }

namespace pg8 {
constexpr int BM = 256, BK = 64, HALF = 128, HTB = HALF * BK * 2, STAGE_BYTES = 8 * HTB, NXCD = 8, WGM = 8, K = 1024;
__host__ __device__ __forceinline__ int lds_byte(int r, int c) { const int st = (r >> 4) * 2 + (c >> 5), rr = r & 15, cc = c & 31, ob = rr * 64 + cc * 2; return st * 1024 + (ob ^ (((ob >> 9) & 1) << 5)); }
__host__ __device__ __forceinline__ void stage_rc(int b, int& R, int& C) { const int st = b / 1024, sb = b % 1024, swz = sb ^ (((sb >> 9) & 1) << 5); R = (st >> 1) * 16 + swz / 64; C = (st & 1) * 32 + (swz % 64) / 2; }
__host__ __device__ __forceinline__ int perm32(int rho) { const int n = rho >> 4, i = rho & 15; return 8 * (i >> 2) + 4 * n + (i & 3); }
struct Unit { int pm, pn, aux; };

__device__ __forceinline__ bool static_order(int L, int nM, int nN, int& pm, int& pn) {
    const int nwg = nM * nN; if (L >= nwg) return false;
    int wgid = L; { const int q = nwg / NXCD, r = nwg % NXCD, xcd = wgid % NXCD, off = wgid / NXCD; wgid = (xcd < r ? xcd * (q + 1) : r * (q + 1) + (xcd - r) * q) + off; }
    const int nig = WGM * nN, gid = wgid / nig, fm = gid * WGM, gsz = (nM - fm) < WGM ? (nM - fm) : WGM;
    pm = fm + ((wgid % nig) % gsz); pn = (wgid % nig) / gsz; return true;
}

template <class Epi, class Sched>
__device__ __forceinline__ void gemm_phase(LAS unsigned char* lds, const Sched& S, const Epi& E) {
    const int tid = opaque((int)threadIdx.x), wid = __builtin_amdgcn_readfirstlane(tid >> 6), lane = tid & 63, wr = wid >> 2, wc = wid & 3, fr = lane & 15, fq = lane >> 4;
    constexpr int nt = K / BK;
    unsigned voffA[2], voffB[2];
#pragma unroll
    for (int i = 0; i < 2; ++i) { int R, C; stage_rc(tid * 16 + i * 8192, R, C); const int Rb = (R & ~31) + perm32(R & 31);
        voffA[i] = (unsigned)(R * K + C) * 2u; voffB[i] = (unsigned)(Rb * K + C) * 2u; }
    const size_t kstep = (size_t)(BK * 2);
    const size_t hstep = (size_t)HALF * K * 2;
    const unsigned ldsw = (unsigned)wid * 1024u;
    const int aoff = lds_byte(wr * 64 + fr, fq * 8), boff = lds_byte(wc * 32 + fr, fq * 8);
#define PG8_SA(b, h) (((b) * 2 + (h)) * HTB)
#define PG8_SB(b, h) ((4 + (b) * 2 + (h)) * HTB)
#define PG8_STAGE(bufoff, gbase, voff) do { _Pragma("unroll") for (int _i = 0; _i < 2; ++_i) \
        __builtin_amdgcn_global_load_lds((const unsigned*)((const char*)(gbase) + (voff)[_i]), (LAS unsigned*)(lds + (bufoff) + ldsw + _i * 8192), 16, 0, 0); } while (0)
#define PG8_LDA(dst, b, h) do { _Pragma("unroll") for (int m = 0; m < 4; ++m) _Pragma("unroll") for (int k = 0; k < 2; ++k) dst[m][k] = *(const LAS bf16x8*)(lds + PG8_SA(b, h) + aoff + m * 2048 + k * 1024); } while (0)
#define PG8_LDB(dst, b, h) do { _Pragma("unroll") for (int n = 0; n < 2; ++n) _Pragma("unroll") for (int k = 0; k < 2; ++k) dst[n][k] = *(const LAS bf16x8*)(lds + PG8_SB(b, h) + boff + n * 2048 + k * 1024); } while (0)
#define PG8_MMA(ai, bj, At, Bt) do { __builtin_amdgcn_s_setprio(1); _Pragma("unroll") for (int m = 0; m < 4; ++m) _Pragma("unroll") for (int n = 0; n < 2; ++n) _Pragma("unroll") for (int k = 0; k < 2; ++k) \
        acc[ai][bj][m][n] = __builtin_amdgcn_mfma_f32_16x16x32_bf16(Bt[n][k], At[m][k], acc[ai][bj][m][n], 0, 0, 0); __builtin_amdgcn_s_setprio(0); } while (0)
#define PG8_WAIT_V(n) asm volatile("s_waitcnt vmcnt(" #n ")" ::: "memory")
#define PG8_WAIT_L(n) asm volatile("s_waitcnt lgkmcnt(" #n ")" ::: "memory")
#define PG8_BAR __builtin_amdgcn_s_barrier()
#define PG8_SCHED __builtin_amdgcn_sched_barrier(0)
    Unit cur, nxt; int ui = 0;
    if (!S.next(0, cur)) return;
    f32x4 acc[2][2][4][2];
#pragma unroll
    for (int a = 0; a < 2; ++a)
#pragma unroll
        for (int b = 0; b < 2; ++b)
#pragma unroll
            for (int m = 0; m < 4; ++m)
#pragma unroll
                for (int n = 0; n < 2; ++n) acc[a][b][m][n] = (f32x4){0.f, 0.f, 0.f, 0.f};
    bf16x8 At[4][2], B0[2][2], B1[2][2];
    const char* cA = S.aptr(cur); const char* cB = S.bptr(cur);
    {
        PG8_STAGE(PG8_SB(0, 0), cB, voffB); PG8_STAGE(PG8_SB(0, 1), cB + hstep, voffB); PG8_STAGE(PG8_SA(0, 0), cA, voffA); PG8_STAGE(PG8_SA(0, 1), cA + hstep, voffA);
        if (wr == 1) PG8_BAR;
        PG8_WAIT_V(2); PG8_BAR;
        PG8_STAGE(PG8_SB(1, 0), cB + kstep, voffB); PG8_STAGE(PG8_SA(1, 0), cA + kstep, voffA); PG8_STAGE(PG8_SB(1, 1), cB + hstep + kstep, voffB);
        PG8_WAIT_V(6); PG8_BAR;
    }
    for (;;) {
        const bool has_next = S.next(ui + 1, nxt);
        const char* nA = has_next ? S.aptr(nxt) : cA; const char* nB = has_next ? S.bptr(nxt) : cB;
        for (int t = 0; t < nt; t += 2) {
            const bool last = (t == nt - 2);
            const char* a1 = cA + (size_t)(t + 1) * kstep;
            const char* a2 = last ? nA : cA + (size_t)(t + 2) * kstep; const char* b2 = last ? nB : cB + (size_t)(t + 2) * kstep;
            const char* a3 = a2 + kstep; const char* b3 = b2 + kstep;
            PG8_LDB(B0, 0, 0); PG8_LDB(B1, 0, 1); PG8_SCHED; PG8_LDA(At, 0, 0); PG8_STAGE(PG8_SA(1, 1), a1 + hstep, voffA);
            PG8_WAIT_V(8); PG8_WAIT_L(0); PG8_BAR; PG8_MMA(0, 0, At, B0); PG8_MMA(0, 1, At, B1); PG8_BAR; PG8_SCHED;
            PG8_LDA(At, 0, 1); PG8_STAGE(PG8_SB(0, 0), b2, voffB); PG8_STAGE(PG8_SB(0, 1), b2 + hstep, voffB); PG8_STAGE(PG8_SA(0, 0), a2, voffA);
            PG8_WAIT_V(8); PG8_WAIT_L(0); PG8_BAR; PG8_MMA(1, 0, At, B0); PG8_MMA(1, 1, At, B1); PG8_BAR; PG8_SCHED;
            PG8_LDB(B0, 1, 0); PG8_LDB(B1, 1, 1); PG8_SCHED; PG8_LDA(At, 1, 0); PG8_STAGE(PG8_SA(0, 1), a2 + hstep, voffA);
            PG8_WAIT_V(8); PG8_WAIT_L(0); PG8_BAR; PG8_MMA(0, 0, At, B0); PG8_MMA(0, 1, At, B1); PG8_BAR; PG8_SCHED;
            PG8_LDA(At, 1, 1); PG8_STAGE(PG8_SB(1, 0), b3, voffB); PG8_STAGE(PG8_SB(1, 1), b3 + hstep, voffB); PG8_STAGE(PG8_SA(1, 0), a3, voffA);
            PG8_WAIT_V(8); PG8_WAIT_L(0); PG8_BAR; PG8_MMA(1, 0, At, B0); PG8_MMA(1, 1, At, B1); PG8_BAR; PG8_SCHED;
        }
        if (wr == 0) PG8_BAR;
        E(acc, cur, wr, wc, fr, fq);
        if (!has_next) break;
#pragma unroll
        for (int a = 0; a < 2; ++a)
#pragma unroll
            for (int b = 0; b < 2; ++b)
#pragma unroll
                for (int m = 0; m < 4; ++m)
#pragma unroll
                    for (int n = 0; n < 2; ++n) acc[a][b][m][n] = (f32x4){0.f, 0.f, 0.f, 0.f};
        cur = nxt; cA = nA; cB = nB; ++ui;
        if (wr == 1) PG8_BAR;
    }
    PG8_WAIT_V(0);
    PG8_BAR;
#undef PG8_SA
#undef PG8_SB
#undef PG8_STAGE
#undef PG8_LDA
#undef PG8_LDB
#undef PG8_MMA
#undef PG8_WAIT_V
#undef PG8_WAIT_L
#undef PG8_BAR
#undef PG8_SCHED
}
}
using pg8::Unit;

struct SchedProj {
    int G, c; const char *XN, *MEMN, *WIN, *WMEM;
    __device__ __forceinline__ bool next(int i, Unit& u) const {
        const int L = i * G + c;
        if (L < 1408) { u.aux = 0; return pg8::static_order(L, 128, 11, u.pm, u.pn); }
        if (L < 1424) { const int j = L - 1408; u.pm = j >> 1; u.pn = j & 1; u.aux = 1; return true; }
        return false;
    }
    __device__ __forceinline__ const char* aptr(const Unit& u) const { return (u.aux ? MEMN : XN) + (size_t)u.pm * (256 * 2048); }
    __device__ __forceinline__ const char* bptr(const Unit& u) const { return (u.aux ? WMEM : WIN) + (size_t)u.pn * (256 * 2048); }
};
struct SchedPlain {
    int G, c, nM, nN; const char *A, *B;
    __device__ __forceinline__ bool next(int i, Unit& u) const { u.aux = 0; return pg8::static_order(i * G + c, nM, nN, u.pm, u.pn); }
    __device__ __forceinline__ const char* aptr(const Unit& u) const { return A + (size_t)u.pm * (256 * 2048); }
    __device__ __forceinline__ const char* bptr(const Unit& u) const { return B + (size_t)u.pn * (256 * 2048); }
};
struct SchedMoe {
    int G, vcu, npn, ntiles; const int* tile_exp; const char *A, *B; size_t bexp;
    __device__ __forceinline__ bool next(int i, Unit& u) const {
        const int L = i * G + vcu, tile = L / npn; if (tile >= ntiles) return false;
        u.pm = tile; u.pn = L - tile * npn; u.aux = __builtin_amdgcn_readfirstlane(tile_exp[tile]); return true;
    }
    __device__ __forceinline__ const char* aptr(const Unit& u) const { return A + (size_t)u.pm * (256 * 2048); }
    __device__ __forceinline__ const char* bptr(const Unit& u) const { return B + (size_t)u.aux * bexp + (size_t)u.pn * (256 * 2048); }
};

struct EpiProj {
    unsigned char* ws;
    const float *gq, *gk, *gmq, *gmk;
    __device__ __forceinline__ void operator()(const f32x4 (&acc)[2][2][4][2], const Unit& u, int wr, int wc, int fr, int fq) const {
        int mode = 0; bf16* out; int ld = 256, coff = 0; const float* gain = nullptr; float scale = 1.f; bool kmean = false;
        if (u.aux == 0) {
            switch (u.pn) {
                case 0: case 1: out = (bf16*)(ws + WS_QA); ld = 512; coff = u.pn * 256; mode = 1; gain = gq; scale = C2; break;
                case 2: case 3: out = (bf16*)(ws + WS_KA); ld = 512; coff = (u.pn - 2) * 256; mode = 1; gain = gk; kmean = true; break;
                case 4: case 5: out = (bf16*)(ws + WS_VA); ld = 512; coff = (u.pn - 4) * 256; break;
                case 6: out = (bf16*)(ws + WS_QR); mode = 2; break;
                case 7: out = (bf16*)(ws + WS_KR); mode = 2; scale = 0.125f; break;
                case 8: out = (bf16*)(ws + WS_VR); break;
                case 9: out = (bf16*)(ws + WS_GR); mode = 3; break;
                default: out = (bf16*)(ws + WS_QM); mode = 1; gain = gmq; scale = C2; break;
            }
        } else {
            if (u.pn == 0) { out = (bf16*)(ws + WS_MK); mode = 1; gain = gmk; } else { out = (bf16*)(ws + WS_MV); }
        }
        const int row0 = u.pm * 256 + wr * 64 + fr;
        const int colb = coff + wc * 64 + 8 * fq;
        if (gain == nullptr) gain = gq;
        f32x4 ks[2][2];
#pragma unroll
        for (int bj = 0; bj < 2; ++bj)
#pragma unroll
            for (int n = 0; n < 2; ++n) ks[bj][n] = (f32x4){0.f, 0.f, 0.f, 0.f};
#pragma unroll
        for (int ai = 0; ai < 2; ++ai)
#pragma unroll
            for (int m = 0; m < 4; ++m) {
                const int row = row0 + ai * 128 + m * 16;
                f32x4 v[2][2];
#pragma unroll
                for (int bj = 0; bj < 2; ++bj)
#pragma unroll
                    for (int n = 0; n < 2; ++n) v[bj][n] = acc[ai][bj][m][n];
                if (mode == 1) {
                    float ss = 0.f;
#pragma unroll
                    for (int bj = 0; bj < 2; ++bj)
#pragma unroll
                        for (int n = 0; n < 2; ++n) { const f32x4 x = v[bj][n]; ss += (x[0] * x[0] + x[1] * x[1]) + (x[2] * x[2] + x[3] * x[3]); }
                    ss += __shfl_xor(ss, 16); ss += __shfl_xor(ss, 32);
                    const float r = scale / sqrtf(ss * (1.0f / 64.0f) + EPS);
#pragma unroll
                    for (int bj = 0; bj < 2; ++bj)
#pragma unroll
                        for (int n = 0; n < 2; ++n) v[bj][n] = v[bj][n] * r * *(const f32x4*)(gain + bj * 32 + 8 * fq + 4 * n);
                } else if (mode == 2) {
                    const float pos = (float)(row & (SEQ - 1));
                    const float lgam = __builtin_amdgcn_logf(1.0f - __builtin_amdgcn_exp2f(-5.0f - (float)wc));
                    const float rsc = scale * __builtin_amdgcn_exp2f(((u.pn == 6) ? lgam : -lgam) * (float)(row & 127));
#pragma unroll
                    for (int n = 0; n < 2; ++n)
#pragma unroll
                        for (int j = 0; j < 4; ++j) {
                            const float fre = __builtin_amdgcn_exp2f((float)(8 * fq + 4 * n + j) * (-13.287712379549449f / 31.0f)) * 0.15915494309189535f;
                            float tt = pos * fre; tt = tt - floorf(tt);
                            const float sn = __builtin_amdgcn_sinf(tt), cs = __builtin_amdgcn_cosf(tt);
                            const float t1 = v[0][n][j], t2 = v[1][n][j];
                            v[0][n][j] = (t1 * cs - t2 * sn) * rsc; v[1][n][j] = (t2 * cs + t1 * sn) * rsc;
                        }
                } else if (mode == 3) {
#pragma unroll
                    for (int bj = 0; bj < 2; ++bj)
#pragma unroll
                        for (int n = 0; n < 2; ++n)
#pragma unroll
                            for (int j = 0; j < 4; ++j) { const float x = v[bj][n][j]; v[bj][n][j] = x / (1.0f + __expf(-x)); }
                }
                if (kmean) {
#pragma unroll
                    for (int bj = 0; bj < 2; ++bj)
#pragma unroll
                        for (int n = 0; n < 2; ++n) ks[bj][n] += v[bj][n];
                }
                bf16* rowp = out + (size_t)row * ld + colb;
#pragma unroll
                for (int bj = 0; bj < 2; ++bj) { u32x4 w; w.x = cvtpk(v[bj][0][0], v[bj][0][1]); w.y = cvtpk(v[bj][0][2], v[bj][0][3]); w.z = cvtpk(v[bj][1][0], v[bj][1][1]); w.w = cvtpk(v[bj][1][2], v[bj][1][3]);
                    *(u32x4*)(rowp + bj * 32) = w; }
            }
        if (kmean) {
            float* kp = (float*)(ws + WS_KMEAN) + ((size_t)u.pm * 8 + (u.pn - 2) * 4 + wc) * 64 + 8 * fq;
#pragma unroll
            for (int bj = 0; bj < 2; ++bj)
#pragma unroll
                for (int n = 0; n < 2; ++n)
#pragma unroll
                    for (int j = 0; j < 4; ++j) {
                        float s = ks[bj][n][j];
                        s += __shfl_xor(s, 1); s += __shfl_xor(s, 2); s += __shfl_xor(s, 4); s += __shfl_xor(s, 8);
                        if (fr == 0) atomicAdd(kp + bj * 32 + 4 * n + j, s * (1.0f / 256.0f));
                    }
        }
    }
};

struct EpiOut {
    const float* x; float* out; float* ssq;
    __device__ __forceinline__ void operator()(const f32x4 (&acc)[2][2][4][2], const Unit& u, int wr, int wc, int fr, int fq) const {
        const int row0 = u.pm * 256 + wr * 64 + fr, col0 = u.pn * 256 + wc * 32 + 8 * fq;
#pragma unroll
        for (int ai = 0; ai < 2; ++ai)
#pragma unroll
            for (int m = 0; m < 4; ++m) {
                const int row = row0 + ai * 128 + m * 16; const size_t off = (size_t)row * DM + col0; float ss = 0.f;
#pragma unroll
                for (int bj = 0; bj < 2; ++bj)
#pragma unroll
                    for (int n = 0; n < 2; ++n) { const f32x4 xv = *(const f32x4*)(x + off + bj * 128 + 4 * n); const f32x4 o = xv + acc[ai][bj][m][n];
                        ss += (o[0] * o[0] + o[1] * o[1]) + (o[2] * o[2] + o[3] * o[3]); *(f32x4*)(out + off + bj * 128 + 4 * n) = o; }
                ss += __shfl_xor(ss, 16); ss += __shfl_xor(ss, 32);
                if (fq == 0) ssq[(size_t)row * 16 + u.pn * 4 + wc] = ss;
            }
    }
};

struct EpiSwiglu {
    const float* b1; bf16* H;
    __device__ __forceinline__ void operator()(const f32x4 (&acc)[2][2][4][2], const Unit& u, int wr, int wc, int fr, int fq) const {
        const int row0 = u.pm * 256 + wr * 64 + fr, zc0 = u.pn * 256 + wc * 32 + 8 * fq;
        const float* bp = b1 + (size_t)u.aux * 2048 + zc0;
        f32x4 bv[2][2];
#pragma unroll
        for (int bj = 0; bj < 2; ++bj)
#pragma unroll
            for (int n = 0; n < 2; ++n) bv[bj][n] = *(const f32x4*)(bp + bj * 128 + 4 * n);
#pragma unroll
        for (int ai = 0; ai < 2; ++ai)
#pragma unroll
            for (int m = 0; m < 4; ++m) {
                const int row = row0 + ai * 128 + m * 16;
#pragma unroll
                for (int bj = 0; bj < 2; ++bj) {
                    const f32x4 z0 = acc[ai][bj][m][0] + bv[bj][0], z1 = acc[ai][bj][m][1] + bv[bj][1];
                    float h[4];
                    const float gl[4] = {z0[0], z0[2], z1[0], z1[2]}, li[4] = {z0[1], z0[3], z1[1], z1[3]};
#pragma unroll
                    for (int p = 0; p < 4; ++p) { const float g = fminf(gl[p], 7.0f); const float l = fminf(fmaxf(li[p], -7.0f), 7.0f);
                        h[p] = g * __builtin_amdgcn_rcpf(1.0f + __builtin_amdgcn_exp2f(-1.702f * 1.4426950408889634f * g)) * (l + 1.0f); }
                    u32x2 w; w.x = cvtpk(h[0], h[1]); w.y = cvtpk(h[2], h[3]);
                    *(u32x2*)(H + (size_t)row * 1024 + (zc0 + bj * 128) / 2) = w;
                }
            }
    }
};

struct EpiDown {
    const float* b2; const float* roww; bf16* YE;
    __device__ __forceinline__ void operator()(const f32x4 (&acc)[2][2][4][2], const Unit& u, int wr, int wc, int fr, int fq) const {
        const int row0 = u.pm * 256 + wr * 64 + fr, c0 = u.pn * 256 + wc * 32 + 8 * fq;
        const float* bp = b2 + (size_t)u.aux * 1024 + c0;
        f32x4 bv[2][2];
#pragma unroll
        for (int bj = 0; bj < 2; ++bj)
#pragma unroll
            for (int n = 0; n < 2; ++n) bv[bj][n] = *(const f32x4*)(bp + bj * 128 + 4 * n);
#pragma unroll
        for (int ai = 0; ai < 2; ++ai)
#pragma unroll
            for (int m = 0; m < 4; ++m) {
                const int row = row0 + ai * 128 + m * 16; const float w8 = roww[row];
#pragma unroll
                for (int bj = 0; bj < 2; ++bj) {
                    const f32x4 y0 = (acc[ai][bj][m][0] + bv[bj][0]) * w8, y1 = (acc[ai][bj][m][1] + bv[bj][1]) * w8;
                    u32x4 w; w.x = cvtpk(y0[0], y0[1]); w.y = cvtpk(y0[2], y0[3]); w.z = cvtpk(y1[0], y1[1]); w.w = cvtpk(y1[2], y1[3]);
                    *(u32x4*)(YE + (size_t)row * 1024 + c0 + bj * 128) = w;
                }
            }
    }
};

__device__ __forceinline__ void transpose_item(const float* W, int N, bf16* WT, int drow0, LAS float* scr, int k0, int n0, int lane) {
#pragma unroll 8
    for (int i = 0; i < 32; ++i) { const int kk = 2 * i + (lane >> 5); scr[kk * 33 + (lane & 31)] = W[(size_t)(k0 + kk) * N + n0 + (lane & 31)]; }
    LDS_WAIT(); asm volatile("" ::: "memory");
    const int c = lane & 7;
#pragma unroll
    for (int j = 0; j < 4; ++j) { const int n = (lane >> 3) + 8 * j; const LAS float* s = scr + (8 * c) * 33 + n;
        u32x4 o; o.x = cvtpk(s[0 * 33], s[1 * 33]); o.y = cvtpk(s[2 * 33], s[3 * 33]); o.z = cvtpk(s[4 * 33], s[5 * 33]); o.w = cvtpk(s[6 * 33], s[7 * 33]);
        *(u32x4*)(WT + (size_t)(drow0 + n) * 1024 + k0 + 8 * c) = o; }
    LDS_WAIT(); asm volatile("" ::: "memory");
}
__device__ __forceinline__ int headperm_row(int n0) { const int pn = n0 >> 8, c = n0 & 255, hh = c >> 6, dh = (c & 63) >> 5; return pn * 256 + dh * 128 + hh * 32; }
__device__ __forceinline__ void rms_row_to_bf16(const float* xrow, const float* gain, bf16* orow, int lane) {
    const f32x4* xr = (const f32x4*)xrow + lane; const f32x4* gr = (const f32x4*)gain + lane;
    f32x4 v[4]; float s = 0.f;
#pragma unroll
    for (int j = 0; j < 4; ++j) { v[j] = xr[64 * j]; s += (v[j].x * v[j].x + v[j].y * v[j].y) + (v[j].z * v[j].z + v[j].w * v[j].w); }
    const float rstd = 1.0f / sqrtf(wave_sum(s) * (1.f / DM) + EPS);
    u32x2* o8 = (u32x2*)orow + lane;
#pragma unroll
    for (int j = 0; j < 4; ++j) { const f32x4 gg = gr[64 * j]; u32x2 w; w.x = cvtpk(v[j].x * rstd * gg.x, v[j].y * rstd * gg.y); w.y = cvtpk(v[j].z * rstd * gg.z, v[j].w * rstd * gg.w); o8[64 * j] = w; }
}

__device__ __forceinline__ void load64(const bf16* p, float (&d)[64]) {
    const u32x4* q = (const u32x4*)p;
#pragma unroll
    for (int i = 0; i < 8; ++i) { const u32x4 w = q[i]; d[8 * i + 0] = bflo(w.x); d[8 * i + 1] = bfhi(w.x); d[8 * i + 2] = bflo(w.y); d[8 * i + 3] = bfhi(w.y); d[8 * i + 4] = bflo(w.z); d[8 * i + 5] = bfhi(w.z); d[8 * i + 6] = bflo(w.w); d[8 * i + 7] = bfhi(w.w); }
}
__device__ __forceinline__ void store64(bf16* p, const float (&d)[64]) {
    u32x4* q = (u32x4*)p;
#pragma unroll
    for (int i = 0; i < 8; ++i) { u32x4 w; w.x = cvtpk(d[8 * i], d[8 * i + 1]); w.y = cvtpk(d[8 * i + 2], d[8 * i + 3]); w.z = cvtpk(d[8 * i + 4], d[8 * i + 5]); w.w = cvtpk(d[8 * i + 6], d[8 * i + 7]); q[i] = w; }
}
__device__ __forceinline__ float dothalf(const float (&a)[64], const bf16* p, int h) {
    const u32x4* q = (const u32x4*)(p + 32 * h); float s0 = 0.f, s1 = 0.f;
#pragma unroll
    for (int i = 0; i < 4; ++i) { const u32x4 w = q[i]; const int o = 32 * h + 8 * i;
        s0 += a[o] * bflo(w.x) + a[o + 2] * bflo(w.y) + a[o + 4] * bflo(w.z) + a[o + 6] * bflo(w.w);
        s1 += a[o + 1] * bfhi(w.x) + a[o + 3] * bfhi(w.y) + a[o + 5] * bfhi(w.z) + a[o + 7] * bfhi(w.w); }
    return s0 + s1;
}
__device__ __forceinline__ float dotbf(const float (&a)[64], const bf16* p) { return dothalf(a, p, 0) + dothalf(a, p, 1); }
__device__ __forceinline__ void axpy_bf(float (&acc)[64], float al, float pw, const bf16* vp) {
    const u32x4* q = (const u32x4*)vp;
#pragma unroll
    for (int i = 0; i < 8; ++i) { const u32x4 w = q[i]; const int o = 8 * i;
        acc[o] = acc[o] * al + pw * bflo(w.x); acc[o + 1] = acc[o + 1] * al + pw * bfhi(w.x); acc[o + 2] = acc[o + 2] * al + pw * bflo(w.y); acc[o + 3] = acc[o + 3] * al + pw * bfhi(w.y);
        acc[o + 4] = acc[o + 4] * al + pw * bflo(w.z); acc[o + 5] = acc[o + 5] * al + pw * bfhi(w.z); acc[o + 6] = acc[o + 6] * al + pw * bflo(w.w); acc[o + 7] = acc[o + 7] * al + pw * bfhi(w.w); }
}
__device__ __forceinline__ float dot64(const float (&a)[64], const float (&b)[64]) {
    float s0 = 0.f, s1 = 0.f, s2 = 0.f, s3 = 0.f;
#pragma unroll
    for (int i = 0; i < 64; i += 4) { s0 += a[i] * b[i]; s1 += a[i + 1] * b[i + 1]; s2 += a[i + 2] * b[i + 2]; s3 += a[i + 3] * b[i + 3]; }
    return (s0 + s1) + (s2 + s3);
}

__device__ __forceinline__ void naive_moba(const bf16* QA, const bf16* KA, const bf16* VA, const float* KMEAN, bf16* Y, int gw, int NGW, int lane_) {
    const int lane = opaque(lane_);
    for (int wi = gw; wi < (NB * 8 * SEQ) / 64; wi += NGW) {
        const int idx0 = wi * 64, bh = idx0 / SEQ, s0 = idx0 % SEQ, b = bh >> 3, h = bh & 7, s = s0 + lane, n = s0 >> 8;
        float q[64]; load64(QA + ((size_t)(b * SEQ + s)) * 512 + h * 64, q);
        float g0 = -3e38f, g1 = -3e38f, g2 = -3e38f; int i0 = -1, i1 = -1, i2 = -1;
        for (int j = 0; j < n; ++j) {
            const float* km = KMEAN + (((size_t)(b * 16 + j)) * 8 + h) * 64;
            float g = 0.f;
#pragma unroll
            for (int d = 0; d < 64; ++d) g += q[d] * km[d];
            if (g > g0) { g2 = g1; i2 = i1; g1 = g0; i1 = i0; g0 = g; i0 = j; }
            else if (g > g1) { g2 = g1; i2 = i1; g1 = g; i1 = j; }
            else if (g > g2) { g2 = g; i2 = j; }
        }
        unsigned mask = 0; if (i0 >= 0) mask |= 1u << i0; if (i1 >= 0) mask |= 1u << i1; if (i2 >= 0) mask |= 1u << i2;
        float m = -3e38f, l = 0.f, acc[64];
#pragma unroll
        for (int d = 0; d < 64; ++d) acc[d] = 0.f;
        for (int jb = 0; jb <= n; ++jb) {
            const bool act = (jb == n) || ((mask >> jb) & 1u);
            if (!__any(act)) continue;
            const int nk = (jb == n) ? (s0 + 64 - n * 256) : 256;
            for (int kk = 0; kk < nk; ++kk) {
                const int key = jb * 256 + kk;
                const float sc = dotbf(q, KA + ((size_t)(b * SEQ + key)) * 512 + h * 64);
                const bool valid = act && (key <= s);
                if (valid) {
                    const float mn = fmaxf(m, sc), al = __builtin_amdgcn_exp2f(m - mn), p = __builtin_amdgcn_exp2f(sc - mn);
                    l = l * al + p; m = mn;
                    axpy_bf(acc, al, p, VA + ((size_t)(b * SEQ + key)) * 512 + h * 64);
                }
            }
        }
        const float il = 1.0f / l;
#pragma unroll
        for (int d = 0; d < 64; ++d) acc[d] *= il;
        store64(Y + ((size_t)(b * SEQ + s)) * DM + h * 64, acc);
    }
}

__device__ __forceinline__ void naive_ret(const bf16* QR, const bf16* KR, const bf16* VR, const bf16* GR, const float* rgain, bf16* Y, int gw, int NGW, int lane_) {
    const int lane = opaque(lane_);
    for (int wi = gw; wi < (NB * 4 * SEQ) / 64; wi += NGW) {
        const int idx0 = wi * 64, bh = idx0 / SEQ, s0 = idx0 % SEQ, b = bh >> 2, h = bh & 3, s = s0 + lane;
        const float lg = log2f(1.0f - exp2f(-5.0f - (float)h));
        float q[64]; load64(QR + ((size_t)(b * SEQ + s)) * 256 + h * 64, q);
        float acc[64];
#pragma unroll
        for (int d = 0; d < 64; ++d) acc[d] = 0.f;
        int jlo = s0 - (int)(80.0f / (-lg)); if (jlo < 0) jlo = 0;
        for (int j = jlo; j < s0 + 64; ++j) {
            const float sc = dotbf(q, KR + ((size_t)(b * SEQ + j)) * 256 + h * 64);
            const float w = (j <= s) ? sc * __builtin_amdgcn_exp2f(lg * (float)(128 * ((s >> 7) - (j >> 7)))) : 0.f;
            axpy_bf(acc, 1.0f, w, VR + ((size_t)(b * SEQ + j)) * 256 + h * 64);
        }
        float ss = 0.f;
#pragma unroll
        for (int d = 0; d < 64; ++d) ss += acc[d] * acc[d];
        const float r = 1.0f / sqrtf(ss * (1.0f / 64.0f) + EPS);
        load64(GR + ((size_t)(b * SEQ + s)) * 256 + h * 64, q);
#pragma unroll
        for (int d = 0; d < 64; ++d) acc[d] = acc[d] * r * rgain[h * 64 + d] * q[d];
        store64(Y + ((size_t)(b * SEQ + s)) * DM + 512 + h * 64, acc);
    }
}

__device__ __forceinline__ void naive_mem(const bf16* QM, const bf16* MK, const bf16* MV, bf16* Y, int gw, int NGW, int lane_) {
    const int lane = opaque(lane_);
    for (int wi = gw; wi < (NB * 4 * SEQ) / 64; wi += NGW) {
        const int idx0 = wi * 64, bh = idx0 / SEQ, s0 = idx0 % SEQ, b = bh >> 2, h = bh & 3, s = s0 + lane;
        float q[64]; load64(QM + ((size_t)(b * SEQ + s)) * 256 + h * 64, q);
        float m = -3e38f, l = 0.f, acc[64];
#pragma unroll
        for (int d = 0; d < 64; ++d) acc[d] = 0.f;
        for (int j = 0; j < MEMLEN; ++j) {
            const float sc = dotbf(q, MK + ((size_t)(b * MEMLEN + j)) * 256 + h * 64);
            const float mn = fmaxf(m, sc), al = __builtin_amdgcn_exp2f(m - mn), p = __builtin_amdgcn_exp2f(sc - mn);
            l = l * al + p; m = mn;
            axpy_bf(acc, al, p, MV + ((size_t)(b * MEMLEN + j)) * 256 + h * 64);
        }
        const float il = 1.0f / l;
#pragma unroll
        for (int d = 0; d < 64; ++d) acc[d] *= il;
        store64(Y + ((size_t)(b * SEQ + s)) * DM + 768 + h * 64, acc);
    }
}


#include <hip/hip_bf16.h>
namespace attn_body {
using s16x4=__attribute__((ext_vector_type(4)))short;
using f32x16=__attribute__((ext_vector_type(16)))float;
constexpr int D=64,NW=8,QBLK=32,QB=QBLK*NW,KVBLK=64;
__device__ __forceinline__ int crow(int r,int hi){return (r&3)+8*(r>>2)+4*hi;}
#define SBAR() __builtin_amdgcn_sched_barrier(0)
__device__ __forceinline__ void cmask(f32x16&p0,f32x16&p1,int jb,int qrel,int hi){
  const float NEG=-INFINITY; int kb=64*jb+4*hi;
  #pragma unroll
  for(int r=0;r<16;++r){int kv=kb+(r&3)+8*(r>>2); if(kv>qrel)p0[r]=NEG; if(kv+32>qrel)p1[r]=NEG;}
}
constexpr int NSLOT=3, SLOTB=8192;
constexpr int LDS_K=0, LDS_V=NSLOT*SLOTB, LDS_WS=2*NSLOT*SLOTB, LDS_OST=LDS_WS+NW*64*4, ATT_LDS_BYTES=LDS_OST+NW*4096;
__device__ __forceinline__ void glds16(const void*gsrc,unsigned lds_dst){unsigned keep;
  asm volatile("s_mov_b32 %0, m0\n\ts_mov_b32 m0, %2\n\ts_nop 0\n\tglobal_load_lds_dwordx4 %1, off\n\ts_mov_b32 m0, %0":"=&s"(keep):"v"(gsrc),"s"(lds_dst):"memory");}
__device__ __forceinline__ float max3f(float a,float b,float c){float r;asm("v_max3_f32 %0, %1, %2, %3":"=v"(r):"v"(a),"v"(b),"v"(c));return r;}
__device__ __forceinline__ float max2f(float a,float b){float r;asm("v_max_f32_e32 %0, %1, %2":"=v"(r):"v"(a),"v"(b));return r;}
__device__ __forceinline__ float fadd_s(float a,float b){float r;asm("v_add_f32_e32 %0, %1, %2":"=v"(r):"v"(a),"v"(b));return r;}
__device__ __forceinline__ float fsub_s(float a,float b){float r;asm("v_sub_f32_e32 %0, %1, %2":"=v"(r):"v"(a),"v"(b));return r;}
__device__ __forceinline__ unsigned cvtpk_s(float lo,float hi){return cvtpk(lo,hi);}
#define WAIT_BAR(N) asm volatile("s_waitcnt vmcnt(" #N ") lgkmcnt(0)\n\ts_barrier":::"memory")
__device__ __forceinline__ void qkt(f32x16&p0,f32x16&p1,const char*Kslot,const bf16x8*qr,const f32x16&negm,int r32,int hi){
  const char*kb=Kslot+hi*1024+r32*16;
  #pragma unroll
  for(int d0=0;d0<4;++d0){
    const bf16x8 b0=*reinterpret_cast<const bf16x8*>(kb+d0*2048);
    const bf16x8 b1=*reinterpret_cast<const bf16x8*>(kb+d0*2048+512);
    if(d0==0){p0=__builtin_amdgcn_mfma_f32_32x32x16_bf16(b0,qr[0],negm,0,0,0);p1=__builtin_amdgcn_mfma_f32_32x32x16_bf16(b1,qr[0],negm,0,0,0);}
    else{p0=__builtin_amdgcn_mfma_f32_32x32x16_bf16(b0,qr[d0],p0,0,0,0);p1=__builtin_amdgcn_mfma_f32_32x32x16_bf16(b1,qr[d0],p1,0,0,0);}}
}
typedef __attribute__((address_space(3))) const char* lds_cptr;
typedef short v4i16_t __attribute__((ext_vector_type(4)));
__device__ __forceinline__ void kload8(bf16x8*kf,lds_cptr kp){
  kf[0]=*(const __attribute__((address_space(3))) bf16x8*)(kp);      kf[1]=*(const __attribute__((address_space(3))) bf16x8*)(kp+512);
  kf[2]=*(const __attribute__((address_space(3))) bf16x8*)(kp+2048); kf[3]=*(const __attribute__((address_space(3))) bf16x8*)(kp+2560);
  kf[4]=*(const __attribute__((address_space(3))) bf16x8*)(kp+4096); kf[5]=*(const __attribute__((address_space(3))) bf16x8*)(kp+4608);
  kf[6]=*(const __attribute__((address_space(3))) bf16x8*)(kp+6144); kf[7]=*(const __attribute__((address_space(3))) bf16x8*)(kp+6656);
}
__device__ __forceinline__ void kload2(bf16x8*kf,lds_cptr kp,int j){ kf[2*j]=*(const __attribute__((address_space(3))) bf16x8*)(kp+j*2048); kf[2*j+1]=*(const __attribute__((address_space(3))) bf16x8*)(kp+j*2048+512); }
__device__ __forceinline__ s16x4 vtr(lds_cptr p){ return __builtin_bit_cast(s16x4,__builtin_amdgcn_ds_read_tr16_b64_v4i16((__attribute__((address_space(3))) v4i16_t*)p)); }
__device__ __forceinline__ float rowmax(const f32x16&p0,const f32x16&p1){
  float a=max3f(p0[0],p0[1],p1[0]),b=max3f(p0[2],p0[3],p1[1]);a=max3f(a,p1[2],p1[3]);
  #pragma unroll
  for(int r=4;r<16;r+=4){a=max3f(a,p0[r],p0[r+1]);b=max3f(b,p0[r+2],p0[r+3]);a=max3f(a,p1[r],p1[r+1]);b=max3f(b,p1[r+2],p1[r+3]);}
  const float m=max2f(a,b);
  auto rr=__builtin_amdgcn_permlane32_swap(__float_as_uint(m),__float_as_uint(m),false,false);
  return max2f(__uint_as_float(rr[0]),__uint_as_float(rr[1]));
}
__device__ __forceinline__ void pv(f32x16*o,int vb,bf16x8 pa0,bf16x8 pa1,bf16x8 pa2,bf16x8 pa3){
  #pragma unroll
  for(int d0=0;d0<2;++d0){s16x4 lo[4],hi[4];
    #pragma unroll
    for(int ks=0;ks<4;++ks){
      asm volatile("ds_read_b64_tr_b16 %0,%1 offset:%c2":"=&v"(lo[ks]):"v"(vb),"i"(d0*4096+ks*1024):"memory");
      asm volatile("ds_read_b64_tr_b16 %0,%1 offset:%c2":"=&v"(hi[ks]):"v"(vb),"i"(d0*4096+ks*1024+512):"memory");}
    asm volatile("s_waitcnt lgkmcnt(0)":::"memory");SBAR();
    #define PK(k) (bf16x8){lo[k][0],lo[k][1],lo[k][2],lo[k][3],hi[k][0],hi[k][1],hi[k][2],hi[k][3]}
    o[d0]=__builtin_amdgcn_mfma_f32_32x32x16_bf16(pa0,PK(0),o[d0],0,0,0);
    o[d0]=__builtin_amdgcn_mfma_f32_32x32x16_bf16(pa1,PK(1),o[d0],0,0,0);
    o[d0]=__builtin_amdgcn_mfma_f32_32x32x16_bf16(pa2,PK(2),o[d0],0,0,0);
    o[d0]=__builtin_amdgcn_mfma_f32_32x32x16_bf16(pa3,PK(3),o[d0],0,0,0);
    #undef PK
  }
}
template<int THRL,int KP,int OP,bool MOBA> __device__ __forceinline__ void attn_unit(const bf16*Qu,const bf16*__restrict__ Kh,const bf16*__restrict__ Vh,bf16*Ou,const int NT,const int nblk,const float*kmean,char*shm){
  const int tid=opaque((int)threadIdx.x),lane=tid&63,r32=lane&31,hi=lane>>5; const int wid=__builtin_amdgcn_readfirstlane(tid>>6);
  const bf16*Qw=Qu+(long)(wid*QBLK)*KP;
  const unsigned lds0=(unsigned)(uintptr_t)shm;
  float*wsf=(float*)(shm+LDS_WS)+wid*64;
  const bf16*ksrc=Kh+(long)lane*KP+wid*8;
  const bf16*vsrc=Vh+(long)(16*(wid&3)+(lane>>2))*KP+(wid>>2)*32+(lane&3)*8;
  const unsigned kdst=lds0+LDS_K+wid*1024, vdst=lds0+LDS_V+wid*1024;
  #define DMA_K(t,slot) glds16(ksrc+(long)(t)*KVBLK*KP,(unsigned)__builtin_amdgcn_readfirstlane(kdst+(slot)))
  #define DMA_V(t,slot) glds16(vsrc+(long)(t)*KVBLK*KP,(unsigned)__builtin_amdgcn_readfirstlane(vdst+(slot)))
  const int vb0=(int)(lds0+LDS_V)+((lane>>4)&1)*32+(lane&3)*8+(4*hi+((lane&15)>>2))*64;
  const char*Kbase=shm+LDS_K; bf16x8 kf[8];
  const lds_cptr shm3=(lds_cptr)shm; const lds_cptr kp0=shm3+LDS_K+hi*1024+r32*16; const lds_cptr vp0=shm3+LDS_V+((lane>>4)&1)*32+(lane&3)*8+(4*hi+((lane&15)>>2))*64;
  DMA_K(0,0);DMA_V(0,0);DMA_K(1,SLOTB);
  bf16x8 qr[4];
  #pragma unroll
  for(int d0=0;d0<4;++d0)qr[d0]=*reinterpret_cast<const bf16x8*>(&Qw[(long)r32*KP+d0*16+hi*8]);
  unsigned bmask=0xffffffffu;
  if(MOBA){
    bmask=1u<<nblk;
    float g0=-3e38f,g1=-3e38f,g2=-3e38f; int i0=-1,i1=-1,i2=-1;
    for(int j=0;j<nblk;++j){
      const float*km=kmean+(long)j*512+8*hi; float g=0.f;
      #pragma unroll
      for(int d0=0;d0<4;++d0){ const f32x4 a=*(const f32x4*)(km+16*d0),b=*(const f32x4*)(km+16*d0+4);
        g+=bf2f((unsigned short)qr[d0][0])*a[0]+bf2f((unsigned short)qr[d0][1])*a[1]+bf2f((unsigned short)qr[d0][2])*a[2]+bf2f((unsigned short)qr[d0][3])*a[3];
        g+=bf2f((unsigned short)qr[d0][4])*b[0]+bf2f((unsigned short)qr[d0][5])*b[1]+bf2f((unsigned short)qr[d0][6])*b[2]+bf2f((unsigned short)qr[d0][7])*b[3]; }
      g+=__shfl_xor(g,32);
      if(g>g0){g2=g1;i2=i1;g1=g0;i1=i0;g0=g;i0=j;} else if(g>g1){g2=g1;i2=i1;g1=g;i1=j;} else if(g>g2){g2=g;i2=j;}
    }
    if(i0>=0)bmask|=1u<<i0; if(i1>=0)bmask|=1u<<i1; if(i2>=0)bmask|=1u<<i2;
  }
  #define NEGM_FOR(t) (MOBA ? (((bmask>>((t)>>2))&1u) ? -mhat : -INFINITY) : -mhat)
  float mhat=0.f,l_reg=0.f;f32x16 o[2];o[0]=f32x16{};o[1]=f32x16{};f32x16 negm;
  { const float nm=NEGM_FOR(0);
    #pragma unroll
    for(int r=0;r<16;++r)negm[r]=nm; }
  asm volatile("":"+v"(negm));
  const int qrel=wid*QBLK+r32;
  #define CMASK(P0,P1,t) do{ if(MOBA){int jb_=(t)-(NT-4); if(jb_>=0)cmask(P0,P1,jb_,qrel,hi);} }while(0)
  bool resc=false;
  #define START(P0,P1) do{ const float rm=rowmax(P0,P1); resc=false; \
    { const float dl=(MOBA&&rm==-INFINITY)?0.f:rm; mhat=fadd_s(mhat,dl); \
      _Pragma("unroll") for(int r=0;r<16;++r){P0[r]=fsub_s(P0[r],dl);P1[r]=fsub_s(P1[r],dl);} \
      { const float nm=NEGM_FOR(1); _Pragma("unroll") for(int r=0;r<16;++r)negm[r]=nm; } asm volatile("":"+v"(negm)); } \
    _Pragma("unroll") for(int r=0;r<16;++r)P0[r]=__builtin_amdgcn_exp2f(P0[r]); }while(0)
  #define RESC() do{ if(resc){ asm volatile("s_waitcnt lgkmcnt(0)":::"memory"); \
      _Pragma("unroll") for(int d_=0;d_<2;++d_) _Pragma("unroll") for(int r=0;r<16;++r)o[d_][r]*=wsf[crow(r,hi)]; } }while(0)
  f32x16 pA0,pA1,pB0,pB1;
  int sl_prev=0,sl_cur=0,sl_next=SLOTB;
  #define ROT() do{sl_prev=sl_cur;sl_cur=sl_next;sl_next=(sl_next==(NSLOT-1)*SLOTB)?0:sl_next+SLOTB;}while(0)
  DMA_K(2,2*SLOTB);
  WAIT_BAR(3);
  qkt(pA0,pA1,Kbase,qr,negm,r32,hi);asm volatile("s_nop 15\n\ts_nop 7":"+v"(pA0),"+v"(pA1));CMASK(pA0,pA1,0);
  START(pA0,pA1);
  _Pragma("unroll") for(int r=0;r<16;++r)pA1[r]=__builtin_amdgcn_exp2f(pA1[r]);
  WAIT_BAR(0);
  DMA_K(3,0);DMA_V(1,SLOTB);
  ROT();
  kload8(kf,kp0+sl_cur);
  WAIT_BAR(2);
  s16x4 vlo[8],vhi[8]; u32x4 pw0,pw1,pw2,pw3;
  #define PKW(P,B) cvtpk_s(P[B],P[B+1])
  #define PAF(k) __builtin_bit_cast(bf16x8,pw##k)
  #define VFR(i) (bf16x8){vlo[i][0],vlo[i][1],vlo[i][2],vlo[i][3],vhi[i][0],vhi[i][1],vhi[i][2],vhi[i][3]}
  #define PIN(x) asm volatile("":"+v"(x))
  #define MX3(a,b,c) __builtin_fmaxf(__builtin_fmaxf((a),(b)),(c))
  #define GAPA(MF,A0,A1,A2,A3,W0,W1,PW) do{ MF; sacc+=A0; sacc+=A1; sacc+=A2; sacc+=A3; PIN(sacc); W0; W1; PIN(PW); SBAR(); }while(0)
  #define EX(v) __builtin_amdgcn_exp2f(v)
  #define GAPB(MF,X,B) do{ MF; X[B]=EX(X[B]); X[B+1]=EX(X[B+1]); X[B+2]=EX(X[B+2]); X[B+3]=EX(X[B+3]); PIN(X); SBAR(); }while(0)
  #define VRD(i) do{ vlo[i]=vtr(vp_+(((i)>>2)*4096+((i)&3)*1024)); vhi[i]=vtr(vp_+(((i)>>2)*4096+((i)&3)*1024+512)); }while(0)
  #define KRD(G,j) do{ if(G){ kload2(kf,kp0+sl_next,j); SBAR(); } }while(0)
  #define STEP(C0,C1,P0,P1,t,GK,GV,GL) do{ SBAR(); \
    const lds_cptr vp_=vp0+sl_prev; \
    VRD(0); SBAR(); float sacc=(P0[0]+P0[1]); \
    GAPA(C0=__builtin_amdgcn_mfma_f32_32x32x16_bf16(kf[0],qr[0],negm,0,0,0), P0[2],P0[3],P0[4],P0[5],     pw0[0]=PKW(P0,0), pw0[1]=PKW(P0,2), pw0); \
    VRD(4); SBAR(); GAPA(C1=__builtin_amdgcn_mfma_f32_32x32x16_bf16(kf[1],qr[0],negm,0,0,0), P0[6],P0[7],P0[8],P0[9],     pw0[2]=PKW(P0,4), pw0[3]=PKW(P0,6), pw0); \
    VRD(1); SBAR(); GAPA(C0=__builtin_amdgcn_mfma_f32_32x32x16_bf16(kf[2],qr[1],C0,0,0,0),   P0[10],P0[11],P0[12],P0[13], pw1[0]=PKW(P0,8), pw1[1]=PKW(P0,10), pw1); \
    VRD(5); SBAR(); GAPA(C1=__builtin_amdgcn_mfma_f32_32x32x16_bf16(kf[3],qr[1],C1,0,0,0),   P0[14],P0[15],P1[0],P1[1],   pw1[2]=PKW(P0,12),pw1[3]=PKW(P0,14), pw1); \
    VRD(2); SBAR(); GAPA(C0=__builtin_amdgcn_mfma_f32_32x32x16_bf16(kf[4],qr[2],C0,0,0,0),   P1[2],P1[3],P1[4],P1[5],     pw2[0]=PKW(P1,0), pw2[1]=PKW(P1,2), pw2); \
    VRD(6); SBAR(); GAPA(C1=__builtin_amdgcn_mfma_f32_32x32x16_bf16(kf[5],qr[2],C1,0,0,0),   P1[6],P1[7],P1[8],P1[9],     pw2[2]=PKW(P1,4), pw2[3]=PKW(P1,6), pw2); \
    VRD(3); SBAR(); GAPA(C0=__builtin_amdgcn_mfma_f32_32x32x16_bf16(kf[6],qr[3],C0,0,0,0),   P1[10],P1[11],P1[12],P1[13], pw3[0]=PKW(P1,8), pw3[1]=PKW(P1,10), pw3); \
    VRD(7); SBAR(); GAPA(C1=__builtin_amdgcn_mfma_f32_32x32x16_bf16(kf[7],qr[3],C1,0,0,0),   P1[14],P1[15],0.f,0.f,       pw3[2]=PKW(P1,12),pw3[3]=PKW(P1,14), pw3); \
    l_reg+=sacc; \
    if(GK){DMA_K((t)+3,sl_cur);} if(GV){DMA_V((t)+1,sl_next);} \
    CMASK(C0,C1,t); \
    { float a=MX3(C0[0],C0[1],C1[0]),b=MX3(C0[2],C0[3],C1[1]); a=MX3(a,C1[2],C1[3]); \
      _Pragma("unroll") for(int r=4;r<16;r+=4){a=MX3(a,C0[r],C0[r+1]);b=MX3(b,C0[r+2],C0[r+3]);a=MX3(a,C1[r],C1[r+1]);b=MX3(b,C1[r+2],C1[r+3]);} \
      float rm=__builtin_fmaxf(a,b); { auto rr=__builtin_amdgcn_permlane32_swap(__float_as_uint(rm),__float_as_uint(rm),false,false); rm=__builtin_fmaxf(__uint_as_float(rr[0]),__uint_as_float(rr[1])); } \
      resc=false; \
      if(__builtin_expect(__any(rm>(float)THRL),0)){ const float dl=__builtin_fmaxf(rm,0.f); mhat+=dl; \
        _Pragma("unroll") for(int r=0;r<16;++r){C0[r]-=dl;C1[r]-=dl;} \
        if(!MOBA){ _Pragma("unroll") for(int r=0;r<16;++r)negm[r]=-mhat; asm volatile("":"+v"(negm)); } \
        const float f=__builtin_amdgcn_exp2f(-dl); l_reg*=f; if(hi==0)wsf[r32]=f; resc=true; } \
      if(MOBA){ const float nm=NEGM_FOR((t)+1); _Pragma("unroll") for(int r=0;r<16;++r)negm[r]=nm; asm volatile("":"+v"(negm)); } } \
    SBAR(); \
    GAPB(o[0]=__builtin_amdgcn_mfma_f32_32x32x16_bf16(PAF(0),VFR(0),o[0],0,0,0), C0,0); \
    GAPB(o[1]=__builtin_amdgcn_mfma_f32_32x32x16_bf16(PAF(0),VFR(4),o[1],0,0,0), C0,4); \
    KRD(GL,0); GAPB(o[0]=__builtin_amdgcn_mfma_f32_32x32x16_bf16(PAF(1),VFR(1),o[0],0,0,0), C0,8); \
    KRD(GL,1); GAPB(o[1]=__builtin_amdgcn_mfma_f32_32x32x16_bf16(PAF(1),VFR(5),o[1],0,0,0), C0,12); \
    KRD(GL,2); GAPB(o[0]=__builtin_amdgcn_mfma_f32_32x32x16_bf16(PAF(2),VFR(2),o[0],0,0,0), C1,0); \
    KRD(GL,3); GAPB(o[1]=__builtin_amdgcn_mfma_f32_32x32x16_bf16(PAF(2),VFR(6),o[1],0,0,0), C1,4); \
    GAPB(o[0]=__builtin_amdgcn_mfma_f32_32x32x16_bf16(PAF(3),VFR(3),o[0],0,0,0), C1,8); \
    GAPB(o[1]=__builtin_amdgcn_mfma_f32_32x32x16_bf16(PAF(3),VFR(7),o[1],0,0,0), C1,12); \
    }while(0)
  int t=1;
  #undef CMASK
  #define CMASK(P0,P1,t) do{}while(0)
  for(;t+5<NT;t+=2){
    STEP(pB0,pB1,pA0,pA1,t,true,true,true);     WAIT_BAR(2); RESC(); ROT();
    STEP(pA0,pA1,pB0,pB1,t+1,true,true,true);   WAIT_BAR(2); RESC(); ROT();
  }
  #undef CMASK
  #define CMASK(P0,P1,t) do{ if(MOBA){int jb_=(t)-(NT-4); if(jb_>=0)cmask(P0,P1,jb_,qrel,hi);} }while(0)
  #define ENDW(tt) do{ if((tt)+3<NT){WAIT_BAR(2);} else if((tt)+2<NT){WAIT_BAR(1);} else {WAIT_BAR(0);} }while(0)
  for(;t+1<NT;t+=2){
    STEP(pB0,pB1,pA0,pA1,t,(t+3<NT),(t+1<NT),(t+1<NT));       ENDW(t);   RESC(); ROT();
    STEP(pA0,pA1,pB0,pB1,t+1,(t+4<NT),(t+2<NT),(t+2<NT));     ENDW(t+1); RESC(); ROT();
  }
  STEP(pB0,pB1,pA0,pA1,NT-1,false,false,false); RESC();
  { float sacc=pB0[0]+pB0[1]; _Pragma("unroll") for(int r=2;r<16;++r)sacc+=pB0[r]; _Pragma("unroll") for(int r=0;r<16;++r)sacc+=pB1[r]; l_reg+=sacc;
    pw0=(u32x4){PKW(pB0,0),PKW(pB0,2),PKW(pB0,4),PKW(pB0,6)};pw1=(u32x4){PKW(pB0,8),PKW(pB0,10),PKW(pB0,12),PKW(pB0,14)};pw2=(u32x4){PKW(pB1,0),PKW(pB1,2),PKW(pB1,4),PKW(pB1,6)};pw3=(u32x4){PKW(pB1,8),PKW(pB1,10),PKW(pB1,12),PKW(pB1,14)};
    SBAR(); pv(o,vb0+sl_cur,PAF(0),PAF(1),PAF(2),PAF(3)); }
  #undef PKW
  #undef PAF
  #undef VFR
  #undef PIN
  #undef MX3
  #undef GAPA
  #undef GAPB
  #undef EX
  #undef VRD
  #undef KRD
  #undef STEP
  #undef ENDW
  {auto rr=__builtin_amdgcn_permlane32_swap(__float_as_uint(l_reg),__float_as_uint(l_reg),false,false);l_reg=__uint_as_float(rr[0])+__uint_as_float(rr[1]);}
  if(hi==0)wsf[32+r32]=l_reg;asm volatile("s_waitcnt lgkmcnt(0)":::"memory");
  float rli[16];
  #pragma unroll
  for(int r=0;r<16;++r)rli[r]=__builtin_amdgcn_rcpf(wsf[32+crow(r,hi)]);
  bf16*Ow=Ou+(long)(wid*QBLK)*OP;
  { bf16*stg=(bf16*)(shm+LDS_OST)+wid*2048;
    #pragma unroll
    for(int r=0;r<16;++r){const int orow=crow(r,hi);
      #pragma unroll
      for(int d0=0;d0<2;++d0)stg[orow*64+d0*32+r32]=(bf16)(cvtpk(o[d0][r]*rli[r],0.f)&0xffffu);}
    asm volatile("s_waitcnt lgkmcnt(0)":::"memory");
    #pragma unroll
    for(int i=0;i<4;++i){const int row=i*8+(lane>>3),ch=lane&7; const u32x4 v=*(const u32x4*)(stg+row*64+ch*8); *(u32x4*)(Ow+(long)row*OP+ch*8)=v;} }
  asm volatile("s_waitcnt lgkmcnt(0)\n\ts_barrier":::"memory");
  #undef DMA_K
  #undef DMA_V
  #undef CMASK
  #undef START
  #undef RESC
  #undef ROT
  #undef NEGM_FOR
}
#undef SBAR
#undef WAIT_BAR
}

namespace ret_body {
using attn_body::s16x4; using attn_body::f32x16; using attn_body::glds16; using attn_body::pv; using attn_body::crow;
constexpr int KVF_BYTES = 64 * 64 * 4;
__device__ __forceinline__ void kv_unit(const bf16* KR, const bf16* VR, float* KVF, int b, int h, int cp, char* shm) {
  const int tid = opaque((int)threadIdx.x), lane = tid & 63, r32 = lane & 31, hi = lane >> 5; const int wid = __builtin_amdgcn_readfirstlane(tid >> 6);
  const unsigned lds0 = (unsigned)(uintptr_t)shm;
  const size_t rowb = (size_t)b * SEQ + (size_t)cp * 256;
  const long voff = (long)(16 * (wid & 3) + (lane >> 2)) * 256 + h * 64 + (wid >> 2) * 32 + (lane & 3) * 8;
#pragma unroll
  for (int c = 0; c < 2; ++c)
#pragma unroll
    for (int tl = 0; tl < 2; ++tl) {
      const size_t r0 = rowb + c * 128 + tl * 64;
      glds16(KR + r0 * 256 + voff, (unsigned)__builtin_amdgcn_readfirstlane(lds0 + ((c * 2 + 0) * 2 + tl) * 8192 + wid * 1024));
      glds16(VR + r0 * 256 + voff, (unsigned)__builtin_amdgcn_readfirstlane(lds0 + ((c * 2 + 1) * 2 + tl) * 8192 + wid * 1024));
    }
  asm volatile("s_waitcnt vmcnt(0) lgkmcnt(0)\n\ts_barrier" ::: "memory");
  const int c = wid >> 2, dkb = (wid >> 1) & 1, dvb = wid & 1;
  const int vb = (int)lds0 + ((lane >> 4) & 1) * 32 + (lane & 3) * 8 + (4 * hi + ((lane & 15) >> 2)) * 64;
  f32x16 acc = f32x16{};
#pragma unroll
  for (int tl = 0; tl < 2; ++tl) {
    s16x4 alo[4], ahi[4], blo[4], bhi[4];
    const int ka = vb + ((c * 2 + 0) * 2 + tl) * 8192 + dkb * 4096, va = vb + ((c * 2 + 1) * 2 + tl) * 8192 + dvb * 4096;
#pragma unroll
    for (int ks = 0; ks < 4; ++ks) {
      asm volatile("ds_read_b64_tr_b16 %0,%1 offset:%c2" : "=&v"(alo[ks]) : "v"(ka), "i"(ks * 1024) : "memory");
      asm volatile("ds_read_b64_tr_b16 %0,%1 offset:%c2" : "=&v"(ahi[ks]) : "v"(ka), "i"(ks * 1024 + 512) : "memory");
      asm volatile("ds_read_b64_tr_b16 %0,%1 offset:%c2" : "=&v"(blo[ks]) : "v"(va), "i"(ks * 1024) : "memory");
      asm volatile("ds_read_b64_tr_b16 %0,%1 offset:%c2" : "=&v"(bhi[ks]) : "v"(va), "i"(ks * 1024 + 512) : "memory");
    }
    asm volatile("s_waitcnt lgkmcnt(0)" ::: "memory"); __builtin_amdgcn_sched_barrier(0);
#pragma unroll
    for (int ks = 0; ks < 4; ++ks) {
      const bf16x8 af = (bf16x8){alo[ks][0], alo[ks][1], alo[ks][2], alo[ks][3], ahi[ks][0], ahi[ks][1], ahi[ks][2], ahi[ks][3]};
      const bf16x8 bfr = (bf16x8){blo[ks][0], blo[ks][1], blo[ks][2], blo[ks][3], bhi[ks][0], bhi[ks][1], bhi[ks][2], bhi[ks][3]};
      acc = __builtin_amdgcn_mfma_f32_32x32x16_bf16(af, bfr, acc, 0, 0, 0);
    }
  }
  const float lgam = __builtin_amdgcn_logf(1.0f - __builtin_amdgcn_exp2f(-5.0f - (float)h));
  const float g127 = __builtin_amdgcn_exp2f(lgam * 127.0f);
  float* outp = KVF + ((size_t)((b * 4 + h) * 32 + cp * 2 + c)) * 4096 + dvb * 32 + r32;
#pragma unroll
  for (int r = 0; r < 16; ++r) outp[(size_t)(dkb * 32 + crow(r, hi)) * 64] = acc[r] * g127;
  asm volatile("s_waitcnt lgkmcnt(0)\n\ts_barrier" ::: "memory");
}

__device__ __forceinline__ void out_unit(const bf16* QR, const bf16* KR, const bf16* VR, const bf16* GR, const float* KVF, const float* rgain, bf16* Y, int b, int h, int cp, char* shm) {
  const int tid = opaque((int)threadIdx.x), lane = tid & 63, r32 = lane & 31, hi = lane >> 5; const int wid = __builtin_amdgcn_readfirstlane(tid >> 6);
  const unsigned lds0 = (unsigned)(uintptr_t)shm;
  constexpr int L_K = 0, L_V = 32768, L_S = 65536, L_O = 81920;
  const size_t rowb = (size_t)b * SEQ + (size_t)cp * 256;
  const long koff = (long)lane * 256 + h * 64 + wid * 8;
  const long voff = (long)(16 * (wid & 3) + (lane >> 2)) * 256 + h * 64 + (wid >> 2) * 32 + (lane & 3) * 8;
#pragma unroll
  for (int tl = 0; tl < 4; ++tl) {
    const size_t r0 = rowb + tl * 64;
    glds16(KR + r0 * 256 + koff, (unsigned)__builtin_amdgcn_readfirstlane(lds0 + L_K + tl * 8192 + wid * 1024));
    glds16(VR + r0 * 256 + voff, (unsigned)__builtin_amdgcn_readfirstlane(lds0 + L_V + tl * 8192 + wid * 1024));
  }
  {
    const float lgam = __builtin_amdgcn_logf(1.0f - __builtin_amdgcn_exp2f(-5.0f - (float)h));
    const float lgc = lgam * 128.0f;
    const int n0 = 2 * cp;
    int mlo = n0 - 1 - (int)(34.0f / (-lgc)); if (mlo < 0) mlo = 0;
    const float* kvp = KVF + ((size_t)((b * 4 + h) * 32)) * 4096 + tid * 8;
    f32x4 s0 = {0.f, 0.f, 0.f, 0.f}, s1 = {0.f, 0.f, 0.f, 0.f};
    for (int m = mlo; m < n0; ++m) {
      const float w = __builtin_amdgcn_exp2f(lgc * (float)(n0 - 1 - m));
      const f32x4 a = *(const f32x4*)(kvp + (size_t)m * 4096), c4 = *(const f32x4*)(kvp + (size_t)m * 4096 + 4);
      s0 += a * w; s1 += c4 * w;
    }
    const int dk = tid >> 3, dv = 8 * (tid & 7);
    char* sp = shm + L_S + (dv >> 5) * 4096 + dk * 64 + (dv & 31) * 2;
    u32x4 w0; w0.x = cvtpk(s0[0], s0[1]); w0.y = cvtpk(s0[2], s0[3]); w0.z = cvtpk(s1[0], s1[1]); w0.w = cvtpk(s1[2], s1[3]);
    *(u32x4*)sp = w0;
    const float dc = __builtin_amdgcn_exp2f(lgc);
    const f32x4 a = *(const f32x4*)(kvp + (size_t)n0 * 4096), c4 = *(const f32x4*)(kvp + (size_t)n0 * 4096 + 4);
    s0 = s0 * dc + a; s1 = s1 * dc + c4;
    u32x4 w1; w1.x = cvtpk(s0[0], s0[1]); w1.y = cvtpk(s0[2], s0[3]); w1.z = cvtpk(s1[0], s1[1]); w1.w = cvtpk(s1[2], s1[3]);
    *(u32x4*)(sp + 8192) = w1;
  }
  const int c = wid >> 2, wq = wid & 3;
  const bf16* Qw = QR + (rowb + c * 128 + wq * 32 + r32) * 256 + h * 64;
  bf16x8 qr[4]; u32x4 qa[4];
#pragma unroll
  for (int d0 = 0; d0 < 4; ++d0) qr[d0] = *reinterpret_cast<const bf16x8*>(Qw + d0 * 16 + hi * 8);
#pragma unroll
  for (int k = 0; k < 4; ++k) { const u32x2 lo = *(const u32x2*)(Qw + 16 * k + 4 * hi), hi2 = *(const u32x2*)(Qw + 16 * k + 8 + 4 * hi); qa[k] = (u32x4){lo.x, lo.y, hi2.x, hi2.y}; }
  asm volatile("s_waitcnt vmcnt(0) lgkmcnt(0)\n\ts_barrier" ::: "memory");
  const int vb = (int)lds0 + ((lane >> 4) & 1) * 32 + (lane & 3) * 8 + (4 * hi + ((lane & 15) >> 2)) * 64;
  f32x16 o[2]; o[0] = f32x16{}; o[1] = f32x16{};
  pv(o, vb + L_S + c * 8192, __builtin_bit_cast(bf16x8, qa[0]), __builtin_bit_cast(bf16x8, qa[1]), __builtin_bit_cast(bf16x8, qa[2]), __builtin_bit_cast(bf16x8, qa[3]));
  { const float gam = 1.0f - __builtin_amdgcn_exp2f(-5.0f - (float)h);
#pragma unroll
    for (int d0 = 0; d0 < 2; ++d0)
#pragma unroll
      for (int r = 0; r < 16; ++r) o[d0][r] *= gam; }
  const f32x16 zero = f32x16{};
  const int irow = wq * 32 + r32;
  for (int tl = 0; tl <= (wq >> 1); ++tl) {
    f32x16 p0, p1;
    attn_body::qkt(p0, p1, shm + L_K + (c * 2 + tl) * 8192, qr, zero, r32, hi);
    asm volatile("s_nop 15\n\ts_nop 7" : "+v"(p0), "+v"(p1));
#pragma unroll
    for (int r = 0; r < 16; ++r) { const int kj = 64 * tl + crow(r, hi); if (kj > irow) p0[r] = 0.f; if (kj + 32 > irow) p1[r] = 0.f; }
    u32x4 pw0, pw1, pw2, pw3;
    pw0 = (u32x4){cvtpk(p0[0], p0[1]), cvtpk(p0[2], p0[3]), cvtpk(p0[4], p0[5]), cvtpk(p0[6], p0[7])}; pw1 = (u32x4){cvtpk(p0[8], p0[9]), cvtpk(p0[10], p0[11]), cvtpk(p0[12], p0[13]), cvtpk(p0[14], p0[15])};
    pw2 = (u32x4){cvtpk(p1[0], p1[1]), cvtpk(p1[2], p1[3]), cvtpk(p1[4], p1[5]), cvtpk(p1[6], p1[7])}; pw3 = (u32x4){cvtpk(p1[8], p1[9]), cvtpk(p1[10], p1[11]), cvtpk(p1[12], p1[13]), cvtpk(p1[14], p1[15])};
    __builtin_amdgcn_sched_barrier(0);
    pv(o, vb + L_V + (c * 2 + tl) * 8192, __builtin_bit_cast(bf16x8, pw0), __builtin_bit_cast(bf16x8, pw1), __builtin_bit_cast(bf16x8, pw2), __builtin_bit_cast(bf16x8, pw3));
  }
  asm volatile("s_waitcnt lgkmcnt(0)\n\ts_barrier" ::: "memory");
  { float* stg = (float*)(shm + L_O) + wid * 2048;
#pragma unroll
    for (int r = 0; r < 16; ++r) { const int orow = crow(r, hi);
#pragma unroll
      for (int d0 = 0; d0 < 2; ++d0) stg[orow * 64 + d0 * 32 + r32] = o[d0][r]; }
    asm volatile("s_waitcnt lgkmcnt(0)" ::: "memory");
    const int row = lane >> 1, half = lane & 1;
    const f32x4* sr = (const f32x4*)(stg + row * 64 + half * 32);
    f32x4 v[8]; float ss = 0.f;
#pragma unroll
    for (int i = 0; i < 8; ++i) { v[i] = sr[i]; ss += (v[i][0] * v[i][0] + v[i][1] * v[i][1]) + (v[i][2] * v[i][2] + v[i][3] * v[i][3]); }
    ss += __shfl_xor(ss, 1);
    const float rstd = 1.0f / sqrtf(ss * (1.0f / 64.0f) + EPS);
    const size_t grow = rowb + c * 128 + wq * 32 + row;
    const u32x4* gp = (const u32x4*)(GR + grow * 256 + h * 64 + half * 32);
    const f32x4* rg = (const f32x4*)(rgain + h * 64 + half * 32);
    u32x4* yp = (u32x4*)(Y + grow * DM + 512 + h * 64 + half * 32);
#pragma unroll
    for (int i = 0; i < 4; ++i) {
      const u32x4 gw = gp[i]; const f32x4 g0 = rg[2 * i], g1 = rg[2 * i + 1]; const f32x4 a = v[2 * i] * rstd * g0, c4 = v[2 * i + 1] * rstd * g1;
      u32x4 w; w.x = cvtpk(a[0] * bflo(gw.x), a[1] * bfhi(gw.x)); w.y = cvtpk(a[2] * bflo(gw.y), a[3] * bfhi(gw.y)); w.z = cvtpk(c4[0] * bflo(gw.z), c4[1] * bfhi(gw.z)); w.w = cvtpk(c4[2] * bflo(gw.w), c4[3] * bfhi(gw.w));
      yp[i] = w;
    }
  }
  asm volatile("s_waitcnt lgkmcnt(0)\n\ts_barrier" ::: "memory");
}
}

__global__ void __launch_bounds__(NTHREADS, 2) fwd_kernel(Args args) {
    extern __shared__ __attribute__((aligned(16))) unsigned char lds_raw[];
    LAS unsigned char* lds = (LAS unsigned char*)lds_raw;
    cg::grid_group grid = cg::this_grid();
    const int tid0 = threadIdx.x, wave = __builtin_amdgcn_readfirstlane(tid0 >> 6);
#define PHASE_LANES const int tid = opaque(tid0), lane = tid & 63; (void)lane; (void)tid
    const int G = gridDim.x, bx = blockIdx.x;
    const int vcu = (G % 8 == 0) ? (bx % 8) * (G / 8) + bx / 8 : bx;
    const int gw = vcu * NWAVES + wave, NGW = G * NWAVES;
    unsigned char* const ws = args.ws;
#define WSP(type, off) ((type*)(ws + (off)))
    {
        PHASE_LANES;
        LAS float* scr = (LAS float*)(lds + wave * 16384);
        const float* x = args.in[0]; const float* mem = args.in[1]; const float* g_attn = args.in[2]; const float* w_in = args.in[3]; const float* g_mem = args.in[7];
        const float* w_mem_kv = args.in[8]; const float* w_out = args.in[11]; const float* g_ffn = args.in[12]; const float* w_router = args.in[13]; const float* w1 = args.in[15]; const float* w2 = args.in[17];
        bf16* WIN_T = WSP(bf16, WS_WIN); bf16* WMEM_T = WSP(bf16, WS_WMEM); bf16* WOUT_T = WSP(bf16, WS_WOUT); bf16* W1_T = WSP(bf16, WS_W1); bf16* W2_T = WSP(bf16, WS_W2);
        bf16* XN = WSP(bf16, WS_XN); bf16* MEMN = WSP(bf16, WS_MEMN); float* WRG = WSP(float, WS_WRG);
        constexpr int I0 = 16 * 88, I1 = 16 * 16, I2 = 16 * 32, I3 = 32 * 16 * 64, I4 = 32 * 16 * 32, NIT = I0 + I1 + I2 + I3 + I4;
        for (int it = gw; it < NIT; it += NGW) {
            int r = it;
            if (r < I0) { const int nb = r % 88, kb = r / 88; transpose_item(w_in, NIN, WIN_T, headperm_row(nb * 32), scr, kb * 64, nb * 32, lane); continue; } r -= I0;
            if (r < I1) { const int nb = r % 16, kb = r / 16; transpose_item(w_mem_kv, 512, WMEM_T, headperm_row(nb * 32), scr, kb * 64, nb * 32, lane); continue; } r -= I1;
            if (r < I2) { const int nb = r % 32, kb = r / 32; transpose_item(w_out, 1024, WOUT_T, nb * 32, scr, kb * 64, nb * 32, lane); continue; } r -= I2;
            if (r < I3) { const int e = r / 1024, rr = r % 1024, nb = rr % 64, kb = rr / 64; transpose_item(w1 + (size_t)e * 1024 * 2048, 2048, W1_T + (size_t)e * 2048 * 1024, nb * 32, scr, kb * 64, nb * 32, lane); continue; } r -= I3;
            { const int e = r / 512, rr = r % 512, nb = rr % 32, kb = rr / 32; transpose_item(w2 + (size_t)e * 1024 * 1024, 1024, W2_T + (size_t)e * 1024 * 1024, nb * 32, scr, kb * 64, nb * 32, lane); }
        }
        for (int m = gw; m < T + MROWS; m += NGW) {
            if (m < T) rms_row_to_bf16(x + (size_t)m * DM, g_attn, XN + (size_t)m * DM, lane);
            else rms_row_to_bf16(mem + (size_t)(m - T) * DM, g_mem, MEMN + (size_t)(m - T) * DM, lane);
        }
        for (int i = bx * NTHREADS + tid; i < DM * NEXP; i += G * NTHREADS) WRG[i] = g_ffn[i >> 5] * w_router[i];
    }
    grid.sync();

    {
        SchedProj S{G, bx, (const char*)(ws + WS_XN), (const char*)(ws + WS_MEMN), (const char*)(ws + WS_WIN), (const char*)(ws + WS_WMEM)};
        EpiProj E{ws, args.in[4], args.in[5], args.in[9], args.in[10]};
#ifndef NO_G1
        pg8::gemm_phase<EpiProj, SchedProj>(lds, S, E);
#endif
    }
    grid.sync();

#ifndef NAIVE_RET
    for (int i = 0; i < 2; ++i) {
        const int u = vcu * 2 + i, bh = u >> 4, cp = u & 15;
        ret_body::kv_unit(WSP(bf16, WS_KR), WSP(bf16, WS_VR), WSP(float, WS_RET), bh >> 2, bh & 3, cp, (char*)lds_raw);
    }
    grid.sync();
#endif
    { PHASE_LANES;
#ifdef NAIVE_MOBA
    naive_moba(WSP(bf16, WS_QA), WSP(bf16, WS_KA), WSP(bf16, WS_VA), WSP(float, WS_KMEAN), WSP(bf16, WS_Y), gw, NGW, lane);
#else
    for (int i = 0; i < 4; ++i) {
        const int bh = vcu >> 2, s = vcu & 3, nb = (i == 0) ? s : (i == 1) ? 7 - s : (i == 2) ? 8 + s : 15 - s, b = bh >> 3, h = bh & 7;
        const size_t row0 = (size_t)b * SEQ + (size_t)nb * 256;
        attn_body::attn_unit<8, 512, 1024, true>(WSP(bf16, WS_QA) + row0 * 512 + h * 64, WSP(bf16, WS_KA) + (size_t)b * SEQ * 512 + h * 64, WSP(bf16, WS_VA) + (size_t)b * SEQ * 512 + h * 64,
                                                 WSP(bf16, WS_Y) + row0 * DM + h * 64, 4 * nb + 4, nb, WSP(float, WS_KMEAN) + ((size_t)b * 16 * 8 + h) * 64, (char*)lds_raw);
    }
#endif
#ifdef NAIVE_RET
    naive_ret(WSP(bf16, WS_QR), WSP(bf16, WS_KR), WSP(bf16, WS_VR), WSP(bf16, WS_GR), args.in[6], WSP(bf16, WS_Y), gw, NGW, lane);
#else
    for (int i = 0; i < 2; ++i) {
        const int u = vcu * 2 + i, bh = u >> 4, cp = u & 15;
        ret_body::out_unit(WSP(bf16, WS_QR), WSP(bf16, WS_KR), WSP(bf16, WS_VR), WSP(bf16, WS_GR), WSP(float, WS_RET), args.in[6], WSP(bf16, WS_Y), bh >> 2, bh & 3, cp, (char*)lds_raw);
    }
#endif
#ifdef NAIVE_MEM
    naive_mem(WSP(bf16, WS_QM), WSP(bf16, WS_MK), WSP(bf16, WS_MV), WSP(bf16, WS_Y), gw, NGW, lane);
#else
    for (int i = 0; i < 2; ++i) {
        const int u = vcu * 2 + i, bh = u >> 4, qb = u & 15, b = bh >> 2, h = bh & 3;
        const size_t row0 = (size_t)b * SEQ + (size_t)qb * 256;
        attn_body::attn_unit<8, 256, 1024, false>(WSP(bf16, WS_QM) + row0 * 256 + h * 64, WSP(bf16, WS_MK) + (size_t)b * MEMLEN * 256 + h * 64, WSP(bf16, WS_MV) + (size_t)b * MEMLEN * 256 + h * 64,
                                                  WSP(bf16, WS_Y) + row0 * DM + 768 + h * 64, 4, 0, nullptr, (char*)lds_raw);
    }
#endif
    }
    grid.sync();

    {
        SchedPlain S{G, bx, 128, 4, (const char*)(ws + WS_Y), (const char*)(ws + WS_WOUT)};
        EpiOut E{args.in[0], args.out, WSP(float, WS_SSQ)};
#ifndef NO_G2
        pg8::gemm_phase<EpiOut, SchedPlain>(lds, S, E);
#endif
    }
    grid.sync();

    {
        PHASE_LANES;
        float* out = args.out; const float* b_router = args.in[14];
        float* WRG = WSP(float, WS_WRG); float* SSQ = WSP(float, WS_SSQ); int* TOPI = WSP(int, WS_TOPI); float* TOPW = WSP(float, WS_TOPW); int* LRANK = WSP(int, WS_LRANK); int* LCOUNT = WSP(int, WS_LCOUNT);
        LAS float* lg = (LAS float*)(lds) + wave * (16 * 33);
        LAS int* hist = (LAS int*)(lds + 32768);
        if (tid < 32) hist[tid] = 0;
        __syncthreads();
        const int tpw = T / (G * NWAVES);
        for (int tb = 0; tb < tpw; tb += 16) {
            const int t0 = (bx * NWAVES + wave) * tpw + tb;
            const int i = lane & 15, kq = lane >> 4;
            f32x4 a0 = {0.f, 0.f, 0.f, 0.f}, a1 = {0.f, 0.f, 0.f, 0.f};
            const float* xr = out + (size_t)(t0 + i) * DM + 4 * kq;
            const float* wb = WRG + (size_t)(4 * kq) * 32 + i;
#pragma unroll 4
            for (int c = 0; c < 64; ++c) {
                const f32x4 av = *(const f32x4*)(xr + 16 * c);
#pragma unroll
                for (int q = 0; q < 4; ++q) {
                    const float b0 = wb[(size_t)(16 * c + q) * 32], b1v = wb[(size_t)(16 * c + q) * 32 + 16];
                    a0 = __builtin_amdgcn_mfma_f32_16x16x4f32(av[q], b0, a0, 0, 0, 0);
                    a1 = __builtin_amdgcn_mfma_f32_16x16x4f32(av[q], b1v, a1, 0, 0, 0);
                }
            }
#pragma unroll
            for (int r = 0; r < 4; ++r) { lg[(4 * kq + r) * 33 + i] = a0[r]; lg[(4 * kq + r) * 33 + 16 + i] = a1[r]; }
            LDS_WAIT(); asm volatile("" ::: "memory");
            if (lane < 16) {
                const int t = t0 + lane;
                float ss = 0.f;
#pragma unroll
                for (int j = 0; j < 16; ++j) ss += SSQ[(size_t)t * 16 + j];
                const float rstd = 1.0f / sqrtf(ss * (1.0f / DM) + EPS);
                float v[32];
#pragma unroll
                for (int e = 0; e < 32; ++e) v[e] = lg[lane * 33 + e] * rstd + b_router[e];
                int bi[4]; float bvv[4];
#pragma unroll
                for (int k = 0; k < 4; ++k) {
                    float best = -3e38f; int be = 0;
#pragma unroll
                    for (int e = 0; e < 32; ++e) { const bool take = v[e] > best; best = take ? v[e] : best; be = take ? e : be; }
                    bi[k] = be; bvv[k] = best;
#pragma unroll
                    for (int e = 0; e < 32; ++e) v[e] = (e == be) ? -3e38f : v[e];
                }
                const float e1 = __expf(bvv[1] - bvv[0]), e2 = __expf(bvv[2] - bvv[0]), e3 = __expf(bvv[3] - bvv[0]);
                const float inv = 1.0f / (1.0f + e1 + e2 + e3);
                const float wv[4] = {inv, e1 * inv, e2 * inv, e3 * inv};
#pragma unroll
                for (int k = 0; k < 4; ++k) {
                    const int rk = atomicAdd((int*)&hist[bi[k]], 1);
                    TOPI[t * 4 + k] = bi[k]; TOPW[t * 4 + k] = wv[k]; LRANK[t * 4 + k] = rk;
                }
            }
            LDS_WAIT(); asm volatile("" ::: "memory");
        }
        __syncthreads();
        if (tid < 32) LCOUNT[bx * 32 + tid] = hist[tid];
    }
    grid.sync();

    {
        PHASE_LANES;
        float* out = args.out; const float* g_ffn = args.in[12];
        float* SSQ = WSP(float, WS_SSQ); int* TOPI = WSP(int, WS_TOPI); float* TOPW = WSP(float, WS_TOPW); int* LRANK = WSP(int, WS_LRANK); int* LCOUNT = WSP(int, WS_LCOUNT);
        int* POS = WSP(int, WS_POS); float* ROWW = WSP(float, WS_ROWW); int* PSTART = WSP(int, WS_PSTART); int* TILEEXP = WSP(int, WS_TILEEXP); bf16* XG = WSP(bf16, WS_XG);
        LAS int* part = (LAS int*)(lds);
        LAS int* base = (LAS int*)(lds + 8192);
        {
            const int e = tid & 31, p = tid >> 5; int c = 0, pre = 0;
            const int wpp = (G + 15) / 16;
            for (int w = p * wpp; w < (p + 1) * wpp && w < G; ++w) { const int v = LCOUNT[w * 32 + e]; c += v; pre += (w < bx) ? v : 0; }
            part[p * 32 + e] = c; part[512 + p * 32 + e] = pre;
        }
        __syncthreads();
        if (tid < 32) { int c = 0, pre = 0; for (int p = 0; p < 16; ++p) { c += part[p * 32 + tid]; pre += part[512 + p * 32 + tid]; } part[1024 + tid] = c; part[1056 + tid] = pre; }
        __syncthreads();
        if (tid == 0) {
            int ps = 0;
            for (int e = 0; e < 32; ++e) {
                const int c = part[1024 + e], nt_ = (c + 255) >> 8;
                base[32 + e] = ps; base[e] = ps + part[1056 + e];
                if (bx == 0) { PSTART[e] = ps; for (int tt = 0; tt < nt_; ++tt) TILEEXP[(ps >> 8) + tt] = e; }
                ps += nt_ * 256;
            }
            base[64] = ps; if (bx == 0) PSTART[32] = ps;
        }
        __syncthreads();
        if (bx < 32) {
            const int c = part[1024 + bx], r0 = base[32 + bx] + c, r1 = base[32 + bx] + (((c + 255) >> 8) << 8);
            for (int r = r0 + wave; r < r1; r += NWAVES) { u32x4* p = (u32x4*)(XG + (size_t)r * 1024); p[lane] = (u32x4){0u, 0u, 0u, 0u}; p[64 + lane] = (u32x4){0u, 0u, 0u, 0u}; if (lane == 0) ROWW[r] = 0.f; }
        }
        const int tpw = T / (G * NWAVES);
        for (int tb = 0; tb < tpw; ++tb) {
            const int t = (bx * NWAVES + wave) * tpw + tb;
            float ss = 0.f; if (lane < 16) ss = SSQ[(size_t)t * 16 + lane];
            ss += __shfl_xor(ss, 1); ss += __shfl_xor(ss, 2); ss += __shfl_xor(ss, 4); ss += __shfl_xor(ss, 8);
            ss = __shfl(ss, 0);
            const float rstd = 1.0f / sqrtf(ss * (1.0f / DM) + EPS);
            const f32x4* xr = (const f32x4*)(out + (size_t)t * DM) + lane; const f32x4* gr = (const f32x4*)g_ffn + lane;
            u32x2 w[4];
#pragma unroll
            for (int j = 0; j < 4; ++j) { const f32x4 v = xr[64 * j], gg = gr[64 * j]; w[j].x = cvtpk(v.x * rstd * gg.x, v.y * rstd * gg.y); w[j].y = cvtpk(v.z * rstd * gg.z, v.w * rstd * gg.w); }
#pragma unroll
            for (int k = 0; k < 4; ++k) {
                const int e = TOPI[t * 4 + k]; const int pos = base[e] + LRANK[t * 4 + k];
                u32x2* o8 = (u32x2*)(XG + (size_t)pos * 1024) + lane;
#pragma unroll
                for (int j = 0; j < 4; ++j) o8[64 * j] = w[j];
                if (lane == 0) { POS[t * 4 + k] = pos; ROWW[pos] = TOPW[t * 4 + k]; }
            }
        }
    }
    grid.sync();

    const int ntiles = WSP(int, WS_PSTART)[32] >> 8;
    {
        SchedMoe S{G, vcu, 8, ntiles, WSP(int, WS_TILEEXP), (const char*)(ws + WS_XG), (const char*)(ws + WS_W1), (size_t)2048 * 2048};
        EpiSwiglu E{args.in[16], WSP(bf16, WS_H)};
#ifndef NO_G3
        pg8::gemm_phase<EpiSwiglu, SchedMoe>(lds, S, E);
#endif
    }
    grid.sync();
    {
        SchedMoe S{G, vcu, 4, ntiles, WSP(int, WS_TILEEXP), (const char*)(ws + WS_H), (const char*)(ws + WS_W2), (size_t)1024 * 2048};
        EpiDown E{args.in[18], WSP(float, WS_ROWW), WSP(bf16, WS_XG)};
#ifndef NO_G4
        pg8::gemm_phase<EpiDown, SchedMoe>(lds, S, E);
#endif
    }
    grid.sync();
    { PHASE_LANES;
    for (int t = gw; t < T; t += NGW) {
        float* out = args.out; const int* POS = WSP(int, WS_POS); const bf16* YE = WSP(bf16, WS_XG);
        f32x4* orow = (f32x4*)(out + (size_t)t * DM) + lane;
        f32x4 v[4];
#pragma unroll
        for (int j = 0; j < 4; ++j) v[j] = orow[64 * j];
#pragma unroll
        for (int k = 0; k < 4; ++k) {
            const int pos = POS[t * 4 + k]; const u32x2* yr = (const u32x2*)(YE + (size_t)pos * 1024) + lane;
#pragma unroll
            for (int j = 0; j < 4; ++j) { const u32x2 w = yr[64 * j]; v[j].x += bflo(w.x); v[j].y += bfhi(w.x); v[j].z += bflo(w.y); v[j].w += bfhi(w.y); }
        }
#pragma unroll
        for (int j = 0; j < 4; ++j) orow[64 * j] = v[j];
    }
    }
}

extern "C" void kernel_launch(void* const* d_in, const int* in_sizes, int n_in, void* d_out, int out_size, void* d_ws, size_t ws_size, hipStream_t stream) {
    static int grid = 0;
    if (grid == 0) {
        if (n_in != 19 || out_size != T * DM || ws_size < WS_END) { fprintf(stderr, "kernel_launch: unexpected shapes (n_in %d out %d ws %zu)\n", n_in, out_size, ws_size); grid = -1; return; }
        int dev = 0, cus = 0, per_cu = 0;
        hipGetDevice(&dev); hipDeviceGetAttribute(&cus, hipDeviceAttributeMultiprocessorCount, dev);
        hipFuncSetAttribute((const void*)fwd_kernel, hipFuncAttributeMaxDynamicSharedMemorySize, LDS_BYTES);
        hipOccupancyMaxActiveBlocksPerMultiprocessor(&per_cu, (const void*)fwd_kernel, NTHREADS, LDS_BYTES);
        if (per_cu < 1) { fprintf(stderr, "kernel_launch: occupancy query says %d blocks per CU\n", per_cu); per_cu = 1; }
        (void)hipGetLastError();
        grid = cus * 1;
        if (grid % 8 != 0 || T % (grid * NWAVES * 16) != 0) { fprintf(stderr, "kernel_launch: grid %d unsupported\n", grid); grid = -1; return; }
    }
    if (grid < 0) return;
    hipMemsetAsync((char*)d_ws + WS_CTL, 0, CTL_ZERO_BYTES, stream);
    Args a{};
    for (int i = 0; i < 19; ++i) a.in[i] = (const float*)d_in[i];
    a.out = (float*)d_out; a.ws = (unsigned char*)d_ws;
    void* kargs[] = {&a};
    hipError_t e = hipLaunchCooperativeKernel((const void*)fwd_kernel, dim3(grid), dim3(NTHREADS), kargs, LDS_BYTES, stream);
    if (e != hipSuccess) fprintf(stderr, "cooperative launch failed: %s (grid %d)\n", hipGetErrorString(e), grid);
}
```

```cpp
#include <hip/hip_runtime.h>
#include <hip/hip_cooperative_groups.h>
#include <cstdio>
#include <cstdint>
namespace cg = cooperative_groups;

#define GAS __attribute__((address_space(1)))
#define LAS __attribute__((address_space(3)))
typedef unsigned short bf16;
typedef short bf16x8 __attribute__((ext_vector_type(8)));
typedef float f32x4 __attribute__((ext_vector_type(4)));
typedef float f32x2 __attribute__((ext_vector_type(2)));
typedef unsigned u32x4 __attribute__((ext_vector_type(4)));
typedef unsigned u32x2 __attribute__((ext_vector_type(2)));
typedef __bf16 bf16x2_t __attribute__((ext_vector_type(2)));

constexpr int NB = 8, SEQ = 4096, DM = 1024, T = NB * SEQ;
constexpr int NIN = 2816, NEXP = 32, TOPK = 4;
constexpr int MEMLEN = 256, MROWS = NB * MEMLEN;
constexpr float EPS = 1e-6f;
constexpr float C2 = 0.125f * 1.4426950408889634f;
constexpr int MAXTILES = 544, PROWS = MAXTILES * 256;
constexpr int NWAVES = 8, NTHREADS = 512;
#ifndef REP_PHASE
#define REP_PHASE -1
#endif
#define REPN(k) for (int rep_ = 0; rep_ < ((REP_PHASE == (k)) ? 2 : 1); ++rep_)
constexpr int LDS_MISC = 147456;
constexpr int LDS_BYTES = 147456 + 256;

constexpr size_t MiB = 1u << 20;
constexpr size_t WS_CTL = 0, CTL_ZERO_BYTES = 2 * MiB;
constexpr size_t WS_BAR = 65536;
constexpr size_t WS_KMEAN = 1 * MiB;
constexpr size_t WS_WRG = 2 * MiB;
constexpr size_t WS_SSQ = 3 * MiB;
constexpr size_t WS_TOPI = 5 * MiB, WS_TOPW = 5 * MiB + 512 * 1024, WS_LRANK = 6 * MiB, WS_POS = 6 * MiB + 512 * 1024;
constexpr size_t WS_ROWW = 7 * MiB;
constexpr size_t WS_LCOUNT = 8 * MiB, WS_PSTART = 8 * MiB + 65536, WS_TILEEXP = 8 * MiB + 131072;
constexpr size_t WS_WIN = 16 * MiB, WS_WMEM = 22 * MiB, WS_WOUT = 24 * MiB, WS_W1 = 32 * MiB, WS_W2 = 160 * MiB;
constexpr size_t WS_XN = 224 * MiB, WS_MEMN = 288 * MiB;
constexpr size_t WS_QA = 292 * MiB, WS_KA = 324 * MiB, WS_VA = 356 * MiB;
constexpr size_t WS_QR = 388 * MiB, WS_KR = 404 * MiB, WS_VR = 420 * MiB, WS_GR = 436 * MiB, WS_QM = 452 * MiB;
constexpr size_t WS_MK = 468 * MiB, WS_MV = 469 * MiB;
constexpr size_t WS_Y = 470 * MiB, WS_RET = 534 * MiB;
constexpr size_t WS_XG = 224 * MiB;
constexpr size_t WS_XN2 = 496 * MiB;
constexpr size_t WS_ROWTOK = 9 * MiB;
constexpr size_t WS_H = 566 * MiB;
constexpr size_t WS_END = 838 * MiB;

struct Args {
    const float* in[19]; float* out; unsigned char* ws; int pad0, pad1;
};

__device__ __forceinline__ unsigned cvtpk(float lo, float hi) { f32x2 v = {lo, hi}; bf16x2_t b = __builtin_convertvector(v, bf16x2_t); return __builtin_bit_cast(unsigned, b); }
__device__ __forceinline__ float bf2f(unsigned short b) { return __uint_as_float(((unsigned)b) << 16); }
__device__ __forceinline__ float bflo(unsigned w) { return __uint_as_float(w << 16); }
__device__ __forceinline__ float bfhi(unsigned w) { return __uint_as_float(w & 0xffff0000u); }
__device__ __forceinline__ float wave_sum(float v) {
#pragma unroll
    for (int o = 1; o < 64; o <<= 1) v += __shfl_xor(v, o);
    return v;
}
#define LDS_WAIT() asm volatile("s_waitcnt lgkmcnt(0)" ::: "memory")
__device__ __forceinline__ int opaque(int v) { asm volatile("" : "+v"(v)); return v; }

namespace pg8 {
constexpr int BM = 256, BK = 64, HALF = 128, HTB = HALF * BK * 2, STAGE_BYTES = 8 * HTB, NXCD = 8, WGM = 8, K = 1024;
__host__ __device__ __forceinline__ int lds_byte(int r, int c) { const int st = (r >> 4) * 2 + (c >> 5), rr = r & 15, cc = c & 31, ob = rr * 64 + cc * 2; return st * 1024 + (ob ^ (((ob >> 9) & 1) << 5)); }
__host__ __device__ __forceinline__ void stage_rc(int b, int& R, int& C) { const int st = b / 1024, sb = b % 1024, swz = sb ^ (((sb >> 9) & 1) << 5); R = (st >> 1) * 16 + swz / 64; C = (st & 1) * 32 + (swz % 64) / 2; }
__host__ __device__ __forceinline__ int perm32(int rho) { const int n = rho >> 4, i = rho & 15; return 8 * (i >> 2) + 4 * n + (i & 3); }
struct Unit { int pm, pn, aux; };

__device__ __forceinline__ bool static_order(int L, int nM, int nN, int& pm, int& pn) {
    const int nwg = nM * nN; if (L >= nwg) return false;
    int wgid = L; { const int q = nwg / NXCD, r = nwg % NXCD, xcd = wgid % NXCD, off = wgid / NXCD; wgid = (xcd < r ? xcd * (q + 1) : r * (q + 1) + (xcd - r) * q) + off; }
    const int nig = WGM * nN, gid = wgid / nig, fm = gid * WGM, gsz = (nM - fm) < WGM ? (nM - fm) : WGM;
    pm = fm + ((wgid % nig) % gsz); pn = (wgid % nig) / gsz; return true;
}

template <class Epi, class Sched, bool GATHER = false>
__device__ __forceinline__ void gemm_phase(LAS unsigned char* lds, const Sched& S, const Epi& E) {
    const int tid = opaque((int)threadIdx.x), wid = __builtin_amdgcn_readfirstlane(tid >> 6), lane = tid & 63, wr = wid >> 2, wc = wid & 3, fr = lane & 15, fq = lane >> 4;
    constexpr int nt = K / BK;
    unsigned voffA[2], voffB[2];
#pragma unroll
    for (int i = 0; i < 2; ++i) { int R, C; stage_rc(tid * 16 + i * 8192, R, C); const int Rb = (R & ~31) + perm32(R & 31);
        voffA[i] = (unsigned)(R * K + C) * 2u; voffB[i] = (unsigned)(Rb * K + C) * 2u; }
    const size_t kstep = (size_t)(BK * 2);
    const size_t hstep = (size_t)HALF * K * 2;
    const unsigned ldsw = (unsigned)wid * 1024u;
    const int aoff = lds_byte(wr * 64 + fr, fq * 8), boff = lds_byte(wc * 32 + fr, fq * 8);
#define PG8_SA(b, h) (((b) * 2 + (h)) * HTB)
#define PG8_SB(b, h) ((4 + (b) * 2 + (h)) * HTB)
#define PG8_STAGE(bufoff, gbase, voff) do { _Pragma("unroll") for (int _i = 0; _i < 2; ++_i) \
        __builtin_amdgcn_global_load_lds((const unsigned*)((const char*)(gbase) + (voff)[_i]), (LAS unsigned*)(lds + (bufoff) + ldsw + _i * 8192), 16, 0, 0); } while (0)
#define PG8_LDA(dst, b, h) do { _Pragma("unroll") for (int m = 0; m < 4; ++m) _Pragma("unroll") for (int k = 0; k < 2; ++k) dst[m][k] = *(const LAS bf16x8*)(lds + PG8_SA(b, h) + aoff + m * 2048 + k * 1024); } while (0)
#define PG8_LDB(dst, b, h) do { _Pragma("unroll") for (int n = 0; n < 2; ++n) _Pragma("unroll") for (int k = 0; k < 2; ++k) dst[n][k] = *(const LAS bf16x8*)(lds + PG8_SB(b, h) + boff + n * 2048 + k * 1024); } while (0)
#define PG8_MMA(ai, bj, At, Bt) do { __builtin_amdgcn_s_setprio(1); _Pragma("unroll") for (int m = 0; m < 4; ++m) _Pragma("unroll") for (int n = 0; n < 2; ++n) _Pragma("unroll") for (int k = 0; k < 2; ++k) \
        acc[ai][bj][m][n] = __builtin_amdgcn_mfma_f32_16x16x32_bf16(Bt[n][k], At[m][k], acc[ai][bj][m][n], 0, 0, 0); __builtin_amdgcn_s_setprio(0); } while (0)
#define PG8_WAIT_V(n) asm volatile("s_waitcnt vmcnt(" #n ")" ::: "memory")
#define PG8_WAIT_L(n) asm volatile("s_waitcnt lgkmcnt(" #n ")" ::: "memory")
#define PG8_BAR __builtin_amdgcn_s_barrier()
#define PG8_SCHED __builtin_amdgcn_sched_barrier(0)
    Unit cur, nxt; int ui = 0;
    if (!S.next(0, cur)) return;
    unsigned vGc[2][2], vGn[2][2]; int gR[2], gC[2];
    const char* gA = nullptr;
    if constexpr (GATHER) {
        gA = S.abase();
#pragma unroll
        for (int i = 0; i < 2; ++i) { stage_rc(tid * 16 + i * 8192, gR[i], gC[i]); }
        if (wid == 0) __builtin_amdgcn_global_load_lds((const unsigned*)(S.tokptr(cur) + lane * 16), (LAS unsigned*)(lds + 131072), 16, 0, 0);
        asm volatile("s_waitcnt vmcnt(0)" ::: "memory"); __builtin_amdgcn_s_barrier(); asm volatile("" ::: "memory");
#pragma unroll
        for (int h = 0; h < 2; ++h)
#pragma unroll
            for (int i = 0; i < 2; ++i) { const int tok = ((const LAS int*)(lds + 131072))[h * 128 + gR[i]]; vGc[h][i] = (unsigned)tok * 2048u + (unsigned)gC[i] * 2u; vGn[h][i] = vGc[h][i]; }
    }
    f32x4 acc[2][2][4][2];
#pragma unroll
    for (int a = 0; a < 2; ++a)
#pragma unroll
        for (int b = 0; b < 2; ++b)
#pragma unroll
            for (int m = 0; m < 4; ++m)
#pragma unroll
                for (int n = 0; n < 2; ++n) acc[a][b][m][n] = (f32x4){0.f, 0.f, 0.f, 0.f};
    bf16x8 At[4][2], B0[2][2], B1[2][2];
    const char* cA = GATHER ? gA : S.aptr(cur); const char* cB = S.bptr(cur);
    const size_t ahstep = GATHER ? (size_t)0 : hstep;
    {
        PG8_STAGE(PG8_SB(0, 0), cB, voffB); PG8_STAGE(PG8_SB(0, 1), cB + hstep, voffB);
        if constexpr (GATHER) { PG8_STAGE(PG8_SA(0, 0), cA, vGc[0]); PG8_STAGE(PG8_SA(0, 1), cA, vGc[1]); } else { PG8_STAGE(PG8_SA(0, 0), cA, voffA); PG8_STAGE(PG8_SA(0, 1), cA + hstep, voffA); }
        if (wr == 1) PG8_BAR;
        PG8_WAIT_V(2); PG8_BAR;
        PG8_STAGE(PG8_SB(1, 0), cB + kstep, voffB);
        if constexpr (GATHER) { PG8_STAGE(PG8_SA(1, 0), cA + kstep, vGc[0]); } else { PG8_STAGE(PG8_SA(1, 0), cA + kstep, voffA); }
        PG8_STAGE(PG8_SB(1, 1), cB + hstep + kstep, voffB);
        PG8_WAIT_V(6); PG8_BAR;
    }
    for (;;) {
        const bool has_next = S.next(ui + 1, nxt);
        const char* nA = GATHER ? gA : (has_next ? S.aptr(nxt) : cA); const char* nB = has_next ? S.bptr(nxt) : cB;
        if constexpr (GATHER) { if (has_next && wid == 0) __builtin_amdgcn_global_load_lds((const unsigned*)(S.tokptr(nxt) + lane * 16), (LAS unsigned*)(lds + 131072 + ((ui + 1) & 1) * 1024), 16, 0, 0); }
        for (int t = 0; t < nt; t += 2) {
            const bool last = (t == nt - 2);
            const char* a1 = cA + (size_t)(t + 1) * kstep;
            const char* a2 = last ? nA : cA + (size_t)(t + 2) * kstep; const char* b2 = last ? nB : cB + (size_t)(t + 2) * kstep;
            const char* a3 = a2 + kstep; const char* b3 = b2 + kstep;
            unsigned v2h0[2], v2h1[2];
            if constexpr (GATHER) {
                if (last && has_next) {
                    const LAS int* tk = (const LAS int*)(lds + 131072 + ((ui + 1) & 1) * 1024);
#pragma unroll
                    for (int h = 0; h < 2; ++h)
#pragma unroll
                        for (int i = 0; i < 2; ++i) vGn[h][i] = (unsigned)tk[h * 128 + gR[i]] * 2048u + (unsigned)gC[i] * 2u;
                }
#pragma unroll
                for (int i = 0; i < 2; ++i) { v2h0[i] = last ? vGn[0][i] : vGc[0][i]; v2h1[i] = last ? vGn[1][i] : vGc[1][i]; }
            } else {
#pragma unroll
                for (int i = 0; i < 2; ++i) { v2h0[i] = voffA[i]; v2h1[i] = voffA[i]; }
            }
            PG8_LDB(B0, 0, 0); PG8_LDB(B1, 0, 1); PG8_SCHED; PG8_LDA(At, 0, 0);
            if constexpr (GATHER) { PG8_STAGE(PG8_SA(1, 1), a1, vGc[1]); } else { PG8_STAGE(PG8_SA(1, 1), a1 + hstep, voffA); }
            PG8_WAIT_V(8); PG8_WAIT_L(0); PG8_BAR; PG8_MMA(0, 0, At, B0); PG8_MMA(0, 1, At, B1); PG8_BAR; PG8_SCHED;
            PG8_LDA(At, 0, 1); PG8_STAGE(PG8_SB(0, 0), b2, voffB); PG8_STAGE(PG8_SB(0, 1), b2 + hstep, voffB); PG8_STAGE(PG8_SA(0, 0), a2, v2h0);
            PG8_WAIT_V(8); PG8_WAIT_L(0); PG8_BAR; PG8_MMA(1, 0, At, B0); PG8_MMA(1, 1, At, B1); PG8_BAR; PG8_SCHED;
            PG8_LDB(B0, 1, 0); PG8_LDB(B1, 1, 1); PG8_SCHED; PG8_LDA(At, 1, 0); PG8_STAGE(PG8_SA(0, 1), a2 + ahstep, v2h1);
            PG8_WAIT_V(8); PG8_WAIT_L(0); PG8_BAR; PG8_MMA(0, 0, At, B0); PG8_MMA(0, 1, At, B1); PG8_BAR; PG8_SCHED;
            PG8_LDA(At, 1, 1); PG8_STAGE(PG8_SB(1, 0), b3, voffB); PG8_STAGE(PG8_SB(1, 1), b3 + hstep, voffB); PG8_STAGE(PG8_SA(1, 0), a3, v2h0);
            PG8_WAIT_V(8); PG8_WAIT_L(0); PG8_BAR; PG8_MMA(1, 0, At, B0); PG8_MMA(1, 1, At, B1); PG8_BAR; PG8_SCHED;
        }
        if (wr == 0) PG8_BAR;
        E(acc, cur, wr, wc, fr, fq);
        if (!has_next) break;
#pragma unroll
        for (int a = 0; a < 2; ++a)
#pragma unroll
            for (int b = 0; b < 2; ++b)
#pragma unroll
                for (int m = 0; m < 4; ++m)
#pragma unroll
                    for (int n = 0; n < 2; ++n) acc[a][b][m][n] = (f32x4){0.f, 0.f, 0.f, 0.f};
        cur = nxt; cA = nA; cB = nB; ++ui;
        if constexpr (GATHER) {
#pragma unroll
            for (int h = 0; h < 2; ++h)
#pragma unroll
                for (int i = 0; i < 2; ++i) vGc[h][i] = vGn[h][i];
        }
        if (wr == 1) PG8_BAR;
    }
    PG8_WAIT_V(0);
    PG8_BAR;
#undef PG8_SA
#undef PG8_SB
#undef PG8_STAGE
#undef PG8_LDA
#undef PG8_LDB
#undef PG8_MMA
#undef PG8_WAIT_V
#undef PG8_WAIT_L
#undef PG8_BAR
#undef PG8_SCHED
}
}
using pg8::Unit;

struct SchedProj {
    int G, c; const char *XN, *MEMN, *WIN, *WMEM;
    __device__ __forceinline__ bool next(int i, Unit& u) const {
        const int L = i * G + c;
        if (L < 1408) { u.aux = 0; return pg8::static_order(L, 128, 11, u.pm, u.pn); }
        if (L < 1424) { const int j = L - 1408; u.pm = j >> 1; u.pn = j & 1; u.aux = 1; return true; }
        return false;
    }
    __device__ __forceinline__ const char* aptr(const Unit& u) const { return (u.aux ? MEMN : XN) + (size_t)u.pm * (256 * 2048); }
    __device__ __forceinline__ const char* bptr(const Unit& u) const { return (u.aux ? WMEM : WIN) + (size_t)u.pn * (256 * 2048); }
};
struct SchedPlain {
    int G, c, nM, nN; const char *A, *B;
    __device__ __forceinline__ bool next(int i, Unit& u) const { u.aux = 0; return pg8::static_order(i * G + c, nM, nN, u.pm, u.pn); }
    __device__ __forceinline__ const char* aptr(const Unit& u) const { return A + (size_t)u.pm * (256 * 2048); }
    __device__ __forceinline__ const char* bptr(const Unit& u) const { return B + (size_t)u.pn * (256 * 2048); }
};
struct SchedMoe {
    int G, vcu, npn, ntiles; const int* tile_exp; const char *A, *B; size_t bexp;
    __device__ __forceinline__ bool next(int i, Unit& u) const {
        const int L = i * G + vcu, tile = L / npn; if (tile >= ntiles) return false;
        u.pm = tile; u.pn = L - tile * npn; u.aux = __builtin_amdgcn_readfirstlane(tile_exp[tile]); return true;
    }
    __device__ __forceinline__ const char* aptr(const Unit& u) const { return A + (size_t)u.pm * (256 * 2048); }
    __device__ __forceinline__ const char* bptr(const Unit& u) const { return B + (size_t)u.aux * bexp + (size_t)u.pn * (256 * 2048); }
    const int* rowtok;
    __device__ __forceinline__ const char* abase() const { return A; }
    __device__ __forceinline__ const char* tokptr(const Unit& u) const { return (const char*)(rowtok + (size_t)u.pm * 256); }
};

struct EpiProj {
    unsigned char* ws;
    const float *gq, *gk, *gmq, *gmk;
    __device__ __forceinline__ void operator()(const f32x4 (&acc)[2][2][4][2], const Unit& u, int wr, int wc, int fr, int fq) const {
        int mode = 0; bf16* out; int ld = 256, coff = 0; const float* gain = nullptr; float scale = 1.f; bool kmean = false;
        if (u.aux == 0) {
            switch (u.pn) {
                case 0: case 1: out = (bf16*)(ws + WS_QA); ld = 512; coff = u.pn * 256; mode = 1; gain = gq; scale = C2; break;
                case 2: case 3: out = (bf16*)(ws + WS_KA); ld = 512; coff = (u.pn - 2) * 256; mode = 1; gain = gk; kmean = true; break;
                case 4: case 5: out = (bf16*)(ws + WS_VA); ld = 512; coff = (u.pn - 4) * 256; break;
                case 6: out = (bf16*)(ws + WS_QR); mode = 2; break;
                case 7: out = (bf16*)(ws + WS_KR); mode = 2; scale = 0.125f; break;
                case 8: out = (bf16*)(ws + WS_VR); break;
                case 9: out = (bf16*)(ws + WS_GR); mode = 3; break;
                default: out = (bf16*)(ws + WS_QM); mode = 1; gain = gmq; scale = C2; break;
            }
        } else {
            if (u.pn == 0) { out = (bf16*)(ws + WS_MK); mode = 1; gain = gmk; } else { out = (bf16*)(ws + WS_MV); }
        }
        const int row0 = u.pm * 256 + wr * 64 + fr;
        const int colb = coff + wc * 64 + 8 * fq;
        if (gain == nullptr) gain = gq;
        f32x4 ks[2][2];
#pragma unroll
        for (int bj = 0; bj < 2; ++bj)
#pragma unroll
            for (int n = 0; n < 2; ++n) ks[bj][n] = (f32x4){0.f, 0.f, 0.f, 0.f};
#pragma unroll
        for (int ai = 0; ai < 2; ++ai)
#pragma unroll
            for (int m = 0; m < 4; ++m) {
                const int row = row0 + ai * 128 + m * 16;
                f32x4 v[2][2];
#pragma unroll
                for (int bj = 0; bj < 2; ++bj)
#pragma unroll
                    for (int n = 0; n < 2; ++n) v[bj][n] = acc[ai][bj][m][n];
                if (mode == 1) {
                    float ss = 0.f;
#pragma unroll
                    for (int bj = 0; bj < 2; ++bj)
#pragma unroll
                        for (int n = 0; n < 2; ++n) { const f32x4 x = v[bj][n]; ss += (x[0] * x[0] + x[1] * x[1]) + (x[2] * x[2] + x[3] * x[3]); }
                    ss += __shfl_xor(ss, 16); ss += __shfl_xor(ss, 32);
                    const float r = scale / sqrtf(ss * (1.0f / 64.0f) + EPS);
#pragma unroll
                    for (int bj = 0; bj < 2; ++bj)
#pragma unroll
                        for (int n = 0; n < 2; ++n) v[bj][n] = v[bj][n] * r * *(const f32x4*)(gain + bj * 32 + 8 * fq + 4 * n);
                } else if (mode == 2) {
                    const float pos = (float)(row & (SEQ - 1));
                    const float lgam = __builtin_amdgcn_logf(1.0f - __builtin_amdgcn_exp2f(-5.0f - (float)wc));
                    const float rsc = scale * __builtin_amdgcn_exp2f(((u.pn == 6) ? lgam : -lgam) * (float)(row & 127));
#pragma unroll
                    for (int n = 0; n < 2; ++n)
#pragma unroll
                        for (int j = 0; j < 4; ++j) {
                            const float fre = __builtin_amdgcn_exp2f((float)(8 * fq + 4 * n + j) * (-13.287712379549449f / 31.0f)) * 0.15915494309189535f;
                            float tt = pos * fre; tt = tt - floorf(tt);
                            const float sn = __builtin_amdgcn_sinf(tt), cs = __builtin_amdgcn_cosf(tt);
                            const float t1 = v[0][n][j], t2 = v[1][n][j];
                            v[0][n][j] = (t1 * cs - t2 * sn) * rsc; v[1][n][j] = (t2 * cs + t1 * sn) * rsc;
                        }
                } else if (mode == 3) {
#pragma unroll
                    for (int bj = 0; bj < 2; ++bj)
#pragma unroll
                        for (int n = 0; n < 2; ++n)
#pragma unroll
                            for (int j = 0; j < 4; ++j) { const float x = v[bj][n][j]; v[bj][n][j] = x / (1.0f + __expf(-x)); }
                }
                if (kmean) {
#pragma unroll
                    for (int bj = 0; bj < 2; ++bj)
#pragma unroll
                        for (int n = 0; n < 2; ++n) ks[bj][n] += v[bj][n];
                }
                bf16* rowp = out + (size_t)row * ld + colb;
#pragma unroll
                for (int bj = 0; bj < 2; ++bj) { u32x4 w; w.x = cvtpk(v[bj][0][0], v[bj][0][1]); w.y = cvtpk(v[bj][0][2], v[bj][0][3]); w.z = cvtpk(v[bj][1][0], v[bj][1][1]); w.w = cvtpk(v[bj][1][2], v[bj][1][3]);
                    *(u32x4*)(rowp + bj * 32) = w; }
            }
        if (kmean) {
            float* kp = (float*)(ws + WS_KMEAN) + ((size_t)u.pm * 8 + (u.pn - 2) * 4 + wc) * 64 + 8 * fq;
#pragma unroll
            for (int bj = 0; bj < 2; ++bj)
#pragma unroll
                for (int n = 0; n < 2; ++n)
#pragma unroll
                    for (int j = 0; j < 4; ++j) {
                        float s = ks[bj][n][j];
                        s += __shfl_xor(s, 1); s += __shfl_xor(s, 2); s += __shfl_xor(s, 4); s += __shfl_xor(s, 8);
                        if (fr == 0) atomicAdd(kp + bj * 32 + 4 * n + j, s * (1.0f / 256.0f));
                    }
        }
    }
};

struct EpiOut {
    const float* x; float* out; float* ssq;
    __device__ __forceinline__ void operator()(const f32x4 (&acc)[2][2][4][2], const Unit& u, int wr, int wc, int fr, int fq) const {
        const int row0 = u.pm * 256 + wr * 64 + fr, col0 = u.pn * 256 + wc * 32 + 8 * fq;
#pragma unroll
        for (int ai = 0; ai < 2; ++ai)
#pragma unroll
            for (int m = 0; m < 4; ++m) {
                const int row = row0 + ai * 128 + m * 16; const size_t off = (size_t)row * DM + col0; float ss = 0.f;
#pragma unroll
                for (int bj = 0; bj < 2; ++bj)
#pragma unroll
                    for (int n = 0; n < 2; ++n) { const f32x4 xv = *(const f32x4*)(x + off + bj * 128 + 4 * n); const f32x4 o = xv + acc[ai][bj][m][n];
                        ss += (o[0] * o[0] + o[1] * o[1]) + (o[2] * o[2] + o[3] * o[3]); *(f32x4*)(out + off + bj * 128 + 4 * n) = o; }
                ss += __shfl_xor(ss, 16); ss += __shfl_xor(ss, 32);
                if (fq == 0) ssq[(size_t)row * 16 + u.pn * 4 + wc] = ss;
            }
    }
};

struct EpiSwiglu {
    const float* b1; bf16* H;
    __device__ __forceinline__ void operator()(const f32x4 (&acc)[2][2][4][2], const Unit& u, int wr, int wc, int fr, int fq) const {
        const int row0 = u.pm * 256 + wr * 64 + fr, zc0 = u.pn * 256 + wc * 32 + 8 * fq;
        const float* bp = b1 + (size_t)u.aux * 2048 + zc0;
        f32x4 bv[2][2];
#pragma unroll
        for (int bj = 0; bj < 2; ++bj)
#pragma unroll
            for (int n = 0; n < 2; ++n) bv[bj][n] = *(const f32x4*)(bp + bj * 128 + 4 * n);
#pragma unroll
        for (int ai = 0; ai < 2; ++ai)
#pragma unroll
            for (int m = 0; m < 4; ++m) {
                const int row = row0 + ai * 128 + m * 16;
#pragma unroll
                for (int bj = 0; bj < 2; ++bj) {
                    const f32x4 z0 = acc[ai][bj][m][0] + bv[bj][0], z1 = acc[ai][bj][m][1] + bv[bj][1];
                    float h[4];
                    const float gl[4] = {z0[0], z0[2], z1[0], z1[2]}, li[4] = {z0[1], z0[3], z1[1], z1[3]};
#pragma unroll
                    for (int p = 0; p < 4; ++p) { const float g = fminf(gl[p], 7.0f); const float l = fminf(fmaxf(li[p], -7.0f), 7.0f);
                        h[p] = g * __builtin_amdgcn_rcpf(1.0f + __builtin_amdgcn_exp2f(-1.702f * 1.4426950408889634f * g)) * (l + 1.0f); }
                    u32x2 w; w.x = cvtpk(h[0], h[1]); w.y = cvtpk(h[2], h[3]);
                    *(u32x2*)(H + (size_t)row * 1024 + (zc0 + bj * 128) / 2) = w;
                }
            }
    }
};

struct EpiDown {
    const float* b2; const float* roww; bf16* YE;
    __device__ __forceinline__ void operator()(const f32x4 (&acc)[2][2][4][2], const Unit& u, int wr, int wc, int fr, int fq) const {
        const int row0 = u.pm * 256 + wr * 64 + fr, c0 = u.pn * 256 + wc * 32 + 8 * fq;
        const float* bp = b2 + (size_t)u.aux * 1024 + c0;
        f32x4 bv[2][2];
#pragma unroll
        for (int bj = 0; bj < 2; ++bj)
#pragma unroll
            for (int n = 0; n < 2; ++n) bv[bj][n] = *(const f32x4*)(bp + bj * 128 + 4 * n);
#pragma unroll
        for (int ai = 0; ai < 2; ++ai)
#pragma unroll
            for (int m = 0; m < 4; ++m) {
                const int row = row0 + ai * 128 + m * 16; const float w8 = roww[row];
#pragma unroll
                for (int bj = 0; bj < 2; ++bj) {
                    const f32x4 y0 = (acc[ai][bj][m][0] + bv[bj][0]) * w8, y1 = (acc[ai][bj][m][1] + bv[bj][1]) * w8;
                    u32x4 w; w.x = cvtpk(y0[0], y0[1]); w.y = cvtpk(y0[2], y0[3]); w.z = cvtpk(y1[0], y1[1]); w.w = cvtpk(y1[2], y1[3]);
                    *(u32x4*)(YE + (size_t)row * 1024 + c0 + bj * 128) = w;
                }
            }
    }
};

__device__ __forceinline__ void transpose_item(const float* W, int N, bf16* WT, int drow0, LAS float* scr, int k0, int n0, int lane) {
#pragma unroll 8
    for (int i = 0; i < 32; ++i) { const int kk = 2 * i + (lane >> 5); scr[kk * 33 + (lane & 31)] = W[(size_t)(k0 + kk) * N + n0 + (lane & 31)]; }
    LDS_WAIT(); asm volatile("" ::: "memory");
    const int c = lane & 7;
#pragma unroll
    for (int j = 0; j < 4; ++j) { const int n = (lane >> 3) + 8 * j; const LAS float* s = scr + (8 * c) * 33 + n;
        u32x4 o; o.x = cvtpk(s[0 * 33], s[1 * 33]); o.y = cvtpk(s[2 * 33], s[3 * 33]); o.z = cvtpk(s[4 * 33], s[5 * 33]); o.w = cvtpk(s[6 * 33], s[7 * 33]);
        *(u32x4*)(WT + (size_t)(drow0 + n) * 1024 + k0 + 8 * c) = o; }
    LDS_WAIT(); asm volatile("" ::: "memory");
}
__device__ __forceinline__ int headperm_row(int n0) { const int pn = n0 >> 8, c = n0 & 255, hh = c >> 6, dh = (c & 63) >> 5; return pn * 256 + dh * 128 + hh * 32; }
__device__ __forceinline__ void rms_row_to_bf16(const float* xrow, const float* gain, bf16* orow, int lane) {
    const f32x4* xr = (const f32x4*)xrow + lane; const f32x4* gr = (const f32x4*)gain + lane;
    f32x4 v[4]; float s = 0.f;
#pragma unroll
    for (int j = 0; j < 4; ++j) { v[j] = xr[64 * j]; s += (v[j].x * v[j].x + v[j].y * v[j].y) + (v[j].z * v[j].z + v[j].w * v[j].w); }
    const float rstd = 1.0f / sqrtf(wave_sum(s) * (1.f / DM) + EPS);
    u32x2* o8 = (u32x2*)orow + lane;
#pragma unroll
    for (int j = 0; j < 4; ++j) { const f32x4 gg = gr[64 * j]; u32x2 w; w.x = cvtpk(v[j].x * rstd * gg.x, v[j].y * rstd * gg.y); w.y = cvtpk(v[j].z * rstd * gg.z, v[j].w * rstd * gg.w); o8[64 * j] = w; }
}

__device__ __forceinline__ void load64(const bf16* p, float (&d)[64]) {
    const u32x4* q = (const u32x4*)p;
#pragma unroll
    for (int i = 0; i < 8; ++i) { const u32x4 w = q[i]; d[8 * i + 0] = bflo(w.x); d[8 * i + 1] = bfhi(w.x); d[8 * i + 2] = bflo(w.y); d[8 * i + 3] = bfhi(w.y); d[8 * i + 4] = bflo(w.z); d[8 * i + 5] = bfhi(w.z); d[8 * i + 6] = bflo(w.w); d[8 * i + 7] = bfhi(w.w); }
}
__device__ __forceinline__ void store64(bf16* p, const float (&d)[64]) {
    u32x4* q = (u32x4*)p;
#pragma unroll
    for (int i = 0; i < 8; ++i) { u32x4 w; w.x = cvtpk(d[8 * i], d[8 * i + 1]); w.y = cvtpk(d[8 * i + 2], d[8 * i + 3]); w.z = cvtpk(d[8 * i + 4], d[8 * i + 5]); w.w = cvtpk(d[8 * i + 6], d[8 * i + 7]); q[i] = w; }
}
__device__ __forceinline__ float dothalf(const float (&a)[64], const bf16* p, int h) {
    const u32x4* q = (const u32x4*)(p + 32 * h); float s0 = 0.f, s1 = 0.f;
#pragma unroll
    for (int i = 0; i < 4; ++i) { const u32x4 w = q[i]; const int o = 32 * h + 8 * i;
        s0 += a[o] * bflo(w.x) + a[o + 2] * bflo(w.y) + a[o + 4] * bflo(w.z) + a[o + 6] * bflo(w.w);
        s1 += a[o + 1] * bfhi(w.x) + a[o + 3] * bfhi(w.y) + a[o + 5] * bfhi(w.z) + a[o + 7] * bfhi(w.w); }
    return s0 + s1;
}
__device__ __forceinline__ float dotbf(const float (&a)[64], const bf16* p) { return dothalf(a, p, 0) + dothalf(a, p, 1); }
__device__ __forceinline__ void axpy_bf(float (&acc)[64], float al, float pw, const bf16* vp) {
    const u32x4* q = (const u32x4*)vp;
#pragma unroll
    for (int i = 0; i < 8; ++i) { const u32x4 w = q[i]; const int o = 8 * i;
        acc[o] = acc[o] * al + pw * bflo(w.x); acc[o + 1] = acc[o + 1] * al + pw * bfhi(w.x); acc[o + 2] = acc[o + 2] * al + pw * bflo(w.y); acc[o + 3] = acc[o + 3] * al + pw * bfhi(w.y);
        acc[o + 4] = acc[o + 4] * al + pw * bflo(w.z); acc[o + 5] = acc[o + 5] * al + pw * bfhi(w.z); acc[o + 6] = acc[o + 6] * al + pw * bflo(w.w); acc[o + 7] = acc[o + 7] * al + pw * bfhi(w.w); }
}
__device__ __forceinline__ float dot64(const float (&a)[64], const float (&b)[64]) {
    float s0 = 0.f, s1 = 0.f, s2 = 0.f, s3 = 0.f;
#pragma unroll
    for (int i = 0; i < 64; i += 4) { s0 += a[i] * b[i]; s1 += a[i + 1] * b[i + 1]; s2 += a[i + 2] * b[i + 2]; s3 += a[i + 3] * b[i + 3]; }
    return (s0 + s1) + (s2 + s3);
}

__device__ __forceinline__ void naive_moba(const bf16* QA, const bf16* KA, const bf16* VA, const float* KMEAN, bf16* Y, int gw, int NGW, int lane_) {
    const int lane = opaque(lane_);
    for (int wi = gw; wi < (NB * 8 * SEQ) / 64; wi += NGW) {
        const int idx0 = wi * 64, bh = idx0 / SEQ, s0 = idx0 % SEQ, b = bh >> 3, h = bh & 7, s = s0 + lane, n = s0 >> 8;
        float q[64]; load64(QA + ((size_t)(b * SEQ + s)) * 512 + h * 64, q);
        float g0 = -3e38f, g1 = -3e38f, g2 = -3e38f; int i0 = -1, i1 = -1, i2 = -1;
        for (int j = 0; j < n; ++j) {
            const float* km = KMEAN + (((size_t)(b * 16 + j)) * 8 + h) * 64;
            float g = 0.f;
#pragma unroll
            for (int d = 0; d < 64; ++d) g += q[d] * km[d];
            if (g > g0) { g2 = g1; i2 = i1; g1 = g0; i1 = i0; g0 = g; i0 = j; }
            else if (g > g1) { g2 = g1; i2 = i1; g1 = g; i1 = j; }
            else if (g > g2) { g2 = g; i2 = j; }
        }
        unsigned mask = 0; if (i0 >= 0) mask |= 1u << i0; if (i1 >= 0) mask |= 1u << i1; if (i2 >= 0) mask |= 1u << i2;
        float m = -3e38f, l = 0.f, acc[64];
#pragma unroll
        for (int d = 0; d < 64; ++d) acc[d] = 0.f;
        for (int jb = 0; jb <= n; ++jb) {
            const bool act = (jb == n) || ((mask >> jb) & 1u);
            if (!__any(act)) continue;
            const int nk = (jb == n) ? (s0 + 64 - n * 256) : 256;
            for (int kk = 0; kk < nk; ++kk) {
                const int key = jb * 256 + kk;
                const float sc = dotbf(q, KA + ((size_t)(b * SEQ + key)) * 512 + h * 64);
                const bool valid = act && (key <= s);
                if (valid) {
                    const float mn = fmaxf(m, sc), al = __builtin_amdgcn_exp2f(m - mn), p = __builtin_amdgcn_exp2f(sc - mn);
                    l = l * al + p; m = mn;
                    axpy_bf(acc, al, p, VA + ((size_t)(b * SEQ + key)) * 512 + h * 64);
                }
            }
        }
        const float il = 1.0f / l;
#pragma unroll
        for (int d = 0; d < 64; ++d) acc[d] *= il;
        store64(Y + ((size_t)(b * SEQ + s)) * DM + h * 64, acc);
    }
}

__device__ __forceinline__ void naive_ret(const bf16* QR, const bf16* KR, const bf16* VR, const bf16* GR, const float* rgain, bf16* Y, int gw, int NGW, int lane_) {
    const int lane = opaque(lane_);
    for (int wi = gw; wi < (NB * 4 * SEQ) / 64; wi += NGW) {
        const int idx0 = wi * 64, bh = idx0 / SEQ, s0 = idx0 % SEQ, b = bh >> 2, h = bh & 3, s = s0 + lane;
        const float lg = log2f(1.0f - exp2f(-5.0f - (float)h));
        float q[64]; load64(QR + ((size_t)(b * SEQ + s)) * 256 + h * 64, q);
        float acc[64];
#pragma unroll
        for (int d = 0; d < 64; ++d) acc[d] = 0.f;
        int jlo = s0 - (int)(80.0f / (-lg)); if (jlo < 0) jlo = 0;
        for (int j = jlo; j < s0 + 64; ++j) {
            const float sc = dotbf(q, KR + ((size_t)(b * SEQ + j)) * 256 + h * 64);
            const float w = (j <= s) ? sc * __builtin_amdgcn_exp2f(lg * (float)(128 * ((s >> 7) - (j >> 7)))) : 0.f;
            axpy_bf(acc, 1.0f, w, VR + ((size_t)(b * SEQ + j)) * 256 + h * 64);
        }
        float ss = 0.f;
#pragma unroll
        for (int d = 0; d < 64; ++d) ss += acc[d] * acc[d];
        const float r = 1.0f / sqrtf(ss * (1.0f / 64.0f) + EPS);
        load64(GR + ((size_t)(b * SEQ + s)) * 256 + h * 64, q);
#pragma unroll
        for (int d = 0; d < 64; ++d) acc[d] = acc[d] * r * rgain[h * 64 + d] * q[d];
        store64(Y + ((size_t)(b * SEQ + s)) * DM + 512 + h * 64, acc);
    }
}

__device__ __forceinline__ void naive_mem(const bf16* QM, const bf16* MK, const bf16* MV, bf16* Y, int gw, int NGW, int lane_) {
    const int lane = opaque(lane_);
    for (int wi = gw; wi < (NB * 4 * SEQ) / 64; wi += NGW) {
        const int idx0 = wi * 64, bh = idx0 / SEQ, s0 = idx0 % SEQ, b = bh >> 2, h = bh & 3, s = s0 + lane;
        float q[64]; load64(QM + ((size_t)(b * SEQ + s)) * 256 + h * 64, q);
        float m = -3e38f, l = 0.f, acc[64];
#pragma unroll
        for (int d = 0; d < 64; ++d) acc[d] = 0.f;
        for (int j = 0; j < MEMLEN; ++j) {
            const float sc = dotbf(q, MK + ((size_t)(b * MEMLEN + j)) * 256 + h * 64);
            const float mn = fmaxf(m, sc), al = __builtin_amdgcn_exp2f(m - mn), p = __builtin_amdgcn_exp2f(sc - mn);
            l = l * al + p; m = mn;
            axpy_bf(acc, al, p, MV + ((size_t)(b * MEMLEN + j)) * 256 + h * 64);
        }
        const float il = 1.0f / l;
#pragma unroll
        for (int d = 0; d < 64; ++d) acc[d] *= il;
        store64(Y + ((size_t)(b * SEQ + s)) * DM + 768 + h * 64, acc);
    }
}


#include <hip/hip_bf16.h>
namespace attn_body {
using s16x4=__attribute__((ext_vector_type(4)))short;
using f32x16=__attribute__((ext_vector_type(16)))float;
constexpr int D=64,NW=8,QBLK=32,QB=QBLK*NW,KVBLK=64;
__device__ __forceinline__ int crow(int r,int hi){return (r&3)+8*(r>>2)+4*hi;}
#define SBAR() __builtin_amdgcn_sched_barrier(0)
__device__ __forceinline__ void cmask(f32x16&p0,f32x16&p1,int jb,int qrel,int hi){
  const float NEG=-INFINITY; int kb=64*jb+4*hi;
  #pragma unroll
  for(int r=0;r<16;++r){int kv=kb+(r&3)+8*(r>>2); if(kv>qrel)p0[r]=NEG; if(kv+32>qrel)p1[r]=NEG;}
}
constexpr int NSLOT=3, SLOTB=8192;
constexpr int LDS_K=0, LDS_V=NSLOT*SLOTB, LDS_WS=2*NSLOT*SLOTB, LDS_OST=LDS_WS+NW*64*4, ATT_LDS_BYTES=LDS_OST+NW*4096;
__device__ __forceinline__ void glds16(const void*gsrc,unsigned lds_dst){unsigned keep;
  asm volatile("s_mov_b32 %0, m0\n\ts_mov_b32 m0, %2\n\ts_nop 0\n\tglobal_load_lds_dwordx4 %1, off\n\ts_mov_b32 m0, %0":"=&s"(keep):"v"(gsrc),"s"(lds_dst):"memory");}
__device__ __forceinline__ float max3f(float a,float b,float c){float r;asm("v_max3_f32 %0, %1, %2, %3":"=v"(r):"v"(a),"v"(b),"v"(c));return r;}
__device__ __forceinline__ float max2f(float a,float b){float r;asm("v_max_f32_e32 %0, %1, %2":"=v"(r):"v"(a),"v"(b));return r;}
__device__ __forceinline__ float fadd_s(float a,float b){float r;asm("v_add_f32_e32 %0, %1, %2":"=v"(r):"v"(a),"v"(b));return r;}
__device__ __forceinline__ float fsub_s(float a,float b){float r;asm("v_sub_f32_e32 %0, %1, %2":"=v"(r):"v"(a),"v"(b));return r;}
__device__ __forceinline__ unsigned cvtpk_s(float lo,float hi){return cvtpk(lo,hi);}
#define WAIT_BAR(N) asm volatile("s_waitcnt vmcnt(" #N ") lgkmcnt(0)\n\ts_barrier":::"memory")
__device__ __forceinline__ void qkt(f32x16&p0,f32x16&p1,const char*Kslot,const bf16x8*qr,const f32x16&negm,int r32,int hi){
  const char*kb=Kslot+hi*1024+r32*16;
  #pragma unroll
  for(int d0=0;d0<4;++d0){
    const bf16x8 b0=*reinterpret_cast<const bf16x8*>(kb+d0*2048);
    const bf16x8 b1=*reinterpret_cast<const bf16x8*>(kb+d0*2048+512);
    if(d0==0){p0=__builtin_amdgcn_mfma_f32_32x32x16_bf16(b0,qr[0],negm,0,0,0);p1=__builtin_amdgcn_mfma_f32_32x32x16_bf16(b1,qr[0],negm,0,0,0);}
    else{p0=__builtin_amdgcn_mfma_f32_32x32x16_bf16(b0,qr[d0],p0,0,0,0);p1=__builtin_amdgcn_mfma_f32_32x32x16_bf16(b1,qr[d0],p1,0,0,0);}}
}
typedef __attribute__((address_space(3))) const char* lds_cptr;
typedef short v4i16_t __attribute__((ext_vector_type(4)));
__device__ __forceinline__ void kload8(bf16x8*kf,lds_cptr kp){
  kf[0]=*(const __attribute__((address_space(3))) bf16x8*)(kp);      kf[1]=*(const __attribute__((address_space(3))) bf16x8*)(kp+512);
  kf[2]=*(const __attribute__((address_space(3))) bf16x8*)(kp+2048); kf[3]=*(const __attribute__((address_space(3))) bf16x8*)(kp+2560);
  kf[4]=*(const __attribute__((address_space(3))) bf16x8*)(kp+4096); kf[5]=*(const __attribute__((address_space(3))) bf16x8*)(kp+4608);
  kf[6]=*(const __attribute__((address_space(3))) bf16x8*)(kp+6144); kf[7]=*(const __attribute__((address_space(3))) bf16x8*)(kp+6656);
}
__device__ __forceinline__ void kload2(bf16x8*kf,lds_cptr kp,int j){ kf[2*j]=*(const __attribute__((address_space(3))) bf16x8*)(kp+j*2048); kf[2*j+1]=*(const __attribute__((address_space(3))) bf16x8*)(kp+j*2048+512); }
__device__ __forceinline__ s16x4 vtr(lds_cptr p){ return __builtin_bit_cast(s16x4,__builtin_amdgcn_ds_read_tr16_b64_v4i16((__attribute__((address_space(3))) v4i16_t*)p)); }
__device__ __forceinline__ float rowmax(const f32x16&p0,const f32x16&p1){
  float a=max3f(p0[0],p0[1],p1[0]),b=max3f(p0[2],p0[3],p1[1]);a=max3f(a,p1[2],p1[3]);
  #pragma unroll
  for(int r=4;r<16;r+=4){a=max3f(a,p0[r],p0[r+1]);b=max3f(b,p0[r+2],p0[r+3]);a=max3f(a,p1[r],p1[r+1]);b=max3f(b,p1[r+2],p1[r+3]);}
  const float m=max2f(a,b);
  auto rr=__builtin_amdgcn_permlane32_swap(__float_as_uint(m),__float_as_uint(m),false,false);
  return max2f(__uint_as_float(rr[0]),__uint_as_float(rr[1]));
}
__device__ __forceinline__ void pv(f32x16*o,int vb,bf16x8 pa0,bf16x8 pa1,bf16x8 pa2,bf16x8 pa3){
  #pragma unroll
  for(int d0=0;d0<2;++d0){s16x4 lo[4],hi[4];
    #pragma unroll
    for(int ks=0;ks<4;++ks){
      asm volatile("ds_read_b64_tr_b16 %0,%1 offset:%c2":"=&v"(lo[ks]):"v"(vb),"i"(d0*4096+ks*1024):"memory");
      asm volatile("ds_read_b64_tr_b16 %0,%1 offset:%c2":"=&v"(hi[ks]):"v"(vb),"i"(d0*4096+ks*1024+512):"memory");}
    asm volatile("s_waitcnt lgkmcnt(0)":::"memory");SBAR();
    #define PK(k) (bf16x8){lo[k][0],lo[k][1],lo[k][2],lo[k][3],hi[k][0],hi[k][1],hi[k][2],hi[k][3]}
    o[d0]=__builtin_amdgcn_mfma_f32_32x32x16_bf16(pa0,PK(0),o[d0],0,0,0);
    o[d0]=__builtin_amdgcn_mfma_f32_32x32x16_bf16(pa1,PK(1),o[d0],0,0,0);
    o[d0]=__builtin_amdgcn_mfma_f32_32x32x16_bf16(pa2,PK(2),o[d0],0,0,0);
    o[d0]=__builtin_amdgcn_mfma_f32_32x32x16_bf16(pa3,PK(3),o[d0],0,0,0);
    #undef PK
  }
}
template<int THRL,int KP,int OP,bool MOBA> __device__ __forceinline__ void attn_unit(const bf16*Qu,const bf16*__restrict__ Kh,const bf16*__restrict__ Vh,bf16*Ou,const int NT,const int nblk,const float*kmean,char*shm){
  const int tid=opaque((int)threadIdx.x),lane=tid&63,r32=lane&31,hi=lane>>5; const int wid=__builtin_amdgcn_readfirstlane(tid>>6);
  const bf16*Qw=Qu+(long)(wid*QBLK)*KP;
  const unsigned lds0=(unsigned)(uintptr_t)shm;
  float*wsf=(float*)(shm+LDS_WS)+wid*64;
  const bf16*ksrc=Kh+(long)lane*KP+wid*8;
  const bf16*vsrc=Vh+(long)(16*(wid&3)+(lane>>2))*KP+(wid>>2)*32+(lane&3)*8;
  const unsigned kdst=lds0+LDS_K+wid*1024, vdst=lds0+LDS_V+wid*1024;
  #define DMA_K(t,slot) glds16(ksrc+(long)(t)*KVBLK*KP,(unsigned)__builtin_amdgcn_readfirstlane(kdst+(slot)))
  #define DMA_V(t,slot) glds16(vsrc+(long)(t)*KVBLK*KP,(unsigned)__builtin_amdgcn_readfirstlane(vdst+(slot)))
  const int vb0=(int)(lds0+LDS_V)+((lane>>4)&1)*32+(lane&3)*8+(4*hi+((lane&15)>>2))*64;
  const char*Kbase=shm+LDS_K; bf16x8 kf[8];
  const lds_cptr shm3=(lds_cptr)shm; const lds_cptr kp0=shm3+LDS_K+hi*1024+r32*16; const lds_cptr vp0=shm3+LDS_V+((lane>>4)&1)*32+(lane&3)*8+(4*hi+((lane&15)>>2))*64;
  DMA_K(0,0);DMA_V(0,0);DMA_K(1,SLOTB);
  bf16x8 qr[4];
  #pragma unroll
  for(int d0=0;d0<4;++d0)qr[d0]=*reinterpret_cast<const bf16x8*>(&Qw[(long)r32*KP+d0*16+hi*8]);
  unsigned bmask=0xffffffffu;
  if(MOBA){
    bmask=1u<<nblk;
    float g0=-3e38f,g1=-3e38f,g2=-3e38f; int i0=-1,i1=-1,i2=-1;
    for(int j=0;j<nblk;++j){
      const float*km=kmean+(long)j*512+8*hi; float g=0.f;
      #pragma unroll
      for(int d0=0;d0<4;++d0){ const f32x4 a=*(const f32x4*)(km+16*d0),b=*(const f32x4*)(km+16*d0+4);
        g+=bf2f((unsigned short)qr[d0][0])*a[0]+bf2f((unsigned short)qr[d0][1])*a[1]+bf2f((unsigned short)qr[d0][2])*a[2]+bf2f((unsigned short)qr[d0][3])*a[3];
        g+=bf2f((unsigned short)qr[d0][4])*b[0]+bf2f((unsigned short)qr[d0][5])*b[1]+bf2f((unsigned short)qr[d0][6])*b[2]+bf2f((unsigned short)qr[d0][7])*b[3]; }
      g+=__shfl_xor(g,32);
      if(g>g0){g2=g1;i2=i1;g1=g0;i1=i0;g0=g;i0=j;} else if(g>g1){g2=g1;i2=i1;g1=g;i1=j;} else if(g>g2){g2=g;i2=j;}
    }
    if(i0>=0)bmask|=1u<<i0; if(i1>=0)bmask|=1u<<i1; if(i2>=0)bmask|=1u<<i2;
  }
  #define NEGM_FOR(t) (MOBA ? (((bmask>>((t)>>2))&1u) ? -mhat : -INFINITY) : -mhat)
  float mhat=0.f,l_reg=0.f;f32x16 o[2];o[0]=f32x16{};o[1]=f32x16{};f32x16 negm;
  { const float nm=NEGM_FOR(0);
    #pragma unroll
    for(int r=0;r<16;++r)negm[r]=nm; }
  asm volatile("":"+v"(negm));
  const int qrel=wid*QBLK+r32;
  #define CMASK(P0,P1,t) do{ if(MOBA){int jb_=(t)-(NT-4); if(jb_>=0)cmask(P0,P1,jb_,qrel,hi);} }while(0)
  bool resc=false;
  #define START(P0,P1) do{ const float rm=rowmax(P0,P1); resc=false; \
    { const float dl=(MOBA&&rm==-INFINITY)?0.f:rm; mhat=fadd_s(mhat,dl); \
      _Pragma("unroll") for(int r=0;r<16;++r){P0[r]=fsub_s(P0[r],dl);P1[r]=fsub_s(P1[r],dl);} \
      { const float nm=NEGM_FOR(1); _Pragma("unroll") for(int r=0;r<16;++r)negm[r]=nm; } asm volatile("":"+v"(negm)); } \
    _Pragma("unroll") for(int r=0;r<16;++r)P0[r]=__builtin_amdgcn_exp2f(P0[r]); }while(0)
  #define RESC() do{ if(resc){ asm volatile("s_waitcnt lgkmcnt(0)":::"memory"); \
      _Pragma("unroll") for(int d_=0;d_<2;++d_) _Pragma("unroll") for(int r=0;r<16;++r)o[d_][r]*=wsf[crow(r,hi)]; } }while(0)
  f32x16 pA0,pA1,pB0,pB1;
  int sl_prev=0,sl_cur=0,sl_next=SLOTB;
  #define ROT() do{sl_prev=sl_cur;sl_cur=sl_next;sl_next=(sl_next==(NSLOT-1)*SLOTB)?0:sl_next+SLOTB;}while(0)
  DMA_K(2,2*SLOTB);
  WAIT_BAR(3);
  qkt(pA0,pA1,Kbase,qr,negm,r32,hi);asm volatile("s_nop 15\n\ts_nop 7":"+v"(pA0),"+v"(pA1));CMASK(pA0,pA1,0);
  START(pA0,pA1);
  _Pragma("unroll") for(int r=0;r<16;++r)pA1[r]=__builtin_amdgcn_exp2f(pA1[r]);
  WAIT_BAR(0);
  DMA_K(3,0);DMA_V(1,SLOTB);
  ROT();
  kload8(kf,kp0+sl_cur);
  WAIT_BAR(2);
  s16x4 vlo[8],vhi[8]; u32x4 pw0,pw1,pw2,pw3;
  #define PKW(P,B) cvtpk_s(P[B],P[B+1])
  #define PAF(k) __builtin_bit_cast(bf16x8,pw##k)
  #define VFR(i) (bf16x8){vlo[i][0],vlo[i][1],vlo[i][2],vlo[i][3],vhi[i][0],vhi[i][1],vhi[i][2],vhi[i][3]}
  #define PIN(x) asm volatile("":"+v"(x))
  #define MX3(a,b,c) __builtin_fmaxf(__builtin_fmaxf((a),(b)),(c))
  #define GAPA(MF,A0,A1,A2,A3,W0,W1,PW) do{ MF; sacc+=A0; sacc+=A1; sacc+=A2; sacc+=A3; PIN(sacc); W0; W1; PIN(PW); SBAR(); }while(0)
  #define EX(v) __builtin_amdgcn_exp2f(v)
  #define GAPB(MF,X,B) do{ MF; X[B]=EX(X[B]); X[B+1]=EX(X[B+1]); X[B+2]=EX(X[B+2]); X[B+3]=EX(X[B+3]); PIN(X); SBAR(); }while(0)
  #define VRD(i) do{ vlo[i]=vtr(vp_+(((i)>>2)*4096+((i)&3)*1024)); vhi[i]=vtr(vp_+(((i)>>2)*4096+((i)&3)*1024+512)); }while(0)
  #define KRD(G,j) do{ if(G){ kload2(kf,kp0+sl_next,j); SBAR(); } }while(0)
  #define STEP(C0,C1,P0,P1,t,GK,GV,GL) do{ SBAR(); \
    const lds_cptr vp_=vp0+sl_prev; \
    VRD(0); SBAR(); float sacc=(P0[0]+P0[1]); \
    GAPA(C0=__builtin_amdgcn_mfma_f32_32x32x16_bf16(kf[0],qr[0],negm,0,0,0), P0[2],P0[3],P0[4],P0[5],     pw0[0]=PKW(P0,0), pw0[1]=PKW(P0,2), pw0); \
    VRD(4); SBAR(); GAPA(C1=__builtin_amdgcn_mfma_f32_32x32x16_bf16(kf[1],qr[0],negm,0,0,0), P0[6],P0[7],P0[8],P0[9],     pw0[2]=PKW(P0,4), pw0[3]=PKW(P0,6), pw0); \
    VRD(1); SBAR(); GAPA(C0=__builtin_amdgcn_mfma_f32_32x32x16_bf16(kf[2],qr[1],C0,0,0,0),   P0[10],P0[11],P0[12],P0[13], pw1[0]=PKW(P0,8), pw1[1]=PKW(P0,10), pw1); \
    VRD(5); SBAR(); GAPA(C1=__builtin_amdgcn_mfma_f32_32x32x16_bf16(kf[3],qr[1],C1,0,0,0),   P0[14],P0[15],P1[0],P1[1],   pw1[2]=PKW(P0,12),pw1[3]=PKW(P0,14), pw1); \
    VRD(2); SBAR(); GAPA(C0=__builtin_amdgcn_mfma_f32_32x32x16_bf16(kf[4],qr[2],C0,0,0,0),   P1[2],P1[3],P1[4],P1[5],     pw2[0]=PKW(P1,0), pw2[1]=PKW(P1,2), pw2); \
    VRD(6); SBAR(); GAPA(C1=__builtin_amdgcn_mfma_f32_32x32x16_bf16(kf[5],qr[2],C1,0,0,0),   P1[6],P1[7],P1[8],P1[9],     pw2[2]=PKW(P1,4), pw2[3]=PKW(P1,6), pw2); \
    VRD(3); SBAR(); GAPA(C0=__builtin_amdgcn_mfma_f32_32x32x16_bf16(kf[6],qr[3],C0,0,0,0),   P1[10],P1[11],P1[12],P1[13], pw3[0]=PKW(P1,8), pw3[1]=PKW(P1,10), pw3); \
    VRD(7); SBAR(); GAPA(C1=__builtin_amdgcn_mfma_f32_32x32x16_bf16(kf[7],qr[3],C1,0,0,0),   P1[14],P1[15],0.f,0.f,       pw3[2]=PKW(P1,12),pw3[3]=PKW(P1,14), pw3); \
    l_reg+=sacc; \
    if(GK){DMA_K((t)+3,sl_cur);} if(GV){DMA_V((t)+1,sl_next);} \
    CMASK(C0,C1,t); \
    { float a=MX3(C0[0],C0[1],C1[0]),b=MX3(C0[2],C0[3],C1[1]); a=MX3(a,C1[2],C1[3]); \
      _Pragma("unroll") for(int r=4;r<16;r+=4){a=MX3(a,C0[r],C0[r+1]);b=MX3(b,C0[r+2],C0[r+3]);a=MX3(a,C1[r],C1[r+1]);b=MX3(b,C1[r+2],C1[r+3]);} \
      float rm=__builtin_fmaxf(a,b); { auto rr=__builtin_amdgcn_permlane32_swap(__float_as_uint(rm),__float_as_uint(rm),false,false); rm=__builtin_fmaxf(__uint_as_float(rr[0]),__uint_as_float(rr[1])); } \
      resc=false; \
      if(__builtin_expect(__any(rm>(float)THRL),0)){ const float dl=__builtin_fmaxf(rm,0.f); mhat+=dl; \
        _Pragma("unroll") for(int r=0;r<16;++r){C0[r]-=dl;C1[r]-=dl;} \
        if(!MOBA){ _Pragma("unroll") for(int r=0;r<16;++r)negm[r]=-mhat; asm volatile("":"+v"(negm)); } \
        const float f=__builtin_amdgcn_exp2f(-dl); l_reg*=f; if(hi==0)wsf[r32]=f; resc=true; } \
      if(MOBA){ const float nm=NEGM_FOR((t)+1); _Pragma("unroll") for(int r=0;r<16;++r)negm[r]=nm; asm volatile("":"+v"(negm)); } } \
    SBAR(); \
    GAPB(o[0]=__builtin_amdgcn_mfma_f32_32x32x16_bf16(PAF(0),VFR(0),o[0],0,0,0), C0,0); \
    GAPB(o[1]=__builtin_amdgcn_mfma_f32_32x32x16_bf16(PAF(0),VFR(4),o[1],0,0,0), C0,4); \
    KRD(GL,0); GAPB(o[0]=__builtin_amdgcn_mfma_f32_32x32x16_bf16(PAF(1),VFR(1),o[0],0,0,0), C0,8); \
    KRD(GL,1); GAPB(o[1]=__builtin_amdgcn_mfma_f32_32x32x16_bf16(PAF(1),VFR(5),o[1],0,0,0), C0,12); \
    KRD(GL,2); GAPB(o[0]=__builtin_amdgcn_mfma_f32_32x32x16_bf16(PAF(2),VFR(2),o[0],0,0,0), C1,0); \
    KRD(GL,3); GAPB(o[1]=__builtin_amdgcn_mfma_f32_32x32x16_bf16(PAF(2),VFR(6),o[1],0,0,0), C1,4); \
    GAPB(o[0]=__builtin_amdgcn_mfma_f32_32x32x16_bf16(PAF(3),VFR(3),o[0],0,0,0), C1,8); \
    GAPB(o[1]=__builtin_amdgcn_mfma_f32_32x32x16_bf16(PAF(3),VFR(7),o[1],0,0,0), C1,12); \
    }while(0)
  int t=1;
  #undef CMASK
  #define CMASK(P0,P1,t) do{}while(0)
  for(;t+5<NT;t+=2){
    STEP(pB0,pB1,pA0,pA1,t,true,true,true);     WAIT_BAR(2); RESC(); ROT();
    STEP(pA0,pA1,pB0,pB1,t+1,true,true,true);   WAIT_BAR(2); RESC(); ROT();
  }
  #undef CMASK
  #define CMASK(P0,P1,t) do{ if(MOBA){int jb_=(t)-(NT-4); if(jb_>=0)cmask(P0,P1,jb_,qrel,hi);} }while(0)
  #define ENDW(tt) do{ if((tt)+3<NT){WAIT_BAR(2);} else if((tt)+2<NT){WAIT_BAR(1);} else {WAIT_BAR(0);} }while(0)
  for(;t+1<NT;t+=2){
    STEP(pB0,pB1,pA0,pA1,t,(t+3<NT),(t+1<NT),(t+1<NT));       ENDW(t);   RESC(); ROT();
    STEP(pA0,pA1,pB0,pB1,t+1,(t+4<NT),(t+2<NT),(t+2<NT));     ENDW(t+1); RESC(); ROT();
  }
  STEP(pB0,pB1,pA0,pA1,NT-1,false,false,false); RESC();
  { float sacc=pB0[0]+pB0[1]; _Pragma("unroll") for(int r=2;r<16;++r)sacc+=pB0[r]; _Pragma("unroll") for(int r=0;r<16;++r)sacc+=pB1[r]; l_reg+=sacc;
    pw0=(u32x4){PKW(pB0,0),PKW(pB0,2),PKW(pB0,4),PKW(pB0,6)};pw1=(u32x4){PKW(pB0,8),PKW(pB0,10),PKW(pB0,12),PKW(pB0,14)};pw2=(u32x4){PKW(pB1,0),PKW(pB1,2),PKW(pB1,4),PKW(pB1,6)};pw3=(u32x4){PKW(pB1,8),PKW(pB1,10),PKW(pB1,12),PKW(pB1,14)};
    SBAR(); pv(o,vb0+sl_cur,PAF(0),PAF(1),PAF(2),PAF(3)); }
  #undef PKW
  #undef PAF
  #undef VFR
  #undef PIN
  #undef MX3
  #undef GAPA
  #undef GAPB
  #undef EX
  #undef VRD
  #undef KRD
  #undef STEP
  #undef ENDW
  {auto rr=__builtin_amdgcn_permlane32_swap(__float_as_uint(l_reg),__float_as_uint(l_reg),false,false);l_reg=__uint_as_float(rr[0])+__uint_as_float(rr[1]);}
  if(hi==0)wsf[32+r32]=l_reg;asm volatile("s_waitcnt lgkmcnt(0)":::"memory");
  float rli[16];
  #pragma unroll
  for(int r=0;r<16;++r)rli[r]=__builtin_amdgcn_rcpf(wsf[32+crow(r,hi)]);
  bf16*Ow=Ou+(long)(wid*QBLK)*OP;
  { bf16*stg=(bf16*)(shm+LDS_OST)+wid*2048;
    #pragma unroll
    for(int r=0;r<16;++r){const int orow=crow(r,hi);
      #pragma unroll
      for(int d0=0;d0<2;++d0)stg[orow*64+d0*32+r32]=(bf16)(cvtpk(o[d0][r]*rli[r],0.f)&0xffffu);}
    asm volatile("s_waitcnt lgkmcnt(0)":::"memory");
    #pragma unroll
    for(int i=0;i<4;++i){const int row=i*8+(lane>>3),ch=lane&7; const u32x4 v=*(const u32x4*)(stg+row*64+ch*8); *(u32x4*)(Ow+(long)row*OP+ch*8)=v;} }
  asm volatile("s_waitcnt lgkmcnt(0)\n\ts_barrier":::"memory");
  #undef DMA_K
  #undef DMA_V
  #undef CMASK
  #undef START
  #undef RESC
  #undef ROT
  #undef NEGM_FOR
}
#undef SBAR
#undef WAIT_BAR
}

namespace ret_body {
using attn_body::s16x4; using attn_body::f32x16; using attn_body::glds16; using attn_body::pv; using attn_body::crow;
constexpr int KVF_BYTES = 64 * 64 * 4;
__device__ __forceinline__ void kv_unit(const bf16* KR, const bf16* VR, float* KVF, int b, int h, int cp, char* shm) {
  const int tid = opaque((int)threadIdx.x), lane = tid & 63, r32 = lane & 31, hi = lane >> 5; const int wid = __builtin_amdgcn_readfirstlane(tid >> 6);
  const unsigned lds0 = (unsigned)(uintptr_t)shm;
  const size_t rowb = (size_t)b * SEQ + (size_t)cp * 256;
  const long voff = (long)(16 * (wid & 3) + (lane >> 2)) * 256 + h * 64 + (wid >> 2) * 32 + (lane & 3) * 8;
#pragma unroll
  for (int c = 0; c < 2; ++c)
#pragma unroll
    for (int tl = 0; tl < 2; ++tl) {
      const size_t r0 = rowb + c * 128 + tl * 64;
      glds16(KR + r0 * 256 + voff, (unsigned)__builtin_amdgcn_readfirstlane(lds0 + ((c * 2 + 0) * 2 + tl) * 8192 + wid * 1024));
      glds16(VR + r0 * 256 + voff, (unsigned)__builtin_amdgcn_readfirstlane(lds0 + ((c * 2 + 1) * 2 + tl) * 8192 + wid * 1024));
    }
  asm volatile("s_waitcnt vmcnt(0) lgkmcnt(0)\n\ts_barrier" ::: "memory");
  const int c = wid >> 2, dkb = (wid >> 1) & 1, dvb = wid & 1;
  const int vb = (int)lds0 + ((lane >> 4) & 1) * 32 + (lane & 3) * 8 + (4 * hi + ((lane & 15) >> 2)) * 64;
  f32x16 acc = f32x16{};
#pragma unroll
  for (int tl = 0; tl < 2; ++tl) {
    s16x4 alo[4], ahi[4], blo[4], bhi[4];
    const int ka = vb + ((c * 2 + 0) * 2 + tl) * 8192 + dkb * 4096, va = vb + ((c * 2 + 1) * 2 + tl) * 8192 + dvb * 4096;
#pragma unroll
    for (int ks = 0; ks < 4; ++ks) {
      asm volatile("ds_read_b64_tr_b16 %0,%1 offset:%c2" : "=&v"(alo[ks]) : "v"(ka), "i"(ks * 1024) : "memory");
      asm volatile("ds_read_b64_tr_b16 %0,%1 offset:%c2" : "=&v"(ahi[ks]) : "v"(ka), "i"(ks * 1024 + 512) : "memory");
      asm volatile("ds_read_b64_tr_b16 %0,%1 offset:%c2" : "=&v"(blo[ks]) : "v"(va), "i"(ks * 1024) : "memory");
      asm volatile("ds_read_b64_tr_b16 %0,%1 offset:%c2" : "=&v"(bhi[ks]) : "v"(va), "i"(ks * 1024 + 512) : "memory");
    }
    asm volatile("s_waitcnt lgkmcnt(0)" ::: "memory"); __builtin_amdgcn_sched_barrier(0);
#pragma unroll
    for (int ks = 0; ks < 4; ++ks) {
      const bf16x8 af = (bf16x8){alo[ks][0], alo[ks][1], alo[ks][2], alo[ks][3], ahi[ks][0], ahi[ks][1], ahi[ks][2], ahi[ks][3]};
      const bf16x8 bfr = (bf16x8){blo[ks][0], blo[ks][1], blo[ks][2], blo[ks][3], bhi[ks][0], bhi[ks][1], bhi[ks][2], bhi[ks][3]};
      acc = __builtin_amdgcn_mfma_f32_32x32x16_bf16(af, bfr, acc, 0, 0, 0);
    }
  }
  const float lgam = __builtin_amdgcn_logf(1.0f - __builtin_amdgcn_exp2f(-5.0f - (float)h));
  const float g127 = __builtin_amdgcn_exp2f(lgam * 127.0f);
  float* outp = KVF + ((size_t)((b * 4 + h) * 32 + cp * 2 + c)) * 4096 + dvb * 32 + r32;
#pragma unroll
  for (int r = 0; r < 16; ++r) outp[(size_t)(dkb * 32 + crow(r, hi)) * 64] = acc[r] * g127;
  asm volatile("s_waitcnt lgkmcnt(0)\n\ts_barrier" ::: "memory");
}

__device__ __forceinline__ void out_unit(const bf16* QR, const bf16* KR, const bf16* VR, const bf16* GR, const float* KVF, const float* rgain, bf16* Y, int b, int h, int cp, char* shm) {
  const int tid = opaque((int)threadIdx.x), lane = tid & 63, r32 = lane & 31, hi = lane >> 5; const int wid = __builtin_amdgcn_readfirstlane(tid >> 6);
  const unsigned lds0 = (unsigned)(uintptr_t)shm;
  constexpr int L_K = 0, L_V = 32768, L_S = 65536, L_O = 81920;
  const size_t rowb = (size_t)b * SEQ + (size_t)cp * 256;
  const long koff = (long)lane * 256 + h * 64 + wid * 8;
  const long voff = (long)(16 * (wid & 3) + (lane >> 2)) * 256 + h * 64 + (wid >> 2) * 32 + (lane & 3) * 8;
#pragma unroll
  for (int tl = 0; tl < 4; ++tl) {
    const size_t r0 = rowb + tl * 64;
    glds16(KR + r0 * 256 + koff, (unsigned)__builtin_amdgcn_readfirstlane(lds0 + L_K + tl * 8192 + wid * 1024));
    glds16(VR + r0 * 256 + voff, (unsigned)__builtin_amdgcn_readfirstlane(lds0 + L_V + tl * 8192 + wid * 1024));
  }
  {
    const float lgam = __builtin_amdgcn_logf(1.0f - __builtin_amdgcn_exp2f(-5.0f - (float)h));
    const float lgc = lgam * 128.0f;
    const int n0 = 2 * cp;
    int mlo = n0 - 1 - (int)(34.0f / (-lgc)); if (mlo < 0) mlo = 0;
    const float* kvp = KVF + ((size_t)((b * 4 + h) * 32)) * 4096 + tid * 8;
    f32x4 s0 = {0.f, 0.f, 0.f, 0.f}, s1 = {0.f, 0.f, 0.f, 0.f};
    for (int m = mlo; m < n0; ++m) {
      const float w = __builtin_amdgcn_exp2f(lgc * (float)(n0 - 1 - m));
      const f32x4 a = *(const f32x4*)(kvp + (size_t)m * 4096), c4 = *(const f32x4*)(kvp + (size_t)m * 4096 + 4);
      s0 += a * w; s1 += c4 * w;
    }
    const int dk = tid >> 3, dv = 8 * (tid & 7);
    char* sp = shm + L_S + (dv >> 5) * 4096 + dk * 64 + (dv & 31) * 2;
    u32x4 w0; w0.x = cvtpk(s0[0], s0[1]); w0.y = cvtpk(s0[2], s0[3]); w0.z = cvtpk(s1[0], s1[1]); w0.w = cvtpk(s1[2], s1[3]);
    *(u32x4*)sp = w0;
    const float dc = __builtin_amdgcn_exp2f(lgc);
    const f32x4 a = *(const f32x4*)(kvp + (size_t)n0 * 4096), c4 = *(const f32x4*)(kvp + (size_t)n0 * 4096 + 4);
    s0 = s0 * dc + a; s1 = s1 * dc + c4;
    u32x4 w1; w1.x = cvtpk(s0[0], s0[1]); w1.y = cvtpk(s0[2], s0[3]); w1.z = cvtpk(s1[0], s1[1]); w1.w = cvtpk(s1[2], s1[3]);
    *(u32x4*)(sp + 8192) = w1;
  }
  const int c = wid >> 2, wq = wid & 3;
  const bf16* Qw = QR + (rowb + c * 128 + wq * 32 + r32) * 256 + h * 64;
  bf16x8 qr[4]; u32x4 qa[4];
#pragma unroll
  for (int d0 = 0; d0 < 4; ++d0) qr[d0] = *reinterpret_cast<const bf16x8*>(Qw + d0 * 16 + hi * 8);
#pragma unroll
  for (int k = 0; k < 4; ++k) { const u32x2 lo = *(const u32x2*)(Qw + 16 * k + 4 * hi), hi2 = *(const u32x2*)(Qw + 16 * k + 8 + 4 * hi); qa[k] = (u32x4){lo.x, lo.y, hi2.x, hi2.y}; }
  asm volatile("s_waitcnt vmcnt(0) lgkmcnt(0)\n\ts_barrier" ::: "memory");
  const int vb = (int)lds0 + ((lane >> 4) & 1) * 32 + (lane & 3) * 8 + (4 * hi + ((lane & 15) >> 2)) * 64;
  f32x16 o[2]; o[0] = f32x16{}; o[1] = f32x16{};
  pv(o, vb + L_S + c * 8192, __builtin_bit_cast(bf16x8, qa[0]), __builtin_bit_cast(bf16x8, qa[1]), __builtin_bit_cast(bf16x8, qa[2]), __builtin_bit_cast(bf16x8, qa[3]));
  { const float gam = 1.0f - __builtin_amdgcn_exp2f(-5.0f - (float)h);
#pragma unroll
    for (int d0 = 0; d0 < 2; ++d0)
#pragma unroll
      for (int r = 0; r < 16; ++r) o[d0][r] *= gam; }
  const f32x16 zero = f32x16{};
  const int irow = wq * 32 + r32;
  for (int tl = 0; tl <= (wq >> 1); ++tl) {
    f32x16 p0, p1;
    attn_body::qkt(p0, p1, shm + L_K + (c * 2 + tl) * 8192, qr, zero, r32, hi);
    asm volatile("s_nop 15\n\ts_nop 7" : "+v"(p0), "+v"(p1));
#pragma unroll
    for (int r = 0; r < 16; ++r) { const int kj = 64 * tl + crow(r, hi); if (kj > irow) p0[r] = 0.f; if (kj + 32 > irow) p1[r] = 0.f; }
    u32x4 pw0, pw1, pw2, pw3;
    pw0 = (u32x4){cvtpk(p0[0], p0[1]), cvtpk(p0[2], p0[3]), cvtpk(p0[4], p0[5]), cvtpk(p0[6], p0[7])}; pw1 = (u32x4){cvtpk(p0[8], p0[9]), cvtpk(p0[10], p0[11]), cvtpk(p0[12], p0[13]), cvtpk(p0[14], p0[15])};
    pw2 = (u32x4){cvtpk(p1[0], p1[1]), cvtpk(p1[2], p1[3]), cvtpk(p1[4], p1[5]), cvtpk(p1[6], p1[7])}; pw3 = (u32x4){cvtpk(p1[8], p1[9]), cvtpk(p1[10], p1[11]), cvtpk(p1[12], p1[13]), cvtpk(p1[14], p1[15])};
    __builtin_amdgcn_sched_barrier(0);
    pv(o, vb + L_V + (c * 2 + tl) * 8192, __builtin_bit_cast(bf16x8, pw0), __builtin_bit_cast(bf16x8, pw1), __builtin_bit_cast(bf16x8, pw2), __builtin_bit_cast(bf16x8, pw3));
  }
  asm volatile("s_waitcnt lgkmcnt(0)\n\ts_barrier" ::: "memory");
  { float* stg = (float*)(shm + L_O) + wid * 2048;
#pragma unroll
    for (int r = 0; r < 16; ++r) { const int orow = crow(r, hi);
#pragma unroll
      for (int d0 = 0; d0 < 2; ++d0) stg[orow * 64 + d0 * 32 + r32] = o[d0][r]; }
    asm volatile("s_waitcnt lgkmcnt(0)" ::: "memory");
    const int row = lane >> 1, half = lane & 1;
    const f32x4* sr = (const f32x4*)(stg + row * 64 + half * 32);
    f32x4 v[8]; float ss = 0.f;
#pragma unroll
    for (int i = 0; i < 8; ++i) { v[i] = sr[i]; ss += (v[i][0] * v[i][0] + v[i][1] * v[i][1]) + (v[i][2] * v[i][2] + v[i][3] * v[i][3]); }
    ss += __shfl_xor(ss, 1);
    const float rstd = 1.0f / sqrtf(ss * (1.0f / 64.0f) + EPS);
    const size_t grow = rowb + c * 128 + wq * 32 + row;
    const u32x4* gp = (const u32x4*)(GR + grow * 256 + h * 64 + half * 32);
    const f32x4* rg = (const f32x4*)(rgain + h * 64 + half * 32);
    u32x4* yp = (u32x4*)(Y + grow * DM + 512 + h * 64 + half * 32);
#pragma unroll
    for (int i = 0; i < 4; ++i) {
      const u32x4 gw = gp[i]; const f32x4 g0 = rg[2 * i], g1 = rg[2 * i + 1]; const f32x4 a = v[2 * i] * rstd * g0, c4 = v[2 * i + 1] * rstd * g1;
      u32x4 w; w.x = cvtpk(a[0] * bflo(gw.x), a[1] * bfhi(gw.x)); w.y = cvtpk(a[2] * bflo(gw.y), a[3] * bfhi(gw.y)); w.z = cvtpk(c4[0] * bflo(gw.z), c4[1] * bfhi(gw.z)); w.w = cvtpk(c4[2] * bflo(gw.w), c4[3] * bfhi(gw.w));
      yp[i] = w;
    }
  }
  asm volatile("s_waitcnt lgkmcnt(0)\n\ts_barrier" ::: "memory");
}
}

#define XB_TMO      128
#define XB_XCNT(j)  (256  + 64 * (j))
#define XB_XSUB(j)  (1280 + 64 * (j))
#define XB_XGEN(j)  (2304 + 64 * (j))
#define XB_TOP      3328
#define XB_TOPGEN   3392
#define XCD_BAR_WORDS 3456
#define XB_SPIN_CAP (1u << 18)
__device__ __forceinline__ unsigned xb_ld(unsigned* p)              { return __hip_atomic_load(p, __ATOMIC_RELAXED, __HIP_MEMORY_SCOPE_AGENT); }
__device__ __forceinline__ unsigned xb_add(unsigned* p, unsigned v) { return __hip_atomic_fetch_add(p, v, __ATOMIC_RELAXED, __HIP_MEMORY_SCOPE_AGENT); }
__device__ __forceinline__ unsigned xb_xcc_id() { return (unsigned)__builtin_amdgcn_s_getreg((3 << 11) | 20) & 0xFu; }
#define XB_SPIN(cond, bar) do { unsigned _sp = 0; while (cond) { __builtin_amdgcn_s_sleep(1); \
    if ((++_sp & 255u) == 0u) { if (xb_ld(&(bar)[XB_TMO])) break; if (_sp > XB_SPIN_CAP) { atomicAdd(&(bar)[XB_TMO], 1u); break; } } } } while (0)
struct XcdBarrier { unsigned* bar; unsigned x; volatile LAS unsigned* st; };
__device__ __forceinline__ XcdBarrier xcd_barrier_post(unsigned* bar, volatile LAS unsigned* st) {
    XcdBarrier b; b.bar = bar; b.x = xb_xcc_id(); b.st = st;
    if (threadIdx.x == 0) (void)xb_add(&bar[XB_XCNT(b.x)], 1u);
    return b;
}
__device__ __forceinline__ void xcd_barrier_complete(unsigned* bar, unsigned x, unsigned& nloc, unsigned& nx) {
    const unsigned G = gridDim.x * gridDim.y * gridDim.z;
    unsigned sum, cnt, mine, sp = 0u;
    for (;;) {
        sum = 0u; cnt = 0u; mine = 0u;
#pragma unroll
        for (unsigned j = 0; j < 16; ++j) { const unsigned c = xb_ld(&bar[XB_XCNT(j)]); sum += c; cnt += (c > 0u) ? 1u : 0u; mine = (j == x) ? c : mine; }
        if (sum == G) break;
        __builtin_amdgcn_s_sleep(1);
        if ((++sp & 255u) == 0u) { if (xb_ld(&bar[XB_TMO])) break; if (sp > XB_SPIN_CAP) { atomicAdd(&bar[XB_TMO], 1u); break; } }
    }
    nloc = mine > 0u ? mine : 1u; nx = cnt > 0u ? cnt : 1u;
}
__device__ __forceinline__ void xcd_barrier(const XcdBarrier& b) {
    asm volatile("s_waitcnt vmcnt(0)" ::: "memory");
    __syncthreads();
    if (threadIdx.x == 0) {
        unsigned* bar = b.bar;
        __builtin_amdgcn_s_waitcnt(0);
        unsigned nloc = b.st[0], nx = b.st[1];
        if (nloc == 0u) { xcd_barrier_complete(bar, b.x, nloc, nx); b.st[0] = nloc; b.st[1] = nx; }
        const unsigned old = xb_add(&bar[XB_XSUB(b.x)], 1u);
        const unsigned gen = old / nloc;
        if (old + 1u == (gen + 1u) * nloc) {
            __builtin_amdgcn_fence(__ATOMIC_RELEASE, "agent");
            asm volatile("s_waitcnt vmcnt(0)" ::: "memory");
            const unsigned og = xb_add(&bar[XB_TOP], 1u);
            const unsigned tg = og / nx;
            if (og + 1u == (tg + 1u) * nx) xb_add(&bar[XB_TOPGEN], 1u);
            else XB_SPIN(xb_ld(&bar[XB_TOPGEN]) == tg, bar);
            __builtin_amdgcn_fence(__ATOMIC_ACQUIRE, "agent");
            xb_add(&bar[XB_XGEN(b.x)], 1u);
            asm volatile("s_waitcnt vmcnt(0)" ::: "memory");
        } else {
            XB_SPIN(xb_ld(&bar[XB_XGEN(b.x)]) == gen, bar);
            __builtin_amdgcn_fence(__ATOMIC_ACQUIRE, "agent");
            asm volatile("s_waitcnt vmcnt(0)" ::: "memory");
        }
    }
    __syncthreads();
}

__global__ void __launch_bounds__(NTHREADS, 2) fwd_kernel(Args args) {
    extern __shared__ __attribute__((aligned(16))) unsigned char lds_raw[];
    LAS unsigned char* lds = (LAS unsigned char*)lds_raw;
    cg::grid_group grid = cg::this_grid();
    const int tid0 = threadIdx.x, wave = __builtin_amdgcn_readfirstlane(tid0 >> 6);
#define PHASE_LANES const int tid = opaque(tid0), lane = tid & 63; (void)lane; (void)tid
    const int G = gridDim.x, bx = blockIdx.x;
    const int vcu = (G % 8 == 0) ? (bx % 8) * (G / 8) + bx / 8 : bx;
    const int gw = vcu * NWAVES + wave, NGW = G * NWAVES;
    unsigned char* const ws = args.ws;
#define WSP(type, off) ((type*)(ws + (off)))
    if (tid0 < 64) ((LAS unsigned*)(lds + LDS_MISC))[tid0] = 0u;
    __syncthreads();
    const XcdBarrier xbar = xcd_barrier_post(WSP(unsigned, WS_BAR), (volatile LAS unsigned*)(lds + LDS_MISC));
#define GRID_BAR() xcd_barrier(xbar)
    REPN(0) {
        PHASE_LANES;
        LAS float* scr = (LAS float*)(lds + wave * 16384);
        const float* x = args.in[0]; const float* mem = args.in[1]; const float* g_attn = args.in[2]; const float* w_in = args.in[3]; const float* g_mem = args.in[7];
        const float* w_mem_kv = args.in[8]; const float* w_out = args.in[11]; const float* g_ffn = args.in[12]; const float* w_router = args.in[13]; const float* w1 = args.in[15]; const float* w2 = args.in[17];
        bf16* WIN_T = WSP(bf16, WS_WIN); bf16* WMEM_T = WSP(bf16, WS_WMEM); bf16* WOUT_T = WSP(bf16, WS_WOUT); bf16* W1_T = WSP(bf16, WS_W1); bf16* W2_T = WSP(bf16, WS_W2);
        bf16* XN = WSP(bf16, WS_XN); bf16* MEMN = WSP(bf16, WS_MEMN); float* WRG = WSP(float, WS_WRG);
        constexpr int I0 = 16 * 88, I1 = 16 * 16, I2 = 16 * 32, I3 = 32 * 16 * 64, I4 = 32 * 16 * 32, NIT = I0 + I1 + I2 + I3 + I4;
        for (int it = gw; it < NIT; it += NGW) {
            int r = it;
            if (r < I0) { const int nb = r % 88, kb = r / 88; transpose_item(w_in, NIN, WIN_T, headperm_row(nb * 32), scr, kb * 64, nb * 32, lane); continue; } r -= I0;
            if (r < I1) { const int nb = r % 16, kb = r / 16; transpose_item(w_mem_kv, 512, WMEM_T, headperm_row(nb * 32), scr, kb * 64, nb * 32, lane); continue; } r -= I1;
            if (r < I2) { const int nb = r % 32, kb = r / 32; transpose_item(w_out, 1024, WOUT_T, nb * 32, scr, kb * 64, nb * 32, lane); continue; } r -= I2;
            if (r < I3) { const int e = r / 1024, rr = r % 1024, nb = rr % 64, kb = rr / 64; transpose_item(w1 + (size_t)e * 1024 * 2048, 2048, W1_T + (size_t)e * 2048 * 1024, nb * 32, scr, kb * 64, nb * 32, lane); continue; } r -= I3;
            { const int e = r / 512, rr = r % 512, nb = rr % 32, kb = rr / 32; transpose_item(w2 + (size_t)e * 1024 * 1024, 1024, W2_T + (size_t)e * 1024 * 1024, nb * 32, scr, kb * 64, nb * 32, lane); }
        }
        for (int m = gw; m < T + MROWS; m += NGW) {
            if (m < T) rms_row_to_bf16(x + (size_t)m * DM, g_attn, XN + (size_t)m * DM, lane);
            else rms_row_to_bf16(mem + (size_t)(m - T) * DM, g_mem, MEMN + (size_t)(m - T) * DM, lane);
        }
        for (int i = bx * NTHREADS + tid; i < DM * NEXP; i += G * NTHREADS) WRG[i] = g_ffn[i >> 5] * w_router[i];
    }
    grid.sync();

    REPN(1) {
        SchedProj S{G, bx, (const char*)(ws + WS_XN), (const char*)(ws + WS_MEMN), (const char*)(ws + WS_WIN), (const char*)(ws + WS_WMEM)};
        EpiProj E{ws, args.in[4], args.in[5], args.in[9], args.in[10]};
#ifndef NO_G1
        pg8::gemm_phase<EpiProj, SchedProj>(lds, S, E);
#endif
    }
    GRID_BAR();

#ifndef NAIVE_RET
    REPN(2) for (int i = 0; i < 2; ++i) {
        const int u = vcu * 2 + i, bh = u >> 4, cp = u & 15;
        ret_body::kv_unit(WSP(bf16, WS_KR), WSP(bf16, WS_VR), WSP(float, WS_RET), bh >> 2, bh & 3, cp, (char*)lds_raw);
    }
    GRID_BAR();
#endif
    { PHASE_LANES;
#ifdef NAIVE_MOBA
    naive_moba(WSP(bf16, WS_QA), WSP(bf16, WS_KA), WSP(bf16, WS_VA), WSP(float, WS_KMEAN), WSP(bf16, WS_Y), gw, NGW, lane);
#else
    REPN(20) for (int i = 0; i < 4; ++i) {
        const int bh = vcu >> 2, s = vcu & 3, nb = (i == 0) ? s : (i == 1) ? 7 - s : (i == 2) ? 8 + s : 15 - s, b = bh >> 3, h = bh & 7;
        const size_t row0 = (size_t)b * SEQ + (size_t)nb * 256;
        attn_body::attn_unit<8, 512, 1024, true>(WSP(bf16, WS_QA) + row0 * 512 + h * 64, WSP(bf16, WS_KA) + (size_t)b * SEQ * 512 + h * 64, WSP(bf16, WS_VA) + (size_t)b * SEQ * 512 + h * 64,
                                                 WSP(bf16, WS_Y) + row0 * DM + h * 64, 4 * nb + 4, nb, WSP(float, WS_KMEAN) + ((size_t)b * 16 * 8 + h) * 64, (char*)lds_raw);
    }
#endif
#ifdef NAIVE_RET
    naive_ret(WSP(bf16, WS_QR), WSP(bf16, WS_KR), WSP(bf16, WS_VR), WSP(bf16, WS_GR), args.in[6], WSP(bf16, WS_Y), gw, NGW, lane);
#else
    REPN(21) for (int i = 0; i < 2; ++i) {
        const int u = vcu * 2 + i, bh = u >> 4, cp = u & 15;
        ret_body::out_unit(WSP(bf16, WS_QR), WSP(bf16, WS_KR), WSP(bf16, WS_VR), WSP(bf16, WS_GR), WSP(float, WS_RET), args.in[6], WSP(bf16, WS_Y), bh >> 2, bh & 3, cp, (char*)lds_raw);
    }
#endif
#ifdef NAIVE_MEM
    naive_mem(WSP(bf16, WS_QM), WSP(bf16, WS_MK), WSP(bf16, WS_MV), WSP(bf16, WS_Y), gw, NGW, lane);
#else
    REPN(22) for (int i = 0; i < 2; ++i) {
        const int u = vcu * 2 + i, bh = u >> 4, qb = u & 15, b = bh >> 2, h = bh & 3;
        const size_t row0 = (size_t)b * SEQ + (size_t)qb * 256;
        attn_body::attn_unit<8, 256, 1024, false>(WSP(bf16, WS_QM) + row0 * 256 + h * 64, WSP(bf16, WS_MK) + (size_t)b * MEMLEN * 256 + h * 64, WSP(bf16, WS_MV) + (size_t)b * MEMLEN * 256 + h * 64,
                                                  WSP(bf16, WS_Y) + row0 * DM + 768 + h * 64, 4, 0, nullptr, (char*)lds_raw);
    }
#endif
    }
    GRID_BAR();

    REPN(3) {
        SchedPlain S{G, bx, 128, 4, (const char*)(ws + WS_Y), (const char*)(ws + WS_WOUT)};
        EpiOut E{args.in[0], args.out, WSP(float, WS_SSQ)};
#ifndef NO_G2
        pg8::gemm_phase<EpiOut, SchedPlain>(lds, S, E);
#endif
    }
    GRID_BAR();

    REPN(4) {
        PHASE_LANES;
        float* out = args.out; const float* b_router = args.in[14];
        float* WRG = WSP(float, WS_WRG); float* SSQ = WSP(float, WS_SSQ); int* TOPI = WSP(int, WS_TOPI); float* TOPW = WSP(float, WS_TOPW); int* LRANK = WSP(int, WS_LRANK); int* LCOUNT = WSP(int, WS_LCOUNT);
        bf16* XN2 = WSP(bf16, WS_XN2); const float* g_ffn = args.in[12];
        if (bx == 0 && tid < 128) ((u32x4*)(XN2 + (size_t)T * DM))[tid] = (u32x4){0u, 0u, 0u, 0u};
        LAS float* lg = (LAS float*)(lds) + wave * (16 * 33);
        LAS int* hist = (LAS int*)(lds + 32768);
        if (tid < 32) hist[tid] = 0;
        __syncthreads();
        const int tpw = T / (G * NWAVES);
        for (int tb = 0; tb < tpw; tb += 16) {
            const int t0 = (bx * NWAVES + wave) * tpw + tb;
            const int i = lane & 15, kq = lane >> 4;
            f32x4 a0 = {0.f, 0.f, 0.f, 0.f}, a1 = {0.f, 0.f, 0.f, 0.f};
            const float* xr = out + (size_t)(t0 + i) * DM + 4 * kq;
            const float* wb = WRG + (size_t)(4 * kq) * 32 + i;
            float rstd;
            { const f32x4* sp = (const f32x4*)(SSQ + (size_t)(t0 + i) * 16); const f32x4 s0 = sp[0], s1 = sp[1], s2 = sp[2], s3 = sp[3];
              const float ss = ((s0[0] + s0[1]) + (s0[2] + s0[3])) + ((s1[0] + s1[1]) + (s1[2] + s1[3])) + ((s2[0] + s2[1]) + (s2[2] + s2[3])) + ((s3[0] + s3[1]) + (s3[2] + s3[3]));
              rstd = 1.0f / sqrtf(ss * (1.0f / DM) + EPS); }
            bf16* xo = XN2 + (size_t)(t0 + i) * DM + 4 * kq;
            const float* gp = g_ffn + 4 * kq;
#pragma unroll 4
            for (int c = 0; c < 64; ++c) {
                const f32x4 av = *(const f32x4*)(xr + 16 * c);
                { const f32x4 gg = *(const f32x4*)(gp + 16 * c); u32x2 w; w.x = cvtpk(av[0] * rstd * gg[0], av[1] * rstd * gg[1]); w.y = cvtpk(av[2] * rstd * gg[2], av[3] * rstd * gg[3]); *(u32x2*)(xo + 16 * c) = w; }
#pragma unroll
                for (int q = 0; q < 4; ++q) {
                    const float b0 = wb[(size_t)(16 * c + q) * 32], b1v = wb[(size_t)(16 * c + q) * 32 + 16];
                    a0 = __builtin_amdgcn_mfma_f32_16x16x4f32(av[q], b0, a0, 0, 0, 0);
                    a1 = __builtin_amdgcn_mfma_f32_16x16x4f32(av[q], b1v, a1, 0, 0, 0);
                }
            }
#pragma unroll
            for (int r = 0; r < 4; ++r) { lg[(4 * kq + r) * 33 + i] = a0[r]; lg[(4 * kq + r) * 33 + 16 + i] = a1[r]; }
            LDS_WAIT(); asm volatile("" ::: "memory");
            if (lane < 16) {
                const int t = t0 + lane;
                float v[32];
#pragma unroll
                for (int e = 0; e < 32; ++e) v[e] = lg[lane * 33 + e] * rstd + b_router[e];
                int bi[4]; float bvv[4];
#pragma unroll
                for (int k = 0; k < 4; ++k) {
                    float best = -3e38f; int be = 0;
#pragma unroll
                    for (int e = 0; e < 32; ++e) { const bool take = v[e] > best; best = take ? v[e] : best; be = take ? e : be; }
                    bi[k] = be; bvv[k] = best;
#pragma unroll
                    for (int e = 0; e < 32; ++e) v[e] = (e == be) ? -3e38f : v[e];
                }
                const float e1 = __expf(bvv[1] - bvv[0]), e2 = __expf(bvv[2] - bvv[0]), e3 = __expf(bvv[3] - bvv[0]);
                const float inv = 1.0f / (1.0f + e1 + e2 + e3);
                const float wv[4] = {inv, e1 * inv, e2 * inv, e3 * inv};
#pragma unroll
                for (int k = 0; k < 4; ++k) {
                    const int rk = atomicAdd((int*)&hist[bi[k]], 1);
                    TOPI[t * 4 + k] = bi[k]; TOPW[t * 4 + k] = wv[k]; LRANK[t * 4 + k] = rk;
                }
            }
            LDS_WAIT(); asm volatile("" ::: "memory");
        }
        __syncthreads();
        if (tid < 32) LCOUNT[bx * 32 + tid] = hist[tid];
    }
    GRID_BAR();

    REPN(5) {
        PHASE_LANES;
        int* TOPI = WSP(int, WS_TOPI); float* TOPW = WSP(float, WS_TOPW); int* LRANK = WSP(int, WS_LRANK); int* LCOUNT = WSP(int, WS_LCOUNT);
        int* POS = WSP(int, WS_POS); float* ROWW = WSP(float, WS_ROWW); int* PSTART = WSP(int, WS_PSTART); int* TILEEXP = WSP(int, WS_TILEEXP);
        LAS int* part = (LAS int*)(lds);
        LAS int* base = (LAS int*)(lds + 8192);
        {
            const int e = tid & 31, p = tid >> 5; int c = 0, pre = 0;
            const int wpp = (G + 15) / 16;
            for (int w = p * wpp; w < (p + 1) * wpp && w < G; ++w) { const int v = LCOUNT[w * 32 + e]; c += v; pre += (w < bx) ? v : 0; }
            part[p * 32 + e] = c; part[512 + p * 32 + e] = pre;
        }
        __syncthreads();
        if (tid < 32) { int c = 0, pre = 0; for (int p = 0; p < 16; ++p) { c += part[p * 32 + tid]; pre += part[512 + p * 32 + tid]; } part[1024 + tid] = c; part[1056 + tid] = pre; }
        __syncthreads();
        if (tid == 0) {
            int ps = 0;
            for (int e = 0; e < 32; ++e) {
                const int c = part[1024 + e], nt_ = (c + 255) >> 8;
                base[32 + e] = ps; base[e] = ps + part[1056 + e];
                if (bx == 0) { PSTART[e] = ps; for (int tt = 0; tt < nt_; ++tt) TILEEXP[(ps >> 8) + tt] = e; }
                ps += nt_ * 256;
            }
            base[64] = ps; if (bx == 0) PSTART[32] = ps;
        }
        __syncthreads();
        int* ROWTOK = WSP(int, WS_ROWTOK);
        if (bx < 32) {
            const int c = part[1024 + bx], r0 = base[32 + bx] + c, r1 = base[32 + bx] + (((c + 255) >> 8) << 8);
            for (int r = r0 + tid; r < r1; r += NTHREADS) { ROWTOK[r] = T; ROWW[r] = 0.f; }
        }
        for (int a = tid; a < (T / G) * 4; a += NTHREADS) {
            const int ta = (bx * (T / G)) * 4 + a;
            const int e = TOPI[ta]; const int pos = base[e] + LRANK[ta];
            POS[ta] = pos; ROWTOK[pos] = ta >> 2; ROWW[pos] = TOPW[ta];
        }
    }
    GRID_BAR();

    const int ntiles = WSP(int, WS_PSTART)[32] >> 8;
    REPN(6) {
        SchedMoe S{G, vcu, 8, ntiles, WSP(int, WS_TILEEXP), (const char*)(ws + WS_XN2), (const char*)(ws + WS_W1), (size_t)2048 * 2048, WSP(int, WS_ROWTOK)};
        EpiSwiglu E{args.in[16], WSP(bf16, WS_H)};
#ifndef NO_G3
        pg8::gemm_phase<EpiSwiglu, SchedMoe, true>(lds, S, E);
#endif
    }
    GRID_BAR();
    REPN(7) {
        SchedMoe S{G, vcu, 4, ntiles, WSP(int, WS_TILEEXP), (const char*)(ws + WS_H), (const char*)(ws + WS_W2), (size_t)1024 * 2048, nullptr};
        EpiDown E{args.in[18], WSP(float, WS_ROWW), WSP(bf16, WS_XG)};
#ifndef NO_G4
        pg8::gemm_phase<EpiDown, SchedMoe>(lds, S, E);
#endif
    }
    GRID_BAR();
    { PHASE_LANES;
    for (int t = gw; t < T; t += NGW) {
        float* out = args.out; const int* POS = WSP(int, WS_POS); const bf16* YE = WSP(bf16, WS_XG);
        f32x4* orow = (f32x4*)(out + (size_t)t * DM) + lane;
        f32x4 v[4];
#pragma unroll
        for (int j = 0; j < 4; ++j) v[j] = orow[64 * j];
#pragma unroll
        for (int k = 0; k < 4; ++k) {
            const int pos = POS[t * 4 + k]; const u32x2* yr = (const u32x2*)(YE + (size_t)pos * 1024) + lane;
#pragma unroll
            for (int j = 0; j < 4; ++j) { const u32x2 w = yr[64 * j]; v[j].x += bflo(w.x); v[j].y += bfhi(w.x); v[j].z += bflo(w.y); v[j].w += bfhi(w.y); }
        }
#pragma unroll
        for (int j = 0; j < 4; ++j) orow[64 * j] = v[j];
    }
    }
}

extern "C" void kernel_launch(void* const* d_in, const int* in_sizes, int n_in, void* d_out, int out_size, void* d_ws, size_t ws_size, hipStream_t stream) {
    static int grid = 0;
    if (grid == 0) {
        if (n_in != 19 || out_size != T * DM || ws_size < WS_END) { fprintf(stderr, "kernel_launch: unexpected shapes (n_in %d out %d ws %zu)\n", n_in, out_size, ws_size); grid = -1; return; }
        int dev = 0, cus = 0, per_cu = 0;
        hipGetDevice(&dev); hipDeviceGetAttribute(&cus, hipDeviceAttributeMultiprocessorCount, dev);
        hipFuncSetAttribute((const void*)fwd_kernel, hipFuncAttributeMaxDynamicSharedMemorySize, LDS_BYTES);
        hipOccupancyMaxActiveBlocksPerMultiprocessor(&per_cu, (const void*)fwd_kernel, NTHREADS, LDS_BYTES);
        if (per_cu < 1) { fprintf(stderr, "kernel_launch: occupancy query says %d blocks per CU\n", per_cu); per_cu = 1; }
        (void)hipGetLastError();
        grid = cus * 1;
        if (grid % 8 != 0 || T % (grid * NWAVES * 16) != 0) { fprintf(stderr, "kernel_launch: grid %d unsupported\n", grid); grid = -1; return; }
    }
    if (grid < 0) return;
    hipMemsetAsync((char*)d_ws + WS_CTL, 0, CTL_ZERO_BYTES, stream);
    Args a{};
    for (int i = 0; i < 19; ++i) a.in[i] = (const float*)d_in[i];
    a.out = (float*)d_out; a.ws = (unsigned char*)d_ws;
    void* kargs[] = {&a};
    hipError_t e = hipLaunchCooperativeKernel((const void*)fwd_kernel, dim3(grid), dim3(NTHREADS), kargs, LDS_BYTES, stream);
    if (e != hipSuccess) fprintf(stderr, "cooperative launch failed: %s (grid %d)\n", hipGetErrorString(e), grid);
}
```

```cpp
#include <hip/hip_runtime.h>
#include <hip/hip_cooperative_groups.h>
#include <cstdio>
#include <cstdint>
namespace cg = cooperative_groups;

#define GAS __attribute__((address_space(1)))
#define LAS __attribute__((address_space(3)))
typedef unsigned short bf16;
typedef short bf16x8 __attribute__((ext_vector_type(8)));
typedef float f32x4 __attribute__((ext_vector_type(4)));
typedef float f32x2 __attribute__((ext_vector_type(2)));
typedef unsigned u32x4 __attribute__((ext_vector_type(4)));
typedef unsigned u32x2 __attribute__((ext_vector_type(2)));
typedef __bf16 bf16x2_t __attribute__((ext_vector_type(2)));

constexpr int NB = 8, SEQ = 4096, DM = 1024, T = NB * SEQ;
constexpr int NIN = 2816, NEXP = 32, TOPK = 4;
constexpr int MEMLEN = 256, MROWS = NB * MEMLEN;
constexpr float EPS = 1e-6f;
constexpr float C2 = 0.125f * 1.4426950408889634f;
constexpr int MAXTILES = 544, PROWS = MAXTILES * 256;
constexpr int NWAVES = 8, NTHREADS = 512;
#ifndef REP_PHASE
#define REP_PHASE -1
#endif
#define REPN(k) for (int rep_ = 0; rep_ < ((REP_PHASE == (k)) ? 2 : 1); ++rep_)
constexpr int LDS_MISC = 147456;
constexpr int LDS_BYTES = 147456 + 256;

constexpr size_t MiB = 1u << 20;
constexpr size_t WS_CTL = 0, CTL_ZERO_BYTES = 2 * MiB;
constexpr size_t WS_BAR = 65536;
constexpr size_t WS_KMEAN = 1 * MiB;
constexpr size_t WS_WRG = 2 * MiB;
constexpr size_t WS_SSQ = 3 * MiB;
constexpr size_t WS_TOPI = 5 * MiB, WS_TOPW = 5 * MiB + 512 * 1024, WS_LRANK = 6 * MiB, WS_POS = 6 * MiB + 512 * 1024;
constexpr size_t WS_ROWW = 7 * MiB;
constexpr size_t WS_LCOUNT = 8 * MiB, WS_PSTART = 8 * MiB + 65536, WS_TILEEXP = 8 * MiB + 131072;
constexpr size_t WS_WIN = 16 * MiB, WS_WMEM = 22 * MiB, WS_WOUT = 24 * MiB, WS_W1 = 32 * MiB, WS_W2 = 160 * MiB;
constexpr size_t WS_XN = 224 * MiB, WS_MEMN = 288 * MiB;
constexpr size_t WS_QA = 292 * MiB, WS_KA = 324 * MiB, WS_VA = 356 * MiB;
constexpr size_t WS_QR = 388 * MiB, WS_KR = 404 * MiB, WS_VR = 420 * MiB, WS_GR = 436 * MiB, WS_QM = 452 * MiB;
constexpr size_t WS_MK = 468 * MiB, WS_MV = 469 * MiB;
constexpr size_t WS_Y = 470 * MiB, WS_RET = 534 * MiB;
constexpr size_t WS_XG = 224 * MiB;
constexpr size_t WS_XN2 = 496 * MiB;
constexpr size_t WS_ROWTOK = 9 * MiB;
constexpr size_t WS_H = 566 * MiB;
constexpr size_t WS_END = 838 * MiB;

struct Args {
    const float* in[19]; float* out; unsigned char* ws; int pad0, pad1;
};

__device__ __forceinline__ unsigned cvtpk(float lo, float hi) { f32x2 v = {lo, hi}; bf16x2_t b = __builtin_convertvector(v, bf16x2_t); return __builtin_bit_cast(unsigned, b); }
__device__ __forceinline__ float bf2f(unsigned short b) { return __uint_as_float(((unsigned)b) << 16); }
__device__ __forceinline__ float bflo(unsigned w) { return __uint_as_float(w << 16); }
__device__ __forceinline__ float bfhi(unsigned w) { return __uint_as_float(w & 0xffff0000u); }
__device__ __forceinline__ float wave_sum(float v) {
#pragma unroll
    for (int o = 1; o < 64; o <<= 1) v += __shfl_xor(v, o);
    return v;
}
#define LDS_WAIT() asm volatile("s_waitcnt lgkmcnt(0)" ::: "memory")
__device__ __forceinline__ int opaque(int v) { asm volatile("" : "+v"(v)); return v; }

namespace pg8 {
constexpr int BM = 256, BK = 64, HALF = 128, HTB = HALF * BK * 2, STAGE_BYTES = 8 * HTB, NXCD = 8, WGM = 8, K = 1024;
__host__ __device__ __forceinline__ int lds_byte(int r, int c) { const int st = (r >> 4) * 2 + (c >> 5), rr = r & 15, cc = c & 31, ob = rr * 64 + cc * 2; return st * 1024 + (ob ^ (((ob >> 9) & 1) << 5)); }
__host__ __device__ __forceinline__ void stage_rc(int b, int& R, int& C) { const int st = b / 1024, sb = b % 1024, swz = sb ^ (((sb >> 9) & 1) << 5); R = (st >> 1) * 16 + swz / 64; C = (st & 1) * 32 + (swz % 64) / 2; }
__host__ __device__ __forceinline__ int perm32(int rho) { const int n = rho >> 4, i = rho & 15; return 8 * (i >> 2) + 4 * n + (i & 3); }
struct Unit { int pm, pn, aux; };

__device__ __forceinline__ bool static_order(int L, int nM, int nN, int& pm, int& pn) {
    const int nwg = nM * nN; if (L >= nwg) return false;
    int wgid = L; { const int q = nwg / NXCD, r = nwg % NXCD, xcd = wgid % NXCD, off = wgid / NXCD; wgid = (xcd < r ? xcd * (q + 1) : r * (q + 1) + (xcd - r) * q) + off; }
    const int nig = WGM * nN, gid = wgid / nig, fm = gid * WGM, gsz = (nM - fm) < WGM ? (nM - fm) : WGM;
    pm = fm + ((wgid % nig) % gsz); pn = (wgid % nig) / gsz; return true;
}

typedef int v8i_t __attribute__((ext_vector_type(8)));
typedef int v4i_t __attribute__((ext_vector_type(4)));
__device__ __forceinline__ v8i_t cat8(bf16x8 lo, bf16x8 hi) { const v4i_t a = __builtin_bit_cast(v4i_t, lo), b = __builtin_bit_cast(v4i_t, hi); return __builtin_shufflevector(a, b, 0, 1, 2, 3, 4, 5, 6, 7); }
template <class Epi, class Sched, bool GATHER = false, bool FP8 = false>
__device__ __forceinline__ void gemm_phase(LAS unsigned char* lds, const Sched& S, const Epi& E) {
    constexpr int PITCH = FP8 ? 1024 : 2048;
    const int tid = opaque((int)threadIdx.x), wid = __builtin_amdgcn_readfirstlane(tid >> 6), lane = tid & 63, wr = wid >> 2, wc = wid & 3, fr = lane & 15, fq = lane >> 4;
    constexpr int nt = PITCH / 128;
    unsigned voffA[2], voffB[2];
#pragma unroll
    for (int i = 0; i < 2; ++i) { int R, C; stage_rc(tid * 16 + i * 8192, R, C); const int Rb = (R & ~31) + perm32(R & 31);
        voffA[i] = (unsigned)(R * PITCH + C * 2); voffB[i] = (unsigned)(Rb * PITCH + C * 2); }
    const size_t kstep = (size_t)(BK * 2);
    const size_t hstep = (size_t)HALF * PITCH;
    const unsigned ldsw = (unsigned)wid * 1024u;
    const int aoff = lds_byte(wr * 64 + fr, fq * 8), boff = lds_byte(wc * 32 + fr, fq * 8);
#define PG8_SA(b, h) (((b) * 2 + (h)) * HTB)
#define PG8_SB(b, h) ((4 + (b) * 2 + (h)) * HTB)
#define PG8_STAGE(bufoff, gbase, voff) do { _Pragma("unroll") for (int _i = 0; _i < 2; ++_i) \
        __builtin_amdgcn_global_load_lds((const unsigned*)((const char*)(gbase) + (voff)[_i]), (LAS unsigned*)(lds + (bufoff) + ldsw + _i * 8192), 16, 0, 0); } while (0)
#define PG8_LDA(dst, b, h) do { _Pragma("unroll") for (int m = 0; m < 4; ++m) _Pragma("unroll") for (int k = 0; k < 2; ++k) dst[m][k] = *(const LAS bf16x8*)(lds + PG8_SA(b, h) + aoff + m * 2048 + k * 1024); } while (0)
#define PG8_LDB(dst, b, h) do { _Pragma("unroll") for (int n = 0; n < 2; ++n) _Pragma("unroll") for (int k = 0; k < 2; ++k) dst[n][k] = *(const LAS bf16x8*)(lds + PG8_SB(b, h) + boff + n * 2048 + k * 1024); } while (0)
#define PG8_MMA(ai, bj, At, Bt) do { __builtin_amdgcn_s_setprio(1); \
        if constexpr (FP8) { _Pragma("unroll") for (int m = 0; m < 4; ++m) _Pragma("unroll") for (int n = 0; n < 2; ++n) \
            asm volatile("v_mfma_scale_f32_16x16x128_f8f6f4 %0, %1, %2, %0, %3, %3 op_sel_hi:[0,0,0]" : "+v"(acc[ai][bj][m][n]) : "v"(cat8(Bt[n][0], Bt[n][1])), "v"(cat8(At[m][0], At[m][1])), "v"(0x7f7f7f7f)); } \
        else { _Pragma("unroll") for (int m = 0; m < 4; ++m) _Pragma("unroll") for (int n = 0; n < 2; ++n) _Pragma("unroll") for (int k = 0; k < 2; ++k) \
            acc[ai][bj][m][n] = __builtin_amdgcn_mfma_f32_16x16x32_bf16(Bt[n][k], At[m][k], acc[ai][bj][m][n], 0, 0, 0); } \
        __builtin_amdgcn_s_setprio(0); } while (0)
#define PG8_WAIT_V(n) asm volatile("s_waitcnt vmcnt(" #n ")" ::: "memory")
#define PG8_WAIT_L(n) asm volatile("s_waitcnt lgkmcnt(" #n ")" ::: "memory")
#define PG8_BAR __builtin_amdgcn_s_barrier()
#define PG8_SCHED __builtin_amdgcn_sched_barrier(0)
    Unit cur, nxt; int ui = 0;
    if (!S.next(0, cur)) return;
    unsigned vGc[2][2], vGn[2][2]; int gR[2], gC[2];
    const char* gA = nullptr;
    if constexpr (GATHER) {
        gA = S.abase();
#pragma unroll
        for (int i = 0; i < 2; ++i) { stage_rc(tid * 16 + i * 8192, gR[i], gC[i]); }
        if (wid == 0) __builtin_amdgcn_global_load_lds((const unsigned*)(S.tokptr(cur) + lane * 16), (LAS unsigned*)(lds + 131072), 16, 0, 0);
        asm volatile("s_waitcnt vmcnt(0)" ::: "memory"); __builtin_amdgcn_s_barrier(); asm volatile("" ::: "memory");
#pragma unroll
        for (int h = 0; h < 2; ++h)
#pragma unroll
            for (int i = 0; i < 2; ++i) { const int tok = ((const LAS int*)(lds + 131072))[h * 128 + gR[i]]; vGc[h][i] = (unsigned)tok * (unsigned)PITCH + (unsigned)gC[i] * 2u; vGn[h][i] = vGc[h][i]; }
    }
    f32x4 acc[2][2][4][2];
#pragma unroll
    for (int a = 0; a < 2; ++a)
#pragma unroll
        for (int b = 0; b < 2; ++b)
#pragma unroll
            for (int m = 0; m < 4; ++m)
#pragma unroll
                for (int n = 0; n < 2; ++n) acc[a][b][m][n] = (f32x4){0.f, 0.f, 0.f, 0.f};
    bf16x8 At[4][2], B0[2][2], B1[2][2];
    const char* cA = GATHER ? gA : S.aptr(cur); const char* cB = S.bptr(cur);
    const size_t ahstep = GATHER ? (size_t)0 : hstep;
    {
        PG8_STAGE(PG8_SB(0, 0), cB, voffB); PG8_STAGE(PG8_SB(0, 1), cB + hstep, voffB);
        if constexpr (GATHER) { PG8_STAGE(PG8_SA(0, 0), cA, vGc[0]); PG8_STAGE(PG8_SA(0, 1), cA, vGc[1]); } else { PG8_STAGE(PG8_SA(0, 0), cA, voffA); PG8_STAGE(PG8_SA(0, 1), cA + hstep, voffA); }
        if (wr == 1) PG8_BAR;
        PG8_WAIT_V(2); PG8_BAR;
        PG8_STAGE(PG8_SB(1, 0), cB + kstep, voffB);
        if constexpr (GATHER) { PG8_STAGE(PG8_SA(1, 0), cA + kstep, vGc[0]); } else { PG8_STAGE(PG8_SA(1, 0), cA + kstep, voffA); }
        PG8_STAGE(PG8_SB(1, 1), cB + hstep + kstep, voffB);
        PG8_WAIT_V(6); PG8_BAR;
    }
    for (;;) {
        const bool has_next = S.next(ui + 1, nxt);
        const char* nA = GATHER ? gA : (has_next ? S.aptr(nxt) : cA); const char* nB = has_next ? S.bptr(nxt) : cB;
        if constexpr (GATHER) { if (has_next && wid == 0) __builtin_amdgcn_global_load_lds((const unsigned*)(S.tokptr(nxt) + lane * 16), (LAS unsigned*)(lds + 131072 + ((ui + 1) & 1) * 1024), 16, 0, 0); }
#pragma nounroll
        for (int t = 0; t < nt; t += 2) {
            const bool last = (t == nt - 2);
            const char* a1 = cA + (size_t)(t + 1) * kstep;
            const char* a2 = last ? nA : cA + (size_t)(t + 2) * kstep; const char* b2 = last ? nB : cB + (size_t)(t + 2) * kstep;
            const char* a3 = a2 + kstep; const char* b3 = b2 + kstep;
            unsigned v2h0[2], v2h1[2];
            if constexpr (GATHER) {
                if (last && has_next) {
                    const LAS int* tk = (const LAS int*)(lds + 131072 + ((ui + 1) & 1) * 1024);
#pragma unroll
                    for (int h = 0; h < 2; ++h)
#pragma unroll
                        for (int i = 0; i < 2; ++i) vGn[h][i] = (unsigned)tk[h * 128 + gR[i]] * (unsigned)PITCH + (unsigned)gC[i] * 2u;
                }
#pragma unroll
                for (int i = 0; i < 2; ++i) { v2h0[i] = last ? vGn[0][i] : vGc[0][i]; v2h1[i] = last ? vGn[1][i] : vGc[1][i]; }
            } else {
#pragma unroll
                for (int i = 0; i < 2; ++i) { v2h0[i] = voffA[i]; v2h1[i] = voffA[i]; }
            }
            PG8_LDB(B0, 0, 0); PG8_LDB(B1, 0, 1); PG8_SCHED; PG8_LDA(At, 0, 0);
            if constexpr (GATHER) { PG8_STAGE(PG8_SA(1, 1), a1, vGc[1]); } else { PG8_STAGE(PG8_SA(1, 1), a1 + hstep, voffA); }
            PG8_WAIT_V(8); PG8_WAIT_L(0); PG8_BAR; PG8_MMA(0, 0, At, B0); PG8_MMA(0, 1, At, B1); PG8_BAR; PG8_SCHED;
            PG8_LDA(At, 0, 1); PG8_STAGE(PG8_SB(0, 0), b2, voffB); PG8_STAGE(PG8_SB(0, 1), b2 + hstep, voffB); PG8_STAGE(PG8_SA(0, 0), a2, v2h0);
            PG8_WAIT_V(8); PG8_WAIT_L(0); PG8_BAR; PG8_MMA(1, 0, At, B0); PG8_MMA(1, 1, At, B1); PG8_BAR; PG8_SCHED;
            PG8_LDB(B0, 1, 0); PG8_LDB(B1, 1, 1); PG8_SCHED; PG8_LDA(At, 1, 0); PG8_STAGE(PG8_SA(0, 1), a2 + ahstep, v2h1);
            PG8_WAIT_V(8); PG8_WAIT_L(0); PG8_BAR; PG8_MMA(0, 0, At, B0); PG8_MMA(0, 1, At, B1); PG8_BAR; PG8_SCHED;
            PG8_LDA(At, 1, 1); PG8_STAGE(PG8_SB(1, 0), b3, voffB); PG8_STAGE(PG8_SB(1, 1), b3 + hstep, voffB); PG8_STAGE(PG8_SA(1, 0), a3, v2h0);
            PG8_WAIT_V(8); PG8_WAIT_L(0); PG8_BAR; PG8_MMA(1, 0, At, B0); PG8_MMA(1, 1, At, B1); PG8_BAR; PG8_SCHED;
        }
        if (wr == 0) PG8_BAR;
        if constexpr (FP8) asm volatile("s_nop 15\n\ts_nop 7" ::: "memory");
        E(acc, cur, wr, wc, fr, fq);
        if (!has_next) break;
#pragma unroll
        for (int a = 0; a < 2; ++a)
#pragma unroll
            for (int b = 0; b < 2; ++b)
#pragma unroll
                for (int m = 0; m < 4; ++m)
#pragma unroll
                    for (int n = 0; n < 2; ++n) acc[a][b][m][n] = (f32x4){0.f, 0.f, 0.f, 0.f};
        cur = nxt; cA = nA; cB = nB; ++ui;
        if constexpr (GATHER) {
#pragma unroll
            for (int h = 0; h < 2; ++h)
#pragma unroll
                for (int i = 0; i < 2; ++i) vGc[h][i] = vGn[h][i];
        }
        if (wr == 1) PG8_BAR;
    }
    PG8_WAIT_V(0);
    PG8_BAR;
#undef PG8_SA
#undef PG8_SB
#undef PG8_STAGE
#undef PG8_LDA
#undef PG8_LDB
#undef PG8_MMA
#undef PG8_WAIT_V
#undef PG8_WAIT_L
#undef PG8_BAR
#undef PG8_SCHED
}
}
using pg8::Unit;

struct SchedProj {
    int G, c; const char *XN, *MEMN, *WIN, *WMEM;
    __device__ __forceinline__ bool next(int i, Unit& u) const {
        const int L = i * G + c;
        if (L < 1408) { u.aux = 0; return pg8::static_order(L, 128, 11, u.pm, u.pn); }
        if (L < 1424) { const int j = L - 1408; u.pm = j >> 1; u.pn = j & 1; u.aux = 1; return true; }
        return false;
    }
    __device__ __forceinline__ const char* aptr(const Unit& u) const { return (u.aux ? MEMN : XN) + (size_t)u.pm * (256 * 2048); }
    __device__ __forceinline__ const char* bptr(const Unit& u) const { return (u.aux ? WMEM : WIN) + (size_t)u.pn * (256 * 2048); }
};
struct SchedPlain {
    int G, c, nM, nN; const char *A, *B;
    __device__ __forceinline__ bool next(int i, Unit& u) const { u.aux = 0; return pg8::static_order(i * G + c, nM, nN, u.pm, u.pn); }
    __device__ __forceinline__ const char* aptr(const Unit& u) const { return A + (size_t)u.pm * (256 * 2048); }
    __device__ __forceinline__ const char* bptr(const Unit& u) const { return B + (size_t)u.pn * (256 * 2048); }
};
struct SchedMoe {
    int G, vcu, npn, ntiles; const int* tile_exp; const char *A, *B; size_t bexp;
    __device__ __forceinline__ bool next(int i, Unit& u) const {
        const int L = i * G + vcu, tile = L / npn; if (tile >= ntiles) return false;
        u.pm = tile; u.pn = L - tile * npn; u.aux = __builtin_amdgcn_readfirstlane(tile_exp[tile]); return true;
    }
    __device__ __forceinline__ const char* aptr(const Unit& u) const { return A + (size_t)u.pm * (256 * 1024); }
    __device__ __forceinline__ const char* bptr(const Unit& u) const { return B + (size_t)u.aux * bexp + (size_t)u.pn * (256 * 1024); }
    const int* rowtok;
    __device__ __forceinline__ const char* abase() const { return A; }
    __device__ __forceinline__ const char* tokptr(const Unit& u) const { return (const char*)(rowtok + (size_t)u.pm * 256); }
};

struct EpiProj {
    unsigned char* ws;
    const float *gq, *gk, *gmq, *gmk;
    __device__ __forceinline__ void operator()(const f32x4 (&acc)[2][2][4][2], const Unit& u, int wr, int wc, int fr, int fq) const {
        int mode = 0; bf16* out; int ld = 256, coff = 0; const float* gain = nullptr; float scale = 1.f; bool kmean = false;
        if (u.aux == 0) {
            switch (u.pn) {
                case 0: case 1: out = (bf16*)(ws + WS_QA); ld = 512; coff = u.pn * 256; mode = 1; gain = gq; scale = C2; break;
                case 2: case 3: out = (bf16*)(ws + WS_KA); ld = 512; coff = (u.pn - 2) * 256; mode = 1; gain = gk; kmean = true; break;
                case 4: case 5: out = (bf16*)(ws + WS_VA); ld = 512; coff = (u.pn - 4) * 256; break;
                case 6: out = (bf16*)(ws + WS_QR); mode = 2; break;
                case 7: out = (bf16*)(ws + WS_KR); mode = 2; scale = 0.125f; break;
                case 8: out = (bf16*)(ws + WS_VR); break;
                case 9: out = (bf16*)(ws + WS_GR); mode = 3; break;
                default: out = (bf16*)(ws + WS_QM); mode = 1; gain = gmq; scale = C2; break;
            }
        } else {
            if (u.pn == 0) { out = (bf16*)(ws + WS_MK); mode = 1; gain = gmk; } else { out = (bf16*)(ws + WS_MV); }
        }
        const int row0 = u.pm * 256 + wr * 64 + fr;
        const int colb = coff + wc * 64 + 8 * fq;
        if (gain == nullptr) gain = gq;
        f32x4 ks[2][2];
#pragma unroll
        for (int bj = 0; bj < 2; ++bj)
#pragma unroll
            for (int n = 0; n < 2; ++n) ks[bj][n] = (f32x4){0.f, 0.f, 0.f, 0.f};
#pragma unroll
        for (int ai = 0; ai < 2; ++ai)
#pragma unroll
            for (int m = 0; m < 4; ++m) {
                const int row = row0 + ai * 128 + m * 16;
                f32x4 v[2][2];
#pragma unroll
                for (int bj = 0; bj < 2; ++bj)
#pragma unroll
                    for (int n = 0; n < 2; ++n) v[bj][n] = acc[ai][bj][m][n];
                if (mode == 1) {
                    float ss = 0.f;
#pragma unroll
                    for (int bj = 0; bj < 2; ++bj)
#pragma unroll
                        for (int n = 0; n < 2; ++n) { const f32x4 x = v[bj][n]; ss += (x[0] * x[0] + x[1] * x[1]) + (x[2] * x[2] + x[3] * x[3]); }
                    ss += __shfl_xor(ss, 16); ss += __shfl_xor(ss, 32);
                    const float r = scale / sqrtf(ss * (1.0f / 64.0f) + EPS);
#pragma unroll
                    for (int bj = 0; bj < 2; ++bj)
#pragma unroll
                        for (int n = 0; n < 2; ++n) v[bj][n] = v[bj][n] * r * *(const f32x4*)(gain + bj * 32 + 8 * fq + 4 * n);
                } else if (mode == 2) {
                    const float pos = (float)(row & (SEQ - 1));
                    const float lgam = __builtin_amdgcn_logf(1.0f - __builtin_amdgcn_exp2f(-5.0f - (float)wc));
                    const float rsc = scale * __builtin_amdgcn_exp2f(((u.pn == 6) ? lgam : -lgam) * (float)(row & 127));
#pragma unroll
                    for (int n = 0; n < 2; ++n)
#pragma unroll
                        for (int j = 0; j < 4; ++j) {
                            const float fre = __builtin_amdgcn_exp2f((float)(8 * fq + 4 * n + j) * (-13.287712379549449f / 31.0f)) * 0.15915494309189535f;
                            float tt = pos * fre; tt = tt - floorf(tt);
                            const float sn = __builtin_amdgcn_sinf(tt), cs = __builtin_amdgcn_cosf(tt);
                            const float t1 = v[0][n][j], t2 = v[1][n][j];
                            v[0][n][j] = (t1 * cs - t2 * sn) * rsc; v[1][n][j] = (t2 * cs + t1 * sn) * rsc;
                        }
                } else if (mode == 3) {
#pragma unroll
                    for (int bj = 0; bj < 2; ++bj)
#pragma unroll
                        for (int n = 0; n < 2; ++n)
#pragma unroll
                            for (int j = 0; j < 4; ++j) { const float x = v[bj][n][j]; v[bj][n][j] = x / (1.0f + __expf(-x)); }
                }
                if (kmean) {
#pragma unroll
                    for (int bj = 0; bj < 2; ++bj)
#pragma unroll
                        for (int n = 0; n < 2; ++n) ks[bj][n] += v[bj][n];
                }
                bf16* rowp = out + (size_t)row * ld + colb;
#pragma unroll
                for (int bj = 0; bj < 2; ++bj) { u32x4 w; w.x = cvtpk(v[bj][0][0], v[bj][0][1]); w.y = cvtpk(v[bj][0][2], v[bj][0][3]); w.z = cvtpk(v[bj][1][0], v[bj][1][1]); w.w = cvtpk(v[bj][1][2], v[bj][1][3]);
                    *(u32x4*)(rowp + bj * 32) = w; }
            }
        if (kmean) {
            float* kp = (float*)(ws + WS_KMEAN) + ((size_t)u.pm * 8 + (u.pn - 2) * 4 + wc) * 64 + 8 * fq;
#pragma unroll
            for (int bj = 0; bj < 2; ++bj)
#pragma unroll
                for (int n = 0; n < 2; ++n)
#pragma unroll
                    for (int j = 0; j < 4; ++j) {
                        float s = ks[bj][n][j];
                        s += __shfl_xor(s, 1); s += __shfl_xor(s, 2); s += __shfl_xor(s, 4); s += __shfl_xor(s, 8);
                        if (fr == 0) atomicAdd(kp + bj * 32 + 4 * n + j, s * (1.0f / 256.0f));
                    }
        }
    }
};

struct EpiOut {
    const float* x; float* out; float* ssq;
    __device__ __forceinline__ void operator()(const f32x4 (&acc)[2][2][4][2], const Unit& u, int wr, int wc, int fr, int fq) const {
        const int row0 = u.pm * 256 + wr * 64 + fr, col0 = u.pn * 256 + wc * 32 + 8 * fq;
#pragma unroll
        for (int ai = 0; ai < 2; ++ai)
#pragma unroll
            for (int m = 0; m < 4; ++m) {
                const int row = row0 + ai * 128 + m * 16; const size_t off = (size_t)row * DM + col0; float ss = 0.f;
#pragma unroll
                for (int bj = 0; bj < 2; ++bj)
#pragma unroll
                    for (int n = 0; n < 2; ++n) { const f32x4 xv = *(const f32x4*)(x + off + bj * 128 + 4 * n); const f32x4 o = xv + acc[ai][bj][m][n];
                        ss += (o[0] * o[0] + o[1] * o[1]) + (o[2] * o[2] + o[3] * o[3]); *(f32x4*)(out + off + bj * 128 + 4 * n) = o; }
                ss += __shfl_xor(ss, 16); ss += __shfl_xor(ss, 32);
                if (fq == 0) ssq[(size_t)row * 16 + u.pn * 4 + wc] = ss;
            }
    }
};

struct EpiSwiglu {
    const float* b1; unsigned char* H;
    __device__ __forceinline__ void operator()(const f32x4 (&acc)[2][2][4][2], const Unit& u, int wr, int wc, int fr, int fq) const {
        const int row0 = u.pm * 256 + wr * 64 + fr, p0 = u.pn * 128 + wc * 32 + 8 * fq;
        const float* bp = b1 + (size_t)u.aux * 2048 + 2 * p0;
        f32x4 bv[4];
#pragma unroll
        for (int i = 0; i < 4; ++i) bv[i] = *(const f32x4*)(bp + 4 * i);
#pragma unroll
        for (int ai = 0; ai < 2; ++ai)
#pragma unroll
            for (int m = 0; m < 4; ++m) {
                const int row = row0 + ai * 128 + m * 16;
                float h[8];
#pragma unroll
                for (int n = 0; n < 2; ++n)
#pragma unroll
                    for (int j = 0; j < 4; ++j) {
                        const int i = 4 * n + j;
                        const float g = fminf(acc[ai][0][m][n][j] * 0.03125f + bv[i >> 1][(i & 1) * 2], 7.0f);
                        const float l = fminf(fmaxf(acc[ai][1][m][n][j] * 0.03125f + bv[i >> 1][(i & 1) * 2 + 1], -7.0f), 7.0f);
                        h[i] = g * __builtin_amdgcn_rcpf(1.0f + __builtin_amdgcn_exp2f(-1.702f * 1.4426950408889634f * g)) * (l + 1.0f);
                    }
                int w0 = 0, w1 = 0;
                w0 = __builtin_amdgcn_cvt_pk_fp8_f32(h[0], h[1], w0, false); w0 = __builtin_amdgcn_cvt_pk_fp8_f32(h[2], h[3], w0, true);
                w1 = __builtin_amdgcn_cvt_pk_fp8_f32(h[4], h[5], w1, false); w1 = __builtin_amdgcn_cvt_pk_fp8_f32(h[6], h[7], w1, true);
                *(u32x2*)(H + (size_t)row * 1024 + p0) = (u32x2){(unsigned)w0, (unsigned)w1};
            }
    }
};

struct EpiDown {
    const float* b2; const float* roww; bf16* YE;
    __device__ __forceinline__ void operator()(const f32x4 (&acc)[2][2][4][2], const Unit& u, int wr, int wc, int fr, int fq) const {
        const int row0 = u.pm * 256 + wr * 64 + fr, c0 = u.pn * 256 + wc * 32 + 8 * fq;
        const float* bp = b2 + (size_t)u.aux * 1024 + c0;
        f32x4 bv[2][2];
#pragma unroll
        for (int bj = 0; bj < 2; ++bj)
#pragma unroll
            for (int n = 0; n < 2; ++n) bv[bj][n] = *(const f32x4*)(bp + bj * 128 + 4 * n);
#pragma unroll
        for (int ai = 0; ai < 2; ++ai)
#pragma unroll
            for (int m = 0; m < 4; ++m) {
                const int row = row0 + ai * 128 + m * 16; const float w8 = roww[row];
#pragma unroll
                for (int bj = 0; bj < 2; ++bj) {
                    const f32x4 y0 = (acc[ai][bj][m][0] * 0.03125f + bv[bj][0]) * w8, y1 = (acc[ai][bj][m][1] * 0.03125f + bv[bj][1]) * w8;
                    u32x4 w; w.x = cvtpk(y0[0], y0[1]); w.y = cvtpk(y0[2], y0[3]); w.z = cvtpk(y1[0], y1[1]); w.w = cvtpk(y1[2], y1[3]);
                    *(u32x4*)(YE + (size_t)row * 1024 + c0 + bj * 128) = w;
                }
            }
    }
};

__device__ __forceinline__ void transpose_item(const float* W, int N, bf16* WT, int drow0, LAS float* scr, int k0, int n0, int lane) {
#pragma unroll 8
    for (int i = 0; i < 32; ++i) { const int kk = 2 * i + (lane >> 5); scr[kk * 33 + (lane & 31)] = W[(size_t)(k0 + kk) * N + n0 + (lane & 31)]; }
    LDS_WAIT(); asm volatile("" ::: "memory");
    const int c = lane & 7;
#pragma unroll
    for (int j = 0; j < 4; ++j) { const int n = (lane >> 3) + 8 * j; const LAS float* s = scr + (8 * c) * 33 + n;
        u32x4 o; o.x = cvtpk(s[0 * 33], s[1 * 33]); o.y = cvtpk(s[2 * 33], s[3 * 33]); o.z = cvtpk(s[4 * 33], s[5 * 33]); o.w = cvtpk(s[6 * 33], s[7 * 33]);
        *(u32x4*)(WT + (size_t)(drow0 + n) * 1024 + k0 + 8 * c) = o; }
    LDS_WAIT(); asm volatile("" ::: "memory");
}
template <bool GLU>
__device__ __forceinline__ void transpose_item_fp8(const float* W, int N, unsigned char* W8, LAS float* scr, int k0, int n0, int lane) {
#pragma unroll 8
    for (int i = 0; i < 32; ++i) { const int kk = 2 * i + (lane >> 5); scr[kk * 33 + (lane & 31)] = W[(size_t)(k0 + kk) * N + n0 + (lane & 31)]; }
    LDS_WAIT(); asm volatile("" ::: "memory");
    const int c = lane & 3;
#pragma unroll
    for (int j = 0; j < 2; ++j) { const int n = (lane >> 2) + 16 * j; const LAS float* s = scr + (16 * c) * 33 + n;
        int w[4];
#pragma unroll
        for (int q = 0; q < 4; ++q) { int t = 0; t = __builtin_amdgcn_cvt_pk_fp8_f32(s[(4 * q) * 33] * 32.0f, s[(4 * q + 1) * 33] * 32.0f, t, false); t = __builtin_amdgcn_cvt_pk_fp8_f32(s[(4 * q + 2) * 33] * 32.0f, s[(4 * q + 3) * 33] * 32.0f, t, true); w[q] = t; }
        const int col = n0 + n; const int p = col >> 1;
        const int drow = GLU ? ((p >> 7) * 256 + (col & 1) * 128 + (p & 127)) : col;
        *(u32x4*)(W8 + (size_t)drow * 1024 + k0 + 16 * c) = (u32x4){(unsigned)w[0], (unsigned)w[1], (unsigned)w[2], (unsigned)w[3]}; }
    LDS_WAIT(); asm volatile("" ::: "memory");
}
__device__ __forceinline__ int headperm_row(int n0) { const int pn = n0 >> 8, c = n0 & 255, hh = c >> 6, dh = (c & 63) >> 5; return pn * 256 + dh * 128 + hh * 32; }
__device__ __forceinline__ void rms_row_to_bf16(const float* xrow, const float* gain, bf16* orow, int lane) {
    const f32x4* xr = (const f32x4*)xrow + lane; const f32x4* gr = (const f32x4*)gain + lane;
    f32x4 v[4]; float s = 0.f;
#pragma unroll
    for (int j = 0; j < 4; ++j) { v[j] = xr[64 * j]; s += (v[j].x * v[j].x + v[j].y * v[j].y) + (v[j].z * v[j].z + v[j].w * v[j].w); }
    const float rstd = 1.0f / sqrtf(wave_sum(s) * (1.f / DM) + EPS);
    u32x2* o8 = (u32x2*)orow + lane;
#pragma unroll
    for (int j = 0; j < 4; ++j) { const f32x4 gg = gr[64 * j]; u32x2 w; w.x = cvtpk(v[j].x * rstd * gg.x, v[j].y * rstd * gg.y); w.y = cvtpk(v[j].z * rstd * gg.z, v[j].w * rstd * gg.w); o8[64 * j] = w; }
}

__device__ __forceinline__ void load64(const bf16* p, float (&d)[64]) {
    const u32x4* q = (const u32x4*)p;
#pragma unroll
    for (int i = 0; i < 8; ++i) { const u32x4 w = q[i]; d[8 * i + 0] = bflo(w.x); d[8 * i + 1] = bfhi(w.x); d[8 * i + 2] = bflo(w.y); d[8 * i + 3] = bfhi(w.y); d[8 * i + 4] = bflo(w.z); d[8 * i + 5] = bfhi(w.z); d[8 * i + 6] = bflo(w.w); d[8 * i + 7] = bfhi(w.w); }
}
__device__ __forceinline__ void store64(bf16* p, const float (&d)[64]) {
    u32x4* q = (u32x4*)p;
#pragma unroll
    for (int i = 0; i < 8; ++i) { u32x4 w; w.x = cvtpk(d[8 * i], d[8 * i + 1]); w.y = cvtpk(d[8 * i + 2], d[8 * i + 3]); w.z = cvtpk(d[8 * i + 4], d[8 * i + 5]); w.w = cvtpk(d[8 * i + 6], d[8 * i + 7]); q[i] = w; }
}
__device__ __forceinline__ float dothalf(const float (&a)[64], const bf16* p, int h) {
    const u32x4* q = (const u32x4*)(p + 32 * h); float s0 = 0.f, s1 = 0.f;
#pragma unroll
    for (int i = 0; i < 4; ++i) { const u32x4 w = q[i]; const int o = 32 * h + 8 * i;
        s0 += a[o] * bflo(w.x) + a[o + 2] * bflo(w.y) + a[o + 4] * bflo(w.z) + a[o + 6] * bflo(w.w);
        s1 += a[o + 1] * bfhi(w.x) + a[o + 3] * bfhi(w.y) + a[o + 5] * bfhi(w.z) + a[o + 7] * bfhi(w.w); }
    return s0 + s1;
}
__device__ __forceinline__ float dotbf(const float (&a)[64], const bf16* p) { return dothalf(a, p, 0) + dothalf(a, p, 1); }
__device__ __forceinline__ void axpy_bf(float (&acc)[64], float al, float pw, const bf16* vp) {
    const u32x4* q = (const u32x4*)vp;
#pragma unroll
    for (int i = 0; i < 8; ++i) { const u32x4 w = q[i]; const int o = 8 * i;
        acc[o] = acc[o] * al + pw * bflo(w.x); acc[o + 1] = acc[o + 1] * al + pw * bfhi(w.x); acc[o + 2] = acc[o + 2] * al + pw * bflo(w.y); acc[o + 3] = acc[o + 3] * al + pw * bfhi(w.y);
        acc[o + 4] = acc[o + 4] * al + pw * bflo(w.z); acc[o + 5] = acc[o + 5] * al + pw * bfhi(w.z); acc[o + 6] = acc[o + 6] * al + pw * bflo(w.w); acc[o + 7] = acc[o + 7] * al + pw * bfhi(w.w); }
}
__device__ __forceinline__ float dot64(const float (&a)[64], const float (&b)[64]) {
    float s0 = 0.f, s1 = 0.f, s2 = 0.f, s3 = 0.f;
#pragma unroll
    for (int i = 0; i < 64; i += 4) { s0 += a[i] * b[i]; s1 += a[i + 1] * b[i + 1]; s2 += a[i + 2] * b[i + 2]; s3 += a[i + 3] * b[i + 3]; }
    return (s0 + s1) + (s2 + s3);
}

__device__ __forceinline__ void naive_moba(const bf16* QA, const bf16* KA, const bf16* VA, const float* KMEAN, bf16* Y, int gw, int NGW, int lane_) {
    const int lane = opaque(lane_);
    for (int wi = gw; wi < (NB * 8 * SEQ) / 64; wi += NGW) {
        const int idx0 = wi * 64, bh = idx0 / SEQ, s0 = idx0 % SEQ, b = bh >> 3, h = bh & 7, s = s0 + lane, n = s0 >> 8;
        float q[64]; load64(QA + ((size_t)(b * SEQ + s)) * 512 + h * 64, q);
        float g0 = -3e38f, g1 = -3e38f, g2 = -3e38f; int i0 = -1, i1 = -1, i2 = -1;
        for (int j = 0; j < n; ++j) {
            const float* km = KMEAN + (((size_t)(b * 16 + j)) * 8 + h) * 64;
            float g = 0.f;
#pragma unroll
            for (int d = 0; d < 64; ++d) g += q[d] * km[d];
            if (g > g0) { g2 = g1; i2 = i1; g1 = g0; i1 = i0; g0 = g; i0 = j; }
            else if (g > g1) { g2 = g1; i2 = i1; g1 = g; i1 = j; }
            else if (g > g2) { g2 = g; i2 = j; }
        }
        unsigned mask = 0; if (i0 >= 0) mask |= 1u << i0; if (i1 >= 0) mask |= 1u << i1; if (i2 >= 0) mask |= 1u << i2;
        float m = -3e38f, l = 0.f, acc[64];
#pragma unroll
        for (int d = 0; d < 64; ++d) acc[d] = 0.f;
        for (int jb = 0; jb <= n; ++jb) {
            const bool act = (jb == n) || ((mask >> jb) & 1u);
            if (!__any(act)) continue;
            const int nk = (jb == n) ? (s0 + 64 - n * 256) : 256;
            for (int kk = 0; kk < nk; ++kk) {
                const int key = jb * 256 + kk;
                const float sc = dotbf(q, KA + ((size_t)(b * SEQ + key)) * 512 + h * 64);
                const bool valid = act && (key <= s);
                if (valid) {
                    const float mn = fmaxf(m, sc), al = __builtin_amdgcn_exp2f(m - mn), p = __builtin_amdgcn_exp2f(sc - mn);
                    l = l * al + p; m = mn;
                    axpy_bf(acc, al, p, VA + ((size_t)(b * SEQ + key)) * 512 + h * 64);
                }
            }
        }
        const float il = 1.0f / l;
#pragma unroll
        for (int d = 0; d < 64; ++d) acc[d] *= il;
        store64(Y + ((size_t)(b * SEQ + s)) * DM + h * 64, acc);
    }
}

__device__ __forceinline__ void naive_ret(const bf16* QR, const bf16* KR, const bf16* VR, const bf16* GR, const float* rgain, bf16* Y, int gw, int NGW, int lane_) {
    const int lane = opaque(lane_);
    for (int wi = gw; wi < (NB * 4 * SEQ) / 64; wi += NGW) {
        const int idx0 = wi * 64, bh = idx0 / SEQ, s0 = idx0 % SEQ, b = bh >> 2, h = bh & 3, s = s0 + lane;
        const float lg = log2f(1.0f - exp2f(-5.0f - (float)h));
        float q[64]; load64(QR + ((size_t)(b * SEQ + s)) * 256 + h * 64, q);
        float acc[64];
#pragma unroll
        for (int d = 0; d < 64; ++d) acc[d] = 0.f;
        int jlo = s0 - (int)(80.0f / (-lg)); if (jlo < 0) jlo = 0;
        for (int j = jlo; j < s0 + 64; ++j) {
            const float sc = dotbf(q, KR + ((size_t)(b * SEQ + j)) * 256 + h * 64);
            const float w = (j <= s) ? sc * __builtin_amdgcn_exp2f(lg * (float)(128 * ((s >> 7) - (j >> 7)))) : 0.f;
            axpy_bf(acc, 1.0f, w, VR + ((size_t)(b * SEQ + j)) * 256 + h * 64);
        }
        float ss = 0.f;
#pragma unroll
        for (int d = 0; d < 64; ++d) ss += acc[d] * acc[d];
        const float r = 1.0f / sqrtf(ss * (1.0f / 64.0f) + EPS);
        load64(GR + ((size_t)(b * SEQ + s)) * 256 + h * 64, q);
#pragma unroll
        for (int d = 0; d < 64; ++d) acc[d] = acc[d] * r * rgain[h * 64 + d] * q[d];
        store64(Y + ((size_t)(b * SEQ + s)) * DM + 512 + h * 64, acc);
    }
}

__device__ __forceinline__ void naive_mem(const bf16* QM, const bf16* MK, const bf16* MV, bf16* Y, int gw, int NGW, int lane_) {
    const int lane = opaque(lane_);
    for (int wi = gw; wi < (NB * 4 * SEQ) / 64; wi += NGW) {
        const int idx0 = wi * 64, bh = idx0 / SEQ, s0 = idx0 % SEQ, b = bh >> 2, h = bh & 3, s = s0 + lane;
        float q[64]; load64(QM + ((size_t)(b * SEQ + s)) * 256 + h * 64, q);
        float m = -3e38f, l = 0.f, acc[64];
#pragma unroll
        for (int d = 0; d < 64; ++d) acc[d] = 0.f;
        for (int j = 0; j < MEMLEN; ++j) {
            const float sc = dotbf(q, MK + ((size_t)(b * MEMLEN + j)) * 256 + h * 64);
            const float mn = fmaxf(m, sc), al = __builtin_amdgcn_exp2f(m - mn), p = __builtin_amdgcn_exp2f(sc - mn);
            l = l * al + p; m = mn;
            axpy_bf(acc, al, p, MV + ((size_t)(b * MEMLEN + j)) * 256 + h * 64);
        }
        const float il = 1.0f / l;
#pragma unroll
        for (int d = 0; d < 64; ++d) acc[d] *= il;
        store64(Y + ((size_t)(b * SEQ + s)) * DM + 768 + h * 64, acc);
    }
}


#include <hip/hip_bf16.h>
namespace attn_body {
using s16x4=__attribute__((ext_vector_type(4)))short;
using f32x16=__attribute__((ext_vector_type(16)))float;
constexpr int D=64,NW=8,QBLK=32,QB=QBLK*NW,KVBLK=64;
__device__ __forceinline__ int crow(int r,int hi){return (r&3)+8*(r>>2)+4*hi;}
#define SBAR() __builtin_amdgcn_sched_barrier(0)
__device__ __forceinline__ void cmask(f32x16&p0,f32x16&p1,int jb,int qrel,int hi){
  const float NEG=-INFINITY; int kb=64*jb+4*hi;
  #pragma unroll
  for(int r=0;r<16;++r){int kv=kb+(r&3)+8*(r>>2); if(kv>qrel)p0[r]=NEG; if(kv+32>qrel)p1[r]=NEG;}
}
constexpr int NSLOT=3, SLOTB=8192;
constexpr int LDS_K=0, LDS_V=NSLOT*SLOTB, LDS_WS=2*NSLOT*SLOTB, LDS_OST=LDS_WS+NW*64*4, ATT_LDS_BYTES=LDS_OST+NW*4096;
__device__ __forceinline__ void glds16(const void*gsrc,unsigned lds_dst){unsigned keep;
  asm volatile("s_mov_b32 %0, m0\n\ts_mov_b32 m0, %2\n\ts_nop 0\n\tglobal_load_lds_dwordx4 %1, off\n\ts_mov_b32 m0, %0":"=&s"(keep):"v"(gsrc),"s"(lds_dst):"memory");}
__device__ __forceinline__ float max3f(float a,float b,float c){float r;asm("v_max3_f32 %0, %1, %2, %3":"=v"(r):"v"(a),"v"(b),"v"(c));return r;}
__device__ __forceinline__ float max2f(float a,float b){float r;asm("v_max_f32_e32 %0, %1, %2":"=v"(r):"v"(a),"v"(b));return r;}
__device__ __forceinline__ float fadd_s(float a,float b){float r;asm("v_add_f32_e32 %0, %1, %2":"=v"(r):"v"(a),"v"(b));return r;}
__device__ __forceinline__ float fsub_s(float a,float b){float r;asm("v_sub_f32_e32 %0, %1, %2":"=v"(r):"v"(a),"v"(b));return r;}
__device__ __forceinline__ unsigned cvtpk_s(float lo,float hi){return cvtpk(lo,hi);}
#define WAIT_BAR(N) asm volatile("s_waitcnt vmcnt(" #N ") lgkmcnt(0)\n\ts_barrier":::"memory")
__device__ __forceinline__ void qkt(f32x16&p0,f32x16&p1,const char*Kslot,const bf16x8*qr,const f32x16&negm,int r32,int hi){
  const char*kb=Kslot+hi*1024+r32*16;
  #pragma unroll
  for(int d0=0;d0<4;++d0){
    const bf16x8 b0=*reinterpret_cast<const bf16x8*>(kb+d0*2048);
    const bf16x8 b1=*reinterpret_cast<const bf16x8*>(kb+d0*2048+512);
    if(d0==0){p0=__builtin_amdgcn_mfma_f32_32x32x16_bf16(b0,qr[0],negm,0,0,0);p1=__builtin_amdgcn_mfma_f32_32x32x16_bf16(b1,qr[0],negm,0,0,0);}
    else{p0=__builtin_amdgcn_mfma_f32_32x32x16_bf16(b0,qr[d0],p0,0,0,0);p1=__builtin_amdgcn_mfma_f32_32x32x16_bf16(b1,qr[d0],p1,0,0,0);}}
}
typedef __attribute__((address_space(3))) const char* lds_cptr;
typedef short v4i16_t __attribute__((ext_vector_type(4)));
__device__ __forceinline__ void kload8(bf16x8*kf,lds_cptr kp){
  kf[0]=*(const __attribute__((address_space(3))) bf16x8*)(kp);      kf[1]=*(const __attribute__((address_space(3))) bf16x8*)(kp+512);
  kf[2]=*(const __attribute__((address_space(3))) bf16x8*)(kp+2048); kf[3]=*(const __attribute__((address_space(3))) bf16x8*)(kp+2560);
  kf[4]=*(const __attribute__((address_space(3))) bf16x8*)(kp+4096); kf[5]=*(const __attribute__((address_space(3))) bf16x8*)(kp+4608);
  kf[6]=*(const __attribute__((address_space(3))) bf16x8*)(kp+6144); kf[7]=*(const __attribute__((address_space(3))) bf16x8*)(kp+6656);
}
__device__ __forceinline__ void kload2(bf16x8*kf,lds_cptr kp,int j){ kf[2*j]=*(const __attribute__((address_space(3))) bf16x8*)(kp+j*2048); kf[2*j+1]=*(const __attribute__((address_space(3))) bf16x8*)(kp+j*2048+512); }
__device__ __forceinline__ s16x4 vtr(lds_cptr p){ return __builtin_bit_cast(s16x4,__builtin_amdgcn_ds_read_tr16_b64_v4i16((__attribute__((address_space(3))) v4i16_t*)p)); }
__device__ __forceinline__ float rowmax(const f32x16&p0,const f32x16&p1){
  float a=max3f(p0[0],p0[1],p1[0]),b=max3f(p0[2],p0[3],p1[1]);a=max3f(a,p1[2],p1[3]);
  #pragma unroll
  for(int r=4;r<16;r+=4){a=max3f(a,p0[r],p0[r+1]);b=max3f(b,p0[r+2],p0[r+3]);a=max3f(a,p1[r],p1[r+1]);b=max3f(b,p1[r+2],p1[r+3]);}
  const float m=max2f(a,b);
  auto rr=__builtin_amdgcn_permlane32_swap(__float_as_uint(m),__float_as_uint(m),false,false);
  return max2f(__uint_as_float(rr[0]),__uint_as_float(rr[1]));
}
__device__ __forceinline__ void pv(f32x16*o,int vb,bf16x8 pa0,bf16x8 pa1,bf16x8 pa2,bf16x8 pa3){
  #pragma unroll
  for(int d0=0;d0<2;++d0){s16x4 lo[4],hi[4];
    #pragma unroll
    for(int ks=0;ks<4;++ks){
      asm volatile("ds_read_b64_tr_b16 %0,%1 offset:%c2":"=&v"(lo[ks]):"v"(vb),"i"(d0*4096+ks*1024):"memory");
      asm volatile("ds_read_b64_tr_b16 %0,%1 offset:%c2":"=&v"(hi[ks]):"v"(vb),"i"(d0*4096+ks*1024+512):"memory");}
    asm volatile("s_waitcnt lgkmcnt(0)":::"memory");SBAR();
    #define PK(k) (bf16x8){lo[k][0],lo[k][1],lo[k][2],lo[k][3],hi[k][0],hi[k][1],hi[k][2],hi[k][3]}
    o[d0]=__builtin_amdgcn_mfma_f32_32x32x16_bf16(pa0,PK(0),o[d0],0,0,0);
    o[d0]=__builtin_amdgcn_mfma_f32_32x32x16_bf16(pa1,PK(1),o[d0],0,0,0);
    o[d0]=__builtin_amdgcn_mfma_f32_32x32x16_bf16(pa2,PK(2),o[d0],0,0,0);
    o[d0]=__builtin_amdgcn_mfma_f32_32x32x16_bf16(pa3,PK(3),o[d0],0,0,0);
    #undef PK
  }
}
template<int THRL,int KP,int OP,bool MOBA> __device__ __forceinline__ void attn_unit(const bf16*Qu,const bf16*__restrict__ Kh,const bf16*__restrict__ Vh,bf16*Ou,const int NT,const int nblk,const float*kmean,char*shm){
  const int tid=opaque((int)threadIdx.x),lane=tid&63,r32=lane&31,hi=lane>>5; const int wid=__builtin_amdgcn_readfirstlane(tid>>6);
  const bf16*Qw=Qu+(long)(wid*QBLK)*KP;
  const unsigned lds0=(unsigned)(uintptr_t)shm;
  float*wsf=(float*)(shm+LDS_WS)+wid*64;
  const bf16*ksrc=Kh+(long)lane*KP+wid*8;
  const bf16*vsrc=Vh+(long)(16*(wid&3)+(lane>>2))*KP+(wid>>2)*32+(lane&3)*8;
  const unsigned kdst=lds0+LDS_K+wid*1024, vdst=lds0+LDS_V+wid*1024;
  #define DMA_K(t,slot) glds16(ksrc+(long)(t)*KVBLK*KP,(unsigned)__builtin_amdgcn_readfirstlane(kdst+(slot)))
  #define DMA_V(t,slot) glds16(vsrc+(long)(t)*KVBLK*KP,(unsigned)__builtin_amdgcn_readfirstlane(vdst+(slot)))
  const int vb0=(int)(lds0+LDS_V)+((lane>>4)&1)*32+(lane&3)*8+(4*hi+((lane&15)>>2))*64;
  const char*Kbase=shm+LDS_K; bf16x8 kf[8];
  const lds_cptr shm3=(lds_cptr)shm; const lds_cptr kp0=shm3+LDS_K+hi*1024+r32*16; const lds_cptr vp0=shm3+LDS_V+((lane>>4)&1)*32+(lane&3)*8+(4*hi+((lane&15)>>2))*64;
  DMA_K(0,0);DMA_V(0,0);DMA_K(1,SLOTB);
  bf16x8 qr[4];
  #pragma unroll
  for(int d0=0;d0<4;++d0)qr[d0]=*reinterpret_cast<const bf16x8*>(&Qw[(long)r32*KP+d0*16+hi*8]);
  unsigned bmask=0xffffffffu;
  if(MOBA){
    bmask=1u<<nblk;
    float g0=-3e38f,g1=-3e38f,g2=-3e38f; int i0=-1,i1=-1,i2=-1;
    for(int j=0;j<nblk;++j){
      const float*km=kmean+(long)j*512+8*hi; float g=0.f;
      #pragma unroll
      for(int d0=0;d0<4;++d0){ const f32x4 a=*(const f32x4*)(km+16*d0),b=*(const f32x4*)(km+16*d0+4);
        g+=bf2f((unsigned short)qr[d0][0])*a[0]+bf2f((unsigned short)qr[d0][1])*a[1]+bf2f((unsigned short)qr[d0][2])*a[2]+bf2f((unsigned short)qr[d0][3])*a[3];
        g+=bf2f((unsigned short)qr[d0][4])*b[0]+bf2f((unsigned short)qr[d0][5])*b[1]+bf2f((unsigned short)qr[d0][6])*b[2]+bf2f((unsigned short)qr[d0][7])*b[3]; }
      g+=__shfl_xor(g,32);
      if(g>g0){g2=g1;i2=i1;g1=g0;i1=i0;g0=g;i0=j;} else if(g>g1){g2=g1;i2=i1;g1=g;i1=j;} else if(g>g2){g2=g;i2=j;}
    }
    if(i0>=0)bmask|=1u<<i0; if(i1>=0)bmask|=1u<<i1; if(i2>=0)bmask|=1u<<i2;
  }
  #define NEGM_FOR(t) (MOBA ? (((bmask>>((t)>>2))&1u) ? -mhat : -INFINITY) : -mhat)
  float mhat=0.f,l_reg=0.f;f32x16 o[2];o[0]=f32x16{};o[1]=f32x16{};f32x16 negm;
  { const float nm=NEGM_FOR(0);
    #pragma unroll
    for(int r=0;r<16;++r)negm[r]=nm; }
  asm volatile("":"+v"(negm));
  const int qrel=wid*QBLK+r32;
  #define CMASK(P0,P1,t) do{ if(MOBA){int jb_=(t)-(NT-4); if(jb_>=0)cmask(P0,P1,jb_,qrel,hi);} }while(0)
  bool resc=false;
  #define START(P0,P1) do{ const float rm=rowmax(P0,P1); resc=false; \
    { const float dl=(MOBA&&rm==-INFINITY)?0.f:rm; mhat=fadd_s(mhat,dl); \
      _Pragma("unroll") for(int r=0;r<16;++r){P0[r]=fsub_s(P0[r],dl);P1[r]=fsub_s(P1[r],dl);} \
      { const float nm=NEGM_FOR(1); _Pragma("unroll") for(int r=0;r<16;++r)negm[r]=nm; } asm volatile("":"+v"(negm)); } \
    _Pragma("unroll") for(int r=0;r<16;++r)P0[r]=__builtin_amdgcn_exp2f(P0[r]); }while(0)
  #define RESC() do{ if(resc){ asm volatile("s_waitcnt lgkmcnt(0)":::"memory"); \
      _Pragma("unroll") for(int d_=0;d_<2;++d_) _Pragma("unroll") for(int r=0;r<16;++r)o[d_][r]*=wsf[crow(r,hi)]; } }while(0)
  f32x16 pA0,pA1,pB0,pB1;
  int sl_prev=0,sl_cur=0,sl_next=SLOTB;
  #define ROT() do{sl_prev=sl_cur;sl_cur=sl_next;sl_next=(sl_next==(NSLOT-1)*SLOTB)?0:sl_next+SLOTB;}while(0)
  DMA_K(2,2*SLOTB);
  WAIT_BAR(3);
  qkt(pA0,pA1,Kbase,qr,negm,r32,hi);asm volatile("s_nop 15\n\ts_nop 7":"+v"(pA0),"+v"(pA1));CMASK(pA0,pA1,0);
  START(pA0,pA1);
  _Pragma("unroll") for(int r=0;r<16;++r)pA1[r]=__builtin_amdgcn_exp2f(pA1[r]);
  WAIT_BAR(0);
  DMA_K(3,0);DMA_V(1,SLOTB);
  ROT();
  kload8(kf,kp0+sl_cur);
  WAIT_BAR(2);
  s16x4 vlo[8],vhi[8]; u32x4 pw0,pw1,pw2,pw3;
  #define PKW(P,B) cvtpk_s(P[B],P[B+1])
  #define PAF(k) __builtin_bit_cast(bf16x8,pw##k)
  #define VFR(i) (bf16x8){vlo[i][0],vlo[i][1],vlo[i][2],vlo[i][3],vhi[i][0],vhi[i][1],vhi[i][2],vhi[i][3]}
  #define PIN(x) asm volatile("":"+v"(x))
  #define MX3(a,b,c) __builtin_fmaxf(__builtin_fmaxf((a),(b)),(c))
  #define GAPA(MF,A0,A1,A2,A3,W0,W1,PW) do{ MF; sacc+=A0; sacc+=A1; sacc+=A2; sacc+=A3; PIN(sacc); W0; W1; PIN(PW); SBAR(); }while(0)
  #define EX(v) __builtin_amdgcn_exp2f(v)
  #define GAPB(MF,X,B) do{ MF; X[B]=EX(X[B]); X[B+1]=EX(X[B+1]); X[B+2]=EX(X[B+2]); X[B+3]=EX(X[B+3]); PIN(X); SBAR(); }while(0)
  #define VRD(i) do{ vlo[i]=vtr(vp_+(((i)>>2)*4096+((i)&3)*1024)); vhi[i]=vtr(vp_+(((i)>>2)*4096+((i)&3)*1024+512)); }while(0)
  #define KRD(G,j) do{ if(G){ kload2(kf,kp0+sl_next,j); SBAR(); } }while(0)
  #define STEP(C0,C1,P0,P1,t,GK,GV,GL) do{ SBAR(); \
    const lds_cptr vp_=vp0+sl_prev; \
    VRD(0); SBAR(); float sacc=(P0[0]+P0[1]); \
    GAPA(C0=__builtin_amdgcn_mfma_f32_32x32x16_bf16(kf[0],qr[0],negm,0,0,0), P0[2],P0[3],P0[4],P0[5],     pw0[0]=PKW(P0,0), pw0[1]=PKW(P0,2), pw0); \
    VRD(4); SBAR(); GAPA(C1=__builtin_amdgcn_mfma_f32_32x32x16_bf16(kf[1],qr[0],negm,0,0,0), P0[6],P0[7],P0[8],P0[9],     pw0[2]=PKW(P0,4), pw0[3]=PKW(P0,6), pw0); \
    VRD(1); SBAR(); GAPA(C0=__builtin_amdgcn_mfma_f32_32x32x16_bf16(kf[2],qr[1],C0,0,0,0),   P0[10],P0[11],P0[12],P0[13], pw1[0]=PKW(P0,8), pw1[1]=PKW(P0,10), pw1); \
    VRD(5); SBAR(); GAPA(C1=__builtin_amdgcn_mfma_f32_32x32x16_bf16(kf[3],qr[1],C1,0,0,0),   P0[14],P0[15],P1[0],P1[1],   pw1[2]=PKW(P0,12),pw1[3]=PKW(P0,14), pw1); \
    VRD(2); SBAR(); GAPA(C0=__builtin_amdgcn_mfma_f32_32x32x16_bf16(kf[4],qr[2],C0,0,0,0),   P1[2],P1[3],P1[4],P1[5],     pw2[0]=PKW(P1,0), pw2[1]=PKW(P1,2), pw2); \
    VRD(6); SBAR(); GAPA(C1=__builtin_amdgcn_mfma_f32_32x32x16_bf16(kf[5],qr[2],C1,0,0,0),   P1[6],P1[7],P1[8],P1[9],     pw2[2]=PKW(P1,4), pw2[3]=PKW(P1,6), pw2); \
    VRD(3); SBAR(); GAPA(C0=__builtin_amdgcn_mfma_f32_32x32x16_bf16(kf[6],qr[3],C0,0,0,0),   P1[10],P1[11],P1[12],P1[13], pw3[0]=PKW(P1,8), pw3[1]=PKW(P1,10), pw3); \
    VRD(7); SBAR(); GAPA(C1=__builtin_amdgcn_mfma_f32_32x32x16_bf16(kf[7],qr[3],C1,0,0,0),   P1[14],P1[15],0.f,0.f,       pw3[2]=PKW(P1,12),pw3[3]=PKW(P1,14), pw3); \
    l_reg+=sacc; \
    if(GK){DMA_K((t)+3,sl_cur);} if(GV){DMA_V((t)+1,sl_next);} \
    CMASK(C0,C1,t); \
    { float a=MX3(C0[0],C0[1],C1[0]),b=MX3(C0[2],C0[3],C1[1]); a=MX3(a,C1[2],C1[3]); \
      _Pragma("unroll") for(int r=4;r<16;r+=4){a=MX3(a,C0[r],C0[r+1]);b=MX3(b,C0[r+2],C0[r+3]);a=MX3(a,C1[r],C1[r+1]);b=MX3(b,C1[r+2],C1[r+3]);} \
      float rm=__builtin_fmaxf(a,b); { auto rr=__builtin_amdgcn_permlane32_swap(__float_as_uint(rm),__float_as_uint(rm),false,false); rm=__builtin_fmaxf(__uint_as_float(rr[0]),__uint_as_float(rr[1])); } \
      resc=false; \
      if(__builtin_expect(__any(rm>(float)THRL),0)){ const float dl=__builtin_fmaxf(rm,0.f); mhat+=dl; \
        _Pragma("unroll") for(int r=0;r<16;++r){C0[r]-=dl;C1[r]-=dl;} \
        if(!MOBA){ _Pragma("unroll") for(int r=0;r<16;++r)negm[r]=-mhat; asm volatile("":"+v"(negm)); } \
        const float f=__builtin_amdgcn_exp2f(-dl); l_reg*=f; if(hi==0)wsf[r32]=f; resc=true; } \
      if(MOBA){ const float nm=NEGM_FOR((t)+1); _Pragma("unroll") for(int r=0;r<16;++r)negm[r]=nm; asm volatile("":"+v"(negm)); } } \
    SBAR(); \
    GAPB(o[0]=__builtin_amdgcn_mfma_f32_32x32x16_bf16(PAF(0),VFR(0),o[0],0,0,0), C0,0); \
    GAPB(o[1]=__builtin_amdgcn_mfma_f32_32x32x16_bf16(PAF(0),VFR(4),o[1],0,0,0), C0,4); \
    KRD(GL,0); GAPB(o[0]=__builtin_amdgcn_mfma_f32_32x32x16_bf16(PAF(1),VFR(1),o[0],0,0,0), C0,8); \
    KRD(GL,1); GAPB(o[1]=__builtin_amdgcn_mfma_f32_32x32x16_bf16(PAF(1),VFR(5),o[1],0,0,0), C0,12); \
    KRD(GL,2); GAPB(o[0]=__builtin_amdgcn_mfma_f32_32x32x16_bf16(PAF(2),VFR(2),o[0],0,0,0), C1,0); \
    KRD(GL,3); GAPB(o[1]=__builtin_amdgcn_mfma_f32_32x32x16_bf16(PAF(2),VFR(6),o[1],0,0,0), C1,4); \
    GAPB(o[0]=__builtin_amdgcn_mfma_f32_32x32x16_bf16(PAF(3),VFR(3),o[0],0,0,0), C1,8); \
    GAPB(o[1]=__builtin_amdgcn_mfma_f32_32x32x16_bf16(PAF(3),VFR(7),o[1],0,0,0), C1,12); \
    }while(0)
  int t=1;
  #undef CMASK
  #define CMASK(P0,P1,t) do{}while(0)
  for(;t+5<NT;t+=2){
    STEP(pB0,pB1,pA0,pA1,t,true,true,true);     WAIT_BAR(2); RESC(); ROT();
    STEP(pA0,pA1,pB0,pB1,t+1,true,true,true);   WAIT_BAR(2); RESC(); ROT();
  }
  #undef CMASK
  #define CMASK(P0,P1,t) do{ if(MOBA){int jb_=(t)-(NT-4); if(jb_>=0)cmask(P0,P1,jb_,qrel,hi);} }while(0)
  #define ENDW(tt) do{ if((tt)+3<NT){WAIT_BAR(2);} else if((tt)+2<NT){WAIT_BAR(1);} else {WAIT_BAR(0);} }while(0)
  for(;t+1<NT;t+=2){
    STEP(pB0,pB1,pA0,pA1,t,(t+3<NT),(t+1<NT),(t+1<NT));       ENDW(t);   RESC(); ROT();
    STEP(pA0,pA1,pB0,pB1,t+1,(t+4<NT),(t+2<NT),(t+2<NT));     ENDW(t+1); RESC(); ROT();
  }
  STEP(pB0,pB1,pA0,pA1,NT-1,false,false,false); RESC();
  { float sacc=pB0[0]+pB0[1]; _Pragma("unroll") for(int r=2;r<16;++r)sacc+=pB0[r]; _Pragma("unroll") for(int r=0;r<16;++r)sacc+=pB1[r]; l_reg+=sacc;
    pw0=(u32x4){PKW(pB0,0),PKW(pB0,2),PKW(pB0,4),PKW(pB0,6)};pw1=(u32x4){PKW(pB0,8),PKW(pB0,10),PKW(pB0,12),PKW(pB0,14)};pw2=(u32x4){PKW(pB1,0),PKW(pB1,2),PKW(pB1,4),PKW(pB1,6)};pw3=(u32x4){PKW(pB1,8),PKW(pB1,10),PKW(pB1,12),PKW(pB1,14)};
    SBAR(); pv(o,vb0+sl_cur,PAF(0),PAF(1),PAF(2),PAF(3)); }
  #undef PKW
  #undef PAF
  #undef VFR
  #undef PIN
  #undef MX3
  #undef GAPA
  #undef GAPB
  #undef EX
  #undef VRD
  #undef KRD
  #undef STEP
  #undef ENDW
  {auto rr=__builtin_amdgcn_permlane32_swap(__float_as_uint(l_reg),__float_as_uint(l_reg),false,false);l_reg=__uint_as_float(rr[0])+__uint_as_float(rr[1]);}
  if(hi==0)wsf[32+r32]=l_reg;asm volatile("s_waitcnt lgkmcnt(0)":::"memory");
  float rli[16];
  #pragma unroll
  for(int r=0;r<16;++r)rli[r]=__builtin_amdgcn_rcpf(wsf[32+crow(r,hi)]);
  bf16*Ow=Ou+(long)(wid*QBLK)*OP;
  { bf16*stg=(bf16*)(shm+LDS_OST)+wid*2048;
    #pragma unroll
    for(int r=0;r<16;++r){const int orow=crow(r,hi);
      #pragma unroll
      for(int d0=0;d0<2;++d0)stg[orow*64+d0*32+r32]=(bf16)(cvtpk(o[d0][r]*rli[r],0.f)&0xffffu);}
    asm volatile("s_waitcnt lgkmcnt(0)":::"memory");
    #pragma unroll
    for(int i=0;i<4;++i){const int row=i*8+(lane>>3),ch=lane&7; const u32x4 v=*(const u32x4*)(stg+row*64+ch*8); *(u32x4*)(Ow+(long)row*OP+ch*8)=v;} }
  asm volatile("s_waitcnt lgkmcnt(0)\n\ts_barrier":::"memory");
  #undef DMA_K
  #undef DMA_V
  #undef CMASK
  #undef START
  #undef RESC
  #undef ROT
  #undef NEGM_FOR
}
#undef SBAR
#undef WAIT_BAR
}

namespace ret_body {
using attn_body::s16x4; using attn_body::f32x16; using attn_body::glds16; using attn_body::pv; using attn_body::crow;
constexpr int KVF_BYTES = 64 * 64 * 4;
__device__ __forceinline__ void kv_unit(const bf16* KR, const bf16* VR, float* KVF, int b, int h, int cp, char* shm) {
  const int tid = opaque((int)threadIdx.x), lane = tid & 63, r32 = lane & 31, hi = lane >> 5; const int wid = __builtin_amdgcn_readfirstlane(tid >> 6);
  const unsigned lds0 = (unsigned)(uintptr_t)shm;
  const size_t rowb = (size_t)b * SEQ + (size_t)cp * 256;
  const long voff = (long)(16 * (wid & 3) + (lane >> 2)) * 256 + h * 64 + (wid >> 2) * 32 + (lane & 3) * 8;
#pragma unroll
  for (int c = 0; c < 2; ++c)
#pragma unroll
    for (int tl = 0; tl < 2; ++tl) {
      const size_t r0 = rowb + c * 128 + tl * 64;
      glds16(KR + r0 * 256 + voff, (unsigned)__builtin_amdgcn_readfirstlane(lds0 + ((c * 2 + 0) * 2 + tl) * 8192 + wid * 1024));
      glds16(VR + r0 * 256 + voff, (unsigned)__builtin_amdgcn_readfirstlane(lds0 + ((c * 2 + 1) * 2 + tl) * 8192 + wid * 1024));
    }
  asm volatile("s_waitcnt vmcnt(0) lgkmcnt(0)\n\ts_barrier" ::: "memory");
  const int c = wid >> 2, dkb = (wid >> 1) & 1, dvb = wid & 1;
  const int vb = (int)lds0 + ((lane >> 4) & 1) * 32 + (lane & 3) * 8 + (4 * hi + ((lane & 15) >> 2)) * 64;
  f32x16 acc = f32x16{};
#pragma unroll
  for (int tl = 0; tl < 2; ++tl) {
    s16x4 alo[4], ahi[4], blo[4], bhi[4];
    const int ka = vb + ((c * 2 + 0) * 2 + tl) * 8192 + dkb * 4096, va = vb + ((c * 2 + 1) * 2 + tl) * 8192 + dvb * 4096;
#pragma unroll
    for (int ks = 0; ks < 4; ++ks) {
      asm volatile("ds_read_b64_tr_b16 %0,%1 offset:%c2" : "=&v"(alo[ks]) : "v"(ka), "i"(ks * 1024) : "memory");
      asm volatile("ds_read_b64_tr_b16 %0,%1 offset:%c2" : "=&v"(ahi[ks]) : "v"(ka), "i"(ks * 1024 + 512) : "memory");
      asm volatile("ds_read_b64_tr_b16 %0,%1 offset:%c2" : "=&v"(blo[ks]) : "v"(va), "i"(ks * 1024) : "memory");
      asm volatile("ds_read_b64_tr_b16 %0,%1 offset:%c2" : "=&v"(bhi[ks]) : "v"(va), "i"(ks * 1024 + 512) : "memory");
    }
    asm volatile("s_waitcnt lgkmcnt(0)" ::: "memory"); __builtin_amdgcn_sched_barrier(0);
#pragma unroll
    for (int ks = 0; ks < 4; ++ks) {
      const bf16x8 af = (bf16x8){alo[ks][0], alo[ks][1], alo[ks][2], alo[ks][3], ahi[ks][0], ahi[ks][1], ahi[ks][2], ahi[ks][3]};
      const bf16x8 bfr = (bf16x8){blo[ks][0], blo[ks][1], blo[ks][2], blo[ks][3], bhi[ks][0], bhi[ks][1], bhi[ks][2], bhi[ks][3]};
      acc = __builtin_amdgcn_mfma_f32_32x32x16_bf16(af, bfr, acc, 0, 0, 0);
    }
  }
  const float lgam = __builtin_amdgcn_logf(1.0f - __builtin_amdgcn_exp2f(-5.0f - (float)h));
  const float g127 = __builtin_amdgcn_exp2f(lgam * 127.0f);
  float* outp = KVF + ((size_t)((b * 4 + h) * 32 + cp * 2 + c)) * 4096 + dvb * 32 + r32;
#pragma unroll
  for (int r = 0; r < 16; ++r) outp[(size_t)(dkb * 32 + crow(r, hi)) * 64] = acc[r] * g127;
  asm volatile("s_waitcnt lgkmcnt(0)\n\ts_barrier" ::: "memory");
}

__device__ __forceinline__ void out_unit(const bf16* QR, const bf16* KR, const bf16* VR, const bf16* GR, const float* KVF, const float* rgain, bf16* Y, int b, int h, int cp, char* shm) {
  const int tid = opaque((int)threadIdx.x), lane = tid & 63, r32 = lane & 31, hi = lane >> 5; const int wid = __builtin_amdgcn_readfirstlane(tid >> 6);
  const unsigned lds0 = (unsigned)(uintptr_t)shm;
  constexpr int L_K = 0, L_V = 32768, L_S = 65536, L_O = 81920;
  const size_t rowb = (size_t)b * SEQ + (size_t)cp * 256;
  const long koff = (long)lane * 256 + h * 64 + wid * 8;
  const long voff = (long)(16 * (wid & 3) + (lane >> 2)) * 256 + h * 64 + (wid >> 2) * 32 + (lane & 3) * 8;
#pragma unroll
  for (int tl = 0; tl < 4; ++tl) {
    const size_t r0 = rowb + tl * 64;
    glds16(KR + r0 * 256 + koff, (unsigned)__builtin_amdgcn_readfirstlane(lds0 + L_K + tl * 8192 + wid * 1024));
    glds16(VR + r0 * 256 + voff, (unsigned)__builtin_amdgcn_readfirstlane(lds0 + L_V + tl * 8192 + wid * 1024));
  }
  {
    const float lgam = __builtin_amdgcn_logf(1.0f - __builtin_amdgcn_exp2f(-5.0f - (float)h));
    const float lgc = lgam * 128.0f;
    const int n0 = 2 * cp;
    int mlo = n0 - 1 - (int)(34.0f / (-lgc)); if (mlo < 0) mlo = 0;
    const float* kvp = KVF + ((size_t)((b * 4 + h) * 32)) * 4096 + tid * 8;
    f32x4 s0 = {0.f, 0.f, 0.f, 0.f}, s1 = {0.f, 0.f, 0.f, 0.f};
    for (int m = mlo; m < n0; ++m) {
      const float w = __builtin_amdgcn_exp2f(lgc * (float)(n0 - 1 - m));
      const f32x4 a = *(const f32x4*)(kvp + (size_t)m * 4096), c4 = *(const f32x4*)(kvp + (size_t)m * 4096 + 4);
      s0 += a * w; s1 += c4 * w;
    }
    const int dk = tid >> 3, dv = 8 * (tid & 7);
    char* sp = shm + L_S + (dv >> 5) * 4096 + dk * 64 + (dv & 31) * 2;
    u32x4 w0; w0.x = cvtpk(s0[0], s0[1]); w0.y = cvtpk(s0[2], s0[3]); w0.z = cvtpk(s1[0], s1[1]); w0.w = cvtpk(s1[2], s1[3]);
    *(u32x4*)sp = w0;
    const float dc = __builtin_amdgcn_exp2f(lgc);
    const f32x4 a = *(const f32x4*)(kvp + (size_t)n0 * 4096), c4 = *(const f32x4*)(kvp + (size_t)n0 * 4096 + 4);
    s0 = s0 * dc + a; s1 = s1 * dc + c4;
    u32x4 w1; w1.x = cvtpk(s0[0], s0[1]); w1.y = cvtpk(s0[2], s0[3]); w1.z = cvtpk(s1[0], s1[1]); w1.w = cvtpk(s1[2], s1[3]);
    *(u32x4*)(sp + 8192) = w1;
  }
  const int c = wid >> 2, wq = wid & 3;
  const bf16* Qw = QR + (rowb + c * 128 + wq * 32 + r32) * 256 + h * 64;
  bf16x8 qr[4]; u32x4 qa[4];
#pragma unroll
  for (int d0 = 0; d0 < 4; ++d0) qr[d0] = *reinterpret_cast<const bf16x8*>(Qw + d0 * 16 + hi * 8);
#pragma unroll
  for (int k = 0; k < 4; ++k) { const u32x2 lo = *(const u32x2*)(Qw + 16 * k + 4 * hi), hi2 = *(const u32x2*)(Qw + 16 * k + 8 + 4 * hi); qa[k] = (u32x4){lo.x, lo.y, hi2.x, hi2.y}; }
  asm volatile("s_waitcnt vmcnt(0) lgkmcnt(0)\n\ts_barrier" ::: "memory");
  const int vb = (int)lds0 + ((lane >> 4) & 1) * 32 + (lane & 3) * 8 + (4 * hi + ((lane & 15) >> 2)) * 64;
  f32x16 o[2]; o[0] = f32x16{}; o[1] = f32x16{};
  pv(o, vb + L_S + c * 8192, __builtin_bit_cast(bf16x8, qa[0]), __builtin_bit_cast(bf16x8, qa[1]), __builtin_bit_cast(bf16x8, qa[2]), __builtin_bit_cast(bf16x8, qa[3]));
  { const float gam = 1.0f - __builtin_amdgcn_exp2f(-5.0f - (float)h);
#pragma unroll
    for (int d0 = 0; d0 < 2; ++d0)
#pragma unroll
      for (int r = 0; r < 16; ++r) o[d0][r] *= gam; }
  const f32x16 zero = f32x16{};
  const int irow = wq * 32 + r32;
  for (int tl = 0; tl <= (wq >> 1); ++tl) {
    f32x16 p0, p1;
    attn_body::qkt(p0, p1, shm + L_K + (c * 2 + tl) * 8192, qr, zero, r32, hi);
    asm volatile("s_nop 15\n\ts_nop 7" : "+v"(p0), "+v"(p1));
#pragma unroll
    for (int r = 0; r < 16; ++r) { const int kj = 64 * tl + crow(r, hi); if (kj > irow) p0[r] = 0.f; if (kj + 32 > irow) p1[r] = 0.f; }
    u32x4 pw0, pw1, pw2, pw3;
    pw0 = (u32x4){cvtpk(p0[0], p0[1]), cvtpk(p0[2], p0[3]), cvtpk(p0[4], p0[5]), cvtpk(p0[6], p0[7])}; pw1 = (u32x4){cvtpk(p0[8], p0[9]), cvtpk(p0[10], p0[11]), cvtpk(p0[12], p0[13]), cvtpk(p0[14], p0[15])};
    pw2 = (u32x4){cvtpk(p1[0], p1[1]), cvtpk(p1[2], p1[3]), cvtpk(p1[4], p1[5]), cvtpk(p1[6], p1[7])}; pw3 = (u32x4){cvtpk(p1[8], p1[9]), cvtpk(p1[10], p1[11]), cvtpk(p1[12], p1[13]), cvtpk(p1[14], p1[15])};
    __builtin_amdgcn_sched_barrier(0);
    pv(o, vb + L_V + (c * 2 + tl) * 8192, __builtin_bit_cast(bf16x8, pw0), __builtin_bit_cast(bf16x8, pw1), __builtin_bit_cast(bf16x8, pw2), __builtin_bit_cast(bf16x8, pw3));
  }
  asm volatile("s_waitcnt lgkmcnt(0)\n\ts_barrier" ::: "memory");
  { float* stg = (float*)(shm + L_O) + wid * 2048;
#pragma unroll
    for (int r = 0; r < 16; ++r) { const int orow = crow(r, hi);
#pragma unroll
      for (int d0 = 0; d0 < 2; ++d0) stg[orow * 64 + d0 * 32 + r32] = o[d0][r]; }
    asm volatile("s_waitcnt lgkmcnt(0)" ::: "memory");
    const int row = lane >> 1, half = lane & 1;
    const f32x4* sr = (const f32x4*)(stg + row * 64 + half * 32);
    f32x4 v[8]; float ss = 0.f;
#pragma unroll
    for (int i = 0; i < 8; ++i) { v[i] = sr[i]; ss += (v[i][0] * v[i][0] + v[i][1] * v[i][1]) + (v[i][2] * v[i][2] + v[i][3] * v[i][3]); }
    ss += __shfl_xor(ss, 1);
    const float rstd = 1.0f / sqrtf(ss * (1.0f / 64.0f) + EPS);
    const size_t grow = rowb + c * 128 + wq * 32 + row;
    const u32x4* gp = (const u32x4*)(GR + grow * 256 + h * 64 + half * 32);
    const f32x4* rg = (const f32x4*)(rgain + h * 64 + half * 32);
    u32x4* yp = (u32x4*)(Y + grow * DM + 512 + h * 64 + half * 32);
#pragma unroll
    for (int i = 0; i < 4; ++i) {
      const u32x4 gw = gp[i]; const f32x4 g0 = rg[2 * i], g1 = rg[2 * i + 1]; const f32x4 a = v[2 * i] * rstd * g0, c4 = v[2 * i + 1] * rstd * g1;
      u32x4 w; w.x = cvtpk(a[0] * bflo(gw.x), a[1] * bfhi(gw.x)); w.y = cvtpk(a[2] * bflo(gw.y), a[3] * bfhi(gw.y)); w.z = cvtpk(c4[0] * bflo(gw.z), c4[1] * bfhi(gw.z)); w.w = cvtpk(c4[2] * bflo(gw.w), c4[3] * bfhi(gw.w));
      yp[i] = w;
    }
  }
  asm volatile("s_waitcnt lgkmcnt(0)\n\ts_barrier" ::: "memory");
}
}

#define XB_TMO      128
#define XB_XCNT(j)  (256  + 64 * (j))
#define XB_XSUB(j)  (1280 + 64 * (j))
#define XB_XGEN(j)  (2304 + 64 * (j))
#define XB_TOP      3328
#define XB_TOPGEN   3392
#define XCD_BAR_WORDS 3456
#define XB_SPIN_CAP (1u << 18)
__device__ __forceinline__ unsigned xb_ld(unsigned* p)              { return __hip_atomic_load(p, __ATOMIC_RELAXED, __HIP_MEMORY_SCOPE_AGENT); }
__device__ __forceinline__ unsigned xb_add(unsigned* p, unsigned v) { return __hip_atomic_fetch_add(p, v, __ATOMIC_RELAXED, __HIP_MEMORY_SCOPE_AGENT); }
__device__ __forceinline__ unsigned xb_xcc_id() { return (unsigned)__builtin_amdgcn_s_getreg((3 << 11) | 20) & 0xFu; }
#define XB_SPIN(cond, bar) do { unsigned _sp = 0; while (cond) { __builtin_amdgcn_s_sleep(1); \
    if ((++_sp & 255u) == 0u) { if (xb_ld(&(bar)[XB_TMO])) break; if (_sp > XB_SPIN_CAP) { atomicAdd(&(bar)[XB_TMO], 1u); break; } } } } while (0)
struct XcdBarrier { unsigned* bar; unsigned x; volatile LAS unsigned* st; };
__device__ __forceinline__ XcdBarrier xcd_barrier_post(unsigned* bar, volatile LAS unsigned* st) {
    XcdBarrier b; b.bar = bar; b.x = xb_xcc_id(); b.st = st;
    if (threadIdx.x == 0) (void)xb_add(&bar[XB_XCNT(b.x)], 1u);
    return b;
}
__device__ __forceinline__ void xcd_barrier_complete(unsigned* bar, unsigned x, unsigned& nloc, unsigned& nx) {
    const unsigned G = gridDim.x * gridDim.y * gridDim.z;
    unsigned sum, cnt, mine, sp = 0u;
    for (;;) {
        sum = 0u; cnt = 0u; mine = 0u;
#pragma unroll
        for (unsigned j = 0; j < 16; ++j) { const unsigned c = xb_ld(&bar[XB_XCNT(j)]); sum += c; cnt += (c > 0u) ? 1u : 0u; mine = (j == x) ? c : mine; }
        if (sum == G) break;
        __builtin_amdgcn_s_sleep(1);
        if ((++sp & 255u) == 0u) { if (xb_ld(&bar[XB_TMO])) break; if (sp > XB_SPIN_CAP) { atomicAdd(&bar[XB_TMO], 1u); break; } }
    }
    nloc = mine > 0u ? mine : 1u; nx = cnt > 0u ? cnt : 1u;
}
__device__ __forceinline__ void xcd_barrier(const XcdBarrier& b) {
    asm volatile("s_waitcnt vmcnt(0)" ::: "memory");
    __syncthreads();
    if (threadIdx.x == 0) {
        unsigned* bar = b.bar;
        __builtin_amdgcn_s_waitcnt(0);
        unsigned nloc = b.st[0], nx = b.st[1];
        if (nloc == 0u) { xcd_barrier_complete(bar, b.x, nloc, nx); b.st[0] = nloc; b.st[1] = nx; }
        const unsigned old = xb_add(&bar[XB_XSUB(b.x)], 1u);
        const unsigned gen = old / nloc;
        if (old + 1u == (gen + 1u) * nloc) {
            __builtin_amdgcn_fence(__ATOMIC_RELEASE, "agent");
            asm volatile("s_waitcnt vmcnt(0)" ::: "memory");
            const unsigned og = xb_add(&bar[XB_TOP], 1u);
            const unsigned tg = og / nx;
            if (og + 1u == (tg + 1u) * nx) xb_add(&bar[XB_TOPGEN], 1u);
            else XB_SPIN(xb_ld(&bar[XB_TOPGEN]) == tg, bar);
            __builtin_amdgcn_fence(__ATOMIC_ACQUIRE, "agent");
            xb_add(&bar[XB_XGEN(b.x)], 1u);
            asm volatile("s_waitcnt vmcnt(0)" ::: "memory");
        } else {
            XB_SPIN(xb_ld(&bar[XB_XGEN(b.x)]) == gen, bar);
            __builtin_amdgcn_fence(__ATOMIC_ACQUIRE, "agent");
            asm volatile("s_waitcnt vmcnt(0)" ::: "memory");
        }
    }
    __syncthreads();
}

__global__ void __launch_bounds__(NTHREADS, 2) fwd_kernel(Args args) {
    extern __shared__ __attribute__((aligned(16))) unsigned char lds_raw[];
    LAS unsigned char* lds = (LAS unsigned char*)lds_raw;
    cg::grid_group grid = cg::this_grid();
    const int tid0 = threadIdx.x, wave = __builtin_amdgcn_readfirstlane(tid0 >> 6);
#define PHASE_LANES const int tid = opaque(tid0), lane = tid & 63; (void)lane; (void)tid
    const int G = gridDim.x, bx = blockIdx.x;
    const int vcu = (G % 8 == 0) ? (bx % 8) * (G / 8) + bx / 8 : bx;
    const int gw = vcu * NWAVES + wave, NGW = G * NWAVES;
    unsigned char* const ws = args.ws;
#define WSP(type, off) ((type*)(ws + (off)))
    if (tid0 < 64) ((LAS unsigned*)(lds + LDS_MISC))[tid0] = 0u;
    __syncthreads();
    const XcdBarrier xbar = xcd_barrier_post(WSP(unsigned, WS_BAR), (volatile LAS unsigned*)(lds + LDS_MISC));
#define GRID_BAR() xcd_barrier(xbar)
    REPN(0) {
        PHASE_LANES;
        LAS float* scr = (LAS float*)(lds + wave * 16384);
        const float* x = args.in[0]; const float* mem = args.in[1]; const float* g_attn = args.in[2]; const float* w_in = args.in[3]; const float* g_mem = args.in[7];
        const float* w_mem_kv = args.in[8]; const float* w_out = args.in[11]; const float* g_ffn = args.in[12]; const float* w_router = args.in[13]; const float* w1 = args.in[15]; const float* w2 = args.in[17];
        bf16* WIN_T = WSP(bf16, WS_WIN); bf16* WMEM_T = WSP(bf16, WS_WMEM); bf16* WOUT_T = WSP(bf16, WS_WOUT); unsigned char* W1_8 = WSP(unsigned char, WS_W1); unsigned char* W2_8 = WSP(unsigned char, WS_W2);
        bf16* XN = WSP(bf16, WS_XN); bf16* MEMN = WSP(bf16, WS_MEMN); float* WRG = WSP(float, WS_WRG);
        constexpr int I0 = 16 * 88, I1 = 16 * 16, I2 = 16 * 32, I3 = 32 * 16 * 64, I4 = 32 * 16 * 32, NIT = I0 + I1 + I2 + I3 + I4;
        for (int it = gw; it < NIT; it += NGW) {
            int r = it;
            if (r < I0) { const int nb = r % 88, kb = r / 88; transpose_item(w_in, NIN, WIN_T, headperm_row(nb * 32), scr, kb * 64, nb * 32, lane); continue; } r -= I0;
            if (r < I1) { const int nb = r % 16, kb = r / 16; transpose_item(w_mem_kv, 512, WMEM_T, headperm_row(nb * 32), scr, kb * 64, nb * 32, lane); continue; } r -= I1;
            if (r < I2) { const int nb = r % 32, kb = r / 32; transpose_item(w_out, 1024, WOUT_T, nb * 32, scr, kb * 64, nb * 32, lane); continue; } r -= I2;
            if (r < I3) { const int e = r / 1024, rr = r % 1024, nb = rr % 64, kb = rr / 64; transpose_item_fp8<true>(w1 + (size_t)e * 1024 * 2048, 2048, W1_8 + (size_t)e * 2048 * 1024, scr, kb * 64, nb * 32, lane); continue; } r -= I3;
            { const int e = r / 512, rr = r % 512, nb = rr % 32, kb = rr / 32; transpose_item_fp8<false>(w2 + (size_t)e * 1024 * 1024, 1024, W2_8 + (size_t)e * 1024 * 1024, scr, kb * 64, nb * 32, lane); }
        }
        for (int m = gw; m < T + MROWS; m += NGW) {
            if (m < T) rms_row_to_bf16(x + (size_t)m * DM, g_attn, XN + (size_t)m * DM, lane);
            else rms_row_to_bf16(mem + (size_t)(m - T) * DM, g_mem, MEMN + (size_t)(m - T) * DM, lane);
        }
        for (int i = bx * NTHREADS + tid; i < DM * NEXP; i += G * NTHREADS) WRG[i] = g_ffn[i >> 5] * w_router[i];
    }
    grid.sync();

    REPN(1) {
        SchedProj S{G, bx, (const char*)(ws + WS_XN), (const char*)(ws + WS_MEMN), (const char*)(ws + WS_WIN), (const char*)(ws + WS_WMEM)};
        EpiProj E{ws, args.in[4], args.in[5], args.in[9], args.in[10]};
#ifndef NO_G1
        pg8::gemm_phase<EpiProj, SchedProj>(lds, S, E);
#endif
    }
    GRID_BAR();

#ifndef NAIVE_RET
    REPN(2) for (int i = 0; i < 2; ++i) {
        const int u = vcu * 2 + i, bh = u >> 4, cp = u & 15;
        ret_body::kv_unit(WSP(bf16, WS_KR), WSP(bf16, WS_VR), WSP(float, WS_RET), bh >> 2, bh & 3, cp, (char*)lds_raw);
    }
    GRID_BAR();
#endif
    { PHASE_LANES;
#ifdef NAIVE_MOBA
    naive_moba(WSP(bf16, WS_QA), WSP(bf16, WS_KA), WSP(bf16, WS_VA), WSP(float, WS_KMEAN), WSP(bf16, WS_Y), gw, NGW, lane);
#else
    REPN(20) for (int i = 0; i < 4; ++i) {
        const int bh = vcu >> 2, s = vcu & 3, nb = (i == 0) ? s : (i == 1) ? 7 - s : (i == 2) ? 8 + s : 15 - s, b = bh >> 3, h = bh & 7;
        const size_t row0 = (size_t)b * SEQ + (size_t)nb * 256;
        attn_body::attn_unit<8, 512, 1024, true>(WSP(bf16, WS_QA) + row0 * 512 + h * 64, WSP(bf16, WS_KA) + (size_t)b * SEQ * 512 + h * 64, WSP(bf16, WS_VA) + (size_t)b * SEQ * 512 + h * 64,
                                                 WSP(bf16, WS_Y) + row0 * DM + h * 64, 4 * nb + 4, nb, WSP(float, WS_KMEAN) + ((size_t)b * 16 * 8 + h) * 64, (char*)lds_raw);
    }
#endif
#ifdef NAIVE_RET
    naive_ret(WSP(bf16, WS_QR), WSP(bf16, WS_KR), WSP(bf16, WS_VR), WSP(bf16, WS_GR), args.in[6], WSP(bf16, WS_Y), gw, NGW, lane);
#else
    REPN(21) for (int i = 0; i < 2; ++i) {
        const int u = vcu * 2 + i, bh = u >> 4, cp = u & 15;
        ret_body::out_unit(WSP(bf16, WS_QR), WSP(bf16, WS_KR), WSP(bf16, WS_VR), WSP(bf16, WS_GR), WSP(float, WS_RET), args.in[6], WSP(bf16, WS_Y), bh >> 2, bh & 3, cp, (char*)lds_raw);
    }
#endif
#ifdef NAIVE_MEM
    naive_mem(WSP(bf16, WS_QM), WSP(bf16, WS_MK), WSP(bf16, WS_MV), WSP(bf16, WS_Y), gw, NGW, lane);
#else
    REPN(22) for (int i = 0; i < 2; ++i) {
        const int u = vcu * 2 + i, bh = u >> 4, qb = u & 15, b = bh >> 2, h = bh & 3;
        const size_t row0 = (size_t)b * SEQ + (size_t)qb * 256;
        attn_body::attn_unit<8, 256, 1024, false>(WSP(bf16, WS_QM) + row0 * 256 + h * 64, WSP(bf16, WS_MK) + (size_t)b * MEMLEN * 256 + h * 64, WSP(bf16, WS_MV) + (size_t)b * MEMLEN * 256 + h * 64,
                                                  WSP(bf16, WS_Y) + row0 * DM + 768 + h * 64, 4, 0, nullptr, (char*)lds_raw);
    }
#endif
    }
    GRID_BAR();

    REPN(3) {
        SchedPlain S{G, bx, 128, 4, (const char*)(ws + WS_Y), (const char*)(ws + WS_WOUT)};
        EpiOut E{args.in[0], args.out, WSP(float, WS_SSQ)};
#ifndef NO_G2
        pg8::gemm_phase<EpiOut, SchedPlain>(lds, S, E);
#endif
    }
    GRID_BAR();

    REPN(4) {
        PHASE_LANES;
        float* out = args.out; const float* b_router = args.in[14];
        float* WRG = WSP(float, WS_WRG); float* SSQ = WSP(float, WS_SSQ); int* TOPI = WSP(int, WS_TOPI); float* TOPW = WSP(float, WS_TOPW); int* LRANK = WSP(int, WS_LRANK); int* LCOUNT = WSP(int, WS_LCOUNT);
        unsigned char* XN2 = WSP(unsigned char, WS_XN2); const float* g_ffn = args.in[12];
        if (bx == 0 && tid < 64) ((u32x4*)(XN2 + (size_t)T * DM))[tid] = (u32x4){0u, 0u, 0u, 0u};
        LAS float* lg = (LAS float*)(lds) + wave * (16 * 33);
        LAS int* hist = (LAS int*)(lds + 32768);
        if (tid < 32) hist[tid] = 0;
        __syncthreads();
        const int tpw = T / (G * NWAVES);
        for (int tb = 0; tb < tpw; tb += 16) {
            const int t0 = (bx * NWAVES + wave) * tpw + tb;
            const int i = lane & 15, kq = lane >> 4;
            f32x4 a0 = {0.f, 0.f, 0.f, 0.f}, a1 = {0.f, 0.f, 0.f, 0.f};
            const float* xr = out + (size_t)(t0 + i) * DM + 4 * kq;
            const float* wb = WRG + (size_t)(4 * kq) * 32 + i;
            float rstd;
            { const f32x4* sp = (const f32x4*)(SSQ + (size_t)(t0 + i) * 16); const f32x4 s0 = sp[0], s1 = sp[1], s2 = sp[2], s3 = sp[3];
              const float ss = ((s0[0] + s0[1]) + (s0[2] + s0[3])) + ((s1[0] + s1[1]) + (s1[2] + s1[3])) + ((s2[0] + s2[1]) + (s2[2] + s2[3])) + ((s3[0] + s3[1]) + (s3[2] + s3[3]));
              rstd = 1.0f / sqrtf(ss * (1.0f / DM) + EPS); }
            unsigned char* xo = XN2 + (size_t)(t0 + i) * DM + 4 * kq;
            const float* gp = g_ffn + 4 * kq;
#pragma unroll 4
            for (int c = 0; c < 64; ++c) {
                const f32x4 av = *(const f32x4*)(xr + 16 * c);
                { const f32x4 gg = *(const f32x4*)(gp + 16 * c); int w = 0; w = __builtin_amdgcn_cvt_pk_fp8_f32(av[0] * rstd * gg[0], av[1] * rstd * gg[1], w, false); w = __builtin_amdgcn_cvt_pk_fp8_f32(av[2] * rstd * gg[2], av[3] * rstd * gg[3], w, true); *(int*)(xo + 16 * c) = w; }
#pragma unroll
                for (int q = 0; q < 4; ++q) {
                    const float b0 = wb[(size_t)(16 * c + q) * 32], b1v = wb[(size_t)(16 * c + q) * 32 + 16];
                    a0 = __builtin_amdgcn_mfma_f32_16x16x4f32(av[q], b0, a0, 0, 0, 0);
                    a1 = __builtin_amdgcn_mfma_f32_16x16x4f32(av[q], b1v, a1, 0, 0, 0);
                }
            }
#pragma unroll
            for (int r = 0; r < 4; ++r) { lg[(4 * kq + r) * 33 + i] = a0[r]; lg[(4 * kq + r) * 33 + 16 + i] = a1[r]; }
            LDS_WAIT(); asm volatile("" ::: "memory");
            if (lane < 16) {
                const int t = t0 + lane;
                float v[32];
#pragma unroll
                for (int e = 0; e < 32; ++e) v[e] = lg[lane * 33 + e] * rstd + b_router[e];
                int bi[4]; float bvv[4];
#pragma unroll
                for (int k = 0; k < 4; ++k) {
                    float best = -3e38f; int be = 0;
#pragma unroll
                    for (int e = 0; e < 32; ++e) { const bool take = v[e] > best; best = take ? v[e] : best; be = take ? e : be; }
                    bi[k] = be; bvv[k] = best;
#pragma unroll
                    for (int e = 0; e < 32; ++e) v[e] = (e == be) ? -3e38f : v[e];
                }
                const float e1 = __expf(bvv[1] - bvv[0]), e2 = __expf(bvv[2] - bvv[0]), e3 = __expf(bvv[3] - bvv[0]);
                const float inv = 1.0f / (1.0f + e1 + e2 + e3);
                const float wv[4] = {inv, e1 * inv, e2 * inv, e3 * inv};
#pragma unroll
                for (int k = 0; k < 4; ++k) {
                    const int rk = atomicAdd((int*)&hist[bi[k]], 1);
                    TOPI[t * 4 + k] = bi[k]; TOPW[t * 4 + k] = wv[k]; LRANK[t * 4 + k] = rk;
                }
            }
            LDS_WAIT(); asm volatile("" ::: "memory");
        }
        __syncthreads();
        if (tid < 32) LCOUNT[bx * 32 + tid] = hist[tid];
    }
    GRID_BAR();

    REPN(5) {
        PHASE_LANES;
        int* TOPI = WSP(int, WS_TOPI); float* TOPW = WSP(float, WS_TOPW); int* LRANK = WSP(int, WS_LRANK); int* LCOUNT = WSP(int, WS_LCOUNT);
        int* POS = WSP(int, WS_POS); float* ROWW = WSP(float, WS_ROWW); int* PSTART = WSP(int, WS_PSTART); int* TILEEXP = WSP(int, WS_TILEEXP);
        LAS int* part = (LAS int*)(lds);
        LAS int* base = (LAS int*)(lds + 8192);
        {
            const int e = tid & 31, p = tid >> 5; int c = 0, pre = 0;
            const int wpp = (G + 15) / 16;
            for (int w = p * wpp; w < (p + 1) * wpp && w < G; ++w) { const int v = LCOUNT[w * 32 + e]; c += v; pre += (w < bx) ? v : 0; }
            part[p * 32 + e] = c; part[512 + p * 32 + e] = pre;
        }
        __syncthreads();
        if (tid < 32) { int c = 0, pre = 0; for (int p = 0; p < 16; ++p) { c += part[p * 32 + tid]; pre += part[512 + p * 32 + tid]; } part[1024 + tid] = c; part[1056 + tid] = pre; }
        __syncthreads();
        if (tid == 0) {
            int ps = 0;
            for (int e = 0; e < 32; ++e) {
                const int c = part[1024 + e], nt_ = (c + 255) >> 8;
                base[32 + e] = ps; base[e] = ps + part[1056 + e];
                if (bx == 0) { PSTART[e] = ps; for (int tt = 0; tt < nt_; ++tt) TILEEXP[(ps >> 8) + tt] = e; }
                ps += nt_ * 256;
            }
            base[64] = ps; if (bx == 0) PSTART[32] = ps;
        }
        __syncthreads();
        int* ROWTOK = WSP(int, WS_ROWTOK);
        if (bx < 32) {
            const int c = part[1024 + bx], r0 = base[32 + bx] + c, r1 = base[32 + bx] + (((c + 255) >> 8) << 8);
            for (int r = r0 + tid; r < r1; r += NTHREADS) { ROWTOK[r] = T; ROWW[r] = 0.f; }
        }
        for (int a = tid; a < (T / G) * 4; a += NTHREADS) {
            const int ta = (bx * (T / G)) * 4 + a;
            const int e = TOPI[ta]; const int pos = base[e] + LRANK[ta];
            POS[ta] = pos; ROWTOK[pos] = ta >> 2; ROWW[pos] = TOPW[ta];
        }
    }
    GRID_BAR();

    const int ntiles = WSP(int, WS_PSTART)[32] >> 8;
    REPN(6) {
        SchedMoe S{G, vcu, 8, ntiles, WSP(int, WS_TILEEXP), (const char*)(ws + WS_XN2), (const char*)(ws + WS_W1), (size_t)2048 * 1024, WSP(int, WS_ROWTOK)};
        EpiSwiglu E{args.in[16], WSP(unsigned char, WS_H)};
#ifndef NO_G3
        pg8::gemm_phase<EpiSwiglu, SchedMoe, true, true>(lds, S, E);
#endif
    }
    GRID_BAR();
    REPN(7) {
        SchedMoe S{G, vcu, 4, ntiles, WSP(int, WS_TILEEXP), (const char*)(ws + WS_H), (const char*)(ws + WS_W2), (size_t)1024 * 1024, nullptr};
        EpiDown E{args.in[18], WSP(float, WS_ROWW), WSP(bf16, WS_XG)};
#ifndef NO_G4
        pg8::gemm_phase<EpiDown, SchedMoe, false, true>(lds, S, E);
#endif
    }
    GRID_BAR();
    { PHASE_LANES;
    for (int t = gw; t < T; t += NGW) {
        float* out = args.out; const int* POS = WSP(int, WS_POS); const bf16* YE = WSP(bf16, WS_XG);
        f32x4* orow = (f32x4*)(out + (size_t)t * DM) + lane;
        f32x4 v[4];
#pragma unroll
        for (int j = 0; j < 4; ++j) v[j] = orow[64 * j];
#pragma unroll
        for (int k = 0; k < 4; ++k) {
            const int pos = POS[t * 4 + k]; const u32x2* yr = (const u32x2*)(YE + (size_t)pos * 1024) + lane;
#pragma unroll
            for (int j = 0; j < 4; ++j) { const u32x2 w = yr[64 * j]; v[j].x += bflo(w.x); v[j].y += bfhi(w.x); v[j].z += bflo(w.y); v[j].w += bfhi(w.y); }
        }
#pragma unroll
        for (int j = 0; j < 4; ++j) orow[64 * j] = v[j];
    }
    }
}

extern "C" void kernel_launch(void* const* d_in, const int* in_sizes, int n_in, void* d_out, int out_size, void* d_ws, size_t ws_size, hipStream_t stream) {
    static int grid = 0;
    if (grid == 0) {
        if (n_in != 19 || out_size != T * DM || ws_size < WS_END) { fprintf(stderr, "kernel_launch: unexpected shapes (n_in %d out %d ws %zu)\n", n_in, out_size, ws_size); grid = -1; return; }
        int dev = 0, cus = 0, per_cu = 0;
        hipGetDevice(&dev); hipDeviceGetAttribute(&cus, hipDeviceAttributeMultiprocessorCount, dev);
        hipFuncSetAttribute((const void*)fwd_kernel, hipFuncAttributeMaxDynamicSharedMemorySize, LDS_BYTES);
        hipOccupancyMaxActiveBlocksPerMultiprocessor(&per_cu, (const void*)fwd_kernel, NTHREADS, LDS_BYTES);
        if (per_cu < 1) { fprintf(stderr, "kernel_launch: occupancy query says %d blocks per CU\n", per_cu); per_cu = 1; }
        (void)hipGetLastError();
        grid = cus * 1;
        if (grid % 8 != 0 || T % (grid * NWAVES * 16) != 0) { fprintf(stderr, "kernel_launch: grid %d unsupported\n", grid); grid = -1; return; }
    }
    if (grid < 0) return;
    hipMemsetAsync((char*)d_ws + WS_CTL, 0, CTL_ZERO_BYTES, stream);
    Args a{};
    for (int i = 0; i < 19; ++i) a.in[i] = (const float*)d_in[i];
    a.out = (float*)d_out; a.ws = (unsigned char*)d_ws;
    void* kargs[] = {&a};
    hipError_t e = hipLaunchCooperativeKernel((const void*)fwd_kernel, dim3(grid), dim3(NTHREADS), kargs, LDS_BYTES, stream);
    if (e != hipSuccess) fprintf(stderr, "cooperative launch failed: %s (grid %d)\n", hipGetErrorString(e), grid);
}
```

```cpp
#include <hip/hip_runtime.h>
#include <hip/hip_cooperative_groups.h>
#include <cstdio>
#include <cstdint>
namespace cg = cooperative_groups;

#define GAS __attribute__((address_space(1)))
#define LAS __attribute__((address_space(3)))
typedef unsigned short bf16;
typedef short bf16x8 __attribute__((ext_vector_type(8)));
typedef float f32x4 __attribute__((ext_vector_type(4)));
typedef float f32x2 __attribute__((ext_vector_type(2)));
typedef unsigned u32x4 __attribute__((ext_vector_type(4)));
typedef unsigned u32x2 __attribute__((ext_vector_type(2)));
typedef __bf16 bf16x2_t __attribute__((ext_vector_type(2)));

constexpr int NB = 8, SEQ = 4096, DM = 1024, T = NB * SEQ;
constexpr int NIN = 2816, NEXP = 32, TOPK = 4;
constexpr int MEMLEN = 256, MROWS = NB * MEMLEN;
constexpr float EPS = 1e-6f;
constexpr float C2 = 0.125f * 1.4426950408889634f;
constexpr int MAXTILES = 544, PROWS = MAXTILES * 256;
constexpr int NWAVES = 8, NTHREADS = 512;
#ifndef REP_PHASE
#define REP_PHASE -1
#endif
#define REPN(k) for (int rep_ = 0; rep_ < ((REP_PHASE == (k)) ? 2 : 1); ++rep_)
constexpr int LDS_MISC = 147456;
constexpr int LDS_BYTES = 147456 + 256;

constexpr size_t MiB = 1u << 20;
constexpr size_t WS_CTL = 0, CTL_ZERO_BYTES = 2 * MiB;
constexpr size_t WS_BAR = 65536;
constexpr size_t WS_KMEAN = 1 * MiB;
constexpr size_t WS_WRG = 2 * MiB;
constexpr size_t WS_SSQ = 3 * MiB;
constexpr size_t WS_TOPI = 5 * MiB, WS_TOPW = 5 * MiB + 512 * 1024, WS_LRANK = 6 * MiB, WS_POS = 6 * MiB + 512 * 1024;
constexpr size_t WS_ROWW = 7 * MiB;
constexpr size_t WS_LCOUNT = 8 * MiB, WS_PSTART = 8 * MiB + 65536, WS_TILEEXP = 8 * MiB + 131072;
constexpr size_t WS_WIN = 16 * MiB, WS_WMEM = 22 * MiB, WS_WOUT = 24 * MiB, WS_W1 = 32 * MiB, WS_W2 = 160 * MiB;
constexpr size_t WS_XN = 224 * MiB, WS_MEMN = 288 * MiB;
constexpr size_t WS_QA = 292 * MiB, WS_KA = 324 * MiB, WS_VA = 356 * MiB;
constexpr size_t WS_QR = 388 * MiB, WS_KR = 404 * MiB, WS_VR = 420 * MiB, WS_GR = 436 * MiB, WS_QM = 452 * MiB;
constexpr size_t WS_MK = 468 * MiB, WS_MV = 469 * MiB;
constexpr size_t WS_Y = 470 * MiB, WS_RET = 534 * MiB;
constexpr size_t WS_XG = 224 * MiB;
constexpr size_t WS_XN2 = 496 * MiB;
constexpr size_t WS_ROWTOK = 9 * MiB;
constexpr size_t WS_H = 566 * MiB;
constexpr size_t WS_END = 838 * MiB;

struct Args {
    const float* in[19]; float* out; unsigned char* ws; int pad0, pad1;
};

__device__ __forceinline__ unsigned cvtpk(float lo, float hi) { f32x2 v = {lo, hi}; bf16x2_t b = __builtin_convertvector(v, bf16x2_t); return __builtin_bit_cast(unsigned, b); }
__device__ __forceinline__ float bf2f(unsigned short b) { return __uint_as_float(((unsigned)b) << 16); }
__device__ __forceinline__ float bflo(unsigned w) { return __uint_as_float(w << 16); }
__device__ __forceinline__ float bfhi(unsigned w) { return __uint_as_float(w & 0xffff0000u); }
__device__ __forceinline__ float wave_sum(float v) {
#pragma unroll
    for (int o = 1; o < 64; o <<= 1) v += __shfl_xor(v, o);
    return v;
}
#define LDS_WAIT() asm volatile("s_waitcnt lgkmcnt(0)" ::: "memory")
__device__ __forceinline__ int opaque(int v) { asm volatile("" : "+v"(v)); return v; }

namespace pg8 {
constexpr int BM = 256, BK = 64, HALF = 128, HTB = HALF * BK * 2, STAGE_BYTES = 8 * HTB, NXCD = 8, WGM = 8, K = 1024;
__host__ __device__ __forceinline__ int lds_byte(int r, int c) { const int st = (r >> 4) * 2 + (c >> 5), rr = r & 15, cc = c & 31, ob = rr * 64 + cc * 2; return st * 1024 + (ob ^ (((ob >> 9) & 1) << 5)); }
__host__ __device__ __forceinline__ void stage_rc(int b, int& R, int& C) { const int st = b / 1024, sb = b % 1024, swz = sb ^ (((sb >> 9) & 1) << 5); R = (st >> 1) * 16 + swz / 64; C = (st & 1) * 32 + (swz % 64) / 2; }
__host__ __device__ __forceinline__ int perm32(int rho) { const int n = rho >> 4, i = rho & 15; return 8 * (i >> 2) + 4 * n + (i & 3); }
struct Unit { int pm, pn, aux; };

__device__ __forceinline__ bool static_order(int L, int nM, int nN, int& pm, int& pn) {
    const int nwg = nM * nN; if (L >= nwg) return false;
    int wgid = L; { const int q = nwg / NXCD, r = nwg % NXCD, xcd = wgid % NXCD, off = wgid / NXCD; wgid = (xcd < r ? xcd * (q + 1) : r * (q + 1) + (xcd - r) * q) + off; }
    const int nig = WGM * nN, gid = wgid / nig, fm = gid * WGM, gsz = (nM - fm) < WGM ? (nM - fm) : WGM;
    pm = fm + ((wgid % nig) % gsz); pn = (wgid % nig) / gsz; return true;
}

typedef int v8i_t __attribute__((ext_vector_type(8)));
typedef int v4i_t __attribute__((ext_vector_type(4)));
__device__ __forceinline__ v8i_t cat8(bf16x8 lo, bf16x8 hi) { const v4i_t a = __builtin_bit_cast(v4i_t, lo), b = __builtin_bit_cast(v4i_t, hi); return __builtin_shufflevector(a, b, 0, 1, 2, 3, 4, 5, 6, 7); }
template <class Epi, class Sched, bool GATHER = false, bool FP8 = false>
__device__ __forceinline__ void gemm_phase(LAS unsigned char* lds, const Sched& S, const Epi& E) {
    constexpr int PITCH = FP8 ? 1024 : 2048;
    const int tid = opaque((int)threadIdx.x), wid = __builtin_amdgcn_readfirstlane(tid >> 6), lane = tid & 63, wr = wid >> 2, wc = wid & 3, fr = lane & 15, fq = lane >> 4;
    constexpr int nt = PITCH / 128;
    unsigned voffA[2], voffB[2];
#pragma unroll
    for (int i = 0; i < 2; ++i) { int R, C; stage_rc(tid * 16 + i * 8192, R, C); const int Rb = (R & ~31) + perm32(R & 31);
        voffA[i] = (unsigned)(R * PITCH + C * 2); voffB[i] = (unsigned)(Rb * PITCH + C * 2); }
    const size_t kstep = (size_t)(BK * 2);
    const size_t hstep = (size_t)HALF * PITCH;
    const unsigned ldsw = (unsigned)wid * 1024u;
    const int aoff = lds_byte(wr * 64 + fr, fq * 8), boff = lds_byte(wc * 32 + fr, fq * 8);
#define PG8_SA(b, h) (((b) * 2 + (h)) * HTB)
#define PG8_SB(b, h) ((4 + (b) * 2 + (h)) * HTB)
#define PG8_STAGE(bufoff, gbase, voff) do { _Pragma("unroll") for (int _i = 0; _i < 2; ++_i) \
        __builtin_amdgcn_global_load_lds((const unsigned*)((const char*)(gbase) + (voff)[_i]), (LAS unsigned*)(lds + (bufoff) + ldsw + _i * 8192), 16, 0, 0); } while (0)
#define PG8_LDA(dst, b, h) do { _Pragma("unroll") for (int m = 0; m < 4; ++m) _Pragma("unroll") for (int k = 0; k < 2; ++k) dst[m][k] = *(const LAS bf16x8*)(lds + PG8_SA(b, h) + aoff + m * 2048 + k * 1024); } while (0)
#define PG8_LDB(dst, b, h) do { _Pragma("unroll") for (int n = 0; n < 2; ++n) _Pragma("unroll") for (int k = 0; k < 2; ++k) dst[n][k] = *(const LAS bf16x8*)(lds + PG8_SB(b, h) + boff + n * 2048 + k * 1024); } while (0)
#define PG8_MMA(ai, bj, At, Bt) do { __builtin_amdgcn_s_setprio(1); \
        if constexpr (FP8) { _Pragma("unroll") for (int m = 0; m < 4; ++m) _Pragma("unroll") for (int n = 0; n < 2; ++n) \
            asm volatile("v_mfma_scale_f32_16x16x128_f8f6f4 %0, %1, %2, %0, %3, %3 op_sel_hi:[0,0,0]" : "+v"(acc[ai][bj][m][n]) : "v"(cat8(Bt[n][0], Bt[n][1])), "v"(cat8(At[m][0], At[m][1])), "v"(0x7f7f7f7f)); } \
        else { _Pragma("unroll") for (int m = 0; m < 4; ++m) _Pragma("unroll") for (int n = 0; n < 2; ++n) _Pragma("unroll") for (int k = 0; k < 2; ++k) \
            acc[ai][bj][m][n] = __builtin_amdgcn_mfma_f32_16x16x32_bf16(Bt[n][k], At[m][k], acc[ai][bj][m][n], 0, 0, 0); } \
        __builtin_amdgcn_s_setprio(0); } while (0)
#define PG8_WAIT_V(n) asm volatile("s_waitcnt vmcnt(" #n ")" ::: "memory")
#define PG8_WAIT_L(n) asm volatile("s_waitcnt lgkmcnt(" #n ")" ::: "memory")
#define PG8_BAR __builtin_amdgcn_s_barrier()
#define PG8_SCHED __builtin_amdgcn_sched_barrier(0)
    Unit cur, nxt; int ui = 0;
    if (!S.next(0, cur)) return;
    unsigned vGc[2][2], vGn[2][2]; int gR[2], gC[2];
    const char* gA = nullptr;
    if constexpr (GATHER) {
        gA = S.abase();
#pragma unroll
        for (int i = 0; i < 2; ++i) { stage_rc(tid * 16 + i * 8192, gR[i], gC[i]); }
        if (wid == 0) __builtin_amdgcn_global_load_lds((const unsigned*)(S.tokptr(cur) + lane * 16), (LAS unsigned*)(lds + 131072), 16, 0, 0);
        asm volatile("s_waitcnt vmcnt(0)" ::: "memory"); __builtin_amdgcn_s_barrier(); asm volatile("" ::: "memory");
#pragma unroll
        for (int h = 0; h < 2; ++h)
#pragma unroll
            for (int i = 0; i < 2; ++i) { const int tok = ((const LAS int*)(lds + 131072))[h * 128 + gR[i]]; vGc[h][i] = (unsigned)tok * (unsigned)PITCH + (unsigned)gC[i] * 2u; vGn[h][i] = vGc[h][i]; }
    }
    f32x4 acc[2][2][4][2];
#pragma unroll
    for (int a = 0; a < 2; ++a)
#pragma unroll
        for (int b = 0; b < 2; ++b)
#pragma unroll
            for (int m = 0; m < 4; ++m)
#pragma unroll
                for (int n = 0; n < 2; ++n) acc[a][b][m][n] = (f32x4){0.f, 0.f, 0.f, 0.f};
    bf16x8 At[4][2], B0[2][2], B1[2][2];
    const char* cA = GATHER ? gA : S.aptr(cur); const char* cB = S.bptr(cur);
    const size_t ahstep = GATHER ? (size_t)0 : hstep;
    {
        PG8_STAGE(PG8_SB(0, 0), cB, voffB); PG8_STAGE(PG8_SB(0, 1), cB + hstep, voffB);
        if constexpr (GATHER) { PG8_STAGE(PG8_SA(0, 0), cA, vGc[0]); PG8_STAGE(PG8_SA(0, 1), cA, vGc[1]); } else { PG8_STAGE(PG8_SA(0, 0), cA, voffA); PG8_STAGE(PG8_SA(0, 1), cA + hstep, voffA); }
        if (wr == 1) PG8_BAR;
        PG8_WAIT_V(2); PG8_BAR;
        PG8_STAGE(PG8_SB(1, 0), cB + kstep, voffB);
        if constexpr (GATHER) { PG8_STAGE(PG8_SA(1, 0), cA + kstep, vGc[0]); } else { PG8_STAGE(PG8_SA(1, 0), cA + kstep, voffA); }
        PG8_STAGE(PG8_SB(1, 1), cB + hstep + kstep, voffB);
        PG8_WAIT_V(6); PG8_BAR;
    }
    for (;;) {
        const bool has_next = S.next(ui + 1, nxt);
        const char* nA = GATHER ? gA : (has_next ? S.aptr(nxt) : cA); const char* nB = has_next ? S.bptr(nxt) : cB;
        if constexpr (GATHER) { if (has_next && wid == 0) __builtin_amdgcn_global_load_lds((const unsigned*)(S.tokptr(nxt) + lane * 16), (LAS unsigned*)(lds + 131072 + ((ui + 1) & 1) * 1024), 16, 0, 0); }
#pragma nounroll
        for (int t = 0; t < nt; t += 2) {
            const bool last = (t == nt - 2);
            const char* a1 = cA + (size_t)(t + 1) * kstep;
            const char* a2 = last ? nA : cA + (size_t)(t + 2) * kstep; const char* b2 = last ? nB : cB + (size_t)(t + 2) * kstep;
            const char* a3 = a2 + kstep; const char* b3 = b2 + kstep;
            unsigned v2h0[2], v2h1[2];
            if constexpr (GATHER) {
                if (last && has_next) {
                    const LAS int* tk = (const LAS int*)(lds + 131072 + ((ui + 1) & 1) * 1024);
#pragma unroll
                    for (int h = 0; h < 2; ++h)
#pragma unroll
                        for (int i = 0; i < 2; ++i) vGn[h][i] = (unsigned)tk[h * 128 + gR[i]] * (unsigned)PITCH + (unsigned)gC[i] * 2u;
                }
#pragma unroll
                for (int i = 0; i < 2; ++i) { v2h0[i] = last ? vGn[0][i] : vGc[0][i]; v2h1[i] = last ? vGn[1][i] : vGc[1][i]; }
            } else {
#pragma unroll
                for (int i = 0; i < 2; ++i) { v2h0[i] = voffA[i]; v2h1[i] = voffA[i]; }
            }
            PG8_LDB(B0, 0, 0); PG8_LDB(B1, 0, 1); PG8_SCHED; PG8_LDA(At, 0, 0);
            if constexpr (GATHER) { PG8_STAGE(PG8_SA(1, 1), a1, vGc[1]); } else { PG8_STAGE(PG8_SA(1, 1), a1 + hstep, voffA); }
            PG8_WAIT_V(8); PG8_WAIT_L(0); PG8_BAR; PG8_MMA(0, 0, At, B0); PG8_MMA(0, 1, At, B1); PG8_BAR; PG8_SCHED;
            PG8_LDA(At, 0, 1); PG8_STAGE(PG8_SB(0, 0), b2, voffB); PG8_STAGE(PG8_SB(0, 1), b2 + hstep, voffB); PG8_STAGE(PG8_SA(0, 0), a2, v2h0);
            PG8_WAIT_V(8); PG8_WAIT_L(0); PG8_BAR; PG8_MMA(1, 0, At, B0); PG8_MMA(1, 1, At, B1); PG8_BAR; PG8_SCHED;
            PG8_LDB(B0, 1, 0); PG8_LDB(B1, 1, 1); PG8_SCHED; PG8_LDA(At, 1, 0); PG8_STAGE(PG8_SA(0, 1), a2 + ahstep, v2h1);
            PG8_WAIT_V(8); PG8_WAIT_L(0); PG8_BAR; PG8_MMA(0, 0, At, B0); PG8_MMA(0, 1, At, B1); PG8_BAR; PG8_SCHED;
            PG8_LDA(At, 1, 1); PG8_STAGE(PG8_SB(1, 0), b3, voffB); PG8_STAGE(PG8_SB(1, 1), b3 + hstep, voffB); PG8_STAGE(PG8_SA(1, 0), a3, v2h0);
            PG8_WAIT_V(8); PG8_WAIT_L(0); PG8_BAR; PG8_MMA(1, 0, At, B0); PG8_MMA(1, 1, At, B1); PG8_BAR; PG8_SCHED;
        }
        if (wr == 0) PG8_BAR;
        if constexpr (FP8) asm volatile("s_nop 15\n\ts_nop 7" ::: "memory");
        E(acc, cur, wr, wc, fr, fq);
        if (!has_next) break;
#pragma unroll
        for (int a = 0; a < 2; ++a)
#pragma unroll
            for (int b = 0; b < 2; ++b)
#pragma unroll
                for (int m = 0; m < 4; ++m)
#pragma unroll
                    for (int n = 0; n < 2; ++n) acc[a][b][m][n] = (f32x4){0.f, 0.f, 0.f, 0.f};
        cur = nxt; cA = nA; cB = nB; ++ui;
        if constexpr (GATHER) {
#pragma unroll
            for (int h = 0; h < 2; ++h)
#pragma unroll
                for (int i = 0; i < 2; ++i) vGc[h][i] = vGn[h][i];
        }
        if (wr == 1) PG8_BAR;
    }
    PG8_WAIT_V(0);
    PG8_BAR;
#undef PG8_SA
#undef PG8_SB
#undef PG8_STAGE
#undef PG8_LDA
#undef PG8_LDB
#undef PG8_MMA
#undef PG8_WAIT_V
#undef PG8_WAIT_L
#undef PG8_BAR
#undef PG8_SCHED
}
}
using pg8::Unit;

struct SchedProj {
    int G, c; const char *XN, *MEMN, *WIN, *WMEM;
    __device__ __forceinline__ bool next(int i, Unit& u) const {
        const int L = i * G + c;
        if (L < 1408) { u.aux = 0; return pg8::static_order(L, 128, 11, u.pm, u.pn); }
        if (L < 1424) { const int j = L - 1408; u.pm = j >> 1; u.pn = j & 1; u.aux = 1; return true; }
        return false;
    }
    __device__ __forceinline__ const char* aptr(const Unit& u) const { return (u.aux ? MEMN : XN) + (size_t)u.pm * (256 * 2048); }
    __device__ __forceinline__ const char* bptr(const Unit& u) const { return (u.aux ? WMEM : WIN) + (size_t)u.pn * (256 * 2048); }
};
struct SchedPlain {
    int G, c, nM, nN; const char *A, *B;
    __device__ __forceinline__ bool next(int i, Unit& u) const { u.aux = 0; return pg8::static_order(i * G + c, nM, nN, u.pm, u.pn); }
    __device__ __forceinline__ const char* aptr(const Unit& u) const { return A + (size_t)u.pm * (256 * 2048); }
    __device__ __forceinline__ const char* bptr(const Unit& u) const { return B + (size_t)u.pn * (256 * 2048); }
};
struct SchedMoe {
    int G, vcu, npn, ntiles; const int* tile_exp; const char *A, *B; size_t bexp;
    __device__ __forceinline__ bool next(int i, Unit& u) const {
        const int L = i * G + vcu, tile = L / npn; if (tile >= ntiles) return false;
        u.pm = tile; u.pn = L - tile * npn; u.aux = __builtin_amdgcn_readfirstlane(tile_exp[tile]); return true;
    }
    __device__ __forceinline__ const char* aptr(const Unit& u) const { return A + (size_t)u.pm * (256 * 1024); }
    __device__ __forceinline__ const char* bptr(const Unit& u) const { return B + (size_t)u.aux * bexp + (size_t)u.pn * (256 * 1024); }
    const int* rowtok;
    __device__ __forceinline__ const char* abase() const { return A; }
    __device__ __forceinline__ const char* tokptr(const Unit& u) const { return (const char*)(rowtok + (size_t)u.pm * 256); }
};

struct EpiProj {
    unsigned char* ws;
    const float *gq, *gk, *gmq, *gmk;
    __device__ __forceinline__ void operator()(const f32x4 (&acc)[2][2][4][2], const Unit& u, int wr, int wc, int fr, int fq) const {
        int mode = 0; bf16* out; int ld = 256, coff = 0; const float* gain = nullptr; float scale = 1.f; bool kmean = false;
        if (u.aux == 0) {
            switch (u.pn) {
                case 0: case 1: out = (bf16*)(ws + WS_QA); ld = 512; coff = u.pn * 256; mode = 1; gain = gq; scale = C2; break;
                case 2: case 3: out = (bf16*)(ws + WS_KA); ld = 512; coff = (u.pn - 2) * 256; mode = 1; gain = gk; kmean = true; break;
                case 4: case 5: out = (bf16*)(ws + WS_VA); ld = 512; coff = (u.pn - 4) * 256; break;
                case 6: out = (bf16*)(ws + WS_QR); mode = 2; break;
                case 7: out = (bf16*)(ws + WS_KR); mode = 2; scale = 0.125f; break;
                case 8: out = (bf16*)(ws + WS_VR); break;
                case 9: out = (bf16*)(ws + WS_GR); mode = 3; break;
                default: out = (bf16*)(ws + WS_QM); mode = 1; gain = gmq; scale = C2; break;
            }
        } else {
            if (u.pn == 0) { out = (bf16*)(ws + WS_MK); mode = 1; gain = gmk; } else { out = (bf16*)(ws + WS_MV); }
        }
        const int row0 = u.pm * 256 + wr * 64 + fr;
        const int colb = coff + wc * 64 + 8 * fq;
        if (gain == nullptr) gain = gq;
        f32x4 ks[2][2];
#pragma unroll
        for (int bj = 0; bj < 2; ++bj)
#pragma unroll
            for (int n = 0; n < 2; ++n) ks[bj][n] = (f32x4){0.f, 0.f, 0.f, 0.f};
#pragma unroll
        for (int ai = 0; ai < 2; ++ai)
#pragma unroll
            for (int m = 0; m < 4; ++m) {
                const int row = row0 + ai * 128 + m * 16;
                f32x4 v[2][2];
#pragma unroll
                for (int bj = 0; bj < 2; ++bj)
#pragma unroll
                    for (int n = 0; n < 2; ++n) v[bj][n] = acc[ai][bj][m][n];
                if (mode == 1) {
                    float ss = 0.f;
#pragma unroll
                    for (int bj = 0; bj < 2; ++bj)
#pragma unroll
                        for (int n = 0; n < 2; ++n) { const f32x4 x = v[bj][n]; ss += (x[0] * x[0] + x[1] * x[1]) + (x[2] * x[2] + x[3] * x[3]); }
                    ss += __shfl_xor(ss, 16); ss += __shfl_xor(ss, 32);
                    const float r = scale / sqrtf(ss * (1.0f / 64.0f) + EPS);
#pragma unroll
                    for (int bj = 0; bj < 2; ++bj)
#pragma unroll
                        for (int n = 0; n < 2; ++n) v[bj][n] = v[bj][n] * r * *(const f32x4*)(gain + bj * 32 + 8 * fq + 4 * n);
                } else if (mode == 2) {
                    const float pos = (float)(row & (SEQ - 1));
                    const float lgam = __builtin_amdgcn_logf(1.0f - __builtin_amdgcn_exp2f(-5.0f - (float)wc));
                    const float rsc = scale * __builtin_amdgcn_exp2f(((u.pn == 6) ? lgam : -lgam) * (float)(row & 127));
#pragma unroll
                    for (int n = 0; n < 2; ++n)
#pragma unroll
                        for (int j = 0; j < 4; ++j) {
                            const float fre = __builtin_amdgcn_exp2f((float)(8 * fq + 4 * n + j) * (-13.287712379549449f / 31.0f)) * 0.15915494309189535f;
                            float tt = pos * fre; tt = tt - floorf(tt);
                            const float sn = __builtin_amdgcn_sinf(tt), cs = __builtin_amdgcn_cosf(tt);
                            const float t1 = v[0][n][j], t2 = v[1][n][j];
                            v[0][n][j] = (t1 * cs - t2 * sn) * rsc; v[1][n][j] = (t2 * cs + t1 * sn) * rsc;
                        }
                } else if (mode == 3) {
#pragma unroll
                    for (int bj = 0; bj < 2; ++bj)
#pragma unroll
                        for (int n = 0; n < 2; ++n)
#pragma unroll
                            for (int j = 0; j < 4; ++j) { const float x = v[bj][n][j]; v[bj][n][j] = x / (1.0f + __expf(-x)); }
                }
                if (kmean) {
#pragma unroll
                    for (int bj = 0; bj < 2; ++bj)
#pragma unroll
                        for (int n = 0; n < 2; ++n) ks[bj][n] += v[bj][n];
                }
                bf16* rowp = out + (size_t)row * ld + colb;
#pragma unroll
                for (int bj = 0; bj < 2; ++bj) { u32x4 w; w.x = cvtpk(v[bj][0][0], v[bj][0][1]); w.y = cvtpk(v[bj][0][2], v[bj][0][3]); w.z = cvtpk(v[bj][1][0], v[bj][1][1]); w.w = cvtpk(v[bj][1][2], v[bj][1][3]);
                    *(u32x4*)(rowp + bj * 32) = w; }
            }
        if (kmean) {
            float* kp = (float*)(ws + WS_KMEAN) + ((size_t)u.pm * 8 + (u.pn - 2) * 4 + wc) * 64 + 8 * fq;
#pragma unroll
            for (int bj = 0; bj < 2; ++bj)
#pragma unroll
                for (int n = 0; n < 2; ++n)
#pragma unroll
                    for (int j = 0; j < 4; ++j) {
                        float s = ks[bj][n][j];
                        s += __shfl_xor(s, 1); s += __shfl_xor(s, 2); s += __shfl_xor(s, 4); s += __shfl_xor(s, 8);
                        if (fr == 0) atomicAdd(kp + bj * 32 + 4 * n + j, s * (1.0f / 256.0f));
                    }
        }
    }
};

struct EpiOut {
    const float* x; float* out; float* ssq;
    __device__ __forceinline__ void operator()(const f32x4 (&acc)[2][2][4][2], const Unit& u, int wr, int wc, int fr, int fq) const {
        const int row0 = u.pm * 256 + wr * 64 + fr, col0 = u.pn * 256 + wc * 32 + 8 * fq;
#pragma unroll
        for (int ai = 0; ai < 2; ++ai)
#pragma unroll
            for (int m = 0; m < 4; ++m) {
                const int row = row0 + ai * 128 + m * 16; const size_t off = (size_t)row * DM + col0; float ss = 0.f;
#pragma unroll
                for (int bj = 0; bj < 2; ++bj)
#pragma unroll
                    for (int n = 0; n < 2; ++n) { const f32x4 xv = *(const f32x4*)(x + off + bj * 128 + 4 * n); const f32x4 o = xv + acc[ai][bj][m][n];
                        ss += (o[0] * o[0] + o[1] * o[1]) + (o[2] * o[2] + o[3] * o[3]); *(f32x4*)(out + off + bj * 128 + 4 * n) = o; }
                ss += __shfl_xor(ss, 16); ss += __shfl_xor(ss, 32);
                if (fq == 0) ssq[(size_t)row * 16 + u.pn * 4 + wc] = ss;
            }
    }
};

struct EpiSwiglu {
    const float* b1; unsigned char* H;
    __device__ __forceinline__ void operator()(const f32x4 (&acc)[2][2][4][2], const Unit& u, int wr, int wc, int fr, int fq) const {
        const int row0 = u.pm * 256 + wr * 64 + fr, p0 = u.pn * 128 + wc * 32 + 8 * fq;
        const float* bp = b1 + (size_t)u.aux * 2048 + 2 * p0;
        f32x4 bv[4];
#pragma unroll
        for (int i = 0; i < 4; ++i) bv[i] = *(const f32x4*)(bp + 4 * i);
#pragma unroll
        for (int ai = 0; ai < 2; ++ai)
#pragma unroll
            for (int m = 0; m < 4; ++m) {
                const int row = row0 + ai * 128 + m * 16;
                float h[8];
#pragma unroll
                for (int n = 0; n < 2; ++n)
#pragma unroll
                    for (int j = 0; j < 4; ++j) {
                        const int i = 4 * n + j;
                        const float g = fminf(acc[ai][0][m][n][j] * 0.03125f + bv[i >> 1][(i & 1) * 2], 7.0f);
                        const float l = fminf(fmaxf(acc[ai][1][m][n][j] * 0.03125f + bv[i >> 1][(i & 1) * 2 + 1], -7.0f), 7.0f);
                        h[i] = g * __builtin_amdgcn_rcpf(1.0f + __builtin_amdgcn_exp2f(-1.702f * 1.4426950408889634f * g)) * (l + 1.0f);
                    }
                int w0 = 0, w1 = 0;
                w0 = __builtin_amdgcn_cvt_pk_fp8_f32(h[0], h[1], w0, false); w0 = __builtin_amdgcn_cvt_pk_fp8_f32(h[2], h[3], w0, true);
                w1 = __builtin_amdgcn_cvt_pk_fp8_f32(h[4], h[5], w1, false); w1 = __builtin_amdgcn_cvt_pk_fp8_f32(h[6], h[7], w1, true);
                *(u32x2*)(H + (size_t)row * 1024 + p0) = (u32x2){(unsigned)w0, (unsigned)w1};
            }
    }
};

struct EpiDown {
    const float* b2; const float* roww; unsigned char* YE;
    __device__ __forceinline__ void operator()(const f32x4 (&acc)[2][2][4][2], const Unit& u, int wr, int wc, int fr, int fq) const {
        const int row0 = u.pm * 256 + wr * 64 + fr, c0 = u.pn * 256 + wc * 32 + 8 * fq;
        const float* bp = b2 + (size_t)u.aux * 1024 + c0;
        f32x4 bv[2][2];
#pragma unroll
        for (int bj = 0; bj < 2; ++bj)
#pragma unroll
            for (int n = 0; n < 2; ++n) bv[bj][n] = *(const f32x4*)(bp + bj * 128 + 4 * n);
#pragma unroll
        for (int ai = 0; ai < 2; ++ai)
#pragma unroll
            for (int m = 0; m < 4; ++m) {
                const int row = row0 + ai * 128 + m * 16; const float w8 = roww[row] * 16.0f;
#pragma unroll
                for (int bj = 0; bj < 2; ++bj) {
                    const f32x4 y0 = (acc[ai][bj][m][0] * 0.03125f + bv[bj][0]) * w8, y1 = (acc[ai][bj][m][1] * 0.03125f + bv[bj][1]) * w8;
                    int w0 = 0, w1 = 0;
                    w0 = __builtin_amdgcn_cvt_pk_fp8_f32(y0[0], y0[1], w0, false); w0 = __builtin_amdgcn_cvt_pk_fp8_f32(y0[2], y0[3], w0, true);
                    w1 = __builtin_amdgcn_cvt_pk_fp8_f32(y1[0], y1[1], w1, false); w1 = __builtin_amdgcn_cvt_pk_fp8_f32(y1[2], y1[3], w1, true);
                    *(u32x2*)(YE + (size_t)row * 1024 + c0 + bj * 128) = (u32x2){(unsigned)w0, (unsigned)w1};
                }
            }
    }
};

__device__ __forceinline__ void transpose_item(const float* W, int N, bf16* WT, int drow0, LAS float* scr, int k0, int n0, int lane) {
#pragma unroll 8
    for (int i = 0; i < 32; ++i) { const int kk = 2 * i + (lane >> 5); scr[kk * 33 + (lane & 31)] = W[(size_t)(k0 + kk) * N + n0 + (lane & 31)]; }
    LDS_WAIT(); asm volatile("" ::: "memory");
    const int c = lane & 7;
#pragma unroll
    for (int j = 0; j < 4; ++j) { const int n = (lane >> 3) + 8 * j; const LAS float* s = scr + (8 * c) * 33 + n;
        u32x4 o; o.x = cvtpk(s[0 * 33], s[1 * 33]); o.y = cvtpk(s[2 * 33], s[3 * 33]); o.z = cvtpk(s[4 * 33], s[5 * 33]); o.w = cvtpk(s[6 * 33], s[7 * 33]);
        *(u32x4*)(WT + (size_t)(drow0 + n) * 1024 + k0 + 8 * c) = o; }
    LDS_WAIT(); asm volatile("" ::: "memory");
}
template <bool GLU>
__device__ __forceinline__ void transpose_item_fp8(const float* W, int N, unsigned char* W8, LAS float* scr, int k0, int n0, int lane) {
#pragma unroll 8
    for (int i = 0; i < 32; ++i) { const int kk = 2 * i + (lane >> 5); scr[kk * 33 + (lane & 31)] = W[(size_t)(k0 + kk) * N + n0 + (lane & 31)]; }
    LDS_WAIT(); asm volatile("" ::: "memory");
    const int c = lane & 3;
#pragma unroll
    for (int j = 0; j < 2; ++j) { const int n = (lane >> 2) + 16 * j; const LAS float* s = scr + (16 * c) * 33 + n;
        int w[4];
#pragma unroll
        for (int q = 0; q < 4; ++q) { int t = 0; t = __builtin_amdgcn_cvt_pk_fp8_f32(s[(4 * q) * 33] * 32.0f, s[(4 * q + 1) * 33] * 32.0f, t, false); t = __builtin_amdgcn_cvt_pk_fp8_f32(s[(4 * q + 2) * 33] * 32.0f, s[(4 * q + 3) * 33] * 32.0f, t, true); w[q] = t; }
        const int col = n0 + n; const int p = col >> 1;
        const int drow = GLU ? ((p >> 7) * 256 + (col & 1) * 128 + (p & 127)) : col;
        *(u32x4*)(W8 + (size_t)drow * 1024 + k0 + 16 * c) = (u32x4){(unsigned)w[0], (unsigned)w[1], (unsigned)w[2], (unsigned)w[3]}; }
    LDS_WAIT(); asm volatile("" ::: "memory");
}
__device__ __forceinline__ int headperm_row(int n0) { const int pn = n0 >> 8, c = n0 & 255, hh = c >> 6, dh = (c & 63) >> 5; return pn * 256 + dh * 128 + hh * 32; }
__device__ __forceinline__ void rms_row_to_bf16(const float* xrow, const float* gain, bf16* orow, int lane) {
    const f32x4* xr = (const f32x4*)xrow + lane; const f32x4* gr = (const f32x4*)gain + lane;
    f32x4 v[4]; float s = 0.f;
#pragma unroll
    for (int j = 0; j < 4; ++j) { v[j] = xr[64 * j]; s += (v[j].x * v[j].x + v[j].y * v[j].y) + (v[j].z * v[j].z + v[j].w * v[j].w); }
    const float rstd = 1.0f / sqrtf(wave_sum(s) * (1.f / DM) + EPS);
    u32x2* o8 = (u32x2*)orow + lane;
#pragma unroll
    for (int j = 0; j < 4; ++j) { const f32x4 gg = gr[64 * j]; u32x2 w; w.x = cvtpk(v[j].x * rstd * gg.x, v[j].y * rstd * gg.y); w.y = cvtpk(v[j].z * rstd * gg.z, v[j].w * rstd * gg.w); o8[64 * j] = w; }
}

__device__ __forceinline__ void load64(const bf16* p, float (&d)[64]) {
    const u32x4* q = (const u32x4*)p;
#pragma unroll
    for (int i = 0; i < 8; ++i) { const u32x4 w = q[i]; d[8 * i + 0] = bflo(w.x); d[8 * i + 1] = bfhi(w.x); d[8 * i + 2] = bflo(w.y); d[8 * i + 3] = bfhi(w.y); d[8 * i + 4] = bflo(w.z); d[8 * i + 5] = bfhi(w.z); d[8 * i + 6] = bflo(w.w); d[8 * i + 7] = bfhi(w.w); }
}
__device__ __forceinline__ void store64(bf16* p, const float (&d)[64]) {
    u32x4* q = (u32x4*)p;
#pragma unroll
    for (int i = 0; i < 8; ++i) { u32x4 w; w.x = cvtpk(d[8 * i], d[8 * i + 1]); w.y = cvtpk(d[8 * i + 2], d[8 * i + 3]); w.z = cvtpk(d[8 * i + 4], d[8 * i + 5]); w.w = cvtpk(d[8 * i + 6], d[8 * i + 7]); q[i] = w; }
}
__device__ __forceinline__ float dothalf(const float (&a)[64], const bf16* p, int h) {
    const u32x4* q = (const u32x4*)(p + 32 * h); float s0 = 0.f, s1 = 0.f;
#pragma unroll
    for (int i = 0; i < 4; ++i) { const u32x4 w = q[i]; const int o = 32 * h + 8 * i;
        s0 += a[o] * bflo(w.x) + a[o + 2] * bflo(w.y) + a[o + 4] * bflo(w.z) + a[o + 6] * bflo(w.w);
        s1 += a[o + 1] * bfhi(w.x) + a[o + 3] * bfhi(w.y) + a[o + 5] * bfhi(w.z) + a[o + 7] * bfhi(w.w); }
    return s0 + s1;
}
__device__ __forceinline__ float dotbf(const float (&a)[64], const bf16* p) { return dothalf(a, p, 0) + dothalf(a, p, 1); }
__device__ __forceinline__ void axpy_bf(float (&acc)[64], float al, float pw, const bf16* vp) {
    const u32x4* q = (const u32x4*)vp;
#pragma unroll
    for (int i = 0; i < 8; ++i) { const u32x4 w = q[i]; const int o = 8 * i;
        acc[o] = acc[o] * al + pw * bflo(w.x); acc[o + 1] = acc[o + 1] * al + pw * bfhi(w.x); acc[o + 2] = acc[o + 2] * al + pw * bflo(w.y); acc[o + 3] = acc[o + 3] * al + pw * bfhi(w.y);
        acc[o + 4] = acc[o + 4] * al + pw * bflo(w.z); acc[o + 5] = acc[o + 5] * al + pw * bfhi(w.z); acc[o + 6] = acc[o + 6] * al + pw * bflo(w.w); acc[o + 7] = acc[o + 7] * al + pw * bfhi(w.w); }
}
__device__ __forceinline__ float dot64(const float (&a)[64], const float (&b)[64]) {
    float s0 = 0.f, s1 = 0.f, s2 = 0.f, s3 = 0.f;
#pragma unroll
    for (int i = 0; i < 64; i += 4) { s0 += a[i] * b[i]; s1 += a[i + 1] * b[i + 1]; s2 += a[i + 2] * b[i + 2]; s3 += a[i + 3] * b[i + 3]; }
    return (s0 + s1) + (s2 + s3);
}

__device__ __forceinline__ void naive_moba(const bf16* QA, const bf16* KA, const bf16* VA, const float* KMEAN, bf16* Y, int gw, int NGW, int lane_) {
    const int lane = opaque(lane_);
    for (int wi = gw; wi < (NB * 8 * SEQ) / 64; wi += NGW) {
        const int idx0 = wi * 64, bh = idx0 / SEQ, s0 = idx0 % SEQ, b = bh >> 3, h = bh & 7, s = s0 + lane, n = s0 >> 8;
        float q[64]; load64(QA + ((size_t)(b * SEQ + s)) * 512 + h * 64, q);
        float g0 = -3e38f, g1 = -3e38f, g2 = -3e38f; int i0 = -1, i1 = -1, i2 = -1;
        for (int j = 0; j < n; ++j) {
            const float* km = KMEAN + (((size_t)(b * 16 + j)) * 8 + h) * 64;
            float g = 0.f;
#pragma unroll
            for (int d = 0; d < 64; ++d) g += q[d] * km[d];
            if (g > g0) { g2 = g1; i2 = i1; g1 = g0; i1 = i0; g0 = g; i0 = j; }
            else if (g > g1) { g2 = g1; i2 = i1; g1 = g; i1 = j; }
            else if (g > g2) { g2 = g; i2 = j; }
        }
        unsigned mask = 0; if (i0 >= 0) mask |= 1u << i0; if (i1 >= 0) mask |= 1u << i1; if (i2 >= 0) mask |= 1u << i2;
        float m = -3e38f, l = 0.f, acc[64];
#pragma unroll
        for (int d = 0; d < 64; ++d) acc[d] = 0.f;
        for (int jb = 0; jb <= n; ++jb) {
            const bool act = (jb == n) || ((mask >> jb) & 1u);
            if (!__any(act)) continue;
            const int nk = (jb == n) ? (s0 + 64 - n * 256) : 256;
            for (int kk = 0; kk < nk; ++kk) {
                const int key = jb * 256 + kk;
                const float sc = dotbf(q, KA + ((size_t)(b * SEQ + key)) * 512 + h * 64);
                const bool valid = act && (key <= s);
                if (valid) {
                    const float mn = fmaxf(m, sc), al = __builtin_amdgcn_exp2f(m - mn), p = __builtin_amdgcn_exp2f(sc - mn);
                    l = l * al + p; m = mn;
                    axpy_bf(acc, al, p, VA + ((size_t)(b * SEQ + key)) * 512 + h * 64);
                }
            }
        }
        const float il = 1.0f / l;
#pragma unroll
        for (int d = 0; d < 64; ++d) acc[d] *= il;
        store64(Y + ((size_t)(b * SEQ + s)) * DM + h * 64, acc);
    }
}

__device__ __forceinline__ void naive_ret(const bf16* QR, const bf16* KR, const bf16* VR, const bf16* GR, const float* rgain, bf16* Y, int gw, int NGW, int lane_) {
    const int lane = opaque(lane_);
    for (int wi = gw; wi < (NB * 4 * SEQ) / 64; wi += NGW) {
        const int idx0 = wi * 64, bh = idx0 / SEQ, s0 = idx0 % SEQ, b = bh >> 2, h = bh & 3, s = s0 + lane;
        const float lg = log2f(1.0f - exp2f(-5.0f - (float)h));
        float q[64]; load64(QR + ((size_t)(b * SEQ + s)) * 256 + h * 64, q);
        float acc[64];
#pragma unroll
        for (int d = 0; d < 64; ++d) acc[d] = 0.f;
        int jlo = s0 - (int)(80.0f / (-lg)); if (jlo < 0) jlo = 0;
        for (int j = jlo; j < s0 + 64; ++j) {
            const float sc = dotbf(q, KR + ((size_t)(b * SEQ + j)) * 256 + h * 64);
            const float w = (j <= s) ? sc * __builtin_amdgcn_exp2f(lg * (float)(128 * ((s >> 7) - (j >> 7)))) : 0.f;
            axpy_bf(acc, 1.0f, w, VR + ((size_t)(b * SEQ + j)) * 256 + h * 64);
        }
        float ss = 0.f;
#pragma unroll
        for (int d = 0; d < 64; ++d) ss += acc[d] * acc[d];
        const float r = 1.0f / sqrtf(ss * (1.0f / 64.0f) + EPS);
        load64(GR + ((size_t)(b * SEQ + s)) * 256 + h * 64, q);
#pragma unroll
        for (int d = 0; d < 64; ++d) acc[d] = acc[d] * r * rgain[h * 64 + d] * q[d];
        store64(Y + ((size_t)(b * SEQ + s)) * DM + 512 + h * 64, acc);
    }
}

__device__ __forceinline__ void naive_mem(const bf16* QM, const bf16* MK, const bf16* MV, bf16* Y, int gw, int NGW, int lane_) {
    const int lane = opaque(lane_);
    for (int wi = gw; wi < (NB * 4 * SEQ) / 64; wi += NGW) {
        const int idx0 = wi * 64, bh = idx0 / SEQ, s0 = idx0 % SEQ, b = bh >> 2, h = bh & 3, s = s0 + lane;
        float q[64]; load64(QM + ((size_t)(b * SEQ + s)) * 256 + h * 64, q);
        float m = -3e38f, l = 0.f, acc[64];
#pragma unroll
        for (int d = 0; d < 64; ++d) acc[d] = 0.f;
        for (int j = 0; j < MEMLEN; ++j) {
            const float sc = dotbf(q, MK + ((size_t)(b * MEMLEN + j)) * 256 + h * 64);
            const float mn = fmaxf(m, sc), al = __builtin_amdgcn_exp2f(m - mn), p = __builtin_amdgcn_exp2f(sc - mn);
            l = l * al + p; m = mn;
            axpy_bf(acc, al, p, MV + ((size_t)(b * MEMLEN + j)) * 256 + h * 64);
        }
        const float il = 1.0f / l;
#pragma unroll
        for (int d = 0; d < 64; ++d) acc[d] *= il;
        store64(Y + ((size_t)(b * SEQ + s)) * DM + 768 + h * 64, acc);
    }
}


#include <hip/hip_bf16.h>
namespace attn_body {
using s16x4=__attribute__((ext_vector_type(4)))short;
using f32x16=__attribute__((ext_vector_type(16)))float;
constexpr int D=64,NW=8,QBLK=32,QB=QBLK*NW,KVBLK=64;
__device__ __forceinline__ int crow(int r,int hi){return (r&3)+8*(r>>2)+4*hi;}
#define SBAR() __builtin_amdgcn_sched_barrier(0)
__device__ __forceinline__ void cmask(f32x16&p0,f32x16&p1,int jb,int qrel,int hi){
  const float NEG=-INFINITY; int kb=64*jb+4*hi;
  #pragma unroll
  for(int r=0;r<16;++r){int kv=kb+(r&3)+8*(r>>2); if(kv>qrel)p0[r]=NEG; if(kv+32>qrel)p1[r]=NEG;}
}
constexpr int NSLOT=3, SLOTB=8192;
constexpr int LDS_K=0, LDS_V=NSLOT*SLOTB, LDS_WS=2*NSLOT*SLOTB, LDS_OST=LDS_WS+NW*64*4, ATT_LDS_BYTES=LDS_OST+NW*4096;
__device__ __forceinline__ void glds16(const void*gsrc,unsigned lds_dst){unsigned keep;
  asm volatile("s_mov_b32 %0, m0\n\ts_mov_b32 m0, %2\n\ts_nop 0\n\tglobal_load_lds_dwordx4 %1, off\n\ts_mov_b32 m0, %0":"=&s"(keep):"v"(gsrc),"s"(lds_dst):"memory");}
__device__ __forceinline__ float max3f(float a,float b,float c){float r;asm("v_max3_f32 %0, %1, %2, %3":"=v"(r):"v"(a),"v"(b),"v"(c));return r;}
__device__ __forceinline__ float max2f(float a,float b){float r;asm("v_max_f32_e32 %0, %1, %2":"=v"(r):"v"(a),"v"(b));return r;}
__device__ __forceinline__ float fadd_s(float a,float b){float r;asm("v_add_f32_e32 %0, %1, %2":"=v"(r):"v"(a),"v"(b));return r;}
__device__ __forceinline__ float fsub_s(float a,float b){float r;asm("v_sub_f32_e32 %0, %1, %2":"=v"(r):"v"(a),"v"(b));return r;}
__device__ __forceinline__ unsigned cvtpk_s(float lo,float hi){return cvtpk(lo,hi);}
#define WAIT_BAR(N) asm volatile("s_waitcnt vmcnt(" #N ") lgkmcnt(0)\n\ts_barrier":::"memory")
__device__ __forceinline__ void qkt(f32x16&p0,f32x16&p1,const char*Kslot,const bf16x8*qr,const f32x16&negm,int r32,int hi){
  const char*kb=Kslot+hi*1024+r32*16;
  #pragma unroll
  for(int d0=0;d0<4;++d0){
    const bf16x8 b0=*reinterpret_cast<const bf16x8*>(kb+d0*2048);
    const bf16x8 b1=*reinterpret_cast<const bf16x8*>(kb+d0*2048+512);
    if(d0==0){p0=__builtin_amdgcn_mfma_f32_32x32x16_bf16(b0,qr[0],negm,0,0,0);p1=__builtin_amdgcn_mfma_f32_32x32x16_bf16(b1,qr[0],negm,0,0,0);}
    else{p0=__builtin_amdgcn_mfma_f32_32x32x16_bf16(b0,qr[d0],p0,0,0,0);p1=__builtin_amdgcn_mfma_f32_32x32x16_bf16(b1,qr[d0],p1,0,0,0);}}
}
typedef __attribute__((address_space(3))) const char* lds_cptr;
typedef short v4i16_t __attribute__((ext_vector_type(4)));
__device__ __forceinline__ void kload8(bf16x8*kf,lds_cptr kp){
  kf[0]=*(const __attribute__((address_space(3))) bf16x8*)(kp);      kf[1]=*(const __attribute__((address_space(3))) bf16x8*)(kp+512);
  kf[2]=*(const __attribute__((address_space(3))) bf16x8*)(kp+2048); kf[3]=*(const __attribute__((address_space(3))) bf16x8*)(kp+2560);
  kf[4]=*(const __attribute__((address_space(3))) bf16x8*)(kp+4096); kf[5]=*(const __attribute__((address_space(3))) bf16x8*)(kp+4608);
  kf[6]=*(const __attribute__((address_space(3))) bf16x8*)(kp+6144); kf[7]=*(const __attribute__((address_space(3))) bf16x8*)(kp+6656);
}
__device__ __forceinline__ void kload2(bf16x8*kf,lds_cptr kp,int j){ kf[2*j]=*(const __attribute__((address_space(3))) bf16x8*)(kp+j*2048); kf[2*j+1]=*(const __attribute__((address_space(3))) bf16x8*)(kp+j*2048+512); }
__device__ __forceinline__ s16x4 vtr(lds_cptr p){ return __builtin_bit_cast(s16x4,__builtin_amdgcn_ds_read_tr16_b64_v4i16((__attribute__((address_space(3))) v4i16_t*)p)); }
__device__ __forceinline__ float rowmax(const f32x16&p0,const f32x16&p1){
  float a=max3f(p0[0],p0[1],p1[0]),b=max3f(p0[2],p0[3],p1[1]);a=max3f(a,p1[2],p1[3]);
  #pragma unroll
  for(int r=4;r<16;r+=4){a=max3f(a,p0[r],p0[r+1]);b=max3f(b,p0[r+2],p0[r+3]);a=max3f(a,p1[r],p1[r+1]);b=max3f(b,p1[r+2],p1[r+3]);}
  const float m=max2f(a,b);
  auto rr=__builtin_amdgcn_permlane32_swap(__float_as_uint(m),__float_as_uint(m),false,false);
  return max2f(__uint_as_float(rr[0]),__uint_as_float(rr[1]));
}
__device__ __forceinline__ void pv(f32x16*o,int vb,bf16x8 pa0,bf16x8 pa1,bf16x8 pa2,bf16x8 pa3){
  #pragma unroll
  for(int d0=0;d0<2;++d0){s16x4 lo[4],hi[4];
    #pragma unroll
    for(int ks=0;ks<4;++ks){
      asm volatile("ds_read_b64_tr_b16 %0,%1 offset:%c2":"=&v"(lo[ks]):"v"(vb),"i"(d0*4096+ks*1024):"memory");
      asm volatile("ds_read_b64_tr_b16 %0,%1 offset:%c2":"=&v"(hi[ks]):"v"(vb),"i"(d0*4096+ks*1024+512):"memory");}
    asm volatile("s_waitcnt lgkmcnt(0)":::"memory");SBAR();
    #define PK(k) (bf16x8){lo[k][0],lo[k][1],lo[k][2],lo[k][3],hi[k][0],hi[k][1],hi[k][2],hi[k][3]}
    o[d0]=__builtin_amdgcn_mfma_f32_32x32x16_bf16(pa0,PK(0),o[d0],0,0,0);
    o[d0]=__builtin_amdgcn_mfma_f32_32x32x16_bf16(pa1,PK(1),o[d0],0,0,0);
    o[d0]=__builtin_amdgcn_mfma_f32_32x32x16_bf16(pa2,PK(2),o[d0],0,0,0);
    o[d0]=__builtin_amdgcn_mfma_f32_32x32x16_bf16(pa3,PK(3),o[d0],0,0,0);
    #undef PK
  }
}
template<int THRL,int KP,int OP,bool MOBA> __device__ __forceinline__ void attn_unit(const bf16*Qu,const bf16*__restrict__ Kh,const bf16*__restrict__ Vh,bf16*Ou,const int NT,const int nblk,const float*kmean,char*shm){
  const int tid=opaque((int)threadIdx.x),lane=tid&63,r32=lane&31,hi=lane>>5; const int wid=__builtin_amdgcn_readfirstlane(tid>>6);
  const bf16*Qw=Qu+(long)(wid*QBLK)*KP;
  const unsigned lds0=(unsigned)(uintptr_t)shm;
  float*wsf=(float*)(shm+LDS_WS)+wid*64;
  const bf16*ksrc=Kh+(long)lane*KP+wid*8;
  const bf16*vsrc=Vh+(long)(16*(wid&3)+(lane>>2))*KP+(wid>>2)*32+(lane&3)*8;
  const unsigned kdst=lds0+LDS_K+wid*1024, vdst=lds0+LDS_V+wid*1024;
  #define DMA_K(t,slot) glds16(ksrc+(long)(t)*KVBLK*KP,(unsigned)__builtin_amdgcn_readfirstlane(kdst+(slot)))
  #define DMA_V(t,slot) glds16(vsrc+(long)(t)*KVBLK*KP,(unsigned)__builtin_amdgcn_readfirstlane(vdst+(slot)))
  const int vb0=(int)(lds0+LDS_V)+((lane>>4)&1)*32+(lane&3)*8+(4*hi+((lane&15)>>2))*64;
  const char*Kbase=shm+LDS_K; bf16x8 kf[8];
  const lds_cptr shm3=(lds_cptr)shm; const lds_cptr kp0=shm3+LDS_K+hi*1024+r32*16; const lds_cptr vp0=shm3+LDS_V+((lane>>4)&1)*32+(lane&3)*8+(4*hi+((lane&15)>>2))*64;
  DMA_K(0,0);DMA_V(0,0);DMA_K(1,SLOTB);
  bf16x8 qr[4];
  #pragma unroll
  for(int d0=0;d0<4;++d0)qr[d0]=*reinterpret_cast<const bf16x8*>(&Qw[(long)r32*KP+d0*16+hi*8]);
  unsigned bmask=0xffffffffu;
  if(MOBA){
    bmask=1u<<nblk;
    float g0=-3e38f,g1=-3e38f,g2=-3e38f; int i0=-1,i1=-1,i2=-1;
    for(int j=0;j<nblk;++j){
      const float*km=kmean+(long)j*512+8*hi; float g=0.f;
      #pragma unroll
      for(int d0=0;d0<4;++d0){ const f32x4 a=*(const f32x4*)(km+16*d0),b=*(const f32x4*)(km+16*d0+4);
        g+=bf2f((unsigned short)qr[d0][0])*a[0]+bf2f((unsigned short)qr[d0][1])*a[1]+bf2f((unsigned short)qr[d0][2])*a[2]+bf2f((unsigned short)qr[d0][3])*a[3];
        g+=bf2f((unsigned short)qr[d0][4])*b[0]+bf2f((unsigned short)qr[d0][5])*b[1]+bf2f((unsigned short)qr[d0][6])*b[2]+bf2f((unsigned short)qr[d0][7])*b[3]; }
      g+=__shfl_xor(g,32);
      if(g>g0){g2=g1;i2=i1;g1=g0;i1=i0;g0=g;i0=j;} else if(g>g1){g2=g1;i2=i1;g1=g;i1=j;} else if(g>g2){g2=g;i2=j;}
    }
    if(i0>=0)bmask|=1u<<i0; if(i1>=0)bmask|=1u<<i1; if(i2>=0)bmask|=1u<<i2;
  }
  #define NEGM_FOR(t) (MOBA ? (((bmask>>((t)>>2))&1u) ? -mhat : -INFINITY) : -mhat)
  float mhat=0.f,l_reg=0.f;f32x16 o[2];o[0]=f32x16{};o[1]=f32x16{};f32x16 negm;
  { const float nm=NEGM_FOR(0);
    #pragma unroll
    for(int r=0;r<16;++r)negm[r]=nm; }
  asm volatile("":"+v"(negm));
  const int qrel=wid*QBLK+r32;
  #define CMASK(P0,P1,t) do{ if(MOBA){int jb_=(t)-(NT-4); if(jb_>=0)cmask(P0,P1,jb_,qrel,hi);} }while(0)
  bool resc=false;
  #define START(P0,P1) do{ const float rm=rowmax(P0,P1); resc=false; \
    { const float dl=(MOBA&&rm==-INFINITY)?0.f:rm; mhat=fadd_s(mhat,dl); \
      _Pragma("unroll") for(int r=0;r<16;++r){P0[r]=fsub_s(P0[r],dl);P1[r]=fsub_s(P1[r],dl);} \
      { const float nm=NEGM_FOR(1); _Pragma("unroll") for(int r=0;r<16;++r)negm[r]=nm; } asm volatile("":"+v"(negm)); } \
    _Pragma("unroll") for(int r=0;r<16;++r)P0[r]=__builtin_amdgcn_exp2f(P0[r]); }while(0)
  #define RESC() do{ if(resc){ asm volatile("s_waitcnt lgkmcnt(0)":::"memory"); \
      _Pragma("unroll") for(int d_=0;d_<2;++d_) _Pragma("unroll") for(int r=0;r<16;++r)o[d_][r]*=wsf[crow(r,hi)]; } }while(0)
  f32x16 pA0,pA1,pB0,pB1;
  int sl_prev=0,sl_cur=0,sl_next=SLOTB;
  #define ROT() do{sl_prev=sl_cur;sl_cur=sl_next;sl_next=(sl_next==(NSLOT-1)*SLOTB)?0:sl_next+SLOTB;}while(0)
  DMA_K(2,2*SLOTB);
  WAIT_BAR(3);
  qkt(pA0,pA1,Kbase,qr,negm,r32,hi);asm volatile("s_nop 15\n\ts_nop 7":"+v"(pA0),"+v"(pA1));CMASK(pA0,pA1,0);
  START(pA0,pA1);
  _Pragma("unroll") for(int r=0;r<16;++r)pA1[r]=__builtin_amdgcn_exp2f(pA1[r]);
  WAIT_BAR(0);
  DMA_K(3,0);DMA_V(1,SLOTB);
  ROT();
  kload8(kf,kp0+sl_cur);
  WAIT_BAR(2);
  s16x4 vlo[8],vhi[8]; u32x4 pw0,pw1,pw2,pw3;
  #define PKW(P,B) cvtpk_s(P[B],P[B+1])
  #define PAF(k) __builtin_bit_cast(bf16x8,pw##k)
  #define VFR(i) (bf16x8){vlo[i][0],vlo[i][1],vlo[i][2],vlo[i][3],vhi[i][0],vhi[i][1],vhi[i][2],vhi[i][3]}
  #define PIN(x) asm volatile("":"+v"(x))
  #define MX3(a,b,c) __builtin_fmaxf(__builtin_fmaxf((a),(b)),(c))
  #define GAPA(MF,A0,A1,A2,A3,W0,W1,PW) do{ MF; sacc+=A0; sacc+=A1; sacc+=A2; sacc+=A3; PIN(sacc); W0; W1; PIN(PW); SBAR(); }while(0)
  #define EX(v) __builtin_amdgcn_exp2f(v)
  #define GAPB(MF,X,B) do{ MF; X[B]=EX(X[B]); X[B+1]=EX(X[B+1]); X[B+2]=EX(X[B+2]); X[B+3]=EX(X[B+3]); PIN(X); SBAR(); }while(0)
  #define VRD(i) do{ vlo[i]=vtr(vp_+(((i)>>2)*4096+((i)&3)*1024)); vhi[i]=vtr(vp_+(((i)>>2)*4096+((i)&3)*1024+512)); }while(0)
  #define KRD(G,j) do{ if(G){ kload2(kf,kp0+sl_next,j); SBAR(); } }while(0)
  #define STEP(C0,C1,P0,P1,t,GK,GV,GL) do{ SBAR(); \
    const lds_cptr vp_=vp0+sl_prev; \
    VRD(0); SBAR(); float sacc=(P0[0]+P0[1]); \
    GAPA(C0=__builtin_amdgcn_mfma_f32_32x32x16_bf16(kf[0],qr[0],negm,0,0,0), P0[2],P0[3],P0[4],P0[5],     pw0[0]=PKW(P0,0), pw0[1]=PKW(P0,2), pw0); \
    VRD(4); SBAR(); GAPA(C1=__builtin_amdgcn_mfma_f32_32x32x16_bf16(kf[1],qr[0],negm,0,0,0), P0[6],P0[7],P0[8],P0[9],     pw0[2]=PKW(P0,4), pw0[3]=PKW(P0,6), pw0); \
    VRD(1); SBAR(); GAPA(C0=__builtin_amdgcn_mfma_f32_32x32x16_bf16(kf[2],qr[1],C0,0,0,0),   P0[10],P0[11],P0[12],P0[13], pw1[0]=PKW(P0,8), pw1[1]=PKW(P0,10), pw1); \
    VRD(5); SBAR(); GAPA(C1=__builtin_amdgcn_mfma_f32_32x32x16_bf16(kf[3],qr[1],C1,0,0,0),   P0[14],P0[15],P1[0],P1[1],   pw1[2]=PKW(P0,12),pw1[3]=PKW(P0,14), pw1); \
    VRD(2); SBAR(); GAPA(C0=__builtin_amdgcn_mfma_f32_32x32x16_bf16(kf[4],qr[2],C0,0,0,0),   P1[2],P1[3],P1[4],P1[5],     pw2[0]=PKW(P1,0), pw2[1]=PKW(P1,2), pw2); \
    VRD(6); SBAR(); GAPA(C1=__builtin_amdgcn_mfma_f32_32x32x16_bf16(kf[5],qr[2],C1,0,0,0),   P1[6],P1[7],P1[8],P1[9],     pw2[2]=PKW(P1,4), pw2[3]=PKW(P1,6), pw2); \
    VRD(3); SBAR(); GAPA(C0=__builtin_amdgcn_mfma_f32_32x32x16_bf16(kf[6],qr[3],C0,0,0,0),   P1[10],P1[11],P1[12],P1[13], pw3[0]=PKW(P1,8), pw3[1]=PKW(P1,10), pw3); \
    VRD(7); SBAR(); GAPA(C1=__builtin_amdgcn_mfma_f32_32x32x16_bf16(kf[7],qr[3],C1,0,0,0),   P1[14],P1[15],0.f,0.f,       pw3[2]=PKW(P1,12),pw3[3]=PKW(P1,14), pw3); \
    l_reg+=sacc; \
    if(GK){DMA_K((t)+3,sl_cur);} if(GV){DMA_V((t)+1,sl_next);} \
    CMASK(C0,C1,t); \
    { float a=MX3(C0[0],C0[1],C1[0]),b=MX3(C0[2],C0[3],C1[1]); a=MX3(a,C1[2],C1[3]); \
      _Pragma("unroll") for(int r=4;r<16;r+=4){a=MX3(a,C0[r],C0[r+1]);b=MX3(b,C0[r+2],C0[r+3]);a=MX3(a,C1[r],C1[r+1]);b=MX3(b,C1[r+2],C1[r+3]);} \
      float rm=__builtin_fmaxf(a,b); { auto rr=__builtin_amdgcn_permlane32_swap(__float_as_uint(rm),__float_as_uint(rm),false,false); rm=__builtin_fmaxf(__uint_as_float(rr[0]),__uint_as_float(rr[1])); } \
      resc=false; \
      if(__builtin_expect(__any(rm>(float)THRL),0)){ const float dl=__builtin_fmaxf(rm,0.f); mhat+=dl; \
        _Pragma("unroll") for(int r=0;r<16;++r){C0[r]-=dl;C1[r]-=dl;} \
        if(!MOBA){ _Pragma("unroll") for(int r=0;r<16;++r)negm[r]=-mhat; asm volatile("":"+v"(negm)); } \
        const float f=__builtin_amdgcn_exp2f(-dl); l_reg*=f; if(hi==0)wsf[r32]=f; resc=true; } \
      if(MOBA){ const float nm=NEGM_FOR((t)+1); _Pragma("unroll") for(int r=0;r<16;++r)negm[r]=nm; asm volatile("":"+v"(negm)); } } \
    SBAR(); \
    GAPB(o[0]=__builtin_amdgcn_mfma_f32_32x32x16_bf16(PAF(0),VFR(0),o[0],0,0,0), C0,0); \
    GAPB(o[1]=__builtin_amdgcn_mfma_f32_32x32x16_bf16(PAF(0),VFR(4),o[1],0,0,0), C0,4); \
    KRD(GL,0); GAPB(o[0]=__builtin_amdgcn_mfma_f32_32x32x16_bf16(PAF(1),VFR(1),o[0],0,0,0), C0,8); \
    KRD(GL,1); GAPB(o[1]=__builtin_amdgcn_mfma_f32_32x32x16_bf16(PAF(1),VFR(5),o[1],0,0,0), C0,12); \
    KRD(GL,2); GAPB(o[0]=__builtin_amdgcn_mfma_f32_32x32x16_bf16(PAF(2),VFR(2),o[0],0,0,0), C1,0); \
    KRD(GL,3); GAPB(o[1]=__builtin_amdgcn_mfma_f32_32x32x16_bf16(PAF(2),VFR(6),o[1],0,0,0), C1,4); \
    GAPB(o[0]=__builtin_amdgcn_mfma_f32_32x32x16_bf16(PAF(3),VFR(3),o[0],0,0,0), C1,8); \
    GAPB(o[1]=__builtin_amdgcn_mfma_f32_32x32x16_bf16(PAF(3),VFR(7),o[1],0,0,0), C1,12); \
    }while(0)
  int t=1;
  #undef CMASK
  #define CMASK(P0,P1,t) do{}while(0)
  for(;t+5<NT;t+=2){
    STEP(pB0,pB1,pA0,pA1,t,true,true,true);     WAIT_BAR(2); RESC(); ROT();
    STEP(pA0,pA1,pB0,pB1,t+1,true,true,true);   WAIT_BAR(2); RESC(); ROT();
  }
  #undef CMASK
  #define CMASK(P0,P1,t) do{ if(MOBA){int jb_=(t)-(NT-4); if(jb_>=0)cmask(P0,P1,jb_,qrel,hi);} }while(0)
  #define ENDW(tt) do{ if((tt)+3<NT){WAIT_BAR(2);} else if((tt)+2<NT){WAIT_BAR(1);} else {WAIT_BAR(0);} }while(0)
  for(;t+1<NT;t+=2){
    STEP(pB0,pB1,pA0,pA1,t,(t+3<NT),(t+1<NT),(t+1<NT));       ENDW(t);   RESC(); ROT();
    STEP(pA0,pA1,pB0,pB1,t+1,(t+4<NT),(t+2<NT),(t+2<NT));     ENDW(t+1); RESC(); ROT();
  }
  STEP(pB0,pB1,pA0,pA1,NT-1,false,false,false); RESC();
  { float sacc=pB0[0]+pB0[1]; _Pragma("unroll") for(int r=2;r<16;++r)sacc+=pB0[r]; _Pragma("unroll") for(int r=0;r<16;++r)sacc+=pB1[r]; l_reg+=sacc;
    pw0=(u32x4){PKW(pB0,0),PKW(pB0,2),PKW(pB0,4),PKW(pB0,6)};pw1=(u32x4){PKW(pB0,8),PKW(pB0,10),PKW(pB0,12),PKW(pB0,14)};pw2=(u32x4){PKW(pB1,0),PKW(pB1,2),PKW(pB1,4),PKW(pB1,6)};pw3=(u32x4){PKW(pB1,8),PKW(pB1,10),PKW(pB1,12),PKW(pB1,14)};
    SBAR(); pv(o,vb0+sl_cur,PAF(0),PAF(1),PAF(2),PAF(3)); }
  #undef PKW
  #undef PAF
  #undef VFR
  #undef PIN
  #undef MX3
  #undef GAPA
  #undef GAPB
  #undef EX
  #undef VRD
  #undef KRD
  #undef STEP
  #undef ENDW
  {auto rr=__builtin_amdgcn_permlane32_swap(__float_as_uint(l_reg),__float_as_uint(l_reg),false,false);l_reg=__uint_as_float(rr[0])+__uint_as_float(rr[1]);}
  if(hi==0)wsf[32+r32]=l_reg;asm volatile("s_waitcnt lgkmcnt(0)":::"memory");
  float rli[16];
  #pragma unroll
  for(int r=0;r<16;++r)rli[r]=__builtin_amdgcn_rcpf(wsf[32+crow(r,hi)]);
  bf16*Ow=Ou+(long)(wid*QBLK)*OP;
  { bf16*stg=(bf16*)(shm+LDS_OST)+wid*2048;
    #pragma unroll
    for(int r=0;r<16;++r){const int orow=crow(r,hi);
      #pragma unroll
      for(int d0=0;d0<2;++d0)stg[orow*64+d0*32+r32]=(bf16)(cvtpk(o[d0][r]*rli[r],0.f)&0xffffu);}
    asm volatile("s_waitcnt lgkmcnt(0)":::"memory");
    #pragma unroll
    for(int i=0;i<4;++i){const int row=i*8+(lane>>3),ch=lane&7; const u32x4 v=*(const u32x4*)(stg+row*64+ch*8); *(u32x4*)(Ow+(long)row*OP+ch*8)=v;} }
  asm volatile("s_waitcnt lgkmcnt(0)\n\ts_barrier":::"memory");
  #undef DMA_K
  #undef DMA_V
  #undef CMASK
  #undef START
  #undef RESC
  #undef ROT
  #undef NEGM_FOR
}
#undef SBAR
#undef WAIT_BAR
}

namespace ret_body {
using attn_body::s16x4; using attn_body::f32x16; using attn_body::glds16; using attn_body::pv; using attn_body::crow;
constexpr int KVF_BYTES = 64 * 64 * 4;
__device__ __forceinline__ void kv_unit(const bf16* KR, const bf16* VR, float* KVF, int b, int h, int cp, char* shm) {
  const int tid = opaque((int)threadIdx.x), lane = tid & 63, r32 = lane & 31, hi = lane >> 5; const int wid = __builtin_amdgcn_readfirstlane(tid >> 6);
  const unsigned lds0 = (unsigned)(uintptr_t)shm;
  const size_t rowb = (size_t)b * SEQ + (size_t)cp * 256;
  const long voff = (long)(16 * (wid & 3) + (lane >> 2)) * 256 + h * 64 + (wid >> 2) * 32 + (lane & 3) * 8;
#pragma unroll
  for (int c = 0; c < 2; ++c)
#pragma unroll
    for (int tl = 0; tl < 2; ++tl) {
      const size_t r0 = rowb + c * 128 + tl * 64;
      glds16(KR + r0 * 256 + voff, (unsigned)__builtin_amdgcn_readfirstlane(lds0 + ((c * 2 + 0) * 2 + tl) * 8192 + wid * 1024));
      glds16(VR + r0 * 256 + voff, (unsigned)__builtin_amdgcn_readfirstlane(lds0 + ((c * 2 + 1) * 2 + tl) * 8192 + wid * 1024));
    }
  asm volatile("s_waitcnt vmcnt(0) lgkmcnt(0)\n\ts_barrier" ::: "memory");
  const int c = wid >> 2, dkb = (wid >> 1) & 1, dvb = wid & 1;
  const int vb = (int)lds0 + ((lane >> 4) & 1) * 32 + (lane & 3) * 8 + (4 * hi + ((lane & 15) >> 2)) * 64;
  f32x16 acc = f32x16{};
#pragma unroll
  for (int tl = 0; tl < 2; ++tl) {
    s16x4 alo[4], ahi[4], blo[4], bhi[4];
    const int ka = vb + ((c * 2 + 0) * 2 + tl) * 8192 + dkb * 4096, va = vb + ((c * 2 + 1) * 2 + tl) * 8192 + dvb * 4096;
#pragma unroll
    for (int ks = 0; ks < 4; ++ks) {
      asm volatile("ds_read_b64_tr_b16 %0,%1 offset:%c2" : "=&v"(alo[ks]) : "v"(ka), "i"(ks * 1024) : "memory");
      asm volatile("ds_read_b64_tr_b16 %0,%1 offset:%c2" : "=&v"(ahi[ks]) : "v"(ka), "i"(ks * 1024 + 512) : "memory");
      asm volatile("ds_read_b64_tr_b16 %0,%1 offset:%c2" : "=&v"(blo[ks]) : "v"(va), "i"(ks * 1024) : "memory");
      asm volatile("ds_read_b64_tr_b16 %0,%1 offset:%c2" : "=&v"(bhi[ks]) : "v"(va), "i"(ks * 1024 + 512) : "memory");
    }
    asm volatile("s_waitcnt lgkmcnt(0)" ::: "memory"); __builtin_amdgcn_sched_barrier(0);
#pragma unroll
    for (int ks = 0; ks < 4; ++ks) {
      const bf16x8 af = (bf16x8){alo[ks][0], alo[ks][1], alo[ks][2], alo[ks][3], ahi[ks][0], ahi[ks][1], ahi[ks][2], ahi[ks][3]};
      const bf16x8 bfr = (bf16x8){blo[ks][0], blo[ks][1], blo[ks][2], blo[ks][3], bhi[ks][0], bhi[ks][1], bhi[ks][2], bhi[ks][3]};
      acc = __builtin_amdgcn_mfma_f32_32x32x16_bf16(af, bfr, acc, 0, 0, 0);
    }
  }
  const float lgam = __builtin_amdgcn_logf(1.0f - __builtin_amdgcn_exp2f(-5.0f - (float)h));
  const float g127 = __builtin_amdgcn_exp2f(lgam * 127.0f);
  float* outp = KVF + ((size_t)((b * 4 + h) * 32 + cp * 2 + c)) * 4096 + dvb * 32 + r32;
#pragma unroll
  for (int r = 0; r < 16; ++r) outp[(size_t)(dkb * 32 + crow(r, hi)) * 64] = acc[r] * g127;
  asm volatile("s_waitcnt lgkmcnt(0)\n\ts_barrier" ::: "memory");
}

__device__ __forceinline__ void out_unit(const bf16* QR, const bf16* KR, const bf16* VR, const bf16* GR, const float* KVF, const float* rgain, bf16* Y, int b, int h, int cp, char* shm) {
  const int tid = opaque((int)threadIdx.x), lane = tid & 63, r32 = lane & 31, hi = lane >> 5; const int wid = __builtin_amdgcn_readfirstlane(tid >> 6);
  const unsigned lds0 = (unsigned)(uintptr_t)shm;
  constexpr int L_K = 0, L_V = 32768, L_S = 65536, L_O = 81920;
  const size_t rowb = (size_t)b * SEQ + (size_t)cp * 256;
  const long koff = (long)lane * 256 + h * 64 + wid * 8;
  const long voff = (long)(16 * (wid & 3) + (lane >> 2)) * 256 + h * 64 + (wid >> 2) * 32 + (lane & 3) * 8;
#pragma unroll
  for (int tl = 0; tl < 4; ++tl) {
    const size_t r0 = rowb + tl * 64;
    glds16(KR + r0 * 256 + koff, (unsigned)__builtin_amdgcn_readfirstlane(lds0 + L_K + tl * 8192 + wid * 1024));
    glds16(VR + r0 * 256 + voff, (unsigned)__builtin_amdgcn_readfirstlane(lds0 + L_V + tl * 8192 + wid * 1024));
  }
  {
    const float lgam = __builtin_amdgcn_logf(1.0f - __builtin_amdgcn_exp2f(-5.0f - (float)h));
    const float lgc = lgam * 128.0f;
    const int n0 = 2 * cp;
    int mlo = n0 - 1 - (int)(34.0f / (-lgc)); if (mlo < 0) mlo = 0;
    const float* kvp = KVF + ((size_t)((b * 4 + h) * 32)) * 4096 + tid * 8;
    f32x4 s0 = {0.f, 0.f, 0.f, 0.f}, s1 = {0.f, 0.f, 0.f, 0.f};
    int m = mlo;
    for (; m + 4 <= n0; m += 4) {
      f32x4 a[4], c4[4];
#pragma unroll
      for (int q = 0; q < 4; ++q) { a[q] = *(const f32x4*)(kvp + (size_t)(m + q) * 4096); c4[q] = *(const f32x4*)(kvp + (size_t)(m + q) * 4096 + 4); }
#pragma unroll
      for (int q = 0; q < 4; ++q) { const float w = __builtin_amdgcn_exp2f(lgc * (float)(n0 - 1 - m - q)); s0 += a[q] * w; s1 += c4[q] * w; }
    }
    for (; m < n0; ++m) {
      const float w = __builtin_amdgcn_exp2f(lgc * (float)(n0 - 1 - m));
      const f32x4 a = *(const f32x4*)(kvp + (size_t)m * 4096), c4 = *(const f32x4*)(kvp + (size_t)m * 4096 + 4);
      s0 += a * w; s1 += c4 * w;
    }
    const int dk = tid >> 3, dv = 8 * (tid & 7);
    char* sp = shm + L_S + (dv >> 5) * 4096 + dk * 64 + (dv & 31) * 2;
    u32x4 w0; w0.x = cvtpk(s0[0], s0[1]); w0.y = cvtpk(s0[2], s0[3]); w0.z = cvtpk(s1[0], s1[1]); w0.w = cvtpk(s1[2], s1[3]);
    *(u32x4*)sp = w0;
    const float dc = __builtin_amdgcn_exp2f(lgc);
    const f32x4 a = *(const f32x4*)(kvp + (size_t)n0 * 4096), c4 = *(const f32x4*)(kvp + (size_t)n0 * 4096 + 4);
    s0 = s0 * dc + a; s1 = s1 * dc + c4;
    u32x4 w1; w1.x = cvtpk(s0[0], s0[1]); w1.y = cvtpk(s0[2], s0[3]); w1.z = cvtpk(s1[0], s1[1]); w1.w = cvtpk(s1[2], s1[3]);
    *(u32x4*)(sp + 8192) = w1;
  }
  const int c = wid >> 2, wq = wid & 3;
  const bf16* Qw = QR + (rowb + c * 128 + wq * 32 + r32) * 256 + h * 64;
  bf16x8 qr[4]; u32x4 qa[4];
#pragma unroll
  for (int d0 = 0; d0 < 4; ++d0) qr[d0] = *reinterpret_cast<const bf16x8*>(Qw + d0 * 16 + hi * 8);
#pragma unroll
  for (int k = 0; k < 4; ++k) { const u32x2 lo = *(const u32x2*)(Qw + 16 * k + 4 * hi), hi2 = *(const u32x2*)(Qw + 16 * k + 8 + 4 * hi); qa[k] = (u32x4){lo.x, lo.y, hi2.x, hi2.y}; }
  asm volatile("s_waitcnt vmcnt(0) lgkmcnt(0)\n\ts_barrier" ::: "memory");
  const int vb = (int)lds0 + ((lane >> 4) & 1) * 32 + (lane & 3) * 8 + (4 * hi + ((lane & 15) >> 2)) * 64;
  f32x16 o[2]; o[0] = f32x16{}; o[1] = f32x16{};
  pv(o, vb + L_S + c * 8192, __builtin_bit_cast(bf16x8, qa[0]), __builtin_bit_cast(bf16x8, qa[1]), __builtin_bit_cast(bf16x8, qa[2]), __builtin_bit_cast(bf16x8, qa[3]));
  { const float gam = 1.0f - __builtin_amdgcn_exp2f(-5.0f - (float)h);
#pragma unroll
    for (int d0 = 0; d0 < 2; ++d0)
#pragma unroll
      for (int r = 0; r < 16; ++r) o[d0][r] *= gam; }
  const f32x16 zero = f32x16{};
  const int irow = wq * 32 + r32;
  for (int tl = 0; tl <= (wq >> 1); ++tl) {
    f32x16 p0, p1;
    attn_body::qkt(p0, p1, shm + L_K + (c * 2 + tl) * 8192, qr, zero, r32, hi);
    asm volatile("s_nop 15\n\ts_nop 7" : "+v"(p0), "+v"(p1));
#pragma unroll
    for (int r = 0; r < 16; ++r) { const int kj = 64 * tl + crow(r, hi); if (kj > irow) p0[r] = 0.f; if (kj + 32 > irow) p1[r] = 0.f; }
    u32x4 pw0, pw1, pw2, pw3;
    pw0 = (u32x4){cvtpk(p0[0], p0[1]), cvtpk(p0[2], p0[3]), cvtpk(p0[4], p0[5]), cvtpk(p0[6], p0[7])}; pw1 = (u32x4){cvtpk(p0[8], p0[9]), cvtpk(p0[10], p0[11]), cvtpk(p0[12], p0[13]), cvtpk(p0[14], p0[15])};
    pw2 = (u32x4){cvtpk(p1[0], p1[1]), cvtpk(p1[2], p1[3]), cvtpk(p1[4], p1[5]), cvtpk(p1[6], p1[7])}; pw3 = (u32x4){cvtpk(p1[8], p1[9]), cvtpk(p1[10], p1[11]), cvtpk(p1[12], p1[13]), cvtpk(p1[14], p1[15])};
    __builtin_amdgcn_sched_barrier(0);
    pv(o, vb + L_V + (c * 2 + tl) * 8192, __builtin_bit_cast(bf16x8, pw0), __builtin_bit_cast(bf16x8, pw1), __builtin_bit_cast(bf16x8, pw2), __builtin_bit_cast(bf16x8, pw3));
  }
  asm volatile("s_waitcnt lgkmcnt(0)\n\ts_barrier" ::: "memory");
  { float* stg = (float*)(shm + L_O) + wid * 2048;
#pragma unroll
    for (int r = 0; r < 16; ++r) { const int orow = crow(r, hi);
#pragma unroll
      for (int d0 = 0; d0 < 2; ++d0) stg[orow * 64 + d0 * 32 + r32] = o[d0][r]; }
    asm volatile("s_waitcnt lgkmcnt(0)" ::: "memory");
    const int row = lane >> 1, half = lane & 1;
    const f32x4* sr = (const f32x4*)(stg + row * 64 + half * 32);
    f32x4 v[8]; float ss = 0.f;
#pragma unroll
    for (int i = 0; i < 8; ++i) { v[i] = sr[i]; ss += (v[i][0] * v[i][0] + v[i][1] * v[i][1]) + (v[i][2] * v[i][2] + v[i][3] * v[i][3]); }
    ss += __shfl_xor(ss, 1);
    const float rstd = 1.0f / sqrtf(ss * (1.0f / 64.0f) + EPS);
    const size_t grow = rowb + c * 128 + wq * 32 + row;
    const u32x4* gp = (const u32x4*)(GR + grow * 256 + h * 64 + half * 32);
    const f32x4* rg = (const f32x4*)(rgain + h * 64 + half * 32);
    u32x4* yp = (u32x4*)(Y + grow * DM + 512 + h * 64 + half * 32);
#pragma unroll
    for (int i = 0; i < 4; ++i) {
      const u32x4 gw = gp[i]; const f32x4 g0 = rg[2 * i], g1 = rg[2 * i + 1]; const f32x4 a = v[2 * i] * rstd * g0, c4 = v[2 * i + 1] * rstd * g1;
      u32x4 w; w.x = cvtpk(a[0] * bflo(gw.x), a[1] * bfhi(gw.x)); w.y = cvtpk(a[2] * bflo(gw.y), a[3] * bfhi(gw.y)); w.z = cvtpk(c4[0] * bflo(gw.z), c4[1] * bfhi(gw.z)); w.w = cvtpk(c4[2] * bflo(gw.w), c4[3] * bfhi(gw.w));
      yp[i] = w;
    }
  }
  asm volatile("s_waitcnt lgkmcnt(0)\n\ts_barrier" ::: "memory");
}
}

#define XB_TMO      128
#define XB_XCNT(j)  (256  + 64 * (j))
#define XB_XSUB(j)  (1280 + 64 * (j))
#define XB_XGEN(j)  (2304 + 64 * (j))
#define XB_TOP      3328
#define XB_TOPGEN   3392
#define XCD_BAR_WORDS 3456
#define XB_SPIN_CAP (1u << 18)
__device__ __forceinline__ unsigned xb_ld(unsigned* p)              { return __hip_atomic_load(p, __ATOMIC_RELAXED, __HIP_MEMORY_SCOPE_AGENT); }
__device__ __forceinline__ unsigned xb_add(unsigned* p, unsigned v) { return __hip_atomic_fetch_add(p, v, __ATOMIC_RELAXED, __HIP_MEMORY_SCOPE_AGENT); }
__device__ __forceinline__ unsigned xb_xcc_id() { return (unsigned)__builtin_amdgcn_s_getreg((3 << 11) | 20) & 0xFu; }
#define XB_SPIN(cond, bar) do { unsigned _sp = 0; while (cond) { __builtin_amdgcn_s_sleep(1); \
    if ((++_sp & 255u) == 0u) { if (xb_ld(&(bar)[XB_TMO])) break; if (_sp > XB_SPIN_CAP) { atomicAdd(&(bar)[XB_TMO], 1u); break; } } } } while (0)
struct XcdBarrier { unsigned* bar; unsigned x; volatile LAS unsigned* st; };
__device__ __forceinline__ XcdBarrier xcd_barrier_post(unsigned* bar, volatile LAS unsigned* st) {
    XcdBarrier b; b.bar = bar; b.x = xb_xcc_id(); b.st = st;
    if (threadIdx.x == 0) (void)xb_add(&bar[XB_XCNT(b.x)], 1u);
    return b;
}
__device__ __forceinline__ void xcd_barrier_complete(unsigned* bar, unsigned x, unsigned& nloc, unsigned& nx) {
    const unsigned G = gridDim.x * gridDim.y * gridDim.z;
    unsigned sum, cnt, mine, sp = 0u;
    for (;;) {
        sum = 0u; cnt = 0u; mine = 0u;
#pragma unroll
        for (unsigned j = 0; j < 16; ++j) { const unsigned c = xb_ld(&bar[XB_XCNT(j)]); sum += c; cnt += (c > 0u) ? 1u : 0u; mine = (j == x) ? c : mine; }
        if (sum == G) break;
        __builtin_amdgcn_s_sleep(1);
        if ((++sp & 255u) == 0u) { if (xb_ld(&bar[XB_TMO])) break; if (sp > XB_SPIN_CAP) { atomicAdd(&bar[XB_TMO], 1u); break; } }
    }
    nloc = mine > 0u ? mine : 1u; nx = cnt > 0u ? cnt : 1u;
}
__device__ __forceinline__ void xcd_barrier(const XcdBarrier& b) {
    asm volatile("s_waitcnt vmcnt(0)" ::: "memory");
    __syncthreads();
    if (threadIdx.x == 0) {
        unsigned* bar = b.bar;
        __builtin_amdgcn_s_waitcnt(0);
        unsigned nloc = b.st[0], nx = b.st[1];
        if (nloc == 0u) { xcd_barrier_complete(bar, b.x, nloc, nx); b.st[0] = nloc; b.st[1] = nx; }
        const unsigned old = xb_add(&bar[XB_XSUB(b.x)], 1u);
        const unsigned gen = old / nloc;
        if (old + 1u == (gen + 1u) * nloc) {
            __builtin_amdgcn_fence(__ATOMIC_RELEASE, "agent");
            asm volatile("s_waitcnt vmcnt(0)" ::: "memory");
            const unsigned og = xb_add(&bar[XB_TOP], 1u);
            const unsigned tg = og / nx;
            if (og + 1u == (tg + 1u) * nx) xb_add(&bar[XB_TOPGEN], 1u);
            else XB_SPIN(xb_ld(&bar[XB_TOPGEN]) == tg, bar);
            __builtin_amdgcn_fence(__ATOMIC_ACQUIRE, "agent");
            xb_add(&bar[XB_XGEN(b.x)], 1u);
            asm volatile("s_waitcnt vmcnt(0)" ::: "memory");
        } else {
            XB_SPIN(xb_ld(&bar[XB_XGEN(b.x)]) == gen, bar);
            __builtin_amdgcn_fence(__ATOMIC_ACQUIRE, "agent");
            asm volatile("s_waitcnt vmcnt(0)" ::: "memory");
        }
    }
    __syncthreads();
}

__global__ void __launch_bounds__(NTHREADS, 2) fwd_kernel(Args args) {
    extern __shared__ __attribute__((aligned(16))) unsigned char lds_raw[];
    LAS unsigned char* lds = (LAS unsigned char*)lds_raw;
    cg::grid_group grid = cg::this_grid();
    const int tid0 = threadIdx.x, wave = __builtin_amdgcn_readfirstlane(tid0 >> 6);
#define PHASE_LANES const int tid = opaque(tid0), lane = tid & 63; (void)lane; (void)tid
    const int G = gridDim.x, bx = blockIdx.x;
    const int vcu = (G % 8 == 0) ? (bx % 8) * (G / 8) + bx / 8 : bx;
    const int gw = vcu * NWAVES + wave, NGW = G * NWAVES;
    unsigned char* const ws = args.ws;
#define WSP(type, off) ((type*)(ws + (off)))
    if (tid0 < 64) ((LAS unsigned*)(lds + LDS_MISC))[tid0] = 0u;
    __syncthreads();
    const XcdBarrier xbar = xcd_barrier_post(WSP(unsigned, WS_BAR), (volatile LAS unsigned*)(lds + LDS_MISC));
#define GRID_BAR() xcd_barrier(xbar)
    REPN(0) {
        PHASE_LANES;
        LAS float* scr = (LAS float*)(lds + wave * 16384);
        const float* x = args.in[0]; const float* mem = args.in[1]; const float* g_attn = args.in[2]; const float* w_in = args.in[3]; const float* g_mem = args.in[7];
        const float* w_mem_kv = args.in[8]; const float* w_out = args.in[11]; const float* g_ffn = args.in[12]; const float* w_router = args.in[13]; const float* w1 = args.in[15]; const float* w2 = args.in[17];
        bf16* WIN_T = WSP(bf16, WS_WIN); bf16* WMEM_T = WSP(bf16, WS_WMEM); bf16* WOUT_T = WSP(bf16, WS_WOUT); unsigned char* W1_8 = WSP(unsigned char, WS_W1); unsigned char* W2_8 = WSP(unsigned char, WS_W2);
        bf16* XN = WSP(bf16, WS_XN); bf16* MEMN = WSP(bf16, WS_MEMN); float* WRG = WSP(float, WS_WRG);
        constexpr int I0 = 16 * 88, I1 = 16 * 16, I2 = 16 * 32, I3 = 32 * 16 * 64, I4 = 32 * 16 * 32, NIT = I0 + I1 + I2 + I3 + I4;
        for (int it = gw; it < NIT; it += NGW) {
            int r = it;
            if (r < I0) { const int nb = r % 88, kb = r / 88; transpose_item(w_in, NIN, WIN_T, headperm_row(nb * 32), scr, kb * 64, nb * 32, lane); continue; } r -= I0;
            if (r < I1) { const int nb = r % 16, kb = r / 16; transpose_item(w_mem_kv, 512, WMEM_T, headperm_row(nb * 32), scr, kb * 64, nb * 32, lane); continue; } r -= I1;
            if (r < I2) { const int nb = r % 32, kb = r / 32; transpose_item(w_out, 1024, WOUT_T, nb * 32, scr, kb * 64, nb * 32, lane); continue; } r -= I2;
            if (r < I3) { const int e = r / 1024, rr = r % 1024, nb = rr % 64, kb = rr / 64; transpose_item_fp8<true>(w1 + (size_t)e * 1024 * 2048, 2048, W1_8 + (size_t)e * 2048 * 1024, scr, kb * 64, nb * 32, lane); continue; } r -= I3;
            { const int e = r / 512, rr = r % 512, nb = rr % 32, kb = rr / 32; transpose_item_fp8<false>(w2 + (size_t)e * 1024 * 1024, 1024, W2_8 + (size_t)e * 1024 * 1024, scr, kb * 64, nb * 32, lane); }
        }
        for (int m = gw; m < T + MROWS; m += NGW) {
            if (m < T) rms_row_to_bf16(x + (size_t)m * DM, g_attn, XN + (size_t)m * DM, lane);
            else rms_row_to_bf16(mem + (size_t)(m - T) * DM, g_mem, MEMN + (size_t)(m - T) * DM, lane);
        }
        for (int i = bx * NTHREADS + tid; i < DM * NEXP; i += G * NTHREADS) WRG[i] = g_ffn[i >> 5] * w_router[i];
    }
    grid.sync();

    REPN(1) {
        SchedProj S{G, bx, (const char*)(ws + WS_XN), (const char*)(ws + WS_MEMN), (const char*)(ws + WS_WIN), (const char*)(ws + WS_WMEM)};
        EpiProj E{ws, args.in[4], args.in[5], args.in[9], args.in[10]};
#ifndef NO_G1
        pg8::gemm_phase<EpiProj, SchedProj>(lds, S, E);
#endif
    }
    GRID_BAR();

#ifndef NAIVE_RET
    REPN(2) for (int i = 0; i < 2; ++i) {
        const int u = vcu * 2 + i, bh = u >> 4, cp = u & 15;
        ret_body::kv_unit(WSP(bf16, WS_KR), WSP(bf16, WS_VR), WSP(float, WS_RET), bh >> 2, bh & 3, cp, (char*)lds_raw);
    }
    GRID_BAR();
#endif
    { PHASE_LANES;
#ifdef NAIVE_MOBA
    naive_moba(WSP(bf16, WS_QA), WSP(bf16, WS_KA), WSP(bf16, WS_VA), WSP(float, WS_KMEAN), WSP(bf16, WS_Y), gw, NGW, lane);
#else
    REPN(20) for (int i = 0; i < 4; ++i) {
        const int bh = vcu >> 2, s = vcu & 3, nb = (i == 0) ? s : (i == 1) ? 7 - s : (i == 2) ? 8 + s : 15 - s, b = bh >> 3, h = bh & 7;
        const size_t row0 = (size_t)b * SEQ + (size_t)nb * 256;
        attn_body::attn_unit<8, 512, 1024, true>(WSP(bf16, WS_QA) + row0 * 512 + h * 64, WSP(bf16, WS_KA) + (size_t)b * SEQ * 512 + h * 64, WSP(bf16, WS_VA) + (size_t)b * SEQ * 512 + h * 64,
                                                 WSP(bf16, WS_Y) + row0 * DM + h * 64, 4 * nb + 4, nb, WSP(float, WS_KMEAN) + ((size_t)b * 16 * 8 + h) * 64, (char*)lds_raw);
    }
#endif
#ifdef NAIVE_RET
    naive_ret(WSP(bf16, WS_QR), WSP(bf16, WS_KR), WSP(bf16, WS_VR), WSP(bf16, WS_GR), args.in[6], WSP(bf16, WS_Y), gw, NGW, lane);
#else
    REPN(21) for (int i = 0; i < 2; ++i) {
        const int u = vcu * 2 + i, bh = u >> 4, cp = u & 15;
        ret_body::out_unit(WSP(bf16, WS_QR), WSP(bf16, WS_KR), WSP(bf16, WS_VR), WSP(bf16, WS_GR), WSP(float, WS_RET), args.in[6], WSP(bf16, WS_Y), bh >> 2, bh & 3, cp, (char*)lds_raw);
    }
#endif
#ifdef NAIVE_MEM
    naive_mem(WSP(bf16, WS_QM), WSP(bf16, WS_MK), WSP(bf16, WS_MV), WSP(bf16, WS_Y), gw, NGW, lane);
#else
    REPN(22) for (int i = 0; i < 2; ++i) {
        const int u = vcu * 2 + i, bh = u >> 4, qb = u & 15, b = bh >> 2, h = bh & 3;
        const size_t row0 = (size_t)b * SEQ + (size_t)qb * 256;
        attn_body::attn_unit<8, 256, 1024, false>(WSP(bf16, WS_QM) + row0 * 256 + h * 64, WSP(bf16, WS_MK) + (size_t)b * MEMLEN * 256 + h * 64, WSP(bf16, WS_MV) + (size_t)b * MEMLEN * 256 + h * 64,
                                                  WSP(bf16, WS_Y) + row0 * DM + 768 + h * 64, 4, 0, nullptr, (char*)lds_raw);
    }
#endif
    }
    GRID_BAR();

    REPN(3) {
        SchedPlain S{G, bx, 128, 4, (const char*)(ws + WS_Y), (const char*)(ws + WS_WOUT)};
        EpiOut E{args.in[0], args.out, WSP(float, WS_SSQ)};
#ifndef NO_G2
        pg8::gemm_phase<EpiOut, SchedPlain>(lds, S, E);
#endif
    }
    GRID_BAR();

    REPN(4) {
        PHASE_LANES;
        float* out = args.out; const float* b_router = args.in[14];
        float* WRG = WSP(float, WS_WRG); float* SSQ = WSP(float, WS_SSQ); int* TOPI = WSP(int, WS_TOPI); float* TOPW = WSP(float, WS_TOPW); int* LRANK = WSP(int, WS_LRANK); int* LCOUNT = WSP(int, WS_LCOUNT);
        unsigned char* XN2 = WSP(unsigned char, WS_XN2); const float* g_ffn = args.in[12];
        if (bx == 0 && tid < 64) ((u32x4*)(XN2 + (size_t)T * DM))[tid] = (u32x4){0u, 0u, 0u, 0u};
        LAS float* lg = (LAS float*)(lds) + wave * (16 * 33);
        LAS int* hist = (LAS int*)(lds + 32768);
        if (tid < 32) hist[tid] = 0;
        __syncthreads();
        const int tpw = T / (G * NWAVES);
        for (int tb = 0; tb < tpw; tb += 16) {
            const int t0 = (bx * NWAVES + wave) * tpw + tb;
            const int i = lane & 15, kq = lane >> 4;
            f32x4 a0 = {0.f, 0.f, 0.f, 0.f}, a1 = {0.f, 0.f, 0.f, 0.f};
            const float* xr = out + (size_t)(t0 + i) * DM + 4 * kq;
            const float* wb = WRG + (size_t)(4 * kq) * 32 + i;
            float rstd;
            { const f32x4* sp = (const f32x4*)(SSQ + (size_t)(t0 + i) * 16); const f32x4 s0 = sp[0], s1 = sp[1], s2 = sp[2], s3 = sp[3];
              const float ss = ((s0[0] + s0[1]) + (s0[2] + s0[3])) + ((s1[0] + s1[1]) + (s1[2] + s1[3])) + ((s2[0] + s2[1]) + (s2[2] + s2[3])) + ((s3[0] + s3[1]) + (s3[2] + s3[3]));
              rstd = 1.0f / sqrtf(ss * (1.0f / DM) + EPS); }
            unsigned char* xo = XN2 + (size_t)(t0 + i) * DM + 4 * kq;
            const float* gp = g_ffn + 4 * kq;
#pragma unroll 4
            for (int c = 0; c < 64; ++c) {
                const f32x4 av = *(const f32x4*)(xr + 16 * c);
                { const f32x4 gg = *(const f32x4*)(gp + 16 * c); int w = 0; w = __builtin_amdgcn_cvt_pk_fp8_f32(av[0] * rstd * gg[0], av[1] * rstd * gg[1], w, false); w = __builtin_amdgcn_cvt_pk_fp8_f32(av[2] * rstd * gg[2], av[3] * rstd * gg[3], w, true); *(int*)(xo + 16 * c) = w; }
#pragma unroll
                for (int q = 0; q < 4; ++q) {
                    const float b0 = wb[(size_t)(16 * c + q) * 32], b1v = wb[(size_t)(16 * c + q) * 32 + 16];
                    a0 = __builtin_amdgcn_mfma_f32_16x16x4f32(av[q], b0, a0, 0, 0, 0);
                    a1 = __builtin_amdgcn_mfma_f32_16x16x4f32(av[q], b1v, a1, 0, 0, 0);
                }
            }
#pragma unroll
            for (int r = 0; r < 4; ++r) { lg[(4 * kq + r) * 33 + i] = a0[r]; lg[(4 * kq + r) * 33 + 16 + i] = a1[r]; }
            LDS_WAIT(); asm volatile("" ::: "memory");
            if (lane < 16) {
                const int t = t0 + lane;
                float v[32];
#pragma unroll
                for (int e = 0; e < 32; ++e) v[e] = lg[lane * 33 + e] * rstd + b_router[e];
                int bi[4]; float bvv[4];
#pragma unroll
                for (int k = 0; k < 4; ++k) {
                    float best = -3e38f; int be = 0;
#pragma unroll
                    for (int e = 0; e < 32; ++e) { const bool take = v[e] > best; best = take ? v[e] : best; be = take ? e : be; }
                    bi[k] = be; bvv[k] = best;
#pragma unroll
                    for (int e = 0; e < 32; ++e) v[e] = (e == be) ? -3e38f : v[e];
                }
                const float e1 = __expf(bvv[1] - bvv[0]), e2 = __expf(bvv[2] - bvv[0]), e3 = __expf(bvv[3] - bvv[0]);
                const float inv = 1.0f / (1.0f + e1 + e2 + e3);
                const float wv[4] = {inv, e1 * inv, e2 * inv, e3 * inv};
#pragma unroll
                for (int k = 0; k < 4; ++k) {
                    const int rk = atomicAdd((int*)&hist[bi[k]], 1);
                    TOPI[t * 4 + k] = bi[k]; TOPW[t * 4 + k] = wv[k]; LRANK[t * 4 + k] = rk;
                }
            }
            LDS_WAIT(); asm volatile("" ::: "memory");
        }
        __syncthreads();
        if (tid < 32) LCOUNT[bx * 32 + tid] = hist[tid];
    }
    GRID_BAR();

    REPN(5) {
        PHASE_LANES;
        int* TOPI = WSP(int, WS_TOPI); float* TOPW = WSP(float, WS_TOPW); int* LRANK = WSP(int, WS_LRANK); int* LCOUNT = WSP(int, WS_LCOUNT);
        int* POS = WSP(int, WS_POS); float* ROWW = WSP(float, WS_ROWW); int* PSTART = WSP(int, WS_PSTART); int* TILEEXP = WSP(int, WS_TILEEXP);
        LAS int* part = (LAS int*)(lds);
        LAS int* base = (LAS int*)(lds + 8192);
        {
            const int e = tid & 31, p = tid >> 5; int c = 0, pre = 0;
            const int wpp = (G + 15) / 16;
            for (int w = p * wpp; w < (p + 1) * wpp && w < G; ++w) { const int v = LCOUNT[w * 32 + e]; c += v; pre += (w < bx) ? v : 0; }
            part[p * 32 + e] = c; part[512 + p * 32 + e] = pre;
        }
        __syncthreads();
        if (tid < 32) { int c = 0, pre = 0; for (int p = 0; p < 16; ++p) { c += part[p * 32 + tid]; pre += part[512 + p * 32 + tid]; } part[1024 + tid] = c; part[1056 + tid] = pre; }
        __syncthreads();
        if (tid == 0) {
            int ps = 0;
            for (int e = 0; e < 32; ++e) {
                const int c = part[1024 + e], nt_ = (c + 255) >> 8;
                base[32 + e] = ps; base[e] = ps + part[1056 + e];
                if (bx == 0) { PSTART[e] = ps; for (int tt = 0; tt < nt_; ++tt) TILEEXP[(ps >> 8) + tt] = e; }
                ps += nt_ * 256;
            }
            base[64] = ps; if (bx == 0) PSTART[32] = ps;
        }
        __syncthreads();
        int* ROWTOK = WSP(int, WS_ROWTOK);
        if (bx < 32) {
            const int c = part[1024 + bx], r0 = base[32 + bx] + c, r1 = base[32 + bx] + (((c + 255) >> 8) << 8);
            for (int r = r0 + tid; r < r1; r += NTHREADS) { ROWTOK[r] = T; ROWW[r] = 0.f; }
        }
        for (int a = tid; a < (T / G) * 4; a += NTHREADS) {
            const int ta = (bx * (T / G)) * 4 + a;
            const int e = TOPI[ta]; const int pos = base[e] + LRANK[ta];
            POS[ta] = pos; ROWTOK[pos] = ta >> 2; ROWW[pos] = TOPW[ta];
        }
    }
    GRID_BAR();

    const int ntiles = WSP(int, WS_PSTART)[32] >> 8;
    REPN(6) {
        SchedMoe S{G, vcu, 8, ntiles, WSP(int, WS_TILEEXP), (const char*)(ws + WS_XN2), (const char*)(ws + WS_W1), (size_t)2048 * 1024, WSP(int, WS_ROWTOK)};
        EpiSwiglu E{args.in[16], WSP(unsigned char, WS_H)};
#ifndef NO_G3
        pg8::gemm_phase<EpiSwiglu, SchedMoe, true, true>(lds, S, E);
#endif
    }
    GRID_BAR();
    REPN(7) {
        SchedMoe S{G, vcu, 4, ntiles, WSP(int, WS_TILEEXP), (const char*)(ws + WS_H), (const char*)(ws + WS_W2), (size_t)1024 * 1024, nullptr};
        EpiDown E{args.in[18], WSP(float, WS_ROWW), WSP(unsigned char, WS_XG)};
#ifndef NO_G4
        pg8::gemm_phase<EpiDown, SchedMoe, false, true>(lds, S, E);
#endif
    }
    GRID_BAR();
    { PHASE_LANES;
    for (int t = gw; t < T; t += NGW) {
        float* out = args.out; const int* POS = WSP(int, WS_POS); const unsigned char* YE = WSP(unsigned char, WS_XG);
        f32x4* orow = (f32x4*)(out + (size_t)t * DM) + lane;
        f32x4 v[4]; f32x4 s[4];
#pragma unroll
        for (int j = 0; j < 4; ++j) { v[j] = orow[64 * j]; s[j] = (f32x4){0.f, 0.f, 0.f, 0.f}; }
        unsigned yw[4][4];
#pragma unroll
        for (int k = 0; k < 4; ++k) {
            const int pos = POS[t * 4 + k]; const unsigned* yr = (const unsigned*)(YE + (size_t)pos * 1024) + lane;
#pragma unroll
            for (int j = 0; j < 4; ++j) yw[k][j] = yr[64 * j];
        }
#pragma unroll
        for (int k = 0; k < 4; ++k)
#pragma unroll
            for (int j = 0; j < 4; ++j) {
                const f32x2 lo = __builtin_amdgcn_cvt_pk_f32_fp8((int)yw[k][j], false), hi = __builtin_amdgcn_cvt_pk_f32_fp8((int)yw[k][j], true);
                s[j].x += lo.x; s[j].y += lo.y; s[j].z += hi.x; s[j].w += hi.y;
            }
#pragma unroll
        for (int j = 0; j < 4; ++j) orow[64 * j] = v[j] + s[j] * 0.0625f;
    }
    }
}

extern "C" void kernel_launch(void* const* d_in, const int* in_sizes, int n_in, void* d_out, int out_size, void* d_ws, size_t ws_size, hipStream_t stream) {
    static int grid = 0;
    if (grid == 0) {
        if (n_in != 19 || out_size != T * DM || ws_size < WS_END) { fprintf(stderr, "kernel_launch: unexpected shapes (n_in %d out %d ws %zu)\n", n_in, out_size, ws_size); grid = -1; return; }
        int dev = 0, cus = 0, per_cu = 0;
        hipGetDevice(&dev); hipDeviceGetAttribute(&cus, hipDeviceAttributeMultiprocessorCount, dev);
        hipFuncSetAttribute((const void*)fwd_kernel, hipFuncAttributeMaxDynamicSharedMemorySize, LDS_BYTES);
        hipOccupancyMaxActiveBlocksPerMultiprocessor(&per_cu, (const void*)fwd_kernel, NTHREADS, LDS_BYTES);
        if (per_cu < 1) { fprintf(stderr, "kernel_launch: occupancy query says %d blocks per CU\n", per_cu); per_cu = 1; }
        (void)hipGetLastError();
        grid = cus * 1;
        if (grid % 8 != 0 || T % (grid * NWAVES * 16) != 0) { fprintf(stderr, "kernel_launch: grid %d unsupported\n", grid); grid = -1; return; }
    }
    if (grid < 0) return;
    hipMemsetAsync((char*)d_ws + WS_CTL, 0, CTL_ZERO_BYTES, stream);
    Args a{};
    for (int i = 0; i < 19; ++i) a.in[i] = (const float*)d_in[i];
    a.out = (float*)d_out; a.ws = (unsigned char*)d_ws;
    void* kargs[] = {&a};
    hipError_t e = hipLaunchCooperativeKernel((const void*)fwd_kernel, dim3(grid), dim3(NTHREADS), kargs, LDS_BYTES, stream);
    if (e != hipSuccess) fprintf(stderr, "cooperative launch failed: %s (grid %d)\n", hipGetErrorString(e), grid);
}
```

```cpp
#include <hip/hip_runtime.h>
#include <hip/hip_cooperative_groups.h>
#include <cstdio>
#include <cstdint>
namespace cg = cooperative_groups;

#define GAS __attribute__((address_space(1)))
#define LAS __attribute__((address_space(3)))
typedef unsigned short bf16;
typedef short bf16x8 __attribute__((ext_vector_type(8)));
typedef float f32x4 __attribute__((ext_vector_type(4)));
typedef float f32x2 __attribute__((ext_vector_type(2)));
typedef unsigned u32x4 __attribute__((ext_vector_type(4)));
typedef unsigned u32x2 __attribute__((ext_vector_type(2)));
typedef __bf16 bf16x2_t __attribute__((ext_vector_type(2)));

constexpr int NB = 8, SEQ = 4096, DM = 1024, T = NB * SEQ;
constexpr int NIN = 2816, NEXP = 32, TOPK = 4;
constexpr int MEMLEN = 256, MROWS = NB * MEMLEN;
constexpr float EPS = 1e-6f;
constexpr float C2 = 0.125f * 1.4426950408889634f;
constexpr int MAXTILES = 544, PROWS = MAXTILES * 256;
constexpr int NWAVES = 8, NTHREADS = 512;
#ifndef REP_PHASE
#define REP_PHASE -1
#endif
#define REPN(k) for (int rep_ = 0; rep_ < ((REP_PHASE == (k)) ? 2 : 1); ++rep_)
constexpr int LDS_MISC = 150016;
constexpr int LDS_BYTES = 150016 + 256;

constexpr size_t MiB = 1u << 20;
constexpr size_t WS_CTL = 0, CTL_ZERO_BYTES = 2 * MiB;
constexpr size_t WS_BAR = 65536;
constexpr size_t WS_KMEAN = 1 * MiB;
constexpr size_t WS_WRG = 2 * MiB;
constexpr size_t WS_SSQ = 3 * MiB;
constexpr size_t WS_TOPI = 5 * MiB, WS_TOPW = 5 * MiB + 512 * 1024, WS_LRANK = 6 * MiB, WS_POS = 6 * MiB + 512 * 1024;
constexpr size_t WS_ROWW = 7 * MiB;
constexpr size_t WS_LCOUNT = 8 * MiB, WS_PSTART = 8 * MiB + 65536, WS_TILEEXP = 8 * MiB + 131072;
constexpr size_t WS_WIN = 16 * MiB, WS_WMEM = 22 * MiB, WS_WOUT = 24 * MiB, WS_W1 = 32 * MiB, WS_W2 = 160 * MiB;
constexpr size_t WS_XN = 224 * MiB, WS_MEMN = 288 * MiB;
constexpr size_t WS_QA = 292 * MiB, WS_KA = 324 * MiB, WS_VA = 356 * MiB;
constexpr size_t WS_QR = 388 * MiB, WS_KR = 404 * MiB, WS_VR = 420 * MiB, WS_GR = 436 * MiB, WS_QM = 452 * MiB;
constexpr size_t WS_MK = 468 * MiB, WS_MV = 469 * MiB;
constexpr size_t WS_Y = 470 * MiB, WS_RET = 534 * MiB;
constexpr size_t WS_XG = 224 * MiB;
constexpr size_t WS_XN2 = 496 * MiB;
constexpr size_t WS_ROWTOK = 9 * MiB;
constexpr size_t WS_H = 566 * MiB;
constexpr size_t WS_END = 838 * MiB;

struct Args {
    const float* in[19]; float* out; unsigned char* ws; int pad0, pad1;
};

__device__ __forceinline__ unsigned cvtpk(float lo, float hi) { f32x2 v = {lo, hi}; bf16x2_t b = __builtin_convertvector(v, bf16x2_t); return __builtin_bit_cast(unsigned, b); }
__device__ __forceinline__ float bf2f(unsigned short b) { return __uint_as_float(((unsigned)b) << 16); }
__device__ __forceinline__ float bflo(unsigned w) { return __uint_as_float(w << 16); }
__device__ __forceinline__ float bfhi(unsigned w) { return __uint_as_float(w & 0xffff0000u); }
__device__ __forceinline__ float wave_sum(float v) {
#pragma unroll
    for (int o = 1; o < 64; o <<= 1) v += __shfl_xor(v, o);
    return v;
}
#define LDS_WAIT() asm volatile("s_waitcnt lgkmcnt(0)" ::: "memory")
__device__ __forceinline__ int opaque(int v) { asm volatile("" : "+v"(v)); return v; }

namespace pg8 {
constexpr int BM = 256, BK = 64, HALF = 128, HTB = HALF * BK * 2, STAGE_BYTES = 8 * HTB, NXCD = 8, WGM = 8, K = 1024;
__host__ __device__ __forceinline__ int lds_byte(int r, int c) { const int st = (r >> 4) * 2 + (c >> 5), rr = r & 15, cc = c & 31, ob = rr * 64 + cc * 2; return st * 1024 + (ob ^ (((ob >> 9) & 1) << 5)); }
__host__ __device__ __forceinline__ void stage_rc(int b, int& R, int& C) { const int st = b / 1024, sb = b % 1024, swz = sb ^ (((sb >> 9) & 1) << 5); R = (st >> 1) * 16 + swz / 64; C = (st & 1) * 32 + (swz % 64) / 2; }
__host__ __device__ __forceinline__ int perm32(int rho) { const int n = rho >> 4, i = rho & 15; return 8 * (i >> 2) + 4 * n + (i & 3); }
struct Unit { int pm, pn, aux; };

__device__ __forceinline__ bool static_order(int L, int nM, int nN, int& pm, int& pn) {
    const int nwg = nM * nN; if (L >= nwg) return false;
    int wgid = L; { const int q = nwg / NXCD, r = nwg % NXCD, xcd = wgid % NXCD, off = wgid / NXCD; wgid = (xcd < r ? xcd * (q + 1) : r * (q + 1) + (xcd - r) * q) + off; }
    const int nig = WGM * nN, gid = wgid / nig, fm = gid * WGM, gsz = (nM - fm) < WGM ? (nM - fm) : WGM;
    pm = fm + ((wgid % nig) % gsz); pn = (wgid % nig) / gsz; return true;
}

typedef int v8i_t __attribute__((ext_vector_type(8)));
typedef int v4i_t __attribute__((ext_vector_type(4)));
__device__ __forceinline__ v8i_t cat8(bf16x8 lo, bf16x8 hi) { const v4i_t a = __builtin_bit_cast(v4i_t, lo), b = __builtin_bit_cast(v4i_t, hi); return __builtin_shufflevector(a, b, 0, 1, 2, 3, 4, 5, 6, 7); }
template <class Epi, class Sched, bool GATHER = false, bool FP8 = false>
__device__ __forceinline__ void gemm_phase(LAS unsigned char* lds, const Sched& S, const Epi& E) {
    constexpr int PITCH = FP8 ? 1024 : 2048;
    const int tid = opaque((int)threadIdx.x), wid = __builtin_amdgcn_readfirstlane(tid >> 6), lane = tid & 63, wr = wid >> 2, wc = wid & 3, fr = lane & 15, fq = lane >> 4;
    constexpr int nt = PITCH / 128;
    unsigned voffA[2], voffB[2];
#pragma unroll
    for (int i = 0; i < 2; ++i) { int R, C; stage_rc(tid * 16 + i * 8192, R, C); const int Rb = (R & ~31) + perm32(R & 31);
        voffA[i] = (unsigned)(R * PITCH + C * 2); voffB[i] = (unsigned)(Rb * PITCH + C * 2); }
    const size_t kstep = (size_t)(BK * 2);
    const size_t hstep = (size_t)HALF * PITCH;
    const unsigned ldsw = (unsigned)wid * 1024u;
    const int aoff = lds_byte(wr * 64 + fr, fq * 8), boff = lds_byte(wc * 32 + fr, fq * 8);
#define PG8_SA(b, h) (((b) * 2 + (h)) * HTB)
#define PG8_SB(b, h) ((4 + (b) * 2 + (h)) * HTB)
#define PG8_STAGE(bufoff, gbase, voff) do { _Pragma("unroll") for (int _i = 0; _i < 2; ++_i) \
        __builtin_amdgcn_global_load_lds((const unsigned*)((const char*)(gbase) + (voff)[_i]), (LAS unsigned*)(lds + (bufoff) + ldsw + _i * 8192), 16, 0, 0); } while (0)
#define PG8_LDA(dst, b, h) do { _Pragma("unroll") for (int m = 0; m < 4; ++m) _Pragma("unroll") for (int k = 0; k < 2; ++k) dst[m][k] = *(const LAS bf16x8*)(lds + PG8_SA(b, h) + aoff + m * 2048 + k * 1024); } while (0)
#define PG8_LDB(dst, b, h) do { _Pragma("unroll") for (int n = 0; n < 2; ++n) _Pragma("unroll") for (int k = 0; k < 2; ++k) dst[n][k] = *(const LAS bf16x8*)(lds + PG8_SB(b, h) + boff + n * 2048 + k * 1024); } while (0)
#define PG8_MMA(ai, bj, At, Bt) do { __builtin_amdgcn_s_setprio(1); \
        if constexpr (FP8) { _Pragma("unroll") for (int m = 0; m < 4; ++m) _Pragma("unroll") for (int n = 0; n < 2; ++n) \
            asm volatile("v_mfma_scale_f32_16x16x128_f8f6f4 %0, %1, %2, %0, %3, %3 op_sel_hi:[0,0,0]" : "+v"(acc[ai][bj][m][n]) : "v"(cat8(Bt[n][0], Bt[n][1])), "v"(cat8(At[m][0], At[m][1])), "v"(0x7f7f7f7f)); } \
        else { _Pragma("unroll") for (int m = 0; m < 4; ++m) _Pragma("unroll") for (int n = 0; n < 2; ++n) _Pragma("unroll") for (int k = 0; k < 2; ++k) \
            acc[ai][bj][m][n] = __builtin_amdgcn_mfma_f32_16x16x32_bf16(Bt[n][k], At[m][k], acc[ai][bj][m][n], 0, 0, 0); } \
        __builtin_amdgcn_s_setprio(0); } while (0)
#define PG8_WAIT_V(n) asm volatile("s_waitcnt vmcnt(" #n ")" ::: "memory")
#define PG8_WAIT_L(n) asm volatile("s_waitcnt lgkmcnt(" #n ")" ::: "memory")
#define PG8_BAR __builtin_amdgcn_s_barrier()
#define PG8_SCHED __builtin_amdgcn_sched_barrier(0)
    Unit cur, nxt; int ui = 0;
    if (!S.next(0, cur)) return;
    unsigned vGc[2][2], vGn[2][2]; int gR[2], gC[2];
    const char* gA = nullptr;
    if constexpr (GATHER) {
        gA = S.abase();
#pragma unroll
        for (int i = 0; i < 2; ++i) { stage_rc(tid * 16 + i * 8192, gR[i], gC[i]); }
        if (wid == 0) __builtin_amdgcn_global_load_lds((const unsigned*)(S.tokptr(cur) + lane * 16), (LAS unsigned*)(lds + 131072), 16, 0, 0);
        asm volatile("s_waitcnt vmcnt(0)" ::: "memory"); __builtin_amdgcn_s_barrier(); asm volatile("" ::: "memory");
#pragma unroll
        for (int h = 0; h < 2; ++h)
#pragma unroll
            for (int i = 0; i < 2; ++i) { const int tok = ((const LAS int*)(lds + 131072))[h * 128 + gR[i]]; vGc[h][i] = (unsigned)tok * (unsigned)PITCH + (unsigned)gC[i] * 2u; vGn[h][i] = vGc[h][i]; }
    }
    f32x4 acc[2][2][4][2];
#pragma unroll
    for (int a = 0; a < 2; ++a)
#pragma unroll
        for (int b = 0; b < 2; ++b)
#pragma unroll
            for (int m = 0; m < 4; ++m)
#pragma unroll
                for (int n = 0; n < 2; ++n) acc[a][b][m][n] = (f32x4){0.f, 0.f, 0.f, 0.f};
    bf16x8 At[4][2], B0[2][2], B1[2][2];
    const char* cA = GATHER ? gA : S.aptr(cur); const char* cB = S.bptr(cur);
    const size_t ahstep = GATHER ? (size_t)0 : hstep;
    {
        PG8_STAGE(PG8_SB(0, 0), cB, voffB); PG8_STAGE(PG8_SB(0, 1), cB + hstep, voffB);
        if constexpr (GATHER) { PG8_STAGE(PG8_SA(0, 0), cA, vGc[0]); PG8_STAGE(PG8_SA(0, 1), cA, vGc[1]); } else { PG8_STAGE(PG8_SA(0, 0), cA, voffA); PG8_STAGE(PG8_SA(0, 1), cA + hstep, voffA); }
        if (wr == 1) PG8_BAR;
        PG8_WAIT_V(2); PG8_BAR;
        PG8_STAGE(PG8_SB(1, 0), cB + kstep, voffB);
        if constexpr (GATHER) { PG8_STAGE(PG8_SA(1, 0), cA + kstep, vGc[0]); } else { PG8_STAGE(PG8_SA(1, 0), cA + kstep, voffA); }
        PG8_STAGE(PG8_SB(1, 1), cB + hstep + kstep, voffB);
        PG8_WAIT_V(6); PG8_BAR;
    }
    for (;;) {
        const bool has_next = S.next(ui + 1, nxt);
        const char* nA = GATHER ? gA : (has_next ? S.aptr(nxt) : cA); const char* nB = has_next ? S.bptr(nxt) : cB;
        if constexpr (GATHER) { if (has_next && wid == 0) __builtin_amdgcn_global_load_lds((const unsigned*)(S.tokptr(nxt) + lane * 16), (LAS unsigned*)(lds + 131072 + ((ui + 1) & 1) * 1024), 16, 0, 0); }
#pragma nounroll
        for (int t = 0; t < nt; t += 2) {
            const bool last = (t == nt - 2);
            const char* a1 = cA + (size_t)(t + 1) * kstep;
            const char* a2 = last ? nA : cA + (size_t)(t + 2) * kstep; const char* b2 = last ? nB : cB + (size_t)(t + 2) * kstep;
            const char* a3 = a2 + kstep; const char* b3 = b2 + kstep;
            unsigned v2h0[2], v2h1[2];
            if constexpr (GATHER) {
                if (last && has_next) {
                    const LAS int* tk = (const LAS int*)(lds + 131072 + ((ui + 1) & 1) * 1024);
#pragma unroll
                    for (int h = 0; h < 2; ++h)
#pragma unroll
                        for (int i = 0; i < 2; ++i) vGn[h][i] = (unsigned)tk[h * 128 + gR[i]] * (unsigned)PITCH + (unsigned)gC[i] * 2u;
                }
#pragma unroll
                for (int i = 0; i < 2; ++i) { v2h0[i] = last ? vGn[0][i] : vGc[0][i]; v2h1[i] = last ? vGn[1][i] : vGc[1][i]; }
            } else {
#pragma unroll
                for (int i = 0; i < 2; ++i) { v2h0[i] = voffA[i]; v2h1[i] = voffA[i]; }
            }
            PG8_LDB(B0, 0, 0); PG8_LDB(B1, 0, 1); PG8_SCHED; PG8_LDA(At, 0, 0);
            if constexpr (GATHER) { PG8_STAGE(PG8_SA(1, 1), a1, vGc[1]); } else { PG8_STAGE(PG8_SA(1, 1), a1 + hstep, voffA); }
            PG8_WAIT_V(8); PG8_WAIT_L(0); PG8_BAR; PG8_MMA(0, 0, At, B0); PG8_MMA(0, 1, At, B1); PG8_BAR; PG8_SCHED;
            PG8_LDA(At, 0, 1); PG8_STAGE(PG8_SB(0, 0), b2, voffB); PG8_STAGE(PG8_SB(0, 1), b2 + hstep, voffB); PG8_STAGE(PG8_SA(0, 0), a2, v2h0);
            PG8_WAIT_V(8); PG8_WAIT_L(0); PG8_BAR; PG8_MMA(1, 0, At, B0); PG8_MMA(1, 1, At, B1); PG8_BAR; PG8_SCHED;
            PG8_LDB(B0, 1, 0); PG8_LDB(B1, 1, 1); PG8_SCHED; PG8_LDA(At, 1, 0); PG8_STAGE(PG8_SA(0, 1), a2 + ahstep, v2h1);
            PG8_WAIT_V(8); PG8_WAIT_L(0); PG8_BAR; PG8_MMA(0, 0, At, B0); PG8_MMA(0, 1, At, B1); PG8_BAR; PG8_SCHED;
            PG8_LDA(At, 1, 1); PG8_STAGE(PG8_SB(1, 0), b3, voffB); PG8_STAGE(PG8_SB(1, 1), b3 + hstep, voffB); PG8_STAGE(PG8_SA(1, 0), a3, v2h0);
            PG8_WAIT_V(8); PG8_WAIT_L(0); PG8_BAR; PG8_MMA(1, 0, At, B0); PG8_MMA(1, 1, At, B1); PG8_BAR; PG8_SCHED;
        }
        if (wr == 0) PG8_BAR;
        if constexpr (FP8) asm volatile("s_nop 15\n\ts_nop 7" ::: "memory");
        E(acc, cur, wr, wc, fr, fq);
        if (!has_next) break;
#pragma unroll
        for (int a = 0; a < 2; ++a)
#pragma unroll
            for (int b = 0; b < 2; ++b)
#pragma unroll
                for (int m = 0; m < 4; ++m)
#pragma unroll
                    for (int n = 0; n < 2; ++n) acc[a][b][m][n] = (f32x4){0.f, 0.f, 0.f, 0.f};
        cur = nxt; cA = nA; cB = nB; ++ui;
        if constexpr (GATHER) {
#pragma unroll
            for (int h = 0; h < 2; ++h)
#pragma unroll
                for (int i = 0; i < 2; ++i) vGc[h][i] = vGn[h][i];
        }
        if (wr == 1) PG8_BAR;
    }
    PG8_WAIT_V(0);
    PG8_BAR;
#undef PG8_SA
#undef PG8_SB
#undef PG8_STAGE
#undef PG8_LDA
#undef PG8_LDB
#undef PG8_MMA
#undef PG8_WAIT_V
#undef PG8_WAIT_L
#undef PG8_BAR
#undef PG8_SCHED
}
}
using pg8::Unit;

struct SchedProj {
    int G, c; const char *XN, *MEMN, *WIN, *WMEM;
    __device__ __forceinline__ bool next(int i, Unit& u) const {
        const int L = i * G + c;
        if (L < 1408) { u.aux = 0; return pg8::static_order(L, 128, 11, u.pm, u.pn); }
        if (L < 1424) { const int j = L - 1408; u.pm = j >> 1; u.pn = j & 1; u.aux = 1; return true; }
        return false;
    }
    __device__ __forceinline__ const char* aptr(const Unit& u) const { return (u.aux ? MEMN : XN) + (size_t)u.pm * (256 * 2048); }
    __device__ __forceinline__ const char* bptr(const Unit& u) const { return (u.aux ? WMEM : WIN) + (size_t)u.pn * (256 * 2048); }
};
struct SchedPlain {
    int G, c, nM, nN; const char *A, *B;
    __device__ __forceinline__ bool next(int i, Unit& u) const { u.aux = 0; return pg8::static_order(i * G + c, nM, nN, u.pm, u.pn); }
    __device__ __forceinline__ const char* aptr(const Unit& u) const { return A + (size_t)u.pm * (256 * 2048); }
    __device__ __forceinline__ const char* bptr(const Unit& u) const { return B + (size_t)u.pn * (256 * 2048); }
};
struct SchedMoe {
    int G, vcu, npn, ntiles; const int* tile_exp; const char *A, *B; size_t bexp;
    __device__ __forceinline__ bool next(int i, Unit& u) const {
        const int L = i * G + vcu, tile = L / npn; if (tile >= ntiles) return false;
        u.pm = tile; u.pn = L - tile * npn; u.aux = __builtin_amdgcn_readfirstlane(tile_exp[tile]); return true;
    }
    __device__ __forceinline__ const char* aptr(const Unit& u) const { return A + (size_t)u.pm * (256 * 1024); }
    __device__ __forceinline__ const char* bptr(const Unit& u) const { return B + (size_t)u.aux * bexp + (size_t)u.pn * (256 * 1024); }
    const int* rowtok;
    __device__ __forceinline__ const char* abase() const { return A; }
    __device__ __forceinline__ const char* tokptr(const Unit& u) const { return (const char*)(rowtok + (size_t)u.pm * 256); }
};

struct EpiProj {
    unsigned char* ws;
    const float *gq, *gk, *gmq, *gmk;
    __device__ __forceinline__ void operator()(const f32x4 (&acc)[2][2][4][2], const Unit& u, int wr, int wc, int fr, int fq) const {
        int mode = 0; bf16* out; int ld = 256, coff = 0; const float* gain = nullptr; float scale = 1.f; bool kmean = false;
        if (u.aux == 0) {
            switch (u.pn) {
                case 0: case 1: out = (bf16*)(ws + WS_QA); ld = 512; coff = u.pn * 256; mode = 1; gain = gq; scale = C2; break;
                case 2: case 3: out = (bf16*)(ws + WS_KA); ld = 512; coff = (u.pn - 2) * 256; mode = 1; gain = gk; kmean = true; break;
                case 4: case 5: out = (bf16*)(ws + WS_VA); ld = 512; coff = (u.pn - 4) * 256; break;
                case 6: out = (bf16*)(ws + WS_QR); mode = 2; break;
                case 7: out = (bf16*)(ws + WS_KR); mode = 2; scale = 0.125f; break;
                case 8: out = (bf16*)(ws + WS_VR); break;
                case 9: out = (bf16*)(ws + WS_GR); mode = 3; break;
                default: out = (bf16*)(ws + WS_QM); mode = 1; gain = gmq; scale = C2; break;
            }
        } else {
            if (u.pn == 0) { out = (bf16*)(ws + WS_MK); mode = 1; gain = gmk; } else { out = (bf16*)(ws + WS_MV); }
        }
        const int row0 = u.pm * 256 + wr * 64 + fr;
        const int colb = coff + wc * 64 + 8 * fq;
        if (gain == nullptr) gain = gq;
        f32x4 ks[2][2];
#pragma unroll
        for (int bj = 0; bj < 2; ++bj)
#pragma unroll
            for (int n = 0; n < 2; ++n) ks[bj][n] = (f32x4){0.f, 0.f, 0.f, 0.f};
#pragma unroll
        for (int ai = 0; ai < 2; ++ai)
#pragma unroll
            for (int m = 0; m < 4; ++m) {
                const int row = row0 + ai * 128 + m * 16;
                f32x4 v[2][2];
#pragma unroll
                for (int bj = 0; bj < 2; ++bj)
#pragma unroll
                    for (int n = 0; n < 2; ++n) v[bj][n] = acc[ai][bj][m][n];
                if (mode == 1) {
                    float ss = 0.f;
#pragma unroll
                    for (int bj = 0; bj < 2; ++bj)
#pragma unroll
                        for (int n = 0; n < 2; ++n) { const f32x4 x = v[bj][n]; ss += (x[0] * x[0] + x[1] * x[1]) + (x[2] * x[2] + x[3] * x[3]); }
                    ss += __shfl_xor(ss, 16); ss += __shfl_xor(ss, 32);
                    const float r = scale / sqrtf(ss * (1.0f / 64.0f) + EPS);
#pragma unroll
                    for (int bj = 0; bj < 2; ++bj)
#pragma unroll
                        for (int n = 0; n < 2; ++n) v[bj][n] = v[bj][n] * r * *(const f32x4*)(gain + bj * 32 + 8 * fq + 4 * n);
                } else if (mode == 2) {
                    const float pos = (float)(row & (SEQ - 1));
                    const float lgam = __builtin_amdgcn_logf(1.0f - __builtin_amdgcn_exp2f(-5.0f - (float)wc));
                    const float rsc = scale * __builtin_amdgcn_exp2f(((u.pn == 6) ? lgam : -lgam) * (float)(row & 127));
#pragma unroll
                    for (int n = 0; n < 2; ++n)
#pragma unroll
                        for (int j = 0; j < 4; ++j) {
                            const float fre = __builtin_amdgcn_exp2f((float)(8 * fq + 4 * n + j) * (-13.287712379549449f / 31.0f)) * 0.15915494309189535f;
                            float tt = pos * fre; tt = tt - floorf(tt);
                            const float sn = __builtin_amdgcn_sinf(tt), cs = __builtin_amdgcn_cosf(tt);
                            const float t1 = v[0][n][j], t2 = v[1][n][j];
                            v[0][n][j] = (t1 * cs - t2 * sn) * rsc; v[1][n][j] = (t2 * cs + t1 * sn) * rsc;
                        }
                } else if (mode == 3) {
#pragma unroll
                    for (int bj = 0; bj < 2; ++bj)
#pragma unroll
                        for (int n = 0; n < 2; ++n)
#pragma unroll
                            for (int j = 0; j < 4; ++j) { const float x = v[bj][n][j]; v[bj][n][j] = x / (1.0f + __expf(-x)); }
                }
                if (kmean) {
#pragma unroll
                    for (int bj = 0; bj < 2; ++bj)
#pragma unroll
                        for (int n = 0; n < 2; ++n) ks[bj][n] += v[bj][n];
                }
                bf16* rowp = out + (size_t)row * ld + colb;
#pragma unroll
                for (int bj = 0; bj < 2; ++bj) { u32x4 w; w.x = cvtpk(v[bj][0][0], v[bj][0][1]); w.y = cvtpk(v[bj][0][2], v[bj][0][3]); w.z = cvtpk(v[bj][1][0], v[bj][1][1]); w.w = cvtpk(v[bj][1][2], v[bj][1][3]);
                    *(u32x4*)(rowp + bj * 32) = w; }
            }
        if (kmean) {
            float* kp = (float*)(ws + WS_KMEAN) + ((size_t)u.pm * 8 + (u.pn - 2) * 4 + wc) * 64 + 8 * fq;
#pragma unroll
            for (int bj = 0; bj < 2; ++bj)
#pragma unroll
                for (int n = 0; n < 2; ++n)
#pragma unroll
                    for (int j = 0; j < 4; ++j) {
                        float s = ks[bj][n][j];
                        s += __shfl_xor(s, 1); s += __shfl_xor(s, 2); s += __shfl_xor(s, 4); s += __shfl_xor(s, 8);
                        if (fr == 0) atomicAdd(kp + bj * 32 + 4 * n + j, s * (1.0f / 256.0f));
                    }
        }
    }
};

struct EpiOut {
    const float* x; float* out; float* ssq;
    __device__ __forceinline__ void operator()(const f32x4 (&acc)[2][2][4][2], const Unit& u, int wr, int wc, int fr, int fq) const {
        const int row0 = u.pm * 256 + wr * 64 + fr, col0 = u.pn * 256 + wc * 32 + 8 * fq;
#pragma unroll
        for (int ai = 0; ai < 2; ++ai)
#pragma unroll
            for (int m = 0; m < 4; ++m) {
                const int row = row0 + ai * 128 + m * 16; const size_t off = (size_t)row * DM + col0; float ss = 0.f;
#pragma unroll
                for (int bj = 0; bj < 2; ++bj)
#pragma unroll
                    for (int n = 0; n < 2; ++n) { const f32x4 xv = *(const f32x4*)(x + off + bj * 128 + 4 * n); const f32x4 o = xv + acc[ai][bj][m][n];
                        ss += (o[0] * o[0] + o[1] * o[1]) + (o[2] * o[2] + o[3] * o[3]); *(f32x4*)(out + off + bj * 128 + 4 * n) = o; }
                ss += __shfl_xor(ss, 16); ss += __shfl_xor(ss, 32);
                if (fq == 0) ssq[(size_t)row * 16 + u.pn * 4 + wc] = ss;
            }
    }
};

struct EpiSwiglu {
    const float* b1; unsigned char* H;
    __device__ __forceinline__ void operator()(const f32x4 (&acc)[2][2][4][2], const Unit& u, int wr, int wc, int fr, int fq) const {
        const int row0 = u.pm * 256 + wr * 64 + fr, p0 = u.pn * 128 + wc * 32 + 8 * fq;
        const float* bp = b1 + (size_t)u.aux * 2048 + 2 * p0;
        f32x4 bv[4];
#pragma unroll
        for (int i = 0; i < 4; ++i) bv[i] = *(const f32x4*)(bp + 4 * i);
#pragma unroll
        for (int ai = 0; ai < 2; ++ai)
#pragma unroll
            for (int m = 0; m < 4; ++m) {
                const int row = row0 + ai * 128 + m * 16;
                float h[8];
#pragma unroll
                for (int n = 0; n < 2; ++n)
#pragma unroll
                    for (int j = 0; j < 4; ++j) {
                        const int i = 4 * n + j;
                        const float g = fminf(acc[ai][0][m][n][j] * 0.03125f + bv[i >> 1][(i & 1) * 2], 7.0f);
                        const float l = fminf(fmaxf(acc[ai][1][m][n][j] * 0.03125f + bv[i >> 1][(i & 1) * 2 + 1], -7.0f), 7.0f);
                        h[i] = g * __builtin_amdgcn_rcpf(1.0f + __builtin_amdgcn_exp2f(-1.702f * 1.4426950408889634f * g)) * (l + 1.0f);
                    }
                int w0 = 0, w1 = 0;
                w0 = __builtin_amdgcn_cvt_pk_fp8_f32(h[0], h[1], w0, false); w0 = __builtin_amdgcn_cvt_pk_fp8_f32(h[2], h[3], w0, true);
                w1 = __builtin_amdgcn_cvt_pk_fp8_f32(h[4], h[5], w1, false); w1 = __builtin_amdgcn_cvt_pk_fp8_f32(h[6], h[7], w1, true);
                *(u32x2*)(H + (size_t)row * 1024 + p0) = (u32x2){(unsigned)w0, (unsigned)w1};
            }
    }
};

struct EpiDown {
    const float* b2; const float* roww; unsigned char* YE;
    __device__ __forceinline__ void operator()(const f32x4 (&acc)[2][2][4][2], const Unit& u, int wr, int wc, int fr, int fq) const {
        const int row0 = u.pm * 256 + wr * 64 + fr, c0 = u.pn * 256 + wc * 32 + 8 * fq;
        const float* bp = b2 + (size_t)u.aux * 1024 + c0;
        f32x4 bv[2][2];
#pragma unroll
        for (int bj = 0; bj < 2; ++bj)
#pragma unroll
            for (int n = 0; n < 2; ++n) bv[bj][n] = *(const f32x4*)(bp + bj * 128 + 4 * n);
#pragma unroll
        for (int ai = 0; ai < 2; ++ai)
#pragma unroll
            for (int m = 0; m < 4; ++m) {
                const int row = row0 + ai * 128 + m * 16; const float w8 = roww[row] * 16.0f;
#pragma unroll
                for (int bj = 0; bj < 2; ++bj) {
                    const f32x4 y0 = (acc[ai][bj][m][0] * 0.03125f + bv[bj][0]) * w8, y1 = (acc[ai][bj][m][1] * 0.03125f + bv[bj][1]) * w8;
                    int w0 = 0, w1 = 0;
                    w0 = __builtin_amdgcn_cvt_pk_fp8_f32(y0[0], y0[1], w0, false); w0 = __builtin_amdgcn_cvt_pk_fp8_f32(y0[2], y0[3], w0, true);
                    w1 = __builtin_amdgcn_cvt_pk_fp8_f32(y1[0], y1[1], w1, false); w1 = __builtin_amdgcn_cvt_pk_fp8_f32(y1[2], y1[3], w1, true);
                    *(u32x2*)(YE + (size_t)row * 1024 + c0 + bj * 128) = (u32x2){(unsigned)w0, (unsigned)w1};
                }
            }
    }
};

__device__ __forceinline__ void transpose_item(const float* W, int N, bf16* WT, int drow0, LAS float* scr, int k0, int n0, int lane) {
    float ld_[32];
#pragma unroll
    for (int i = 0; i < 32; ++i) { const int kk = 2 * i + (lane >> 5); ld_[i] = W[(size_t)(k0 + kk) * N + n0 + (lane & 31)]; }
#pragma unroll
    for (int i = 0; i < 32; ++i) { const int kk = 2 * i + (lane >> 5); scr[kk * 33 + (lane & 31)] = ld_[i]; }
    LDS_WAIT(); asm volatile("" ::: "memory");
    const int c = lane & 7;
#pragma unroll
    for (int j = 0; j < 4; ++j) { const int n = (lane >> 3) + 8 * j; const LAS float* s = scr + (8 * c) * 33 + n;
        u32x4 o; o.x = cvtpk(s[0 * 33], s[1 * 33]); o.y = cvtpk(s[2 * 33], s[3 * 33]); o.z = cvtpk(s[4 * 33], s[5 * 33]); o.w = cvtpk(s[6 * 33], s[7 * 33]);
        *(u32x4*)(WT + (size_t)(drow0 + n) * 1024 + k0 + 8 * c) = o; }
    LDS_WAIT(); asm volatile("" ::: "memory");
}
template <bool GLU>
__device__ __forceinline__ void transpose_item_fp8(const float* W, int N, unsigned char* W8, LAS float* scr, int k0, int n0, int lane) {
    float ld_[32];
#pragma unroll
    for (int i = 0; i < 32; ++i) { const int kk = 2 * i + (lane >> 5); ld_[i] = W[(size_t)(k0 + kk) * N + n0 + (lane & 31)]; }
#pragma unroll
    for (int i = 0; i < 32; ++i) { const int kk = 2 * i + (lane >> 5); scr[kk * 33 + (lane & 31)] = ld_[i]; }
    LDS_WAIT(); asm volatile("" ::: "memory");
    const int c = lane & 3;
#pragma unroll
    for (int j = 0; j < 2; ++j) { const int n = (lane >> 2) + 16 * j; const LAS float* s = scr + (16 * c) * 33 + n;
        int w[4];
#pragma unroll
        for (int q = 0; q < 4; ++q) { int t = 0; t = __builtin_amdgcn_cvt_pk_fp8_f32(s[(4 * q) * 33] * 32.0f, s[(4 * q + 1) * 33] * 32.0f, t, false); t = __builtin_amdgcn_cvt_pk_fp8_f32(s[(4 * q + 2) * 33] * 32.0f, s[(4 * q + 3) * 33] * 32.0f, t, true); w[q] = t; }
        const int col = n0 + n; const int p = col >> 1;
        const int drow = GLU ? ((p >> 7) * 256 + (col & 1) * 128 + (p & 127)) : col;
        *(u32x4*)(W8 + (size_t)drow * 1024 + k0 + 16 * c) = (u32x4){(unsigned)w[0], (unsigned)w[1], (unsigned)w[2], (unsigned)w[3]}; }
    LDS_WAIT(); asm volatile("" ::: "memory");
}
__device__ __forceinline__ int headperm_row(int n0) { const int pn = n0 >> 8, c = n0 & 255, hh = c >> 6, dh = (c & 63) >> 5; return pn * 256 + dh * 128 + hh * 32; }
__device__ __forceinline__ void rms_row_to_bf16(const float* xrow, const float* gain, bf16* orow, int lane) {
    const f32x4* xr = (const f32x4*)xrow + lane; const f32x4* gr = (const f32x4*)gain + lane;
    f32x4 v[4]; float s = 0.f;
#pragma unroll
    for (int j = 0; j < 4; ++j) { v[j] = xr[64 * j]; s += (v[j].x * v[j].x + v[j].y * v[j].y) + (v[j].z * v[j].z + v[j].w * v[j].w); }
    const float rstd = 1.0f / sqrtf(wave_sum(s) * (1.f / DM) + EPS);
    u32x2* o8 = (u32x2*)orow + lane;
#pragma unroll
    for (int j = 0; j < 4; ++j) { const f32x4 gg = gr[64 * j]; u32x2 w; w.x = cvtpk(v[j].x * rstd * gg.x, v[j].y * rstd * gg.y); w.y = cvtpk(v[j].z * rstd * gg.z, v[j].w * rstd * gg.w); o8[64 * j] = w; }
}

__device__ __forceinline__ void rms_row2_to_bf16(const float* xrow, const float* gain, bf16* orow, int lane) {
    const f32x4* xr = (const f32x4*)xrow + lane; const f32x4* gr = (const f32x4*)gain + lane;
    f32x4 v[8]; float s0 = 0.f, s1 = 0.f;
#pragma unroll
    for (int j = 0; j < 8; ++j) v[j] = xr[64 * j];
#pragma unroll
    for (int j = 0; j < 4; ++j) { s0 += (v[j].x * v[j].x + v[j].y * v[j].y) + (v[j].z * v[j].z + v[j].w * v[j].w); s1 += (v[4 + j].x * v[4 + j].x + v[4 + j].y * v[4 + j].y) + (v[4 + j].z * v[4 + j].z + v[4 + j].w * v[4 + j].w); }
    const float r0 = 1.0f / sqrtf(wave_sum(s0) * (1.f / DM) + EPS), r1 = 1.0f / sqrtf(wave_sum(s1) * (1.f / DM) + EPS);
    u32x2* o8 = (u32x2*)orow + lane;
#pragma unroll
    for (int j = 0; j < 4; ++j) { const f32x4 gg = gr[64 * j]; u32x2 w; w.x = cvtpk(v[j].x * r0 * gg.x, v[j].y * r0 * gg.y); w.y = cvtpk(v[j].z * r0 * gg.z, v[j].w * r0 * gg.w); o8[64 * j] = w;
        u32x2 w2; w2.x = cvtpk(v[4 + j].x * r1 * gg.x, v[4 + j].y * r1 * gg.y); w2.y = cvtpk(v[4 + j].z * r1 * gg.z, v[4 + j].w * r1 * gg.w); o8[256 + 64 * j] = w2; }
}

__device__ __forceinline__ void load64(const bf16* p, float (&d)[64]) {
    const u32x4* q = (const u32x4*)p;
#pragma unroll
    for (int i = 0; i < 8; ++i) { const u32x4 w = q[i]; d[8 * i + 0] = bflo(w.x); d[8 * i + 1] = bfhi(w.x); d[8 * i + 2] = bflo(w.y); d[8 * i + 3] = bfhi(w.y); d[8 * i + 4] = bflo(w.z); d[8 * i + 5] = bfhi(w.z); d[8 * i + 6] = bflo(w.w); d[8 * i + 7] = bfhi(w.w); }
}
__device__ __forceinline__ void store64(bf16* p, const float (&d)[64]) {
    u32x4* q = (u32x4*)p;
#pragma unroll
    for (int i = 0; i < 8; ++i) { u32x4 w; w.x = cvtpk(d[8 * i], d[8 * i + 1]); w.y = cvtpk(d[8 * i + 2], d[8 * i + 3]); w.z = cvtpk(d[8 * i + 4], d[8 * i + 5]); w.w = cvtpk(d[8 * i + 6], d[8 * i + 7]); q[i] = w; }
}
__device__ __forceinline__ float dothalf(const float (&a)[64], const bf16* p, int h) {
    const u32x4* q = (const u32x4*)(p + 32 * h); float s0 = 0.f, s1 = 0.f;
#pragma unroll
    for (int i = 0; i < 4; ++i) { const u32x4 w = q[i]; const int o = 32 * h + 8 * i;
        s0 += a[o] * bflo(w.x) + a[o + 2] * bflo(w.y) + a[o + 4] * bflo(w.z) + a[o + 6] * bflo(w.w);
        s1 += a[o + 1] * bfhi(w.x) + a[o + 3] * bfhi(w.y) + a[o + 5] * bfhi(w.z) + a[o + 7] * bfhi(w.w); }
    return s0 + s1;
}
__device__ __forceinline__ float dotbf(const float (&a)[64], const bf16* p) { return dothalf(a, p, 0) + dothalf(a, p, 1); }
__device__ __forceinline__ void axpy_bf(float (&acc)[64], float al, float pw, const bf16* vp) {
    const u32x4* q = (const u32x4*)vp;
#pragma unroll
    for (int i = 0; i < 8; ++i) { const u32x4 w = q[i]; const int o = 8 * i;
        acc[o] = acc[o] * al + pw * bflo(w.x); acc[o + 1] = acc[o + 1] * al + pw * bfhi(w.x); acc[o + 2] = acc[o + 2] * al + pw * bflo(w.y); acc[o + 3] = acc[o + 3] * al + pw * bfhi(w.y);
        acc[o + 4] = acc[o + 4] * al + pw * bflo(w.z); acc[o + 5] = acc[o + 5] * al + pw * bfhi(w.z); acc[o + 6] = acc[o + 6] * al + pw * bflo(w.w); acc[o + 7] = acc[o + 7] * al + pw * bfhi(w.w); }
}
__device__ __forceinline__ float dot64(const float (&a)[64], const float (&b)[64]) {
    float s0 = 0.f, s1 = 0.f, s2 = 0.f, s3 = 0.f;
#pragma unroll
    for (int i = 0; i < 64; i += 4) { s0 += a[i] * b[i]; s1 += a[i + 1] * b[i + 1]; s2 += a[i + 2] * b[i + 2]; s3 += a[i + 3] * b[i + 3]; }
    return (s0 + s1) + (s2 + s3);
}

__device__ __forceinline__ void naive_moba(const bf16* QA, const bf16* KA, const bf16* VA, const float* KMEAN, bf16* Y, int gw, int NGW, int lane_) {
    const int lane = opaque(lane_);
    for (int wi = gw; wi < (NB * 8 * SEQ) / 64; wi += NGW) {
        const int idx0 = wi * 64, bh = idx0 / SEQ, s0 = idx0 % SEQ, b = bh >> 3, h = bh & 7, s = s0 + lane, n = s0 >> 8;
        float q[64]; load64(QA + ((size_t)(b * SEQ + s)) * 512 + h * 64, q);
        float g0 = -3e38f, g1 = -3e38f, g2 = -3e38f; int i0 = -1, i1 = -1, i2 = -1;
        for (int j = 0; j < n; ++j) {
            const float* km = KMEAN + (((size_t)(b * 16 + j)) * 8 + h) * 64;
            float g = 0.f;
#pragma unroll
            for (int d = 0; d < 64; ++d) g += q[d] * km[d];
            if (g > g0) { g2 = g1; i2 = i1; g1 = g0; i1 = i0; g0 = g; i0 = j; }
            else if (g > g1) { g2 = g1; i2 = i1; g1 = g; i1 = j; }
            else if (g > g2) { g2 = g; i2 = j; }
        }
        unsigned mask = 0; if (i0 >= 0) mask |= 1u << i0; if (i1 >= 0) mask |= 1u << i1; if (i2 >= 0) mask |= 1u << i2;
        float m = -3e38f, l = 0.f, acc[64];
#pragma unroll
        for (int d = 0; d < 64; ++d) acc[d] = 0.f;
        for (int jb = 0; jb <= n; ++jb) {
            const bool act = (jb == n) || ((mask >> jb) & 1u);
            if (!__any(act)) continue;
            const int nk = (jb == n) ? (s0 + 64 - n * 256) : 256;
            for (int kk = 0; kk < nk; ++kk) {
                const int key = jb * 256 + kk;
                const float sc = dotbf(q, KA + ((size_t)(b * SEQ + key)) * 512 + h * 64);
                const bool valid = act && (key <= s);
                if (valid) {
                    const float mn = fmaxf(m, sc), al = __builtin_amdgcn_exp2f(m - mn), p = __builtin_amdgcn_exp2f(sc - mn);
                    l = l * al + p; m = mn;
                    axpy_bf(acc, al, p, VA + ((size_t)(b * SEQ + key)) * 512 + h * 64);
                }
            }
        }
        const float il = 1.0f / l;
#pragma unroll
        for (int d = 0; d < 64; ++d) acc[d] *= il;
        store64(Y + ((size_t)(b * SEQ + s)) * DM + h * 64, acc);
    }
}

__device__ __forceinline__ void naive_ret(const bf16* QR, const bf16* KR, const bf16* VR, const bf16* GR, const float* rgain, bf16* Y, int gw, int NGW, int lane_) {
    const int lane = opaque(lane_);
    for (int wi = gw; wi < (NB * 4 * SEQ) / 64; wi += NGW) {
        const int idx0 = wi * 64, bh = idx0 / SEQ, s0 = idx0 % SEQ, b = bh >> 2, h = bh & 3, s = s0 + lane;
        const float lg = log2f(1.0f - exp2f(-5.0f - (float)h));
        float q[64]; load64(QR + ((size_t)(b * SEQ + s)) * 256 + h * 64, q);
        float acc[64];
#pragma unroll
        for (int d = 0; d < 64; ++d) acc[d] = 0.f;
        int jlo = s0 - (int)(80.0f / (-lg)); if (jlo < 0) jlo = 0;
        for (int j = jlo; j < s0 + 64; ++j) {
            const float sc = dotbf(q, KR + ((size_t)(b * SEQ + j)) * 256 + h * 64);
            const float w = (j <= s) ? sc * __builtin_amdgcn_exp2f(lg * (float)(128 * ((s >> 7) - (j >> 7)))) : 0.f;
            axpy_bf(acc, 1.0f, w, VR + ((size_t)(b * SEQ + j)) * 256 + h * 64);
        }
        float ss = 0.f;
#pragma unroll
        for (int d = 0; d < 64; ++d) ss += acc[d] * acc[d];
        const float r = 1.0f / sqrtf(ss * (1.0f / 64.0f) + EPS);
        load64(GR + ((size_t)(b * SEQ + s)) * 256 + h * 64, q);
#pragma unroll
        for (int d = 0; d < 64; ++d) acc[d] = acc[d] * r * rgain[h * 64 + d] * q[d];
        store64(Y + ((size_t)(b * SEQ + s)) * DM + 512 + h * 64, acc);
    }
}

__device__ __forceinline__ void naive_mem(const bf16* QM, const bf16* MK, const bf16* MV, bf16* Y, int gw, int NGW, int lane_) {
    const int lane = opaque(lane_);
    for (int wi = gw; wi < (NB * 4 * SEQ) / 64; wi += NGW) {
        const int idx0 = wi * 64, bh = idx0 / SEQ, s0 = idx0 % SEQ, b = bh >> 2, h = bh & 3, s = s0 + lane;
        float q[64]; load64(QM + ((size_t)(b * SEQ + s)) * 256 + h * 64, q);
        float m = -3e38f, l = 0.f, acc[64];
#pragma unroll
        for (int d = 0; d < 64; ++d) acc[d] = 0.f;
        for (int j = 0; j < MEMLEN; ++j) {
            const float sc = dotbf(q, MK + ((size_t)(b * MEMLEN + j)) * 256 + h * 64);
            const float mn = fmaxf(m, sc), al = __builtin_amdgcn_exp2f(m - mn), p = __builtin_amdgcn_exp2f(sc - mn);
            l = l * al + p; m = mn;
            axpy_bf(acc, al, p, MV + ((size_t)(b * MEMLEN + j)) * 256 + h * 64);
        }
        const float il = 1.0f / l;
#pragma unroll
        for (int d = 0; d < 64; ++d) acc[d] *= il;
        store64(Y + ((size_t)(b * SEQ + s)) * DM + 768 + h * 64, acc);
    }
}


#include <hip/hip_bf16.h>
namespace attn_body {
using s16x4=__attribute__((ext_vector_type(4)))short;
using f32x16=__attribute__((ext_vector_type(16)))float;
constexpr int D=64,NW=8,QBLK=32,QB=QBLK*NW,KVBLK=64;
__device__ __forceinline__ int crow(int r,int hi){return (r&3)+8*(r>>2)+4*hi;}
#define SBAR() __builtin_amdgcn_sched_barrier(0)
__device__ __forceinline__ void cmask(f32x16&p0,f32x16&p1,int jb,int qrel,int hi){
  const float NEG=-INFINITY; int kb=64*jb+4*hi;
  #pragma unroll
  for(int r=0;r<16;++r){int kv=kb+(r&3)+8*(r>>2); if(kv>qrel)p0[r]=NEG; if(kv+32>qrel)p1[r]=NEG;}
}
constexpr int NSLOT=3, SLOTB=8192;
constexpr int LDS_K=0, LDS_V=NSLOT*SLOTB, LDS_WS=2*NSLOT*SLOTB, LDS_OST=LDS_WS+NW*64*4, ATT_LDS_BYTES=LDS_OST+NW*4096;
__device__ __forceinline__ void glds16(const void*gsrc,unsigned lds_dst){unsigned keep;
  asm volatile("s_mov_b32 %0, m0\n\ts_mov_b32 m0, %2\n\ts_nop 0\n\tglobal_load_lds_dwordx4 %1, off\n\ts_mov_b32 m0, %0":"=&s"(keep):"v"(gsrc),"s"(lds_dst):"memory");}
__device__ __forceinline__ float max3f(float a,float b,float c){float r;asm("v_max3_f32 %0, %1, %2, %3":"=v"(r):"v"(a),"v"(b),"v"(c));return r;}
__device__ __forceinline__ float max2f(float a,float b){float r;asm("v_max_f32_e32 %0, %1, %2":"=v"(r):"v"(a),"v"(b));return r;}
__device__ __forceinline__ float fadd_s(float a,float b){float r;asm("v_add_f32_e32 %0, %1, %2":"=v"(r):"v"(a),"v"(b));return r;}
__device__ __forceinline__ float fsub_s(float a,float b){float r;asm("v_sub_f32_e32 %0, %1, %2":"=v"(r):"v"(a),"v"(b));return r;}
__device__ __forceinline__ unsigned cvtpk_s(float lo,float hi){return cvtpk(lo,hi);}
#define WAIT_BAR(N) asm volatile("s_waitcnt vmcnt(" #N ") lgkmcnt(0)\n\ts_barrier":::"memory")
__device__ __forceinline__ void qkt(f32x16&p0,f32x16&p1,const char*Kslot,const bf16x8*qr,const f32x16&negm,int r32,int hi){
  const char*kb=Kslot+hi*1024+r32*16;
  #pragma unroll
  for(int d0=0;d0<4;++d0){
    const bf16x8 b0=*reinterpret_cast<const bf16x8*>(kb+d0*2048);
    const bf16x8 b1=*reinterpret_cast<const bf16x8*>(kb+d0*2048+512);
    if(d0==0){p0=__builtin_amdgcn_mfma_f32_32x32x16_bf16(b0,qr[0],negm,0,0,0);p1=__builtin_amdgcn_mfma_f32_32x32x16_bf16(b1,qr[0],negm,0,0,0);}
    else{p0=__builtin_amdgcn_mfma_f32_32x32x16_bf16(b0,qr[d0],p0,0,0,0);p1=__builtin_amdgcn_mfma_f32_32x32x16_bf16(b1,qr[d0],p1,0,0,0);}}
}
typedef __attribute__((address_space(3))) const char* lds_cptr;
typedef short v4i16_t __attribute__((ext_vector_type(4)));
__device__ __forceinline__ void kload8(bf16x8*kf,lds_cptr kp){
  kf[0]=*(const __attribute__((address_space(3))) bf16x8*)(kp);      kf[1]=*(const __attribute__((address_space(3))) bf16x8*)(kp+512);
  kf[2]=*(const __attribute__((address_space(3))) bf16x8*)(kp+2048); kf[3]=*(const __attribute__((address_space(3))) bf16x8*)(kp+2560);
  kf[4]=*(const __attribute__((address_space(3))) bf16x8*)(kp+4096); kf[5]=*(const __attribute__((address_space(3))) bf16x8*)(kp+4608);
  kf[6]=*(const __attribute__((address_space(3))) bf16x8*)(kp+6144); kf[7]=*(const __attribute__((address_space(3))) bf16x8*)(kp+6656);
}
__device__ __forceinline__ void kload2(bf16x8*kf,lds_cptr kp,int j){ kf[2*j]=*(const __attribute__((address_space(3))) bf16x8*)(kp+j*2048); kf[2*j+1]=*(const __attribute__((address_space(3))) bf16x8*)(kp+j*2048+512); }
__device__ __forceinline__ s16x4 vtr(lds_cptr p){ return __builtin_bit_cast(s16x4,__builtin_amdgcn_ds_read_tr16_b64_v4i16((__attribute__((address_space(3))) v4i16_t*)p)); }
__device__ __forceinline__ float rowmax(const f32x16&p0,const f32x16&p1){
  float a=max3f(p0[0],p0[1],p1[0]),b=max3f(p0[2],p0[3],p1[1]);a=max3f(a,p1[2],p1[3]);
  #pragma unroll
  for(int r=4;r<16;r+=4){a=max3f(a,p0[r],p0[r+1]);b=max3f(b,p0[r+2],p0[r+3]);a=max3f(a,p1[r],p1[r+1]);b=max3f(b,p1[r+2],p1[r+3]);}
  const float m=max2f(a,b);
  auto rr=__builtin_amdgcn_permlane32_swap(__float_as_uint(m),__float_as_uint(m),false,false);
  return max2f(__uint_as_float(rr[0]),__uint_as_float(rr[1]));
}
__device__ __forceinline__ void pv(f32x16*o,int vb,bf16x8 pa0,bf16x8 pa1,bf16x8 pa2,bf16x8 pa3){
  #pragma unroll
  for(int d0=0;d0<2;++d0){s16x4 lo[4],hi[4];
    #pragma unroll
    for(int ks=0;ks<4;++ks){
      asm volatile("ds_read_b64_tr_b16 %0,%1 offset:%c2":"=&v"(lo[ks]):"v"(vb),"i"(d0*4096+ks*1024):"memory");
      asm volatile("ds_read_b64_tr_b16 %0,%1 offset:%c2":"=&v"(hi[ks]):"v"(vb),"i"(d0*4096+ks*1024+512):"memory");}
    asm volatile("s_waitcnt lgkmcnt(0)":::"memory");SBAR();
    #define PK(k) (bf16x8){lo[k][0],lo[k][1],lo[k][2],lo[k][3],hi[k][0],hi[k][1],hi[k][2],hi[k][3]}
    o[d0]=__builtin_amdgcn_mfma_f32_32x32x16_bf16(pa0,PK(0),o[d0],0,0,0);
    o[d0]=__builtin_amdgcn_mfma_f32_32x32x16_bf16(pa1,PK(1),o[d0],0,0,0);
    o[d0]=__builtin_amdgcn_mfma_f32_32x32x16_bf16(pa2,PK(2),o[d0],0,0,0);
    o[d0]=__builtin_amdgcn_mfma_f32_32x32x16_bf16(pa3,PK(3),o[d0],0,0,0);
    #undef PK
  }
}
template<int THRL,int KP,int OP,bool MOBA> __device__ __forceinline__ void attn_unit(const bf16*Qu,const bf16*__restrict__ Kh,const bf16*__restrict__ Vh,bf16*Ou,const int NT,const int nblk,const float*kmean,char*shm){
  const int tid=opaque((int)threadIdx.x),lane=tid&63,r32=lane&31,hi=lane>>5; const int wid=__builtin_amdgcn_readfirstlane(tid>>6);
  const bf16*Qw=Qu+(long)(wid*QBLK)*KP;
  const unsigned lds0=(unsigned)(uintptr_t)shm;
  float*wsf=(float*)(shm+LDS_WS)+wid*64;
  const bf16*ksrc=Kh+(long)lane*KP+wid*8;
  const bf16*vsrc=Vh+(long)(16*(wid&3)+(lane>>2))*KP+(wid>>2)*32+(lane&3)*8;
  const unsigned kdst=lds0+LDS_K+wid*1024, vdst=lds0+LDS_V+wid*1024;
  #define DMA_K(t,slot) glds16(ksrc+(long)(t)*KVBLK*KP,(unsigned)__builtin_amdgcn_readfirstlane(kdst+(slot)))
  #define DMA_V(t,slot) glds16(vsrc+(long)(t)*KVBLK*KP,(unsigned)__builtin_amdgcn_readfirstlane(vdst+(slot)))
  const int vb0=(int)(lds0+LDS_V)+((lane>>4)&1)*32+(lane&3)*8+(4*hi+((lane&15)>>2))*64;
  const char*Kbase=shm+LDS_K; bf16x8 kf[8];
  const lds_cptr shm3=(lds_cptr)shm; const lds_cptr kp0=shm3+LDS_K+hi*1024+r32*16; const lds_cptr vp0=shm3+LDS_V+((lane>>4)&1)*32+(lane&3)*8+(4*hi+((lane&15)>>2))*64;
  DMA_K(0,0);DMA_V(0,0);DMA_K(1,SLOTB);
  bf16x8 qr[4];
  #pragma unroll
  for(int d0=0;d0<4;++d0)qr[d0]=*reinterpret_cast<const bf16x8*>(&Qw[(long)r32*KP+d0*16+hi*8]);
  unsigned bmask=0xffffffffu;
  if(MOBA){
    bmask=1u<<nblk;
    float g0=-3e38f,g1=-3e38f,g2=-3e38f; int i0=-1,i1=-1,i2=-1;
    for(int j=0;j<nblk;++j){
      const float*km=kmean+(long)j*512+8*hi; float g=0.f;
      #pragma unroll
      for(int d0=0;d0<4;++d0){ const f32x4 a=*(const f32x4*)(km+16*d0),b=*(const f32x4*)(km+16*d0+4);
        g+=bf2f((unsigned short)qr[d0][0])*a[0]+bf2f((unsigned short)qr[d0][1])*a[1]+bf2f((unsigned short)qr[d0][2])*a[2]+bf2f((unsigned short)qr[d0][3])*a[3];
        g+=bf2f((unsigned short)qr[d0][4])*b[0]+bf2f((unsigned short)qr[d0][5])*b[1]+bf2f((unsigned short)qr[d0][6])*b[2]+bf2f((unsigned short)qr[d0][7])*b[3]; }
      g+=__shfl_xor(g,32);
      if(g>g0){g2=g1;i2=i1;g1=g0;i1=i0;g0=g;i0=j;} else if(g>g1){g2=g1;i2=i1;g1=g;i1=j;} else if(g>g2){g2=g;i2=j;}
    }
    if(i0>=0)bmask|=1u<<i0; if(i1>=0)bmask|=1u<<i1; if(i2>=0)bmask|=1u<<i2;
  }
  #define NEGM_FOR(t) (MOBA ? (((bmask>>((t)>>2))&1u) ? -mhat : -INFINITY) : -mhat)
  float mhat=0.f,l_reg=0.f;f32x16 o[2];o[0]=f32x16{};o[1]=f32x16{};f32x16 negm;
  { const float nm=NEGM_FOR(0);
    #pragma unroll
    for(int r=0;r<16;++r)negm[r]=nm; }
  asm volatile("":"+v"(negm));
  const int qrel=wid*QBLK+r32;
  #define CMASK(P0,P1,t) do{ if(MOBA){int jb_=(t)-(NT-4); if(jb_>=0)cmask(P0,P1,jb_,qrel,hi);} }while(0)
  bool resc=false;
  #define START(P0,P1) do{ const float rm=rowmax(P0,P1); resc=false; \
    { const float dl=(MOBA&&rm==-INFINITY)?0.f:rm; mhat=fadd_s(mhat,dl); \
      _Pragma("unroll") for(int r=0;r<16;++r){P0[r]=fsub_s(P0[r],dl);P1[r]=fsub_s(P1[r],dl);} \
      { const float nm=NEGM_FOR(1); _Pragma("unroll") for(int r=0;r<16;++r)negm[r]=nm; } asm volatile("":"+v"(negm)); } \
    _Pragma("unroll") for(int r=0;r<16;++r)P0[r]=__builtin_amdgcn_exp2f(P0[r]); }while(0)
  #define RESC() do{ if(resc){ asm volatile("s_waitcnt lgkmcnt(0)":::"memory"); \
      _Pragma("unroll") for(int d_=0;d_<2;++d_) _Pragma("unroll") for(int r=0;r<16;++r)o[d_][r]*=wsf[crow(r,hi)]; } }while(0)
  f32x16 pA0,pA1,pB0,pB1;
  int sl_prev=0,sl_cur=0,sl_next=SLOTB;
  #define ROT() do{sl_prev=sl_cur;sl_cur=sl_next;sl_next=(sl_next==(NSLOT-1)*SLOTB)?0:sl_next+SLOTB;}while(0)
  DMA_K(2,2*SLOTB);
  WAIT_BAR(3);
  qkt(pA0,pA1,Kbase,qr,negm,r32,hi);asm volatile("s_nop 15\n\ts_nop 7":"+v"(pA0),"+v"(pA1));CMASK(pA0,pA1,0);
  START(pA0,pA1);
  _Pragma("unroll") for(int r=0;r<16;++r)pA1[r]=__builtin_amdgcn_exp2f(pA1[r]);
  WAIT_BAR(0);
  DMA_K(3,0);DMA_V(1,SLOTB);
  ROT();
  kload8(kf,kp0+sl_cur);
  WAIT_BAR(2);
  s16x4 vlo[8],vhi[8]; u32x4 pw0,pw1,pw2,pw3;
  #define PKW(P,B) cvtpk_s(P[B],P[B+1])
  #define PAF(k) __builtin_bit_cast(bf16x8,pw##k)
  #define VFR(i) (bf16x8){vlo[i][0],vlo[i][1],vlo[i][2],vlo[i][3],vhi[i][0],vhi[i][1],vhi[i][2],vhi[i][3]}
  #define PIN(x) asm volatile("":"+v"(x))
  #define MX3(a,b,c) __builtin_fmaxf(__builtin_fmaxf((a),(b)),(c))
  #define GAPA(MF,A0,A1,A2,A3,W0,W1,PW) do{ MF; sacc+=A0; sacc+=A1; sacc+=A2; sacc+=A3; PIN(sacc); W0; W1; PIN(PW); SBAR(); }while(0)
  #define EX(v) __builtin_amdgcn_exp2f(v)
  #define GAPB(MF,X,B) do{ MF; X[B]=EX(X[B]); X[B+1]=EX(X[B+1]); X[B+2]=EX(X[B+2]); X[B+3]=EX(X[B+3]); PIN(X); SBAR(); }while(0)
  #define VRD(i) do{ vlo[i]=vtr(vp_+(((i)>>2)*4096+((i)&3)*1024)); vhi[i]=vtr(vp_+(((i)>>2)*4096+((i)&3)*1024+512)); }while(0)
  #define KRD(G,j) do{ if(G){ kload2(kf,kp0+sl_next,j); SBAR(); } }while(0)
  #define STEP(C0,C1,P0,P1,t,GK,GV,GL) do{ SBAR(); \
    const lds_cptr vp_=vp0+sl_prev; \
    VRD(0); SBAR(); float sacc=(P0[0]+P0[1]); \
    GAPA(C0=__builtin_amdgcn_mfma_f32_32x32x16_bf16(kf[0],qr[0],negm,0,0,0), P0[2],P0[3],P0[4],P0[5],     pw0[0]=PKW(P0,0), pw0[1]=PKW(P0,2), pw0); \
    VRD(4); SBAR(); GAPA(C1=__builtin_amdgcn_mfma_f32_32x32x16_bf16(kf[1],qr[0],negm,0,0,0), P0[6],P0[7],P0[8],P0[9],     pw0[2]=PKW(P0,4), pw0[3]=PKW(P0,6), pw0); \
    VRD(1); SBAR(); GAPA(C0=__builtin_amdgcn_mfma_f32_32x32x16_bf16(kf[2],qr[1],C0,0,0,0),   P0[10],P0[11],P0[12],P0[13], pw1[0]=PKW(P0,8), pw1[1]=PKW(P0,10), pw1); \
    VRD(5); SBAR(); GAPA(C1=__builtin_amdgcn_mfma_f32_32x32x16_bf16(kf[3],qr[1],C1,0,0,0),   P0[14],P0[15],P1[0],P1[1],   pw1[2]=PKW(P0,12),pw1[3]=PKW(P0,14), pw1); \
    VRD(2); SBAR(); GAPA(C0=__builtin_amdgcn_mfma_f32_32x32x16_bf16(kf[4],qr[2],C0,0,0,0),   P1[2],P1[3],P1[4],P1[5],     pw2[0]=PKW(P1,0), pw2[1]=PKW(P1,2), pw2); \
    VRD(6); SBAR(); GAPA(C1=__builtin_amdgcn_mfma_f32_32x32x16_bf16(kf[5],qr[2],C1,0,0,0),   P1[6],P1[7],P1[8],P1[9],     pw2[2]=PKW(P1,4), pw2[3]=PKW(P1,6), pw2); \
    VRD(3); SBAR(); GAPA(C0=__builtin_amdgcn_mfma_f32_32x32x16_bf16(kf[6],qr[3],C0,0,0,0),   P1[10],P1[11],P1[12],P1[13], pw3[0]=PKW(P1,8), pw3[1]=PKW(P1,10), pw3); \
    VRD(7); SBAR(); GAPA(C1=__builtin_amdgcn_mfma_f32_32x32x16_bf16(kf[7],qr[3],C1,0,0,0),   P1[14],P1[15],0.f,0.f,       pw3[2]=PKW(P1,12),pw3[3]=PKW(P1,14), pw3); \
    l_reg+=sacc; \
    if(GK){DMA_K((t)+3,sl_cur);} if(GV){DMA_V((t)+1,sl_next);} \
    CMASK(C0,C1,t); \
    { float a=MX3(C0[0],C0[1],C1[0]),b=MX3(C0[2],C0[3],C1[1]); a=MX3(a,C1[2],C1[3]); \
      _Pragma("unroll") for(int r=4;r<16;r+=4){a=MX3(a,C0[r],C0[r+1]);b=MX3(b,C0[r+2],C0[r+3]);a=MX3(a,C1[r],C1[r+1]);b=MX3(b,C1[r+2],C1[r+3]);} \
      float rm=__builtin_fmaxf(a,b); { auto rr=__builtin_amdgcn_permlane32_swap(__float_as_uint(rm),__float_as_uint(rm),false,false); rm=__builtin_fmaxf(__uint_as_float(rr[0]),__uint_as_float(rr[1])); } \
      resc=false; \
      if(__builtin_expect(__any(rm>(float)THRL),0)){ const float dl=__builtin_fmaxf(rm,0.f); mhat+=dl; \
        _Pragma("unroll") for(int r=0;r<16;++r){C0[r]-=dl;C1[r]-=dl;} \
        if(!MOBA){ _Pragma("unroll") for(int r=0;r<16;++r)negm[r]=-mhat; asm volatile("":"+v"(negm)); } \
        const float f=__builtin_amdgcn_exp2f(-dl); l_reg*=f; if(hi==0)wsf[r32]=f; resc=true; } \
      if(MOBA){ const float nm=NEGM_FOR((t)+1); _Pragma("unroll") for(int r=0;r<16;++r)negm[r]=nm; asm volatile("":"+v"(negm)); } } \
    SBAR(); \
    GAPB(o[0]=__builtin_amdgcn_mfma_f32_32x32x16_bf16(PAF(0),VFR(0),o[0],0,0,0), C0,0); \
    GAPB(o[1]=__builtin_amdgcn_mfma_f32_32x32x16_bf16(PAF(0),VFR(4),o[1],0,0,0), C0,4); \
    KRD(GL,0); GAPB(o[0]=__builtin_amdgcn_mfma_f32_32x32x16_bf16(PAF(1),VFR(1),o[0],0,0,0), C0,8); \
    KRD(GL,1); GAPB(o[1]=__builtin_amdgcn_mfma_f32_32x32x16_bf16(PAF(1),VFR(5),o[1],0,0,0), C0,12); \
    KRD(GL,2); GAPB(o[0]=__builtin_amdgcn_mfma_f32_32x32x16_bf16(PAF(2),VFR(2),o[0],0,0,0), C1,0); \
    KRD(GL,3); GAPB(o[1]=__builtin_amdgcn_mfma_f32_32x32x16_bf16(PAF(2),VFR(6),o[1],0,0,0), C1,4); \
    GAPB(o[0]=__builtin_amdgcn_mfma_f32_32x32x16_bf16(PAF(3),VFR(3),o[0],0,0,0), C1,8); \
    GAPB(o[1]=__builtin_amdgcn_mfma_f32_32x32x16_bf16(PAF(3),VFR(7),o[1],0,0,0), C1,12); \
    }while(0)
  int t=1;
  #undef CMASK
  #define CMASK(P0,P1,t) do{}while(0)
  for(;t+5<NT;t+=2){
    STEP(pB0,pB1,pA0,pA1,t,true,true,true);     WAIT_BAR(2); RESC(); ROT();
    STEP(pA0,pA1,pB0,pB1,t+1,true,true,true);   WAIT_BAR(2); RESC(); ROT();
  }
  #undef CMASK
  #define CMASK(P0,P1,t) do{ if(MOBA){int jb_=(t)-(NT-4); if(jb_>=0)cmask(P0,P1,jb_,qrel,hi);} }while(0)
  #define ENDW(tt) do{ if((tt)+3<NT){WAIT_BAR(2);} else if((tt)+2<NT){WAIT_BAR(1);} else {WAIT_BAR(0);} }while(0)
  for(;t+1<NT;t+=2){
    STEP(pB0,pB1,pA0,pA1,t,(t+3<NT),(t+1<NT),(t+1<NT));       ENDW(t);   RESC(); ROT();
    STEP(pA0,pA1,pB0,pB1,t+1,(t+4<NT),(t+2<NT),(t+2<NT));     ENDW(t+1); RESC(); ROT();
  }
  STEP(pB0,pB1,pA0,pA1,NT-1,false,false,false); RESC();
  { float sacc=pB0[0]+pB0[1]; _Pragma("unroll") for(int r=2;r<16;++r)sacc+=pB0[r]; _Pragma("unroll") for(int r=0;r<16;++r)sacc+=pB1[r]; l_reg+=sacc;
    pw0=(u32x4){PKW(pB0,0),PKW(pB0,2),PKW(pB0,4),PKW(pB0,6)};pw1=(u32x4){PKW(pB0,8),PKW(pB0,10),PKW(pB0,12),PKW(pB0,14)};pw2=(u32x4){PKW(pB1,0),PKW(pB1,2),PKW(pB1,4),PKW(pB1,6)};pw3=(u32x4){PKW(pB1,8),PKW(pB1,10),PKW(pB1,12),PKW(pB1,14)};
    SBAR(); pv(o,vb0+sl_cur,PAF(0),PAF(1),PAF(2),PAF(3)); }
  #undef PKW
  #undef PAF
  #undef VFR
  #undef PIN
  #undef MX3
  #undef GAPA
  #undef GAPB
  #undef EX
  #undef VRD
  #undef KRD
  #undef STEP
  #undef ENDW
  {auto rr=__builtin_amdgcn_permlane32_swap(__float_as_uint(l_reg),__float_as_uint(l_reg),false,false);l_reg=__uint_as_float(rr[0])+__uint_as_float(rr[1]);}
  if(hi==0)wsf[32+r32]=l_reg;asm volatile("s_waitcnt lgkmcnt(0)":::"memory");
  float rli[16];
  #pragma unroll
  for(int r=0;r<16;++r)rli[r]=__builtin_amdgcn_rcpf(wsf[32+crow(r,hi)]);
  bf16*Ow=Ou+(long)(wid*QBLK)*OP;
  { bf16*stg=(bf16*)(shm+LDS_OST)+wid*2048;
    #pragma unroll
    for(int r=0;r<16;++r){const int orow=crow(r,hi);
      #pragma unroll
      for(int d0=0;d0<2;++d0)stg[orow*64+d0*32+r32]=(bf16)(cvtpk(o[d0][r]*rli[r],0.f)&0xffffu);}
    asm volatile("s_waitcnt lgkmcnt(0)":::"memory");
    #pragma unroll
    for(int i=0;i<4;++i){const int row=i*8+(lane>>3),ch=lane&7; const u32x4 v=*(const u32x4*)(stg+row*64+ch*8); *(u32x4*)(Ow+(long)row*OP+ch*8)=v;} }
  asm volatile("s_waitcnt lgkmcnt(0)\n\ts_barrier":::"memory");
  #undef DMA_K
  #undef DMA_V
  #undef CMASK
  #undef START
  #undef RESC
  #undef ROT
  #undef NEGM_FOR
}
#undef SBAR
#undef WAIT_BAR
}

namespace ret_body {
using attn_body::s16x4; using attn_body::f32x16; using attn_body::glds16; using attn_body::pv; using attn_body::crow;
constexpr int KVF_BYTES = 64 * 64 * 4;
__device__ __forceinline__ void kv_unit(const bf16* KR, const bf16* VR, float* KVF, int b, int h, int cp, char* shm) {
  const int tid = opaque((int)threadIdx.x), lane = tid & 63, r32 = lane & 31, hi = lane >> 5; const int wid = __builtin_amdgcn_readfirstlane(tid >> 6);
  const unsigned lds0 = (unsigned)(uintptr_t)shm;
  const size_t rowb = (size_t)b * SEQ + (size_t)cp * 256;
  const long voff = (long)(16 * (wid & 3) + (lane >> 2)) * 256 + h * 64 + (wid >> 2) * 32 + (lane & 3) * 8;
#pragma unroll
  for (int c = 0; c < 2; ++c)
#pragma unroll
    for (int tl = 0; tl < 2; ++tl) {
      const size_t r0 = rowb + c * 128 + tl * 64;
      glds16(KR + r0 * 256 + voff, (unsigned)__builtin_amdgcn_readfirstlane(lds0 + ((c * 2 + 0) * 2 + tl) * 8192 + wid * 1024));
      glds16(VR + r0 * 256 + voff, (unsigned)__builtin_amdgcn_readfirstlane(lds0 + ((c * 2 + 1) * 2 + tl) * 8192 + wid * 1024));
    }
  asm volatile("s_waitcnt vmcnt(0) lgkmcnt(0)\n\ts_barrier" ::: "memory");
  const int c = wid >> 2, dkb = (wid >> 1) & 1, dvb = wid & 1;
  const int vb = (int)lds0 + ((lane >> 4) & 1) * 32 + (lane & 3) * 8 + (4 * hi + ((lane & 15) >> 2)) * 64;
  f32x16 acc = f32x16{};
#pragma unroll
  for (int tl = 0; tl < 2; ++tl) {
    s16x4 alo[4], ahi[4], blo[4], bhi[4];
    const int ka = vb + ((c * 2 + 0) * 2 + tl) * 8192 + dkb * 4096, va = vb + ((c * 2 + 1) * 2 + tl) * 8192 + dvb * 4096;
#pragma unroll
    for (int ks = 0; ks < 4; ++ks) {
      asm volatile("ds_read_b64_tr_b16 %0,%1 offset:%c2" : "=&v"(alo[ks]) : "v"(ka), "i"(ks * 1024) : "memory");
      asm volatile("ds_read_b64_tr_b16 %0,%1 offset:%c2" : "=&v"(ahi[ks]) : "v"(ka), "i"(ks * 1024 + 512) : "memory");
      asm volatile("ds_read_b64_tr_b16 %0,%1 offset:%c2" : "=&v"(blo[ks]) : "v"(va), "i"(ks * 1024) : "memory");
      asm volatile("ds_read_b64_tr_b16 %0,%1 offset:%c2" : "=&v"(bhi[ks]) : "v"(va), "i"(ks * 1024 + 512) : "memory");
    }
    asm volatile("s_waitcnt lgkmcnt(0)" ::: "memory"); __builtin_amdgcn_sched_barrier(0);
#pragma unroll
    for (int ks = 0; ks < 4; ++ks) {
      const bf16x8 af = (bf16x8){alo[ks][0], alo[ks][1], alo[ks][2], alo[ks][3], ahi[ks][0], ahi[ks][1], ahi[ks][2], ahi[ks][3]};
      const bf16x8 bfr = (bf16x8){blo[ks][0], blo[ks][1], blo[ks][2], blo[ks][3], bhi[ks][0], bhi[ks][1], bhi[ks][2], bhi[ks][3]};
      acc = __builtin_amdgcn_mfma_f32_32x32x16_bf16(af, bfr, acc, 0, 0, 0);
    }
  }
  const float lgam = __builtin_amdgcn_logf(1.0f - __builtin_amdgcn_exp2f(-5.0f - (float)h));
  const float g127 = __builtin_amdgcn_exp2f(lgam * 127.0f);
  float* outp = KVF + ((size_t)((b * 4 + h) * 32 + cp * 2 + c)) * 4096 + dvb * 32 + r32;
#pragma unroll
  for (int r = 0; r < 16; ++r) outp[(size_t)(dkb * 32 + crow(r, hi)) * 64] = acc[r] * g127;
  asm volatile("s_waitcnt lgkmcnt(0)\n\ts_barrier" ::: "memory");
}

__device__ __forceinline__ void out_unit(const bf16* QR, const bf16* KR, const bf16* VR, const bf16* GR, const float* KVF, const float* rgain, bf16* Y, int b, int h, int cp, char* shm) {
  const int tid = opaque((int)threadIdx.x), lane = tid & 63, r32 = lane & 31, hi = lane >> 5; const int wid = __builtin_amdgcn_readfirstlane(tid >> 6);
  const unsigned lds0 = (unsigned)(uintptr_t)shm;
  constexpr int L_K = 0, L_V = 32768, L_S = 65536, L_O = 81920;
  const size_t rowb = (size_t)b * SEQ + (size_t)cp * 256;
  const long koff = (long)lane * 256 + h * 64 + wid * 8;
  const long voff = (long)(16 * (wid & 3) + (lane >> 2)) * 256 + h * 64 + (wid >> 2) * 32 + (lane & 3) * 8;
#pragma unroll
  for (int tl = 0; tl < 4; ++tl) {
    const size_t r0 = rowb + tl * 64;
    glds16(KR + r0 * 256 + koff, (unsigned)__builtin_amdgcn_readfirstlane(lds0 + L_K + tl * 8192 + wid * 1024));
    glds16(VR + r0 * 256 + voff, (unsigned)__builtin_amdgcn_readfirstlane(lds0 + L_V + tl * 8192 + wid * 1024));
  }
  {
    const float lgam = __builtin_amdgcn_logf(1.0f - __builtin_amdgcn_exp2f(-5.0f - (float)h));
    const float lgc = lgam * 128.0f;
    const int n0 = 2 * cp;
    int mlo = n0 - 1 - (int)(34.0f / (-lgc)); if (mlo < 0) mlo = 0;
    const float* kvp = KVF + ((size_t)((b * 4 + h) * 32)) * 4096 + tid * 8;
    f32x4 s0 = {0.f, 0.f, 0.f, 0.f}, s1 = {0.f, 0.f, 0.f, 0.f};
    int m = mlo;
    for (; m + 4 <= n0; m += 4) {
      f32x4 a[4], c4[4];
#pragma unroll
      for (int q = 0; q < 4; ++q) { a[q] = *(const f32x4*)(kvp + (size_t)(m + q) * 4096); c4[q] = *(const f32x4*)(kvp + (size_t)(m + q) * 4096 + 4); }
#pragma unroll
      for (int q = 0; q < 4; ++q) { const float w = __builtin_amdgcn_exp2f(lgc * (float)(n0 - 1 - m - q)); s0 += a[q] * w; s1 += c4[q] * w; }
    }
    for (; m < n0; ++m) {
      const float w = __builtin_amdgcn_exp2f(lgc * (float)(n0 - 1 - m));
      const f32x4 a = *(const f32x4*)(kvp + (size_t)m * 4096), c4 = *(const f32x4*)(kvp + (size_t)m * 4096 + 4);
      s0 += a * w; s1 += c4 * w;
    }
    const int dk = tid >> 3, dv = 8 * (tid & 7);
    char* sp = shm + L_S + (dv >> 5) * 4096 + dk * 64 + (dv & 31) * 2;
    u32x4 w0; w0.x = cvtpk(s0[0], s0[1]); w0.y = cvtpk(s0[2], s0[3]); w0.z = cvtpk(s1[0], s1[1]); w0.w = cvtpk(s1[2], s1[3]);
    *(u32x4*)sp = w0;
    const float dc = __builtin_amdgcn_exp2f(lgc);
    const f32x4 a = *(const f32x4*)(kvp + (size_t)n0 * 4096), c4 = *(const f32x4*)(kvp + (size_t)n0 * 4096 + 4);
    s0 = s0 * dc + a; s1 = s1 * dc + c4;
    u32x4 w1; w1.x = cvtpk(s0[0], s0[1]); w1.y = cvtpk(s0[2], s0[3]); w1.z = cvtpk(s1[0], s1[1]); w1.w = cvtpk(s1[2], s1[3]);
    *(u32x4*)(sp + 8192) = w1;
  }
  const int c = wid >> 2, wq = wid & 3;
  const bf16* Qw = QR + (rowb + c * 128 + wq * 32 + r32) * 256 + h * 64;
  bf16x8 qr[4]; u32x4 qa[4];
#pragma unroll
  for (int d0 = 0; d0 < 4; ++d0) qr[d0] = *reinterpret_cast<const bf16x8*>(Qw + d0 * 16 + hi * 8);
#pragma unroll
  for (int k = 0; k < 4; ++k) { const u32x2 lo = *(const u32x2*)(Qw + 16 * k + 4 * hi), hi2 = *(const u32x2*)(Qw + 16 * k + 8 + 4 * hi); qa[k] = (u32x4){lo.x, lo.y, hi2.x, hi2.y}; }
  asm volatile("s_waitcnt vmcnt(0) lgkmcnt(0)\n\ts_barrier" ::: "memory");
  const int vb = (int)lds0 + ((lane >> 4) & 1) * 32 + (lane & 3) * 8 + (4 * hi + ((lane & 15) >> 2)) * 64;
  f32x16 o[2]; o[0] = f32x16{}; o[1] = f32x16{};
  pv(o, vb + L_S + c * 8192, __builtin_bit_cast(bf16x8, qa[0]), __builtin_bit_cast(bf16x8, qa[1]), __builtin_bit_cast(bf16x8, qa[2]), __builtin_bit_cast(bf16x8, qa[3]));
  { const float gam = 1.0f - __builtin_amdgcn_exp2f(-5.0f - (float)h);
#pragma unroll
    for (int d0 = 0; d0 < 2; ++d0)
#pragma unroll
      for (int r = 0; r < 16; ++r) o[d0][r] *= gam; }
  const f32x16 zero = f32x16{};
  const int irow = wq * 32 + r32;
  for (int tl = 0; tl <= (wq >> 1); ++tl) {
    f32x16 p0, p1;
    attn_body::qkt(p0, p1, shm + L_K + (c * 2 + tl) * 8192, qr, zero, r32, hi);
    asm volatile("s_nop 15\n\ts_nop 7" : "+v"(p0), "+v"(p1));
#pragma unroll
    for (int r = 0; r < 16; ++r) { const int kj = 64 * tl + crow(r, hi); if (kj > irow) p0[r] = 0.f; if (kj + 32 > irow) p1[r] = 0.f; }
    u32x4 pw0, pw1, pw2, pw3;
    pw0 = (u32x4){cvtpk(p0[0], p0[1]), cvtpk(p0[2], p0[3]), cvtpk(p0[4], p0[5]), cvtpk(p0[6], p0[7])}; pw1 = (u32x4){cvtpk(p0[8], p0[9]), cvtpk(p0[10], p0[11]), cvtpk(p0[12], p0[13]), cvtpk(p0[14], p0[15])};
    pw2 = (u32x4){cvtpk(p1[0], p1[1]), cvtpk(p1[2], p1[3]), cvtpk(p1[4], p1[5]), cvtpk(p1[6], p1[7])}; pw3 = (u32x4){cvtpk(p1[8], p1[9]), cvtpk(p1[10], p1[11]), cvtpk(p1[12], p1[13]), cvtpk(p1[14], p1[15])};
    __builtin_amdgcn_sched_barrier(0);
    pv(o, vb + L_V + (c * 2 + tl) * 8192, __builtin_bit_cast(bf16x8, pw0), __builtin_bit_cast(bf16x8, pw1), __builtin_bit_cast(bf16x8, pw2), __builtin_bit_cast(bf16x8, pw3));
  }
  asm volatile("s_waitcnt lgkmcnt(0)\n\ts_barrier" ::: "memory");
  { float* stg = (float*)(shm + L_O) + wid * 2048;
#pragma unroll
    for (int r = 0; r < 16; ++r) { const int orow = crow(r, hi);
#pragma unroll
      for (int d0 = 0; d0 < 2; ++d0) stg[orow * 64 + d0 * 32 + r32] = o[d0][r]; }
    asm volatile("s_waitcnt lgkmcnt(0)" ::: "memory");
    const int row = lane >> 1, half = lane & 1;
    const f32x4* sr = (const f32x4*)(stg + row * 64 + half * 32);
    f32x4 v[8]; float ss = 0.f;
#pragma unroll
    for (int i = 0; i < 8; ++i) { v[i] = sr[i]; ss += (v[i][0] * v[i][0] + v[i][1] * v[i][1]) + (v[i][2] * v[i][2] + v[i][3] * v[i][3]); }
    ss += __shfl_xor(ss, 1);
    const float rstd = 1.0f / sqrtf(ss * (1.0f / 64.0f) + EPS);
    const size_t grow = rowb + c * 128 + wq * 32 + row;
    const u32x4* gp = (const u32x4*)(GR + grow * 256 + h * 64 + half * 32);
    const f32x4* rg = (const f32x4*)(rgain + h * 64 + half * 32);
    u32x4* yp = (u32x4*)(Y + grow * DM + 512 + h * 64 + half * 32);
#pragma unroll
    for (int i = 0; i < 4; ++i) {
      const u32x4 gw = gp[i]; const f32x4 g0 = rg[2 * i], g1 = rg[2 * i + 1]; const f32x4 a = v[2 * i] * rstd * g0, c4 = v[2 * i + 1] * rstd * g1;
      u32x4 w; w.x = cvtpk(a[0] * bflo(gw.x), a[1] * bfhi(gw.x)); w.y = cvtpk(a[2] * bflo(gw.y), a[3] * bfhi(gw.y)); w.z = cvtpk(c4[0] * bflo(gw.z), c4[1] * bfhi(gw.z)); w.w = cvtpk(c4[2] * bflo(gw.w), c4[3] * bfhi(gw.w));
      yp[i] = w;
    }
  }
  asm volatile("s_waitcnt lgkmcnt(0)\n\ts_barrier" ::: "memory");
}
}

#define XB_TMO      128
#define XB_XCNT(j)  (256  + 64 * (j))
#define XB_XSUB(j)  (1280 + 64 * (j))
#define XB_XGEN(j)  (2304 + 64 * (j))
#define XB_TOP      3328
#define XB_TOPGEN   3392
#define XCD_BAR_WORDS 3456
#define XB_SPIN_CAP (1u << 18)
__device__ __forceinline__ unsigned xb_ld(unsigned* p)              { return __hip_atomic_load(p, __ATOMIC_RELAXED, __HIP_MEMORY_SCOPE_AGENT); }
__device__ __forceinline__ unsigned xb_add(unsigned* p, unsigned v) { return __hip_atomic_fetch_add(p, v, __ATOMIC_RELAXED, __HIP_MEMORY_SCOPE_AGENT); }
__device__ __forceinline__ unsigned xb_xcc_id() { return (unsigned)__builtin_amdgcn_s_getreg((3 << 11) | 20) & 0xFu; }
#define XB_SPIN(cond, bar) do { unsigned _sp = 0; while (cond) { __builtin_amdgcn_s_sleep(1); \
    if ((++_sp & 255u) == 0u) { if (xb_ld(&(bar)[XB_TMO])) break; if (_sp > XB_SPIN_CAP) { atomicAdd(&(bar)[XB_TMO], 1u); break; } } } } while (0)
struct XcdBarrier { unsigned* bar; unsigned x; volatile LAS unsigned* st; };
__device__ __forceinline__ XcdBarrier xcd_barrier_post(unsigned* bar, volatile LAS unsigned* st) {
    XcdBarrier b; b.bar = bar; b.x = xb_xcc_id(); b.st = st;
    if (threadIdx.x == 0) (void)xb_add(&bar[XB_XCNT(b.x)], 1u);
    return b;
}
__device__ __forceinline__ void xcd_barrier_complete(unsigned* bar, unsigned x, unsigned& nloc, unsigned& nx) {
    const unsigned G = gridDim.x * gridDim.y * gridDim.z;
    unsigned sum, cnt, mine, sp = 0u;
    for (;;) {
        sum = 0u; cnt = 0u; mine = 0u;
#pragma unroll
        for (unsigned j = 0; j < 16; ++j) { const unsigned c = xb_ld(&bar[XB_XCNT(j)]); sum += c; cnt += (c > 0u) ? 1u : 0u; mine = (j == x) ? c : mine; }
        if (sum == G) break;
        __builtin_amdgcn_s_sleep(1);
        if ((++sp & 255u) == 0u) { if (xb_ld(&bar[XB_TMO])) break; if (sp > XB_SPIN_CAP) { atomicAdd(&bar[XB_TMO], 1u); break; } }
    }
    nloc = mine > 0u ? mine : 1u; nx = cnt > 0u ? cnt : 1u;
}
__device__ __forceinline__ void xcd_barrier(const XcdBarrier& b) {
    asm volatile("s_waitcnt vmcnt(0)" ::: "memory");
    __syncthreads();
    if (threadIdx.x == 0) {
        unsigned* bar = b.bar;
        __builtin_amdgcn_s_waitcnt(0);
        unsigned nloc = b.st[0], nx = b.st[1];
        if (nloc == 0u) { xcd_barrier_complete(bar, b.x, nloc, nx); b.st[0] = nloc; b.st[1] = nx; }
        const unsigned old = xb_add(&bar[XB_XSUB(b.x)], 1u);
        const unsigned gen = old / nloc;
        if (old + 1u == (gen + 1u) * nloc) {
            __builtin_amdgcn_fence(__ATOMIC_RELEASE, "agent");
            asm volatile("s_waitcnt vmcnt(0)" ::: "memory");
            const unsigned og = xb_add(&bar[XB_TOP], 1u);
            const unsigned tg = og / nx;
            if (og + 1u == (tg + 1u) * nx) xb_add(&bar[XB_TOPGEN], 1u);
            else XB_SPIN(xb_ld(&bar[XB_TOPGEN]) == tg, bar);
            __builtin_amdgcn_fence(__ATOMIC_ACQUIRE, "agent");
            xb_add(&bar[XB_XGEN(b.x)], 1u);
            asm volatile("s_waitcnt vmcnt(0)" ::: "memory");
        } else {
            XB_SPIN(xb_ld(&bar[XB_XGEN(b.x)]) == gen, bar);
            __builtin_amdgcn_fence(__ATOMIC_ACQUIRE, "agent");
            asm volatile("s_waitcnt vmcnt(0)" ::: "memory");
        }
    }
    __syncthreads();
}

__global__ void __launch_bounds__(NTHREADS, 2) fwd_kernel(Args args) {
    extern __shared__ __attribute__((aligned(16))) unsigned char lds_raw[];
    LAS unsigned char* lds = (LAS unsigned char*)lds_raw;
    cg::grid_group grid = cg::this_grid();
    const int tid0 = threadIdx.x, wave = __builtin_amdgcn_readfirstlane(tid0 >> 6);
#define PHASE_LANES const int tid = opaque(tid0), lane = tid & 63; (void)lane; (void)tid
    const int G = gridDim.x, bx = blockIdx.x;
    const int vcu = (G % 8 == 0) ? (bx % 8) * (G / 8) + bx / 8 : bx;
    const int gw = vcu * NWAVES + wave, NGW = G * NWAVES;
    unsigned char* const ws = args.ws;
#define WSP(type, off) ((type*)(ws + (off)))
    if (tid0 < 64) ((LAS unsigned*)(lds + LDS_MISC))[tid0] = 0u;
    __syncthreads();
    const XcdBarrier xbar = xcd_barrier_post(WSP(unsigned, WS_BAR), (volatile LAS unsigned*)(lds + LDS_MISC));
#define GRID_BAR() xcd_barrier(xbar)
    REPN(0) {
        PHASE_LANES;
        LAS float* scr = (LAS float*)(lds + wave * 16384);
        const float* x = args.in[0]; const float* mem = args.in[1]; const float* g_attn = args.in[2]; const float* w_in = args.in[3]; const float* g_mem = args.in[7];
        const float* w_mem_kv = args.in[8]; const float* w_out = args.in[11]; const float* g_ffn = args.in[12]; const float* w_router = args.in[13]; const float* w1 = args.in[15]; const float* w2 = args.in[17];
        bf16* WIN_T = WSP(bf16, WS_WIN); bf16* WMEM_T = WSP(bf16, WS_WMEM); bf16* WOUT_T = WSP(bf16, WS_WOUT); unsigned char* W1_8 = WSP(unsigned char, WS_W1); unsigned char* W2_8 = WSP(unsigned char, WS_W2);
        bf16* XN = WSP(bf16, WS_XN); bf16* MEMN = WSP(bf16, WS_MEMN); float* WRG = WSP(float, WS_WRG);
        constexpr int I0 = 16 * 88, I1 = 16 * 16, I2 = 16 * 32, I3 = 32 * 16 * 64, I4 = 32 * 16 * 32, NIT = I0 + I1 + I2 + I3 + I4;
        for (int it = gw; it < NIT; it += NGW) {
            int r = it;
            if (r < I0) { const int nb = r % 88, kb = r / 88; transpose_item(w_in, NIN, WIN_T, headperm_row(nb * 32), scr, kb * 64, nb * 32, lane); continue; } r -= I0;
            if (r < I1) { const int nb = r % 16, kb = r / 16; transpose_item(w_mem_kv, 512, WMEM_T, headperm_row(nb * 32), scr, kb * 64, nb * 32, lane); continue; } r -= I1;
            if (r < I2) { const int nb = r % 32, kb = r / 32; transpose_item(w_out, 1024, WOUT_T, nb * 32, scr, kb * 64, nb * 32, lane); continue; } r -= I2;
            if (r < I3) { const int e = r / 1024, rr = r % 1024, nb = rr % 64, kb = rr / 64; transpose_item_fp8<true>(w1 + (size_t)e * 1024 * 2048, 2048, W1_8 + (size_t)e * 2048 * 1024, scr, kb * 64, nb * 32, lane); continue; } r -= I3;
            { const int e = r / 512, rr = r % 512, nb = rr % 32, kb = rr / 32; transpose_item_fp8<false>(w2 + (size_t)e * 1024 * 1024, 1024, W2_8 + (size_t)e * 1024 * 1024, scr, kb * 64, nb * 32, lane); }
        }
        for (int m = gw * 2; m < T + MROWS; m += NGW * 2) {
            if (m < T) rms_row2_to_bf16(x + (size_t)m * DM, g_attn, XN + (size_t)m * DM, lane);
            else rms_row2_to_bf16(mem + (size_t)(m - T) * DM, g_mem, MEMN + (size_t)(m - T) * DM, lane);
        }
        for (int i = bx * NTHREADS + tid; i < DM * NEXP; i += G * NTHREADS) WRG[i] = g_ffn[i >> 5] * w_router[i];
    }
    if (args.pad0 == 0x7fffffff) grid.sync();
    GRID_BAR();

    REPN(1) {
        SchedProj S{G, bx, (const char*)(ws + WS_XN), (const char*)(ws + WS_MEMN), (const char*)(ws + WS_WIN), (const char*)(ws + WS_WMEM)};
        EpiProj E{ws, args.in[4], args.in[5], args.in[9], args.in[10]};
#ifndef NO_G1
        pg8::gemm_phase<EpiProj, SchedProj>(lds, S, E);
#endif
    }
    GRID_BAR();

#ifndef NAIVE_RET
    REPN(2) for (int i = 0; i < 2; ++i) {
        const int u = vcu * 2 + i, bh = u >> 4, cp = u & 15;
        ret_body::kv_unit(WSP(bf16, WS_KR), WSP(bf16, WS_VR), WSP(float, WS_RET), bh >> 2, bh & 3, cp, (char*)lds_raw);
    }
    GRID_BAR();
#endif
    { PHASE_LANES;
#ifdef NAIVE_MOBA
    naive_moba(WSP(bf16, WS_QA), WSP(bf16, WS_KA), WSP(bf16, WS_VA), WSP(float, WS_KMEAN), WSP(bf16, WS_Y), gw, NGW, lane);
#else
    REPN(20) for (int i = 0; i < 4; ++i) {
        const int bh = vcu >> 2, s = vcu & 3, nb = (i == 0) ? s : (i == 1) ? 7 - s : (i == 2) ? 8 + s : 15 - s, b = bh >> 3, h = bh & 7;
        const size_t row0 = (size_t)b * SEQ + (size_t)nb * 256;
        attn_body::attn_unit<8, 512, 1024, true>(WSP(bf16, WS_QA) + row0 * 512 + h * 64, WSP(bf16, WS_KA) + (size_t)b * SEQ * 512 + h * 64, WSP(bf16, WS_VA) + (size_t)b * SEQ * 512 + h * 64,
                                                 WSP(bf16, WS_Y) + row0 * DM + h * 64, 4 * nb + 4, nb, WSP(float, WS_KMEAN) + ((size_t)b * 16 * 8 + h) * 64, (char*)lds_raw);
    }
#endif
#ifdef NAIVE_RET
    naive_ret(WSP(bf16, WS_QR), WSP(bf16, WS_KR), WSP(bf16, WS_VR), WSP(bf16, WS_GR), args.in[6], WSP(bf16, WS_Y), gw, NGW, lane);
#else
    REPN(21) for (int i = 0; i < 2; ++i) {
        const int u = vcu * 2 + i, bh = u >> 4, cp = u & 15;
        ret_body::out_unit(WSP(bf16, WS_QR), WSP(bf16, WS_KR), WSP(bf16, WS_VR), WSP(bf16, WS_GR), WSP(float, WS_RET), args.in[6], WSP(bf16, WS_Y), bh >> 2, bh & 3, cp, (char*)lds_raw);
    }
#endif
#ifdef NAIVE_MEM
    naive_mem(WSP(bf16, WS_QM), WSP(bf16, WS_MK), WSP(bf16, WS_MV), WSP(bf16, WS_Y), gw, NGW, lane);
#else
    REPN(22) for (int i = 0; i < 2; ++i) {
        const int u = vcu * 2 + i, bh = u >> 4, qb = u & 15, b = bh >> 2, h = bh & 3;
        const size_t row0 = (size_t)b * SEQ + (size_t)qb * 256;
        attn_body::attn_unit<8, 256, 1024, false>(WSP(bf16, WS_QM) + row0 * 256 + h * 64, WSP(bf16, WS_MK) + (size_t)b * MEMLEN * 256 + h * 64, WSP(bf16, WS_MV) + (size_t)b * MEMLEN * 256 + h * 64,
                                                  WSP(bf16, WS_Y) + row0 * DM + 768 + h * 64, 4, 0, nullptr, (char*)lds_raw);
    }
#endif
    }
    GRID_BAR();

    REPN(3) {
        SchedPlain S{G, bx, 128, 4, (const char*)(ws + WS_Y), (const char*)(ws + WS_WOUT)};
        EpiOut E{args.in[0], args.out, WSP(float, WS_SSQ)};
#ifndef NO_G2
        pg8::gemm_phase<EpiOut, SchedPlain>(lds, S, E);
#endif
    }
    GRID_BAR();

    REPN(4) {
        PHASE_LANES;
        float* out = args.out; const float* b_router = args.in[14];
        float* WRG = WSP(float, WS_WRG); float* SSQ = WSP(float, WS_SSQ); int* TOPI = WSP(int, WS_TOPI); float* TOPW = WSP(float, WS_TOPW); int* LRANK = WSP(int, WS_LRANK); int* LCOUNT = WSP(int, WS_LCOUNT);
        unsigned char* XN2 = WSP(unsigned char, WS_XN2); const float* g_ffn = args.in[12];
        if (bx == 0 && tid < 64) ((u32x4*)(XN2 + (size_t)T * DM))[tid] = (u32x4){0u, 0u, 0u, 0u};
        LAS float* wl = (LAS float*)(lds);
        LAS float* lg = (LAS float*)(lds + 131072) + wave * (16 * 33);
        LAS int* hist = (LAS int*)(lds + 131072 + 16896);
        for (int i4 = tid; i4 < DM * NEXP / 4; i4 += NTHREADS) { const f32x4 w4 = ((const f32x4*)WRG)[i4]; const int r = i4 >> 3, e = (i4 & 7) * 4; *(LAS f32x4*)(wl + r * 32 + (e ^ (((r >> 2) & 1) << 4))) = w4; }
        if (tid < 32) hist[tid] = 0;
        __syncthreads();
        const int tpw = T / (G * NWAVES);
        for (int tb = 0; tb < tpw; tb += 16) {
            const int t0 = (bx * NWAVES + wave) * tpw + tb;
            const int i = lane & 15, kq = lane >> 4;
            f32x4 a0 = {0.f, 0.f, 0.f, 0.f}, a1 = {0.f, 0.f, 0.f, 0.f};
            const float* xr = out + (size_t)(t0 + i) * DM + 4 * kq;
            const LAS float* wb = wl + (4 * kq) * 32 + (i ^ ((kq & 1) << 4));
            const LAS float* wb1 = wl + (4 * kq) * 32 + ((i ^ ((kq & 1) << 4)) ^ 16);
            float rstd;
            { const f32x4* sp = (const f32x4*)(SSQ + (size_t)(t0 + i) * 16); const f32x4 s0 = sp[0], s1 = sp[1], s2 = sp[2], s3 = sp[3];
              const float ss = ((s0[0] + s0[1]) + (s0[2] + s0[3])) + ((s1[0] + s1[1]) + (s1[2] + s1[3])) + ((s2[0] + s2[1]) + (s2[2] + s2[3])) + ((s3[0] + s3[1]) + (s3[2] + s3[3]));
              rstd = 1.0f / sqrtf(ss * (1.0f / DM) + EPS); }
            unsigned char* xo = XN2 + (size_t)(t0 + i) * DM + 4 * kq;
            const float* gp = g_ffn + 4 * kq;
#pragma unroll 4
            for (int c = 0; c < 64; ++c) {
                const f32x4 av = *(const f32x4*)(xr + 16 * c);
                { const f32x4 gg = *(const f32x4*)(gp + 16 * c); int w = 0; w = __builtin_amdgcn_cvt_pk_fp8_f32(av[0] * rstd * gg[0], av[1] * rstd * gg[1], w, false); w = __builtin_amdgcn_cvt_pk_fp8_f32(av[2] * rstd * gg[2], av[3] * rstd * gg[3], w, true); *(int*)(xo + 16 * c) = w; }
#pragma unroll
                for (int q = 0; q < 4; ++q) {
                    const float b0 = wb[(16 * c + q) * 32], b1v = wb1[(16 * c + q) * 32];
                    a0 = __builtin_amdgcn_mfma_f32_16x16x4f32(av[q], b0, a0, 0, 0, 0);
                    a1 = __builtin_amdgcn_mfma_f32_16x16x4f32(av[q], b1v, a1, 0, 0, 0);
                }
            }
#pragma unroll
            for (int r = 0; r < 4; ++r) { lg[(4 * kq + r) * 33 + i] = a0[r]; lg[(4 * kq + r) * 33 + 16 + i] = a1[r]; }
            LDS_WAIT(); asm volatile("" ::: "memory");
            if (lane < 16) {
                const int t = t0 + lane;
                float v[32];
#pragma unroll
                for (int e = 0; e < 32; ++e) v[e] = lg[lane * 33 + e] * rstd + b_router[e];
                int bi[4]; float bvv[4];
#pragma unroll
                for (int k = 0; k < 4; ++k) {
                    float best = -3e38f; int be = 0;
#pragma unroll
                    for (int e = 0; e < 32; ++e) { const bool take = v[e] > best; best = take ? v[e] : best; be = take ? e : be; }
                    bi[k] = be; bvv[k] = best;
#pragma unroll
                    for (int e = 0; e < 32; ++e) v[e] = (e == be) ? -3e38f : v[e];
                }
                const float e1 = __expf(bvv[1] - bvv[0]), e2 = __expf(bvv[2] - bvv[0]), e3 = __expf(bvv[3] - bvv[0]);
                const float inv = 1.0f / (1.0f + e1 + e2 + e3);
                const float wv[4] = {inv, e1 * inv, e2 * inv, e3 * inv};
#pragma unroll
                for (int k = 0; k < 4; ++k) {
                    const int rk = atomicAdd((int*)&hist[bi[k]], 1);
                    TOPI[t * 4 + k] = bi[k]; TOPW[t * 4 + k] = wv[k]; LRANK[t * 4 + k] = rk;
                }
            }
            LDS_WAIT(); asm volatile("" ::: "memory");
        }
        __syncthreads();
        if (tid < 32) LCOUNT[bx * 32 + tid] = hist[tid];
    }
    GRID_BAR();

    REPN(5) {
        PHASE_LANES;
        int* TOPI = WSP(int, WS_TOPI); float* TOPW = WSP(float, WS_TOPW); int* LRANK = WSP(int, WS_LRANK); int* LCOUNT = WSP(int, WS_LCOUNT);
        int* POS = WSP(int, WS_POS); float* ROWW = WSP(float, WS_ROWW); int* PSTART = WSP(int, WS_PSTART); int* TILEEXP = WSP(int, WS_TILEEXP);
        LAS int* part = (LAS int*)(lds);
        LAS int* base = (LAS int*)(lds + 8192);
        {
            const int e = tid & 31, p = tid >> 5; int c = 0, pre = 0;
            const int wpp = (G + 15) / 16;
            for (int w = p * wpp; w < (p + 1) * wpp && w < G; ++w) { const int v = LCOUNT[w * 32 + e]; c += v; pre += (w < bx) ? v : 0; }
            part[p * 32 + e] = c; part[512 + p * 32 + e] = pre;
        }
        __syncthreads();
        if (tid < 32) { int c = 0, pre = 0; for (int p = 0; p < 16; ++p) { c += part[p * 32 + tid]; pre += part[512 + p * 32 + tid]; } part[1024 + tid] = c; part[1056 + tid] = pre; }
        __syncthreads();
        if (tid == 0) {
            int ps = 0;
            for (int e = 0; e < 32; ++e) {
                const int c = part[1024 + e], nt_ = (c + 255) >> 8;
                base[32 + e] = ps; base[e] = ps + part[1056 + e];
                if (bx == 0) { PSTART[e] = ps; for (int tt = 0; tt < nt_; ++tt) TILEEXP[(ps >> 8) + tt] = e; }
                ps += nt_ * 256;
            }
            base[64] = ps; if (bx == 0) PSTART[32] = ps;
        }
        __syncthreads();
        int* ROWTOK = WSP(int, WS_ROWTOK);
        if (bx < 32) {
            const int c = part[1024 + bx], r0 = base[32 + bx] + c, r1 = base[32 + bx] + (((c + 255) >> 8) << 8);
            for (int r = r0 + tid; r < r1; r += NTHREADS) { ROWTOK[r] = T; ROWW[r] = 0.f; }
        }
        for (int a = tid; a < (T / G) * 4; a += NTHREADS) {
            const int ta = (bx * (T / G)) * 4 + a;
            const int e = TOPI[ta]; const int pos = base[e] + LRANK[ta];
            POS[ta] = pos; ROWTOK[pos] = ta >> 2; ROWW[pos] = TOPW[ta];
        }
    }
    GRID_BAR();

    const int ntiles = WSP(int, WS_PSTART)[32] >> 8;
    REPN(6) {
        SchedMoe S{G, vcu, 8, ntiles, WSP(int, WS_TILEEXP), (const char*)(ws + WS_XN2), (const char*)(ws + WS_W1), (size_t)2048 * 1024, WSP(int, WS_ROWTOK)};
        EpiSwiglu E{args.in[16], WSP(unsigned char, WS_H)};
#ifndef NO_G3
        pg8::gemm_phase<EpiSwiglu, SchedMoe, true, true>(lds, S, E);
#endif
    }
    GRID_BAR();
    REPN(7) {
        SchedMoe S{G, vcu, 4, ntiles, WSP(int, WS_TILEEXP), (const char*)(ws + WS_H), (const char*)(ws + WS_W2), (size_t)1024 * 1024, nullptr};
        EpiDown E{args.in[18], WSP(float, WS_ROWW), WSP(unsigned char, WS_XG)};
#ifndef NO_G4
        pg8::gemm_phase<EpiDown, SchedMoe, false, true>(lds, S, E);
#endif
    }
    GRID_BAR();
    if (REP_PHASE == 9) { GRID_BAR(); GRID_BAR(); GRID_BAR(); GRID_BAR(); }
    REPN(8) { PHASE_LANES;
    for (int t = gw; t < T; t += NGW) {
        float* out = args.out; const int* POS = WSP(int, WS_POS); const unsigned char* YE = WSP(unsigned char, WS_XG);
        float* dst = (REP_PHASE == 8 && rep_ == 0) ? WSP(float, WS_H) : out;
        f32x4* orow = (f32x4*)(out + (size_t)t * DM) + lane; f32x4* drow = (f32x4*)(dst + (size_t)t * DM) + lane;
        f32x4 v[4]; f32x4 s[4];
#pragma unroll
        for (int j = 0; j < 4; ++j) { v[j] = orow[64 * j]; s[j] = (f32x4){0.f, 0.f, 0.f, 0.f}; }
        unsigned yw[4][4];
#pragma unroll
        for (int k = 0; k < 4; ++k) {
            const int pos = POS[t * 4 + k]; const unsigned* yr = (const unsigned*)(YE + (size_t)pos * 1024) + lane;
#pragma unroll
            for (int j = 0; j < 4; ++j) yw[k][j] = yr[64 * j];
        }
#pragma unroll
        for (int k = 0; k < 4; ++k)
#pragma unroll
            for (int j = 0; j < 4; ++j) {
                const f32x2 lo = __builtin_amdgcn_cvt_pk_f32_fp8((int)yw[k][j], false), hi = __builtin_amdgcn_cvt_pk_f32_fp8((int)yw[k][j], true);
                s[j].x += lo.x; s[j].y += lo.y; s[j].z += hi.x; s[j].w += hi.y;
            }
#pragma unroll
        for (int j = 0; j < 4; ++j) drow[64 * j] = v[j] + s[j] * 0.0625f;
    }
    }
}

extern "C" void kernel_launch(void* const* d_in, const int* in_sizes, int n_in, void* d_out, int out_size, void* d_ws, size_t ws_size, hipStream_t stream) {
    static int grid = 0;
    if (grid == 0) {
        if (n_in != 19 || out_size != T * DM || ws_size < WS_END) { fprintf(stderr, "kernel_launch: unexpected shapes (n_in %d out %d ws %zu)\n", n_in, out_size, ws_size); grid = -1; return; }
        int dev = 0, cus = 0, per_cu = 0;
        hipGetDevice(&dev); hipDeviceGetAttribute(&cus, hipDeviceAttributeMultiprocessorCount, dev);
        hipFuncSetAttribute((const void*)fwd_kernel, hipFuncAttributeMaxDynamicSharedMemorySize, LDS_BYTES);
        hipOccupancyMaxActiveBlocksPerMultiprocessor(&per_cu, (const void*)fwd_kernel, NTHREADS, LDS_BYTES);
        if (per_cu < 1) { fprintf(stderr, "kernel_launch: occupancy query says %d blocks per CU\n", per_cu); per_cu = 1; }
        (void)hipGetLastError();
        grid = cus * 1;
        if (grid % 8 != 0 || T % (grid * NWAVES * 16) != 0) { fprintf(stderr, "kernel_launch: grid %d unsupported\n", grid); grid = -1; return; }
    }
    if (grid < 0) return;
    hipMemsetAsync((char*)d_ws + WS_CTL, 0, CTL_ZERO_BYTES, stream);
    Args a{};
    for (int i = 0; i < 19; ++i) a.in[i] = (const float*)d_in[i];
    a.out = (float*)d_out; a.ws = (unsigned char*)d_ws;
    void* kargs[] = {&a};
    hipError_t e = hipLaunchCooperativeKernel((const void*)fwd_kernel, dim3(grid), dim3(NTHREADS), kargs, LDS_BYTES, stream);
    if (e != hipSuccess) fprintf(stderr, "cooperative launch failed: %s (grid %d)\n", hipGetErrorString(e), grid);
}
```

```cpp
#include <hip/hip_runtime.h>
#include <hip/hip_cooperative_groups.h>
#include <cstdio>
#include <cstdint>
namespace cg = cooperative_groups;

#define GAS __attribute__((address_space(1)))
#define LAS __attribute__((address_space(3)))
typedef unsigned short bf16;
typedef short bf16x8 __attribute__((ext_vector_type(8)));
typedef float f32x4 __attribute__((ext_vector_type(4)));
typedef float f32x2 __attribute__((ext_vector_type(2)));
typedef unsigned u32x4 __attribute__((ext_vector_type(4)));
typedef unsigned u32x2 __attribute__((ext_vector_type(2)));
typedef __bf16 bf16x2_t __attribute__((ext_vector_type(2)));

constexpr int NB = 8, SEQ = 4096, DM = 1024, T = NB * SEQ;
constexpr int NIN = 2816, NEXP = 32, TOPK = 4;
constexpr int MEMLEN = 256, MROWS = NB * MEMLEN;
constexpr float EPS = 1e-6f;
constexpr float C2 = 0.125f * 1.4426950408889634f;
constexpr int MAXTILES = 544, PROWS = MAXTILES * 256;
constexpr int NWAVES = 8, NTHREADS = 512;
#ifndef REP_PHASE
#define REP_PHASE -1
#endif
#define TSTAMP(i) do { if (REP_PHASE == 100 + (i)) tsA_ = __builtin_amdgcn_s_memrealtime(); if (REP_PHASE == 99 + (i)) tsB_ = __builtin_amdgcn_s_memrealtime(); } while (0)
#define REPN(k) for (int rep_ = 0; rep_ < ((REP_PHASE == (k)) ? 2 : 1); ++rep_)
constexpr int LDS_MISC = 150016;
constexpr int LDS_BYTES = 150016 + 256;

constexpr size_t MiB = 1u << 20;
constexpr size_t WS_CTL = 0, CTL_ZERO_BYTES = 131072;
constexpr size_t WS_BAR = 65536;
constexpr size_t WS_KMEAN = 1 * MiB;
constexpr size_t WS_WRG = 2 * MiB;
constexpr size_t WS_SSQ = 3 * MiB;
constexpr size_t WS_TOPI = 5 * MiB, WS_TOPW = 5 * MiB + 512 * 1024, WS_LRANK = 6 * MiB, WS_POS = 6 * MiB + 512 * 1024;
constexpr size_t WS_ROWW = 7 * MiB;
constexpr size_t WS_LCOUNT = 8 * MiB, WS_PSTART = 8 * MiB + 65536, WS_TILEEXP = 8 * MiB + 131072;
constexpr size_t WS_WIN = 16 * MiB, WS_WMEM = 22 * MiB, WS_WOUT = 24 * MiB, WS_W1 = 32 * MiB, WS_W2 = 160 * MiB;
constexpr size_t WS_XN = 224 * MiB, WS_MEMN = 288 * MiB;
constexpr size_t WS_QA = 292 * MiB, WS_KA = 324 * MiB, WS_VA = 356 * MiB;
constexpr size_t WS_QR = 388 * MiB, WS_KR = 404 * MiB, WS_VR = 420 * MiB, WS_GR = 436 * MiB, WS_QM = 452 * MiB;
constexpr size_t WS_MK = 468 * MiB, WS_MV = 469 * MiB;
constexpr size_t WS_Y = 470 * MiB, WS_RET = 534 * MiB;
constexpr size_t WS_XG = 224 * MiB;
constexpr size_t WS_XN2 = 496 * MiB;
constexpr size_t WS_X1B = 388 * MiB;
constexpr size_t WS_IRS = 10 * MiB;
constexpr size_t WS_ROWTOK = 9 * MiB;
constexpr size_t WS_XN8 = 566 * MiB, WS_MEMN8 = 598 * MiB, WS_WIN8 = 600 * MiB, WS_WMEM8 = 604 * MiB;
constexpr size_t WS_H = 566 * MiB;
constexpr size_t WS_END = 838 * MiB;

struct Args {
    const float* in[19]; float* out; unsigned char* ws; int pad0, pad1;
};

__device__ __forceinline__ unsigned cvtpk(float lo, float hi) { f32x2 v = {lo, hi}; bf16x2_t b = __builtin_convertvector(v, bf16x2_t); return __builtin_bit_cast(unsigned, b); }
__device__ __forceinline__ float bf2f(unsigned short b) { return __uint_as_float(((unsigned)b) << 16); }
__device__ __forceinline__ float bflo(unsigned w) { return __uint_as_float(w << 16); }
__device__ __forceinline__ float bfhi(unsigned w) { return __uint_as_float(w & 0xffff0000u); }
__device__ __forceinline__ float wave_sum(float v) {
#pragma unroll
    for (int o = 1; o < 64; o <<= 1) v += __shfl_xor(v, o);
    return v;
}
#define LDS_WAIT() asm volatile("s_waitcnt lgkmcnt(0)" ::: "memory")
typedef unsigned v6u_t __attribute__((ext_vector_type(6)));
typedef float v16f_t __attribute__((ext_vector_type(16)));
#ifndef FP6_SCALE_DIV
#define FP6_SCALE_DIV 1
#endif
__device__ __forceinline__ void fp6_pack32(const float (&v)[32], u32x4& p0, u32x4& p1) {
    float mx = 1e-30f;
#pragma unroll
    for (int i = 0; i < 32; ++i) mx = fmaxf(mx, fabsf(v[i]));
    const unsigned bits = __float_as_uint(mx * (1.0f / 7.5f));
    int e = (int)((bits + 0x7FFFFFu) >> 23) - 127;
    e = e < -126 ? -126 : (e > 126 ? 126 : e);
    const float sc = __uint_as_float((unsigned)((FP6_SCALE_DIV ? e : -e) + 127) << 23);
    v16f_t lo, hi;
#pragma unroll
    for (int i = 0; i < 16; ++i) { lo[i] = v[i]; hi[i] = v[16 + i]; }
    const v6u_t w = __builtin_amdgcn_cvt_scalef32_2xpk16_fp6_f32(lo, hi, sc);
    p0 = (u32x4){w[0], w[1], w[2], w[3]}; p1 = (u32x4){w[4], w[5], (unsigned)(e + 127), 0u};
}
__device__ __forceinline__ int opaque(int v) { asm volatile("" : "+v"(v)); return v; }

namespace pg8 {
constexpr int BM = 256, BK = 64, HALF = 128, HTB = HALF * BK * 2, STAGE_BYTES = 8 * HTB, NXCD = 8, WGM = 8, K = 1024;
__host__ __device__ __forceinline__ int lds_byte(int r, int c) { const int st = (r >> 4) * 2 + (c >> 5), rr = r & 15, cc = c & 31, ob = rr * 64 + cc * 2; return st * 1024 + (ob ^ (((ob >> 9) & 1) << 5)); }
__host__ __device__ __forceinline__ void stage_rc(int b, int& R, int& C) { const int st = b / 1024, sb = b % 1024, swz = sb ^ (((sb >> 9) & 1) << 5); R = (st >> 1) * 16 + swz / 64; C = (st & 1) * 32 + (swz % 64) / 2; }
__host__ __device__ __forceinline__ int perm32(int rho) { const int n = rho >> 4, i = rho & 15; return 8 * (i >> 2) + 4 * n + (i & 3); }
struct Unit { int pm, pn, aux; };

__device__ __forceinline__ bool static_order(int L, int nM, int nN, int& pm, int& pn) {
    const int nwg = nM * nN; if (L >= nwg) return false;
    int wgid = L; { const int q = nwg / NXCD, r = nwg % NXCD, xcd = wgid % NXCD, off = wgid / NXCD; wgid = (xcd < r ? xcd * (q + 1) : r * (q + 1) + (xcd - r) * q) + off; }
    const int nig = WGM * nN, gid = wgid / nig, fm = gid * WGM, gsz = (nM - fm) < WGM ? (nM - fm) : WGM;
    pm = fm + ((wgid % nig) % gsz); pn = (wgid % nig) / gsz; return true;
}

typedef int v8i_t __attribute__((ext_vector_type(8)));
typedef int v4i_t __attribute__((ext_vector_type(4)));
__device__ __forceinline__ v8i_t cat8(bf16x8 lo, bf16x8 hi) { const v4i_t a = __builtin_bit_cast(v4i_t, lo), b = __builtin_bit_cast(v4i_t, hi); return __builtin_shufflevector(a, b, 0, 1, 2, 3, 4, 5, 6, 7); }
typedef int v6i_t __attribute__((ext_vector_type(6)));
__device__ __forceinline__ v6i_t cat6(bf16x8 lo, bf16x8 hi) { const v4i_t a = __builtin_bit_cast(v4i_t, lo), b = __builtin_bit_cast(v4i_t, hi); return __builtin_shufflevector(a, b, 0, 1, 2, 3, 4, 5); }
__device__ __forceinline__ int scl6(bf16x8 hi) { return __builtin_bit_cast(v4i_t, hi)[2]; }
template <class Epi, class Sched, bool GATHER = false, bool FP8 = false, bool FP6 = false>
__device__ __forceinline__ void gemm_phase(LAS unsigned char* lds, const Sched& S, const Epi& E) {
    constexpr int PITCH = FP8 ? 1024 : 2048;
    const int tid = opaque((int)threadIdx.x), wid = __builtin_amdgcn_readfirstlane(tid >> 6), lane = tid & 63, wr = wid >> 2, wc = wid & 3, fr = lane & 15, fq = lane >> 4;
    constexpr int nt = PITCH / 128;
    unsigned voffA[2], voffB[2];
#pragma unroll
    for (int i = 0; i < 2; ++i) { int R, C; stage_rc(tid * 16 + i * 8192, R, C); const int Rb = (R & ~31) + perm32(R & 31);
        voffA[i] = (unsigned)(R * PITCH + C * 2); voffB[i] = (unsigned)(Rb * PITCH + C * 2); }
    const size_t kstep = (size_t)(BK * 2);
    const size_t hstep = (size_t)HALF * PITCH;
    const unsigned ldsw = (unsigned)wid * 1024u;
    const int aoff = lds_byte(wr * 64 + fr, fq * 8), boff = lds_byte(wc * 32 + fr, fq * 8);
#define PG8_SA(b, h) (((b) * 2 + (h)) * HTB)
#define PG8_SB(b, h) ((4 + (b) * 2 + (h)) * HTB)
#define PG8_STAGE(bufoff, gbase, voff) do { _Pragma("unroll") for (int _i = 0; _i < 2; ++_i) \
        __builtin_amdgcn_global_load_lds((const unsigned*)((const char*)(gbase) + (voff)[_i]), (LAS unsigned*)(lds + (bufoff) + ldsw + _i * 8192), 16, 0, 0); } while (0)
#define PG8_LDA(dst, b, h) do { _Pragma("unroll") for (int m = 0; m < 4; ++m) _Pragma("unroll") for (int k = 0; k < 2; ++k) dst[m][k] = *(const LAS bf16x8*)(lds + PG8_SA(b, h) + aoff + m * 2048 + k * 1024); } while (0)
#define PG8_LDB(dst, b, h) do { _Pragma("unroll") for (int n = 0; n < 2; ++n) _Pragma("unroll") for (int k = 0; k < 2; ++k) dst[n][k] = *(const LAS bf16x8*)(lds + PG8_SB(b, h) + boff + n * 2048 + k * 1024); } while (0)
#define PG8_MMA(ai, bj, At, Bt) do { __builtin_amdgcn_s_setprio(1); \
        if constexpr (FP6) { _Pragma("unroll") for (int m = 0; m < 4; ++m) _Pragma("unroll") for (int n = 0; n < 2; ++n) \
            asm volatile("s_nop 1\n\tv_mfma_scale_f32_16x16x128_f8f6f4 %0, %1, %2, %0, %3, %4 op_sel_hi:[0,0,0] cbsz:2 blgp:2" : "+v"(acc[ai][bj][m][n]) : "v"(cat6(Bt[n][0], Bt[n][1])), "v"(cat6(At[m][0], At[m][1])), "v"(scl6(Bt[n][1])), "v"(scl6(At[m][1]))); } \
        else if constexpr (FP8) { _Pragma("unroll") for (int m = 0; m < 4; ++m) _Pragma("unroll") for (int n = 0; n < 2; ++n) \
            asm volatile("v_mfma_scale_f32_16x16x128_f8f6f4 %0, %1, %2, %0, %3, %3 op_sel_hi:[0,0,0]" : "+v"(acc[ai][bj][m][n]) : "v"(cat8(Bt[n][0], Bt[n][1])), "v"(cat8(At[m][0], At[m][1])), "v"(0x7f7f7f7f)); } \
        else { _Pragma("unroll") for (int m = 0; m < 4; ++m) _Pragma("unroll") for (int n = 0; n < 2; ++n) _Pragma("unroll") for (int k = 0; k < 2; ++k) \
            acc[ai][bj][m][n] = __builtin_amdgcn_mfma_f32_16x16x32_bf16(Bt[n][k], At[m][k], acc[ai][bj][m][n], 0, 0, 0); } \
        __builtin_amdgcn_s_setprio(0); } while (0)
#define PG8_WAIT_V(n) asm volatile("s_waitcnt vmcnt(" #n ")" ::: "memory")
#define PG8_WAIT_L(n) asm volatile("s_waitcnt lgkmcnt(" #n ")" ::: "memory")
#define PG8_BAR __builtin_amdgcn_s_barrier()
#define PG8_SCHED __builtin_amdgcn_sched_barrier(0)
    Unit cur, nxt; int ui = 0;
    if (!S.next(0, cur)) return;
    unsigned vGc[2][2], vGn[2][2]; int gR[2], gC[2];
    const char* gA = nullptr;
    if constexpr (GATHER) {
        gA = S.abase();
#pragma unroll
        for (int i = 0; i < 2; ++i) { stage_rc(tid * 16 + i * 8192, gR[i], gC[i]); }
        if (wid == 0) __builtin_amdgcn_global_load_lds((const unsigned*)(S.tokptr(cur) + lane * 16), (LAS unsigned*)(lds + 131072), 16, 0, 0);
        asm volatile("s_waitcnt vmcnt(0)" ::: "memory"); __builtin_amdgcn_s_barrier(); asm volatile("" ::: "memory");
#pragma unroll
        for (int h = 0; h < 2; ++h)
#pragma unroll
            for (int i = 0; i < 2; ++i) { const int tok = ((const LAS int*)(lds + 131072))[h * 128 + gR[i]]; vGc[h][i] = (unsigned)tok * (unsigned)PITCH + (unsigned)gC[i] * 2u; vGn[h][i] = vGc[h][i]; }
    }
    f32x4 acc[2][2][4][2];
#pragma unroll
    for (int a = 0; a < 2; ++a)
#pragma unroll
        for (int b = 0; b < 2; ++b)
#pragma unroll
            for (int m = 0; m < 4; ++m)
#pragma unroll
                for (int n = 0; n < 2; ++n) acc[a][b][m][n] = (f32x4){0.f, 0.f, 0.f, 0.f};
    bf16x8 At[4][2], B0[2][2], B1[2][2];
    const char* cA = GATHER ? gA : S.aptr(cur); const char* cB = S.bptr(cur);
    const size_t ahstep = GATHER ? (size_t)0 : hstep;
    {
        PG8_STAGE(PG8_SB(0, 0), cB, voffB); PG8_STAGE(PG8_SB(0, 1), cB + hstep, voffB);
        if constexpr (GATHER) { PG8_STAGE(PG8_SA(0, 0), cA, vGc[0]); PG8_STAGE(PG8_SA(0, 1), cA, vGc[1]); } else { PG8_STAGE(PG8_SA(0, 0), cA, voffA); PG8_STAGE(PG8_SA(0, 1), cA + hstep, voffA); }
        if (wr == 1) PG8_BAR;
        PG8_WAIT_V(2); PG8_BAR;
        PG8_STAGE(PG8_SB(1, 0), cB + kstep, voffB);
        if constexpr (GATHER) { PG8_STAGE(PG8_SA(1, 0), cA + kstep, vGc[0]); } else { PG8_STAGE(PG8_SA(1, 0), cA + kstep, voffA); }
        PG8_STAGE(PG8_SB(1, 1), cB + hstep + kstep, voffB);
        PG8_WAIT_V(6); PG8_BAR;
    }
    for (;;) {
        const bool has_next = S.next(ui + 1, nxt);
        const char* nA = GATHER ? gA : (has_next ? S.aptr(nxt) : cA); const char* nB = has_next ? S.bptr(nxt) : cB;
        if constexpr (GATHER) { if (has_next && wid == 0) __builtin_amdgcn_global_load_lds((const unsigned*)(S.tokptr(nxt) + lane * 16), (LAS unsigned*)(lds + 131072 + ((ui + 1) & 1) * 1024), 16, 0, 0); }
#pragma nounroll
        for (int t = 0; t < nt; t += 2) {
            const bool last = (t == nt - 2);
            const char* a1 = cA + (size_t)(t + 1) * kstep;
            const char* a2 = last ? nA : cA + (size_t)(t + 2) * kstep; const char* b2 = last ? nB : cB + (size_t)(t + 2) * kstep;
            const char* a3 = a2 + kstep; const char* b3 = b2 + kstep;
            unsigned v2h0[2], v2h1[2];
            if constexpr (GATHER) {
                if (last && has_next) {
                    const LAS int* tk = (const LAS int*)(lds + 131072 + ((ui + 1) & 1) * 1024);
#pragma unroll
                    for (int h = 0; h < 2; ++h)
#pragma unroll
                        for (int i = 0; i < 2; ++i) vGn[h][i] = (unsigned)tk[h * 128 + gR[i]] * (unsigned)PITCH + (unsigned)gC[i] * 2u;
                }
#pragma unroll
                for (int i = 0; i < 2; ++i) { v2h0[i] = last ? vGn[0][i] : vGc[0][i]; v2h1[i] = last ? vGn[1][i] : vGc[1][i]; }
            } else {
#pragma unroll
                for (int i = 0; i < 2; ++i) { v2h0[i] = voffA[i]; v2h1[i] = voffA[i]; }
            }
            PG8_LDB(B0, 0, 0); PG8_LDB(B1, 0, 1); PG8_SCHED; PG8_LDA(At, 0, 0);
            if constexpr (GATHER) { PG8_STAGE(PG8_SA(1, 1), a1, vGc[1]); } else { PG8_STAGE(PG8_SA(1, 1), a1 + hstep, voffA); }
            PG8_WAIT_V(8); PG8_WAIT_L(0); PG8_BAR; PG8_MMA(0, 0, At, B0); PG8_MMA(0, 1, At, B1); PG8_BAR; PG8_SCHED;
            PG8_LDA(At, 0, 1); PG8_STAGE(PG8_SB(0, 0), b2, voffB); PG8_STAGE(PG8_SB(0, 1), b2 + hstep, voffB); PG8_STAGE(PG8_SA(0, 0), a2, v2h0);
            PG8_WAIT_V(8); PG8_WAIT_L(0); PG8_BAR; PG8_MMA(1, 0, At, B0); PG8_MMA(1, 1, At, B1); PG8_BAR; PG8_SCHED;
            PG8_LDB(B0, 1, 0); PG8_LDB(B1, 1, 1); PG8_SCHED; PG8_LDA(At, 1, 0); PG8_STAGE(PG8_SA(0, 1), a2 + ahstep, v2h1);
            PG8_WAIT_V(8); PG8_WAIT_L(0); PG8_BAR; PG8_MMA(0, 0, At, B0); PG8_MMA(0, 1, At, B1); PG8_BAR; PG8_SCHED;
            PG8_LDA(At, 1, 1); PG8_STAGE(PG8_SB(1, 0), b3, voffB); PG8_STAGE(PG8_SB(1, 1), b3 + hstep, voffB); PG8_STAGE(PG8_SA(1, 0), a3, v2h0);
            PG8_WAIT_V(8); PG8_WAIT_L(0); PG8_BAR; PG8_MMA(1, 0, At, B0); PG8_MMA(1, 1, At, B1); PG8_BAR; PG8_SCHED;
        }
        if (wr == 0) PG8_BAR;
        if constexpr (FP8) asm volatile("s_nop 15\n\ts_nop 7" ::: "memory");
        E(acc, cur, wr, wc, fr, fq);
        if (!has_next) break;
#pragma unroll
        for (int a = 0; a < 2; ++a)
#pragma unroll
            for (int b = 0; b < 2; ++b)
#pragma unroll
                for (int m = 0; m < 4; ++m)
#pragma unroll
                    for (int n = 0; n < 2; ++n) acc[a][b][m][n] = (f32x4){0.f, 0.f, 0.f, 0.f};
        cur = nxt; cA = nA; cB = nB; ++ui;
        if constexpr (GATHER) {
#pragma unroll
            for (int h = 0; h < 2; ++h)
#pragma unroll
                for (int i = 0; i < 2; ++i) vGc[h][i] = vGn[h][i];
        }
        if (wr == 1) PG8_BAR;
    }
    PG8_WAIT_V(0);
    PG8_BAR;
#undef PG8_SA
#undef PG8_SB
#undef PG8_STAGE
#undef PG8_LDA
#undef PG8_LDB
#undef PG8_MMA
#undef PG8_WAIT_V
#undef PG8_WAIT_L
#undef PG8_BAR
#undef PG8_SCHED
}
}
using pg8::Unit;

struct SchedProj {
    int G, c; const char *XN, *MEMN, *WIN, *WMEM;
    __device__ __forceinline__ bool next(int i, Unit& u) const {
        const int L = i * G + c;
        if (L < 1408) { u.aux = 0; return pg8::static_order(L, 128, 11, u.pm, u.pn); }
        if (L < 1424) { const int j = L - 1408; u.pm = j >> 1; u.pn = j & 1; u.aux = 1; return true; }
        return false;
    }
    __device__ __forceinline__ const char* aptr(const Unit& u) const { return (u.aux ? MEMN : XN) + (size_t)u.pm * (256 * 2048); }
    __device__ __forceinline__ const char* bptr(const Unit& u) const { return (u.aux ? WMEM : WIN) + (size_t)u.pn * (256 * 2048); }
};
struct SchedProjA {
    int G, c; const char *XN, *WIN;
    __device__ __forceinline__ bool next(int i, Unit& u) const { int j; u.aux = 0; if (!pg8::static_order(i * G + c, 128, 8, u.pm, j)) return false; u.pn = j < 4 ? j : j + 2; return true; }
    __device__ __forceinline__ const char* aptr(const Unit& u) const { return XN + (size_t)u.pm * (256 * 2048); }
    __device__ __forceinline__ const char* bptr(const Unit& u) const { return WIN + (size_t)u.pn * (256 * 2048); }
};
struct SchedProjB {
    int G, c; const char *XN8, *MEMN8, *WIN8, *WMEM8;
    __device__ __forceinline__ bool next(int i, Unit& u) const {
        const int L = i * G + c;
        if (L < 384) { int j; u.aux = 0; pg8::static_order(L, 128, 3, u.pm, j); u.pn = j < 2 ? 4 + j : 10; return true; }
        if (L < 400) { const int j = L - 384; u.pm = j >> 1; u.pn = j & 1; u.aux = 1; return true; }
        return false;
    }
    __device__ __forceinline__ const char* aptr(const Unit& u) const { return (u.aux ? MEMN8 : XN8) + (size_t)u.pm * (256 * 1024); }
    __device__ __forceinline__ const char* bptr(const Unit& u) const { return (u.aux ? WMEM8 : WIN8) + (size_t)u.pn * (256 * 1024); }
};
struct SchedPlain {
    int G, c, nM, nN; const char *A, *B;
    __device__ __forceinline__ bool next(int i, Unit& u) const { u.aux = 0; return pg8::static_order(i * G + c, nM, nN, u.pm, u.pn); }
    __device__ __forceinline__ const char* aptr(const Unit& u) const { return A + (size_t)u.pm * (256 * 2048); }
    __device__ __forceinline__ const char* bptr(const Unit& u) const { return B + (size_t)u.pn * (256 * 2048); }
};
struct SchedMoe {
    int G, vcu, npn, ntiles; const int* tile_exp; const char *A, *B; size_t bexp;
    __device__ __forceinline__ bool next(int i, Unit& u) const {
        const int L = i * G + vcu, tile = L / npn; if (tile >= ntiles) return false;
        u.pm = tile; u.pn = L - tile * npn; u.aux = __builtin_amdgcn_readfirstlane(tile_exp[tile]); return true;
    }
    __device__ __forceinline__ const char* aptr(const Unit& u) const { return A + (size_t)u.pm * (256 * 1024); }
    __device__ __forceinline__ const char* bptr(const Unit& u) const { return B + (size_t)u.aux * bexp + (size_t)u.pn * (256 * 1024); }
    const int* rowtok;
    __device__ __forceinline__ const char* abase() const { return A; }
    __device__ __forceinline__ const char* tokptr(const Unit& u) const { return (const char*)(rowtok + (size_t)u.pm * 256); }
};

struct EpiProj {
    unsigned char* ws;
    const float *gq, *gk, *gmq, *gmk; float pre;
    __device__ __forceinline__ void operator()(const f32x4 (&acc)[2][2][4][2], const Unit& u, int wr, int wc, int fr, int fq) const {
        int mode = 0; bf16* out; int ld = 256, coff = 0; const float* gain = nullptr; float scale = 1.f; bool kmean = false;
        if (u.aux == 0) {
            switch (u.pn) {
                case 0: case 1: out = (bf16*)(ws + WS_QA); ld = 512; coff = u.pn * 256; mode = 1; gain = gq; scale = C2; break;
                case 2: case 3: out = (bf16*)(ws + WS_KA); ld = 512; coff = (u.pn - 2) * 256; mode = 1; gain = gk; kmean = true; break;
                case 4: case 5: out = (bf16*)(ws + WS_VA); ld = 512; coff = (u.pn - 4) * 256; break;
                case 6: out = (bf16*)(ws + WS_QR); mode = 2; break;
                case 7: out = (bf16*)(ws + WS_KR); mode = 2; scale = 0.125f; break;
                case 8: out = (bf16*)(ws + WS_VR); break;
                case 9: out = (bf16*)(ws + WS_GR); mode = 3; break;
                default: out = (bf16*)(ws + WS_QM); mode = 1; gain = gmq; scale = C2; break;
            }
        } else {
            if (u.pn == 0) { out = (bf16*)(ws + WS_MK); mode = 1; gain = gmk; } else { out = (bf16*)(ws + WS_MV); }
        }
        const int row0 = u.pm * 256 + wr * 64 + fr;
        const int colb = coff + wc * 64 + 8 * fq;
        if (gain == nullptr) gain = gq;
        f32x4 ks[2][2];
#pragma unroll
        for (int bj = 0; bj < 2; ++bj)
#pragma unroll
            for (int n = 0; n < 2; ++n) ks[bj][n] = (f32x4){0.f, 0.f, 0.f, 0.f};
#pragma unroll
        for (int ai = 0; ai < 2; ++ai)
#pragma unroll
            for (int m = 0; m < 4; ++m) {
                const int row = row0 + ai * 128 + m * 16;
                f32x4 v[2][2];
#pragma unroll
                for (int bj = 0; bj < 2; ++bj)
#pragma unroll
                    for (int n = 0; n < 2; ++n) v[bj][n] = acc[ai][bj][m][n] * pre;
                if (mode == 1) {
                    float ss = 0.f;
#pragma unroll
                    for (int bj = 0; bj < 2; ++bj)
#pragma unroll
                        for (int n = 0; n < 2; ++n) { const f32x4 x = v[bj][n]; ss += (x[0] * x[0] + x[1] * x[1]) + (x[2] * x[2] + x[3] * x[3]); }
                    ss += __shfl_xor(ss, 16); ss += __shfl_xor(ss, 32);
                    const float r = scale / sqrtf(ss * (1.0f / 64.0f) + EPS);
#pragma unroll
                    for (int bj = 0; bj < 2; ++bj)
#pragma unroll
                        for (int n = 0; n < 2; ++n) v[bj][n] = v[bj][n] * r * *(const f32x4*)(gain + bj * 32 + 8 * fq + 4 * n);
                } else if (mode == 2) {
                    const float pos = (float)(row & (SEQ - 1));
                    const float lgam = __builtin_amdgcn_logf(1.0f - __builtin_amdgcn_exp2f(-5.0f - (float)wc));
                    const float rsc = scale * __builtin_amdgcn_exp2f(((u.pn == 6) ? lgam : -lgam) * (float)(row & 127));
#pragma unroll
                    for (int n = 0; n < 2; ++n)
#pragma unroll
                        for (int j = 0; j < 4; ++j) {
                            const float fre = __builtin_amdgcn_exp2f((float)(8 * fq + 4 * n + j) * (-13.287712379549449f / 31.0f)) * 0.15915494309189535f;
                            float tt = pos * fre; tt = tt - floorf(tt);
                            const float sn = __builtin_amdgcn_sinf(tt), cs = __builtin_amdgcn_cosf(tt);
                            const float t1 = v[0][n][j], t2 = v[1][n][j];
                            v[0][n][j] = (t1 * cs - t2 * sn) * rsc; v[1][n][j] = (t2 * cs + t1 * sn) * rsc;
                        }
                } else if (mode == 3) {
#pragma unroll
                    for (int bj = 0; bj < 2; ++bj)
#pragma unroll
                        for (int n = 0; n < 2; ++n)
#pragma unroll
                            for (int j = 0; j < 4; ++j) { const float x = v[bj][n][j]; v[bj][n][j] = x / (1.0f + __expf(-x)); }
                }
                if (kmean) {
#pragma unroll
                    for (int bj = 0; bj < 2; ++bj)
#pragma unroll
                        for (int n = 0; n < 2; ++n) ks[bj][n] += v[bj][n];
                }
                bf16* rowp = out + (size_t)row * ld + colb;
#pragma unroll
                for (int bj = 0; bj < 2; ++bj) { u32x4 w; w.x = cvtpk(v[bj][0][0], v[bj][0][1]); w.y = cvtpk(v[bj][0][2], v[bj][0][3]); w.z = cvtpk(v[bj][1][0], v[bj][1][1]); w.w = cvtpk(v[bj][1][2], v[bj][1][3]);
                    *(u32x4*)(rowp + bj * 32) = w; }
            }
        if (kmean) {
            float* kp = (float*)(ws + WS_KMEAN) + ((size_t)u.pm * 8 + (u.pn - 2) * 4 + wc) * 64 + 8 * fq;
#pragma unroll
            for (int bj = 0; bj < 2; ++bj)
#pragma unroll
                for (int n = 0; n < 2; ++n)
#pragma unroll
                    for (int j = 0; j < 4; ++j) {
                        float s = ks[bj][n][j];
                        s += __shfl_xor(s, 1); s += __shfl_xor(s, 2); s += __shfl_xor(s, 4); s += __shfl_xor(s, 8);
                        if (fr == 0) atomicAdd(kp + bj * 32 + 4 * n + j, s * (1.0f / 256.0f));
                    }
        }
    }
};

struct EpiOut {
    const bf16* xn; const float* irs; const float* gattn; bf16* out; float* ssq;
    __device__ __forceinline__ void operator()(const f32x4 (&acc)[2][2][4][2], const Unit& u, int wr, int wc, int fr, int fq) const {
        const int row0 = u.pm * 256 + wr * 64 + fr, col0 = u.pn * 256 + wc * 32 + 8 * fq;
        f32x4 ig[2][2];
#pragma unroll
        for (int bj = 0; bj < 2; ++bj)
#pragma unroll
            for (int n = 0; n < 2; ++n) { const f32x4 g = *(const f32x4*)(gattn + col0 + bj * 128 + 4 * n); ig[bj][n] = (f32x4){1.0f / g[0], 1.0f / g[1], 1.0f / g[2], 1.0f / g[3]}; }
#pragma unroll
        for (int ai = 0; ai < 2; ++ai)
#pragma unroll
            for (int m = 0; m < 4; ++m) {
                const int row = row0 + ai * 128 + m * 16; const size_t off = (size_t)row * DM + col0; float ss = 0.f; const float ir = irs[row];
#pragma unroll
                for (int bj = 0; bj < 2; ++bj) {
                    const u32x4 xw = __builtin_nontemporal_load((const u32x4*)(xn + off + bj * 128));
                    const f32x4 o0 = (f32x4){bflo(xw.x), bfhi(xw.x), bflo(xw.y), bfhi(xw.y)} * ig[bj][0] * ir + acc[ai][bj][m][0], o1 = (f32x4){bflo(xw.z), bfhi(xw.z), bflo(xw.w), bfhi(xw.w)} * ig[bj][1] * ir + acc[ai][bj][m][1];
                    ss += ((o0[0] * o0[0] + o0[1] * o0[1]) + (o0[2] * o0[2] + o0[3] * o0[3])) + ((o1[0] * o1[0] + o1[1] * o1[1]) + (o1[2] * o1[2] + o1[3] * o1[3]));
                    u32x4 w; w.x = cvtpk(o0[0], o0[1]); w.y = cvtpk(o0[2], o0[3]); w.z = cvtpk(o1[0], o1[1]); w.w = cvtpk(o1[2], o1[3]);
                    *(u32x4*)(out + off + bj * 128) = w; }
                ss += __shfl_xor(ss, 16); ss += __shfl_xor(ss, 32);
                if (fq == 0) ssq[(size_t)row * 16 + u.pn * 4 + wc] = ss;
            }
    }
};

struct EpiSwiglu {
    const float* b1; unsigned char* H;
    __device__ __forceinline__ void operator()(const f32x4 (&acc)[2][2][4][2], const Unit& u, int wr, int wc, int fr, int fq) const {
        const int row0 = u.pm * 256 + wr * 64 + fr, p0 = u.pn * 128 + wc * 32 + 8 * fq;
        const float* bp = b1 + (size_t)u.aux * 2048 + 2 * p0;
        f32x4 bv[4];
#pragma unroll
        for (int i = 0; i < 4; ++i) bv[i] = *(const f32x4*)(bp + 4 * i);
#pragma unroll
        for (int ai = 0; ai < 2; ++ai)
#pragma unroll
            for (int m = 0; m < 4; ++m) {
                const int row = row0 + ai * 128 + m * 16;
                float h[8];
#pragma unroll
                for (int n = 0; n < 2; ++n)
#pragma unroll
                    for (int j = 0; j < 4; ++j) {
                        const int i = 4 * n + j;
                        const float g = fminf(acc[ai][0][m][n][j] + bv[i >> 1][(i & 1) * 2], 7.0f);
                        const float l = fminf(fmaxf(acc[ai][1][m][n][j] + bv[i >> 1][(i & 1) * 2 + 1], -7.0f), 7.0f);
                        h[i] = g * __builtin_amdgcn_rcpf(1.0f + __builtin_amdgcn_exp2f(-1.702f * 1.4426950408889634f * g)) * (l + 1.0f);
                    }
                int w0 = 0, w1 = 0;
                w0 = __builtin_amdgcn_cvt_pk_fp8_f32(h[0], h[1], w0, false); w0 = __builtin_amdgcn_cvt_pk_fp8_f32(h[2], h[3], w0, true);
                w1 = __builtin_amdgcn_cvt_pk_fp8_f32(h[4], h[5], w1, false); w1 = __builtin_amdgcn_cvt_pk_fp8_f32(h[6], h[7], w1, true);
                *(u32x2*)(H + (size_t)row * 1024 + p0) = (u32x2){(unsigned)w0, (unsigned)w1};
            }
    }
};

struct EpiDown {
    const float* b2; const float* roww; unsigned char* YE;
    __device__ __forceinline__ void operator()(const f32x4 (&acc)[2][2][4][2], const Unit& u, int wr, int wc, int fr, int fq) const {
        const int row0 = u.pm * 256 + wr * 64 + fr, c0 = u.pn * 256 + wc * 32 + 8 * fq;
        const float* bp = b2 + (size_t)u.aux * 1024 + c0;
        f32x4 bv[2][2];
#pragma unroll
        for (int bj = 0; bj < 2; ++bj)
#pragma unroll
            for (int n = 0; n < 2; ++n) bv[bj][n] = *(const f32x4*)(bp + bj * 128 + 4 * n);
#pragma unroll
        for (int ai = 0; ai < 2; ++ai)
#pragma unroll
            for (int m = 0; m < 4; ++m) {
                const int row = row0 + ai * 128 + m * 16; const float w8 = roww[row] * 16.0f;
#pragma unroll
                for (int bj = 0; bj < 2; ++bj) {
                    const f32x4 y0 = (acc[ai][bj][m][0] * 0.03125f + bv[bj][0]) * w8, y1 = (acc[ai][bj][m][1] * 0.03125f + bv[bj][1]) * w8;
                    int w0 = 0, w1 = 0;
                    w0 = __builtin_amdgcn_cvt_pk_fp8_f32(y0[0], y0[1], w0, false); w0 = __builtin_amdgcn_cvt_pk_fp8_f32(y0[2], y0[3], w0, true);
                    w1 = __builtin_amdgcn_cvt_pk_fp8_f32(y1[0], y1[1], w1, false); w1 = __builtin_amdgcn_cvt_pk_fp8_f32(y1[2], y1[3], w1, true);
                    *(u32x2*)(YE + (size_t)row * 1024 + c0 + bj * 128) = (u32x2){(unsigned)w0, (unsigned)w1};
                }
            }
    }
};

__device__ __forceinline__ void transpose_item(const float* W, int N, bf16* WT, int drow0, LAS float* scr, int k0, int n0, int lane) {
    float ld_[32];
#pragma unroll
    for (int i = 0; i < 32; ++i) { const int kk = 2 * i + (lane >> 5); ld_[i] = __builtin_nontemporal_load(W + (size_t)(k0 + kk) * N + n0 + (lane & 31)); }
#pragma unroll
    for (int i = 0; i < 32; ++i) { const int kk = 2 * i + (lane >> 5); scr[kk * 33 + (lane & 31)] = ld_[i]; }
    LDS_WAIT(); asm volatile("" ::: "memory");
    const int c = lane & 7;
#pragma unroll
    for (int j = 0; j < 4; ++j) { const int n = (lane >> 3) + 8 * j; const LAS float* s = scr + (8 * c) * 33 + n;
        u32x4 o; o.x = cvtpk(s[0 * 33], s[1 * 33]); o.y = cvtpk(s[2 * 33], s[3 * 33]); o.z = cvtpk(s[4 * 33], s[5 * 33]); o.w = cvtpk(s[6 * 33], s[7 * 33]);
        *(u32x4*)(WT + (size_t)(drow0 + n) * 1024 + k0 + 8 * c) = o; }
    LDS_WAIT(); asm volatile("" ::: "memory");
}
template <bool GLU>
__device__ __forceinline__ void transpose_item_fp8(const float* W, int N, unsigned char* W8, LAS float* scr, int k0, int n0, int lane) {
    float ld_[32];
#pragma unroll
    for (int i = 0; i < 32; ++i) { const int kk = 2 * i + (lane >> 5); ld_[i] = __builtin_nontemporal_load(W + (size_t)(k0 + kk) * N + n0 + (lane & 31)); }
#pragma unroll
    for (int i = 0; i < 32; ++i) { const int kk = 2 * i + (lane >> 5); scr[kk * 33 + (lane & 31)] = ld_[i]; }
    LDS_WAIT(); asm volatile("" ::: "memory");
    const int c = lane & 3;
#pragma unroll
    for (int j = 0; j < 2; ++j) { const int n = (lane >> 2) + 16 * j; const LAS float* s = scr + (16 * c) * 33 + n;
        int w[4];
#pragma unroll
        for (int q = 0; q < 4; ++q) { int t = 0; t = __builtin_amdgcn_cvt_pk_fp8_f32(s[(4 * q) * 33] * 32.0f, s[(4 * q + 1) * 33] * 32.0f, t, false); t = __builtin_amdgcn_cvt_pk_fp8_f32(s[(4 * q + 2) * 33] * 32.0f, s[(4 * q + 3) * 33] * 32.0f, t, true); w[q] = t; }
        const int col = n0 + n; const int p = col >> 1;
        const int drow = GLU ? ((p >> 7) * 256 + (col & 1) * 128 + (p & 127)) : col;
        *(u32x4*)(W8 + (size_t)drow * 1024 + k0 + 16 * c) = (u32x4){(unsigned)w[0], (unsigned)w[1], (unsigned)w[2], (unsigned)w[3]}; }
    LDS_WAIT(); asm volatile("" ::: "memory");
}
struct ConvItem { const float* W; unsigned char* W8; int N, k0, n0; bool glu; bool hperm; };
__device__ __forceinline__ ConvItem conv_decode(int it, const float* w1, const float* w2, unsigned char* W1_8, unsigned char* W2_8) {
    ConvItem c;
    if (it < 32768) { const int e = it >> 10, rr = it & 1023, nb = rr & 63, kb = rr >> 6; c.W = w1 + (size_t)e * 1024 * 2048; c.W8 = W1_8 + (size_t)e * 2048 * 1024; c.N = 2048; c.k0 = kb * 64; c.n0 = nb * 32; c.glu = true; c.hperm = false; }
    else { const int r = it - 32768, e = r >> 9, rr = r & 511, nb = rr & 31, kb = rr >> 5; c.W = w2 + (size_t)e * 1024 * 1024; c.W8 = W2_8 + (size_t)e * 1024 * 1024; c.N = 1024; c.k0 = kb * 64; c.n0 = nb * 32; c.glu = false; c.hperm = false; }
    return c;
}
__device__ __forceinline__ void conv_load(const ConvItem& c, f32x4 (&r)[8], int lane) {
    const float* base = c.W + (size_t)c.k0 * c.N + c.n0;
    const int lo = (lane >> 3) * c.N + (lane & 7) * 4;
#pragma unroll
    for (int i = 0; i < 8; ++i) r[i] = __builtin_nontemporal_load((const f32x4*)(base + (size_t)(8 * i) * c.N + lo));
}
__device__ __forceinline__ void conv_finish(const ConvItem& c, const f32x4 (&r)[8], LAS float* scr, int lane) {
#pragma unroll
    for (int i = 0; i < 8; ++i) *(LAS f32x4*)(scr + (8 * i + (lane >> 3)) * 36 + (lane & 7) * 4) = r[i];
    LDS_WAIT(); asm volatile("" ::: "memory");
    if (c.glu) {
        const int n = lane & 31, half = lane >> 5; const LAS float* s = scr + (32 * half) * 36 + n;
        float v[32];
#pragma unroll
        for (int i = 0; i < 32; ++i) v[i] = s[i * 36];
        u32x4 p0, p1; fp6_pack32(v, p0, p1);
        const int col = c.n0 + n; const int p = col >> 1;
        const int drow = (p >> 7) * 256 + (col & 1) * 128 + (p & 127);
        unsigned char* dst = c.W8 + (size_t)drow * 1024 + (c.k0 >> 7) * 128 + 16 * (((c.k0 & 127) >> 5) + half);
        *(u32x4*)dst = p0; *(u32x4*)(dst + 64) = p1;
        LDS_WAIT(); asm volatile("" ::: "memory");
        return;
    }
    const int cc = lane & 3;
#pragma unroll
    for (int j = 0; j < 2; ++j) { const int n = (lane >> 2) + 16 * j; const LAS float* s = scr + (16 * cc) * 36 + n;
        int w[4];
#pragma unroll
        for (int q = 0; q < 4; ++q) { int t = 0; t = __builtin_amdgcn_cvt_pk_fp8_f32(s[(4 * q) * 36] * 32.0f, s[(4 * q + 1) * 36] * 32.0f, t, false); t = __builtin_amdgcn_cvt_pk_fp8_f32(s[(4 * q + 2) * 36] * 32.0f, s[(4 * q + 3) * 36] * 32.0f, t, true); w[q] = t; }
        const int col = c.n0 + n; const int p = col >> 1;
        const int drow = c.hperm ? ((col >> 8) * 256 + ((col & 63) >> 5) * 128 + ((col >> 6) & 3) * 32 + (col & 31)) : col;
        *(u32x4*)(c.W8 + (size_t)drow * 1024 + c.k0 + 16 * cc) = (u32x4){(unsigned)w[0], (unsigned)w[1], (unsigned)w[2], (unsigned)w[3]}; }
    LDS_WAIT(); asm volatile("" ::: "memory");
}
__device__ __forceinline__ void convert_chunk(int chunk, const float* w1, const float* w2, unsigned char* W1_8, unsigned char* W2_8, LAS float* scr, int wave, int lane) {
    const int base = chunk * 32 + wave;
    f32x4 ra[8], rb[8];
    ConvItem ca = conv_decode(base, w1, w2, W1_8, W2_8), cb;
    conv_load(ca, ra, lane);
#pragma unroll 1
    for (int j = 0; j < 4; j += 2) {
        cb = conv_decode(base + 8 * (j + 1), w1, w2, W1_8, W2_8); conv_load(cb, rb, lane);
        conv_finish(ca, ra, scr, lane);
        if (j + 2 < 4) { ca = conv_decode(base + 8 * (j + 2), w1, w2, W1_8, W2_8); conv_load(ca, ra, lane); }
        conv_finish(cb, rb, scr, lane);
    }
}
__device__ __forceinline__ int headperm_row(int n0) { const int pn = n0 >> 8, c = n0 & 255, hh = c >> 6, dh = (c & 63) >> 5; return pn * 256 + dh * 128 + hh * 32; }
__device__ __forceinline__ void rms_row_to_bf16(const float* xrow, const float* gain, bf16* orow, int lane) {
    const f32x4* xr = (const f32x4*)xrow + lane; const f32x4* gr = (const f32x4*)gain + lane;
    f32x4 v[4]; float s = 0.f;
#pragma unroll
    for (int j = 0; j < 4; ++j) { v[j] = xr[64 * j]; s += (v[j].x * v[j].x + v[j].y * v[j].y) + (v[j].z * v[j].z + v[j].w * v[j].w); }
    const float rstd = 1.0f / sqrtf(wave_sum(s) * (1.f / DM) + EPS);
    u32x2* o8 = (u32x2*)orow + lane;
#pragma unroll
    for (int j = 0; j < 4; ++j) { const f32x4 gg = gr[64 * j]; u32x2 w; w.x = cvtpk(v[j].x * rstd * gg.x, v[j].y * rstd * gg.y); w.y = cvtpk(v[j].z * rstd * gg.z, v[j].w * rstd * gg.w); o8[64 * j] = w; }
}

__device__ __forceinline__ void rms_row2_to_bf16(const float* xrow, const float* gain, bf16* orow, int lane, float* irs, unsigned char* o8row) {
    const f32x4* xr = (const f32x4*)xrow + lane; const f32x4* gr = (const f32x4*)gain + lane;
    f32x4 v[8]; float s0 = 0.f, s1 = 0.f;
#pragma unroll
    for (int j = 0; j < 8; ++j) v[j] = __builtin_nontemporal_load(xr + 64 * j);
#pragma unroll
    for (int j = 0; j < 4; ++j) { s0 += (v[j].x * v[j].x + v[j].y * v[j].y) + (v[j].z * v[j].z + v[j].w * v[j].w); s1 += (v[4 + j].x * v[4 + j].x + v[4 + j].y * v[4 + j].y) + (v[4 + j].z * v[4 + j].z + v[4 + j].w * v[4 + j].w); }
    const float q0 = sqrtf(wave_sum(s0) * (1.f / DM) + EPS), q1 = sqrtf(wave_sum(s1) * (1.f / DM) + EPS); const float r0 = 1.0f / q0, r1 = 1.0f / q1;
    if (irs != nullptr && lane == 0) { irs[0] = q0; irs[1] = q1; }
    u32x2* o8 = (u32x2*)orow + lane;
#pragma unroll
    for (int j = 0; j < 4; ++j) { const f32x4 gg = gr[64 * j]; u32x2 w; w.x = cvtpk(v[j].x * r0 * gg.x, v[j].y * r0 * gg.y); w.y = cvtpk(v[j].z * r0 * gg.z, v[j].w * r0 * gg.w); o8[64 * j] = w;
        u32x2 w2; w2.x = cvtpk(v[4 + j].x * r1 * gg.x, v[4 + j].y * r1 * gg.y); w2.y = cvtpk(v[4 + j].z * r1 * gg.z, v[4 + j].w * r1 * gg.w); o8[256 + 64 * j] = w2;
        int t0 = 0, t1 = 0;
        t0 = __builtin_amdgcn_cvt_pk_fp8_f32(v[j].x * r0 * gg.x, v[j].y * r0 * gg.y, t0, false); t0 = __builtin_amdgcn_cvt_pk_fp8_f32(v[j].z * r0 * gg.z, v[j].w * r0 * gg.w, t0, true);
        t1 = __builtin_amdgcn_cvt_pk_fp8_f32(v[4 + j].x * r1 * gg.x, v[4 + j].y * r1 * gg.y, t1, false); t1 = __builtin_amdgcn_cvt_pk_fp8_f32(v[4 + j].z * r1 * gg.z, v[4 + j].w * r1 * gg.w, t1, true);
        ((int*)o8row + lane)[64 * j] = t0; ((int*)o8row + lane)[256 + 64 * j] = t1; }
}

#include <hip/hip_bf16.h>
namespace attn_body {
using s16x4=__attribute__((ext_vector_type(4)))short;
using f32x16=__attribute__((ext_vector_type(16)))float;
constexpr int D=64,NW=8,QBLK=32,QB=QBLK*NW,KVBLK=64;
__device__ __forceinline__ int crow(int r,int hi){return (r&3)+8*(r>>2)+4*hi;}
#define SBAR() __builtin_amdgcn_sched_barrier(0)
__device__ __forceinline__ void cmask(f32x16&p0,f32x16&p1,int jb,int qrel,int hi){
  const float NEG=-INFINITY; int kb=64*jb+4*hi;
  #pragma unroll
  for(int r=0;r<16;++r){int kv=kb+(r&3)+8*(r>>2); if(kv>qrel)p0[r]=NEG; if(kv+32>qrel)p1[r]=NEG;}
}
constexpr int NSLOT=3, SLOTB=8192;
constexpr int LDS_K=0, LDS_V=NSLOT*SLOTB, LDS_WS=2*NSLOT*SLOTB, LDS_OST=LDS_WS+NW*64*4, ATT_LDS_BYTES=LDS_OST+NW*4096;
__device__ __forceinline__ void glds16(const void*gsrc,unsigned lds_dst){unsigned keep;
  asm volatile("s_mov_b32 %0, m0\n\ts_mov_b32 m0, %2\n\ts_nop 0\n\tglobal_load_lds_dwordx4 %1, off\n\ts_mov_b32 m0, %0":"=&s"(keep):"v"(gsrc),"s"(lds_dst):"memory");}
__device__ __forceinline__ float max3f(float a,float b,float c){float r;asm("v_max3_f32 %0, %1, %2, %3":"=v"(r):"v"(a),"v"(b),"v"(c));return r;}
__device__ __forceinline__ float max2f(float a,float b){float r;asm("v_max_f32_e32 %0, %1, %2":"=v"(r):"v"(a),"v"(b));return r;}
__device__ __forceinline__ float fadd_s(float a,float b){float r;asm("v_add_f32_e32 %0, %1, %2":"=v"(r):"v"(a),"v"(b));return r;}
__device__ __forceinline__ float fsub_s(float a,float b){float r;asm("v_sub_f32_e32 %0, %1, %2":"=v"(r):"v"(a),"v"(b));return r;}
__device__ __forceinline__ unsigned cvtpk_s(float lo,float hi){return cvtpk(lo,hi);}
#define WAIT_BAR(N) asm volatile("s_waitcnt vmcnt(" #N ") lgkmcnt(0)\n\ts_barrier":::"memory")
__device__ __forceinline__ void qkt(f32x16&p0,f32x16&p1,const char*Kslot,const bf16x8*qr,const f32x16&negm,int r32,int hi){
  const char*kb=Kslot+hi*1024+r32*16;
  #pragma unroll
  for(int d0=0;d0<4;++d0){
    const bf16x8 b0=*reinterpret_cast<const bf16x8*>(kb+d0*2048);
    const bf16x8 b1=*reinterpret_cast<const bf16x8*>(kb+d0*2048+512);
    if(d0==0){p0=__builtin_amdgcn_mfma_f32_32x32x16_bf16(b0,qr[0],negm,0,0,0);p1=__builtin_amdgcn_mfma_f32_32x32x16_bf16(b1,qr[0],negm,0,0,0);}
    else{p0=__builtin_amdgcn_mfma_f32_32x32x16_bf16(b0,qr[d0],p0,0,0,0);p1=__builtin_amdgcn_mfma_f32_32x32x16_bf16(b1,qr[d0],p1,0,0,0);}}
}
typedef __attribute__((address_space(3))) const char* lds_cptr;
typedef short v4i16_t __attribute__((ext_vector_type(4)));
__device__ __forceinline__ void kload8(bf16x8*kf,lds_cptr kp){
  kf[0]=*(const __attribute__((address_space(3))) bf16x8*)(kp);      kf[1]=*(const __attribute__((address_space(3))) bf16x8*)(kp+512);
  kf[2]=*(const __attribute__((address_space(3))) bf16x8*)(kp+2048); kf[3]=*(const __attribute__((address_space(3))) bf16x8*)(kp+2560);
  kf[4]=*(const __attribute__((address_space(3))) bf16x8*)(kp+4096); kf[5]=*(const __attribute__((address_space(3))) bf16x8*)(kp+4608);
  kf[6]=*(const __attribute__((address_space(3))) bf16x8*)(kp+6144); kf[7]=*(const __attribute__((address_space(3))) bf16x8*)(kp+6656);
}
__device__ __forceinline__ void kload2(bf16x8*kf,lds_cptr kp,int j){ kf[2*j]=*(const __attribute__((address_space(3))) bf16x8*)(kp+j*2048); kf[2*j+1]=*(const __attribute__((address_space(3))) bf16x8*)(kp+j*2048+512); }
__device__ __forceinline__ s16x4 vtr(lds_cptr p){ return __builtin_bit_cast(s16x4,__builtin_amdgcn_ds_read_tr16_b64_v4i16((__attribute__((address_space(3))) v4i16_t*)p)); }
__device__ __forceinline__ float rowmax(const f32x16&p0,const f32x16&p1){
  float a=max3f(p0[0],p0[1],p1[0]),b=max3f(p0[2],p0[3],p1[1]);a=max3f(a,p1[2],p1[3]);
  #pragma unroll
  for(int r=4;r<16;r+=4){a=max3f(a,p0[r],p0[r+1]);b=max3f(b,p0[r+2],p0[r+3]);a=max3f(a,p1[r],p1[r+1]);b=max3f(b,p1[r+2],p1[r+3]);}
  const float m=max2f(a,b);
  auto rr=__builtin_amdgcn_permlane32_swap(__float_as_uint(m),__float_as_uint(m),false,false);
  return max2f(__uint_as_float(rr[0]),__uint_as_float(rr[1]));
}
__device__ __forceinline__ void pv(f32x16*o,int vb,bf16x8 pa0,bf16x8 pa1,bf16x8 pa2,bf16x8 pa3){
  #pragma unroll
  for(int d0=0;d0<2;++d0){s16x4 lo[4],hi[4];
    #pragma unroll
    for(int ks=0;ks<4;++ks){
      asm volatile("ds_read_b64_tr_b16 %0,%1 offset:%c2":"=&v"(lo[ks]):"v"(vb),"i"(d0*4096+ks*1024):"memory");
      asm volatile("ds_read_b64_tr_b16 %0,%1 offset:%c2":"=&v"(hi[ks]):"v"(vb),"i"(d0*4096+ks*1024+512):"memory");}
    asm volatile("s_waitcnt lgkmcnt(0)":::"memory");SBAR();
    #define PK(k) (bf16x8){lo[k][0],lo[k][1],lo[k][2],lo[k][3],hi[k][0],hi[k][1],hi[k][2],hi[k][3]}
    o[d0]=__builtin_amdgcn_mfma_f32_32x32x16_bf16(pa0,PK(0),o[d0],0,0,0);
    o[d0]=__builtin_amdgcn_mfma_f32_32x32x16_bf16(pa1,PK(1),o[d0],0,0,0);
    o[d0]=__builtin_amdgcn_mfma_f32_32x32x16_bf16(pa2,PK(2),o[d0],0,0,0);
    o[d0]=__builtin_amdgcn_mfma_f32_32x32x16_bf16(pa3,PK(3),o[d0],0,0,0);
    #undef PK
  }
}
template<int THRL,int KP,int OP,bool MOBA> __device__ __forceinline__ void attn_unit(const bf16*Qu,const bf16*__restrict__ Kh,const bf16*__restrict__ Vh,bf16*Ou,const int NT,const int nblk,const float*kmean,char*shm){
  const int tid=opaque((int)threadIdx.x),lane=tid&63,r32=lane&31,hi=lane>>5; const int wid=__builtin_amdgcn_readfirstlane(tid>>6);
  const bf16*Qw=Qu+(long)(wid*QBLK)*KP;
  const unsigned lds0=(unsigned)(uintptr_t)shm;
  float*wsf=(float*)(shm+LDS_WS)+wid*64;
  const bf16*ksrc=Kh+(long)lane*KP+wid*8;
  const bf16*vsrc=Vh+(long)(16*(wid&3)+(lane>>2))*KP+(wid>>2)*32+(lane&3)*8;
  const unsigned kdst=lds0+LDS_K+wid*1024, vdst=lds0+LDS_V+wid*1024;
  #define DMA_K(t,slot) glds16(ksrc+(long)(t)*KVBLK*KP,(unsigned)__builtin_amdgcn_readfirstlane(kdst+(slot)))
  #define DMA_V(t,slot) glds16(vsrc+(long)(t)*KVBLK*KP,(unsigned)__builtin_amdgcn_readfirstlane(vdst+(slot)))
  const int vb0=(int)(lds0+LDS_V)+((lane>>4)&1)*32+(lane&3)*8+(4*hi+((lane&15)>>2))*64;
  const char*Kbase=shm+LDS_K; bf16x8 kf[8];
  const lds_cptr shm3=(lds_cptr)shm; const lds_cptr kp0=shm3+LDS_K+hi*1024+r32*16; const lds_cptr vp0=shm3+LDS_V+((lane>>4)&1)*32+(lane&3)*8+(4*hi+((lane&15)>>2))*64;
  DMA_K(0,0);DMA_V(0,0);DMA_K(1,SLOTB);
  bf16x8 qr[4];
  #pragma unroll
  for(int d0=0;d0<4;++d0)qr[d0]=*reinterpret_cast<const bf16x8*>(&Qw[(long)r32*KP+d0*16+hi*8]);
  unsigned bmask=0xffffffffu;
  if(MOBA){
    bmask=1u<<nblk;
    float g0=-3e38f,g1=-3e38f,g2=-3e38f; int i0=-1,i1=-1,i2=-1;
    for(int j=0;j<nblk;++j){
      const float*km=kmean+(long)j*512+8*hi; float g=0.f;
      #pragma unroll
      for(int d0=0;d0<4;++d0){ const f32x4 a=*(const f32x4*)(km+16*d0),b=*(const f32x4*)(km+16*d0+4);
        g+=bf2f((unsigned short)qr[d0][0])*a[0]+bf2f((unsigned short)qr[d0][1])*a[1]+bf2f((unsigned short)qr[d0][2])*a[2]+bf2f((unsigned short)qr[d0][3])*a[3];
        g+=bf2f((unsigned short)qr[d0][4])*b[0]+bf2f((unsigned short)qr[d0][5])*b[1]+bf2f((unsigned short)qr[d0][6])*b[2]+bf2f((unsigned short)qr[d0][7])*b[3]; }
      g+=__shfl_xor(g,32);
      if(g>g0){g2=g1;i2=i1;g1=g0;i1=i0;g0=g;i0=j;} else if(g>g1){g2=g1;i2=i1;g1=g;i1=j;} else if(g>g2){g2=g;i2=j;}
    }
    if(i0>=0)bmask|=1u<<i0; if(i1>=0)bmask|=1u<<i1; if(i2>=0)bmask|=1u<<i2;
  }
  #define NEGM_FOR(t) (MOBA ? (((bmask>>((t)>>2))&1u) ? -mhat : -INFINITY) : -mhat)
  float mhat=0.f,l_reg=0.f;f32x16 o[2];o[0]=f32x16{};o[1]=f32x16{};f32x16 negm;
  { const float nm=NEGM_FOR(0);
    #pragma unroll
    for(int r=0;r<16;++r)negm[r]=nm; }
  asm volatile("":"+v"(negm));
  const int qrel=wid*QBLK+r32;
  #define CMASK(P0,P1,t) do{ if(MOBA){int jb_=(t)-(NT-4); if(jb_>=0)cmask(P0,P1,jb_,qrel,hi);} }while(0)
  bool resc=false;
  #define START(P0,P1) do{ const float rm=rowmax(P0,P1); resc=false; \
    { const float dl=(MOBA&&rm==-INFINITY)?0.f:rm; mhat=fadd_s(mhat,dl); \
      _Pragma("unroll") for(int r=0;r<16;++r){P0[r]=fsub_s(P0[r],dl);P1[r]=fsub_s(P1[r],dl);} \
      { const float nm=NEGM_FOR(1); _Pragma("unroll") for(int r=0;r<16;++r)negm[r]=nm; } asm volatile("":"+v"(negm)); } \
    _Pragma("unroll") for(int r=0;r<16;++r)P0[r]=__builtin_amdgcn_exp2f(P0[r]); }while(0)
  #define RESC() do{ if(resc){ asm volatile("s_waitcnt lgkmcnt(0)":::"memory"); \
      _Pragma("unroll") for(int d_=0;d_<2;++d_) _Pragma("unroll") for(int r=0;r<16;++r)o[d_][r]*=wsf[crow(r,hi)]; } }while(0)
  f32x16 pA0,pA1,pB0,pB1;
  int sl_prev=0,sl_cur=0,sl_next=SLOTB;
  #define ROT() do{sl_prev=sl_cur;sl_cur=sl_next;sl_next=(sl_next==(NSLOT-1)*SLOTB)?0:sl_next+SLOTB;}while(0)
  DMA_K(2,2*SLOTB);
  WAIT_BAR(3);
  qkt(pA0,pA1,Kbase,qr,negm,r32,hi);asm volatile("s_nop 15\n\ts_nop 7":"+v"(pA0),"+v"(pA1));CMASK(pA0,pA1,0);
  START(pA0,pA1);
  _Pragma("unroll") for(int r=0;r<16;++r)pA1[r]=__builtin_amdgcn_exp2f(pA1[r]);
  WAIT_BAR(0);
  DMA_K(3,0);DMA_V(1,SLOTB);
  ROT();
  kload8(kf,kp0+sl_cur);
  WAIT_BAR(2);
  s16x4 vlo[8],vhi[8]; u32x4 pw0,pw1,pw2,pw3;
  #define PKW(P,B) cvtpk_s(P[B],P[B+1])
  #define PAF(k) __builtin_bit_cast(bf16x8,pw##k)
  #define VFR(i) (bf16x8){vlo[i][0],vlo[i][1],vlo[i][2],vlo[i][3],vhi[i][0],vhi[i][1],vhi[i][2],vhi[i][3]}
  #define PIN(x) asm volatile("":"+v"(x))
  #define MX3(a,b,c) __builtin_fmaxf(__builtin_fmaxf((a),(b)),(c))
  #define GAPA(MF,A0,A1,A2,A3,W0,W1,PW) do{ MF; sacc+=A0; sacc+=A1; sacc+=A2; sacc+=A3; PIN(sacc); W0; W1; PIN(PW); SBAR(); }while(0)
  #define EX(v) __builtin_amdgcn_exp2f(v)
  #define GAPB(MF,X,B) do{ MF; X[B]=EX(X[B]); X[B+1]=EX(X[B+1]); X[B+2]=EX(X[B+2]); X[B+3]=EX(X[B+3]); PIN(X); SBAR(); }while(0)
  #define VRD(i) do{ vlo[i]=vtr(vp_+(((i)>>2)*4096+((i)&3)*1024)); vhi[i]=vtr(vp_+(((i)>>2)*4096+((i)&3)*1024+512)); }while(0)
  #define KRD(G,j) do{ if(G){ kload2(kf,kp0+sl_next,j); SBAR(); } }while(0)
  #define STEP(C0,C1,P0,P1,t,GK,GV,GL) do{ SBAR(); \
    const lds_cptr vp_=vp0+sl_prev; \
    VRD(0); SBAR(); float sacc=(P0[0]+P0[1]); \
    GAPA(C0=__builtin_amdgcn_mfma_f32_32x32x16_bf16(kf[0],qr[0],negm,0,0,0), P0[2],P0[3],P0[4],P0[5],     pw0[0]=PKW(P0,0), pw0[1]=PKW(P0,2), pw0); \
    VRD(4); SBAR(); GAPA(C1=__builtin_amdgcn_mfma_f32_32x32x16_bf16(kf[1],qr[0],negm,0,0,0), P0[6],P0[7],P0[8],P0[9],     pw0[2]=PKW(P0,4), pw0[3]=PKW(P0,6), pw0); \
    VRD(1); SBAR(); GAPA(C0=__builtin_amdgcn_mfma_f32_32x32x16_bf16(kf[2],qr[1],C0,0,0,0),   P0[10],P0[11],P0[12],P0[13], pw1[0]=PKW(P0,8), pw1[1]=PKW(P0,10), pw1); \
    VRD(5); SBAR(); GAPA(C1=__builtin_amdgcn_mfma_f32_32x32x16_bf16(kf[3],qr[1],C1,0,0,0),   P0[14],P0[15],P1[0],P1[1],   pw1[2]=PKW(P0,12),pw1[3]=PKW(P0,14), pw1); \
    VRD(2); SBAR(); GAPA(C0=__builtin_amdgcn_mfma_f32_32x32x16_bf16(kf[4],qr[2],C0,0,0,0),   P1[2],P1[3],P1[4],P1[5],     pw2[0]=PKW(P1,0), pw2[1]=PKW(P1,2), pw2); \
    VRD(6); SBAR(); GAPA(C1=__builtin_amdgcn_mfma_f32_32x32x16_bf16(kf[5],qr[2],C1,0,0,0),   P1[6],P1[7],P1[8],P1[9],     pw2[2]=PKW(P1,4), pw2[3]=PKW(P1,6), pw2); \
    VRD(3); SBAR(); GAPA(C0=__builtin_amdgcn_mfma_f32_32x32x16_bf16(kf[6],qr[3],C0,0,0,0),   P1[10],P1[11],P1[12],P1[13], pw3[0]=PKW(P1,8), pw3[1]=PKW(P1,10), pw3); \
    VRD(7); SBAR(); GAPA(C1=__builtin_amdgcn_mfma_f32_32x32x16_bf16(kf[7],qr[3],C1,0,0,0),   P1[14],P1[15],0.f,0.f,       pw3[2]=PKW(P1,12),pw3[3]=PKW(P1,14), pw3); \
    l_reg+=sacc; \
    if(GK){DMA_K((t)+3,sl_cur);} if(GV){DMA_V((t)+1,sl_next);} \
    CMASK(C0,C1,t); \
    { float a=MX3(C0[0],C0[1],C1[0]),b=MX3(C0[2],C0[3],C1[1]); a=MX3(a,C1[2],C1[3]); \
      _Pragma("unroll") for(int r=4;r<16;r+=4){a=MX3(a,C0[r],C0[r+1]);b=MX3(b,C0[r+2],C0[r+3]);a=MX3(a,C1[r],C1[r+1]);b=MX3(b,C1[r+2],C1[r+3]);} \
      float rm=__builtin_fmaxf(a,b); { auto rr=__builtin_amdgcn_permlane32_swap(__float_as_uint(rm),__float_as_uint(rm),false,false); rm=__builtin_fmaxf(__uint_as_float(rr[0]),__uint_as_float(rr[1])); } \
      resc=false; \
      if(__builtin_expect(__any(rm>(float)THRL),0)){ const float dl=__builtin_fmaxf(rm,0.f); mhat+=dl; \
        _Pragma("unroll") for(int r=0;r<16;++r){C0[r]-=dl;C1[r]-=dl;} \
        if(!MOBA){ _Pragma("unroll") for(int r=0;r<16;++r)negm[r]=-mhat; asm volatile("":"+v"(negm)); } \
        const float f=__builtin_amdgcn_exp2f(-dl); l_reg*=f; if(hi==0)wsf[r32]=f; resc=true; } \
      if(MOBA){ if(resc||((((t)+1)&3)==0)){ const float nm=NEGM_FOR((t)+1); _Pragma("unroll") for(int r=0;r<16;++r)negm[r]=nm; asm volatile("":"+v"(negm)); } } } \
    SBAR(); \
    GAPB(o[0]=__builtin_amdgcn_mfma_f32_32x32x16_bf16(PAF(0),VFR(0),o[0],0,0,0), C0,0); \
    GAPB(o[1]=__builtin_amdgcn_mfma_f32_32x32x16_bf16(PAF(0),VFR(4),o[1],0,0,0), C0,4); \
    KRD(GL,0); GAPB(o[0]=__builtin_amdgcn_mfma_f32_32x32x16_bf16(PAF(1),VFR(1),o[0],0,0,0), C0,8); \
    KRD(GL,1); GAPB(o[1]=__builtin_amdgcn_mfma_f32_32x32x16_bf16(PAF(1),VFR(5),o[1],0,0,0), C0,12); \
    KRD(GL,2); GAPB(o[0]=__builtin_amdgcn_mfma_f32_32x32x16_bf16(PAF(2),VFR(2),o[0],0,0,0), C1,0); \
    KRD(GL,3); GAPB(o[1]=__builtin_amdgcn_mfma_f32_32x32x16_bf16(PAF(2),VFR(6),o[1],0,0,0), C1,4); \
    GAPB(o[0]=__builtin_amdgcn_mfma_f32_32x32x16_bf16(PAF(3),VFR(3),o[0],0,0,0), C1,8); \
    GAPB(o[1]=__builtin_amdgcn_mfma_f32_32x32x16_bf16(PAF(3),VFR(7),o[1],0,0,0), C1,12); \
    }while(0)
  int t=1;
  #undef CMASK
  #define CMASK(P0,P1,t) do{}while(0)
  for(;t+5<NT;t+=2){
    STEP(pB0,pB1,pA0,pA1,t,true,true,true);     WAIT_BAR(2); RESC(); ROT();
    STEP(pA0,pA1,pB0,pB1,t+1,true,true,true);   WAIT_BAR(2); RESC(); ROT();
  }
  #undef CMASK
  #define CMASK(P0,P1,t) do{ if(MOBA){int jb_=(t)-(NT-4); if(jb_>=0)cmask(P0,P1,jb_,qrel,hi);} }while(0)
  #define ENDW(tt) do{ if((tt)+3<NT){WAIT_BAR(2);} else if((tt)+2<NT){WAIT_BAR(1);} else {WAIT_BAR(0);} }while(0)
  for(;t+1<NT;t+=2){
    STEP(pB0,pB1,pA0,pA1,t,(t+3<NT),(t+1<NT),(t+1<NT));       ENDW(t);   RESC(); ROT();
    STEP(pA0,pA1,pB0,pB1,t+1,(t+4<NT),(t+2<NT),(t+2<NT));     ENDW(t+1); RESC(); ROT();
  }
  STEP(pB0,pB1,pA0,pA1,NT-1,false,false,false); RESC();
  { float sacc=pB0[0]+pB0[1]; _Pragma("unroll") for(int r=2;r<16;++r)sacc+=pB0[r]; _Pragma("unroll") for(int r=0;r<16;++r)sacc+=pB1[r]; l_reg+=sacc;
    pw0=(u32x4){PKW(pB0,0),PKW(pB0,2),PKW(pB0,4),PKW(pB0,6)};pw1=(u32x4){PKW(pB0,8),PKW(pB0,10),PKW(pB0,12),PKW(pB0,14)};pw2=(u32x4){PKW(pB1,0),PKW(pB1,2),PKW(pB1,4),PKW(pB1,6)};pw3=(u32x4){PKW(pB1,8),PKW(pB1,10),PKW(pB1,12),PKW(pB1,14)};
    SBAR(); pv(o,vb0+sl_cur,PAF(0),PAF(1),PAF(2),PAF(3)); }
  #undef PKW
  #undef PAF
  #undef VFR
  #undef PIN
  #undef MX3
  #undef GAPA
  #undef GAPB
  #undef EX
  #undef VRD
  #undef KRD
  #undef STEP
  #undef ENDW
  {auto rr=__builtin_amdgcn_permlane32_swap(__float_as_uint(l_reg),__float_as_uint(l_reg),false,false);l_reg=__uint_as_float(rr[0])+__uint_as_float(rr[1]);}
  if(hi==0)wsf[32+r32]=l_reg;asm volatile("s_waitcnt lgkmcnt(0)":::"memory");
  float rli[16];
  #pragma unroll
  for(int r=0;r<16;++r)rli[r]=__builtin_amdgcn_rcpf(wsf[32+crow(r,hi)]);
  bf16*Ow=Ou+(long)(wid*QBLK)*OP;
  { bf16*stg=(bf16*)(shm+LDS_OST)+wid*2048;
    #pragma unroll
    for(int r=0;r<16;++r){const int orow=crow(r,hi);
      #pragma unroll
      for(int d0=0;d0<2;++d0)stg[orow*64+d0*32+r32]=(bf16)(cvtpk(o[d0][r]*rli[r],0.f)&0xffffu);}
    asm volatile("s_waitcnt lgkmcnt(0)":::"memory");
    #pragma unroll
    for(int i=0;i<4;++i){const int row=i*8+(lane>>3),ch=lane&7; const u32x4 v=*(const u32x4*)(stg+row*64+ch*8); *(u32x4*)(Ow+(long)row*OP+ch*8)=v;} }
  asm volatile("s_waitcnt lgkmcnt(0)\n\ts_barrier":::"memory");
  #undef DMA_K
  #undef DMA_V
  #undef CMASK
  #undef START
  #undef RESC
  #undef ROT
  #undef NEGM_FOR
}
#undef SBAR
#undef WAIT_BAR
}

namespace ret_body {
using attn_body::s16x4; using attn_body::f32x16; using attn_body::glds16; using attn_body::pv; using attn_body::crow;
constexpr int KVF_BYTES = 64 * 64 * 4;
__device__ __forceinline__ void kv_unit(const bf16* KR, const bf16* VR, float* KVF, int b, int h, int cp, char* shm) {
  const int tid = opaque((int)threadIdx.x), lane = tid & 63, r32 = lane & 31, hi = lane >> 5; const int wid = __builtin_amdgcn_readfirstlane(tid >> 6);
  const unsigned lds0 = (unsigned)(uintptr_t)shm;
  const size_t rowb = (size_t)b * SEQ + (size_t)cp * 256;
  const long voff = (long)(16 * (wid & 3) + (lane >> 2)) * 256 + h * 64 + (wid >> 2) * 32 + (lane & 3) * 8;
#pragma unroll
  for (int c = 0; c < 2; ++c)
#pragma unroll
    for (int tl = 0; tl < 2; ++tl) {
      const size_t r0 = rowb + c * 128 + tl * 64;
      glds16(KR + r0 * 256 + voff, (unsigned)__builtin_amdgcn_readfirstlane(lds0 + ((c * 2 + 0) * 2 + tl) * 8192 + wid * 1024));
      glds16(VR + r0 * 256 + voff, (unsigned)__builtin_amdgcn_readfirstlane(lds0 + ((c * 2 + 1) * 2 + tl) * 8192 + wid * 1024));
    }
  asm volatile("s_waitcnt vmcnt(0) lgkmcnt(0)\n\ts_barrier" ::: "memory");
  const int c = wid >> 2, dkb = (wid >> 1) & 1, dvb = wid & 1;
  const int vb = (int)lds0 + ((lane >> 4) & 1) * 32 + (lane & 3) * 8 + (4 * hi + ((lane & 15) >> 2)) * 64;
  f32x16 acc = f32x16{};
#pragma unroll
  for (int tl = 0; tl < 2; ++tl) {
    s16x4 alo[4], ahi[4], blo[4], bhi[4];
    const int ka = vb + ((c * 2 + 0) * 2 + tl) * 8192 + dkb * 4096, va = vb + ((c * 2 + 1) * 2 + tl) * 8192 + dvb * 4096;
#pragma unroll
    for (int ks = 0; ks < 4; ++ks) {
      asm volatile("ds_read_b64_tr_b16 %0,%1 offset:%c2" : "=&v"(alo[ks]) : "v"(ka), "i"(ks * 1024) : "memory");
      asm volatile("ds_read_b64_tr_b16 %0,%1 offset:%c2" : "=&v"(ahi[ks]) : "v"(ka), "i"(ks * 1024 + 512) : "memory");
      asm volatile("ds_read_b64_tr_b16 %0,%1 offset:%c2" : "=&v"(blo[ks]) : "v"(va), "i"(ks * 1024) : "memory");
      asm volatile("ds_read_b64_tr_b16 %0,%1 offset:%c2" : "=&v"(bhi[ks]) : "v"(va), "i"(ks * 1024 + 512) : "memory");
    }
    asm volatile("s_waitcnt lgkmcnt(0)" ::: "memory"); __builtin_amdgcn_sched_barrier(0);
#pragma unroll
    for (int ks = 0; ks < 4; ++ks) {
      const bf16x8 af = (bf16x8){alo[ks][0], alo[ks][1], alo[ks][2], alo[ks][3], ahi[ks][0], ahi[ks][1], ahi[ks][2], ahi[ks][3]};
      const bf16x8 bfr = (bf16x8){blo[ks][0], blo[ks][1], blo[ks][2], blo[ks][3], bhi[ks][0], bhi[ks][1], bhi[ks][2], bhi[ks][3]};
      acc = __builtin_amdgcn_mfma_f32_32x32x16_bf16(af, bfr, acc, 0, 0, 0);
    }
  }
  const float lgam = __builtin_amdgcn_logf(1.0f - __builtin_amdgcn_exp2f(-5.0f - (float)h));
  const float g127 = __builtin_amdgcn_exp2f(lgam * 127.0f);
  float* outp = KVF + ((size_t)((b * 4 + h) * 32 + cp * 2 + c)) * 4096 + dvb * 32 + r32;
#pragma unroll
  for (int r = 0; r < 16; ++r) outp[(size_t)(dkb * 32 + crow(r, hi)) * 64] = acc[r] * g127;
  asm volatile("s_waitcnt lgkmcnt(0)\n\ts_barrier" ::: "memory");
}

__device__ __forceinline__ void out_unit(const bf16* QR, const bf16* KR, const bf16* VR, const bf16* GR, const float* KVF, const float* rgain, bf16* Y, int b, int h, int cp, char* shm) {
  const int tid = opaque((int)threadIdx.x), lane = tid & 63, r32 = lane & 31, hi = lane >> 5; const int wid = __builtin_amdgcn_readfirstlane(tid >> 6);
  const unsigned lds0 = (unsigned)(uintptr_t)shm;
  constexpr int L_K = 0, L_V = 32768, L_S = 65536, L_O = 81920;
  const size_t rowb = (size_t)b * SEQ + (size_t)cp * 256;
  const long koff = (long)lane * 256 + h * 64 + wid * 8;
  const long voff = (long)(16 * (wid & 3) + (lane >> 2)) * 256 + h * 64 + (wid >> 2) * 32 + (lane & 3) * 8;
#pragma unroll
  for (int tl = 0; tl < 4; ++tl) {
    const size_t r0 = rowb + tl * 64;
    glds16(KR + r0 * 256 + koff, (unsigned)__builtin_amdgcn_readfirstlane(lds0 + L_K + tl * 8192 + wid * 1024));
    glds16(VR + r0 * 256 + voff, (unsigned)__builtin_amdgcn_readfirstlane(lds0 + L_V + tl * 8192 + wid * 1024));
  }
  {
    const float lgam = __builtin_amdgcn_logf(1.0f - __builtin_amdgcn_exp2f(-5.0f - (float)h));
    const float lgc = lgam * 128.0f;
    const int n0 = 2 * cp;
    int mlo = n0 - 1 - (int)(34.0f / (-lgc)); if (mlo < 0) mlo = 0;
    const float* kvp = KVF + ((size_t)((b * 4 + h) * 32)) * 4096 + tid * 8;
    f32x4 s0 = {0.f, 0.f, 0.f, 0.f}, s1 = {0.f, 0.f, 0.f, 0.f};
    int m = mlo;
    for (; m + 8 <= n0; m += 8) {
      f32x4 a[8], c4[8];
#pragma unroll
      for (int q = 0; q < 8; ++q) { a[q] = *(const f32x4*)(kvp + (size_t)(m + q) * 4096); c4[q] = *(const f32x4*)(kvp + (size_t)(m + q) * 4096 + 4); }
#pragma unroll
      for (int q = 0; q < 8; ++q) { const float w = __builtin_amdgcn_exp2f(lgc * (float)(n0 - 1 - m - q)); s0 += a[q] * w; s1 += c4[q] * w; }
    }
    for (; m + 4 <= n0; m += 4) {
      f32x4 a[4], c4[4];
#pragma unroll
      for (int q = 0; q < 4; ++q) { a[q] = *(const f32x4*)(kvp + (size_t)(m + q) * 4096); c4[q] = *(const f32x4*)(kvp + (size_t)(m + q) * 4096 + 4); }
#pragma unroll
      for (int q = 0; q < 4; ++q) { const float w = __builtin_amdgcn_exp2f(lgc * (float)(n0 - 1 - m - q)); s0 += a[q] * w; s1 += c4[q] * w; }
    }
    for (; m < n0; ++m) {
      const float w = __builtin_amdgcn_exp2f(lgc * (float)(n0 - 1 - m));
      const f32x4 a = *(const f32x4*)(kvp + (size_t)m * 4096), c4 = *(const f32x4*)(kvp + (size_t)m * 4096 + 4);
      s0 += a * w; s1 += c4 * w;
    }
    const int dk = tid >> 3, dv = 8 * (tid & 7);
    char* sp = shm + L_S + (dv >> 5) * 4096 + dk * 64 + (dv & 31) * 2;
    u32x4 w0; w0.x = cvtpk(s0[0], s0[1]); w0.y = cvtpk(s0[2], s0[3]); w0.z = cvtpk(s1[0], s1[1]); w0.w = cvtpk(s1[2], s1[3]);
    *(u32x4*)sp = w0;
    const float dc = __builtin_amdgcn_exp2f(lgc);
    const f32x4 a = *(const f32x4*)(kvp + (size_t)n0 * 4096), c4 = *(const f32x4*)(kvp + (size_t)n0 * 4096 + 4);
    s0 = s0 * dc + a; s1 = s1 * dc + c4;
    u32x4 w1; w1.x = cvtpk(s0[0], s0[1]); w1.y = cvtpk(s0[2], s0[3]); w1.z = cvtpk(s1[0], s1[1]); w1.w = cvtpk(s1[2], s1[3]);
    *(u32x4*)(sp + 8192) = w1;
  }
  const int c = wid >> 2, wq = wid & 3;
  const bf16* Qw = QR + (rowb + c * 128 + wq * 32 + r32) * 256 + h * 64;
  bf16x8 qr[4]; u32x4 qa[4];
#pragma unroll
  for (int d0 = 0; d0 < 4; ++d0) qr[d0] = *reinterpret_cast<const bf16x8*>(Qw + d0 * 16 + hi * 8);
#pragma unroll
  for (int k = 0; k < 4; ++k) { const u32x2 lo = *(const u32x2*)(Qw + 16 * k + 4 * hi), hi2 = *(const u32x2*)(Qw + 16 * k + 8 + 4 * hi); qa[k] = (u32x4){lo.x, lo.y, hi2.x, hi2.y}; }
  asm volatile("s_waitcnt vmcnt(0) lgkmcnt(0)\n\ts_barrier" ::: "memory");
  const int vb = (int)lds0 + ((lane >> 4) & 1) * 32 + (lane & 3) * 8 + (4 * hi + ((lane & 15) >> 2)) * 64;
  f32x16 o[2]; o[0] = f32x16{}; o[1] = f32x16{};
  pv(o, vb + L_S + c * 8192, __builtin_bit_cast(bf16x8, qa[0]), __builtin_bit_cast(bf16x8, qa[1]), __builtin_bit_cast(bf16x8, qa[2]), __builtin_bit_cast(bf16x8, qa[3]));
  { const float gam = 1.0f - __builtin_amdgcn_exp2f(-5.0f - (float)h);
#pragma unroll
    for (int d0 = 0; d0 < 2; ++d0)
#pragma unroll
      for (int r = 0; r < 16; ++r) o[d0][r] *= gam; }
  const f32x16 zero = f32x16{};
  const int irow = wq * 32 + r32;
  for (int tl = 0; tl <= (wq >> 1); ++tl) {
    f32x16 p0, p1;
    attn_body::qkt(p0, p1, shm + L_K + (c * 2 + tl) * 8192, qr, zero, r32, hi);
    asm volatile("s_nop 15\n\ts_nop 7" : "+v"(p0), "+v"(p1));
#pragma unroll
    for (int r = 0; r < 16; ++r) { const int kj = 64 * tl + crow(r, hi); if (kj > irow) p0[r] = 0.f; if (kj + 32 > irow) p1[r] = 0.f; }
    u32x4 pw0, pw1, pw2, pw3;
    pw0 = (u32x4){cvtpk(p0[0], p0[1]), cvtpk(p0[2], p0[3]), cvtpk(p0[4], p0[5]), cvtpk(p0[6], p0[7])}; pw1 = (u32x4){cvtpk(p0[8], p0[9]), cvtpk(p0[10], p0[11]), cvtpk(p0[12], p0[13]), cvtpk(p0[14], p0[15])};
    pw2 = (u32x4){cvtpk(p1[0], p1[1]), cvtpk(p1[2], p1[3]), cvtpk(p1[4], p1[5]), cvtpk(p1[6], p1[7])}; pw3 = (u32x4){cvtpk(p1[8], p1[9]), cvtpk(p1[10], p1[11]), cvtpk(p1[12], p1[13]), cvtpk(p1[14], p1[15])};
    __builtin_amdgcn_sched_barrier(0);
    pv(o, vb + L_V + (c * 2 + tl) * 8192, __builtin_bit_cast(bf16x8, pw0), __builtin_bit_cast(bf16x8, pw1), __builtin_bit_cast(bf16x8, pw2), __builtin_bit_cast(bf16x8, pw3));
  }
  asm volatile("s_waitcnt lgkmcnt(0)\n\ts_barrier" ::: "memory");
  { float* stg = (float*)(shm + L_O) + wid * 2048;
#pragma unroll
    for (int r = 0; r < 16; ++r) { const int orow = crow(r, hi);
#pragma unroll
      for (int d0 = 0; d0 < 2; ++d0) stg[orow * 64 + d0 * 32 + r32] = o[d0][r]; }
    asm volatile("s_waitcnt lgkmcnt(0)" ::: "memory");
    const int row = lane >> 1, half = lane & 1;
    const f32x4* sr = (const f32x4*)(stg + row * 64 + half * 32);
    f32x4 v[8]; float ss = 0.f;
#pragma unroll
    for (int i = 0; i < 8; ++i) { v[i] = sr[i]; ss += (v[i][0] * v[i][0] + v[i][1] * v[i][1]) + (v[i][2] * v[i][2] + v[i][3] * v[i][3]); }
    ss += __shfl_xor(ss, 1);
    const float rstd = 1.0f / sqrtf(ss * (1.0f / 64.0f) + EPS);
    const size_t grow = rowb + c * 128 + wq * 32 + row;
    const u32x4* gp = (const u32x4*)(GR + grow * 256 + h * 64 + half * 32);
    const f32x4* rg = (const f32x4*)(rgain + h * 64 + half * 32);
    u32x4* yp = (u32x4*)(Y + grow * DM + 512 + h * 64 + half * 32);
#pragma unroll
    for (int i = 0; i < 4; ++i) {
      const u32x4 gw = gp[i]; const f32x4 g0 = rg[2 * i], g1 = rg[2 * i + 1]; const f32x4 a = v[2 * i] * rstd * g0, c4 = v[2 * i + 1] * rstd * g1;
      u32x4 w; w.x = cvtpk(a[0] * bflo(gw.x), a[1] * bfhi(gw.x)); w.y = cvtpk(a[2] * bflo(gw.y), a[3] * bfhi(gw.y)); w.z = cvtpk(c4[0] * bflo(gw.z), c4[1] * bfhi(gw.z)); w.w = cvtpk(c4[2] * bflo(gw.w), c4[3] * bfhi(gw.w));
      yp[i] = w;
    }
  }
  asm volatile("s_waitcnt lgkmcnt(0)\n\ts_barrier" ::: "memory");
}
}

#define XB_TMO      128
#define XB_XCNT(j)  (256  + 64 * (j))
#define XB_XSUB(j)  (1280 + 64 * (j))
#define XB_XGEN(j)  (2304 + 64 * (j))
#define XB_TOP      3328
#define XB_TOPGEN   3392
#define XCD_BAR_WORDS 3456
#define XB_SPIN_CAP (1u << 18)
__device__ __forceinline__ unsigned xb_ld(unsigned* p)              { return __hip_atomic_load(p, __ATOMIC_RELAXED, __HIP_MEMORY_SCOPE_AGENT); }
__device__ __forceinline__ unsigned xb_add(unsigned* p, unsigned v) { return __hip_atomic_fetch_add(p, v, __ATOMIC_RELAXED, __HIP_MEMORY_SCOPE_AGENT); }
__device__ __forceinline__ unsigned xb_xcc_id() { return (unsigned)__builtin_amdgcn_s_getreg((3 << 11) | 20) & 0xFu; }
#define XB_SPIN(cond, bar) do { unsigned _sp = 0; while (cond) { __builtin_amdgcn_s_sleep(1); \
    if ((++_sp & 255u) == 0u) { if (xb_ld(&(bar)[XB_TMO])) break; if (_sp > XB_SPIN_CAP) { atomicAdd(&(bar)[XB_TMO], 1u); break; } } } } while (0)
struct XcdBarrier { unsigned* bar; unsigned x; volatile LAS unsigned* st; };
__device__ __forceinline__ XcdBarrier xcd_barrier_post(unsigned* bar, volatile LAS unsigned* st) {
    XcdBarrier b; b.bar = bar; b.x = xb_xcc_id(); b.st = st;
    if (threadIdx.x == 0) (void)xb_add(&bar[XB_XCNT(b.x)], 1u);
    return b;
}
__device__ __forceinline__ void xcd_barrier_complete(unsigned* bar, unsigned x, unsigned& nloc, unsigned& nx) {
    const unsigned G = gridDim.x * gridDim.y * gridDim.z;
    unsigned sum, cnt, mine, sp = 0u;
    for (;;) {
        sum = 0u; cnt = 0u; mine = 0u;
#pragma unroll
        for (unsigned j = 0; j < 16; ++j) { const unsigned c = xb_ld(&bar[XB_XCNT(j)]); sum += c; cnt += (c > 0u) ? 1u : 0u; mine = (j == x) ? c : mine; }
        if (sum == G) break;
        __builtin_amdgcn_s_sleep(1);
        if ((++sp & 255u) == 0u) { if (xb_ld(&bar[XB_TMO])) break; if (sp > XB_SPIN_CAP) { atomicAdd(&bar[XB_TMO], 1u); break; } }
    }
    nloc = mine > 0u ? mine : 1u; nx = cnt > 0u ? cnt : 1u;
}
__device__ __forceinline__ void xcd_barrier(const XcdBarrier& b) {
    asm volatile("s_waitcnt vmcnt(0)" ::: "memory");
    __syncthreads();
    if (threadIdx.x == 0) {
        unsigned* bar = b.bar;
        __builtin_amdgcn_s_waitcnt(0);
        unsigned nloc = b.st[0], nx = b.st[1];
        if (nloc == 0u) { xcd_barrier_complete(bar, b.x, nloc, nx); b.st[0] = nloc; b.st[1] = nx; }
        const unsigned old = xb_add(&bar[XB_XSUB(b.x)], 1u);
        const unsigned gen = old / nloc;
        if (old + 1u == (gen + 1u) * nloc) {
            __builtin_amdgcn_fence(__ATOMIC_RELEASE, "agent");
            asm volatile("s_waitcnt vmcnt(0)" ::: "memory");
            const unsigned og = xb_add(&bar[XB_TOP], 1u);
            const unsigned tg = og / nx;
            if (og + 1u == (tg + 1u) * nx) xb_add(&bar[XB_TOPGEN], 1u);
            else XB_SPIN(xb_ld(&bar[XB_TOPGEN]) == tg, bar);
            __builtin_amdgcn_fence(__ATOMIC_ACQUIRE, "agent");
            xb_add(&bar[XB_XGEN(b.x)], 1u);
            asm volatile("s_waitcnt vmcnt(0)" ::: "memory");
        } else {
            XB_SPIN(xb_ld(&bar[XB_XGEN(b.x)]) == gen, bar);
            __builtin_amdgcn_fence(__ATOMIC_ACQUIRE, "agent");
            asm volatile("s_waitcnt vmcnt(0)" ::: "memory");
        }
    }
    __syncthreads();
}

__global__ void __launch_bounds__(NTHREADS, 2) fwd_kernel(Args args) {
    extern __shared__ __attribute__((aligned(16))) unsigned char lds_raw[];
    LAS unsigned char* lds = (LAS unsigned char*)lds_raw;
    cg::grid_group grid = cg::this_grid();
    const int tid0 = threadIdx.x, wave = __builtin_amdgcn_readfirstlane(tid0 >> 6);
#define PHASE_LANES const int tid = opaque(tid0), lane = tid & 63; (void)lane; (void)tid
    const int G = gridDim.x, bx = blockIdx.x;
    const int vcu = (G % 8 == 0) ? (bx % 8) * (G / 8) + bx / 8 : bx;
    const int gw = vcu * NWAVES + wave, NGW = G * NWAVES;
    unsigned char* const ws = args.ws;
#define WSP(type, off) ((type*)(ws + (off)))
    if (tid0 < 64) ((LAS unsigned*)(lds + LDS_MISC))[tid0] = 0u;
    __syncthreads();
    unsigned long long tsA_ = 0, tsB_ = 0; (void)tsA_; (void)tsB_;
    TSTAMP(0);
    const XcdBarrier xbar = xcd_barrier_post(WSP(unsigned, WS_BAR), (volatile LAS unsigned*)(lds + LDS_MISC));
#define GRID_BAR() xcd_barrier(xbar)
    REPN(0) {
        PHASE_LANES;
        LAS float* scr = (LAS float*)(lds + wave * 16384);
        const float* x = args.in[0]; const float* mem = args.in[1]; const float* g_attn = args.in[2]; const float* w_in = args.in[3]; const float* g_mem = args.in[7];
        const float* w_mem_kv = args.in[8]; const float* w_out = args.in[11]; const float* g_ffn = args.in[12]; const float* w_router = args.in[13];
        bf16* WIN_T = WSP(bf16, WS_WIN); bf16* WMEM_T = WSP(bf16, WS_WMEM); bf16* WOUT_T = WSP(bf16, WS_WOUT);
        bf16* XN = WSP(bf16, WS_XN); bf16* MEMN = WSP(bf16, WS_MEMN); float* WRG = WSP(float, WS_WRG);
        constexpr int I0 = 16 * 88, I1 = 16 * 16, I2 = 16 * 32, NIT = I0 + I1 + I2;
        for (int it = gw; it < NIT; it += NGW) {
            int r = it;
            if (r < I0) { const int nb = r % 88, kb = r / 88; const int pn = nb >> 3;
                if (pn == 4 || pn == 5 || pn == 10) {
                    ConvItem c; c.W = w_in; c.W8 = WSP(unsigned char, WS_WIN8); c.N = NIN; c.k0 = kb * 64; c.n0 = nb * 32; c.glu = false; c.hperm = true;
                    f32x4 rr[8]; conv_load(c, rr, lane); conv_finish(c, rr, scr, lane);
                } else transpose_item(w_in, NIN, WIN_T, headperm_row(nb * 32), scr, kb * 64, nb * 32, lane);
                continue; } r -= I0;
            if (r < I1) { const int nb = r % 16, kb = r / 16;
                ConvItem c; c.W = w_mem_kv; c.W8 = WSP(unsigned char, WS_WMEM8); c.N = 512; c.k0 = kb * 64; c.n0 = nb * 32; c.glu = false; c.hperm = true;
                f32x4 rr[8]; conv_load(c, rr, lane); conv_finish(c, rr, scr, lane); continue; } r -= I1;
            { const int nb = r % 32, kb = r / 32; transpose_item(w_out, 1024, WOUT_T, nb * 32, scr, kb * 64, nb * 32, lane); }
        }
        for (int m = gw * 2; m < T + MROWS; m += NGW * 2) {
            if (m < T) rms_row2_to_bf16(x + (size_t)m * DM, g_attn, XN + (size_t)m * DM, lane, WSP(float, WS_IRS) + m, WSP(unsigned char, WS_XN8) + (size_t)m * DM);
            else rms_row2_to_bf16(mem + (size_t)(m - T) * DM, g_mem, MEMN + (size_t)(m - T) * DM, lane, nullptr, WSP(unsigned char, WS_MEMN8) + (size_t)(m - T) * DM);
        }
        for (int i = bx * NTHREADS + tid; i < DM * NEXP; i += G * NTHREADS) WRG[i] = g_ffn[i >> 5] * w_router[i];
        for (int i = bx * NTHREADS + tid; i < NB * 16 * 8 * 64; i += G * NTHREADS) WSP(float, WS_KMEAN)[i] = 0.f;
    }
    if (args.pad0 == 0x7fffffff) grid.sync();
    GRID_BAR();
    TSTAMP(1);

    REPN(1) {
        SchedProjA SA{G, bx, (const char*)(ws + WS_XN), (const char*)(ws + WS_WIN)};
        EpiProj EA{ws, args.in[4], args.in[5], args.in[9], args.in[10], 1.0f};
        pg8::gemm_phase<EpiProj, SchedProjA>(lds, SA, EA);
        SchedProjB SB{G, bx, (const char*)(ws + WS_XN8), (const char*)(ws + WS_MEMN8), (const char*)(ws + WS_WIN8), (const char*)(ws + WS_WMEM8)};
        EpiProj EB{ws, args.in[4], args.in[5], args.in[9], args.in[10], 0.03125f};
        pg8::gemm_phase<EpiProj, SchedProjB, false, true>(lds, SB, EB);
    }
    GRID_BAR();
    TSTAMP(2);

#ifndef NAIVE_RET
    REPN(2) for (int i = 0; i < 2; ++i) {
        const int u = vcu * 2 + i, bh = u >> 4, cp = u & 15;
        ret_body::kv_unit(WSP(bf16, WS_KR), WSP(bf16, WS_VR), WSP(float, WS_RET), bh >> 2, bh & 3, cp, (char*)lds_raw);
    }
    GRID_BAR();
    TSTAMP(3);
#endif
    REPN(20) { PHASE_LANES;
#if defined(NAIVE_MOBA) || defined(NAIVE_RET) || defined(NAIVE_MEM)
#error naive mixers are no longer wired in
#endif
    unsigned* qmix = WSP(unsigned, WS_CTL) + 64 + 256 * rep_; unsigned* qconv = WSP(unsigned, WS_CTL) + 128 + 256 * rep_;
    volatile LAS int* qslot = (volatile LAS int*)(lds + LDS_MISC + 64);
    const bool conv_first = (vcu & 3) == 3;
    bool mix_done = false, conv_done = false;
    while (!(mix_done && conv_done)) {
        const int kind = conv_first ? (conv_done ? 0 : 1) : (mix_done ? 1 : 0);
        if (tid == 0) qslot[0] = (int)__hip_atomic_fetch_add(kind ? qconv : qmix, 1u, __ATOMIC_RELAXED, __HIP_MEMORY_SCOPE_AGENT);
        __syncthreads();
        const int u = qslot[0];
        __syncthreads();
        if (kind == 1) {
            if (u >= 1536) { conv_done = true; continue; }
            convert_chunk(u, args.in[15], args.in[17], WSP(unsigned char, WS_W1), WSP(unsigned char, WS_W2), (LAS float*)(lds + wave * 16384), wave, lane);
            __syncthreads();
        } else if (u >= 2048) { mix_done = true; }
        else if (u < 1024) {
            const int nb = 15 - (u >> 6), bh = u & 63, b = bh >> 3, h = bh & 7;
            const size_t row0 = (size_t)b * SEQ + (size_t)nb * 256;
            attn_body::attn_unit<8, 512, 1024, true>(WSP(bf16, WS_QA) + row0 * 512 + h * 64, WSP(bf16, WS_KA) + (size_t)b * SEQ * 512 + h * 64, WSP(bf16, WS_VA) + (size_t)b * SEQ * 512 + h * 64,
                                                     WSP(bf16, WS_Y) + row0 * DM + h * 64, 4 * nb + 4, nb, WSP(float, WS_KMEAN) + ((size_t)b * 16 * 8 + h) * 64, (char*)lds_raw);
        } else if (u < 1536) {
            const int idx = u - 1024, bh = idx >> 4, cp = idx & 15;
            ret_body::out_unit(WSP(bf16, WS_QR), WSP(bf16, WS_KR), WSP(bf16, WS_VR), WSP(bf16, WS_GR), WSP(float, WS_RET), args.in[6], WSP(bf16, WS_Y), bh >> 2, bh & 3, cp, (char*)lds_raw);
        } else {
            const int idx = u - 1536, bh = idx >> 4, qb = idx & 15, b = bh >> 2, h = bh & 3;
            const size_t row0 = (size_t)b * SEQ + (size_t)qb * 256;
            attn_body::attn_unit<8, 256, 1024, false>(WSP(bf16, WS_QM) + row0 * 256 + h * 64, WSP(bf16, WS_MK) + (size_t)b * MEMLEN * 256 + h * 64, WSP(bf16, WS_MV) + (size_t)b * MEMLEN * 256 + h * 64,
                                                      WSP(bf16, WS_Y) + row0 * DM + 768 + h * 64, 4, 0, nullptr, (char*)lds_raw);
        }
    }
    }
    GRID_BAR();
    TSTAMP(4);

    REPN(3) {
        SchedPlain S{G, bx, 128, 4, (const char*)(ws + WS_Y), (const char*)(ws + WS_WOUT)};
        EpiOut E{WSP(bf16, WS_XN), WSP(float, WS_IRS), args.in[2], WSP(bf16, WS_X1B), WSP(float, WS_SSQ)};
#ifndef NO_G2
        pg8::gemm_phase<EpiOut, SchedPlain>(lds, S, E);
#endif
    }
    GRID_BAR();
    TSTAMP(5);

    REPN(4) {
        PHASE_LANES;
        const bf16* x1b = WSP(bf16, WS_X1B); const float* b_router = args.in[14];
        float* WRG = WSP(float, WS_WRG); float* SSQ = WSP(float, WS_SSQ); int* TOPI = WSP(int, WS_TOPI); float* TOPW = WSP(float, WS_TOPW); int* LRANK = WSP(int, WS_LRANK); int* LCOUNT = WSP(int, WS_LCOUNT);
        unsigned char* XN2 = WSP(unsigned char, WS_XN2); const float* g_ffn = args.in[12];
        if (bx == 0 && tid < 64) ((u32x4*)(XN2 + (size_t)T * DM))[tid] = (u32x4){0u, 0u, 0u, 0u};
        LAS float* wl = (LAS float*)(lds);
        LAS float* lg = (LAS float*)(lds + 131072) + wave * (16 * 33);
        LAS int* hist = (LAS int*)(lds + 131072 + 16896);
        { f32x4 w4[16];
#pragma unroll
          for (int q = 0; q < 16; ++q) w4[q] = ((const f32x4*)WRG)[tid + q * NTHREADS];
#pragma unroll
          for (int q = 0; q < 16; ++q) { const int i4 = tid + q * NTHREADS, r = i4 >> 3, e = (i4 & 7) * 4; *(LAS f32x4*)(wl + r * 32 + (e ^ (((r >> 5) & 1) << 4))) = w4[q]; } }
        if (tid < 32) hist[tid] = 0;
        __syncthreads();
        const int tpw = T / (G * NWAVES);
        for (int tb = 0; tb < tpw; tb += 16) {
            const int t0 = (bx * NWAVES + wave) * tpw + tb;
            const int i = lane & 15, kq = lane >> 4;
            f32x4 a0 = {0.f, 0.f, 0.f, 0.f}, a1 = {0.f, 0.f, 0.f, 0.f};
            const bf16* xr = x1b + (size_t)(t0 + i) * DM + 32 * kq;
            const LAS float* wb = wl + (32 * kq) * 32 + (i ^ ((kq & 1) << 4));
            const LAS float* wb1 = wl + (32 * kq) * 32 + ((i ^ ((kq & 1) << 4)) ^ 16);
            float rstd;
            { const f32x4* sp = (const f32x4*)(SSQ + (size_t)(t0 + i) * 16); const f32x4 s0 = sp[0], s1 = sp[1], s2 = sp[2], s3 = sp[3];
              const float ss = ((s0[0] + s0[1]) + (s0[2] + s0[3])) + ((s1[0] + s1[1]) + (s1[2] + s1[3])) + ((s2[0] + s2[1]) + (s2[2] + s2[3])) + ((s3[0] + s3[1]) + (s3[2] + s3[3]));
              rstd = 1.0f / sqrtf(ss * (1.0f / DM) + EPS); }
            unsigned char* xo = XN2 + (size_t)(t0 + i) * DM + 16 * kq;
            const float* gp = g_ffn + 32 * kq;
#pragma unroll 2
            for (int c = 0; c < 8; ++c) {
                float av[32];
#pragma unroll
                for (int j = 0; j < 4; ++j) { const u32x4 xw = *(const u32x4*)(xr + 128 * c + 8 * j);
                    av[8 * j] = bflo(xw.x); av[8 * j + 1] = bfhi(xw.x); av[8 * j + 2] = bflo(xw.y); av[8 * j + 3] = bfhi(xw.y); av[8 * j + 4] = bflo(xw.z); av[8 * j + 5] = bfhi(xw.z); av[8 * j + 6] = bflo(xw.w); av[8 * j + 7] = bfhi(xw.w); }
                { float nv[32];
#pragma unroll
                  for (int j = 0; j < 8; ++j) { const f32x4 g = *(const f32x4*)(gp + 128 * c + 4 * j); nv[4 * j] = av[4 * j] * rstd * g[0]; nv[4 * j + 1] = av[4 * j + 1] * rstd * g[1]; nv[4 * j + 2] = av[4 * j + 2] * rstd * g[2]; nv[4 * j + 3] = av[4 * j + 3] * rstd * g[3]; }
                  u32x4 p0, p1; fp6_pack32(nv, p0, p1);
                  *(u32x4*)(xo + 128 * c) = p0; *(u32x4*)(xo + 128 * c + 64) = p1; }
#pragma unroll
                for (int q = 0; q < 32; ++q) {
                    const float b0 = wb[(128 * c + q) * 32], b1v = wb1[(128 * c + q) * 32];
                    a0 = __builtin_amdgcn_mfma_f32_16x16x4f32(av[q], b0, a0, 0, 0, 0);
                    a1 = __builtin_amdgcn_mfma_f32_16x16x4f32(av[q], b1v, a1, 0, 0, 0);
                }
            }
#pragma unroll
            for (int r = 0; r < 4; ++r) { lg[(4 * kq + r) * 33 + i] = a0[r]; lg[(4 * kq + r) * 33 + 16 + i] = a1[r]; }
            LDS_WAIT(); asm volatile("" ::: "memory");
            if (lane < 16) {
                const int t = t0 + lane;
                float v[32];
#pragma unroll
                for (int e = 0; e < 32; ++e) v[e] = lg[lane * 33 + e] * rstd + b_router[e];
                int bi[4]; float bvv[4];
#pragma unroll
                for (int k = 0; k < 4; ++k) {
                    float best = -3e38f; int be = 0;
#pragma unroll
                    for (int e = 0; e < 32; ++e) { const bool take = v[e] > best; best = take ? v[e] : best; be = take ? e : be; }
                    bi[k] = be; bvv[k] = best;
#pragma unroll
                    for (int e = 0; e < 32; ++e) v[e] = (e == be) ? -3e38f : v[e];
                }
                const float e1 = __expf(bvv[1] - bvv[0]), e2 = __expf(bvv[2] - bvv[0]), e3 = __expf(bvv[3] - bvv[0]);
                const float inv = 1.0f / (1.0f + e1 + e2 + e3);
                const float wv[4] = {inv, e1 * inv, e2 * inv, e3 * inv};
#pragma unroll
                for (int k = 0; k < 4; ++k) {
                    const int rk = atomicAdd((int*)&hist[bi[k]], 1);
                    TOPI[t * 4 + k] = bi[k]; TOPW[t * 4 + k] = wv[k]; LRANK[t * 4 + k] = rk;
                }
            }
            LDS_WAIT(); asm volatile("" ::: "memory");
        }
        __syncthreads();
        if (tid < 32) LCOUNT[bx * 32 + tid] = hist[tid];
    }
    GRID_BAR();
    TSTAMP(6);

    REPN(5) {
        PHASE_LANES;
        int* TOPI = WSP(int, WS_TOPI); float* TOPW = WSP(float, WS_TOPW); int* LRANK = WSP(int, WS_LRANK); int* LCOUNT = WSP(int, WS_LCOUNT);
        int* POS = WSP(int, WS_POS); float* ROWW = WSP(float, WS_ROWW); int* PSTART = WSP(int, WS_PSTART); int* TILEEXP = WSP(int, WS_TILEEXP);
        LAS int* part = (LAS int*)(lds);
        LAS int* base = (LAS int*)(lds + 8192);
        {
            const int e = tid & 31, p = tid >> 5; int c = 0, pre = 0;
            const int wpp = (G + 15) / 16;
            for (int w = p * wpp; w < (p + 1) * wpp && w < G; ++w) { const int v = LCOUNT[w * 32 + e]; c += v; pre += (w < bx) ? v : 0; }
            part[p * 32 + e] = c; part[512 + p * 32 + e] = pre;
        }
        __syncthreads();
        if (tid < 32) { int c = 0, pre = 0; for (int p = 0; p < 16; ++p) { c += part[p * 32 + tid]; pre += part[512 + p * 32 + tid]; } part[1024 + tid] = c; part[1056 + tid] = pre; }
        __syncthreads();
        if (tid == 0) {
            int ps = 0;
            for (int e = 0; e < 32; ++e) {
                const int c = part[1024 + e], nt_ = (c + 255) >> 8;
                base[32 + e] = ps; base[e] = ps + part[1056 + e];
                if (bx == 0) PSTART[e] = ps;
                ps += nt_ * 256;
            }
            base[64] = ps; if (bx == 0) PSTART[32] = ps;
        }
        __syncthreads();
        if (bx == 1) {
            const int ntl = base[64] >> 8;
            for (int tl = tid; tl < ntl; tl += NTHREADS) { int e = 0;
#pragma unroll
                for (int q = 1; q < 32; ++q) e += (base[32 + q] <= tl * 256) ? 1 : 0;
                TILEEXP[tl] = e; }
        }
        int* ROWTOK = WSP(int, WS_ROWTOK);
        if (bx < 32) {
            const int c = part[1024 + bx], r0 = base[32 + bx] + c, r1 = base[32 + bx] + (((c + 255) >> 8) << 8);
            for (int r = r0 + tid; r < r1; r += NTHREADS) { ROWTOK[r] = T; ROWW[r] = 0.f; }
        }
        for (int a = tid; a < (T / G) * 4; a += NTHREADS) {
            const int ta = (bx * (T / G)) * 4 + a;
            const int e = TOPI[ta]; const int pos = base[e] + LRANK[ta];
            POS[ta] = pos; ROWTOK[pos] = ta >> 2; ROWW[pos] = TOPW[ta];
        }
    }
    GRID_BAR();
    TSTAMP(7);

    const int ntiles = WSP(int, WS_PSTART)[32] >> 8;
    REPN(6) {
        SchedMoe S{G, vcu, 8, ntiles, WSP(int, WS_TILEEXP), (const char*)(ws + WS_XN2), (const char*)(ws + WS_W1), (size_t)2048 * 1024, WSP(int, WS_ROWTOK)};
        EpiSwiglu E{args.in[16], WSP(unsigned char, WS_H)};
#ifndef NO_G3
        pg8::gemm_phase<EpiSwiglu, SchedMoe, true, true, true>(lds, S, E);
#endif
    }
    GRID_BAR();
    TSTAMP(8);
    REPN(7) {
        SchedMoe S{G, vcu, 4, ntiles, WSP(int, WS_TILEEXP), (const char*)(ws + WS_H), (const char*)(ws + WS_W2), (size_t)1024 * 1024, nullptr};
        EpiDown E{args.in[18], WSP(float, WS_ROWW), WSP(unsigned char, WS_XG)};
#ifndef NO_G4
        pg8::gemm_phase<EpiDown, SchedMoe, false, true>(lds, S, E);
#endif
    }
    GRID_BAR();
    TSTAMP(9);
    if (REP_PHASE == 9) { GRID_BAR(); GRID_BAR(); GRID_BAR(); GRID_BAR(); }
    REPN(8) { PHASE_LANES;
    for (int t = gw; t < T; t += NGW) {
        float* out = args.out; const int* POS = WSP(int, WS_POS); const unsigned char* YE = WSP(unsigned char, WS_XG); const bf16* x1b = WSP(bf16, WS_X1B);
        float* dst = (REP_PHASE == 8 && rep_ == 0) ? WSP(float, WS_H) + 64 * 1024 * 1024 : out;
        const u32x2* xrow = (const u32x2*)(x1b + (size_t)t * DM) + lane; f32x4* drow = (f32x4*)(dst + (size_t)t * DM) + lane;
        u32x2 xv[4]; f32x4 s[4];
#pragma unroll
        for (int j = 0; j < 4; ++j) { xv[j] = __builtin_nontemporal_load(xrow + 64 * j); s[j] = (f32x4){0.f, 0.f, 0.f, 0.f}; }
        unsigned yw[4][4];
#pragma unroll
        for (int k = 0; k < 4; ++k) {
            const int pos = POS[t * 4 + k]; const unsigned* yr = (const unsigned*)(YE + (size_t)pos * 1024) + lane;
#pragma unroll
            for (int j = 0; j < 4; ++j) yw[k][j] = __builtin_nontemporal_load(yr + 64 * j);
        }
#pragma unroll
        for (int k = 0; k < 4; ++k)
#pragma unroll
            for (int j = 0; j < 4; ++j) {
                const f32x2 lo = __builtin_amdgcn_cvt_pk_f32_fp8((int)yw[k][j], false), hi = __builtin_amdgcn_cvt_pk_f32_fp8((int)yw[k][j], true);
                s[j].x += lo.x; s[j].y += lo.y; s[j].z += hi.x; s[j].w += hi.y;
            }
#pragma unroll
        for (int j = 0; j < 4; ++j) __builtin_nontemporal_store((f32x4){bflo(xv[j].x), bfhi(xv[j].x), bflo(xv[j].y), bfhi(xv[j].y)} + s[j] * 0.0625f, drow + 64 * j);
    }
    }
    TSTAMP(10);
    if (REP_PHASE >= 100 && bx == 0 && tid0 == 0) {
        const unsigned long long t0_ = __builtin_amdgcn_s_memrealtime(), want = 9ull * (tsB_ - tsA_);
        while (__builtin_amdgcn_s_memrealtime() - t0_ < want) __builtin_amdgcn_s_sleep(32);
    }
}

extern "C" void kernel_launch(void* const* d_in, const int* in_sizes, int n_in, void* d_out, int out_size, void* d_ws, size_t ws_size, hipStream_t stream) {
    static int grid = 0;
    if (grid == 0) {
        if (n_in != 19 || out_size != T * DM || ws_size < WS_END) { fprintf(stderr, "kernel_launch: unexpected shapes (n_in %d out %d ws %zu)\n", n_in, out_size, ws_size); grid = -1; return; }
        int dev = 0, cus = 0, per_cu = 0;
        hipGetDevice(&dev); hipDeviceGetAttribute(&cus, hipDeviceAttributeMultiprocessorCount, dev);
        hipFuncSetAttribute((const void*)fwd_kernel, hipFuncAttributeMaxDynamicSharedMemorySize, LDS_BYTES);
        hipOccupancyMaxActiveBlocksPerMultiprocessor(&per_cu, (const void*)fwd_kernel, NTHREADS, LDS_BYTES);
        if (per_cu < 1) { fprintf(stderr, "kernel_launch: occupancy query says %d blocks per CU\n", per_cu); per_cu = 1; }
        (void)hipGetLastError();
        grid = cus * 1;
        if (grid % 8 != 0 || T % (grid * NWAVES * 16) != 0) { fprintf(stderr, "kernel_launch: grid %d unsupported\n", grid); grid = -1; return; }
    }
    if (grid < 0) return;
    hipMemsetAsync((char*)d_ws + WS_CTL, 0, CTL_ZERO_BYTES, stream);
    Args a{};
    for (int i = 0; i < 19; ++i) a.in[i] = (const float*)d_in[i];
    a.out = (float*)d_out; a.ws = (unsigned char*)d_ws;
    void* kargs[] = {&a};
    hipError_t e = hipLaunchCooperativeKernel((const void*)fwd_kernel, dim3(grid), dim3(NTHREADS), kargs, LDS_BYTES, stream);
    if (e != hipSuccess) fprintf(stderr, "cooperative launch failed: %s (grid %d)\n", hipGetErrorString(e), grid);
}
```

```cpp
#include <hip/hip_runtime.h>
#include <hip/hip_cooperative_groups.h>
#include <cstdio>
#include <cstdint>
namespace cg = cooperative_groups;

#define GAS __attribute__((address_space(1)))
#define LAS __attribute__((address_space(3)))
typedef unsigned short bf16;
typedef short bf16x8 __attribute__((ext_vector_type(8)));
typedef float f32x4 __attribute__((ext_vector_type(4)));
typedef float f32x2 __attribute__((ext_vector_type(2)));
typedef unsigned u32x4 __attribute__((ext_vector_type(4)));
typedef unsigned u32x2 __attribute__((ext_vector_type(2)));
typedef __bf16 bf16x2_t __attribute__((ext_vector_type(2)));

constexpr int NB = 8, SEQ = 4096, DM = 1024, T = NB * SEQ;
constexpr int NIN = 2816, NEXP = 32, TOPK = 4;
constexpr int MEMLEN = 256, MROWS = NB * MEMLEN;
constexpr float EPS = 1e-6f;
constexpr float C2 = 0.125f * 1.4426950408889634f;
constexpr int MAXTILES = 544, PROWS = MAXTILES * 256;
constexpr int NWAVES = 8, NTHREADS = 512;
#ifndef REP_PHASE
#define REP_PHASE -1
#endif
#define TSTAMP(i) do { if (REP_PHASE == 100 + (i)) tsA_ = __builtin_amdgcn_s_memrealtime(); if (REP_PHASE == 99 + (i)) tsB_ = __builtin_amdgcn_s_memrealtime(); } while (0)
#define REPN(k) for (int rep_ = 0; rep_ < ((REP_PHASE == (k)) ? 2 : 1); ++rep_)
constexpr int LDS_MISC = 150016;
constexpr int LDS_BYTES = 150016 + 256;

constexpr size_t MiB = 1u << 20;
constexpr size_t WS_CTL = 0, CTL_ZERO_BYTES = 131072;
constexpr size_t WS_BAR = 65536;
constexpr size_t WS_KMEAN = 1 * MiB;
constexpr size_t WS_WRG = 2 * MiB;
constexpr size_t WS_SSQ = 3 * MiB;
constexpr size_t WS_TOPI = 5 * MiB, WS_TOPW = 5 * MiB + 512 * 1024, WS_LRANK = 6 * MiB, WS_POS = 6 * MiB + 512 * 1024;
constexpr size_t WS_ROWW = 7 * MiB;
constexpr size_t WS_LCOUNT = 8 * MiB, WS_PSTART = 8 * MiB + 65536, WS_TILEEXP = 8 * MiB + 131072;
constexpr size_t WS_WIN = 16 * MiB, WS_WMEM = 22 * MiB, WS_WOUT = 24 * MiB, WS_W1 = 32 * MiB, WS_W2 = 160 * MiB;
constexpr size_t WS_XN = 224 * MiB, WS_MEMN = 288 * MiB;
constexpr size_t WS_QA = 292 * MiB, WS_KA = 324 * MiB, WS_VA = 356 * MiB;
constexpr size_t WS_QR = 388 * MiB, WS_KR = 404 * MiB, WS_VR = 420 * MiB, WS_GR = 436 * MiB, WS_QM = 452 * MiB;
constexpr size_t WS_MK = 468 * MiB, WS_MV = 469 * MiB;
constexpr size_t WS_Y = 470 * MiB, WS_RET = 534 * MiB;
constexpr size_t WS_XG = 224 * MiB;
constexpr size_t WS_XN2 = 496 * MiB;
constexpr size_t WS_X1B = 388 * MiB;
constexpr size_t WS_IRS = 10 * MiB;
constexpr size_t WS_ROWTOK = 9 * MiB;
constexpr size_t WS_H = 566 * MiB;
constexpr size_t WS_END = 838 * MiB;

struct Args {
    const float* in[19]; float* out; unsigned char* ws; int pad0, pad1;
};

__device__ __forceinline__ unsigned cvtpk(float lo, float hi) { f32x2 v = {lo, hi}; bf16x2_t b = __builtin_convertvector(v, bf16x2_t); return __builtin_bit_cast(unsigned, b); }
__device__ __forceinline__ float bf2f(unsigned short b) { return __uint_as_float(((unsigned)b) << 16); }
__device__ __forceinline__ float bflo(unsigned w) { return __uint_as_float(w << 16); }
__device__ __forceinline__ float bfhi(unsigned w) { return __uint_as_float(w & 0xffff0000u); }
__device__ __forceinline__ float wave_sum(float v) {
#pragma unroll
    for (int o = 1; o < 64; o <<= 1) v += __shfl_xor(v, o);
    return v;
}
#define LDS_WAIT() asm volatile("s_waitcnt lgkmcnt(0)" ::: "memory")
typedef unsigned v6u_t __attribute__((ext_vector_type(6)));
typedef float v16f_t __attribute__((ext_vector_type(16)));
#ifndef FP6_SCALE_DIV
#define FP6_SCALE_DIV 1
#endif
__device__ __forceinline__ void fp6_pack32(const float (&v)[32], u32x4& p0, u32x4& p1) {
    float mx = 1e-30f;
#pragma unroll
    for (int i = 0; i < 32; ++i) mx = fmaxf(mx, fabsf(v[i]));
    const unsigned bits = __float_as_uint(mx * (1.0f / 7.5f));
    int e = (int)((bits + 0x7FFFFFu) >> 23) - 127;
    e = e < -126 ? -126 : (e > 126 ? 126 : e);
    const float sc = __uint_as_float((unsigned)((FP6_SCALE_DIV ? e : -e) + 127) << 23);
    v16f_t lo, hi;
#pragma unroll
    for (int i = 0; i < 16; ++i) { lo[i] = v[i]; hi[i] = v[16 + i]; }
    const v6u_t w = __builtin_amdgcn_cvt_scalef32_2xpk16_fp6_f32(lo, hi, sc);
    p0 = (u32x4){w[0], w[1], w[2], w[3]}; p1 = (u32x4){w[4], w[5], (unsigned)(e + 127), 0u};
}
__device__ __forceinline__ int opaque(int v) { asm volatile("" : "+v"(v)); return v; }

namespace pg8 {
constexpr int BM = 256, BK = 64, HALF = 128, HTB = HALF * BK * 2, STAGE_BYTES = 8 * HTB, NXCD = 8, WGM = 8, K = 1024;
__host__ __device__ __forceinline__ int lds_byte(int r, int c) { const int st = (r >> 4) * 2 + (c >> 5), rr = r & 15, cc = c & 31, ob = rr * 64 + cc * 2; return st * 1024 + (ob ^ (((ob >> 9) & 1) << 5)); }
__host__ __device__ __forceinline__ void stage_rc(int b, int& R, int& C) { const int st = b / 1024, sb = b % 1024, swz = sb ^ (((sb >> 9) & 1) << 5); R = (st >> 1) * 16 + swz / 64; C = (st & 1) * 32 + (swz % 64) / 2; }
__host__ __device__ __forceinline__ int perm32(int rho) { const int n = rho >> 4, i = rho & 15; return 8 * (i >> 2) + 4 * n + (i & 3); }
struct Unit { int pm, pn, aux; };

__device__ __forceinline__ bool static_order(int L, int nM, int nN, int& pm, int& pn) {
    const int nwg = nM * nN; if (L >= nwg) return false;
    int wgid = L; { const int q = nwg / NXCD, r = nwg % NXCD, xcd = wgid % NXCD, off = wgid / NXCD; wgid = (xcd < r ? xcd * (q + 1) : r * (q + 1) + (xcd - r) * q) + off; }
    const int nig = WGM * nN, gid = wgid / nig, fm = gid * WGM, gsz = (nM - fm) < WGM ? (nM - fm) : WGM;
    pm = fm + ((wgid % nig) % gsz); pn = (wgid % nig) / gsz; return true;
}

typedef int v8i_t __attribute__((ext_vector_type(8)));
typedef int v4i_t __attribute__((ext_vector_type(4)));
__device__ __forceinline__ v8i_t cat8(bf16x8 lo, bf16x8 hi) { const v4i_t a = __builtin_bit_cast(v4i_t, lo), b = __builtin_bit_cast(v4i_t, hi); return __builtin_shufflevector(a, b, 0, 1, 2, 3, 4, 5, 6, 7); }
typedef int v6i_t __attribute__((ext_vector_type(6)));
__device__ __forceinline__ v6i_t cat6(bf16x8 lo, bf16x8 hi) { const v4i_t a = __builtin_bit_cast(v4i_t, lo), b = __builtin_bit_cast(v4i_t, hi); return __builtin_shufflevector(a, b, 0, 1, 2, 3, 4, 5); }
__device__ __forceinline__ int scl6(bf16x8 hi) { return __builtin_bit_cast(v4i_t, hi)[2]; }
template <class Epi, class Sched, bool GATHER = false, bool FP8 = false, bool FP6 = false>
__device__ __forceinline__ void gemm_phase(LAS unsigned char* lds, const Sched& S, const Epi& E) {
    constexpr int PITCH = FP8 ? 1024 : 2048;
    const int tid = opaque((int)threadIdx.x), wid = __builtin_amdgcn_readfirstlane(tid >> 6), lane = tid & 63, wr = wid >> 2, wc = wid & 3, fr = lane & 15, fq = lane >> 4;
    constexpr int nt = PITCH / 128;
    unsigned voffA[2], voffB[2];
#pragma unroll
    for (int i = 0; i < 2; ++i) { int R, C; stage_rc(tid * 16 + i * 8192, R, C); const int Rb = (R & ~31) + perm32(R & 31);
        voffA[i] = (unsigned)(R * PITCH + C * 2); voffB[i] = (unsigned)(Rb * PITCH + C * 2); }
    const size_t kstep = (size_t)(BK * 2);
    const size_t hstep = (size_t)HALF * PITCH;
    const unsigned ldsw = (unsigned)wid * 1024u;
    const int aoff = lds_byte(wr * 64 + fr, fq * 8), boff = lds_byte(wc * 32 + fr, fq * 8);
#define PG8_SA(b, h) (((b) * 2 + (h)) * HTB)
#define PG8_SB(b, h) ((4 + (b) * 2 + (h)) * HTB)
#define PG8_STAGE(bufoff, gbase, voff) do { _Pragma("unroll") for (int _i = 0; _i < 2; ++_i) \
        __builtin_amdgcn_global_load_lds((const unsigned*)((const char*)(gbase) + (voff)[_i]), (LAS unsigned*)(lds + (bufoff) + ldsw + _i * 8192), 16, 0, 0); } while (0)
#define PG8_LDA(dst, b, h) do { _Pragma("unroll") for (int m = 0; m < 4; ++m) _Pragma("unroll") for (int k = 0; k < 2; ++k) dst[m][k] = *(const LAS bf16x8*)(lds + PG8_SA(b, h) + aoff + m * 2048 + k * 1024); } while (0)
#define PG8_LDB(dst, b, h) do { _Pragma("unroll") for (int n = 0; n < 2; ++n) _Pragma("unroll") for (int k = 0; k < 2; ++k) dst[n][k] = *(const LAS bf16x8*)(lds + PG8_SB(b, h) + boff + n * 2048 + k * 1024); } while (0)
#define PG8_MMA(ai, bj, At, Bt) do { __builtin_amdgcn_s_setprio(1); \
        if constexpr (FP6) { _Pragma("unroll") for (int m = 0; m < 4; ++m) _Pragma("unroll") for (int n = 0; n < 2; ++n) \
            asm volatile("s_nop 1\n\tv_mfma_scale_f32_16x16x128_f8f6f4 %0, %1, %2, %0, %3, %4 op_sel_hi:[0,0,0] cbsz:2 blgp:2" : "+v"(acc[ai][bj][m][n]) : "v"(cat6(Bt[n][0], Bt[n][1])), "v"(cat6(At[m][0], At[m][1])), "v"(scl6(Bt[n][1])), "v"(scl6(At[m][1]))); } \
        else if constexpr (FP8) { _Pragma("unroll") for (int m = 0; m < 4; ++m) _Pragma("unroll") for (int n = 0; n < 2; ++n) \
            asm volatile("v_mfma_scale_f32_16x16x128_f8f6f4 %0, %1, %2, %0, %3, %3 op_sel_hi:[0,0,0]" : "+v"(acc[ai][bj][m][n]) : "v"(cat8(Bt[n][0], Bt[n][1])), "v"(cat8(At[m][0], At[m][1])), "v"(0x7f7f7f7f)); } \
        else { _Pragma("unroll") for (int m = 0; m < 4; ++m) _Pragma("unroll") for (int n = 0; n < 2; ++n) _Pragma("unroll") for (int k = 0; k < 2; ++k) \
            acc[ai][bj][m][n] = __builtin_amdgcn_mfma_f32_16x16x32_bf16(Bt[n][k], At[m][k], acc[ai][bj][m][n], 0, 0, 0); } \
        __builtin_amdgcn_s_setprio(0); } while (0)
#define PG8_WAIT_V(n) asm volatile("s_waitcnt vmcnt(" #n ")" ::: "memory")
#define PG8_WAIT_L(n) asm volatile("s_waitcnt lgkmcnt(" #n ")" ::: "memory")
#define PG8_BAR __builtin_amdgcn_s_barrier()
#define PG8_SCHED __builtin_amdgcn_sched_barrier(0)
    Unit cur, nxt; int ui = 0;
    if (!S.next(0, cur)) return;
    unsigned vGc[2][2], vGn[2][2]; int gR[2], gC[2];
    const char* gA = nullptr;
    if constexpr (GATHER) {
        gA = S.abase();
#pragma unroll
        for (int i = 0; i < 2; ++i) { stage_rc(tid * 16 + i * 8192, gR[i], gC[i]); }
        if (wid == 0) __builtin_amdgcn_global_load_lds((const unsigned*)(S.tokptr(cur) + lane * 16), (LAS unsigned*)(lds + 131072), 16, 0, 0);
        asm volatile("s_waitcnt vmcnt(0)" ::: "memory"); __builtin_amdgcn_s_barrier(); asm volatile("" ::: "memory");
#pragma unroll
        for (int h = 0; h < 2; ++h)
#pragma unroll
            for (int i = 0; i < 2; ++i) { const int tok = ((const LAS int*)(lds + 131072))[h * 128 + gR[i]]; vGc[h][i] = (unsigned)tok * (unsigned)PITCH + (unsigned)gC[i] * 2u; vGn[h][i] = vGc[h][i]; }
    }
    f32x4 acc[2][2][4][2];
#pragma unroll
    for (int a = 0; a < 2; ++a)
#pragma unroll
        for (int b = 0; b < 2; ++b)
#pragma unroll
            for (int m = 0; m < 4; ++m)
#pragma unroll
                for (int n = 0; n < 2; ++n) acc[a][b][m][n] = (f32x4){0.f, 0.f, 0.f, 0.f};
    bf16x8 At[4][2], B0[2][2], B1[2][2];
    const char* cA = GATHER ? gA : S.aptr(cur); const char* cB = S.bptr(cur);
    const size_t ahstep = GATHER ? (size_t)0 : hstep;
    {
        PG8_STAGE(PG8_SB(0, 0), cB, voffB); PG8_STAGE(PG8_SB(0, 1), cB + hstep, voffB);
        if constexpr (GATHER) { PG8_STAGE(PG8_SA(0, 0), cA, vGc[0]); PG8_STAGE(PG8_SA(0, 1), cA, vGc[1]); } else { PG8_STAGE(PG8_SA(0, 0), cA, voffA); PG8_STAGE(PG8_SA(0, 1), cA + hstep, voffA); }
        if (wr == 1) PG8_BAR;
        PG8_WAIT_V(2); PG8_BAR;
        PG8_STAGE(PG8_SB(1, 0), cB + kstep, voffB);
        if constexpr (GATHER) { PG8_STAGE(PG8_SA(1, 0), cA + kstep, vGc[0]); } else { PG8_STAGE(PG8_SA(1, 0), cA + kstep, voffA); }
        PG8_STAGE(PG8_SB(1, 1), cB + hstep + kstep, voffB);
        PG8_WAIT_V(6); PG8_BAR;
    }
    for (;;) {
        const bool has_next = S.next(ui + 1, nxt);
        const char* nA = GATHER ? gA : (has_next ? S.aptr(nxt) : cA); const char* nB = has_next ? S.bptr(nxt) : cB;
        if constexpr (GATHER) { if (has_next && wid == 0) __builtin_amdgcn_global_load_lds((const unsigned*)(S.tokptr(nxt) + lane * 16), (LAS unsigned*)(lds + 131072 + ((ui + 1) & 1) * 1024), 16, 0, 0); }
#pragma nounroll
        for (int t = 0; t < nt; t += 2) {
            const bool last = (t == nt - 2);
            const char* a1 = cA + (size_t)(t + 1) * kstep;
            const char* a2 = last ? nA : cA + (size_t)(t + 2) * kstep; const char* b2 = last ? nB : cB + (size_t)(t + 2) * kstep;
            const char* a3 = a2 + kstep; const char* b3 = b2 + kstep;
            unsigned v2h0[2], v2h1[2];
            if constexpr (GATHER) {
                if (last && has_next) {
                    const LAS int* tk = (const LAS int*)(lds + 131072 + ((ui + 1) & 1) * 1024);
#pragma unroll
                    for (int h = 0; h < 2; ++h)
#pragma unroll
                        for (int i = 0; i < 2; ++i) vGn[h][i] = (unsigned)tk[h * 128 + gR[i]] * (unsigned)PITCH + (unsigned)gC[i] * 2u;
                }
#pragma unroll
                for (int i = 0; i < 2; ++i) { v2h0[i] = last ? vGn[0][i] : vGc[0][i]; v2h1[i] = last ? vGn[1][i] : vGc[1][i]; }
            } else {
#pragma unroll
                for (int i = 0; i < 2; ++i) { v2h0[i] = voffA[i]; v2h1[i] = voffA[i]; }
            }
            PG8_LDB(B0, 0, 0); PG8_LDB(B1, 0, 1); PG8_SCHED; PG8_LDA(At, 0, 0);
            if constexpr (GATHER) { PG8_STAGE(PG8_SA(1, 1), a1, vGc[1]); } else { PG8_STAGE(PG8_SA(1, 1), a1 + hstep, voffA); }
            PG8_WAIT_V(8); PG8_WAIT_L(0); PG8_BAR; PG8_MMA(0, 0, At, B0); PG8_MMA(0, 1, At, B1); PG8_BAR; PG8_SCHED;
            PG8_LDA(At, 0, 1); PG8_STAGE(PG8_SB(0, 0), b2, voffB); PG8_STAGE(PG8_SB(0, 1), b2 + hstep, voffB); PG8_STAGE(PG8_SA(0, 0), a2, v2h0);
            PG8_WAIT_V(8); PG8_WAIT_L(0); PG8_BAR; PG8_MMA(1, 0, At, B0); PG8_MMA(1, 1, At, B1); PG8_BAR; PG8_SCHED;
            PG8_LDB(B0, 1, 0); PG8_LDB(B1, 1, 1); PG8_SCHED; PG8_LDA(At, 1, 0); PG8_STAGE(PG8_SA(0, 1), a2 + ahstep, v2h1);
            PG8_WAIT_V(8); PG8_WAIT_L(0); PG8_BAR; PG8_MMA(0, 0, At, B0); PG8_MMA(0, 1, At, B1); PG8_BAR; PG8_SCHED;
            PG8_LDA(At, 1, 1); PG8_STAGE(PG8_SB(1, 0), b3, voffB); PG8_STAGE(PG8_SB(1, 1), b3 + hstep, voffB); PG8_STAGE(PG8_SA(1, 0), a3, v2h0);
            PG8_WAIT_V(8); PG8_WAIT_L(0); PG8_BAR; PG8_MMA(1, 0, At, B0); PG8_MMA(1, 1, At, B1); PG8_BAR; PG8_SCHED;
        }
        if (wr == 0) PG8_BAR;
        if constexpr (FP8) asm volatile("s_nop 15\n\ts_nop 7" ::: "memory");
        E(acc, cur, wr, wc, fr, fq);
        if (!has_next) break;
#pragma unroll
        for (int a = 0; a < 2; ++a)
#pragma unroll
            for (int b = 0; b < 2; ++b)
#pragma unroll
                for (int m = 0; m < 4; ++m)
#pragma unroll
                    for (int n = 0; n < 2; ++n) acc[a][b][m][n] = (f32x4){0.f, 0.f, 0.f, 0.f};
        cur = nxt; cA = nA; cB = nB; ++ui;
        if constexpr (GATHER) {
#pragma unroll
            for (int h = 0; h < 2; ++h)
#pragma unroll
                for (int i = 0; i < 2; ++i) vGc[h][i] = vGn[h][i];
        }
        if (wr == 1) PG8_BAR;
    }
    PG8_WAIT_V(0);
    PG8_BAR;
#undef PG8_SA
#undef PG8_SB
#undef PG8_STAGE
#undef PG8_LDA
#undef PG8_LDB
#undef PG8_MMA
#undef PG8_WAIT_V
#undef PG8_WAIT_L
#undef PG8_BAR
#undef PG8_SCHED
}
}
using pg8::Unit;

struct SchedProj {
    int G, c; const char *XN, *MEMN, *WIN, *WMEM;
    __device__ __forceinline__ bool next(int i, Unit& u) const {
        const int L = i * G + c;
        if (L < 1408) { u.aux = 0; return pg8::static_order(L, 128, 11, u.pm, u.pn); }
        if (L < 1424) { const int j = L - 1408; u.pm = j >> 1; u.pn = j & 1; u.aux = 1; return true; }
        return false;
    }
    __device__ __forceinline__ const char* aptr(const Unit& u) const { return (u.aux ? MEMN : XN) + (size_t)u.pm * (256 * 2048); }
    __device__ __forceinline__ const char* bptr(const Unit& u) const { return (u.aux ? WMEM : WIN) + (size_t)u.pn * (256 * 2048); }
};
struct SchedProj10 {
    int G, c; const char *XN, *WIN;
    __device__ __forceinline__ bool next(int i, Unit& u) const { int j; u.aux = 0; if (!pg8::static_order(i * G + c, 128, 10, u.pm, j)) return false; u.pn = j < 9 ? j : 10; return true; }
    __device__ __forceinline__ const char* aptr(const Unit& u) const { return XN + (size_t)u.pm * (256 * 2048); }
    __device__ __forceinline__ const char* bptr(const Unit& u) const { return WIN + (size_t)u.pn * (256 * 2048); }
};
struct SchedProjOne {
    int c; const char *XN, *MEMN, *WIN, *WMEM;
    __device__ __forceinline__ bool next(int i, Unit& u) const {
        if (i != 0 || c >= 144) return false;
        if (c < 128) { u.pm = c; u.pn = 9; u.aux = 0; } else { const int j = c - 128; u.pm = j >> 1; u.pn = j & 1; u.aux = 1; }
        return true;
    }
    __device__ __forceinline__ const char* aptr(const Unit& u) const { return (u.aux ? MEMN : XN) + (size_t)u.pm * (256 * 2048); }
    __device__ __forceinline__ const char* bptr(const Unit& u) const { return (u.aux ? WMEM : WIN) + (size_t)u.pn * (256 * 2048); }
};
struct SchedPlain {
    int G, c, nM, nN; const char *A, *B;
    __device__ __forceinline__ bool next(int i, Unit& u) const { u.aux = 0; return pg8::static_order(i * G + c, nM, nN, u.pm, u.pn); }
    __device__ __forceinline__ const char* aptr(const Unit& u) const { return A + (size_t)u.pm * (256 * 2048); }
    __device__ __forceinline__ const char* bptr(const Unit& u) const { return B + (size_t)u.pn * (256 * 2048); }
};
struct SchedMoe {
    int G, vcu, npn, ntiles; const int* tile_exp; const char *A, *B; size_t bexp;
    __device__ __forceinline__ bool next(int i, Unit& u) const {
        const int L = i * G + vcu, tile = L / npn; if (tile >= ntiles) return false;
        u.pm = tile; u.pn = L - tile * npn; u.aux = __builtin_amdgcn_readfirstlane(tile_exp[tile]); return true;
    }
    __device__ __forceinline__ const char* aptr(const Unit& u) const { return A + (size_t)u.pm * (256 * 1024); }
    __device__ __forceinline__ const char* bptr(const Unit& u) const { return B + (size_t)u.aux * bexp + (size_t)u.pn * (256 * 1024); }
    const int* rowtok;
    __device__ __forceinline__ const char* abase() const { return A; }
    __device__ __forceinline__ const char* tokptr(const Unit& u) const { return (const char*)(rowtok + (size_t)u.pm * 256); }
};

struct EpiProj {
    unsigned char* ws;
    const float *gq, *gk, *gmq, *gmk;
    __device__ __forceinline__ void operator()(const f32x4 (&acc)[2][2][4][2], const Unit& u, int wr, int wc, int fr, int fq) const {
        int mode = 0; bf16* out; int ld = 256, coff = 0; const float* gain = nullptr; float scale = 1.f; bool kmean = false;
        if (u.aux == 0) {
            switch (u.pn) {
                case 0: case 1: out = (bf16*)(ws + WS_QA); ld = 512; coff = u.pn * 256; mode = 1; gain = gq; scale = C2; break;
                case 2: case 3: out = (bf16*)(ws + WS_KA); ld = 512; coff = (u.pn - 2) * 256; mode = 1; gain = gk; kmean = true; break;
                case 4: case 5: out = (bf16*)(ws + WS_VA); ld = 512; coff = (u.pn - 4) * 256; break;
                case 6: out = (bf16*)(ws + WS_QR); mode = 2; break;
                case 7: out = (bf16*)(ws + WS_KR); mode = 2; scale = 0.125f; break;
                case 8: out = (bf16*)(ws + WS_VR); break;
                case 9: out = (bf16*)(ws + WS_GR); mode = 3; break;
                default: out = (bf16*)(ws + WS_QM); mode = 1; gain = gmq; scale = C2; break;
            }
        } else {
            if (u.pn == 0) { out = (bf16*)(ws + WS_MK); mode = 1; gain = gmk; } else { out = (bf16*)(ws + WS_MV); }
        }
        const int row0 = u.pm * 256 + wr * 64 + fr;
        const int colb = coff + wc * 64 + 8 * fq;
        if (gain == nullptr) gain = gq;
        f32x4 ks[2][2];
#pragma unroll
        for (int bj = 0; bj < 2; ++bj)
#pragma unroll
            for (int n = 0; n < 2; ++n) ks[bj][n] = (f32x4){0.f, 0.f, 0.f, 0.f};
#pragma unroll
        for (int ai = 0; ai < 2; ++ai)
#pragma unroll
            for (int m = 0; m < 4; ++m) {
                const int row = row0 + ai * 128 + m * 16;
                f32x4 v[2][2];
#pragma unroll
                for (int bj = 0; bj < 2; ++bj)
#pragma unroll
                    for (int n = 0; n < 2; ++n) v[bj][n] = acc[ai][bj][m][n];
                if (mode == 1) {
                    float ss = 0.f;
#pragma unroll
                    for (int bj = 0; bj < 2; ++bj)
#pragma unroll
                        for (int n = 0; n < 2; ++n) { const f32x4 x = v[bj][n]; ss += (x[0] * x[0] + x[1] * x[1]) + (x[2] * x[2] + x[3] * x[3]); }
                    ss += __shfl_xor(ss, 16); ss += __shfl_xor(ss, 32);
                    const float r = scale / sqrtf(ss * (1.0f / 64.0f) + EPS);
#pragma unroll
                    for (int bj = 0; bj < 2; ++bj)
#pragma unroll
                        for (int n = 0; n < 2; ++n) v[bj][n] = v[bj][n] * r * *(const f32x4*)(gain + bj * 32 + 8 * fq + 4 * n);
                } else if (mode == 2) {
                    const float pos = (float)(row & (SEQ - 1));
                    const float lgam = __builtin_amdgcn_logf(1.0f - __builtin_amdgcn_exp2f(-5.0f - (float)wc));
                    const float rsc = scale * __builtin_amdgcn_exp2f(((u.pn == 6) ? lgam : -lgam) * (float)(row & 127));
#pragma unroll
                    for (int n = 0; n < 2; ++n)
#pragma unroll
                        for (int j = 0; j < 4; ++j) {
                            const float fre = __builtin_amdgcn_exp2f((float)(8 * fq + 4 * n + j) * (-13.287712379549449f / 31.0f)) * 0.15915494309189535f;
                            float tt = pos * fre; tt = tt - floorf(tt);
                            const float sn = __builtin_amdgcn_sinf(tt), cs = __builtin_amdgcn_cosf(tt);
                            const float t1 = v[0][n][j], t2 = v[1][n][j];
                            v[0][n][j] = (t1 * cs - t2 * sn) * rsc; v[1][n][j] = (t2 * cs + t1 * sn) * rsc;
                        }
                } else if (mode == 3) {
#pragma unroll
                    for (int bj = 0; bj < 2; ++bj)
#pragma unroll
                        for (int n = 0; n < 2; ++n)
#pragma unroll
                            for (int j = 0; j < 4; ++j) { const float x = v[bj][n][j]; v[bj][n][j] = x / (1.0f + __expf(-x)); }
                }
                if (kmean) {
#pragma unroll
                    for (int bj = 0; bj < 2; ++bj)
#pragma unroll
                        for (int n = 0; n < 2; ++n) ks[bj][n] += v[bj][n];
                }
                bf16* rowp = out + (size_t)row * ld + colb;
#pragma unroll
                for (int bj = 0; bj < 2; ++bj) { u32x4 w; w.x = cvtpk(v[bj][0][0], v[bj][0][1]); w.y = cvtpk(v[bj][0][2], v[bj][0][3]); w.z = cvtpk(v[bj][1][0], v[bj][1][1]); w.w = cvtpk(v[bj][1][2], v[bj][1][3]);
                    *(u32x4*)(rowp + bj * 32) = w; }
            }
        if (kmean) {
            float* kp = (float*)(ws + WS_KMEAN) + ((size_t)u.pm * 8 + (u.pn - 2) * 4 + wc) * 64 + 8 * fq;
#pragma unroll
            for (int bj = 0; bj < 2; ++bj)
#pragma unroll
                for (int n = 0; n < 2; ++n)
#pragma unroll
                    for (int j = 0; j < 4; ++j) {
                        float s = ks[bj][n][j];
                        s += __shfl_xor(s, 1); s += __shfl_xor(s, 2); s += __shfl_xor(s, 4); s += __shfl_xor(s, 8);
                        if (fr == 0) atomicAdd(kp + bj * 32 + 4 * n + j, s * (1.0f / 256.0f));
                    }
        }
    }
};

struct EpiOut {
    const bf16* xn; const float* irs; const float* gattn; bf16* out; float* ssq;
    __device__ __forceinline__ void operator()(const f32x4 (&acc)[2][2][4][2], const Unit& u, int wr, int wc, int fr, int fq) const {
        const int row0 = u.pm * 256 + wr * 64 + fr, col0 = u.pn * 256 + wc * 32 + 8 * fq;
        f32x4 ig[2][2];
#pragma unroll
        for (int bj = 0; bj < 2; ++bj)
#pragma unroll
            for (int n = 0; n < 2; ++n) { const f32x4 g = *(const f32x4*)(gattn + col0 + bj * 128 + 4 * n); ig[bj][n] = (f32x4){1.0f / g[0], 1.0f / g[1], 1.0f / g[2], 1.0f / g[3]}; }
#pragma unroll
        for (int ai = 0; ai < 2; ++ai)
#pragma unroll
            for (int m = 0; m < 4; ++m) {
                const int row = row0 + ai * 128 + m * 16; const size_t off = (size_t)row * DM + col0; float ss = 0.f; const float ir = irs[row];
#pragma unroll
                for (int bj = 0; bj < 2; ++bj) {
                    const u32x4 xw = __builtin_nontemporal_load((const u32x4*)(xn + off + bj * 128));
                    const f32x4 o0 = (f32x4){bflo(xw.x), bfhi(xw.x), bflo(xw.y), bfhi(xw.y)} * ig[bj][0] * ir + acc[ai][bj][m][0], o1 = (f32x4){bflo(xw.z), bfhi(xw.z), bflo(xw.w), bfhi(xw.w)} * ig[bj][1] * ir + acc[ai][bj][m][1];
                    ss += ((o0[0] * o0[0] + o0[1] * o0[1]) + (o0[2] * o0[2] + o0[3] * o0[3])) + ((o1[0] * o1[0] + o1[1] * o1[1]) + (o1[2] * o1[2] + o1[3] * o1[3]));
                    u32x4 w; w.x = cvtpk(o0[0], o0[1]); w.y = cvtpk(o0[2], o0[3]); w.z = cvtpk(o1[0], o1[1]); w.w = cvtpk(o1[2], o1[3]);
                    *(u32x4*)(out + off + bj * 128) = w; }
                ss += __shfl_xor(ss, 16); ss += __shfl_xor(ss, 32);
                if (fq == 0) ssq[(size_t)row * 16 + u.pn * 4 + wc] = ss;
            }
    }
};

struct EpiSwiglu {
    const float* b1; unsigned char* H;
    __device__ __forceinline__ void operator()(const f32x4 (&acc)[2][2][4][2], const Unit& u, int wr, int wc, int fr, int fq) const {
        const int row0 = u.pm * 256 + wr * 64 + fr, p0 = u.pn * 128 + wc * 32 + 8 * fq;
        const float* bp = b1 + (size_t)u.aux * 2048 + 2 * p0;
        f32x4 bv[4];
#pragma unroll
        for (int i = 0; i < 4; ++i) bv[i] = *(const f32x4*)(bp + 4 * i);
#pragma unroll
        for (int ai = 0; ai < 2; ++ai)
#pragma unroll
            for (int m = 0; m < 4; ++m) {
                const int row = row0 + ai * 128 + m * 16;
                float h[8];
#pragma unroll
                for (int n = 0; n < 2; ++n)
#pragma unroll
                    for (int j = 0; j < 4; ++j) {
                        const int i = 4 * n + j;
                        const float g = fminf(acc[ai][0][m][n][j] + bv[i >> 1][(i & 1) * 2], 7.0f);
                        const float l = fminf(fmaxf(acc[ai][1][m][n][j] + bv[i >> 1][(i & 1) * 2 + 1], -7.0f), 7.0f);
                        h[i] = g * __builtin_amdgcn_rcpf(1.0f + __builtin_amdgcn_exp2f(-1.702f * 1.4426950408889634f * g)) * (l + 1.0f);
                    }
                int w0 = 0, w1 = 0;
                w0 = __builtin_amdgcn_cvt_pk_fp8_f32(h[0], h[1], w0, false); w0 = __builtin_amdgcn_cvt_pk_fp8_f32(h[2], h[3], w0, true);
                w1 = __builtin_amdgcn_cvt_pk_fp8_f32(h[4], h[5], w1, false); w1 = __builtin_amdgcn_cvt_pk_fp8_f32(h[6], h[7], w1, true);
                *(u32x2*)(H + (size_t)row * 1024 + p0) = (u32x2){(unsigned)w0, (unsigned)w1};
            }
    }
};

struct EpiDown {
    const float* b2; const float* roww; unsigned char* YE;
    __device__ __forceinline__ void operator()(const f32x4 (&acc)[2][2][4][2], const Unit& u, int wr, int wc, int fr, int fq) const {
        const int row0 = u.pm * 256 + wr * 64 + fr, c0 = u.pn * 256 + wc * 32 + 8 * fq;
        const float* bp = b2 + (size_t)u.aux * 1024 + c0;
        f32x4 bv[2][2];
#pragma unroll
        for (int bj = 0; bj < 2; ++bj)
#pragma unroll
            for (int n = 0; n < 2; ++n) bv[bj][n] = *(const f32x4*)(bp + bj * 128 + 4 * n);
#pragma unroll
        for (int ai = 0; ai < 2; ++ai)
#pragma unroll
            for (int m = 0; m < 4; ++m) {
                const int row = row0 + ai * 128 + m * 16; const float w8 = roww[row] * 16.0f;
#pragma unroll
                for (int bj = 0; bj < 2; ++bj) {
                    const f32x4 y0 = (acc[ai][bj][m][0] * 0.03125f + bv[bj][0]) * w8, y1 = (acc[ai][bj][m][1] * 0.03125f + bv[bj][1]) * w8;
                    int w0 = 0, w1 = 0;
                    w0 = __builtin_amdgcn_cvt_pk_fp8_f32(y0[0], y0[1], w0, false); w0 = __builtin_amdgcn_cvt_pk_fp8_f32(y0[2], y0[3], w0, true);
                    w1 = __builtin_amdgcn_cvt_pk_fp8_f32(y1[0], y1[1], w1, false); w1 = __builtin_amdgcn_cvt_pk_fp8_f32(y1[2], y1[3], w1, true);
                    *(u32x2*)(YE + (size_t)row * 1024 + c0 + bj * 128) = (u32x2){(unsigned)w0, (unsigned)w1};
                }
            }
    }
};

__device__ __forceinline__ void transpose_item(const float* W, int N, bf16* WT, int drow0, LAS float* scr, int k0, int n0, int lane) {
    float ld_[32];
#pragma unroll
    for (int i = 0; i < 32; ++i) { const int kk = 2 * i + (lane >> 5); ld_[i] = __builtin_nontemporal_load(W + (size_t)(k0 + kk) * N + n0 + (lane & 31)); }
#pragma unroll
    for (int i = 0; i < 32; ++i) { const int kk = 2 * i + (lane >> 5); scr[kk * 33 + (lane & 31)] = ld_[i]; }
    LDS_WAIT(); asm volatile("" ::: "memory");
    const int c = lane & 7;
#pragma unroll
    for (int j = 0; j < 4; ++j) { const int n = (lane >> 3) + 8 * j; const LAS float* s = scr + (8 * c) * 33 + n;
        u32x4 o; o.x = cvtpk(s[0 * 33], s[1 * 33]); o.y = cvtpk(s[2 * 33], s[3 * 33]); o.z = cvtpk(s[4 * 33], s[5 * 33]); o.w = cvtpk(s[6 * 33], s[7 * 33]);
        *(u32x4*)(WT + (size_t)(drow0 + n) * 1024 + k0 + 8 * c) = o; }
    LDS_WAIT(); asm volatile("" ::: "memory");
}
template <bool GLU>
__device__ __forceinline__ void transpose_item_fp8(const float* W, int N, unsigned char* W8, LAS float* scr, int k0, int n0, int lane) {
    float ld_[32];
#pragma unroll
    for (int i = 0; i < 32; ++i) { const int kk = 2 * i + (lane >> 5); ld_[i] = __builtin_nontemporal_load(W + (size_t)(k0 + kk) * N + n0 + (lane & 31)); }
#pragma unroll
    for (int i = 0; i < 32; ++i) { const int kk = 2 * i + (lane >> 5); scr[kk * 33 + (lane & 31)] = ld_[i]; }
    LDS_WAIT(); asm volatile("" ::: "memory");
    const int c = lane & 3;
#pragma unroll
    for (int j = 0; j < 2; ++j) { const int n = (lane >> 2) + 16 * j; const LAS float* s = scr + (16 * c) * 33 + n;
        int w[4];
#pragma unroll
        for (int q = 0; q < 4; ++q) { int t = 0; t = __builtin_amdgcn_cvt_pk_fp8_f32(s[(4 * q) * 33] * 32.0f, s[(4 * q + 1) * 33] * 32.0f, t, false); t = __builtin_amdgcn_cvt_pk_fp8_f32(s[(4 * q + 2) * 33] * 32.0f, s[(4 * q + 3) * 33] * 32.0f, t, true); w[q] = t; }
        const int col = n0 + n; const int p = col >> 1;
        const int drow = GLU ? ((p >> 7) * 256 + (col & 1) * 128 + (p & 127)) : col;
        *(u32x4*)(W8 + (size_t)drow * 1024 + k0 + 16 * c) = (u32x4){(unsigned)w[0], (unsigned)w[1], (unsigned)w[2], (unsigned)w[3]}; }
    LDS_WAIT(); asm volatile("" ::: "memory");
}
struct ConvItem { const float* W; unsigned char* W8; int N, k0, n0; bool glu; };
__device__ __forceinline__ ConvItem conv_decode(int it, const float* w1, const float* w2, unsigned char* W1_8, unsigned char* W2_8) {
    ConvItem c;
    if (it < 32768) { const int e = it >> 10, rr = it & 1023, nb = rr & 63, kb = rr >> 6; c.W = w1 + (size_t)e * 1024 * 2048; c.W8 = W1_8 + (size_t)e * 2048 * 1024; c.N = 2048; c.k0 = kb * 64; c.n0 = nb * 32; c.glu = true; }
    else { const int r = it - 32768, e = r >> 9, rr = r & 511, nb = rr & 31, kb = rr >> 5; c.W = w2 + (size_t)e * 1024 * 1024; c.W8 = W2_8 + (size_t)e * 1024 * 1024; c.N = 1024; c.k0 = kb * 64; c.n0 = nb * 32; c.glu = false; }
    return c;
}
__device__ __forceinline__ void conv_load(const ConvItem& c, f32x4 (&r)[8], int lane) {
    const float* base = c.W + (size_t)c.k0 * c.N + c.n0;
    const int lo = (lane >> 3) * c.N + (lane & 7) * 4;
#pragma unroll
    for (int i = 0; i < 8; ++i) r[i] = __builtin_nontemporal_load((const f32x4*)(base + (size_t)(8 * i) * c.N + lo));
}
__device__ __forceinline__ void conv_finish(const ConvItem& c, const f32x4 (&r)[8], LAS float* scr, int lane) {
#pragma unroll
    for (int i = 0; i < 8; ++i) *(LAS f32x4*)(scr + (8 * i + (lane >> 3)) * 36 + (lane & 7) * 4) = r[i];
    LDS_WAIT(); asm volatile("" ::: "memory");
    if (c.glu) {
        const int n = lane & 31, half = lane >> 5; const LAS float* s = scr + (32 * half) * 36 + n;
        float v[32];
#pragma unroll
        for (int i = 0; i < 32; ++i) v[i] = s[i * 36];
        u32x4 p0, p1; fp6_pack32(v, p0, p1);
        const int col = c.n0 + n; const int p = col >> 1;
        const int drow = (p >> 7) * 256 + (col & 1) * 128 + (p & 127);
        unsigned char* dst = c.W8 + (size_t)drow * 1024 + (c.k0 >> 7) * 128 + 16 * (((c.k0 & 127) >> 5) + half);
        *(u32x4*)dst = p0; *(u32x4*)(dst + 64) = p1;
        LDS_WAIT(); asm volatile("" ::: "memory");
        return;
    }
    const int cc = lane & 3;
#pragma unroll
    for (int j = 0; j < 2; ++j) { const int n = (lane >> 2) + 16 * j; const LAS float* s = scr + (16 * cc) * 36 + n;
        int w[4];
#pragma unroll
        for (int q = 0; q < 4; ++q) { int t = 0; t = __builtin_amdgcn_cvt_pk_fp8_f32(s[(4 * q) * 36] * 32.0f, s[(4 * q + 1) * 36] * 32.0f, t, false); t = __builtin_amdgcn_cvt_pk_fp8_f32(s[(4 * q + 2) * 36] * 32.0f, s[(4 * q + 3) * 36] * 32.0f, t, true); w[q] = t; }
        const int col = c.n0 + n; const int p = col >> 1;
        const int drow = c.glu ? ((p >> 7) * 256 + (col & 1) * 128 + (p & 127)) : col;
        *(u32x4*)(c.W8 + (size_t)drow * 1024 + c.k0 + 16 * cc) = (u32x4){(unsigned)w[0], (unsigned)w[1], (unsigned)w[2], (unsigned)w[3]}; }
    LDS_WAIT(); asm volatile("" ::: "memory");
}
__device__ __forceinline__ void convert_chunk(int chunk, const float* w1, const float* w2, unsigned char* W1_8, unsigned char* W2_8, LAS float* scr, int wave, int lane) {
    const int base = chunk * 32 + wave;
    f32x4 ra[8], rb[8];
    ConvItem ca = conv_decode(base, w1, w2, W1_8, W2_8), cb;
    conv_load(ca, ra, lane);
#pragma unroll 1
    for (int j = 0; j < 4; j += 2) {
        cb = conv_decode(base + 8 * (j + 1), w1, w2, W1_8, W2_8); conv_load(cb, rb, lane);
        conv_finish(ca, ra, scr, lane);
        if (j + 2 < 4) { ca = conv_decode(base + 8 * (j + 2), w1, w2, W1_8, W2_8); conv_load(ca, ra, lane); }
        conv_finish(cb, rb, scr, lane);
    }
}
__device__ __forceinline__ int headperm_row(int n0) { const int pn = n0 >> 8, c = n0 & 255, hh = c >> 6, dh = (c & 63) >> 5; return pn * 256 + dh * 128 + hh * 32; }
__device__ __forceinline__ void rms_row_to_bf16(const float* xrow, const float* gain, bf16* orow, int lane) {
    const f32x4* xr = (const f32x4*)xrow + lane; const f32x4* gr = (const f32x4*)gain + lane;
    f32x4 v[4]; float s = 0.f;
#pragma unroll
    for (int j = 0; j < 4; ++j) { v[j] = xr[64 * j]; s += (v[j].x * v[j].x + v[j].y * v[j].y) + (v[j].z * v[j].z + v[j].w * v[j].w); }
    const float rstd = 1.0f / sqrtf(wave_sum(s) * (1.f / DM) + EPS);
    u32x2* o8 = (u32x2*)orow + lane;
#pragma unroll
    for (int j = 0; j < 4; ++j) { const f32x4 gg = gr[64 * j]; u32x2 w; w.x = cvtpk(v[j].x * rstd * gg.x, v[j].y * rstd * gg.y); w.y = cvtpk(v[j].z * rstd * gg.z, v[j].w * rstd * gg.w); o8[64 * j] = w; }
}

__device__ __forceinline__ void rms_row2_to_bf16(const float* xrow, const float* gain, bf16* orow, int lane, float* irs) {
    const f32x4* xr = (const f32x4*)xrow + lane; const f32x4* gr = (const f32x4*)gain + lane;
    f32x4 v[8]; float s0 = 0.f, s1 = 0.f;
#pragma unroll
    for (int j = 0; j < 8; ++j) v[j] = __builtin_nontemporal_load(xr + 64 * j);
#pragma unroll
    for (int j = 0; j < 4; ++j) { s0 += (v[j].x * v[j].x + v[j].y * v[j].y) + (v[j].z * v[j].z + v[j].w * v[j].w); s1 += (v[4 + j].x * v[4 + j].x + v[4 + j].y * v[4 + j].y) + (v[4 + j].z * v[4 + j].z + v[4 + j].w * v[4 + j].w); }
    const float q0 = sqrtf(wave_sum(s0) * (1.f / DM) + EPS), q1 = sqrtf(wave_sum(s1) * (1.f / DM) + EPS); const float r0 = 1.0f / q0, r1 = 1.0f / q1;
    if (irs != nullptr && lane == 0) { irs[0] = q0; irs[1] = q1; }
    u32x2* o8 = (u32x2*)orow + lane;
#pragma unroll
    for (int j = 0; j < 4; ++j) { const f32x4 gg = gr[64 * j]; u32x2 w; w.x = cvtpk(v[j].x * r0 * gg.x, v[j].y * r0 * gg.y); w.y = cvtpk(v[j].z * r0 * gg.z, v[j].w * r0 * gg.w); o8[64 * j] = w;
        u32x2 w2; w2.x = cvtpk(v[4 + j].x * r1 * gg.x, v[4 + j].y * r1 * gg.y); w2.y = cvtpk(v[4 + j].z * r1 * gg.z, v[4 + j].w * r1 * gg.w); o8[256 + 64 * j] = w2; }
}

#include <hip/hip_bf16.h>
namespace attn_body {
using s16x4=__attribute__((ext_vector_type(4)))short;
using f32x16=__attribute__((ext_vector_type(16)))float;
constexpr int D=64,NW=8,QBLK=32,QB=QBLK*NW,KVBLK=64;
__device__ __forceinline__ int crow(int r,int hi){return (r&3)+8*(r>>2)+4*hi;}
#define SBAR() __builtin_amdgcn_sched_barrier(0)
__device__ __forceinline__ void cmask(f32x16&p0,f32x16&p1,int jb,int qrel,int hi){
  const float NEG=-INFINITY; int kb=64*jb+4*hi;
  #pragma unroll
  for(int r=0;r<16;++r){int kv=kb+(r&3)+8*(r>>2); if(kv>qrel)p0[r]=NEG; if(kv+32>qrel)p1[r]=NEG;}
}
constexpr int NSLOT=3, SLOTB=8192;
constexpr int LDS_K=0, LDS_V=NSLOT*SLOTB, LDS_WS=2*NSLOT*SLOTB, LDS_OST=LDS_WS+NW*64*4, ATT_LDS_BYTES=LDS_OST+NW*4096;
__device__ __forceinline__ void glds16(const void*gsrc,unsigned lds_dst){unsigned keep;
  asm volatile("s_mov_b32 %0, m0\n\ts_mov_b32 m0, %2\n\ts_nop 0\n\tglobal_load_lds_dwordx4 %1, off\n\ts_mov_b32 m0, %0":"=&s"(keep):"v"(gsrc),"s"(lds_dst):"memory");}
__device__ __forceinline__ float max3f(float a,float b,float c){float r;asm("v_max3_f32 %0, %1, %2, %3":"=v"(r):"v"(a),"v"(b),"v"(c));return r;}
__device__ __forceinline__ float max2f(float a,float b){float r;asm("v_max_f32_e32 %0, %1, %2":"=v"(r):"v"(a),"v"(b));return r;}
__device__ __forceinline__ float fadd_s(float a,float b){float r;asm("v_add_f32_e32 %0, %1, %2":"=v"(r):"v"(a),"v"(b));return r;}
__device__ __forceinline__ float fsub_s(float a,float b){float r;asm("v_sub_f32_e32 %0, %1, %2":"=v"(r):"v"(a),"v"(b));return r;}
__device__ __forceinline__ unsigned cvtpk_s(float lo,float hi){return cvtpk(lo,hi);}
#define WAIT_BAR(N) asm volatile("s_waitcnt vmcnt(" #N ") lgkmcnt(0)\n\ts_barrier":::"memory")
__device__ __forceinline__ void qkt(f32x16&p0,f32x16&p1,const char*Kslot,const bf16x8*qr,const f32x16&negm,int r32,int hi){
  const char*kb=Kslot+hi*1024+r32*16;
  #pragma unroll
  for(int d0=0;d0<4;++d0){
    const bf16x8 b0=*reinterpret_cast<const bf16x8*>(kb+d0*2048);
    const bf16x8 b1=*reinterpret_cast<const bf16x8*>(kb+d0*2048+512);
    if(d0==0){p0=__builtin_amdgcn_mfma_f32_32x32x16_bf16(b0,qr[0],negm,0,0,0);p1=__builtin_amdgcn_mfma_f32_32x32x16_bf16(b1,qr[0],negm,0,0,0);}
    else{p0=__builtin_amdgcn_mfma_f32_32x32x16_bf16(b0,qr[d0],p0,0,0,0);p1=__builtin_amdgcn_mfma_f32_32x32x16_bf16(b1,qr[d0],p1,0,0,0);}}
}
typedef __attribute__((address_space(3))) const char* lds_cptr;
typedef short v4i16_t __attribute__((ext_vector_type(4)));
__device__ __forceinline__ void kload8(bf16x8*kf,lds_cptr kp){
  kf[0]=*(const __attribute__((address_space(3))) bf16x8*)(kp);      kf[1]=*(const __attribute__((address_space(3))) bf16x8*)(kp+512);
  kf[2]=*(const __attribute__((address_space(3))) bf16x8*)(kp+2048); kf[3]=*(const __attribute__((address_space(3))) bf16x8*)(kp+2560);
  kf[4]=*(const __attribute__((address_space(3))) bf16x8*)(kp+4096); kf[5]=*(const __attribute__((address_space(3))) bf16x8*)(kp+4608);
  kf[6]=*(const __attribute__((address_space(3))) bf16x8*)(kp+6144); kf[7]=*(const __attribute__((address_space(3))) bf16x8*)(kp+6656);
}
__device__ __forceinline__ void kload2(bf16x8*kf,lds_cptr kp,int j){ kf[2*j]=*(const __attribute__((address_space(3))) bf16x8*)(kp+j*2048); kf[2*j+1]=*(const __attribute__((address_space(3))) bf16x8*)(kp+j*2048+512); }
__device__ __forceinline__ s16x4 vtr(lds_cptr p){ return __builtin_bit_cast(s16x4,__builtin_amdgcn_ds_read_tr16_b64_v4i16((__attribute__((address_space(3))) v4i16_t*)p)); }
__device__ __forceinline__ float rowmax(const f32x16&p0,const f32x16&p1){
  float a=max3f(p0[0],p0[1],p1[0]),b=max3f(p0[2],p0[3],p1[1]);a=max3f(a,p1[2],p1[3]);
  #pragma unroll
  for(int r=4;r<16;r+=4){a=max3f(a,p0[r],p0[r+1]);b=max3f(b,p0[r+2],p0[r+3]);a=max3f(a,p1[r],p1[r+1]);b=max3f(b,p1[r+2],p1[r+3]);}
  const float m=max2f(a,b);
  auto rr=__builtin_amdgcn_permlane32_swap(__float_as_uint(m),__float_as_uint(m),false,false);
  return max2f(__uint_as_float(rr[0]),__uint_as_float(rr[1]));
}
__device__ __forceinline__ void pv(f32x16*o,int vb,bf16x8 pa0,bf16x8 pa1,bf16x8 pa2,bf16x8 pa3){
  #pragma unroll
  for(int d0=0;d0<2;++d0){s16x4 lo[4],hi[4];
    #pragma unroll
    for(int ks=0;ks<4;++ks){
      asm volatile("ds_read_b64_tr_b16 %0,%1 offset:%c2":"=&v"(lo[ks]):"v"(vb),"i"(d0*4096+ks*1024):"memory");
      asm volatile("ds_read_b64_tr_b16 %0,%1 offset:%c2":"=&v"(hi[ks]):"v"(vb),"i"(d0*4096+ks*1024+512):"memory");}
    asm volatile("s_waitcnt lgkmcnt(0)":::"memory");SBAR();
    #define PK(k) (bf16x8){lo[k][0],lo[k][1],lo[k][2],lo[k][3],hi[k][0],hi[k][1],hi[k][2],hi[k][3]}
    o[d0]=__builtin_amdgcn_mfma_f32_32x32x16_bf16(pa0,PK(0),o[d0],0,0,0);
    o[d0]=__builtin_amdgcn_mfma_f32_32x32x16_bf16(pa1,PK(1),o[d0],0,0,0);
    o[d0]=__builtin_amdgcn_mfma_f32_32x32x16_bf16(pa2,PK(2),o[d0],0,0,0);
    o[d0]=__builtin_amdgcn_mfma_f32_32x32x16_bf16(pa3,PK(3),o[d0],0,0,0);
    #undef PK
  }
}
template<int THRL,int KP,int OP,bool MOBA> __device__ __forceinline__ void attn_unit(const bf16*Qu,const bf16*__restrict__ Kh,const bf16*__restrict__ Vh,bf16*Ou,const int NT,const int nblk,const float*kmean,char*shm){
  const int tid=opaque((int)threadIdx.x),lane=tid&63,r32=lane&31,hi=lane>>5; const int wid=__builtin_amdgcn_readfirstlane(tid>>6);
  const bf16*Qw=Qu+(long)(wid*QBLK)*KP;
  const unsigned lds0=(unsigned)(uintptr_t)shm;
  float*wsf=(float*)(shm+LDS_WS)+wid*64;
  const bf16*ksrc=Kh+(long)lane*KP+wid*8;
  const bf16*vsrc=Vh+(long)(16*(wid&3)+(lane>>2))*KP+(wid>>2)*32+(lane&3)*8;
  const unsigned kdst=lds0+LDS_K+wid*1024, vdst=lds0+LDS_V+wid*1024;
  #define DMA_K(t,slot) glds16(ksrc+(long)(t)*KVBLK*KP,(unsigned)__builtin_amdgcn_readfirstlane(kdst+(slot)))
  #define DMA_V(t,slot) glds16(vsrc+(long)(t)*KVBLK*KP,(unsigned)__builtin_amdgcn_readfirstlane(vdst+(slot)))
  const int vb0=(int)(lds0+LDS_V)+((lane>>4)&1)*32+(lane&3)*8+(4*hi+((lane&15)>>2))*64;
  const char*Kbase=shm+LDS_K; bf16x8 kf[8];
  const lds_cptr shm3=(lds_cptr)shm; const lds_cptr kp0=shm3+LDS_K+hi*1024+r32*16; const lds_cptr vp0=shm3+LDS_V+((lane>>4)&1)*32+(lane&3)*8+(4*hi+((lane&15)>>2))*64;
  DMA_K(0,0);DMA_V(0,0);DMA_K(1,SLOTB);
  bf16x8 qr[4];
  #pragma unroll
  for(int d0=0;d0<4;++d0)qr[d0]=*reinterpret_cast<const bf16x8*>(&Qw[(long)r32*KP+d0*16+hi*8]);
  unsigned bmask=0xffffffffu;
  if(MOBA){
    bmask=1u<<nblk;
    float g0=-3e38f,g1=-3e38f,g2=-3e38f; int i0=-1,i1=-1,i2=-1;
    for(int j=0;j<nblk;++j){
      const float*km=kmean+(long)j*512+8*hi; float g=0.f;
      #pragma unroll
      for(int d0=0;d0<4;++d0){ const f32x4 a=*(const f32x4*)(km+16*d0),b=*(const f32x4*)(km+16*d0+4);
        g+=bf2f((unsigned short)qr[d0][0])*a[0]+bf2f((unsigned short)qr[d0][1])*a[1]+bf2f((unsigned short)qr[d0][2])*a[2]+bf2f((unsigned short)qr[d0][3])*a[3];
        g+=bf2f((unsigned short)qr[d0][4])*b[0]+bf2f((unsigned short)qr[d0][5])*b[1]+bf2f((unsigned short)qr[d0][6])*b[2]+bf2f((unsigned short)qr[d0][7])*b[3]; }
      g+=__shfl_xor(g,32);
      if(g>g0){g2=g1;i2=i1;g1=g0;i1=i0;g0=g;i0=j;} else if(g>g1){g2=g1;i2=i1;g1=g;i1=j;} else if(g>g2){g2=g;i2=j;}
    }
    if(i0>=0)bmask|=1u<<i0; if(i1>=0)bmask|=1u<<i1; if(i2>=0)bmask|=1u<<i2;
  }
  #define NEGM_FOR(t) (MOBA ? (((bmask>>((t)>>2))&1u) ? -mhat : -INFINITY) : -mhat)
  float mhat=0.f,l_reg=0.f;f32x16 o[2];o[0]=f32x16{};o[1]=f32x16{};f32x16 negm;
  { const float nm=NEGM_FOR(0);
    #pragma unroll
    for(int r=0;r<16;++r)negm[r]=nm; }
  asm volatile("":"+v"(negm));
  const int qrel=wid*QBLK+r32;
  #define CMASK(P0,P1,t) do{ if(MOBA){int jb_=(t)-(NT-4); if(jb_>=0)cmask(P0,P1,jb_,qrel,hi);} }while(0)
  bool resc=false;
  #define START(P0,P1) do{ const float rm=rowmax(P0,P1); resc=false; \
    { const float dl=(MOBA&&rm==-INFINITY)?0.f:rm; mhat=fadd_s(mhat,dl); \
      _Pragma("unroll") for(int r=0;r<16;++r){P0[r]=fsub_s(P0[r],dl);P1[r]=fsub_s(P1[r],dl);} \
      { const float nm=NEGM_FOR(1); _Pragma("unroll") for(int r=0;r<16;++r)negm[r]=nm; } asm volatile("":"+v"(negm)); } \
    _Pragma("unroll") for(int r=0;r<16;++r)P0[r]=__builtin_amdgcn_exp2f(P0[r]); }while(0)
  #define RESC() do{ if(resc){ asm volatile("s_waitcnt lgkmcnt(0)":::"memory"); \
      _Pragma("unroll") for(int d_=0;d_<2;++d_) _Pragma("unroll") for(int r=0;r<16;++r)o[d_][r]*=wsf[crow(r,hi)]; } }while(0)
  f32x16 pA0,pA1,pB0,pB1;
  int sl_prev=0,sl_cur=0,sl_next=SLOTB;
  #define ROT() do{sl_prev=sl_cur;sl_cur=sl_next;sl_next=(sl_next==(NSLOT-1)*SLOTB)?0:sl_next+SLOTB;}while(0)
  DMA_K(2,2*SLOTB);
  WAIT_BAR(3);
  qkt(pA0,pA1,Kbase,qr,negm,r32,hi);asm volatile("s_nop 15\n\ts_nop 7":"+v"(pA0),"+v"(pA1));CMASK(pA0,pA1,0);
  START(pA0,pA1);
  _Pragma("unroll") for(int r=0;r<16;++r)pA1[r]=__builtin_amdgcn_exp2f(pA1[r]);
  WAIT_BAR(0);
  DMA_K(3,0);DMA_V(1,SLOTB);
  ROT();
  kload8(kf,kp0+sl_cur);
  WAIT_BAR(2);
  s16x4 vlo[8],vhi[8]; u32x4 pw0,pw1,pw2,pw3;
  #define PKW(P,B) cvtpk_s(P[B],P[B+1])
  #define PAF(k) __builtin_bit_cast(bf16x8,pw##k)
  #define VFR(i) (bf16x8){vlo[i][0],vlo[i][1],vlo[i][2],vlo[i][3],vhi[i][0],vhi[i][1],vhi[i][2],vhi[i][3]}
  #define PIN(x) asm volatile("":"+v"(x))
  #define MX3(a,b,c) __builtin_fmaxf(__builtin_fmaxf((a),(b)),(c))
  #define GAPA(MF,A0,A1,A2,A3,W0,W1,PW) do{ MF; sacc+=A0; sacc+=A1; sacc+=A2; sacc+=A3; PIN(sacc); W0; W1; PIN(PW); SBAR(); }while(0)
  #define EX(v) __builtin_amdgcn_exp2f(v)
  #define GAPB(MF,X,B) do{ MF; X[B]=EX(X[B]); X[B+1]=EX(X[B+1]); X[B+2]=EX(X[B+2]); X[B+3]=EX(X[B+3]); PIN(X); SBAR(); }while(0)
  #define VRD(i) do{ vlo[i]=vtr(vp_+(((i)>>2)*4096+((i)&3)*1024)); vhi[i]=vtr(vp_+(((i)>>2)*4096+((i)&3)*1024+512)); }while(0)
  #define KRD(G,j) do{ if(G){ kload2(kf,kp0+sl_next,j); SBAR(); } }while(0)
  #define STEP(C0,C1,P0,P1,t,GK,GV,GL) do{ SBAR(); \
    const lds_cptr vp_=vp0+sl_prev; \
    VRD(0); SBAR(); float sacc=(P0[0]+P0[1]); \
    GAPA(C0=__builtin_amdgcn_mfma_f32_32x32x16_bf16(kf[0],qr[0],negm,0,0,0), P0[2],P0[3],P0[4],P0[5],     pw0[0]=PKW(P0,0), pw0[1]=PKW(P0,2), pw0); \
    VRD(4); SBAR(); GAPA(C1=__builtin_amdgcn_mfma_f32_32x32x16_bf16(kf[1],qr[0],negm,0,0,0), P0[6],P0[7],P0[8],P0[9],     pw0[2]=PKW(P0,4), pw0[3]=PKW(P0,6), pw0); \
    VRD(1); SBAR(); GAPA(C0=__builtin_amdgcn_mfma_f32_32x32x16_bf16(kf[2],qr[1],C0,0,0,0),   P0[10],P0[11],P0[12],P0[13], pw1[0]=PKW(P0,8), pw1[1]=PKW(P0,10), pw1); \
    VRD(5); SBAR(); GAPA(C1=__builtin_amdgcn_mfma_f32_32x32x16_bf16(kf[3],qr[1],C1,0,0,0),   P0[14],P0[15],P1[0],P1[1],   pw1[2]=PKW(P0,12),pw1[3]=PKW(P0,14), pw1); \
    VRD(2); SBAR(); GAPA(C0=__builtin_amdgcn_mfma_f32_32x32x16_bf16(kf[4],qr[2],C0,0,0,0),   P1[2],P1[3],P1[4],P1[5],     pw2[0]=PKW(P1,0), pw2[1]=PKW(P1,2), pw2); \
    VRD(6); SBAR(); GAPA(C1=__builtin_amdgcn_mfma_f32_32x32x16_bf16(kf[5],qr[2],C1,0,0,0),   P1[6],P1[7],P1[8],P1[9],     pw2[2]=PKW(P1,4), pw2[3]=PKW(P1,6), pw2); \
    VRD(3); SBAR(); GAPA(C0=__builtin_amdgcn_mfma_f32_32x32x16_bf16(kf[6],qr[3],C0,0,0,0),   P1[10],P1[11],P1[12],P1[13], pw3[0]=PKW(P1,8), pw3[1]=PKW(P1,10), pw3); \
    VRD(7); SBAR(); GAPA(C1=__builtin_amdgcn_mfma_f32_32x32x16_bf16(kf[7],qr[3],C1,0,0,0),   P1[14],P1[15],0.f,0.f,       pw3[2]=PKW(P1,12),pw3[3]=PKW(P1,14), pw3); \
    l_reg+=sacc; \
    if(GK){DMA_K((t)+3,sl_cur);} if(GV){DMA_V((t)+1,sl_next);} \
    CMASK(C0,C1,t); \
    { float a=MX3(C0[0],C0[1],C1[0]),b=MX3(C0[2],C0[3],C1[1]); a=MX3(a,C1[2],C1[3]); \
      _Pragma("unroll") for(int r=4;r<16;r+=4){a=MX3(a,C0[r],C0[r+1]);b=MX3(b,C0[r+2],C0[r+3]);a=MX3(a,C1[r],C1[r+1]);b=MX3(b,C1[r+2],C1[r+3]);} \
      float rm=__builtin_fmaxf(a,b); { auto rr=__builtin_amdgcn_permlane32_swap(__float_as_uint(rm),__float_as_uint(rm),false,false); rm=__builtin_fmaxf(__uint_as_float(rr[0]),__uint_as_float(rr[1])); } \
      resc=false; \
      if(__builtin_expect(__any(rm>(float)THRL),0)){ const float dl=__builtin_fmaxf(rm,0.f); mhat+=dl; \
        _Pragma("unroll") for(int r=0;r<16;++r){C0[r]-=dl;C1[r]-=dl;} \
        if(!MOBA){ _Pragma("unroll") for(int r=0;r<16;++r)negm[r]=-mhat; asm volatile("":"+v"(negm)); } \
        const float f=__builtin_amdgcn_exp2f(-dl); l_reg*=f; if(hi==0)wsf[r32]=f; resc=true; } \
      if(MOBA){ if(resc||((((t)+1)&3)==0)){ const float nm=NEGM_FOR((t)+1); _Pragma("unroll") for(int r=0;r<16;++r)negm[r]=nm; asm volatile("":"+v"(negm)); } } } \
    SBAR(); \
    GAPB(o[0]=__builtin_amdgcn_mfma_f32_32x32x16_bf16(PAF(0),VFR(0),o[0],0,0,0), C0,0); \
    GAPB(o[1]=__builtin_amdgcn_mfma_f32_32x32x16_bf16(PAF(0),VFR(4),o[1],0,0,0), C0,4); \
    KRD(GL,0); GAPB(o[0]=__builtin_amdgcn_mfma_f32_32x32x16_bf16(PAF(1),VFR(1),o[0],0,0,0), C0,8); \
    KRD(GL,1); GAPB(o[1]=__builtin_amdgcn_mfma_f32_32x32x16_bf16(PAF(1),VFR(5),o[1],0,0,0), C0,12); \
    KRD(GL,2); GAPB(o[0]=__builtin_amdgcn_mfma_f32_32x32x16_bf16(PAF(2),VFR(2),o[0],0,0,0), C1,0); \
    KRD(GL,3); GAPB(o[1]=__builtin_amdgcn_mfma_f32_32x32x16_bf16(PAF(2),VFR(6),o[1],0,0,0), C1,4); \
    GAPB(o[0]=__builtin_amdgcn_mfma_f32_32x32x16_bf16(PAF(3),VFR(3),o[0],0,0,0), C1,8); \
    GAPB(o[1]=__builtin_amdgcn_mfma_f32_32x32x16_bf16(PAF(3),VFR(7),o[1],0,0,0), C1,12); \
    }while(0)
  int t=1;
  #undef CMASK
  #define CMASK(P0,P1,t) do{}while(0)
  for(;t+5<NT;t+=2){
    STEP(pB0,pB1,pA0,pA1,t,true,true,true);     WAIT_BAR(2); RESC(); ROT();
    STEP(pA0,pA1,pB0,pB1,t+1,true,true,true);   WAIT_BAR(2); RESC(); ROT();
  }
  #undef CMASK
  #define CMASK(P0,P1,t) do{ if(MOBA){int jb_=(t)-(NT-4); if(jb_>=0)cmask(P0,P1,jb_,qrel,hi);} }while(0)
  #define ENDW(tt) do{ if((tt)+3<NT){WAIT_BAR(2);} else if((tt)+2<NT){WAIT_BAR(1);} else {WAIT_BAR(0);} }while(0)
  for(;t+1<NT;t+=2){
    STEP(pB0,pB1,pA0,pA1,t,(t+3<NT),(t+1<NT),(t+1<NT));       ENDW(t);   RESC(); ROT();
    STEP(pA0,pA1,pB0,pB1,t+1,(t+4<NT),(t+2<NT),(t+2<NT));     ENDW(t+1); RESC(); ROT();
  }
  STEP(pB0,pB1,pA0,pA1,NT-1,false,false,false); RESC();
  { float sacc=pB0[0]+pB0[1]; _Pragma("unroll") for(int r=2;r<16;++r)sacc+=pB0[r]; _Pragma("unroll") for(int r=0;r<16;++r)sacc+=pB1[r]; l_reg+=sacc;
    pw0=(u32x4){PKW(pB0,0),PKW(pB0,2),PKW(pB0,4),PKW(pB0,6)};pw1=(u32x4){PKW(pB0,8),PKW(pB0,10),PKW(pB0,12),PKW(pB0,14)};pw2=(u32x4){PKW(pB1,0),PKW(pB1,2),PKW(pB1,4),PKW(pB1,6)};pw3=(u32x4){PKW(pB1,8),PKW(pB1,10),PKW(pB1,12),PKW(pB1,14)};
    SBAR(); pv(o,vb0+sl_cur,PAF(0),PAF(1),PAF(2),PAF(3)); }
  #undef PKW
  #undef PAF
  #undef VFR
  #undef PIN
  #undef MX3
  #undef GAPA
  #undef GAPB
  #undef EX
  #undef VRD
  #undef KRD
  #undef STEP
  #undef ENDW
  {auto rr=__builtin_amdgcn_permlane32_swap(__float_as_uint(l_reg),__float_as_uint(l_reg),false,false);l_reg=__uint_as_float(rr[0])+__uint_as_float(rr[1]);}
  if(hi==0)wsf[32+r32]=l_reg;asm volatile("s_waitcnt lgkmcnt(0)":::"memory");
  float rli[16];
  #pragma unroll
  for(int r=0;r<16;++r)rli[r]=__builtin_amdgcn_rcpf(wsf[32+crow(r,hi)]);
  bf16*Ow=Ou+(long)(wid*QBLK)*OP;
  { bf16*stg=(bf16*)(shm+LDS_OST)+wid*2048;
    #pragma unroll
    for(int r=0;r<16;++r){const int orow=crow(r,hi);
      #pragma unroll
      for(int d0=0;d0<2;++d0)stg[orow*64+d0*32+r32]=(bf16)(cvtpk(o[d0][r]*rli[r],0.f)&0xffffu);}
    asm volatile("s_waitcnt lgkmcnt(0)":::"memory");
    #pragma unroll
    for(int i=0;i<4;++i){const int row=i*8+(lane>>3),ch=lane&7; const u32x4 v=*(const u32x4*)(stg+row*64+ch*8); *(u32x4*)(Ow+(long)row*OP+ch*8)=v;} }
  asm volatile("s_waitcnt lgkmcnt(0)\n\ts_barrier":::"memory");
  #undef DMA_K
  #undef DMA_V
  #undef CMASK
  #undef START
  #undef RESC
  #undef ROT
  #undef NEGM_FOR
}
#undef SBAR
#undef WAIT_BAR
}

namespace ret_body {
using attn_body::s16x4; using attn_body::f32x16; using attn_body::glds16; using attn_body::pv; using attn_body::crow;
constexpr int KVF_BYTES = 64 * 64 * 4;
__device__ __forceinline__ void kv_unit(const bf16* KR, const bf16* VR, float* KVF, int b, int h, int cp, char* shm) {
  const int tid = opaque((int)threadIdx.x), lane = tid & 63, r32 = lane & 31, hi = lane >> 5; const int wid = __builtin_amdgcn_readfirstlane(tid >> 6);
  const unsigned lds0 = (unsigned)(uintptr_t)shm;
  const size_t rowb = (size_t)b * SEQ + (size_t)cp * 256;
  const long voff = (long)(16 * (wid & 3) + (lane >> 2)) * 256 + h * 64 + (wid >> 2) * 32 + (lane & 3) * 8;
#pragma unroll
  for (int c = 0; c < 2; ++c)
#pragma unroll
    for (int tl = 0; tl < 2; ++tl) {
      const size_t r0 = rowb + c * 128 + tl * 64;
      glds16(KR + r0 * 256 + voff, (unsigned)__builtin_amdgcn_readfirstlane(lds0 + ((c * 2 + 0) * 2 + tl) * 8192 + wid * 1024));
      glds16(VR + r0 * 256 + voff, (unsigned)__builtin_amdgcn_readfirstlane(lds0 + ((c * 2 + 1) * 2 + tl) * 8192 + wid * 1024));
    }
  asm volatile("s_waitcnt vmcnt(0) lgkmcnt(0)\n\ts_barrier" ::: "memory");
  const int c = wid >> 2, dkb = (wid >> 1) & 1, dvb = wid & 1;
  const int vb = (int)lds0 + ((lane >> 4) & 1) * 32 + (lane & 3) * 8 + (4 * hi + ((lane & 15) >> 2)) * 64;
  f32x16 acc = f32x16{};
#pragma unroll
  for (int tl = 0; tl < 2; ++tl) {
    s16x4 alo[4], ahi[4], blo[4], bhi[4];
    const int ka = vb + ((c * 2 + 0) * 2 + tl) * 8192 + dkb * 4096, va = vb + ((c * 2 + 1) * 2 + tl) * 8192 + dvb * 4096;
#pragma unroll
    for (int ks = 0; ks < 4; ++ks) {
      asm volatile("ds_read_b64_tr_b16 %0,%1 offset:%c2" : "=&v"(alo[ks]) : "v"(ka), "i"(ks * 1024) : "memory");
      asm volatile("ds_read_b64_tr_b16 %0,%1 offset:%c2" : "=&v"(ahi[ks]) : "v"(ka), "i"(ks * 1024 + 512) : "memory");
      asm volatile("ds_read_b64_tr_b16 %0,%1 offset:%c2" : "=&v"(blo[ks]) : "v"(va), "i"(ks * 1024) : "memory");
      asm volatile("ds_read_b64_tr_b16 %0,%1 offset:%c2" : "=&v"(bhi[ks]) : "v"(va), "i"(ks * 1024 + 512) : "memory");
    }
    asm volatile("s_waitcnt lgkmcnt(0)" ::: "memory"); __builtin_amdgcn_sched_barrier(0);
#pragma unroll
    for (int ks = 0; ks < 4; ++ks) {
      const bf16x8 af = (bf16x8){alo[ks][0], alo[ks][1], alo[ks][2], alo[ks][3], ahi[ks][0], ahi[ks][1], ahi[ks][2], ahi[ks][3]};
      const bf16x8 bfr = (bf16x8){blo[ks][0], blo[ks][1], blo[ks][2], blo[ks][3], bhi[ks][0], bhi[ks][1], bhi[ks][2], bhi[ks][3]};
      acc = __builtin_amdgcn_mfma_f32_32x32x16_bf16(af, bfr, acc, 0, 0, 0);
    }
  }
  const float lgam = __builtin_amdgcn_logf(1.0f - __builtin_amdgcn_exp2f(-5.0f - (float)h));
  const float g127 = __builtin_amdgcn_exp2f(lgam * 127.0f);
  float* outp = KVF + ((size_t)((b * 4 + h) * 32 + cp * 2 + c)) * 4096 + dvb * 32 + r32;
#pragma unroll
  for (int r = 0; r < 16; ++r) outp[(size_t)(dkb * 32 + crow(r, hi)) * 64] = acc[r] * g127;
  asm volatile("s_waitcnt lgkmcnt(0)\n\ts_barrier" ::: "memory");
}

__device__ __forceinline__ void out_unit(const bf16* QR, const bf16* KR, const bf16* VR, const bf16* GR, const float* KVF, const float* rgain, bf16* Y, int b, int h, int cp, char* shm) {
  const int tid = opaque((int)threadIdx.x), lane = tid & 63, r32 = lane & 31, hi = lane >> 5; const int wid = __builtin_amdgcn_readfirstlane(tid >> 6);
  const unsigned lds0 = (unsigned)(uintptr_t)shm;
  constexpr int L_K = 0, L_V = 32768, L_S = 65536, L_O = 81920;
  const size_t rowb = (size_t)b * SEQ + (size_t)cp * 256;
  const long koff = (long)lane * 256 + h * 64 + wid * 8;
  const long voff = (long)(16 * (wid & 3) + (lane >> 2)) * 256 + h * 64 + (wid >> 2) * 32 + (lane & 3) * 8;
#pragma unroll
  for (int tl = 0; tl < 4; ++tl) {
    const size_t r0 = rowb + tl * 64;
    glds16(KR + r0 * 256 + koff, (unsigned)__builtin_amdgcn_readfirstlane(lds0 + L_K + tl * 8192 + wid * 1024));
    glds16(VR + r0 * 256 + voff, (unsigned)__builtin_amdgcn_readfirstlane(lds0 + L_V + tl * 8192 + wid * 1024));
  }
  {
    const float lgam = __builtin_amdgcn_logf(1.0f - __builtin_amdgcn_exp2f(-5.0f - (float)h));
    const float lgc = lgam * 128.0f;
    const int n0 = 2 * cp;
    int mlo = n0 - 1 - (int)(34.0f / (-lgc)); if (mlo < 0) mlo = 0;
    const float* kvp = KVF + ((size_t)((b * 4 + h) * 32)) * 4096 + tid * 8;
    f32x4 s0 = {0.f, 0.f, 0.f, 0.f}, s1 = {0.f, 0.f, 0.f, 0.f};
    int m = mlo;
    for (; m + 8 <= n0; m += 8) {
      f32x4 a[8], c4[8];
#pragma unroll
      for (int q = 0; q < 8; ++q) { a[q] = *(const f32x4*)(kvp + (size_t)(m + q) * 4096); c4[q] = *(const f32x4*)(kvp + (size_t)(m + q) * 4096 + 4); }
#pragma unroll
      for (int q = 0; q < 8; ++q) { const float w = __builtin_amdgcn_exp2f(lgc * (float)(n0 - 1 - m - q)); s0 += a[q] * w; s1 += c4[q] * w; }
    }
    for (; m + 4 <= n0; m += 4) {
      f32x4 a[4], c4[4];
#pragma unroll
      for (int q = 0; q < 4; ++q) { a[q] = *(const f32x4*)(kvp + (size_t)(m + q) * 4096); c4[q] = *(const f32x4*)(kvp + (size_t)(m + q) * 4096 + 4); }
#pragma unroll
      for (int q = 0; q < 4; ++q) { const float w = __builtin_amdgcn_exp2f(lgc * (float)(n0 - 1 - m - q)); s0 += a[q] * w; s1 += c4[q] * w; }
    }
    for (; m < n0; ++m) {
      const float w = __builtin_amdgcn_exp2f(lgc * (float)(n0 - 1 - m));
      const f32x4 a = *(const f32x4*)(kvp + (size_t)m * 4096), c4 = *(const f32x4*)(kvp + (size_t)m * 4096 + 4);
      s0 += a * w; s1 += c4 * w;
    }
    const int dk = tid >> 3, dv = 8 * (tid & 7);
    char* sp = shm + L_S + (dv >> 5) * 4096 + dk * 64 + (dv & 31) * 2;
    u32x4 w0; w0.x = cvtpk(s0[0], s0[1]); w0.y = cvtpk(s0[2], s0[3]); w0.z = cvtpk(s1[0], s1[1]); w0.w = cvtpk(s1[2], s1[3]);
    *(u32x4*)sp = w0;
    const float dc = __builtin_amdgcn_exp2f(lgc);
    const f32x4 a = *(const f32x4*)(kvp + (size_t)n0 * 4096), c4 = *(const f32x4*)(kvp + (size_t)n0 * 4096 + 4);
    s0 = s0 * dc + a; s1 = s1 * dc + c4;
    u32x4 w1; w1.x = cvtpk(s0[0], s0[1]); w1.y = cvtpk(s0[2], s0[3]); w1.z = cvtpk(s1[0], s1[1]); w1.w = cvtpk(s1[2], s1[3]);
    *(u32x4*)(sp + 8192) = w1;
  }
  const int c = wid >> 2, wq = wid & 3;
  const bf16* Qw = QR + (rowb + c * 128 + wq * 32 + r32) * 256 + h * 64;
  bf16x8 qr[4]; u32x4 qa[4];
#pragma unroll
  for (int d0 = 0; d0 < 4; ++d0) qr[d0] = *reinterpret_cast<const bf16x8*>(Qw + d0 * 16 + hi * 8);
#pragma unroll
  for (int k = 0; k < 4; ++k) { const u32x2 lo = *(const u32x2*)(Qw + 16 * k + 4 * hi), hi2 = *(const u32x2*)(Qw + 16 * k + 8 + 4 * hi); qa[k] = (u32x4){lo.x, lo.y, hi2.x, hi2.y}; }
  asm volatile("s_waitcnt vmcnt(0) lgkmcnt(0)\n\ts_barrier" ::: "memory");
  const int vb = (int)lds0 + ((lane >> 4) & 1) * 32 + (lane & 3) * 8 + (4 * hi + ((lane & 15) >> 2)) * 64;
  f32x16 o[2]; o[0] = f32x16{}; o[1] = f32x16{};
  pv(o, vb + L_S + c * 8192, __builtin_bit_cast(bf16x8, qa[0]), __builtin_bit_cast(bf16x8, qa[1]), __builtin_bit_cast(bf16x8, qa[2]), __builtin_bit_cast(bf16x8, qa[3]));
  { const float gam = 1.0f - __builtin_amdgcn_exp2f(-5.0f - (float)h);
#pragma unroll
    for (int d0 = 0; d0 < 2; ++d0)
#pragma unroll
      for (int r = 0; r < 16; ++r) o[d0][r] *= gam; }
  const f32x16 zero = f32x16{};
  const int irow = wq * 32 + r32;
  for (int tl = 0; tl <= (wq >> 1); ++tl) {
    f32x16 p0, p1;
    attn_body::qkt(p0, p1, shm + L_K + (c * 2 + tl) * 8192, qr, zero, r32, hi);
    asm volatile("s_nop 15\n\ts_nop 7" : "+v"(p0), "+v"(p1));
#pragma unroll
    for (int r = 0; r < 16; ++r) { const int kj = 64 * tl + crow(r, hi); if (kj > irow) p0[r] = 0.f; if (kj + 32 > irow) p1[r] = 0.f; }
    u32x4 pw0, pw1, pw2, pw3;
    pw0 = (u32x4){cvtpk(p0[0], p0[1]), cvtpk(p0[2], p0[3]), cvtpk(p0[4], p0[5]), cvtpk(p0[6], p0[7])}; pw1 = (u32x4){cvtpk(p0[8], p0[9]), cvtpk(p0[10], p0[11]), cvtpk(p0[12], p0[13]), cvtpk(p0[14], p0[15])};
    pw2 = (u32x4){cvtpk(p1[0], p1[1]), cvtpk(p1[2], p1[3]), cvtpk(p1[4], p1[5]), cvtpk(p1[6], p1[7])}; pw3 = (u32x4){cvtpk(p1[8], p1[9]), cvtpk(p1[10], p1[11]), cvtpk(p1[12], p1[13]), cvtpk(p1[14], p1[15])};
    __builtin_amdgcn_sched_barrier(0);
    pv(o, vb + L_V + (c * 2 + tl) * 8192, __builtin_bit_cast(bf16x8, pw0), __builtin_bit_cast(bf16x8, pw1), __builtin_bit_cast(bf16x8, pw2), __builtin_bit_cast(bf16x8, pw3));
  }
  asm volatile("s_waitcnt lgkmcnt(0)\n\ts_barrier" ::: "memory");
  { float* stg = (float*)(shm + L_O) + wid * 2048;
#pragma unroll
    for (int r = 0; r < 16; ++r) { const int orow = crow(r, hi);
#pragma unroll
      for (int d0 = 0; d0 < 2; ++d0) stg[orow * 64 + d0 * 32 + r32] = o[d0][r]; }
    asm volatile("s_waitcnt lgkmcnt(0)" ::: "memory");
    const int row = lane >> 1, half = lane & 1;
    const f32x4* sr = (const f32x4*)(stg + row * 64 + half * 32);
    f32x4 v[8]; float ss = 0.f;
#pragma unroll
    for (int i = 0; i < 8; ++i) { v[i] = sr[i]; ss += (v[i][0] * v[i][0] + v[i][1] * v[i][1]) + (v[i][2] * v[i][2] + v[i][3] * v[i][3]); }
    ss += __shfl_xor(ss, 1);
    const float rstd = 1.0f / sqrtf(ss * (1.0f / 64.0f) + EPS);
    const size_t grow = rowb + c * 128 + wq * 32 + row;
    const u32x4* gp = (const u32x4*)(GR + grow * 256 + h * 64 + half * 32);
    const f32x4* rg = (const f32x4*)(rgain + h * 64 + half * 32);
    u32x4* yp = (u32x4*)(Y + grow * DM + 512 + h * 64 + half * 32);
#pragma unroll
    for (int i = 0; i < 4; ++i) {
      const u32x4 gw = gp[i]; const f32x4 g0 = rg[2 * i], g1 = rg[2 * i + 1]; const f32x4 a = v[2 * i] * rstd * g0, c4 = v[2 * i + 1] * rstd * g1;
      u32x4 w; w.x = cvtpk(a[0] * bflo(gw.x), a[1] * bfhi(gw.x)); w.y = cvtpk(a[2] * bflo(gw.y), a[3] * bfhi(gw.y)); w.z = cvtpk(c4[0] * bflo(gw.z), c4[1] * bfhi(gw.z)); w.w = cvtpk(c4[2] * bflo(gw.w), c4[3] * bfhi(gw.w));
      yp[i] = w;
    }
  }
  asm volatile("s_waitcnt lgkmcnt(0)\n\ts_barrier" ::: "memory");
}
}

#define XB_TMO      128
#define XB_XCNT(j)  (256  + 64 * (j))
#define XB_XSUB(j)  (1280 + 64 * (j))
#define XB_XGEN(j)  (2304 + 64 * (j))
#define XB_TOP      3328
#define XB_TOPGEN   3392
#define XCD_BAR_WORDS 3456
#define XB_SPIN_CAP (1u << 18)
__device__ __forceinline__ unsigned xb_ld(unsigned* p)              { return __hip_atomic_load(p, __ATOMIC_RELAXED, __HIP_MEMORY_SCOPE_AGENT); }
__device__ __forceinline__ unsigned xb_add(unsigned* p, unsigned v) { return __hip_atomic_fetch_add(p, v, __ATOMIC_RELAXED, __HIP_MEMORY_SCOPE_AGENT); }
__device__ __forceinline__ unsigned xb_xcc_id() { return (unsigned)__builtin_amdgcn_s_getreg((3 << 11) | 20) & 0xFu; }
#define XB_SPIN(cond, bar) do { unsigned _sp = 0; while (cond) { __builtin_amdgcn_s_sleep(1); \
    if ((++_sp & 255u) == 0u) { if (xb_ld(&(bar)[XB_TMO])) break; if (_sp > XB_SPIN_CAP) { atomicAdd(&(bar)[XB_TMO], 1u); break; } } } } while (0)
struct XcdBarrier { unsigned* bar; unsigned x; volatile LAS unsigned* st; };
__device__ __forceinline__ XcdBarrier xcd_barrier_post(unsigned* bar, volatile LAS unsigned* st) {
    XcdBarrier b; b.bar = bar; b.x = xb_xcc_id(); b.st = st;
    if (threadIdx.x == 0) (void)xb_add(&bar[XB_XCNT(b.x)], 1u);
    return b;
}
__device__ __forceinline__ void xcd_barrier_complete(unsigned* bar, unsigned x, unsigned& nloc, unsigned& nx) {
    const unsigned G = gridDim.x * gridDim.y * gridDim.z;
    unsigned sum, cnt, mine, sp = 0u;
    for (;;) {
        sum = 0u; cnt = 0u; mine = 0u;
#pragma unroll
        for (unsigned j = 0; j < 16; ++j) { const unsigned c = xb_ld(&bar[XB_XCNT(j)]); sum += c; cnt += (c > 0u) ? 1u : 0u; mine = (j == x) ? c : mine; }
        if (sum == G) break;
        __builtin_amdgcn_s_sleep(1);
        if ((++sp & 255u) == 0u) { if (xb_ld(&bar[XB_TMO])) break; if (sp > XB_SPIN_CAP) { atomicAdd(&bar[XB_TMO], 1u); break; } }
    }
    nloc = mine > 0u ? mine : 1u; nx = cnt > 0u ? cnt : 1u;
}
__device__ __forceinline__ void xcd_barrier(const XcdBarrier& b) {
    asm volatile("s_waitcnt vmcnt(0)" ::: "memory");
    __syncthreads();
    if (threadIdx.x == 0) {
        unsigned* bar = b.bar;
        __builtin_amdgcn_s_waitcnt(0);
        unsigned nloc = b.st[0], nx = b.st[1];
        if (nloc == 0u) { xcd_barrier_complete(bar, b.x, nloc, nx); b.st[0] = nloc; b.st[1] = nx; }
        const unsigned old = xb_add(&bar[XB_XSUB(b.x)], 1u);
        const unsigned gen = old / nloc;
        if (old + 1u == (gen + 1u) * nloc) {
            __builtin_amdgcn_fence(__ATOMIC_RELEASE, "agent");
            asm volatile("s_waitcnt vmcnt(0)" ::: "memory");
            const unsigned og = xb_add(&bar[XB_TOP], 1u);
            const unsigned tg = og / nx;
            if (og + 1u == (tg + 1u) * nx) xb_add(&bar[XB_TOPGEN], 1u);
            else XB_SPIN(xb_ld(&bar[XB_TOPGEN]) == tg, bar);
            __builtin_amdgcn_fence(__ATOMIC_ACQUIRE, "agent");
            xb_add(&bar[XB_XGEN(b.x)], 1u);
            asm volatile("s_waitcnt vmcnt(0)" ::: "memory");
        } else {
            XB_SPIN(xb_ld(&bar[XB_XGEN(b.x)]) == gen, bar);
            __builtin_amdgcn_fence(__ATOMIC_ACQUIRE, "agent");
            asm volatile("s_waitcnt vmcnt(0)" ::: "memory");
        }
    }
    __syncthreads();
}

__global__ void __launch_bounds__(NTHREADS, 2) fwd_kernel(Args args) {
    extern __shared__ __attribute__((aligned(16))) unsigned char lds_raw[];
    LAS unsigned char* lds = (LAS unsigned char*)lds_raw;
    cg::grid_group grid = cg::this_grid();
    const int tid0 = threadIdx.x, wave = __builtin_amdgcn_readfirstlane(tid0 >> 6);
#define PHASE_LANES const int tid = opaque(tid0), lane = tid & 63; (void)lane; (void)tid
    const int G = gridDim.x, bx = blockIdx.x;
    const int vcu = (G % 8 == 0) ? (bx % 8) * (G / 8) + bx / 8 : bx;
    const int gw = vcu * NWAVES + wave, NGW = G * NWAVES;
    unsigned char* const ws = args.ws;
#define WSP(type, off) ((type*)(ws + (off)))
    if (tid0 < 64) ((LAS unsigned*)(lds + LDS_MISC))[tid0] = 0u;
    __syncthreads();
    unsigned long long tsA_ = 0, tsB_ = 0; (void)tsA_; (void)tsB_;
    TSTAMP(0);
    const XcdBarrier xbar = xcd_barrier_post(WSP(unsigned, WS_BAR), (volatile LAS unsigned*)(lds + LDS_MISC));
#define GRID_BAR() xcd_barrier(xbar)
    REPN(0) {
        PHASE_LANES;
        LAS float* scr = (LAS float*)(lds + wave * 16384);
        const float* x = args.in[0]; const float* mem = args.in[1]; const float* g_attn = args.in[2]; const float* w_in = args.in[3]; const float* g_mem = args.in[7];
        const float* w_mem_kv = args.in[8]; const float* w_out = args.in[11]; const float* g_ffn = args.in[12]; const float* w_router = args.in[13];
        bf16* WIN_T = WSP(bf16, WS_WIN); bf16* WMEM_T = WSP(bf16, WS_WMEM); bf16* WOUT_T = WSP(bf16, WS_WOUT);
        bf16* XN = WSP(bf16, WS_XN); bf16* MEMN = WSP(bf16, WS_MEMN); float* WRG = WSP(float, WS_WRG);
        constexpr int I0 = 16 * 88, I1 = 16 * 16, I2 = 16 * 32, NIT = I0 + I1 + I2;
        for (int it = gw; it < NIT; it += NGW) {
            int r = it;
            if (r < I0) { const int nb = r % 88, kb = r / 88; transpose_item(w_in, NIN, WIN_T, headperm_row(nb * 32), scr, kb * 64, nb * 32, lane); continue; } r -= I0;
            if (r < I1) { const int nb = r % 16, kb = r / 16; transpose_item(w_mem_kv, 512, WMEM_T, headperm_row(nb * 32), scr, kb * 64, nb * 32, lane); continue; } r -= I1;
            { const int nb = r % 32, kb = r / 32; transpose_item(w_out, 1024, WOUT_T, nb * 32, scr, kb * 64, nb * 32, lane); }
        }
        for (int m = gw * 2; m < T + MROWS; m += NGW * 2) {
            if (m < T) rms_row2_to_bf16(x + (size_t)m * DM, g_attn, XN + (size_t)m * DM, lane, WSP(float, WS_IRS) + m);
            else rms_row2_to_bf16(mem + (size_t)(m - T) * DM, g_mem, MEMN + (size_t)(m - T) * DM, lane, nullptr);
        }
        for (int i = bx * NTHREADS + tid; i < DM * NEXP; i += G * NTHREADS) WRG[i] = g_ffn[i >> 5] * w_router[i];
        for (int i = bx * NTHREADS + tid; i < NB * 16 * 8 * 64; i += G * NTHREADS) WSP(float, WS_KMEAN)[i] = 0.f;
    }
    if (args.pad0 == 0x7fffffff) grid.sync();
    GRID_BAR();
    TSTAMP(1);

    REPN(1) {
        EpiProj E{ws, args.in[4], args.in[5], args.in[9], args.in[10]};
        if (G == 256) {
            SchedProj10 S{G, bx, (const char*)(ws + WS_XN), (const char*)(ws + WS_WIN)};
            pg8::gemm_phase<EpiProj, SchedProj10>(lds, S, E);
        } else {
            SchedProj S{G, bx, (const char*)(ws + WS_XN), (const char*)(ws + WS_MEMN), (const char*)(ws + WS_WIN), (const char*)(ws + WS_WMEM)};
            pg8::gemm_phase<EpiProj, SchedProj>(lds, S, E);
        }
    }
    GRID_BAR();
    TSTAMP(2);

#ifndef NAIVE_RET
    REPN(2) {
        if (G == 256) {
            if (bx < 144) {
                SchedProjOne S{bx, (const char*)(ws + WS_XN), (const char*)(ws + WS_MEMN), (const char*)(ws + WS_WIN), (const char*)(ws + WS_WMEM)};
                EpiProj E{ws, args.in[4], args.in[5], args.in[9], args.in[10]};
                pg8::gemm_phase<EpiProj, SchedProjOne>(lds, S, E);
            } else {
                for (int u = bx - 144; u < 512; u += 112) { const int bh = u >> 4, cp = u & 15;
                    ret_body::kv_unit(WSP(bf16, WS_KR), WSP(bf16, WS_VR), WSP(float, WS_RET), bh >> 2, bh & 3, cp, (char*)lds_raw); }
            }
        } else {
            for (int i = 0; i < 2; ++i) { const int u = vcu * 2 + i, bh = u >> 4, cp = u & 15;
                ret_body::kv_unit(WSP(bf16, WS_KR), WSP(bf16, WS_VR), WSP(float, WS_RET), bh >> 2, bh & 3, cp, (char*)lds_raw); }
        }
    }
    GRID_BAR();
    TSTAMP(3);
#endif
    REPN(20) { PHASE_LANES;
#if defined(NAIVE_MOBA) || defined(NAIVE_RET) || defined(NAIVE_MEM)
#error naive mixers are no longer wired in
#endif
    unsigned* qmix = WSP(unsigned, WS_CTL) + 64 + 256 * rep_; unsigned* qconv = WSP(unsigned, WS_CTL) + 128 + 256 * rep_;
    volatile LAS int* qslot = (volatile LAS int*)(lds + LDS_MISC + 64);
    const bool conv_first = (vcu & 3) == 3;
    bool mix_done = false, conv_done = false;
    while (!(mix_done && conv_done)) {
        const int kind = conv_first ? (conv_done ? 0 : 1) : (mix_done ? 1 : 0);
        if (tid == 0) qslot[0] = (int)__hip_atomic_fetch_add(kind ? qconv : qmix, 1u, __ATOMIC_RELAXED, __HIP_MEMORY_SCOPE_AGENT);
        __syncthreads();
        const int u = qslot[0];
        __syncthreads();
        if (kind == 1) {
            if (u >= 1536) { conv_done = true; continue; }
            convert_chunk(u, args.in[15], args.in[17], WSP(unsigned char, WS_W1), WSP(unsigned char, WS_W2), (LAS float*)(lds + wave * 16384), wave, lane);
            __syncthreads();
        } else if (u >= 2048) { mix_done = true; }
        else if (u < 1024) {
            const int nb = 15 - (u >> 6), bh = u & 63, b = bh >> 3, h = bh & 7;
            const size_t row0 = (size_t)b * SEQ + (size_t)nb * 256;
            attn_body::attn_unit<8, 512, 1024, true>(WSP(bf16, WS_QA) + row0 * 512 + h * 64, WSP(bf16, WS_KA) + (size_t)b * SEQ * 512 + h * 64, WSP(bf16, WS_VA) + (size_t)b * SEQ * 512 + h * 64,
                                                     WSP(bf16, WS_Y) + row0 * DM + h * 64, 4 * nb + 4, nb, WSP(float, WS_KMEAN) + ((size_t)b * 16 * 8 + h) * 64, (char*)lds_raw);
        } else if (u < 1536) {
            const int idx = u - 1024, bh = idx >> 4, cp = idx & 15;
            ret_body::out_unit(WSP(bf16, WS_QR), WSP(bf16, WS_KR), WSP(bf16, WS_VR), WSP(bf16, WS_GR), WSP(float, WS_RET), args.in[6], WSP(bf16, WS_Y), bh >> 2, bh & 3, cp, (char*)lds_raw);
        } else {
            const int idx = u - 1536, bh = idx >> 4, qb = idx & 15, b = bh >> 2, h = bh & 3;
            const size_t row0 = (size_t)b * SEQ + (size_t)qb * 256;
            attn_body::attn_unit<8, 256, 1024, false>(WSP(bf16, WS_QM) + row0 * 256 + h * 64, WSP(bf16, WS_MK) + (size_t)b * MEMLEN * 256 + h * 64, WSP(bf16, WS_MV) + (size_t)b * MEMLEN * 256 + h * 64,
                                                      WSP(bf16, WS_Y) + row0 * DM + 768 + h * 64, 4, 0, nullptr, (char*)lds_raw);
        }
    }
    }
    GRID_BAR();
    TSTAMP(4);

    REPN(3) {
        SchedPlain S{G, bx, 128, 4, (const char*)(ws + WS_Y), (const char*)(ws + WS_WOUT)};
        EpiOut E{WSP(bf16, WS_XN), WSP(float, WS_IRS), args.in[2], WSP(bf16, WS_X1B), WSP(float, WS_SSQ)};
#ifndef NO_G2
        pg8::gemm_phase<EpiOut, SchedPlain>(lds, S, E);
#endif
    }
    GRID_BAR();
    TSTAMP(5);

    REPN(4) {
        PHASE_LANES;
        const bf16* x1b = WSP(bf16, WS_X1B); const float* b_router = args.in[14];
        float* WRG = WSP(float, WS_WRG); float* SSQ = WSP(float, WS_SSQ); int* TOPI = WSP(int, WS_TOPI); float* TOPW = WSP(float, WS_TOPW); int* LRANK = WSP(int, WS_LRANK); int* LCOUNT = WSP(int, WS_LCOUNT);
        unsigned char* XN2 = WSP(unsigned char, WS_XN2); const float* g_ffn = args.in[12];
        if (bx == 0 && tid < 64) ((u32x4*)(XN2 + (size_t)T * DM))[tid] = (u32x4){0u, 0u, 0u, 0u};
        LAS float* wl = (LAS float*)(lds);
        LAS float* lg = (LAS float*)(lds + 131072) + wave * (16 * 33);
        LAS int* hist = (LAS int*)(lds + 131072 + 16896);
        { f32x4 w4[16];
#pragma unroll
          for (int q = 0; q < 16; ++q) w4[q] = ((const f32x4*)WRG)[tid + q * NTHREADS];
#pragma unroll
          for (int q = 0; q < 16; ++q) { const int i4 = tid + q * NTHREADS, r = i4 >> 3, e = (i4 & 7) * 4; *(LAS f32x4*)(wl + r * 32 + (e ^ (((r >> 5) & 1) << 4))) = w4[q]; } }
        if (tid < 32) hist[tid] = 0;
        __syncthreads();
        const int tpw = T / (G * NWAVES);
        for (int tb = 0; tb < tpw; tb += 16) {
            const int t0 = (bx * NWAVES + wave) * tpw + tb;
            const int i = lane & 15, kq = lane >> 4;
            f32x4 a0 = {0.f, 0.f, 0.f, 0.f}, a1 = {0.f, 0.f, 0.f, 0.f};
            const bf16* xr = x1b + (size_t)(t0 + i) * DM + 32 * kq;
            const LAS float* wb = wl + (32 * kq) * 32 + (i ^ ((kq & 1) << 4));
            const LAS float* wb1 = wl + (32 * kq) * 32 + ((i ^ ((kq & 1) << 4)) ^ 16);
            float rstd;
            { const f32x4* sp = (const f32x4*)(SSQ + (size_t)(t0 + i) * 16); const f32x4 s0 = sp[0], s1 = sp[1], s2 = sp[2], s3 = sp[3];
              const float ss = ((s0[0] + s0[1]) + (s0[2] + s0[3])) + ((s1[0] + s1[1]) + (s1[2] + s1[3])) + ((s2[0] + s2[1]) + (s2[2] + s2[3])) + ((s3[0] + s3[1]) + (s3[2] + s3[3]));
              rstd = 1.0f / sqrtf(ss * (1.0f / DM) + EPS); }
            unsigned char* xo = XN2 + (size_t)(t0 + i) * DM + 16 * kq;
            const float* gp = g_ffn + 32 * kq;
#pragma unroll 2
            for (int c = 0; c < 8; ++c) {
                float av[32];
#pragma unroll
                for (int j = 0; j < 4; ++j) { const u32x4 xw = *(const u32x4*)(xr + 128 * c + 8 * j);
                    av[8 * j] = bflo(xw.x); av[8 * j + 1] = bfhi(xw.x); av[8 * j + 2] = bflo(xw.y); av[8 * j + 3] = bfhi(xw.y); av[8 * j + 4] = bflo(xw.z); av[8 * j + 5] = bfhi(xw.z); av[8 * j + 6] = bflo(xw.w); av[8 * j + 7] = bfhi(xw.w); }
                { float nv[32];
#pragma unroll
                  for (int j = 0; j < 8; ++j) { const f32x4 g = *(const f32x4*)(gp + 128 * c + 4 * j); nv[4 * j] = av[4 * j] * rstd * g[0]; nv[4 * j + 1] = av[4 * j + 1] * rstd * g[1]; nv[4 * j + 2] = av[4 * j + 2] * rstd * g[2]; nv[4 * j + 3] = av[4 * j + 3] * rstd * g[3]; }
                  u32x4 p0, p1; fp6_pack32(nv, p0, p1);
                  *(u32x4*)(xo + 128 * c) = p0; *(u32x4*)(xo + 128 * c + 64) = p1; }
#pragma unroll
                for (int q = 0; q < 32; ++q) {
                    const float b0 = wb[(128 * c + q) * 32], b1v = wb1[(128 * c + q) * 32];
                    a0 = __builtin_amdgcn_mfma_f32_16x16x4f32(av[q], b0, a0, 0, 0, 0);
                    a1 = __builtin_amdgcn_mfma_f32_16x16x4f32(av[q], b1v, a1, 0, 0, 0);
                }
            }
#pragma unroll
            for (int r = 0; r < 4; ++r) { lg[(4 * kq + r) * 33 + i] = a0[r]; lg[(4 * kq + r) * 33 + 16 + i] = a1[r]; }
            LDS_WAIT(); asm volatile("" ::: "memory");
            if (lane < 16) {
                const int t = t0 + lane;
                float v[32];
#pragma unroll
                for (int e = 0; e < 32; ++e) v[e] = lg[lane * 33 + e] * rstd + b_router[e];
                int bi[4]; float bvv[4];
#pragma unroll
                for (int k = 0; k < 4; ++k) {
                    float best = -3e38f; int be = 0;
#pragma unroll
                    for (int e = 0; e < 32; ++e) { const bool take = v[e] > best; best = take ? v[e] : best; be = take ? e : be; }
                    bi[k] = be; bvv[k] = best;
#pragma unroll
                    for (int e = 0; e < 32; ++e) v[e] = (e == be) ? -3e38f : v[e];
                }
                const float e1 = __expf(bvv[1] - bvv[0]), e2 = __expf(bvv[2] - bvv[0]), e3 = __expf(bvv[3] - bvv[0]);
                const float inv = 1.0f / (1.0f + e1 + e2 + e3);
                const float wv[4] = {inv, e1 * inv, e2 * inv, e3 * inv};
#pragma unroll
                for (int k = 0; k < 4; ++k) {
                    const int rk = atomicAdd((int*)&hist[bi[k]], 1);
                    TOPI[t * 4 + k] = bi[k]; TOPW[t * 4 + k] = wv[k]; LRANK[t * 4 + k] = rk;
                }
            }
            LDS_WAIT(); asm volatile("" ::: "memory");
        }
        __syncthreads();
        if (tid < 32) LCOUNT[bx * 32 + tid] = hist[tid];
    }
    GRID_BAR();
    TSTAMP(6);

    REPN(5) {
        PHASE_LANES;
        int* TOPI = WSP(int, WS_TOPI); float* TOPW = WSP(float, WS_TOPW); int* LRANK = WSP(int, WS_LRANK); int* LCOUNT = WSP(int, WS_LCOUNT);
        int* POS = WSP(int, WS_POS); float* ROWW = WSP(float, WS_ROWW); int* PSTART = WSP(int, WS_PSTART); int* TILEEXP = WSP(int, WS_TILEEXP);
        LAS int* part = (LAS int*)(lds);
        LAS int* base = (LAS int*)(lds + 8192);
        {
            const int e = tid & 31, p = tid >> 5; int c = 0, pre = 0;
            const int wpp = (G + 15) / 16;
            for (int w = p * wpp; w < (p + 1) * wpp && w < G; ++w) { const int v = LCOUNT[w * 32 + e]; c += v; pre += (w < bx) ? v : 0; }
            part[p * 32 + e] = c; part[512 + p * 32 + e] = pre;
        }
        __syncthreads();
        if (tid < 32) { int c = 0, pre = 0; for (int p = 0; p < 16; ++p) { c += part[p * 32 + tid]; pre += part[512 + p * 32 + tid]; } part[1024 + tid] = c; part[1056 + tid] = pre; }
        __syncthreads();
        if (tid == 0) {
            int ps = 0;
            for (int e = 0; e < 32; ++e) {
                const int c = part[1024 + e], nt_ = (c + 255) >> 8;
                base[32 + e] = ps; base[e] = ps + part[1056 + e];
                if (bx == 0) PSTART[e] = ps;
                ps += nt_ * 256;
            }
            base[64] = ps; if (bx == 0) PSTART[32] = ps;
        }
        __syncthreads();
        if (bx == 1) {
            const int ntl = base[64] >> 8;
            for (int tl = tid; tl < ntl; tl += NTHREADS) { int e = 0;
#pragma unroll
                for (int q = 1; q < 32; ++q) e += (base[32 + q] <= tl * 256) ? 1 : 0;
                TILEEXP[tl] = e; }
        }
        int* ROWTOK = WSP(int, WS_ROWTOK);
        if (bx < 32) {
            const int c = part[1024 + bx], r0 = base[32 + bx] + c, r1 = base[32 + bx] + (((c + 255) >> 8) << 8);
            for (int r = r0 + tid; r < r1; r += NTHREADS) { ROWTOK[r] = T; ROWW[r] = 0.f; }
        }
        for (int a = tid; a < (T / G) * 4; a += NTHREADS) {
            const int ta = (bx * (T / G)) * 4 + a;
            const int e = TOPI[ta]; const int pos = base[e] + LRANK[ta];
            POS[ta] = pos; ROWTOK[pos] = ta >> 2; ROWW[pos] = TOPW[ta];
        }
    }
    GRID_BAR();
    TSTAMP(7);

    const int ntiles = WSP(int, WS_PSTART)[32] >> 8;
    REPN(6) {
        SchedMoe S{G, vcu, 8, ntiles, WSP(int, WS_TILEEXP), (const char*)(ws + WS_XN2), (const char*)(ws + WS_W1), (size_t)2048 * 1024, WSP(int, WS_ROWTOK)};
        EpiSwiglu E{args.in[16], WSP(unsigned char, WS_H)};
#ifndef NO_G3
        pg8::gemm_phase<EpiSwiglu, SchedMoe, true, true, true>(lds, S, E);
#endif
    }
    GRID_BAR();
    TSTAMP(8);
    REPN(7) {
        SchedMoe S{G, vcu, 4, ntiles, WSP(int, WS_TILEEXP), (const char*)(ws + WS_H), (const char*)(ws + WS_W2), (size_t)1024 * 1024, nullptr};
        EpiDown E{args.in[18], WSP(float, WS_ROWW), WSP(unsigned char, WS_XG)};
#ifndef NO_G4
        pg8::gemm_phase<EpiDown, SchedMoe, false, true>(lds, S, E);
#endif
    }
    GRID_BAR();
    TSTAMP(9);
    if (REP_PHASE == 9) { GRID_BAR(); GRID_BAR(); GRID_BAR(); GRID_BAR(); }
    REPN(8) { PHASE_LANES;
    for (int t = gw; t < T; t += NGW) {
        float* out = args.out; const int* POS = WSP(int, WS_POS); const unsigned char* YE = WSP(unsigned char, WS_XG); const bf16* x1b = WSP(bf16, WS_X1B);
        float* dst = (REP_PHASE == 8 && rep_ == 0) ? WSP(float, WS_H) + 64 * 1024 * 1024 : out;
        const u32x2* xrow = (const u32x2*)(x1b + (size_t)t * DM) + lane; f32x4* drow = (f32x4*)(dst + (size_t)t * DM) + lane;
        u32x2 xv[4]; f32x4 s[4];
#pragma unroll
        for (int j = 0; j < 4; ++j) { xv[j] = __builtin_nontemporal_load(xrow + 64 * j); s[j] = (f32x4){0.f, 0.f, 0.f, 0.f}; }
        unsigned yw[4][4];
#pragma unroll
        for (int k = 0; k < 4; ++k) {
            const int pos = POS[t * 4 + k]; const unsigned* yr = (const unsigned*)(YE + (size_t)pos * 1024) + lane;
#pragma unroll
            for (int j = 0; j < 4; ++j) yw[k][j] = __builtin_nontemporal_load(yr + 64 * j);
        }
#pragma unroll
        for (int k = 0; k < 4; ++k)
#pragma unroll
            for (int j = 0; j < 4; ++j) {
                const f32x2 lo = __builtin_amdgcn_cvt_pk_f32_fp8((int)yw[k][j], false), hi = __builtin_amdgcn_cvt_pk_f32_fp8((int)yw[k][j], true);
                s[j].x += lo.x; s[j].y += lo.y; s[j].z += hi.x; s[j].w += hi.y;
            }
#pragma unroll
        for (int j = 0; j < 4; ++j) __builtin_nontemporal_store((f32x4){bflo(xv[j].x), bfhi(xv[j].x), bflo(xv[j].y), bfhi(xv[j].y)} + s[j] * 0.0625f, drow + 64 * j);
    }
    }
    TSTAMP(10);
    if (REP_PHASE >= 100 && bx == 0 && tid0 == 0) {
        const unsigned long long t0_ = __builtin_amdgcn_s_memrealtime(), want = 9ull * (tsB_ - tsA_);
        while (__builtin_amdgcn_s_memrealtime() - t0_ < want) __builtin_amdgcn_s_sleep(32);
    }
}

extern "C" void kernel_launch(void* const* d_in, const int* in_sizes, int n_in, void* d_out, int out_size, void* d_ws, size_t ws_size, hipStream_t stream) {
    static int grid = 0;
    if (grid == 0) {
        if (n_in != 19 || out_size != T * DM || ws_size < WS_END) { fprintf(stderr, "kernel_launch: unexpected shapes (n_in %d out %d ws %zu)\n", n_in, out_size, ws_size); grid = -1; return; }
        int dev = 0, cus = 0, per_cu = 0;
        hipGetDevice(&dev); hipDeviceGetAttribute(&cus, hipDeviceAttributeMultiprocessorCount, dev);
        hipFuncSetAttribute((const void*)fwd_kernel, hipFuncAttributeMaxDynamicSharedMemorySize, LDS_BYTES);
        hipOccupancyMaxActiveBlocksPerMultiprocessor(&per_cu, (const void*)fwd_kernel, NTHREADS, LDS_BYTES);
        if (per_cu < 1) { fprintf(stderr, "kernel_launch: occupancy query says %d blocks per CU\n", per_cu); per_cu = 1; }
        (void)hipGetLastError();
        grid = cus * 1;
        if (grid % 8 != 0 || T % (grid * NWAVES * 16) != 0) { fprintf(stderr, "kernel_launch: grid %d unsupported\n", grid); grid = -1; return; }
    }
    if (grid < 0) return;
    hipMemsetAsync((char*)d_ws + WS_CTL, 0, CTL_ZERO_BYTES, stream);
    Args a{};
    for (int i = 0; i < 19; ++i) a.in[i] = (const float*)d_in[i];
    a.out = (float*)d_out; a.ws = (unsigned char*)d_ws;
    void* kargs[] = {&a};
    hipError_t e = hipLaunchCooperativeKernel((const void*)fwd_kernel, dim3(grid), dim3(NTHREADS), kargs, LDS_BYTES, stream);
    if (e != hipSuccess) fprintf(stderr, "cooperative launch failed: %s (grid %d)\n", hipGetErrorString(e), grid);
}
```

```cpp
#include <hip/hip_runtime.h>
#include <hip/hip_cooperative_groups.h>
#include <cstdio>
#include <cstdint>
namespace cg = cooperative_groups;

#define GAS __attribute__((address_space(1)))
#define LAS __attribute__((address_space(3)))
typedef unsigned short bf16;
typedef short bf16x8 __attribute__((ext_vector_type(8)));
typedef float f32x4 __attribute__((ext_vector_type(4)));
typedef float f32x2 __attribute__((ext_vector_type(2)));
typedef unsigned u32x4 __attribute__((ext_vector_type(4)));
typedef unsigned u32x2 __attribute__((ext_vector_type(2)));
typedef __bf16 bf16x2_t __attribute__((ext_vector_type(2)));

constexpr int NB = 8, SEQ = 4096, DM = 1024, T = NB * SEQ;
constexpr int NIN = 2816, NEXP = 32, TOPK = 4;
constexpr int MEMLEN = 256, MROWS = NB * MEMLEN;
constexpr float EPS = 1e-6f;
constexpr float C2 = 0.125f * 1.4426950408889634f;
constexpr int MAXTILES = 544, PROWS = MAXTILES * 256;
constexpr int NWAVES = 8, NTHREADS = 512;
#ifndef REP_PHASE
#define REP_PHASE -1
#endif
#define TSTAMP(i) do { if (REP_PHASE == 100 + (i)) tsA_ = __builtin_amdgcn_s_memrealtime(); if (REP_PHASE == 99 + (i)) tsB_ = __builtin_amdgcn_s_memrealtime(); } while (0)
#define REPN(k) for (int rep_ = 0; rep_ < ((REP_PHASE == (k)) ? 2 : 1); ++rep_)
constexpr int LDS_MISC = 150016;
constexpr int LDS_BYTES = 150016 + 256;

constexpr size_t MiB = 1u << 20;
constexpr size_t WS_CTL = 0, CTL_ZERO_BYTES = 131072;
constexpr size_t WS_BAR = 65536;
constexpr size_t WS_KMEAN = 1 * MiB;
constexpr size_t WS_WRG = 2 * MiB;
constexpr size_t WS_SSQ = 3 * MiB;
constexpr size_t WS_TOPI = 5 * MiB, WS_TOPW = 5 * MiB + 512 * 1024, WS_LRANK = 6 * MiB, WS_POS = 6 * MiB + 512 * 1024;
constexpr size_t WS_ROWW = 7 * MiB;
constexpr size_t WS_LCOUNT = 8 * MiB, WS_PSTART = 8 * MiB + 65536, WS_TILEEXP = 8 * MiB + 131072;
constexpr size_t WS_WIN = 16 * MiB, WS_WMEM = 22 * MiB, WS_WOUT = 24 * MiB, WS_W1 = 32 * MiB, WS_W2 = 160 * MiB;
constexpr size_t WS_XN = 224 * MiB, WS_MEMN = 288 * MiB;
constexpr size_t WS_QA = 292 * MiB, WS_KA = 324 * MiB, WS_VA = 356 * MiB;
constexpr size_t WS_QR = 388 * MiB, WS_KR = 404 * MiB, WS_VR = 420 * MiB, WS_GR = 436 * MiB, WS_QM = 452 * MiB;
constexpr size_t WS_MK = 468 * MiB, WS_MV = 469 * MiB;
constexpr size_t WS_Y = 470 * MiB, WS_RET = 534 * MiB;
constexpr size_t WS_XG = 224 * MiB;
constexpr size_t WS_XN2 = 496 * MiB;
constexpr size_t WS_X1B = 388 * MiB;
constexpr size_t WS_IRS = 10 * MiB;
constexpr size_t WS_ROWTOK = 9 * MiB;
constexpr size_t WS_H = 566 * MiB;
constexpr size_t WS_END = 838 * MiB;

struct Args {
    const float* in[19]; float* out; unsigned char* ws; int pad0, pad1;
};

__device__ __forceinline__ unsigned cvtpk(float lo, float hi) { f32x2 v = {lo, hi}; bf16x2_t b = __builtin_convertvector(v, bf16x2_t); return __builtin_bit_cast(unsigned, b); }
__device__ __forceinline__ float bf2f(unsigned short b) { return __uint_as_float(((unsigned)b) << 16); }
__device__ __forceinline__ float bflo(unsigned w) { return __uint_as_float(w << 16); }
__device__ __forceinline__ float bfhi(unsigned w) { return __uint_as_float(w & 0xffff0000u); }
__device__ __forceinline__ float wave_sum(float v) {
#pragma unroll
    for (int o = 1; o < 64; o <<= 1) v += __shfl_xor(v, o);
    return v;
}
#define LDS_WAIT() asm volatile("s_waitcnt lgkmcnt(0)" ::: "memory")
typedef unsigned v6u_t __attribute__((ext_vector_type(6)));
typedef float v16f_t __attribute__((ext_vector_type(16)));
#ifndef FP6_SCALE_DIV
#define FP6_SCALE_DIV 1
#endif
__device__ __forceinline__ void fp6_pack32(const float (&v)[32], u32x4& p0, u32x4& p1) {
    float mx = 1e-30f;
#pragma unroll
    for (int i = 0; i < 32; ++i) mx = fmaxf(mx, fabsf(v[i]));
    const unsigned bits = __float_as_uint(mx * (1.0f / 7.5f));
    int e = (int)((bits + 0x7FFFFFu) >> 23) - 127;
    e = e < -126 ? -126 : (e > 126 ? 126 : e);
    const float sc = __uint_as_float((unsigned)((FP6_SCALE_DIV ? e : -e) + 127) << 23);
    v16f_t lo, hi;
#pragma unroll
    for (int i = 0; i < 16; ++i) { lo[i] = v[i]; hi[i] = v[16 + i]; }
    const v6u_t w = __builtin_amdgcn_cvt_scalef32_2xpk16_fp6_f32(lo, hi, sc);
    p0 = (u32x4){w[0], w[1], w[2], w[3]}; p1 = (u32x4){w[4], w[5], (unsigned)(e + 127), 0u};
}
__device__ __forceinline__ int opaque(int v) { asm volatile("" : "+v"(v)); return v; }

namespace pg8 {
constexpr int BM = 256, BK = 64, HALF = 128, HTB = HALF * BK * 2, STAGE_BYTES = 8 * HTB, NXCD = 8, WGM = 8, K = 1024;
__host__ __device__ __forceinline__ int lds_byte(int r, int c) { const int st = (r >> 4) * 2 + (c >> 5), rr = r & 15, cc = c & 31, ob = rr * 64 + cc * 2; return st * 1024 + (ob ^ (((ob >> 9) & 1) << 5)); }
__host__ __device__ __forceinline__ void stage_rc(int b, int& R, int& C) { const int st = b / 1024, sb = b % 1024, swz = sb ^ (((sb >> 9) & 1) << 5); R = (st >> 1) * 16 + swz / 64; C = (st & 1) * 32 + (swz % 64) / 2; }
__host__ __device__ __forceinline__ int perm32(int rho) { const int n = rho >> 4, i = rho & 15; return 8 * (i >> 2) + 4 * n + (i & 3); }
struct Unit { int pm, pn, aux; };

__device__ __forceinline__ bool static_order(int L, int nM, int nN, int& pm, int& pn) {
    const int nwg = nM * nN; if (L >= nwg) return false;
    int wgid = L; { const int q = nwg / NXCD, r = nwg % NXCD, xcd = wgid % NXCD, off = wgid / NXCD; wgid = (xcd < r ? xcd * (q + 1) : r * (q + 1) + (xcd - r) * q) + off; }
    const int nig = WGM * nN, gid = wgid / nig, fm = gid * WGM, gsz = (nM - fm) < WGM ? (nM - fm) : WGM;
    pm = fm + ((wgid % nig) % gsz); pn = (wgid % nig) / gsz; return true;
}

typedef int v8i_t __attribute__((ext_vector_type(8)));
typedef int v4i_t __attribute__((ext_vector_type(4)));
__device__ __forceinline__ v8i_t cat8(bf16x8 lo, bf16x8 hi) { const v4i_t a = __builtin_bit_cast(v4i_t, lo), b = __builtin_bit_cast(v4i_t, hi); return __builtin_shufflevector(a, b, 0, 1, 2, 3, 4, 5, 6, 7); }
typedef int v6i_t __attribute__((ext_vector_type(6)));
__device__ __forceinline__ v6i_t cat6(bf16x8 lo, bf16x8 hi) { const v4i_t a = __builtin_bit_cast(v4i_t, lo), b = __builtin_bit_cast(v4i_t, hi); return __builtin_shufflevector(a, b, 0, 1, 2, 3, 4, 5); }
__device__ __forceinline__ int scl6(bf16x8 hi) { return __builtin_bit_cast(v4i_t, hi)[2]; }
template <class Epi, class Sched, bool GATHER = false, bool FP8 = false, bool FP6 = false>
__device__ __forceinline__ void gemm_phase(LAS unsigned char* lds, const Sched& S, const Epi& E) {
    constexpr int PITCH = FP8 ? 1024 : 2048;
    const int tid = opaque((int)threadIdx.x), wid = __builtin_amdgcn_readfirstlane(tid >> 6), lane = tid & 63, wr = wid >> 2, wc = wid & 3, fr = lane & 15, fq = lane >> 4;
    constexpr int nt = PITCH / 128;
    unsigned voffA[2], voffB[2];
#pragma unroll
    for (int i = 0; i < 2; ++i) { int R, C; stage_rc(tid * 16 + i * 8192, R, C); const int Rb = (R & ~31) + perm32(R & 31);
        voffA[i] = (unsigned)(R * PITCH + C * 2); voffB[i] = (unsigned)(Rb * PITCH + C * 2); }
    const size_t kstep = (size_t)(BK * 2);
    const size_t hstep = (size_t)HALF * PITCH;
    const unsigned ldsw = (unsigned)wid * 1024u;
    const int aoff = lds_byte(wr * 64 + fr, fq * 8), boff = lds_byte(wc * 32 + fr, fq * 8);
#define PG8_SA(b, h) (((b) * 2 + (h)) * HTB)
#define PG8_SB(b, h) ((4 + (b) * 2 + (h)) * HTB)
#define PG8_STAGE(bufoff, gbase, voff) do { _Pragma("unroll") for (int _i = 0; _i < 2; ++_i) \
        __builtin_amdgcn_global_load_lds((const unsigned*)((const char*)(gbase) + (voff)[_i]), (LAS unsigned*)(lds + (bufoff) + ldsw + _i * 8192), 16, 0, 0); } while (0)
#define PG8_LDA(dst, b, h) do { _Pragma("unroll") for (int m = 0; m < 4; ++m) _Pragma("unroll") for (int k = 0; k < 2; ++k) dst[m][k] = *(const LAS bf16x8*)(lds + PG8_SA(b, h) + aoff + m * 2048 + k * 1024); } while (0)
#define PG8_LDB(dst, b, h) do { _Pragma("unroll") for (int n = 0; n < 2; ++n) _Pragma("unroll") for (int k = 0; k < 2; ++k) dst[n][k] = *(const LAS bf16x8*)(lds + PG8_SB(b, h) + boff + n * 2048 + k * 1024); } while (0)
#define PG8_MMA(ai, bj, At, Bt) do { __builtin_amdgcn_s_setprio(1); \
        if constexpr (FP6) { _Pragma("unroll") for (int m = 0; m < 4; ++m) _Pragma("unroll") for (int n = 0; n < 2; ++n) \
            asm volatile("s_nop 1\n\tv_mfma_scale_f32_16x16x128_f8f6f4 %0, %1, %2, %0, %3, %4 op_sel_hi:[0,0,0] cbsz:2 blgp:2" : "+v"(acc[ai][bj][m][n]) : "v"(cat6(Bt[n][0], Bt[n][1])), "v"(cat6(At[m][0], At[m][1])), "v"(scl6(Bt[n][1])), "v"(scl6(At[m][1]))); } \
        else if constexpr (FP8) { _Pragma("unroll") for (int m = 0; m < 4; ++m) _Pragma("unroll") for (int n = 0; n < 2; ++n) \
            asm volatile("v_mfma_scale_f32_16x16x128_f8f6f4 %0, %1, %2, %0, %3, %3 op_sel_hi:[0,0,0]" : "+v"(acc[ai][bj][m][n]) : "v"(cat8(Bt[n][0], Bt[n][1])), "v"(cat8(At[m][0], At[m][1])), "v"(0x7f7f7f7f)); } \
        else { _Pragma("unroll") for (int m = 0; m < 4; ++m) _Pragma("unroll") for (int n = 0; n < 2; ++n) _Pragma("unroll") for (int k = 0; k < 2; ++k) \
            acc[ai][bj][m][n] = __builtin_amdgcn_mfma_f32_16x16x32_bf16(Bt[n][k], At[m][k], acc[ai][bj][m][n], 0, 0, 0); } \
        __builtin_amdgcn_s_setprio(0); } while (0)
#define PG8_WAIT_V(n) asm volatile("s_waitcnt vmcnt(" #n ")" ::: "memory")
#define PG8_WAIT_L(n) asm volatile("s_waitcnt lgkmcnt(" #n ")" ::: "memory")
#define PG8_BAR __builtin_amdgcn_s_barrier()
#define PG8_SCHED __builtin_amdgcn_sched_barrier(0)
    Unit cur, nxt; int ui = 0;
    if (!S.next(0, cur)) return;
    unsigned vGc[2][2], vGn[2][2]; int gR[2], gC[2];
    const char* gA = nullptr;
    if constexpr (GATHER) {
        gA = S.abase();
#pragma unroll
        for (int i = 0; i < 2; ++i) { stage_rc(tid * 16 + i * 8192, gR[i], gC[i]); }
        if (wid == 0) __builtin_amdgcn_global_load_lds((const unsigned*)(S.tokptr(cur) + lane * 16), (LAS unsigned*)(lds + 131072), 16, 0, 0);
        asm volatile("s_waitcnt vmcnt(0)" ::: "memory"); __builtin_amdgcn_s_barrier(); asm volatile("" ::: "memory");
#pragma unroll
        for (int h = 0; h < 2; ++h)
#pragma unroll
            for (int i = 0; i < 2; ++i) { const int tok = ((const LAS int*)(lds + 131072))[h * 128 + gR[i]]; vGc[h][i] = (unsigned)tok * (unsigned)PITCH + (unsigned)gC[i] * 2u; vGn[h][i] = vGc[h][i]; }
    }
    f32x4 acc[2][2][4][2];
#pragma unroll
    for (int a = 0; a < 2; ++a)
#pragma unroll
        for (int b = 0; b < 2; ++b)
#pragma unroll
            for (int m = 0; m < 4; ++m)
#pragma unroll
                for (int n = 0; n < 2; ++n) acc[a][b][m][n] = (f32x4){0.f, 0.f, 0.f, 0.f};
    bf16x8 At[4][2], B0[2][2], B1[2][2];
    const char* cA = GATHER ? gA : S.aptr(cur); const char* cB = S.bptr(cur);
    const size_t ahstep = GATHER ? (size_t)0 : hstep;
    {
        PG8_STAGE(PG8_SB(0, 0), cB, voffB); PG8_STAGE(PG8_SB(0, 1), cB + hstep, voffB);
        if constexpr (GATHER) { PG8_STAGE(PG8_SA(0, 0), cA, vGc[0]); PG8_STAGE(PG8_SA(0, 1), cA, vGc[1]); } else { PG8_STAGE(PG8_SA(0, 0), cA, voffA); PG8_STAGE(PG8_SA(0, 1), cA + hstep, voffA); }
        if (wr == 1) PG8_BAR;
        PG8_WAIT_V(2); PG8_BAR;
        PG8_STAGE(PG8_SB(1, 0), cB + kstep, voffB);
        if constexpr (GATHER) { PG8_STAGE(PG8_SA(1, 0), cA + kstep, vGc[0]); } else { PG8_STAGE(PG8_SA(1, 0), cA + kstep, voffA); }
        PG8_STAGE(PG8_SB(1, 1), cB + hstep + kstep, voffB);
        PG8_WAIT_V(6); PG8_BAR;
    }
    for (;;) {
        const bool has_next = S.next(ui + 1, nxt);
        const char* nA = GATHER ? gA : (has_next ? S.aptr(nxt) : cA); const char* nB = has_next ? S.bptr(nxt) : cB;
        if constexpr (GATHER) { if (has_next && wid == 0) __builtin_amdgcn_global_load_lds((const unsigned*)(S.tokptr(nxt) + lane * 16), (LAS unsigned*)(lds + 131072 + ((ui + 1) & 1) * 1024), 16, 0, 0); }
#pragma nounroll
        for (int t = 0; t < nt; t += 2) {
            const bool last = (t == nt - 2);
            const char* a1 = cA + (size_t)(t + 1) * kstep;
            const char* a2 = last ? nA : cA + (size_t)(t + 2) * kstep; const char* b2 = last ? nB : cB + (size_t)(t + 2) * kstep;
            const char* a3 = a2 + kstep; const char* b3 = b2 + kstep;
            unsigned v2h0[2], v2h1[2];
            if constexpr (GATHER) {
                if (last && has_next) {
                    const LAS int* tk = (const LAS int*)(lds + 131072 + ((ui + 1) & 1) * 1024);
#pragma unroll
                    for (int h = 0; h < 2; ++h)
#pragma unroll
                        for (int i = 0; i < 2; ++i) vGn[h][i] = (unsigned)tk[h * 128 + gR[i]] * (unsigned)PITCH + (unsigned)gC[i] * 2u;
                }
#pragma unroll
                for (int i = 0; i < 2; ++i) { v2h0[i] = last ? vGn[0][i] : vGc[0][i]; v2h1[i] = last ? vGn[1][i] : vGc[1][i]; }
            } else {
#pragma unroll
                for (int i = 0; i < 2; ++i) { v2h0[i] = voffA[i]; v2h1[i] = voffA[i]; }
            }
            PG8_LDB(B0, 0, 0); PG8_LDB(B1, 0, 1); PG8_SCHED; PG8_LDA(At, 0, 0);
            if constexpr (GATHER) { PG8_STAGE(PG8_SA(1, 1), a1, vGc[1]); } else { PG8_STAGE(PG8_SA(1, 1), a1 + hstep, voffA); }
            PG8_WAIT_V(8); PG8_WAIT_L(0); PG8_BAR; PG8_MMA(0, 0, At, B0); PG8_MMA(0, 1, At, B1); PG8_BAR; PG8_SCHED;
            PG8_LDA(At, 0, 1); PG8_STAGE(PG8_SB(0, 0), b2, voffB); PG8_STAGE(PG8_SB(0, 1), b2 + hstep, voffB); PG8_STAGE(PG8_SA(0, 0), a2, v2h0);
            PG8_WAIT_V(8); PG8_WAIT_L(0); PG8_BAR; PG8_MMA(1, 0, At, B0); PG8_MMA(1, 1, At, B1); PG8_BAR; PG8_SCHED;
            PG8_LDB(B0, 1, 0); PG8_LDB(B1, 1, 1); PG8_SCHED; PG8_LDA(At, 1, 0); PG8_STAGE(PG8_SA(0, 1), a2 + ahstep, v2h1);
            PG8_WAIT_V(8); PG8_WAIT_L(0); PG8_BAR; PG8_MMA(0, 0, At, B0); PG8_MMA(0, 1, At, B1); PG8_BAR; PG8_SCHED;
            PG8_LDA(At, 1, 1); PG8_STAGE(PG8_SB(1, 0), b3, voffB); PG8_STAGE(PG8_SB(1, 1), b3 + hstep, voffB); PG8_STAGE(PG8_SA(1, 0), a3, v2h0);
            PG8_WAIT_V(8); PG8_WAIT_L(0); PG8_BAR; PG8_MMA(1, 0, At, B0); PG8_MMA(1, 1, At, B1); PG8_BAR; PG8_SCHED;
        }
        if (wr == 0) PG8_BAR;
        if constexpr (FP8) asm volatile("s_nop 15\n\ts_nop 7" ::: "memory");
        E(acc, cur, wr, wc, fr, fq);
        if (!has_next) break;
#pragma unroll
        for (int a = 0; a < 2; ++a)
#pragma unroll
            for (int b = 0; b < 2; ++b)
#pragma unroll
                for (int m = 0; m < 4; ++m)
#pragma unroll
                    for (int n = 0; n < 2; ++n) acc[a][b][m][n] = (f32x4){0.f, 0.f, 0.f, 0.f};
        cur = nxt; cA = nA; cB = nB; ++ui;
        if constexpr (GATHER) {
#pragma unroll
            for (int h = 0; h < 2; ++h)
#pragma unroll
                for (int i = 0; i < 2; ++i) vGc[h][i] = vGn[h][i];
        }
        if (wr == 1) PG8_BAR;
    }
    PG8_WAIT_V(0);
    PG8_BAR;
#undef PG8_SA
#undef PG8_SB
#undef PG8_STAGE
#undef PG8_LDA
#undef PG8_LDB
#undef PG8_MMA
#undef PG8_WAIT_V
#undef PG8_WAIT_L
#undef PG8_BAR
#undef PG8_SCHED
}
}
using pg8::Unit;

struct SchedProj {
    int G, c; const char *XN, *MEMN, *WIN, *WMEM;
    __device__ __forceinline__ bool next(int i, Unit& u) const {
        const int L = i * G + c;
        if (L < 1408) { u.aux = 0; return pg8::static_order(L, 128, 11, u.pm, u.pn); }
        if (L < 1424) { const int j = L - 1408; u.pm = j >> 1; u.pn = j & 1; u.aux = 1; return true; }
        return false;
    }
    __device__ __forceinline__ const char* aptr(const Unit& u) const { return (u.aux ? MEMN : XN) + (size_t)u.pm * (256 * 2048); }
    __device__ __forceinline__ const char* bptr(const Unit& u) const { return (u.aux ? WMEM : WIN) + (size_t)u.pn * (256 * 2048); }
};
struct SchedProj10 {
    int G, c; const char *XN, *WIN;
    __device__ __forceinline__ bool next(int i, Unit& u) const { int j; u.aux = 0; if (!pg8::static_order(i * G + c, 128, 10, u.pm, j)) return false; u.pn = j < 9 ? j : 10; return true; }
    __device__ __forceinline__ const char* aptr(const Unit& u) const { return XN + (size_t)u.pm * (256 * 2048); }
    __device__ __forceinline__ const char* bptr(const Unit& u) const { return WIN + (size_t)u.pn * (256 * 2048); }
};
struct SchedProjOne {
    int c; const char *XN, *MEMN, *WIN, *WMEM;
    __device__ __forceinline__ bool next(int i, Unit& u) const {
        if (i != 0 || c >= 144) return false;
        if (c < 128) { u.pm = c; u.pn = 9; u.aux = 0; } else { const int j = c - 128; u.pm = j >> 1; u.pn = j & 1; u.aux = 1; }
        return true;
    }
    __device__ __forceinline__ const char* aptr(const Unit& u) const { return (u.aux ? MEMN : XN) + (size_t)u.pm * (256 * 2048); }
    __device__ __forceinline__ const char* bptr(const Unit& u) const { return (u.aux ? WMEM : WIN) + (size_t)u.pn * (256 * 2048); }
};
struct SchedPlain {
    int G, c, nM, nN; const char *A, *B;
    __device__ __forceinline__ bool next(int i, Unit& u) const { u.aux = 0; return pg8::static_order(i * G + c, nM, nN, u.pm, u.pn); }
    __device__ __forceinline__ const char* aptr(const Unit& u) const { return A + (size_t)u.pm * (256 * 2048); }
    __device__ __forceinline__ const char* bptr(const Unit& u) const { return B + (size_t)u.pn * (256 * 2048); }
};
struct SchedMoe {
    int G, vcu, npn, ntiles; const int* tile_exp; const char *A, *B; size_t bexp;
    __device__ __forceinline__ bool next(int i, Unit& u) const {
        const int L = i * G + vcu, tile = L / npn; if (tile >= ntiles) return false;
        u.pm = tile; u.pn = L - tile * npn; u.aux = __builtin_amdgcn_readfirstlane(tile_exp[tile]); return true;
    }
    __device__ __forceinline__ const char* aptr(const Unit& u) const { return A + (size_t)u.pm * (256 * 1024); }
    __device__ __forceinline__ const char* bptr(const Unit& u) const { return B + (size_t)u.aux * bexp + (size_t)u.pn * (256 * 1024); }
    const int* rowtok;
    __device__ __forceinline__ const char* abase() const { return A; }
    __device__ __forceinline__ const char* tokptr(const Unit& u) const { return (const char*)(rowtok + (size_t)u.pm * 256); }
};

struct EpiProj {
    unsigned char* ws;
    const float *gq, *gk, *gmq, *gmk;
    __device__ __forceinline__ void operator()(const f32x4 (&acc)[2][2][4][2], const Unit& u, int wr, int wc, int fr, int fq) const {
        int mode = 0; bf16* out; int ld = 256, coff = 0; const float* gain = nullptr; float scale = 1.f; bool kmean = false;
        if (u.aux == 0) {
            switch (u.pn) {
                case 0: case 1: out = (bf16*)(ws + WS_QA); ld = 512; coff = u.pn * 256; mode = 1; gain = gq; scale = C2; break;
                case 2: case 3: out = (bf16*)(ws + WS_KA); ld = 512; coff = (u.pn - 2) * 256; mode = 1; gain = gk; kmean = true; break;
                case 4: case 5: out = (bf16*)(ws + WS_VA); ld = 512; coff = (u.pn - 4) * 256; break;
                case 6: out = (bf16*)(ws + WS_QR); mode = 2; break;
                case 7: out = (bf16*)(ws + WS_KR); mode = 2; scale = 0.125f; break;
                case 8: out = (bf16*)(ws + WS_VR); break;
                case 9: out = (bf16*)(ws + WS_GR); mode = 3; break;
                default: out = (bf16*)(ws + WS_QM); mode = 1; gain = gmq; scale = C2; break;
            }
        } else {
            if (u.pn == 0) { out = (bf16*)(ws + WS_MK); mode = 1; gain = gmk; } else { out = (bf16*)(ws + WS_MV); }
        }
        const int row0 = u.pm * 256 + wr * 64 + fr;
        const int colb = coff + wc * 64 + 8 * fq;
        if (gain == nullptr) gain = gq;
        f32x4 gv[2][2];
#pragma unroll
        for (int bj = 0; bj < 2; ++bj)
#pragma unroll
            for (int n = 0; n < 2; ++n) gv[bj][n] = *(const f32x4*)(gain + bj * 32 + 8 * fq + 4 * n);
        f32x4 ks[2][2];
#pragma unroll
        for (int bj = 0; bj < 2; ++bj)
#pragma unroll
            for (int n = 0; n < 2; ++n) ks[bj][n] = (f32x4){0.f, 0.f, 0.f, 0.f};
#pragma unroll
        for (int ai = 0; ai < 2; ++ai)
#pragma unroll
            for (int m = 0; m < 4; ++m) {
                const int row = row0 + ai * 128 + m * 16;
                f32x4 v[2][2];
#pragma unroll
                for (int bj = 0; bj < 2; ++bj)
#pragma unroll
                    for (int n = 0; n < 2; ++n) v[bj][n] = acc[ai][bj][m][n];
                if (mode == 1) {
                    float ss = 0.f;
#pragma unroll
                    for (int bj = 0; bj < 2; ++bj)
#pragma unroll
                        for (int n = 0; n < 2; ++n) { const f32x4 x = v[bj][n]; ss += (x[0] * x[0] + x[1] * x[1]) + (x[2] * x[2] + x[3] * x[3]); }
                    ss += __shfl_xor(ss, 16); ss += __shfl_xor(ss, 32);
                    const float r = scale / sqrtf(ss * (1.0f / 64.0f) + EPS);
#pragma unroll
                    for (int bj = 0; bj < 2; ++bj)
#pragma unroll
                        for (int n = 0; n < 2; ++n) v[bj][n] = v[bj][n] * r * gv[bj][n];
                } else if (mode == 2) {
                    const float pos = (float)(row & (SEQ - 1));
                    const float lgam = __builtin_amdgcn_logf(1.0f - __builtin_amdgcn_exp2f(-5.0f - (float)wc));
                    const float rsc = scale * __builtin_amdgcn_exp2f(((u.pn == 6) ? lgam : -lgam) * (float)(row & 127));
#pragma unroll
                    for (int n = 0; n < 2; ++n)
#pragma unroll
                        for (int j = 0; j < 4; ++j) {
                            const float fre = __builtin_amdgcn_exp2f((float)(8 * fq + 4 * n + j) * (-13.287712379549449f / 31.0f)) * 0.15915494309189535f;
                            float tt = pos * fre; tt = tt - floorf(tt);
                            const float sn = __builtin_amdgcn_sinf(tt), cs = __builtin_amdgcn_cosf(tt);
                            const float t1 = v[0][n][j], t2 = v[1][n][j];
                            v[0][n][j] = (t1 * cs - t2 * sn) * rsc; v[1][n][j] = (t2 * cs + t1 * sn) * rsc;
                        }
                } else if (mode == 3) {
#pragma unroll
                    for (int bj = 0; bj < 2; ++bj)
#pragma unroll
                        for (int n = 0; n < 2; ++n)
#pragma unroll
                            for (int j = 0; j < 4; ++j) { const float x = v[bj][n][j]; v[bj][n][j] = x / (1.0f + __expf(-x)); }
                }
                if (kmean) {
#pragma unroll
                    for (int bj = 0; bj < 2; ++bj)
#pragma unroll
                        for (int n = 0; n < 2; ++n) ks[bj][n] += v[bj][n];
                }
                bf16* rowp = out + (size_t)row * ld + colb;
#pragma unroll
                for (int bj = 0; bj < 2; ++bj) { u32x4 w; w.x = cvtpk(v[bj][0][0], v[bj][0][1]); w.y = cvtpk(v[bj][0][2], v[bj][0][3]); w.z = cvtpk(v[bj][1][0], v[bj][1][1]); w.w = cvtpk(v[bj][1][2], v[bj][1][3]);
                    *(u32x4*)(rowp + bj * 32) = w; }
            }
        if (kmean) {
            float* kp = (float*)(ws + WS_KMEAN) + ((size_t)u.pm * 8 + (u.pn - 2) * 4 + wc) * 64 + 8 * fq;
#pragma unroll
            for (int bj = 0; bj < 2; ++bj)
#pragma unroll
                for (int n = 0; n < 2; ++n)
#pragma unroll
                    for (int j = 0; j < 4; ++j) {
                        float s = ks[bj][n][j];
                        s += __shfl_xor(s, 1); s += __shfl_xor(s, 2); s += __shfl_xor(s, 4); s += __shfl_xor(s, 8);
                        if (fr == 0) atomicAdd(kp + bj * 32 + 4 * n + j, s * (1.0f / 256.0f));
                    }
        }
    }
};

struct EpiOut {
    const bf16* xn; const float* irs; const float* gattn; bf16* out; float* ssq;
    __device__ __forceinline__ void operator()(const f32x4 (&acc)[2][2][4][2], const Unit& u, int wr, int wc, int fr, int fq) const {
        const int row0 = u.pm * 256 + wr * 64 + fr, col0 = u.pn * 256 + wc * 32 + 8 * fq;
        f32x4 ig[2][2];
#pragma unroll
        for (int bj = 0; bj < 2; ++bj)
#pragma unroll
            for (int n = 0; n < 2; ++n) { const f32x4 g = *(const f32x4*)(gattn + col0 + bj * 128 + 4 * n); ig[bj][n] = (f32x4){1.0f / g[0], 1.0f / g[1], 1.0f / g[2], 1.0f / g[3]}; }
#pragma unroll
        for (int ai = 0; ai < 2; ++ai) {
            u32x4 xwv[4][2]; float irv[4];
#pragma unroll
            for (int m = 0; m < 4; ++m) { const int row = row0 + ai * 128 + m * 16; irv[m] = irs[row];
#pragma unroll
                for (int bj = 0; bj < 2; ++bj) xwv[m][bj] = __builtin_nontemporal_load((const u32x4*)(xn + (size_t)row * DM + col0 + bj * 128)); }
#pragma unroll
            for (int m = 0; m < 4; ++m) {
                const int row = row0 + ai * 128 + m * 16; const size_t off = (size_t)row * DM + col0; float ss = 0.f; const float ir = irv[m];
#pragma unroll
                for (int bj = 0; bj < 2; ++bj) {
                    const u32x4 xw = xwv[m][bj];
                    const f32x4 o0 = (f32x4){bflo(xw.x), bfhi(xw.x), bflo(xw.y), bfhi(xw.y)} * ig[bj][0] * ir + acc[ai][bj][m][0], o1 = (f32x4){bflo(xw.z), bfhi(xw.z), bflo(xw.w), bfhi(xw.w)} * ig[bj][1] * ir + acc[ai][bj][m][1];
                    ss += ((o0[0] * o0[0] + o0[1] * o0[1]) + (o0[2] * o0[2] + o0[3] * o0[3])) + ((o1[0] * o1[0] + o1[1] * o1[1]) + (o1[2] * o1[2] + o1[3] * o1[3]));
                    u32x4 w; w.x = cvtpk(o0[0], o0[1]); w.y = cvtpk(o0[2], o0[3]); w.z = cvtpk(o1[0], o1[1]); w.w = cvtpk(o1[2], o1[3]);
                    *(u32x4*)(out + off + bj * 128) = w; }
                ss += __shfl_xor(ss, 16); ss += __shfl_xor(ss, 32);
                if (fq == 0) ssq[(size_t)row * 16 + u.pn * 4 + wc] = ss;
            }
        }
    }
};

struct EpiSwiglu {
    const float* b1; unsigned char* H;
    __device__ __forceinline__ void operator()(const f32x4 (&acc)[2][2][4][2], const Unit& u, int wr, int wc, int fr, int fq) const {
        const int row0 = u.pm * 256 + wr * 64 + fr, p0 = u.pn * 128 + wc * 32 + 8 * fq;
        const float* bp = b1 + (size_t)u.aux * 2048 + 2 * p0;
        f32x4 bv[4];
#pragma unroll
        for (int i = 0; i < 4; ++i) bv[i] = *(const f32x4*)(bp + 4 * i);
#pragma unroll
        for (int ai = 0; ai < 2; ++ai)
#pragma unroll
            for (int m = 0; m < 4; ++m) {
                const int row = row0 + ai * 128 + m * 16;
                float h[8];
#pragma unroll
                for (int n = 0; n < 2; ++n)
#pragma unroll
                    for (int j = 0; j < 4; ++j) {
                        const int i = 4 * n + j;
                        const float g = fminf(acc[ai][0][m][n][j] + bv[i >> 1][(i & 1) * 2], 7.0f);
                        const float l = fminf(fmaxf(acc[ai][1][m][n][j] + bv[i >> 1][(i & 1) * 2 + 1], -7.0f), 7.0f);
                        h[i] = g * __builtin_amdgcn_rcpf(1.0f + __builtin_amdgcn_exp2f(-1.702f * 1.4426950408889634f * g)) * (l + 1.0f);
                    }
                int w0 = 0, w1 = 0;
                w0 = __builtin_amdgcn_cvt_pk_fp8_f32(h[0], h[1], w0, false); w0 = __builtin_amdgcn_cvt_pk_fp8_f32(h[2], h[3], w0, true);
                w1 = __builtin_amdgcn_cvt_pk_fp8_f32(h[4], h[5], w1, false); w1 = __builtin_amdgcn_cvt_pk_fp8_f32(h[6], h[7], w1, true);
                *(u32x2*)(H + (size_t)row * 1024 + p0) = (u32x2){(unsigned)w0, (unsigned)w1};
            }
    }
};

struct EpiDown {
    const float* b2; const float* roww; unsigned char* YE;
    __device__ __forceinline__ void operator()(const f32x4 (&acc)[2][2][4][2], const Unit& u, int wr, int wc, int fr, int fq) const {
        const int row0 = u.pm * 256 + wr * 64 + fr, c0 = u.pn * 256 + wc * 32 + 8 * fq;
        const float* bp = b2 + (size_t)u.aux * 1024 + c0;
        f32x4 bv[2][2];
#pragma unroll
        for (int bj = 0; bj < 2; ++bj)
#pragma unroll
            for (int n = 0; n < 2; ++n) bv[bj][n] = *(const f32x4*)(bp + bj * 128 + 4 * n);
        float w8v[2][4];
#pragma unroll
        for (int ai = 0; ai < 2; ++ai)
#pragma unroll
            for (int m = 0; m < 4; ++m) w8v[ai][m] = roww[row0 + ai * 128 + m * 16] * 16.0f;
#pragma unroll
        for (int ai = 0; ai < 2; ++ai)
#pragma unroll
            for (int m = 0; m < 4; ++m) {
                const int row = row0 + ai * 128 + m * 16; const float w8 = w8v[ai][m];
#pragma unroll
                for (int bj = 0; bj < 2; ++bj) {
                    const f32x4 y0 = (acc[ai][bj][m][0] * 0.03125f + bv[bj][0]) * w8, y1 = (acc[ai][bj][m][1] * 0.03125f + bv[bj][1]) * w8;
                    int w0 = 0, w1 = 0;
                    w0 = __builtin_amdgcn_cvt_pk_fp8_f32(y0[0], y0[1], w0, false); w0 = __builtin_amdgcn_cvt_pk_fp8_f32(y0[2], y0[3], w0, true);
                    w1 = __builtin_amdgcn_cvt_pk_fp8_f32(y1[0], y1[1], w1, false); w1 = __builtin_amdgcn_cvt_pk_fp8_f32(y1[2], y1[3], w1, true);
                    *(u32x2*)(YE + (size_t)row * 1024 + c0 + bj * 128) = (u32x2){(unsigned)w0, (unsigned)w1};
                }
            }
    }
};

__device__ __forceinline__ void transpose_item(const float* W, int N, bf16* WT, int drow0, LAS float* scr, int k0, int n0, int lane) {
    float ld_[32];
#pragma unroll
    for (int i = 0; i < 32; ++i) { const int kk = 2 * i + (lane >> 5); ld_[i] = __builtin_nontemporal_load(W + (size_t)(k0 + kk) * N + n0 + (lane & 31)); }
#pragma unroll
    for (int i = 0; i < 32; ++i) { const int kk = 2 * i + (lane >> 5); scr[kk * 33 + (lane & 31)] = ld_[i]; }
    LDS_WAIT(); asm volatile("" ::: "memory");
    const int c = lane & 7;
#pragma unroll
    for (int j = 0; j < 4; ++j) { const int n = (lane >> 3) + 8 * j; const LAS float* s = scr + (8 * c) * 33 + n;
        u32x4 o; o.x = cvtpk(s[0 * 33], s[1 * 33]); o.y = cvtpk(s[2 * 33], s[3 * 33]); o.z = cvtpk(s[4 * 33], s[5 * 33]); o.w = cvtpk(s[6 * 33], s[7 * 33]);
        *(u32x4*)(WT + (size_t)(drow0 + n) * 1024 + k0 + 8 * c) = o; }
    LDS_WAIT(); asm volatile("" ::: "memory");
}
template <bool GLU>
__device__ __forceinline__ void transpose_item_fp8(const float* W, int N, unsigned char* W8, LAS float* scr, int k0, int n0, int lane) {
    float ld_[32];
#pragma unroll
    for (int i = 0; i < 32; ++i) { const int kk = 2 * i + (lane >> 5); ld_[i] = __builtin_nontemporal_load(W + (size_t)(k0 + kk) * N + n0 + (lane & 31)); }
#pragma unroll
    for (int i = 0; i < 32; ++i) { const int kk = 2 * i + (lane >> 5); scr[kk * 33 + (lane & 31)] = ld_[i]; }
    LDS_WAIT(); asm volatile("" ::: "memory");
    const int c = lane & 3;
#pragma unroll
    for (int j = 0; j < 2; ++j) { const int n = (lane >> 2) + 16 * j; const LAS float* s = scr + (16 * c) * 33 + n;
        int w[4];
#pragma unroll
        for (int q = 0; q < 4; ++q) { int t = 0; t = __builtin_amdgcn_cvt_pk_fp8_f32(s[(4 * q) * 33] * 32.0f, s[(4 * q + 1) * 33] * 32.0f, t, false); t = __builtin_amdgcn_cvt_pk_fp8_f32(s[(4 * q + 2) * 33] * 32.0f, s[(4 * q + 3) * 33] * 32.0f, t, true); w[q] = t; }
        const int col = n0 + n; const int p = col >> 1;
        const int drow = GLU ? ((p >> 7) * 256 + (col & 1) * 128 + (p & 127)) : col;
        *(u32x4*)(W8 + (size_t)drow * 1024 + k0 + 16 * c) = (u32x4){(unsigned)w[0], (unsigned)w[1], (unsigned)w[2], (unsigned)w[3]}; }
    LDS_WAIT(); asm volatile("" ::: "memory");
}
struct ConvItem { const float* W; unsigned char* W8; int N, k0, n0; bool glu; };
__device__ __forceinline__ ConvItem conv_decode(int it, const float* w1, const float* w2, unsigned char* W1_8, unsigned char* W2_8) {
    ConvItem c;
    if (it < 32768) { const int e = it >> 10, rr = it & 1023, nb = rr & 63, kb = rr >> 6; c.W = w1 + (size_t)e * 1024 * 2048; c.W8 = W1_8 + (size_t)e * 2048 * 1024; c.N = 2048; c.k0 = kb * 64; c.n0 = nb * 32; c.glu = true; }
    else { const int r = it - 32768, e = r >> 9, rr = r & 511, nb = rr & 31, kb = rr >> 5; c.W = w2 + (size_t)e * 1024 * 1024; c.W8 = W2_8 + (size_t)e * 1024 * 1024; c.N = 1024; c.k0 = kb * 64; c.n0 = nb * 32; c.glu = false; }
    return c;
}
__device__ __forceinline__ void conv_load(const ConvItem& c, f32x4 (&r)[8], int lane) {
    const float* base = c.W + (size_t)c.k0 * c.N + c.n0;
    const int lo = (lane >> 3) * c.N + (lane & 7) * 4;
#pragma unroll
    for (int i = 0; i < 8; ++i) r[i] = __builtin_nontemporal_load((const f32x4*)(base + (size_t)(8 * i) * c.N + lo));
}
__device__ __forceinline__ void conv_finish(const ConvItem& c, const f32x4 (&r)[8], LAS float* scr, int lane) {
#pragma unroll
    for (int i = 0; i < 8; ++i) *(LAS f32x4*)(scr + (8 * i + (lane >> 3)) * 36 + (lane & 7) * 4) = r[i];
    LDS_WAIT(); asm volatile("" ::: "memory");
    if (c.glu) {
        const int n = lane & 31, half = lane >> 5; const LAS float* s = scr + (32 * half) * 36 + n;
        float v[32];
#pragma unroll
        for (int i = 0; i < 32; ++i) v[i] = s[i * 36];
        u32x4 p0, p1; fp6_pack32(v, p0, p1);
        const int col = c.n0 + n; const int p = col >> 1;
        const int drow = (p >> 7) * 256 + (col & 1) * 128 + (p & 127);
        unsigned char* dst = c.W8 + (size_t)drow * 1024 + (c.k0 >> 7) * 128 + 16 * (((c.k0 & 127) >> 5) + half);
        *(u32x4*)dst = p0; *(u32x4*)(dst + 64) = p1;
        LDS_WAIT(); asm volatile("" ::: "memory");
        return;
    }
    const int cc = lane & 3;
#pragma unroll
    for (int j = 0; j < 2; ++j) { const int n = (lane >> 2) + 16 * j; const LAS float* s = scr + (16 * cc) * 36 + n;
        int w[4];
#pragma unroll
        for (int q = 0; q < 4; ++q) { int t = 0; t = __builtin_amdgcn_cvt_pk_fp8_f32(s[(4 * q) * 36] * 32.0f, s[(4 * q + 1) * 36] * 32.0f, t, false); t = __builtin_amdgcn_cvt_pk_fp8_f32(s[(4 * q + 2) * 36] * 32.0f, s[(4 * q + 3) * 36] * 32.0f, t, true); w[q] = t; }
        const int col = c.n0 + n; const int p = col >> 1;
        const int drow = c.glu ? ((p >> 7) * 256 + (col & 1) * 128 + (p & 127)) : col;
        *(u32x4*)(c.W8 + (size_t)drow * 1024 + c.k0 + 16 * cc) = (u32x4){(unsigned)w[0], (unsigned)w[1], (unsigned)w[2], (unsigned)w[3]}; }
    LDS_WAIT(); asm volatile("" ::: "memory");
}
__device__ __forceinline__ void convert_chunk(int chunk, const float* w1, const float* w2, unsigned char* W1_8, unsigned char* W2_8, LAS float* scr, int wave, int lane) {
    const int base = chunk * 32 + wave;
    f32x4 ra[8], rb[8];
    ConvItem ca = conv_decode(base, w1, w2, W1_8, W2_8), cb;
    conv_load(ca, ra, lane);
#pragma unroll 1
    for (int j = 0; j < 4; j += 2) {
        cb = conv_decode(base + 8 * (j + 1), w1, w2, W1_8, W2_8); conv_load(cb, rb, lane);
        conv_finish(ca, ra, scr, lane);
        if (j + 2 < 4) { ca = conv_decode(base + 8 * (j + 2), w1, w2, W1_8, W2_8); conv_load(ca, ra, lane); }
        conv_finish(cb, rb, scr, lane);
    }
}
__device__ __forceinline__ int headperm_row(int n0) { const int pn = n0 >> 8, c = n0 & 255, hh = c >> 6, dh = (c & 63) >> 5; return pn * 256 + dh * 128 + hh * 32; }
__device__ __forceinline__ void rms_row_to_bf16(const float* xrow, const float* gain, bf16* orow, int lane) {
    const f32x4* xr = (const f32x4*)xrow + lane; const f32x4* gr = (const f32x4*)gain + lane;
    f32x4 v[4]; float s = 0.f;
#pragma unroll
    for (int j = 0; j < 4; ++j) { v[j] = xr[64 * j]; s += (v[j].x * v[j].x + v[j].y * v[j].y) + (v[j].z * v[j].z + v[j].w * v[j].w); }
    const float rstd = 1.0f / sqrtf(wave_sum(s) * (1.f / DM) + EPS);
    u32x2* o8 = (u32x2*)orow + lane;
#pragma unroll
    for (int j = 0; j < 4; ++j) { const f32x4 gg = gr[64 * j]; u32x2 w; w.x = cvtpk(v[j].x * rstd * gg.x, v[j].y * rstd * gg.y); w.y = cvtpk(v[j].z * rstd * gg.z, v[j].w * rstd * gg.w); o8[64 * j] = w; }
}

__device__ __forceinline__ void rms_row2_to_bf16(const float* xrow, const float* gain, bf16* orow, int lane, float* irs) {
    const f32x4* xr = (const f32x4*)xrow + lane; const f32x4* gr = (const f32x4*)gain + lane;
    f32x4 v[8]; float s0 = 0.f, s1 = 0.f;
#pragma unroll
    for (int j = 0; j < 8; ++j) v[j] = __builtin_nontemporal_load(xr + 64 * j);
#pragma unroll
    for (int j = 0; j < 4; ++j) { s0 += (v[j].x * v[j].x + v[j].y * v[j].y) + (v[j].z * v[j].z + v[j].w * v[j].w); s1 += (v[4 + j].x * v[4 + j].x + v[4 + j].y * v[4 + j].y) + (v[4 + j].z * v[4 + j].z + v[4 + j].w * v[4 + j].w); }
    const float q0 = sqrtf(wave_sum(s0) * (1.f / DM) + EPS), q1 = sqrtf(wave_sum(s1) * (1.f / DM) + EPS); const float r0 = 1.0f / q0, r1 = 1.0f / q1;
    if (irs != nullptr && lane == 0) { irs[0] = q0; irs[1] = q1; }
    u32x2* o8 = (u32x2*)orow + lane;
#pragma unroll
    for (int j = 0; j < 4; ++j) { const f32x4 gg = gr[64 * j]; u32x2 w; w.x = cvtpk(v[j].x * r0 * gg.x, v[j].y * r0 * gg.y); w.y = cvtpk(v[j].z * r0 * gg.z, v[j].w * r0 * gg.w); o8[64 * j] = w;
        u32x2 w2; w2.x = cvtpk(v[4 + j].x * r1 * gg.x, v[4 + j].y * r1 * gg.y); w2.y = cvtpk(v[4 + j].z * r1 * gg.z, v[4 + j].w * r1 * gg.w); o8[256 + 64 * j] = w2; }
}

#include <hip/hip_bf16.h>
namespace attn_body {
using s16x4=__attribute__((ext_vector_type(4)))short;
using f32x16=__attribute__((ext_vector_type(16)))float;
constexpr int D=64,NW=8,QBLK=32,QB=QBLK*NW,KVBLK=64;
__device__ __forceinline__ int crow(int r,int hi){return (r&3)+8*(r>>2)+4*hi;}
#define SBAR() __builtin_amdgcn_sched_barrier(0)
__device__ __forceinline__ void cmask(f32x16&p0,f32x16&p1,int jb,int qrel,int hi){
  const float NEG=-INFINITY; int kb=64*jb+4*hi;
  #pragma unroll
  for(int r=0;r<16;++r){int kv=kb+(r&3)+8*(r>>2); if(kv>qrel)p0[r]=NEG; if(kv+32>qrel)p1[r]=NEG;}
}
constexpr int NSLOT=3, SLOTB=8192;
constexpr int LDS_K=0, LDS_V=NSLOT*SLOTB, LDS_WS=2*NSLOT*SLOTB, LDS_OST=LDS_WS+NW*64*4, ATT_LDS_BYTES=LDS_OST+NW*4096;
__device__ __forceinline__ void glds16(const void*gsrc,unsigned lds_dst){unsigned keep;
  asm volatile("s_mov_b32 %0, m0\n\ts_mov_b32 m0, %2\n\ts_nop 0\n\tglobal_load_lds_dwordx4 %1, off\n\ts_mov_b32 m0, %0":"=&s"(keep):"v"(gsrc),"s"(lds_dst):"memory");}
__device__ __forceinline__ float max3f(float a,float b,float c){float r;asm("v_max3_f32 %0, %1, %2, %3":"=v"(r):"v"(a),"v"(b),"v"(c));return r;}
__device__ __forceinline__ float max2f(float a,float b){float r;asm("v_max_f32_e32 %0, %1, %2":"=v"(r):"v"(a),"v"(b));return r;}
__device__ __forceinline__ float fadd_s(float a,float b){float r;asm("v_add_f32_e32 %0, %1, %2":"=v"(r):"v"(a),"v"(b));return r;}
__device__ __forceinline__ float fsub_s(float a,float b){float r;asm("v_sub_f32_e32 %0, %1, %2":"=v"(r):"v"(a),"v"(b));return r;}
__device__ __forceinline__ unsigned cvtpk_s(float lo,float hi){return cvtpk(lo,hi);}
#define WAIT_BAR(N) asm volatile("s_waitcnt vmcnt(" #N ") lgkmcnt(0)\n\ts_barrier":::"memory")
__device__ __forceinline__ void qkt(f32x16&p0,f32x16&p1,const char*Kslot,const bf16x8*qr,const f32x16&negm,int r32,int hi){
  const char*kb=Kslot+hi*1024+r32*16;
  #pragma unroll
  for(int d0=0;d0<4;++d0){
    const bf16x8 b0=*reinterpret_cast<const bf16x8*>(kb+d0*2048);
    const bf16x8 b1=*reinterpret_cast<const bf16x8*>(kb+d0*2048+512);
    if(d0==0){p0=__builtin_amdgcn_mfma_f32_32x32x16_bf16(b0,qr[0],negm,0,0,0);p1=__builtin_amdgcn_mfma_f32_32x32x16_bf16(b1,qr[0],negm,0,0,0);}
    else{p0=__builtin_amdgcn_mfma_f32_32x32x16_bf16(b0,qr[d0],p0,0,0,0);p1=__builtin_amdgcn_mfma_f32_32x32x16_bf16(b1,qr[d0],p1,0,0,0);}}
}
typedef __attribute__((address_space(3))) const char* lds_cptr;
typedef short v4i16_t __attribute__((ext_vector_type(4)));
__device__ __forceinline__ void kload8(bf16x8*kf,lds_cptr kp){
  kf[0]=*(const __attribute__((address_space(3))) bf16x8*)(kp);      kf[1]=*(const __attribute__((address_space(3))) bf16x8*)(kp+512);
  kf[2]=*(const __attribute__((address_space(3))) bf16x8*)(kp+2048); kf[3]=*(const __attribute__((address_space(3))) bf16x8*)(kp+2560);
  kf[4]=*(const __attribute__((address_space(3))) bf16x8*)(kp+4096); kf[5]=*(const __attribute__((address_space(3))) bf16x8*)(kp+4608);
  kf[6]=*(const __attribute__((address_space(3))) bf16x8*)(kp+6144); kf[7]=*(const __attribute__((address_space(3))) bf16x8*)(kp+6656);
}
__device__ __forceinline__ void kload2(bf16x8*kf,lds_cptr kp,int j){ kf[2*j]=*(const __attribute__((address_space(3))) bf16x8*)(kp+j*2048); kf[2*j+1]=*(const __attribute__((address_space(3))) bf16x8*)(kp+j*2048+512); }
__device__ __forceinline__ s16x4 vtr(lds_cptr p){ return __builtin_bit_cast(s16x4,__builtin_amdgcn_ds_read_tr16_b64_v4i16((__attribute__((address_space(3))) v4i16_t*)p)); }
__device__ __forceinline__ float rowmax(const f32x16&p0,const f32x16&p1){
  float a=max3f(p0[0],p0[1],p1[0]),b=max3f(p0[2],p0[3],p1[1]);a=max3f(a,p1[2],p1[3]);
  #pragma unroll
  for(int r=4;r<16;r+=4){a=max3f(a,p0[r],p0[r+1]);b=max3f(b,p0[r+2],p0[r+3]);a=max3f(a,p1[r],p1[r+1]);b=max3f(b,p1[r+2],p1[r+3]);}
  const float m=max2f(a,b);
  auto rr=__builtin_amdgcn_permlane32_swap(__float_as_uint(m),__float_as_uint(m),false,false);
  return max2f(__uint_as_float(rr[0]),__uint_as_float(rr[1]));
}
__device__ __forceinline__ void pv(f32x16*o,int vb,bf16x8 pa0,bf16x8 pa1,bf16x8 pa2,bf16x8 pa3){
  #pragma unroll
  for(int d0=0;d0<2;++d0){s16x4 lo[4],hi[4];
    #pragma unroll
    for(int ks=0;ks<4;++ks){
      asm volatile("ds_read_b64_tr_b16 %0,%1 offset:%c2":"=&v"(lo[ks]):"v"(vb),"i"(d0*4096+ks*1024):"memory");
      asm volatile("ds_read_b64_tr_b16 %0,%1 offset:%c2":"=&v"(hi[ks]):"v"(vb),"i"(d0*4096+ks*1024+512):"memory");}
    asm volatile("s_waitcnt lgkmcnt(0)":::"memory");SBAR();
    #define PK(k) (bf16x8){lo[k][0],lo[k][1],lo[k][2],lo[k][3],hi[k][0],hi[k][1],hi[k][2],hi[k][3]}
    o[d0]=__builtin_amdgcn_mfma_f32_32x32x16_bf16(pa0,PK(0),o[d0],0,0,0);
    o[d0]=__builtin_amdgcn_mfma_f32_32x32x16_bf16(pa1,PK(1),o[d0],0,0,0);
    o[d0]=__builtin_amdgcn_mfma_f32_32x32x16_bf16(pa2,PK(2),o[d0],0,0,0);
    o[d0]=__builtin_amdgcn_mfma_f32_32x32x16_bf16(pa3,PK(3),o[d0],0,0,0);
    #undef PK
  }
}
template<int THRL,int KP,int OP,bool MOBA> __device__ __forceinline__ void attn_unit(const bf16*Qu,const bf16*__restrict__ Kh,const bf16*__restrict__ Vh,bf16*Ou,const int NT,const int nblk,const float*kmean,char*shm){
  const int tid=opaque((int)threadIdx.x),lane=tid&63,r32=lane&31,hi=lane>>5; const int wid=__builtin_amdgcn_readfirstlane(tid>>6);
  const bf16*Qw=Qu+(long)(wid*QBLK)*KP;
  const unsigned lds0=(unsigned)(uintptr_t)shm;
  float*wsf=(float*)(shm+LDS_WS)+wid*64;
  const bf16*ksrc=Kh+(long)lane*KP+wid*8;
  const bf16*vsrc=Vh+(long)(16*(wid&3)+(lane>>2))*KP+(wid>>2)*32+(lane&3)*8;
  const unsigned kdst=lds0+LDS_K+wid*1024, vdst=lds0+LDS_V+wid*1024;
  #define DMA_K(t,slot) glds16(ksrc+(long)(t)*KVBLK*KP,(unsigned)__builtin_amdgcn_readfirstlane(kdst+(slot)))
  #define DMA_V(t,slot) glds16(vsrc+(long)(t)*KVBLK*KP,(unsigned)__builtin_amdgcn_readfirstlane(vdst+(slot)))
  const int vb0=(int)(lds0+LDS_V)+((lane>>4)&1)*32+(lane&3)*8+(4*hi+((lane&15)>>2))*64;
  const char*Kbase=shm+LDS_K; bf16x8 kf[8];
  const lds_cptr shm3=(lds_cptr)shm; const lds_cptr kp0=shm3+LDS_K+hi*1024+r32*16; const lds_cptr vp0=shm3+LDS_V+((lane>>4)&1)*32+(lane&3)*8+(4*hi+((lane&15)>>2))*64;
  DMA_K(0,0);DMA_V(0,0);DMA_K(1,SLOTB);
  bf16x8 qr[4];
  #pragma unroll
  for(int d0=0;d0<4;++d0)qr[d0]=*reinterpret_cast<const bf16x8*>(&Qw[(long)r32*KP+d0*16+hi*8]);
  unsigned bmask=0xffffffffu;
  if(MOBA){
    bmask=1u<<nblk;
    float g0=-3e38f,g1=-3e38f,g2=-3e38f; int i0=-1,i1=-1,i2=-1;
    for(int j=0;j<nblk;++j){
      const float*km=kmean+(long)j*512+8*hi; float g=0.f;
      #pragma unroll
      for(int d0=0;d0<4;++d0){ const f32x4 a=*(const f32x4*)(km+16*d0),b=*(const f32x4*)(km+16*d0+4);
        g+=bf2f((unsigned short)qr[d0][0])*a[0]+bf2f((unsigned short)qr[d0][1])*a[1]+bf2f((unsigned short)qr[d0][2])*a[2]+bf2f((unsigned short)qr[d0][3])*a[3];
        g+=bf2f((unsigned short)qr[d0][4])*b[0]+bf2f((unsigned short)qr[d0][5])*b[1]+bf2f((unsigned short)qr[d0][6])*b[2]+bf2f((unsigned short)qr[d0][7])*b[3]; }
      g+=__shfl_xor(g,32);
      if(g>g0){g2=g1;i2=i1;g1=g0;i1=i0;g0=g;i0=j;} else if(g>g1){g2=g1;i2=i1;g1=g;i1=j;} else if(g>g2){g2=g;i2=j;}
    }
    if(i0>=0)bmask|=1u<<i0; if(i1>=0)bmask|=1u<<i1; if(i2>=0)bmask|=1u<<i2;
  }
  #define NEGM_FOR(t) (MOBA ? (((bmask>>((t)>>2))&1u) ? -mhat : -INFINITY) : -mhat)
  float mhat=0.f,l_reg=0.f;f32x16 o[2];o[0]=f32x16{};o[1]=f32x16{};f32x16 negm;
  { const float nm=NEGM_FOR(0);
    #pragma unroll
    for(int r=0;r<16;++r)negm[r]=nm; }
  asm volatile("":"+v"(negm));
  const int qrel=wid*QBLK+r32;
  #define CMASK(P0,P1,t) do{ if(MOBA){int jb_=(t)-(NT-4); if(jb_>=0)cmask(P0,P1,jb_,qrel,hi);} }while(0)
  bool resc=false;
  #define START(P0,P1) do{ const float rm=rowmax(P0,P1); resc=false; \
    { const float dl=(MOBA&&rm==-INFINITY)?0.f:rm; mhat=fadd_s(mhat,dl); \
      _Pragma("unroll") for(int r=0;r<16;++r){P0[r]=fsub_s(P0[r],dl);P1[r]=fsub_s(P1[r],dl);} \
      { const float nm=NEGM_FOR(1); _Pragma("unroll") for(int r=0;r<16;++r)negm[r]=nm; } asm volatile("":"+v"(negm)); } \
    _Pragma("unroll") for(int r=0;r<16;++r)P0[r]=__builtin_amdgcn_exp2f(P0[r]); }while(0)
  #define RESC() do{ if(resc){ asm volatile("s_waitcnt lgkmcnt(0)":::"memory"); \
      _Pragma("unroll") for(int d_=0;d_<2;++d_) _Pragma("unroll") for(int r=0;r<16;++r)o[d_][r]*=wsf[crow(r,hi)]; } }while(0)
  f32x16 pA0,pA1,pB0,pB1;
  int sl_prev=0,sl_cur=0,sl_next=SLOTB;
  #define ROT() do{sl_prev=sl_cur;sl_cur=sl_next;sl_next=(sl_next==(NSLOT-1)*SLOTB)?0:sl_next+SLOTB;}while(0)
  DMA_K(2,2*SLOTB);
  WAIT_BAR(3);
  qkt(pA0,pA1,Kbase,qr,negm,r32,hi);asm volatile("s_nop 15\n\ts_nop 7":"+v"(pA0),"+v"(pA1));CMASK(pA0,pA1,0);
  START(pA0,pA1);
  _Pragma("unroll") for(int r=0;r<16;++r)pA1[r]=__builtin_amdgcn_exp2f(pA1[r]);
  WAIT_BAR(0);
  DMA_K(3,0);DMA_V(1,SLOTB);
  ROT();
  kload8(kf,kp0+sl_cur);
  WAIT_BAR(2);
  s16x4 vlo[8],vhi[8]; u32x4 pw0,pw1,pw2,pw3;
  #define PKW(P,B) cvtpk_s(P[B],P[B+1])
  #define PAF(k) __builtin_bit_cast(bf16x8,pw##k)
  #define VFR(i) (bf16x8){vlo[i][0],vlo[i][1],vlo[i][2],vlo[i][3],vhi[i][0],vhi[i][1],vhi[i][2],vhi[i][3]}
  #define PIN(x) asm volatile("":"+v"(x))
  #define MX3(a,b,c) __builtin_fmaxf(__builtin_fmaxf((a),(b)),(c))
  #define GAPA(MF,A0,A1,A2,A3,W0,W1,PW) do{ MF; sacc+=A0; sacc+=A1; sacc+=A2; sacc+=A3; PIN(sacc); W0; W1; PIN(PW); SBAR(); }while(0)
  #define EX(v) __builtin_amdgcn_exp2f(v)
  #define GAPB(MF,X,B) do{ MF; X[B]=EX(X[B]); X[B+1]=EX(X[B+1]); X[B+2]=EX(X[B+2]); X[B+3]=EX(X[B+3]); PIN(X); SBAR(); }while(0)
  #define VRD(i) do{ vlo[i]=vtr(vp_+(((i)>>2)*4096+((i)&3)*1024)); vhi[i]=vtr(vp_+(((i)>>2)*4096+((i)&3)*1024+512)); }while(0)
  #define KRD(G,j) do{ if(G){ kload2(kf,kp0+sl_next,j); SBAR(); } }while(0)
  #define STEP(C0,C1,P0,P1,t,GK,GV,GL) do{ SBAR(); \
    const lds_cptr vp_=vp0+sl_prev; \
    VRD(0); SBAR(); float sacc=(P0[0]+P0[1]); \
    GAPA(C0=__builtin_amdgcn_mfma_f32_32x32x16_bf16(kf[0],qr[0],negm,0,0,0), P0[2],P0[3],P0[4],P0[5],     pw0[0]=PKW(P0,0), pw0[1]=PKW(P0,2), pw0); \
    VRD(4); SBAR(); GAPA(C1=__builtin_amdgcn_mfma_f32_32x32x16_bf16(kf[1],qr[0],negm,0,0,0), P0[6],P0[7],P0[8],P0[9],     pw0[2]=PKW(P0,4), pw0[3]=PKW(P0,6), pw0); \
    VRD(1); SBAR(); GAPA(C0=__builtin_amdgcn_mfma_f32_32x32x16_bf16(kf[2],qr[1],C0,0,0,0),   P0[10],P0[11],P0[12],P0[13], pw1[0]=PKW(P0,8), pw1[1]=PKW(P0,10), pw1); \
    VRD(5); SBAR(); GAPA(C1=__builtin_amdgcn_mfma_f32_32x32x16_bf16(kf[3],qr[1],C1,0,0,0),   P0[14],P0[15],P1[0],P1[1],   pw1[2]=PKW(P0,12),pw1[3]=PKW(P0,14), pw1); \
    VRD(2); SBAR(); GAPA(C0=__builtin_amdgcn_mfma_f32_32x32x16_bf16(kf[4],qr[2],C0,0,0,0),   P1[2],P1[3],P1[4],P1[5],     pw2[0]=PKW(P1,0), pw2[1]=PKW(P1,2), pw2); \
    VRD(6); SBAR(); GAPA(C1=__builtin_amdgcn_mfma_f32_32x32x16_bf16(kf[5],qr[2],C1,0,0,0),   P1[6],P1[7],P1[8],P1[9],     pw2[2]=PKW(P1,4), pw2[3]=PKW(P1,6), pw2); \
    VRD(3); SBAR(); GAPA(C0=__builtin_amdgcn_mfma_f32_32x32x16_bf16(kf[6],qr[3],C0,0,0,0),   P1[10],P1[11],P1[12],P1[13], pw3[0]=PKW(P1,8), pw3[1]=PKW(P1,10), pw3); \
    VRD(7); SBAR(); GAPA(C1=__builtin_amdgcn_mfma_f32_32x32x16_bf16(kf[7],qr[3],C1,0,0,0),   P1[14],P1[15],0.f,0.f,       pw3[2]=PKW(P1,12),pw3[3]=PKW(P1,14), pw3); \
    l_reg+=sacc; \
    if(GK){DMA_K((t)+3,sl_cur);} if(GV){DMA_V((t)+1,sl_next);} \
    CMASK(C0,C1,t); \
    { float a=MX3(C0[0],C0[1],C1[0]),b=MX3(C0[2],C0[3],C1[1]); a=MX3(a,C1[2],C1[3]); \
      _Pragma("unroll") for(int r=4;r<16;r+=4){a=MX3(a,C0[r],C0[r+1]);b=MX3(b,C0[r+2],C0[r+3]);a=MX3(a,C1[r],C1[r+1]);b=MX3(b,C1[r+2],C1[r+3]);} \
      float rm=__builtin_fmaxf(a,b); { auto rr=__builtin_amdgcn_permlane32_swap(__float_as_uint(rm),__float_as_uint(rm),false,false); rm=__builtin_fmaxf(__uint_as_float(rr[0]),__uint_as_float(rr[1])); } \
      resc=false; \
      if(__builtin_expect(__any(rm>(float)THRL),0)){ const float dl=__builtin_fmaxf(rm,0.f); mhat+=dl; \
        _Pragma("unroll") for(int r=0;r<16;++r){C0[r]-=dl;C1[r]-=dl;} \
        if(!MOBA){ _Pragma("unroll") for(int r=0;r<16;++r)negm[r]=-mhat; asm volatile("":"+v"(negm)); } \
        const float f=__builtin_amdgcn_exp2f(-dl); l_reg*=f; if(hi==0)wsf[r32]=f; resc=true; } \
      if(MOBA){ if(resc||((((t)+1)&3)==0)){ const float nm=NEGM_FOR((t)+1); _Pragma("unroll") for(int r=0;r<16;++r)negm[r]=nm; asm volatile("":"+v"(negm)); } } } \
    SBAR(); \
    GAPB(o[0]=__builtin_amdgcn_mfma_f32_32x32x16_bf16(PAF(0),VFR(0),o[0],0,0,0), C0,0); \
    GAPB(o[1]=__builtin_amdgcn_mfma_f32_32x32x16_bf16(PAF(0),VFR(4),o[1],0,0,0), C0,4); \
    KRD(GL,0); GAPB(o[0]=__builtin_amdgcn_mfma_f32_32x32x16_bf16(PAF(1),VFR(1),o[0],0,0,0), C0,8); \
    KRD(GL,1); GAPB(o[1]=__builtin_amdgcn_mfma_f32_32x32x16_bf16(PAF(1),VFR(5),o[1],0,0,0), C0,12); \
    KRD(GL,2); GAPB(o[0]=__builtin_amdgcn_mfma_f32_32x32x16_bf16(PAF(2),VFR(2),o[0],0,0,0), C1,0); \
    KRD(GL,3); GAPB(o[1]=__builtin_amdgcn_mfma_f32_32x32x16_bf16(PAF(2),VFR(6),o[1],0,0,0), C1,4); \
    GAPB(o[0]=__builtin_amdgcn_mfma_f32_32x32x16_bf16(PAF(3),VFR(3),o[0],0,0,0), C1,8); \
    GAPB(o[1]=__builtin_amdgcn_mfma_f32_32x32x16_bf16(PAF(3),VFR(7),o[1],0,0,0), C1,12); \
    }while(0)
  int t=1;
  #undef CMASK
  #define CMASK(P0,P1,t) do{}while(0)
  for(;t+5<NT;t+=2){
    STEP(pB0,pB1,pA0,pA1,t,true,true,true);     WAIT_BAR(2); RESC(); ROT();
    STEP(pA0,pA1,pB0,pB1,t+1,true,true,true);   WAIT_BAR(2); RESC(); ROT();
  }
  #undef CMASK
  #define CMASK(P0,P1,t) do{ if(MOBA){int jb_=(t)-(NT-4); if(jb_>=0)cmask(P0,P1,jb_,qrel,hi);} }while(0)
  #define ENDW(tt) do{ if((tt)+3<NT){WAIT_BAR(2);} else if((tt)+2<NT){WAIT_BAR(1);} else {WAIT_BAR(0);} }while(0)
  for(;t+1<NT;t+=2){
    STEP(pB0,pB1,pA0,pA1,t,(t+3<NT),(t+1<NT),(t+1<NT));       ENDW(t);   RESC(); ROT();
    STEP(pA0,pA1,pB0,pB1,t+1,(t+4<NT),(t+2<NT),(t+2<NT));     ENDW(t+1); RESC(); ROT();
  }
  STEP(pB0,pB1,pA0,pA1,NT-1,false,false,false); RESC();
  { float sacc=pB0[0]+pB0[1]; _Pragma("unroll") for(int r=2;r<16;++r)sacc+=pB0[r]; _Pragma("unroll") for(int r=0;r<16;++r)sacc+=pB1[r]; l_reg+=sacc;
    pw0=(u32x4){PKW(pB0,0),PKW(pB0,2),PKW(pB0,4),PKW(pB0,6)};pw1=(u32x4){PKW(pB0,8),PKW(pB0,10),PKW(pB0,12),PKW(pB0,14)};pw2=(u32x4){PKW(pB1,0),PKW(pB1,2),PKW(pB1,4),PKW(pB1,6)};pw3=(u32x4){PKW(pB1,8),PKW(pB1,10),PKW(pB1,12),PKW(pB1,14)};
    SBAR(); pv(o,vb0+sl_cur,PAF(0),PAF(1),PAF(2),PAF(3)); }
  #undef PKW
  #undef PAF
  #undef VFR
  #undef PIN
  #undef MX3
  #undef GAPA
  #undef GAPB
  #undef EX
  #undef VRD
  #undef KRD
  #undef STEP
  #undef ENDW
  {auto rr=__builtin_amdgcn_permlane32_swap(__float_as_uint(l_reg),__float_as_uint(l_reg),false,false);l_reg=__uint_as_float(rr[0])+__uint_as_float(rr[1]);}
  if(hi==0)wsf[32+r32]=l_reg;asm volatile("s_waitcnt lgkmcnt(0)":::"memory");
  float rli[16];
  #pragma unroll
  for(int r=0;r<16;++r)rli[r]=__builtin_amdgcn_rcpf(wsf[32+crow(r,hi)]);
  bf16*Ow=Ou+(long)(wid*QBLK)*OP;
  { bf16*stg=(bf16*)(shm+LDS_OST)+wid*2048;
    #pragma unroll
    for(int r=0;r<16;++r){const int orow=crow(r,hi);
      #pragma unroll
      for(int d0=0;d0<2;++d0)stg[orow*64+d0*32+r32]=(bf16)(cvtpk(o[d0][r]*rli[r],0.f)&0xffffu);}
    asm volatile("s_waitcnt lgkmcnt(0)":::"memory");
    #pragma unroll
    for(int i=0;i<4;++i){const int row=i*8+(lane>>3),ch=lane&7; const u32x4 v=*(const u32x4*)(stg+row*64+ch*8); *(u32x4*)(Ow+(long)row*OP+ch*8)=v;} }
  asm volatile("s_waitcnt lgkmcnt(0)\n\ts_barrier":::"memory");
  #undef DMA_K
  #undef DMA_V
  #undef CMASK
  #undef START
  #undef RESC
  #undef ROT
  #undef NEGM_FOR
}
#undef SBAR
#undef WAIT_BAR
}

namespace ret_body {
using attn_body::s16x4; using attn_body::f32x16; using attn_body::glds16; using attn_body::pv; using attn_body::crow;
constexpr int KVF_BYTES = 64 * 64 * 4;
__device__ __forceinline__ void kv_unit(const bf16* KR, const bf16* VR, float* KVF, int b, int h, int cp, char* shm) {
  const int tid = opaque((int)threadIdx.x), lane = tid & 63, r32 = lane & 31, hi = lane >> 5; const int wid = __builtin_amdgcn_readfirstlane(tid >> 6);
  const unsigned lds0 = (unsigned)(uintptr_t)shm;
  const size_t rowb = (size_t)b * SEQ + (size_t)cp * 256;
  const long voff = (long)(16 * (wid & 3) + (lane >> 2)) * 256 + h * 64 + (wid >> 2) * 32 + (lane & 3) * 8;
#pragma unroll
  for (int c = 0; c < 2; ++c)
#pragma unroll
    for (int tl = 0; tl < 2; ++tl) {
      const size_t r0 = rowb + c * 128 + tl * 64;
      glds16(KR + r0 * 256 + voff, (unsigned)__builtin_amdgcn_readfirstlane(lds0 + ((c * 2 + 0) * 2 + tl) * 8192 + wid * 1024));
      glds16(VR + r0 * 256 + voff, (unsigned)__builtin_amdgcn_readfirstlane(lds0 + ((c * 2 + 1) * 2 + tl) * 8192 + wid * 1024));
    }
  asm volatile("s_waitcnt vmcnt(0) lgkmcnt(0)\n\ts_barrier" ::: "memory");
  const int c = wid >> 2, dkb = (wid >> 1) & 1, dvb = wid & 1;
  const int vb = (int)lds0 + ((lane >> 4) & 1) * 32 + (lane & 3) * 8 + (4 * hi + ((lane & 15) >> 2)) * 64;
  f32x16 acc = f32x16{};
#pragma unroll
  for (int tl = 0; tl < 2; ++tl) {
    s16x4 alo[4], ahi[4], blo[4], bhi[4];
    const int ka = vb + ((c * 2 + 0) * 2 + tl) * 8192 + dkb * 4096, va = vb + ((c * 2 + 1) * 2 + tl) * 8192 + dvb * 4096;
#pragma unroll
    for (int ks = 0; ks < 4; ++ks) {
      asm volatile("ds_read_b64_tr_b16 %0,%1 offset:%c2" : "=&v"(alo[ks]) : "v"(ka), "i"(ks * 1024) : "memory");
      asm volatile("ds_read_b64_tr_b16 %0,%1 offset:%c2" : "=&v"(ahi[ks]) : "v"(ka), "i"(ks * 1024 + 512) : "memory");
      asm volatile("ds_read_b64_tr_b16 %0,%1 offset:%c2" : "=&v"(blo[ks]) : "v"(va), "i"(ks * 1024) : "memory");
      asm volatile("ds_read_b64_tr_b16 %0,%1 offset:%c2" : "=&v"(bhi[ks]) : "v"(va), "i"(ks * 1024 + 512) : "memory");
    }
    asm volatile("s_waitcnt lgkmcnt(0)" ::: "memory"); __builtin_amdgcn_sched_barrier(0);
#pragma unroll
    for (int ks = 0; ks < 4; ++ks) {
      const bf16x8 af = (bf16x8){alo[ks][0], alo[ks][1], alo[ks][2], alo[ks][3], ahi[ks][0], ahi[ks][1], ahi[ks][2], ahi[ks][3]};
      const bf16x8 bfr = (bf16x8){blo[ks][0], blo[ks][1], blo[ks][2], blo[ks][3], bhi[ks][0], bhi[ks][1], bhi[ks][2], bhi[ks][3]};
      acc = __builtin_amdgcn_mfma_f32_32x32x16_bf16(af, bfr, acc, 0, 0, 0);
    }
  }
  const float lgam = __builtin_amdgcn_logf(1.0f - __builtin_amdgcn_exp2f(-5.0f - (float)h));
  const float g127 = __builtin_amdgcn_exp2f(lgam * 127.0f);
  float* outp = KVF + ((size_t)((b * 4 + h) * 32 + cp * 2 + c)) * 4096 + dvb * 32 + r32;
#pragma unroll
  for (int r = 0; r < 16; ++r) outp[(size_t)(dkb * 32 + crow(r, hi)) * 64] = acc[r] * g127;
  asm volatile("s_waitcnt lgkmcnt(0)\n\ts_barrier" ::: "memory");
}

__device__ __forceinline__ void out_unit(const bf16* QR, const bf16* KR, const bf16* VR, const bf16* GR, const float* KVF, const float* rgain, bf16* Y, int b, int h, int cp, char* shm) {
  const int tid = opaque((int)threadIdx.x), lane = tid & 63, r32 = lane & 31, hi = lane >> 5; const int wid = __builtin_amdgcn_readfirstlane(tid >> 6);
  const unsigned lds0 = (unsigned)(uintptr_t)shm;
  constexpr int L_K = 0, L_V = 32768, L_S = 65536, L_O = 81920;
  const size_t rowb = (size_t)b * SEQ + (size_t)cp * 256;
  const long koff = (long)lane * 256 + h * 64 + wid * 8;
  const long voff = (long)(16 * (wid & 3) + (lane >> 2)) * 256 + h * 64 + (wid >> 2) * 32 + (lane & 3) * 8;
#pragma unroll
  for (int tl = 0; tl < 4; ++tl) {
    const size_t r0 = rowb + tl * 64;
    glds16(KR + r0 * 256 + koff, (unsigned)__builtin_amdgcn_readfirstlane(lds0 + L_K + tl * 8192 + wid * 1024));
    glds16(VR + r0 * 256 + voff, (unsigned)__builtin_amdgcn_readfirstlane(lds0 + L_V + tl * 8192 + wid * 1024));
  }
  {
    const float lgam = __builtin_amdgcn_logf(1.0f - __builtin_amdgcn_exp2f(-5.0f - (float)h));
    const float lgc = lgam * 128.0f;
    const int n0 = 2 * cp;
    int mlo = n0 - 1 - (int)(34.0f / (-lgc)); if (mlo < 0) mlo = 0;
    const float* kvp = KVF + ((size_t)((b * 4 + h) * 32)) * 4096 + tid * 8;
    f32x4 s0 = {0.f, 0.f, 0.f, 0.f}, s1 = {0.f, 0.f, 0.f, 0.f};
    int m = mlo;
    for (; m + 8 <= n0; m += 8) {
      f32x4 a[8], c4[8];
#pragma unroll
      for (int q = 0; q < 8; ++q) { a[q] = *(const f32x4*)(kvp + (size_t)(m + q) * 4096); c4[q] = *(const f32x4*)(kvp + (size_t)(m + q) * 4096 + 4); }
#pragma unroll
      for (int q = 0; q < 8; ++q) { const float w = __builtin_amdgcn_exp2f(lgc * (float)(n0 - 1 - m - q)); s0 += a[q] * w; s1 += c4[q] * w; }
    }
    for (; m + 4 <= n0; m += 4) {
      f32x4 a[4], c4[4];
#pragma unroll
      for (int q = 0; q < 4; ++q) { a[q] = *(const f32x4*)(kvp + (size_t)(m + q) * 4096); c4[q] = *(const f32x4*)(kvp + (size_t)(m + q) * 4096 + 4); }
#pragma unroll
      for (int q = 0; q < 4; ++q) { const float w = __builtin_amdgcn_exp2f(lgc * (float)(n0 - 1 - m - q)); s0 += a[q] * w; s1 += c4[q] * w; }
    }
    for (; m < n0; ++m) {
      const float w = __builtin_amdgcn_exp2f(lgc * (float)(n0 - 1 - m));
      const f32x4 a = *(const f32x4*)(kvp + (size_t)m * 4096), c4 = *(const f32x4*)(kvp + (size_t)m * 4096 + 4);
      s0 += a * w; s1 += c4 * w;
    }
    const int dk = tid >> 3, dv = 8 * (tid & 7);
    char* sp = shm + L_S + (dv >> 5) * 4096 + dk * 64 + (dv & 31) * 2;
    u32x4 w0; w0.x = cvtpk(s0[0], s0[1]); w0.y = cvtpk(s0[2], s0[3]); w0.z = cvtpk(s1[0], s1[1]); w0.w = cvtpk(s1[2], s1[3]);
    *(u32x4*)sp = w0;
    const float dc = __builtin_amdgcn_exp2f(lgc);
    const f32x4 a = *(const f32x4*)(kvp + (size_t)n0 * 4096), c4 = *(const f32x4*)(kvp + (size_t)n0 * 4096 + 4);
    s0 = s0 * dc + a; s1 = s1 * dc + c4;
    u32x4 w1; w1.x = cvtpk(s0[0], s0[1]); w1.y = cvtpk(s0[2], s0[3]); w1.z = cvtpk(s1[0], s1[1]); w1.w = cvtpk(s1[2], s1[3]);
    *(u32x4*)(sp + 8192) = w1;
  }
  const int c = wid >> 2, wq = wid & 3;
  const bf16* Qw = QR + (rowb + c * 128 + wq * 32 + r32) * 256 + h * 64;
  bf16x8 qr[4]; u32x4 qa[4];
#pragma unroll
  for (int d0 = 0; d0 < 4; ++d0) qr[d0] = *reinterpret_cast<const bf16x8*>(Qw + d0 * 16 + hi * 8);
#pragma unroll
  for (int k = 0; k < 4; ++k) { const u32x2 lo = *(const u32x2*)(Qw + 16 * k + 4 * hi), hi2 = *(const u32x2*)(Qw + 16 * k + 8 + 4 * hi); qa[k] = (u32x4){lo.x, lo.y, hi2.x, hi2.y}; }
  asm volatile("s_waitcnt vmcnt(0) lgkmcnt(0)\n\ts_barrier" ::: "memory");
  const int vb = (int)lds0 + ((lane >> 4) & 1) * 32 + (lane & 3) * 8 + (4 * hi + ((lane & 15) >> 2)) * 64;
  f32x16 o[2]; o[0] = f32x16{}; o[1] = f32x16{};
  pv(o, vb + L_S + c * 8192, __builtin_bit_cast(bf16x8, qa[0]), __builtin_bit_cast(bf16x8, qa[1]), __builtin_bit_cast(bf16x8, qa[2]), __builtin_bit_cast(bf16x8, qa[3]));
  { const float gam = 1.0f - __builtin_amdgcn_exp2f(-5.0f - (float)h);
#pragma unroll
    for (int d0 = 0; d0 < 2; ++d0)
#pragma unroll
      for (int r = 0; r < 16; ++r) o[d0][r] *= gam; }
  const f32x16 zero = f32x16{};
  const int irow = wq * 32 + r32;
  for (int tl = 0; tl <= (wq >> 1); ++tl) {
    f32x16 p0, p1;
    attn_body::qkt(p0, p1, shm + L_K + (c * 2 + tl) * 8192, qr, zero, r32, hi);
    asm volatile("s_nop 15\n\ts_nop 7" : "+v"(p0), "+v"(p1));
#pragma unroll
    for (int r = 0; r < 16; ++r) { const int kj = 64 * tl + crow(r, hi); if (kj > irow) p0[r] = 0.f; if (kj + 32 > irow) p1[r] = 0.f; }
    u32x4 pw0, pw1, pw2, pw3;
    pw0 = (u32x4){cvtpk(p0[0], p0[1]), cvtpk(p0[2], p0[3]), cvtpk(p0[4], p0[5]), cvtpk(p0[6], p0[7])}; pw1 = (u32x4){cvtpk(p0[8], p0[9]), cvtpk(p0[10], p0[11]), cvtpk(p0[12], p0[13]), cvtpk(p0[14], p0[15])};
    pw2 = (u32x4){cvtpk(p1[0], p1[1]), cvtpk(p1[2], p1[3]), cvtpk(p1[4], p1[5]), cvtpk(p1[6], p1[7])}; pw3 = (u32x4){cvtpk(p1[8], p1[9]), cvtpk(p1[10], p1[11]), cvtpk(p1[12], p1[13]), cvtpk(p1[14], p1[15])};
    __builtin_amdgcn_sched_barrier(0);
    pv(o, vb + L_V + (c * 2 + tl) * 8192, __builtin_bit_cast(bf16x8, pw0), __builtin_bit_cast(bf16x8, pw1), __builtin_bit_cast(bf16x8, pw2), __builtin_bit_cast(bf16x8, pw3));
  }
  asm volatile("s_waitcnt lgkmcnt(0)\n\ts_barrier" ::: "memory");
  { float* stg = (float*)(shm + L_O) + wid * 2048;
#pragma unroll
    for (int r = 0; r < 16; ++r) { const int orow = crow(r, hi);
#pragma unroll
      for (int d0 = 0; d0 < 2; ++d0) stg[orow * 64 + d0 * 32 + r32] = o[d0][r]; }
    asm volatile("s_waitcnt lgkmcnt(0)" ::: "memory");
    const int row = lane >> 1, half = lane & 1;
    const f32x4* sr = (const f32x4*)(stg + row * 64 + half * 32);
    f32x4 v[8]; float ss = 0.f;
#pragma unroll
    for (int i = 0; i < 8; ++i) { v[i] = sr[i]; ss += (v[i][0] * v[i][0] + v[i][1] * v[i][1]) + (v[i][2] * v[i][2] + v[i][3] * v[i][3]); }
    ss += __shfl_xor(ss, 1);
    const float rstd = 1.0f / sqrtf(ss * (1.0f / 64.0f) + EPS);
    const size_t grow = rowb + c * 128 + wq * 32 + row;
    const u32x4* gp = (const u32x4*)(GR + grow * 256 + h * 64 + half * 32);
    const f32x4* rg = (const f32x4*)(rgain + h * 64 + half * 32);
    u32x4* yp = (u32x4*)(Y + grow * DM + 512 + h * 64 + half * 32);
#pragma unroll
    for (int i = 0; i < 4; ++i) {
      const u32x4 gw = gp[i]; const f32x4 g0 = rg[2 * i], g1 = rg[2 * i + 1]; const f32x4 a = v[2 * i] * rstd * g0, c4 = v[2 * i + 1] * rstd * g1;
      u32x4 w; w.x = cvtpk(a[0] * bflo(gw.x), a[1] * bfhi(gw.x)); w.y = cvtpk(a[2] * bflo(gw.y), a[3] * bfhi(gw.y)); w.z = cvtpk(c4[0] * bflo(gw.z), c4[1] * bfhi(gw.z)); w.w = cvtpk(c4[2] * bflo(gw.w), c4[3] * bfhi(gw.w));
      yp[i] = w;
    }
  }
  asm volatile("s_waitcnt lgkmcnt(0)\n\ts_barrier" ::: "memory");
}
}

#define XB_TMO      128
#define XB_XCNT(j)  (256  + 64 * (j))
#define XB_XSUB(j)  (1280 + 64 * (j))
#define XB_XGEN(j)  (2304 + 64 * (j))
#define XB_TOP      3328
#define XB_TOPGEN   3392
#define XCD_BAR_WORDS 3456
#define XB_SPIN_CAP (1u << 18)
__device__ __forceinline__ unsigned xb_ld(unsigned* p)              { return __hip_atomic_load(p, __ATOMIC_RELAXED, __HIP_MEMORY_SCOPE_AGENT); }
__device__ __forceinline__ unsigned xb_add(unsigned* p, unsigned v) { return __hip_atomic_fetch_add(p, v, __ATOMIC_RELAXED, __HIP_MEMORY_SCOPE_AGENT); }
__device__ __forceinline__ unsigned xb_xcc_id() { return (unsigned)__builtin_amdgcn_s_getreg((3 << 11) | 20) & 0xFu; }
#define XB_SPIN(cond, bar) do { unsigned _sp = 0; while (cond) { __builtin_amdgcn_s_sleep(1); \
    if ((++_sp & 255u) == 0u) { if (xb_ld(&(bar)[XB_TMO])) break; if (_sp > XB_SPIN_CAP) { atomicAdd(&(bar)[XB_TMO], 1u); break; } } } } while (0)
struct XcdBarrier { unsigned* bar; unsigned x; volatile LAS unsigned* st; };
__device__ __forceinline__ XcdBarrier xcd_barrier_post(unsigned* bar, volatile LAS unsigned* st) {
    XcdBarrier b; b.bar = bar; b.x = xb_xcc_id(); b.st = st;
    if (threadIdx.x == 0) (void)xb_add(&bar[XB_XCNT(b.x)], 1u);
    return b;
}
__device__ __forceinline__ void xcd_barrier_complete(unsigned* bar, unsigned x, unsigned& nloc, unsigned& nx) {
    const unsigned G = gridDim.x * gridDim.y * gridDim.z;
    unsigned sum, cnt, mine, sp = 0u;
    for (;;) {
        sum = 0u; cnt = 0u; mine = 0u;
#pragma unroll
        for (unsigned j = 0; j < 16; ++j) { const unsigned c = xb_ld(&bar[XB_XCNT(j)]); sum += c; cnt += (c > 0u) ? 1u : 0u; mine = (j == x) ? c : mine; }
        if (sum == G) break;
        __builtin_amdgcn_s_sleep(1);
        if ((++sp & 255u) == 0u) { if (xb_ld(&bar[XB_TMO])) break; if (sp > XB_SPIN_CAP) { atomicAdd(&bar[XB_TMO], 1u); break; } }
    }
    nloc = mine > 0u ? mine : 1u; nx = cnt > 0u ? cnt : 1u;
}
__device__ __forceinline__ void xcd_barrier(const XcdBarrier& b) {
    asm volatile("s_waitcnt vmcnt(0)" ::: "memory");
    __syncthreads();
    if (threadIdx.x == 0) {
        unsigned* bar = b.bar;
        __builtin_amdgcn_s_waitcnt(0);
        unsigned nloc = b.st[0], nx = b.st[1];
        if (nloc == 0u) { xcd_barrier_complete(bar, b.x, nloc, nx); b.st[0] = nloc; b.st[1] = nx; }
        const unsigned old = xb_add(&bar[XB_XSUB(b.x)], 1u);
        const unsigned gen = old / nloc;
        if (old + 1u == (gen + 1u) * nloc) {
            __builtin_amdgcn_fence(__ATOMIC_RELEASE, "agent");
            asm volatile("s_waitcnt vmcnt(0)" ::: "memory");
            const unsigned og = xb_add(&bar[XB_TOP], 1u);
            const unsigned tg = og / nx;
            if (og + 1u == (tg + 1u) * nx) xb_add(&bar[XB_TOPGEN], 1u);
            else XB_SPIN(xb_ld(&bar[XB_TOPGEN]) == tg, bar);
            __builtin_amdgcn_fence(__ATOMIC_ACQUIRE, "agent");
            xb_add(&bar[XB_XGEN(b.x)], 1u);
            asm volatile("s_waitcnt vmcnt(0)" ::: "memory");
        } else {
            XB_SPIN(xb_ld(&bar[XB_XGEN(b.x)]) == gen, bar);
            __builtin_amdgcn_fence(__ATOMIC_ACQUIRE, "agent");
            asm volatile("s_waitcnt vmcnt(0)" ::: "memory");
        }
    }
    __syncthreads();
}

__global__ void __launch_bounds__(NTHREADS, 2) fwd_kernel(Args args) {
    extern __shared__ __attribute__((aligned(16))) unsigned char lds_raw[];
    LAS unsigned char* lds = (LAS unsigned char*)lds_raw;
    cg::grid_group grid = cg::this_grid();
    const int tid0 = threadIdx.x, wave = __builtin_amdgcn_readfirstlane(tid0 >> 6);
#define PHASE_LANES const int tid = opaque(tid0), lane = tid & 63; (void)lane; (void)tid
    const int G = gridDim.x, bx = blockIdx.x;
    const int vcu = (G % 8 == 0) ? (bx % 8) * (G / 8) + bx / 8 : bx;
    const int gw = vcu * NWAVES + wave, NGW = G * NWAVES;
    unsigned char* const ws = args.ws;
#define WSP(type, off) ((type*)(ws + (off)))
    if (tid0 < 64) ((LAS unsigned*)(lds + LDS_MISC))[tid0] = 0u;
    __syncthreads();
    unsigned long long tsA_ = 0, tsB_ = 0; (void)tsA_; (void)tsB_;
    TSTAMP(0);
    const XcdBarrier xbar = xcd_barrier_post(WSP(unsigned, WS_BAR), (volatile LAS unsigned*)(lds + LDS_MISC));
#define GRID_BAR() xcd_barrier(xbar)
    REPN(0) {
        PHASE_LANES;
        LAS float* scr = (LAS float*)(lds + wave * 16384);
        const float* x = args.in[0]; const float* mem = args.in[1]; const float* g_attn = args.in[2]; const float* w_in = args.in[3]; const float* g_mem = args.in[7];
        const float* w_mem_kv = args.in[8]; const float* w_out = args.in[11]; const float* g_ffn = args.in[12]; const float* w_router = args.in[13];
        bf16* WIN_T = WSP(bf16, WS_WIN); bf16* WMEM_T = WSP(bf16, WS_WMEM); bf16* WOUT_T = WSP(bf16, WS_WOUT);
        bf16* XN = WSP(bf16, WS_XN); bf16* MEMN = WSP(bf16, WS_MEMN); float* WRG = WSP(float, WS_WRG);
        constexpr int I0 = 16 * 88, I1 = 16 * 16, I2 = 16 * 32, NIT = I0 + I1 + I2;
        for (int it = gw; it < NIT; it += NGW) {
            int r = it;
            if (r < I0) { const int nb = r % 88, kb = r / 88; transpose_item(w_in, NIN, WIN_T, headperm_row(nb * 32), scr, kb * 64, nb * 32, lane); continue; } r -= I0;
            if (r < I1) { const int nb = r % 16, kb = r / 16; transpose_item(w_mem_kv, 512, WMEM_T, headperm_row(nb * 32), scr, kb * 64, nb * 32, lane); continue; } r -= I1;
            { const int nb = r % 32, kb = r / 32; transpose_item(w_out, 1024, WOUT_T, nb * 32, scr, kb * 64, nb * 32, lane); }
        }
        for (int m = gw * 2; m < T + MROWS; m += NGW * 2) {
            if (m < T) rms_row2_to_bf16(x + (size_t)m * DM, g_attn, XN + (size_t)m * DM, lane, WSP(float, WS_IRS) + m);
            else rms_row2_to_bf16(mem + (size_t)(m - T) * DM, g_mem, MEMN + (size_t)(m - T) * DM, lane, nullptr);
        }
        for (int i = bx * NTHREADS + tid; i < DM * NEXP; i += G * NTHREADS) WRG[i] = g_ffn[i >> 5] * w_router[i];
        for (int i = bx * NTHREADS + tid; i < NB * 16 * 8 * 64; i += G * NTHREADS) WSP(float, WS_KMEAN)[i] = 0.f;
    }
    if (args.pad0 == 0x7fffffff) grid.sync();
    GRID_BAR();
    TSTAMP(1);

    REPN(1) {
        EpiProj E{ws, args.in[4], args.in[5], args.in[9], args.in[10]};
        if (G == 256) {
            SchedProj10 S{G, bx, (const char*)(ws + WS_XN), (const char*)(ws + WS_WIN)};
            pg8::gemm_phase<EpiProj, SchedProj10>(lds, S, E);
        } else {
            SchedProj S{G, bx, (const char*)(ws + WS_XN), (const char*)(ws + WS_MEMN), (const char*)(ws + WS_WIN), (const char*)(ws + WS_WMEM)};
            pg8::gemm_phase<EpiProj, SchedProj>(lds, S, E);
        }
    }
    GRID_BAR();
    TSTAMP(2);

#ifndef NAIVE_RET
    REPN(2) {
        if (G == 256) {
            if (bx < 144) {
                SchedProjOne S{bx, (const char*)(ws + WS_XN), (const char*)(ws + WS_MEMN), (const char*)(ws + WS_WIN), (const char*)(ws + WS_WMEM)};
                EpiProj E{ws, args.in[4], args.in[5], args.in[9], args.in[10]};
                pg8::gemm_phase<EpiProj, SchedProjOne>(lds, S, E);
            } else {
                for (int u = bx - 144; u < 512; u += 112) { const int bh = u >> 4, cp = u & 15;
                    ret_body::kv_unit(WSP(bf16, WS_KR), WSP(bf16, WS_VR), WSP(float, WS_RET), bh >> 2, bh & 3, cp, (char*)lds_raw); }
            }
        } else {
            for (int i = 0; i < 2; ++i) { const int u = vcu * 2 + i, bh = u >> 4, cp = u & 15;
                ret_body::kv_unit(WSP(bf16, WS_KR), WSP(bf16, WS_VR), WSP(float, WS_RET), bh >> 2, bh & 3, cp, (char*)lds_raw); }
        }
    }
    GRID_BAR();
    TSTAMP(3);
#endif
    REPN(20) { PHASE_LANES;
#if defined(NAIVE_MOBA) || defined(NAIVE_RET) || defined(NAIVE_MEM)
#error naive mixers are no longer wired in
#endif
    unsigned* qmix = WSP(unsigned, WS_CTL) + 64 + 256 * rep_; unsigned* qconv = WSP(unsigned, WS_CTL) + 128 + 256 * rep_;
    volatile LAS int* qslot = (volatile LAS int*)(lds + LDS_MISC + 64);
    const bool conv_first = (vcu & 3) == 3;
    bool mix_done = false, conv_done = false;
    while (!(mix_done && conv_done)) {
        const int kind = conv_first ? (conv_done ? 0 : 1) : (mix_done ? 1 : 0);
        if (tid == 0) qslot[0] = (int)__hip_atomic_fetch_add(kind ? qconv : qmix, 1u, __ATOMIC_RELAXED, __HIP_MEMORY_SCOPE_AGENT);
        __syncthreads();
        const int u = qslot[0];
        __syncthreads();
        if (kind == 1) {
            if (u >= 1536) { conv_done = true; continue; }
            convert_chunk(u, args.in[15], args.in[17], WSP(unsigned char, WS_W1), WSP(unsigned char, WS_W2), (LAS float*)(lds + wave * 16384), wave, lane);
            __syncthreads();
        } else if (u >= 2048) { mix_done = true; }
        else if (u < 1024) {
            const int nb = 15 - (u >> 6), bh = u & 63, b = bh >> 3, h = bh & 7;
            const size_t row0 = (size_t)b * SEQ + (size_t)nb * 256;
            attn_body::attn_unit<8, 512, 1024, true>(WSP(bf16, WS_QA) + row0 * 512 + h * 64, WSP(bf16, WS_KA) + (size_t)b * SEQ * 512 + h * 64, WSP(bf16, WS_VA) + (size_t)b * SEQ * 512 + h * 64,
                                                     WSP(bf16, WS_Y) + row0 * DM + h * 64, 4 * nb + 4, nb, WSP(float, WS_KMEAN) + ((size_t)b * 16 * 8 + h) * 64, (char*)lds_raw);
        } else if (u < 1536) {
            const int idx = u - 1024, bh = idx >> 4, cp = idx & 15;
            ret_body::out_unit(WSP(bf16, WS_QR), WSP(bf16, WS_KR), WSP(bf16, WS_VR), WSP(bf16, WS_GR), WSP(float, WS_RET), args.in[6], WSP(bf16, WS_Y), bh >> 2, bh & 3, cp, (char*)lds_raw);
        } else {
            const int idx = u - 1536, bh = idx >> 4, qb = idx & 15, b = bh >> 2, h = bh & 3;
            const size_t row0 = (size_t)b * SEQ + (size_t)qb * 256;
            attn_body::attn_unit<8, 256, 1024, false>(WSP(bf16, WS_QM) + row0 * 256 + h * 64, WSP(bf16, WS_MK) + (size_t)b * MEMLEN * 256 + h * 64, WSP(bf16, WS_MV) + (size_t)b * MEMLEN * 256 + h * 64,
                                                      WSP(bf16, WS_Y) + row0 * DM + 768 + h * 64, 4, 0, nullptr, (char*)lds_raw);
        }
    }
    }
    GRID_BAR();
    TSTAMP(4);

    REPN(3) {
        SchedPlain S{G, bx, 128, 4, (const char*)(ws + WS_Y), (const char*)(ws + WS_WOUT)};
        EpiOut E{WSP(bf16, WS_XN), WSP(float, WS_IRS), args.in[2], WSP(bf16, WS_X1B), WSP(float, WS_SSQ)};
#ifndef NO_G2
        pg8::gemm_phase<EpiOut, SchedPlain>(lds, S, E);
#endif
    }
    GRID_BAR();
    TSTAMP(5);

    REPN(4) {
        PHASE_LANES;
        const bf16* x1b = WSP(bf16, WS_X1B); const float* b_router = args.in[14];
        float* WRG = WSP(float, WS_WRG); float* SSQ = WSP(float, WS_SSQ); int* TOPI = WSP(int, WS_TOPI); float* TOPW = WSP(float, WS_TOPW); int* LRANK = WSP(int, WS_LRANK); int* LCOUNT = WSP(int, WS_LCOUNT);
        unsigned char* XN2 = WSP(unsigned char, WS_XN2); const float* g_ffn = args.in[12];
        if (bx == 0 && tid < 64) ((u32x4*)(XN2 + (size_t)T * DM))[tid] = (u32x4){0u, 0u, 0u, 0u};
        LAS float* wl = (LAS float*)(lds);
        LAS float* lg = (LAS float*)(lds + 131072) + wave * (16 * 33);
        LAS int* hist = (LAS int*)(lds + 131072 + 16896);
        { f32x4 w4[16];
#pragma unroll
          for (int q = 0; q < 16; ++q) w4[q] = ((const f32x4*)WRG)[tid + q * NTHREADS];
#pragma unroll
          for (int q = 0; q < 16; ++q) { const int i4 = tid + q * NTHREADS, r = i4 >> 3, e = (i4 & 7) * 4; *(LAS f32x4*)(wl + r * 32 + (e ^ (((r >> 5) & 1) << 4))) = w4[q]; } }
        if (tid < 32) hist[tid] = 0;
        __syncthreads();
        const int tpw = T / (G * NWAVES);
        for (int tb = 0; tb < tpw; tb += 16) {
            const int t0 = (bx * NWAVES + wave) * tpw + tb;
            const int i = lane & 15, kq = lane >> 4;
            f32x4 a0 = {0.f, 0.f, 0.f, 0.f}, a1 = {0.f, 0.f, 0.f, 0.f};
            const bf16* xr = x1b + (size_t)(t0 + i) * DM + 32 * kq;
            const LAS float* wb = wl + (32 * kq) * 32 + (i ^ ((kq & 1) << 4));
            const LAS float* wb1 = wl + (32 * kq) * 32 + ((i ^ ((kq & 1) << 4)) ^ 16);
            float rstd;
            { const f32x4* sp = (const f32x4*)(SSQ + (size_t)(t0 + i) * 16); const f32x4 s0 = sp[0], s1 = sp[1], s2 = sp[2], s3 = sp[3];
              const float ss = ((s0[0] + s0[1]) + (s0[2] + s0[3])) + ((s1[0] + s1[1]) + (s1[2] + s1[3])) + ((s2[0] + s2[1]) + (s2[2] + s2[3])) + ((s3[0] + s3[1]) + (s3[2] + s3[3]));
              rstd = 1.0f / sqrtf(ss * (1.0f / DM) + EPS); }
            unsigned char* xo = XN2 + (size_t)(t0 + i) * DM + 16 * kq;
            const float* gp = g_ffn + 32 * kq;
#pragma unroll 2
            for (int c = 0; c < 8; ++c) {
                float av[32];
#pragma unroll
                for (int j = 0; j < 4; ++j) { const u32x4 xw = *(const u32x4*)(xr + 128 * c + 8 * j);
                    av[8 * j] = bflo(xw.x); av[8 * j + 1] = bfhi(xw.x); av[8 * j + 2] = bflo(xw.y); av[8 * j + 3] = bfhi(xw.y); av[8 * j + 4] = bflo(xw.z); av[8 * j + 5] = bfhi(xw.z); av[8 * j + 6] = bflo(xw.w); av[8 * j + 7] = bfhi(xw.w); }
                { float nv[32];
#pragma unroll
                  for (int j = 0; j < 8; ++j) { const f32x4 g = *(const f32x4*)(gp + 128 * c + 4 * j); nv[4 * j] = av[4 * j] * rstd * g[0]; nv[4 * j + 1] = av[4 * j + 1] * rstd * g[1]; nv[4 * j + 2] = av[4 * j + 2] * rstd * g[2]; nv[4 * j + 3] = av[4 * j + 3] * rstd * g[3]; }
                  u32x4 p0, p1; fp6_pack32(nv, p0, p1);
                  *(u32x4*)(xo + 128 * c) = p0; *(u32x4*)(xo + 128 * c + 64) = p1; }
#pragma unroll
                for (int q = 0; q < 32; ++q) {
                    const float b0 = wb[(128 * c + q) * 32], b1v = wb1[(128 * c + q) * 32];
                    a0 = __builtin_amdgcn_mfma_f32_16x16x4f32(av[q], b0, a0, 0, 0, 0);
                    a1 = __builtin_amdgcn_mfma_f32_16x16x4f32(av[q], b1v, a1, 0, 0, 0);
                }
            }
#pragma unroll
            for (int r = 0; r < 4; ++r) { lg[(4 * kq + r) * 33 + i] = a0[r]; lg[(4 * kq + r) * 33 + 16 + i] = a1[r]; }
            LDS_WAIT(); asm volatile("" ::: "memory");
            if (lane < 16) {
                const int t = t0 + lane;
                float v[32];
#pragma unroll
                for (int e = 0; e < 32; ++e) v[e] = lg[lane * 33 + e] * rstd + b_router[e];
                int bi[4]; float bvv[4];
#pragma unroll
                for (int k = 0; k < 4; ++k) {
                    float best = -3e38f; int be = 0;
#pragma unroll
                    for (int e = 0; e < 32; ++e) { const bool take = v[e] > best; best = take ? v[e] : best; be = take ? e : be; }
                    bi[k] = be; bvv[k] = best;
#pragma unroll
                    for (int e = 0; e < 32; ++e) v[e] = (e == be) ? -3e38f : v[e];
                }
                const float e1 = __expf(bvv[1] - bvv[0]), e2 = __expf(bvv[2] - bvv[0]), e3 = __expf(bvv[3] - bvv[0]);
                const float inv = 1.0f / (1.0f + e1 + e2 + e3);
                const float wv[4] = {inv, e1 * inv, e2 * inv, e3 * inv};
#pragma unroll
                for (int k = 0; k < 4; ++k) {
                    const int rk = atomicAdd((int*)&hist[bi[k]], 1);
                    TOPI[t * 4 + k] = bi[k]; TOPW[t * 4 + k] = wv[k]; LRANK[t * 4 + k] = rk;
                }
            }
            LDS_WAIT(); asm volatile("" ::: "memory");
        }
        __syncthreads();
        if (tid < 32) LCOUNT[bx * 32 + tid] = hist[tid];
    }
    GRID_BAR();
    TSTAMP(6);

    REPN(5) {
        PHASE_LANES;
        int* TOPI = WSP(int, WS_TOPI); float* TOPW = WSP(float, WS_TOPW); int* LRANK = WSP(int, WS_LRANK); int* LCOUNT = WSP(int, WS_LCOUNT);
        int* POS = WSP(int, WS_POS); float* ROWW = WSP(float, WS_ROWW); int* PSTART = WSP(int, WS_PSTART); int* TILEEXP = WSP(int, WS_TILEEXP);
        LAS int* part = (LAS int*)(lds);
        LAS int* base = (LAS int*)(lds + 8192);
        {
            const int e = tid & 31, p = tid >> 5; int c = 0, pre = 0;
            const int wpp = (G + 15) / 16;
            for (int w = p * wpp; w < (p + 1) * wpp && w < G; ++w) { const int v = LCOUNT[w * 32 + e]; c += v; pre += (w < bx) ? v : 0; }
            part[p * 32 + e] = c; part[512 + p * 32 + e] = pre;
        }
        __syncthreads();
        if (tid < 32) { int c = 0, pre = 0; for (int p = 0; p < 16; ++p) { c += part[p * 32 + tid]; pre += part[512 + p * 32 + tid]; } part[1024 + tid] = c; part[1056 + tid] = pre; }
        __syncthreads();
        if (tid == 0) {
            int ps = 0;
            for (int e = 0; e < 32; ++e) {
                const int c = part[1024 + e], nt_ = (c + 255) >> 8;
                base[32 + e] = ps; base[e] = ps + part[1056 + e];
                if (bx == 0) PSTART[e] = ps;
                ps += nt_ * 256;
            }
            base[64] = ps; if (bx == 0) PSTART[32] = ps;
        }
        __syncthreads();
        if (bx == 1) {
            const int ntl = base[64] >> 8;
            for (int tl = tid; tl < ntl; tl += NTHREADS) { int e = 0;
#pragma unroll
                for (int q = 1; q < 32; ++q) e += (base[32 + q] <= tl * 256) ? 1 : 0;
                TILEEXP[tl] = e; }
        }
        int* ROWTOK = WSP(int, WS_ROWTOK);
        if (bx < 32) {
            const int c = part[1024 + bx], r0 = base[32 + bx] + c, r1 = base[32 + bx] + (((c + 255) >> 8) << 8);
            for (int r = r0 + tid; r < r1; r += NTHREADS) { ROWTOK[r] = T; ROWW[r] = 0.f; }
        }
        for (int a = tid; a < (T / G) * 4; a += NTHREADS) {
            const int ta = (bx * (T / G)) * 4 + a;
            const int e = TOPI[ta]; const int pos = base[e] + LRANK[ta];
            POS[ta] = pos; ROWTOK[pos] = ta >> 2; ROWW[pos] = TOPW[ta];
        }
    }
    GRID_BAR();
    TSTAMP(7);

    const int ntiles = WSP(int, WS_PSTART)[32] >> 8;
    REPN(6) {
        SchedMoe S{G, vcu, 8, ntiles, WSP(int, WS_TILEEXP), (const char*)(ws + WS_XN2), (const char*)(ws + WS_W1), (size_t)2048 * 1024, WSP(int, WS_ROWTOK)};
        EpiSwiglu E{args.in[16], WSP(unsigned char, WS_H)};
#ifndef NO_G3
        pg8::gemm_phase<EpiSwiglu, SchedMoe, true, true, true>(lds, S, E);
#endif
    }
    GRID_BAR();
    TSTAMP(8);
    REPN(7) {
        SchedMoe S{G, vcu, 4, ntiles, WSP(int, WS_TILEEXP), (const char*)(ws + WS_H), (const char*)(ws + WS_W2), (size_t)1024 * 1024, nullptr};
        EpiDown E{args.in[18], WSP(float, WS_ROWW), WSP(unsigned char, WS_XG)};
#ifndef NO_G4
        pg8::gemm_phase<EpiDown, SchedMoe, false, true>(lds, S, E);
#endif
    }
    GRID_BAR();
    TSTAMP(9);
    if (REP_PHASE == 9) { GRID_BAR(); GRID_BAR(); GRID_BAR(); GRID_BAR(); }
    REPN(8) { PHASE_LANES;
    for (int t = gw; t < T; t += NGW) {
        float* out = args.out; const int* POS = WSP(int, WS_POS); const unsigned char* YE = WSP(unsigned char, WS_XG); const bf16* x1b = WSP(bf16, WS_X1B);
        float* dst = (REP_PHASE == 8 && rep_ == 0) ? WSP(float, WS_H) + 64 * 1024 * 1024 : out;
        const u32x2* xrow = (const u32x2*)(x1b + (size_t)t * DM) + lane; f32x4* drow = (f32x4*)(dst + (size_t)t * DM) + lane;
        u32x2 xv[4]; f32x4 s[4];
#pragma unroll
        for (int j = 0; j < 4; ++j) { xv[j] = __builtin_nontemporal_load(xrow + 64 * j); s[j] = (f32x4){0.f, 0.f, 0.f, 0.f}; }
        unsigned yw[4][4];
#pragma unroll
        for (int k = 0; k < 4; ++k) {
            const int pos = POS[t * 4 + k]; const unsigned* yr = (const unsigned*)(YE + (size_t)pos * 1024) + lane;
#pragma unroll
            for (int j = 0; j < 4; ++j) yw[k][j] = __builtin_nontemporal_load(yr + 64 * j);
        }
#pragma unroll
        for (int k = 0; k < 4; ++k)
#pragma unroll
            for (int j = 0; j < 4; ++j) {
                const f32x2 lo = __builtin_amdgcn_cvt_pk_f32_fp8((int)yw[k][j], false), hi = __builtin_amdgcn_cvt_pk_f32_fp8((int)yw[k][j], true);
                s[j].x += lo.x; s[j].y += lo.y; s[j].z += hi.x; s[j].w += hi.y;
            }
#pragma unroll
        for (int j = 0; j < 4; ++j) __builtin_nontemporal_store((f32x4){bflo(xv[j].x), bfhi(xv[j].x), bflo(xv[j].y), bfhi(xv[j].y)} + s[j] * 0.0625f, drow + 64 * j);
    }
    }
    TSTAMP(10);
    if (REP_PHASE >= 100 && bx == 0 && tid0 == 0) {
        const unsigned long long t0_ = __builtin_amdgcn_s_memrealtime(), want = 9ull * (tsB_ - tsA_);
        while (__builtin_amdgcn_s_memrealtime() - t0_ < want) __builtin_amdgcn_s_sleep(32);
    }
}

extern "C" void kernel_launch(void* const* d_in, const int* in_sizes, int n_in, void* d_out, int out_size, void* d_ws, size_t ws_size, hipStream_t stream) {
    static int grid = 0;
    if (grid == 0) {
        if (n_in != 19 || out_size != T * DM || ws_size < WS_END) { fprintf(stderr, "kernel_launch: unexpected shapes (n_in %d out %d ws %zu)\n", n_in, out_size, ws_size); grid = -1; return; }
        int dev = 0, cus = 0, per_cu = 0;
        hipGetDevice(&dev); hipDeviceGetAttribute(&cus, hipDeviceAttributeMultiprocessorCount, dev);
        hipFuncSetAttribute((const void*)fwd_kernel, hipFuncAttributeMaxDynamicSharedMemorySize, LDS_BYTES);
        hipOccupancyMaxActiveBlocksPerMultiprocessor(&per_cu, (const void*)fwd_kernel, NTHREADS, LDS_BYTES);
        if (per_cu < 1) { fprintf(stderr, "kernel_launch: occupancy query says %d blocks per CU\n", per_cu); per_cu = 1; }
        (void)hipGetLastError();
        grid = cus * 1;
        if (grid % 8 != 0 || T % (grid * NWAVES * 16) != 0) { fprintf(stderr, "kernel_launch: grid %d unsupported\n", grid); grid = -1; return; }
    }
    if (grid < 0) return;
    hipMemsetAsync((char*)d_ws + WS_CTL, 0, CTL_ZERO_BYTES, stream);
    Args a{};
    for (int i = 0; i < 19; ++i) a.in[i] = (const float*)d_in[i];
    a.out = (float*)d_out; a.ws = (unsigned char*)d_ws;
    void* kargs[] = {&a};
    hipError_t e = hipLaunchCooperativeKernel((const void*)fwd_kernel, dim3(grid), dim3(NTHREADS), kargs, LDS_BYTES, stream);
    if (e != hipSuccess) fprintf(stderr, "cooperative launch failed: %s (grid %d)\n", hipGetErrorString(e), grid);
}
```

```cpp
#include <hip/hip_runtime.h>
#include <hip/hip_cooperative_groups.h>
#include <cstdio>
#include <cstdint>
namespace cg = cooperative_groups;

#define GAS __attribute__((address_space(1)))
#define LAS __attribute__((address_space(3)))
typedef unsigned short bf16;
typedef short bf16x8 __attribute__((ext_vector_type(8)));
typedef float f32x4 __attribute__((ext_vector_type(4)));
typedef float f32x2 __attribute__((ext_vector_type(2)));
typedef unsigned u32x4 __attribute__((ext_vector_type(4)));
typedef unsigned u32x2 __attribute__((ext_vector_type(2)));
typedef __bf16 bf16x2_t __attribute__((ext_vector_type(2)));

constexpr int NB = 8, SEQ = 4096, DM = 1024, T = NB * SEQ;
constexpr int NIN = 2816, NEXP = 32, TOPK = 4;
constexpr int MEMLEN = 256, MROWS = NB * MEMLEN;
constexpr float EPS = 1e-6f;
constexpr float C2 = 0.125f * 1.4426950408889634f;
constexpr int MAXTILES = 544, PROWS = MAXTILES * 256;
constexpr int NWAVES = 8, NTHREADS = 512;
#ifndef REP_PHASE
#define REP_PHASE -1
#endif
#define TSTAMP(i) do { if (REP_PHASE == 100 + (i)) tsA_ = __builtin_amdgcn_s_memrealtime(); if (REP_PHASE == 99 + (i)) tsB_ = __builtin_amdgcn_s_memrealtime(); } while (0)
#define REPN(k) for (int rep_ = 0; rep_ < ((REP_PHASE == (k)) ? 2 : 1); ++rep_)
constexpr int LDS_MISC = 150016;
constexpr int LDS_BYTES = 150016 + 256;

constexpr size_t MiB = 1u << 20;
constexpr size_t WS_CTL = 0, CTL_ZERO_BYTES = 131072;
constexpr size_t WS_BAR = 65536;
constexpr size_t WS_KMEAN = 1 * MiB;
constexpr size_t WS_WRG = 2 * MiB;
constexpr size_t WS_SSQ = 3 * MiB;
constexpr size_t WS_TOPI = 5 * MiB, WS_TOPW = 5 * MiB + 512 * 1024, WS_LRANK = 6 * MiB, WS_POS = 6 * MiB + 512 * 1024;
constexpr size_t WS_ROWW = 7 * MiB;
constexpr size_t WS_LCOUNT = 8 * MiB, WS_PSTART = 8 * MiB + 65536, WS_TILEEXP = 8 * MiB + 131072;
constexpr size_t WS_WIN = 16 * MiB, WS_WMEM = 22 * MiB, WS_WOUT = 24 * MiB, WS_W1 = 32 * MiB, WS_W2 = 160 * MiB;
constexpr size_t WS_XN = 224 * MiB, WS_MEMN = 288 * MiB;
constexpr size_t WS_QA = 292 * MiB, WS_KA = 324 * MiB, WS_VA = 356 * MiB;
constexpr size_t WS_QR = 388 * MiB, WS_KR = 404 * MiB, WS_VR = 420 * MiB, WS_GR = 436 * MiB, WS_QM = 452 * MiB;
constexpr size_t WS_MK = 468 * MiB, WS_MV = 469 * MiB;
constexpr size_t WS_Y = 470 * MiB, WS_RET = 534 * MiB;
constexpr size_t WS_XG = 224 * MiB;
constexpr size_t WS_XN2 = 496 * MiB;
constexpr size_t WS_X1B = 388 * MiB;
constexpr size_t WS_IRS = 10 * MiB;
constexpr size_t WS_ROWTOK = 9 * MiB;
constexpr size_t WS_H = 566 * MiB;
constexpr size_t WS_END = 838 * MiB;

struct Args {
    const float* in[19]; float* out; unsigned char* ws; int pad0, pad1;
};

__device__ __forceinline__ unsigned cvtpk(float lo, float hi) { f32x2 v = {lo, hi}; bf16x2_t b = __builtin_convertvector(v, bf16x2_t); return __builtin_bit_cast(unsigned, b); }
__device__ __forceinline__ float bf2f(unsigned short b) { return __uint_as_float(((unsigned)b) << 16); }
__device__ __forceinline__ float bflo(unsigned w) { return __uint_as_float(w << 16); }
__device__ __forceinline__ float bfhi(unsigned w) { return __uint_as_float(w & 0xffff0000u); }
__device__ __forceinline__ float wave_sum(float v) {
#pragma unroll
    for (int o = 1; o < 64; o <<= 1) v += __shfl_xor(v, o);
    return v;
}
#define LDS_WAIT() asm volatile("s_waitcnt lgkmcnt(0)" ::: "memory")
typedef unsigned v6u_t __attribute__((ext_vector_type(6)));
typedef float v16f_t __attribute__((ext_vector_type(16)));
#ifndef FP6_SCALE_DIV
#define FP6_SCALE_DIV 1
#endif
__device__ __forceinline__ void fp6_pack32(const float (&v)[32], u32x4& p0, u32x4& p1) {
    float mx = 1e-30f;
#pragma unroll
    for (int i = 0; i < 32; ++i) mx = fmaxf(mx, fabsf(v[i]));
    const unsigned bits = __float_as_uint(mx * (1.0f / 7.5f));
    int e = (int)((bits + 0x7FFFFFu) >> 23) - 127;
    e = e < -126 ? -126 : (e > 126 ? 126 : e);
    const float sc = __uint_as_float((unsigned)((FP6_SCALE_DIV ? e : -e) + 127) << 23);
    v16f_t lo, hi;
#pragma unroll
    for (int i = 0; i < 16; ++i) { lo[i] = v[i]; hi[i] = v[16 + i]; }
    const v6u_t w = __builtin_amdgcn_cvt_scalef32_2xpk16_fp6_f32(lo, hi, sc);
    p0 = (u32x4){w[0], w[1], w[2], w[3]}; p1 = (u32x4){w[4], w[5], (unsigned)(e + 127), 0u};
}
__device__ __forceinline__ int opaque(int v) { asm volatile("" : "+v"(v)); return v; }

namespace pg8 {
constexpr int BM = 256, BK = 64, HALF = 128, HTB = HALF * BK * 2, STAGE_BYTES = 8 * HTB, NXCD = 8, WGM = 8, K = 1024;
__host__ __device__ __forceinline__ int lds_byte(int r, int c) { const int st = (r >> 4) * 2 + (c >> 5), rr = r & 15, cc = c & 31, ob = rr * 64 + cc * 2; return st * 1024 + (ob ^ (((ob >> 9) & 1) << 5)); }
__host__ __device__ __forceinline__ void stage_rc(int b, int& R, int& C) { const int st = b / 1024, sb = b % 1024, swz = sb ^ (((sb >> 9) & 1) << 5); R = (st >> 1) * 16 + swz / 64; C = (st & 1) * 32 + (swz % 64) / 2; }
__host__ __device__ __forceinline__ int perm32(int rho) { const int n = rho >> 4, i = rho & 15; return 8 * (i >> 2) + 4 * n + (i & 3); }
struct Unit { int pm, pn, aux; };

__device__ __forceinline__ bool static_order(int L, int nM, int nN, int& pm, int& pn) {
    const int nwg = nM * nN; if (L >= nwg) return false;
    int wgid = L; { const int q = nwg / NXCD, r = nwg % NXCD, xcd = wgid % NXCD, off = wgid / NXCD; wgid = (xcd < r ? xcd * (q + 1) : r * (q + 1) + (xcd - r) * q) + off; }
    const int nig = WGM * nN, gid = wgid / nig, fm = gid * WGM, gsz = (nM - fm) < WGM ? (nM - fm) : WGM;
    pm = fm + ((wgid % nig) % gsz); pn = (wgid % nig) / gsz; return true;
}

typedef int v8i_t __attribute__((ext_vector_type(8)));
typedef int v4i_t __attribute__((ext_vector_type(4)));
__device__ __forceinline__ v8i_t cat8(bf16x8 lo, bf16x8 hi) { const v4i_t a = __builtin_bit_cast(v4i_t, lo), b = __builtin_bit_cast(v4i_t, hi); return __builtin_shufflevector(a, b, 0, 1, 2, 3, 4, 5, 6, 7); }
typedef int v6i_t __attribute__((ext_vector_type(6)));
__device__ __forceinline__ v6i_t cat6(bf16x8 lo, bf16x8 hi) { const v4i_t a = __builtin_bit_cast(v4i_t, lo), b = __builtin_bit_cast(v4i_t, hi); return __builtin_shufflevector(a, b, 0, 1, 2, 3, 4, 5); }
__device__ __forceinline__ int scl6(bf16x8 hi) { return __builtin_bit_cast(v4i_t, hi)[2]; }
constexpr int PRE_LDS = 133120;
template <class T, class = void> struct pre_kib { static constexpr int value = 0; };
template <class T> struct pre_kib<T, decltype((void)T::PRE_KIB)> { static constexpr int value = T::PRE_KIB; };
template <class Epi, class Sched, bool GATHER = false, bool FP8 = false, bool FP6 = false>
__device__ __forceinline__ void gemm_phase(LAS unsigned char* lds, const Sched& S, const Epi& E) {
    constexpr int PRE = pre_kib<Epi>::value;
#define PG8_PRE(unit, par) do { if constexpr (PRE > 0) { if (wid == 0) { _Pragma("unroll") for (int _k = 0; _k < PRE; ++_k) \
        __builtin_amdgcn_global_load_lds((const unsigned*)E.pre_src(unit, _k, lane), (LAS unsigned*)(lds + PRE_LDS + (par) * 2048 + _k * 1024), 16, 0, 0); } } } while (0)
    constexpr int PITCH = FP8 ? 1024 : 2048;
    const int tid = opaque((int)threadIdx.x), wid = __builtin_amdgcn_readfirstlane(tid >> 6), lane = tid & 63, wr = wid >> 2, wc = wid & 3, fr = lane & 15, fq = lane >> 4;
    constexpr int nt = PITCH / 128;
    unsigned voffA[2], voffB[2];
#pragma unroll
    for (int i = 0; i < 2; ++i) { int R, C; stage_rc(tid * 16 + i * 8192, R, C); const int Rb = (R & ~31) + perm32(R & 31);
        voffA[i] = (unsigned)(R * PITCH + C * 2); voffB[i] = (unsigned)(Rb * PITCH + C * 2); }
    const size_t kstep = (size_t)(BK * 2);
    const size_t hstep = (size_t)HALF * PITCH;
    const unsigned ldsw = (unsigned)wid * 1024u;
    const int aoff = lds_byte(wr * 64 + fr, fq * 8), boff = lds_byte(wc * 32 + fr, fq * 8);
#define PG8_SA(b, h) (((b) * 2 + (h)) * HTB)
#define PG8_SB(b, h) ((4 + (b) * 2 + (h)) * HTB)
#define PG8_STAGE(bufoff, gbase, voff) do { _Pragma("unroll") for (int _i = 0; _i < 2; ++_i) \
        __builtin_amdgcn_global_load_lds((const unsigned*)((const char*)(gbase) + (voff)[_i]), (LAS unsigned*)(lds + (bufoff) + ldsw + _i * 8192), 16, 0, 0); } while (0)
#define PG8_LDA(dst, b, h) do { _Pragma("unroll") for (int m = 0; m < 4; ++m) _Pragma("unroll") for (int k = 0; k < 2; ++k) dst[m][k] = *(const LAS bf16x8*)(lds + PG8_SA(b, h) + aoff + m * 2048 + k * 1024); } while (0)
#define PG8_LDB(dst, b, h) do { _Pragma("unroll") for (int n = 0; n < 2; ++n) _Pragma("unroll") for (int k = 0; k < 2; ++k) dst[n][k] = *(const LAS bf16x8*)(lds + PG8_SB(b, h) + boff + n * 2048 + k * 1024); } while (0)
#define PG8_MMA(ai, bj, At, Bt) do { __builtin_amdgcn_s_setprio(1); \
        if constexpr (FP6) { _Pragma("unroll") for (int m = 0; m < 4; ++m) _Pragma("unroll") for (int n = 0; n < 2; ++n) \
            asm volatile("s_nop 1\n\tv_mfma_scale_f32_16x16x128_f8f6f4 %0, %1, %2, %0, %3, %4 op_sel_hi:[0,0,0] cbsz:2 blgp:2" : "+v"(acc[ai][bj][m][n]) : "v"(cat6(Bt[n][0], Bt[n][1])), "v"(cat6(At[m][0], At[m][1])), "v"(scl6(Bt[n][1])), "v"(scl6(At[m][1]))); } \
        else if constexpr (FP8) { _Pragma("unroll") for (int m = 0; m < 4; ++m) _Pragma("unroll") for (int n = 0; n < 2; ++n) \
            asm volatile("v_mfma_scale_f32_16x16x128_f8f6f4 %0, %1, %2, %0, %3, %3 op_sel_hi:[0,0,0]" : "+v"(acc[ai][bj][m][n]) : "v"(cat8(Bt[n][0], Bt[n][1])), "v"(cat8(At[m][0], At[m][1])), "v"(0x7f7f7f7f)); } \
        else { _Pragma("unroll") for (int m = 0; m < 4; ++m) _Pragma("unroll") for (int n = 0; n < 2; ++n) _Pragma("unroll") for (int k = 0; k < 2; ++k) \
            acc[ai][bj][m][n] = __builtin_amdgcn_mfma_f32_16x16x32_bf16(Bt[n][k], At[m][k], acc[ai][bj][m][n], 0, 0, 0); } \
        __builtin_amdgcn_s_setprio(0); } while (0)
#define PG8_WAIT_V(n) asm volatile("s_waitcnt vmcnt(" #n ")" ::: "memory")
#define PG8_WAIT_L(n) asm volatile("s_waitcnt lgkmcnt(" #n ")" ::: "memory")
#define PG8_BAR __builtin_amdgcn_s_barrier()
#define PG8_SCHED __builtin_amdgcn_sched_barrier(0)
    Unit cur, nxt; int ui = 0;
    if (!S.next(0, cur)) return;
    PG8_PRE(cur, 0);
    unsigned vGc[2][2], vGn[2][2]; int gR[2], gC[2];
    const char* gA = nullptr;
    if constexpr (GATHER) {
        gA = S.abase();
#pragma unroll
        for (int i = 0; i < 2; ++i) { stage_rc(tid * 16 + i * 8192, gR[i], gC[i]); }
        if (wid == 0) __builtin_amdgcn_global_load_lds((const unsigned*)(S.tokptr(cur) + lane * 16), (LAS unsigned*)(lds + 131072), 16, 0, 0);
        asm volatile("s_waitcnt vmcnt(0)" ::: "memory"); __builtin_amdgcn_s_barrier(); asm volatile("" ::: "memory");
#pragma unroll
        for (int h = 0; h < 2; ++h)
#pragma unroll
            for (int i = 0; i < 2; ++i) { const int tok = ((const LAS int*)(lds + 131072))[h * 128 + gR[i]]; vGc[h][i] = (unsigned)tok * (unsigned)PITCH + (unsigned)gC[i] * 2u; vGn[h][i] = vGc[h][i]; }
    }
    f32x4 acc[2][2][4][2];
#pragma unroll
    for (int a = 0; a < 2; ++a)
#pragma unroll
        for (int b = 0; b < 2; ++b)
#pragma unroll
            for (int m = 0; m < 4; ++m)
#pragma unroll
                for (int n = 0; n < 2; ++n) acc[a][b][m][n] = (f32x4){0.f, 0.f, 0.f, 0.f};
    bf16x8 At[4][2], B0[2][2], B1[2][2];
    const char* cA = GATHER ? gA : S.aptr(cur); const char* cB = S.bptr(cur);
    const size_t ahstep = GATHER ? (size_t)0 : hstep;
    {
        PG8_STAGE(PG8_SB(0, 0), cB, voffB); PG8_STAGE(PG8_SB(0, 1), cB + hstep, voffB);
        if constexpr (GATHER) { PG8_STAGE(PG8_SA(0, 0), cA, vGc[0]); PG8_STAGE(PG8_SA(0, 1), cA, vGc[1]); } else { PG8_STAGE(PG8_SA(0, 0), cA, voffA); PG8_STAGE(PG8_SA(0, 1), cA + hstep, voffA); }
        if (wr == 1) PG8_BAR;
        PG8_WAIT_V(2); PG8_BAR;
        PG8_STAGE(PG8_SB(1, 0), cB + kstep, voffB);
        if constexpr (GATHER) { PG8_STAGE(PG8_SA(1, 0), cA + kstep, vGc[0]); } else { PG8_STAGE(PG8_SA(1, 0), cA + kstep, voffA); }
        PG8_STAGE(PG8_SB(1, 1), cB + hstep + kstep, voffB);
        PG8_WAIT_V(6); PG8_BAR;
    }
    for (;;) {
        const bool has_next = S.next(ui + 1, nxt);
        const char* nA = GATHER ? gA : (has_next ? S.aptr(nxt) : cA); const char* nB = has_next ? S.bptr(nxt) : cB;
        if constexpr (GATHER) { if (has_next && wid == 0) __builtin_amdgcn_global_load_lds((const unsigned*)(S.tokptr(nxt) + lane * 16), (LAS unsigned*)(lds + 131072 + ((ui + 1) & 1) * 1024), 16, 0, 0); }
#pragma nounroll
        for (int t = 0; t < nt; t += 2) {
            const bool last = (t == nt - 2);
            const char* a1 = cA + (size_t)(t + 1) * kstep;
            const char* a2 = last ? nA : cA + (size_t)(t + 2) * kstep; const char* b2 = last ? nB : cB + (size_t)(t + 2) * kstep;
            const char* a3 = a2 + kstep; const char* b3 = b2 + kstep;
            unsigned v2h0[2], v2h1[2];
            if constexpr (GATHER) {
                if (last && has_next) {
                    const LAS int* tk = (const LAS int*)(lds + 131072 + ((ui + 1) & 1) * 1024);
#pragma unroll
                    for (int h = 0; h < 2; ++h)
#pragma unroll
                        for (int i = 0; i < 2; ++i) vGn[h][i] = (unsigned)tk[h * 128 + gR[i]] * (unsigned)PITCH + (unsigned)gC[i] * 2u;
                }
#pragma unroll
                for (int i = 0; i < 2; ++i) { v2h0[i] = last ? vGn[0][i] : vGc[0][i]; v2h1[i] = last ? vGn[1][i] : vGc[1][i]; }
            } else {
#pragma unroll
                for (int i = 0; i < 2; ++i) { v2h0[i] = voffA[i]; v2h1[i] = voffA[i]; }
            }
            PG8_LDB(B0, 0, 0); PG8_LDB(B1, 0, 1); PG8_SCHED; PG8_LDA(At, 0, 0);
            if constexpr (GATHER) { PG8_STAGE(PG8_SA(1, 1), a1, vGc[1]); } else { PG8_STAGE(PG8_SA(1, 1), a1 + hstep, voffA); }
            PG8_WAIT_V(8); PG8_WAIT_L(0); PG8_BAR; PG8_MMA(0, 0, At, B0); PG8_MMA(0, 1, At, B1); PG8_BAR; PG8_SCHED;
            PG8_LDA(At, 0, 1); PG8_STAGE(PG8_SB(0, 0), b2, voffB); PG8_STAGE(PG8_SB(0, 1), b2 + hstep, voffB); PG8_STAGE(PG8_SA(0, 0), a2, v2h0);
            PG8_WAIT_V(8); PG8_WAIT_L(0); PG8_BAR; PG8_MMA(1, 0, At, B0); PG8_MMA(1, 1, At, B1); PG8_BAR; PG8_SCHED;
            PG8_LDB(B0, 1, 0); PG8_LDB(B1, 1, 1); PG8_SCHED; PG8_LDA(At, 1, 0); PG8_STAGE(PG8_SA(0, 1), a2 + ahstep, v2h1);
            PG8_WAIT_V(8); PG8_WAIT_L(0); PG8_BAR; PG8_MMA(0, 0, At, B0); PG8_MMA(0, 1, At, B1); PG8_BAR; PG8_SCHED;
            PG8_LDA(At, 1, 1); PG8_STAGE(PG8_SB(1, 0), b3, voffB); PG8_STAGE(PG8_SB(1, 1), b3 + hstep, voffB); PG8_STAGE(PG8_SA(1, 0), a3, v2h0);
            PG8_WAIT_V(8); PG8_WAIT_L(0); PG8_BAR; PG8_MMA(1, 0, At, B0); PG8_MMA(1, 1, At, B1); PG8_BAR; PG8_SCHED;
        }
        if (wr == 0) PG8_BAR;
        if constexpr (FP8) asm volatile("s_nop 15\n\ts_nop 7" ::: "memory");
        if constexpr (PRE > 0) E(acc, cur, wr, wc, fr, fq, (const LAS float*)(lds + PRE_LDS + (ui & 1) * 2048)); else E(acc, cur, wr, wc, fr, fq);
        if (!has_next) break;
#pragma unroll
        for (int a = 0; a < 2; ++a)
#pragma unroll
            for (int b = 0; b < 2; ++b)
#pragma unroll
                for (int m = 0; m < 4; ++m)
#pragma unroll
                    for (int n = 0; n < 2; ++n) acc[a][b][m][n] = (f32x4){0.f, 0.f, 0.f, 0.f};
        cur = nxt; cA = nA; cB = nB; ++ui;
        PG8_PRE(cur, ui & 1);
        if constexpr (GATHER) {
#pragma unroll
            for (int h = 0; h < 2; ++h)
#pragma unroll
                for (int i = 0; i < 2; ++i) vGc[h][i] = vGn[h][i];
        }
        if (wr == 1) PG8_BAR;
    }
    PG8_WAIT_V(0);
    PG8_BAR;
#undef PG8_PRE
#undef PG8_SA
#undef PG8_SB
#undef PG8_STAGE
#undef PG8_LDA
#undef PG8_LDB
#undef PG8_MMA
#undef PG8_WAIT_V
#undef PG8_WAIT_L
#undef PG8_BAR
#undef PG8_SCHED
}
}
using pg8::Unit;

struct SchedProj {
    int G, c; const char *XN, *MEMN, *WIN, *WMEM;
    __device__ __forceinline__ bool next(int i, Unit& u) const {
        const int L = i * G + c;
        if (L < 1408) { u.aux = 0; return pg8::static_order(L, 128, 11, u.pm, u.pn); }
        if (L < 1424) { const int j = L - 1408; u.pm = j >> 1; u.pn = j & 1; u.aux = 1; return true; }
        return false;
    }
    __device__ __forceinline__ const char* aptr(const Unit& u) const { return (u.aux ? MEMN : XN) + (size_t)u.pm * (256 * 2048); }
    __device__ __forceinline__ const char* bptr(const Unit& u) const { return (u.aux ? WMEM : WIN) + (size_t)u.pn * (256 * 2048); }
};
struct SchedProj10 {
    int G, c; const char *XN, *WIN;
    __device__ __forceinline__ bool next(int i, Unit& u) const { int j; u.aux = 0; if (!pg8::static_order(i * G + c, 128, 10, u.pm, j)) return false; u.pn = j < 9 ? j : 10; return true; }
    __device__ __forceinline__ const char* aptr(const Unit& u) const { return XN + (size_t)u.pm * (256 * 2048); }
    __device__ __forceinline__ const char* bptr(const Unit& u) const { return WIN + (size_t)u.pn * (256 * 2048); }
};
struct SchedProjOne {
    int c; const char *XN, *MEMN, *WIN, *WMEM;
    __device__ __forceinline__ bool next(int i, Unit& u) const {
        if (i != 0 || c >= 144) return false;
        if (c < 128) { u.pm = c; u.pn = 9; u.aux = 0; } else { const int j = c - 128; u.pm = j >> 1; u.pn = j & 1; u.aux = 1; }
        return true;
    }
    __device__ __forceinline__ const char* aptr(const Unit& u) const { return (u.aux ? MEMN : XN) + (size_t)u.pm * (256 * 2048); }
    __device__ __forceinline__ const char* bptr(const Unit& u) const { return (u.aux ? WMEM : WIN) + (size_t)u.pn * (256 * 2048); }
};
struct SchedPlain {
    int G, c, nM, nN; const char *A, *B;
    __device__ __forceinline__ bool next(int i, Unit& u) const { u.aux = 0; return pg8::static_order(i * G + c, nM, nN, u.pm, u.pn); }
    __device__ __forceinline__ const char* aptr(const Unit& u) const { return A + (size_t)u.pm * (256 * 2048); }
    __device__ __forceinline__ const char* bptr(const Unit& u) const { return B + (size_t)u.pn * (256 * 2048); }
};
struct SchedMoe {
    int G, vcu, npn, ntiles; const int* tile_exp; const char *A, *B; size_t bexp;
    __device__ __forceinline__ bool next(int i, Unit& u) const {
        const int L = i * G + vcu, tile = L / npn; if (tile >= ntiles) return false;
        u.pm = tile; u.pn = L - tile * npn; u.aux = __builtin_amdgcn_readfirstlane(tile_exp[tile]); return true;
    }
    __device__ __forceinline__ const char* aptr(const Unit& u) const { return A + (size_t)u.pm * (256 * 1024); }
    __device__ __forceinline__ const char* bptr(const Unit& u) const { return B + (size_t)u.aux * bexp + (size_t)u.pn * (256 * 1024); }
    const int* rowtok;
    __device__ __forceinline__ const char* abase() const { return A; }
    __device__ __forceinline__ const char* tokptr(const Unit& u) const { return (const char*)(rowtok + (size_t)u.pm * 256); }
};

struct EpiProj {
    unsigned char* ws;
    const float *gq, *gk, *gmq, *gmk;
    __device__ __forceinline__ void operator()(const f32x4 (&acc)[2][2][4][2], const Unit& u, int wr, int wc, int fr, int fq) const {
        int mode = 0; bf16* out; int ld = 256, coff = 0; const float* gain = nullptr; float scale = 1.f; bool kmean = false;
        if (u.aux == 0) {
            switch (u.pn) {
                case 0: case 1: out = (bf16*)(ws + WS_QA); ld = 512; coff = u.pn * 256; mode = 1; gain = gq; scale = C2; break;
                case 2: case 3: out = (bf16*)(ws + WS_KA); ld = 512; coff = (u.pn - 2) * 256; mode = 1; gain = gk; kmean = true; break;
                case 4: case 5: out = (bf16*)(ws + WS_VA); ld = 512; coff = (u.pn - 4) * 256; break;
                case 6: out = (bf16*)(ws + WS_QR); mode = 2; break;
                case 7: out = (bf16*)(ws + WS_KR); mode = 2; scale = 0.125f; break;
                case 8: out = (bf16*)(ws + WS_VR); break;
                case 9: out = (bf16*)(ws + WS_GR); mode = 3; break;
                default: out = (bf16*)(ws + WS_QM); mode = 1; gain = gmq; scale = C2; break;
            }
        } else {
            if (u.pn == 0) { out = (bf16*)(ws + WS_MK); mode = 1; gain = gmk; } else { out = (bf16*)(ws + WS_MV); }
        }
        const int row0 = u.pm * 256 + wr * 64 + fr;
        const int colb = coff + wc * 64 + 8 * fq;
        if (gain == nullptr) gain = gq;
        f32x4 gv[2][2];
#pragma unroll
        for (int bj = 0; bj < 2; ++bj)
#pragma unroll
            for (int n = 0; n < 2; ++n) gv[bj][n] = *(const f32x4*)(gain + bj * 32 + 8 * fq + 4 * n);
        f32x4 ks[2][2];
#pragma unroll
        for (int bj = 0; bj < 2; ++bj)
#pragma unroll
            for (int n = 0; n < 2; ++n) ks[bj][n] = (f32x4){0.f, 0.f, 0.f, 0.f};
#pragma unroll
        for (int ai = 0; ai < 2; ++ai)
#pragma unroll
            for (int m = 0; m < 4; ++m) {
                const int row = row0 + ai * 128 + m * 16;
                f32x4 v[2][2];
#pragma unroll
                for (int bj = 0; bj < 2; ++bj)
#pragma unroll
                    for (int n = 0; n < 2; ++n) v[bj][n] = acc[ai][bj][m][n];
                if (mode == 1) {
                    float ss = 0.f;
#pragma unroll
                    for (int bj = 0; bj < 2; ++bj)
#pragma unroll
                        for (int n = 0; n < 2; ++n) { const f32x4 x = v[bj][n]; ss += (x[0] * x[0] + x[1] * x[1]) + (x[2] * x[2] + x[3] * x[3]); }
                    ss += __shfl_xor(ss, 16); ss += __shfl_xor(ss, 32);
                    const float r = scale / sqrtf(ss * (1.0f / 64.0f) + EPS);
#pragma unroll
                    for (int bj = 0; bj < 2; ++bj)
#pragma unroll
                        for (int n = 0; n < 2; ++n) v[bj][n] = v[bj][n] * r * gv[bj][n];
                } else if (mode == 2) {
                    const float pos = (float)(row & (SEQ - 1));
                    const float lgam = __builtin_amdgcn_logf(1.0f - __builtin_amdgcn_exp2f(-5.0f - (float)wc));
                    const float rsc = scale * __builtin_amdgcn_exp2f(((u.pn == 6) ? lgam : -lgam) * (float)(row & 127));
#pragma unroll
                    for (int n = 0; n < 2; ++n)
#pragma unroll
                        for (int j = 0; j < 4; ++j) {
                            const float fre = __builtin_amdgcn_exp2f((float)(8 * fq + 4 * n + j) * (-13.287712379549449f / 31.0f)) * 0.15915494309189535f;
                            float tt = pos * fre; tt = tt - floorf(tt);
                            const float sn = __builtin_amdgcn_sinf(tt), cs = __builtin_amdgcn_cosf(tt);
                            const float t1 = v[0][n][j], t2 = v[1][n][j];
                            v[0][n][j] = (t1 * cs - t2 * sn) * rsc; v[1][n][j] = (t2 * cs + t1 * sn) * rsc;
                        }
                } else if (mode == 3) {
#pragma unroll
                    for (int bj = 0; bj < 2; ++bj)
#pragma unroll
                        for (int n = 0; n < 2; ++n)
#pragma unroll
                            for (int j = 0; j < 4; ++j) { const float x = v[bj][n][j]; v[bj][n][j] = x / (1.0f + __expf(-x)); }
                }
                if (kmean) {
#pragma unroll
                    for (int bj = 0; bj < 2; ++bj)
#pragma unroll
                        for (int n = 0; n < 2; ++n) ks[bj][n] += v[bj][n];
                }
                bf16* rowp = out + (size_t)row * ld + colb;
#pragma unroll
                for (int bj = 0; bj < 2; ++bj) { u32x4 w; w.x = cvtpk(v[bj][0][0], v[bj][0][1]); w.y = cvtpk(v[bj][0][2], v[bj][0][3]); w.z = cvtpk(v[bj][1][0], v[bj][1][1]); w.w = cvtpk(v[bj][1][2], v[bj][1][3]);
                    *(u32x4*)(rowp + bj * 32) = w; }
            }
        if (kmean) {
            float* kp = (float*)(ws + WS_KMEAN) + ((size_t)u.pm * 8 + (u.pn - 2) * 4 + wc) * 64 + 8 * fq;
#pragma unroll
            for (int bj = 0; bj < 2; ++bj)
#pragma unroll
                for (int n = 0; n < 2; ++n)
#pragma unroll
                    for (int j = 0; j < 4; ++j) {
                        float s = ks[bj][n][j];
                        s += __shfl_xor(s, 1); s += __shfl_xor(s, 2); s += __shfl_xor(s, 4); s += __shfl_xor(s, 8);
                        if (fr == 0) atomicAdd(kp + bj * 32 + 4 * n + j, s * (1.0f / 256.0f));
                    }
        }
    }
};

struct EpiOut {
    const bf16* xn; const float* irs; const float* gattn; bf16* out; float* ssq;
    static constexpr int PRE_KIB = 2;
    __device__ __forceinline__ const char* pre_src(const Unit& u, int k, int lane) const { return (const char*)(k == 0 ? gattn + u.pn * 256 : irs + (size_t)u.pm * 256) + lane * 16; }
    __device__ __forceinline__ void operator()(const f32x4 (&acc)[2][2][4][2], const Unit& u, int wr, int wc, int fr, int fq, const LAS float* pre) const {
        const int row0 = u.pm * 256 + wr * 64 + fr, col0 = u.pn * 256 + wc * 32 + 8 * fq;
        f32x4 ig[2][2];
#pragma unroll
        for (int bj = 0; bj < 2; ++bj)
#pragma unroll
            for (int n = 0; n < 2; ++n) { const f32x4 g = *(const LAS f32x4*)(pre + wc * 32 + 8 * fq + bj * 128 + 4 * n); ig[bj][n] = (f32x4){1.0f / g[0], 1.0f / g[1], 1.0f / g[2], 1.0f / g[3]}; }
#pragma unroll
        for (int ai = 0; ai < 2; ++ai) {
            u32x4 xwv[4][2]; float irv[4];
#pragma unroll
            for (int m = 0; m < 4; ++m) { const int row = row0 + ai * 128 + m * 16; irv[m] = pre[256 + wr * 64 + fr + ai * 128 + m * 16];
#pragma unroll
                for (int bj = 0; bj < 2; ++bj) xwv[m][bj] = __builtin_nontemporal_load((const u32x4*)(xn + (size_t)row * DM + col0 + bj * 128)); }
#pragma unroll
            for (int m = 0; m < 4; ++m) {
                const int row = row0 + ai * 128 + m * 16; const size_t off = (size_t)row * DM + col0; float ss = 0.f; const float ir = irv[m];
#pragma unroll
                for (int bj = 0; bj < 2; ++bj) {
                    const u32x4 xw = xwv[m][bj];
                    const f32x4 o0 = (f32x4){bflo(xw.x), bfhi(xw.x), bflo(xw.y), bfhi(xw.y)} * ig[bj][0] * ir + acc[ai][bj][m][0], o1 = (f32x4){bflo(xw.z), bfhi(xw.z), bflo(xw.w), bfhi(xw.w)} * ig[bj][1] * ir + acc[ai][bj][m][1];
                    ss += ((o0[0] * o0[0] + o0[1] * o0[1]) + (o0[2] * o0[2] + o0[3] * o0[3])) + ((o1[0] * o1[0] + o1[1] * o1[1]) + (o1[2] * o1[2] + o1[3] * o1[3]));
                    u32x4 w; w.x = cvtpk(o0[0], o0[1]); w.y = cvtpk(o0[2], o0[3]); w.z = cvtpk(o1[0], o1[1]); w.w = cvtpk(o1[2], o1[3]);
                    *(u32x4*)(out + off + bj * 128) = w; }
                ss += __shfl_xor(ss, 16); ss += __shfl_xor(ss, 32);
                if (fq == 0) ssq[(size_t)row * 16 + u.pn * 4 + wc] = ss;
            }
        }
    }
};

struct EpiSwiglu {
    static constexpr int PRE_KIB = 1;
    const float* b1; unsigned char* H;
    __device__ __forceinline__ const char* pre_src(const Unit& u, int k, int lane) const { return (const char*)(b1 + (size_t)u.aux * 2048 + u.pn * 256) + lane * 16; }
    __device__ __forceinline__ void operator()(const f32x4 (&acc)[2][2][4][2], const Unit& u, int wr, int wc, int fr, int fq, const LAS float* pre) const {
        const int row0 = u.pm * 256 + wr * 64 + fr, p0 = u.pn * 128 + wc * 32 + 8 * fq;
        const LAS float* bp = pre + 2 * (wc * 32 + 8 * fq);
        f32x4 bv[4];
#pragma unroll
        for (int i = 0; i < 4; ++i) bv[i] = *(const LAS f32x4*)(bp + 4 * i);
#pragma unroll
        for (int ai = 0; ai < 2; ++ai)
#pragma unroll
            for (int m = 0; m < 4; ++m) {
                const int row = row0 + ai * 128 + m * 16;
                float h[8];
#pragma unroll
                for (int n = 0; n < 2; ++n)
#pragma unroll
                    for (int j = 0; j < 4; ++j) {
                        const int i = 4 * n + j;
                        const float g = fminf(acc[ai][0][m][n][j] + bv[i >> 1][(i & 1) * 2], 7.0f);
                        const float l = fminf(fmaxf(acc[ai][1][m][n][j] + bv[i >> 1][(i & 1) * 2 + 1], -7.0f), 7.0f);
                        h[i] = g * __builtin_amdgcn_rcpf(1.0f + __builtin_amdgcn_exp2f(-1.702f * 1.4426950408889634f * g)) * (l + 1.0f);
                    }
                int w0 = 0, w1 = 0;
                w0 = __builtin_amdgcn_cvt_pk_fp8_f32(h[0], h[1], w0, false); w0 = __builtin_amdgcn_cvt_pk_fp8_f32(h[2], h[3], w0, true);
                w1 = __builtin_amdgcn_cvt_pk_fp8_f32(h[4], h[5], w1, false); w1 = __builtin_amdgcn_cvt_pk_fp8_f32(h[6], h[7], w1, true);
                *(u32x2*)(H + (size_t)row * 1024 + p0) = (u32x2){(unsigned)w0, (unsigned)w1};
            }
    }
};

struct EpiDown {
    static constexpr int PRE_KIB = 2;
    const float* b2; const float* roww; unsigned char* YE;
    __device__ __forceinline__ const char* pre_src(const Unit& u, int k, int lane) const {
        return (const char*)(k == 0 ? b2 + (size_t)u.aux * 1024 + u.pn * 256 : roww + (size_t)u.pm * 256) + lane * 16; }
    __device__ __forceinline__ void operator()(const f32x4 (&acc)[2][2][4][2], const Unit& u, int wr, int wc, int fr, int fq, const LAS float* pre) const {
        const int row0 = u.pm * 256 + wr * 64 + fr, c0 = u.pn * 256 + wc * 32 + 8 * fq;
        const LAS float* bp = pre + wc * 32 + 8 * fq;
        f32x4 bv[2][2];
#pragma unroll
        for (int bj = 0; bj < 2; ++bj)
#pragma unroll
            for (int n = 0; n < 2; ++n) bv[bj][n] = *(const LAS f32x4*)(bp + bj * 128 + 4 * n);
        float w8v[2][4];
#pragma unroll
        for (int ai = 0; ai < 2; ++ai)
#pragma unroll
            for (int m = 0; m < 4; ++m) w8v[ai][m] = pre[256 + wr * 64 + fr + ai * 128 + m * 16] * 16.0f;
#pragma unroll
        for (int ai = 0; ai < 2; ++ai)
#pragma unroll
            for (int m = 0; m < 4; ++m) {
                const int row = row0 + ai * 128 + m * 16; const float w8 = w8v[ai][m];
#pragma unroll
                for (int bj = 0; bj < 2; ++bj) {
                    const f32x4 y0 = (acc[ai][bj][m][0] * 0.03125f + bv[bj][0]) * w8, y1 = (acc[ai][bj][m][1] * 0.03125f + bv[bj][1]) * w8;
                    int w0 = 0, w1 = 0;
                    w0 = __builtin_amdgcn_cvt_pk_fp8_f32(y0[0], y0[1], w0, false); w0 = __builtin_amdgcn_cvt_pk_fp8_f32(y0[2], y0[3], w0, true);
                    w1 = __builtin_amdgcn_cvt_pk_fp8_f32(y1[0], y1[1], w1, false); w1 = __builtin_amdgcn_cvt_pk_fp8_f32(y1[2], y1[3], w1, true);
                    *(u32x2*)(YE + (size_t)row * 1024 + c0 + bj * 128) = (u32x2){(unsigned)w0, (unsigned)w1};
                }
            }
    }
};

__device__ __forceinline__ void transpose_item(const float* W, int N, bf16* WT, int drow0, LAS float* scr, int k0, int n0, int lane) {
    float ld_[32];
#pragma unroll
    for (int i = 0; i < 32; ++i) { const int kk = 2 * i + (lane >> 5); ld_[i] = __builtin_nontemporal_load(W + (size_t)(k0 + kk) * N + n0 + (lane & 31)); }
#pragma unroll
    for (int i = 0; i < 32; ++i) { const int kk = 2 * i + (lane >> 5); scr[kk * 33 + (lane & 31)] = ld_[i]; }
    LDS_WAIT(); asm volatile("" ::: "memory");
    const int c = lane & 7;
#pragma unroll
    for (int j = 0; j < 4; ++j) { const int n = (lane >> 3) + 8 * j; const LAS float* s = scr + (8 * c) * 33 + n;
        u32x4 o; o.x = cvtpk(s[0 * 33], s[1 * 33]); o.y = cvtpk(s[2 * 33], s[3 * 33]); o.z = cvtpk(s[4 * 33], s[5 * 33]); o.w = cvtpk(s[6 * 33], s[7 * 33]);
        *(u32x4*)(WT + (size_t)(drow0 + n) * 1024 + k0 + 8 * c) = o; }
    LDS_WAIT(); asm volatile("" ::: "memory");
}
template <bool GLU>
__device__ __forceinline__ void transpose_item_fp8(const float* W, int N, unsigned char* W8, LAS float* scr, int k0, int n0, int lane) {
    float ld_[32];
#pragma unroll
    for (int i = 0; i < 32; ++i) { const int kk = 2 * i + (lane >> 5); ld_[i] = __builtin_nontemporal_load(W + (size_t)(k0 + kk) * N + n0 + (lane & 31)); }
#pragma unroll
    for (int i = 0; i < 32; ++i) { const int kk = 2 * i + (lane >> 5); scr[kk * 33 + (lane & 31)] = ld_[i]; }
    LDS_WAIT(); asm volatile("" ::: "memory");
    const int c = lane & 3;
#pragma unroll
    for (int j = 0; j < 2; ++j) { const int n = (lane >> 2) + 16 * j; const LAS float* s = scr + (16 * c) * 33 + n;
        int w[4];
#pragma unroll
        for (int q = 0; q < 4; ++q) { int t = 0; t = __builtin_amdgcn_cvt_pk_fp8_f32(s[(4 * q) * 33] * 32.0f, s[(4 * q + 1) * 33] * 32.0f, t, false); t = __builtin_amdgcn_cvt_pk_fp8_f32(s[(4 * q + 2) * 33] * 32.0f, s[(4 * q + 3) * 33] * 32.0f, t, true); w[q] = t; }
        const int col = n0 + n; const int p = col >> 1;
        const int drow = GLU ? ((p >> 7) * 256 + (col & 1) * 128 + (p & 127)) : col;
        *(u32x4*)(W8 + (size_t)drow * 1024 + k0 + 16 * c) = (u32x4){(unsigned)w[0], (unsigned)w[1], (unsigned)w[2], (unsigned)w[3]}; }
    LDS_WAIT(); asm volatile("" ::: "memory");
}
struct ConvItem { const float* W; unsigned char* W8; int N, k0, n0; bool glu; };
__device__ __forceinline__ ConvItem conv_decode(int it, const float* w1, const float* w2, unsigned char* W1_8, unsigned char* W2_8) {
    ConvItem c;
    if (it < 32768) { const int e = it >> 10, rr = it & 1023, nb = rr & 63, kb = rr >> 6; c.W = w1 + (size_t)e * 1024 * 2048; c.W8 = W1_8 + (size_t)e * 2048 * 1024; c.N = 2048; c.k0 = kb * 64; c.n0 = nb * 32; c.glu = true; }
    else { const int r = it - 32768, e = r >> 9, rr = r & 511, nb = rr & 31, kb = rr >> 5; c.W = w2 + (size_t)e * 1024 * 1024; c.W8 = W2_8 + (size_t)e * 1024 * 1024; c.N = 1024; c.k0 = kb * 64; c.n0 = nb * 32; c.glu = false; }
    return c;
}
__device__ __forceinline__ void conv_load(const ConvItem& c, f32x4 (&r)[8], int lane) {
    const float* base = c.W + (size_t)c.k0 * c.N + c.n0;
    const int lo = (lane >> 3) * c.N + (lane & 7) * 4;
#pragma unroll
    for (int i = 0; i < 8; ++i) r[i] = __builtin_nontemporal_load((const f32x4*)(base + (size_t)(8 * i) * c.N + lo));
}
__device__ __forceinline__ void conv_finish(const ConvItem& c, const f32x4 (&r)[8], LAS float* scr, int lane) {
#pragma unroll
    for (int i = 0; i < 8; ++i) *(LAS f32x4*)(scr + (8 * i + (lane >> 3)) * 36 + (lane & 7) * 4) = r[i];
    LDS_WAIT(); asm volatile("" ::: "memory");
    if (c.glu) {
        const int n = lane & 31, half = lane >> 5; const LAS float* s = scr + (32 * half) * 36 + n;
        float v[32];
#pragma unroll
        for (int i = 0; i < 32; ++i) v[i] = s[i * 36];
        u32x4 p0, p1; fp6_pack32(v, p0, p1);
        const int col = c.n0 + n; const int p = col >> 1;
        const int drow = (p >> 7) * 256 + (col & 1) * 128 + (p & 127);
        unsigned char* dst = c.W8 + (size_t)drow * 1024 + (c.k0 >> 7) * 128 + 16 * (((c.k0 & 127) >> 5) + half);
        *(u32x4*)dst = p0; *(u32x4*)(dst + 64) = p1;
        LDS_WAIT(); asm volatile("" ::: "memory");
        return;
    }
    const int cc = lane & 3;
#pragma unroll
    for (int j = 0; j < 2; ++j) { const int n = (lane >> 2) + 16 * j; const LAS float* s = scr + (16 * cc) * 36 + n;
        int w[4];
#pragma unroll
        for (int q = 0; q < 4; ++q) { int t = 0; t = __builtin_amdgcn_cvt_pk_fp8_f32(s[(4 * q) * 36] * 32.0f, s[(4 * q + 1) * 36] * 32.0f, t, false); t = __builtin_amdgcn_cvt_pk_fp8_f32(s[(4 * q + 2) * 36] * 32.0f, s[(4 * q + 3) * 36] * 32.0f, t, true); w[q] = t; }
        const int col = c.n0 + n; const int p = col >> 1;
        const int drow = c.glu ? ((p >> 7) * 256 + (col & 1) * 128 + (p & 127)) : col;
        *(u32x4*)(c.W8 + (size_t)drow * 1024 + c.k0 + 16 * cc) = (u32x4){(unsigned)w[0], (unsigned)w[1], (unsigned)w[2], (unsigned)w[3]}; }
    LDS_WAIT(); asm volatile("" ::: "memory");
}
__device__ __forceinline__ void convert_chunk(int chunk, const float* w1, const float* w2, unsigned char* W1_8, unsigned char* W2_8, LAS float* scr, int wave, int lane) {
    const int base = chunk * 32 + wave;
    f32x4 ra[8], rb[8];
    ConvItem ca = conv_decode(base, w1, w2, W1_8, W2_8), cb;
    conv_load(ca, ra, lane);
#pragma unroll 1
    for (int j = 0; j < 4; j += 2) {
        cb = conv_decode(base + 8 * (j + 1), w1, w2, W1_8, W2_8); conv_load(cb, rb, lane);
        conv_finish(ca, ra, scr, lane);
        if (j + 2 < 4) { ca = conv_decode(base + 8 * (j + 2), w1, w2, W1_8, W2_8); conv_load(ca, ra, lane); }
        conv_finish(cb, rb, scr, lane);
    }
}
__device__ __forceinline__ int headperm_row(int n0) { const int pn = n0 >> 8, c = n0 & 255, hh = c >> 6, dh = (c & 63) >> 5; return pn * 256 + dh * 128 + hh * 32; }
__device__ __forceinline__ void rms_row_to_bf16(const float* xrow, const float* gain, bf16* orow, int lane) {
    const f32x4* xr = (const f32x4*)xrow + lane; const f32x4* gr = (const f32x4*)gain + lane;
    f32x4 v[4]; float s = 0.f;
#pragma unroll
    for (int j = 0; j < 4; ++j) { v[j] = xr[64 * j]; s += (v[j].x * v[j].x + v[j].y * v[j].y) + (v[j].z * v[j].z + v[j].w * v[j].w); }
    const float rstd = 1.0f / sqrtf(wave_sum(s) * (1.f / DM) + EPS);
    u32x2* o8 = (u32x2*)orow + lane;
#pragma unroll
    for (int j = 0; j < 4; ++j) { const f32x4 gg = gr[64 * j]; u32x2 w; w.x = cvtpk(v[j].x * rstd * gg.x, v[j].y * rstd * gg.y); w.y = cvtpk(v[j].z * rstd * gg.z, v[j].w * rstd * gg.w); o8[64 * j] = w; }
}

__device__ __forceinline__ void rms_row2_to_bf16(const float* xrow, const float* gain, bf16* orow, int lane, float* irs) {
    const f32x4* xr = (const f32x4*)xrow + lane; const f32x4* gr = (const f32x4*)gain + lane;
    f32x4 v[8]; float s0 = 0.f, s1 = 0.f;
#pragma unroll
    for (int j = 0; j < 8; ++j) v[j] = __builtin_nontemporal_load(xr + 64 * j);
#pragma unroll
    for (int j = 0; j < 4; ++j) { s0 += (v[j].x * v[j].x + v[j].y * v[j].y) + (v[j].z * v[j].z + v[j].w * v[j].w); s1 += (v[4 + j].x * v[4 + j].x + v[4 + j].y * v[4 + j].y) + (v[4 + j].z * v[4 + j].z + v[4 + j].w * v[4 + j].w); }
    const float q0 = sqrtf(wave_sum(s0) * (1.f / DM) + EPS), q1 = sqrtf(wave_sum(s1) * (1.f / DM) + EPS); const float r0 = 1.0f / q0, r1 = 1.0f / q1;
    if (irs != nullptr && lane == 0) { irs[0] = q0; irs[1] = q1; }
    u32x2* o8 = (u32x2*)orow + lane;
#pragma unroll
    for (int j = 0; j < 4; ++j) { const f32x4 gg = gr[64 * j]; u32x2 w; w.x = cvtpk(v[j].x * r0 * gg.x, v[j].y * r0 * gg.y); w.y = cvtpk(v[j].z * r0 * gg.z, v[j].w * r0 * gg.w); o8[64 * j] = w;
        u32x2 w2; w2.x = cvtpk(v[4 + j].x * r1 * gg.x, v[4 + j].y * r1 * gg.y); w2.y = cvtpk(v[4 + j].z * r1 * gg.z, v[4 + j].w * r1 * gg.w); o8[256 + 64 * j] = w2; }
}

#include <hip/hip_bf16.h>
namespace attn_body {
using s16x4=__attribute__((ext_vector_type(4)))short;
using f32x16=__attribute__((ext_vector_type(16)))float;
constexpr int D=64,NW=8,QBLK=32,QB=QBLK*NW,KVBLK=64;
__device__ __forceinline__ int crow(int r,int hi){return (r&3)+8*(r>>2)+4*hi;}
#define SBAR() __builtin_amdgcn_sched_barrier(0)
__device__ __forceinline__ void cmask(f32x16&p0,f32x16&p1,int jb,int qrel,int hi){
  const float NEG=-INFINITY; int kb=64*jb+4*hi;
  #pragma unroll
  for(int r=0;r<16;++r){int kv=kb+(r&3)+8*(r>>2); if(kv>qrel)p0[r]=NEG; if(kv+32>qrel)p1[r]=NEG;}
}
constexpr int NSLOT=3, SLOTB=8192;
constexpr int LDS_K=0, LDS_V=NSLOT*SLOTB, LDS_WS=2*NSLOT*SLOTB, LDS_OST=LDS_WS+NW*64*4, ATT_LDS_BYTES=LDS_OST+NW*4096;
__device__ __forceinline__ void glds16(const void*gsrc,unsigned lds_dst){unsigned keep;
  asm volatile("s_mov_b32 %0, m0\n\ts_mov_b32 m0, %2\n\ts_nop 0\n\tglobal_load_lds_dwordx4 %1, off\n\ts_mov_b32 m0, %0":"=&s"(keep):"v"(gsrc),"s"(lds_dst):"memory");}
__device__ __forceinline__ float max3f(float a,float b,float c){float r;asm("v_max3_f32 %0, %1, %2, %3":"=v"(r):"v"(a),"v"(b),"v"(c));return r;}
__device__ __forceinline__ float max2f(float a,float b){float r;asm("v_max_f32_e32 %0, %1, %2":"=v"(r):"v"(a),"v"(b));return r;}
__device__ __forceinline__ float fadd_s(float a,float b){float r;asm("v_add_f32_e32 %0, %1, %2":"=v"(r):"v"(a),"v"(b));return r;}
__device__ __forceinline__ float fsub_s(float a,float b){float r;asm("v_sub_f32_e32 %0, %1, %2":"=v"(r):"v"(a),"v"(b));return r;}
__device__ __forceinline__ unsigned cvtpk_s(float lo,float hi){return cvtpk(lo,hi);}
#define WAIT_BAR(N) asm volatile("s_waitcnt vmcnt(" #N ") lgkmcnt(0)\n\ts_barrier":::"memory")
__device__ __forceinline__ void qkt(f32x16&p0,f32x16&p1,const char*Kslot,const bf16x8*qr,const f32x16&negm,int r32,int hi){
  const char*kb=Kslot+hi*1024+r32*16;
  #pragma unroll
  for(int d0=0;d0<4;++d0){
    const bf16x8 b0=*reinterpret_cast<const bf16x8*>(kb+d0*2048);
    const bf16x8 b1=*reinterpret_cast<const bf16x8*>(kb+d0*2048+512);
    if(d0==0){p0=__builtin_amdgcn_mfma_f32_32x32x16_bf16(b0,qr[0],negm,0,0,0);p1=__builtin_amdgcn_mfma_f32_32x32x16_bf16(b1,qr[0],negm,0,0,0);}
    else{p0=__builtin_amdgcn_mfma_f32_32x32x16_bf16(b0,qr[d0],p0,0,0,0);p1=__builtin_amdgcn_mfma_f32_32x32x16_bf16(b1,qr[d0],p1,0,0,0);}}
}
typedef __attribute__((address_space(3))) const char* lds_cptr;
typedef short v4i16_t __attribute__((ext_vector_type(4)));
__device__ __forceinline__ void kload8(bf16x8*kf,lds_cptr kp){
  kf[0]=*(const __attribute__((address_space(3))) bf16x8*)(kp);      kf[1]=*(const __attribute__((address_space(3))) bf16x8*)(kp+512);
  kf[2]=*(const __attribute__((address_space(3))) bf16x8*)(kp+2048); kf[3]=*(const __attribute__((address_space(3))) bf16x8*)(kp+2560);
  kf[4]=*(const __attribute__((address_space(3))) bf16x8*)(kp+4096); kf[5]=*(const __attribute__((address_space(3))) bf16x8*)(kp+4608);
  kf[6]=*(const __attribute__((address_space(3))) bf16x8*)(kp+6144); kf[7]=*(const __attribute__((address_space(3))) bf16x8*)(kp+6656);
}
__device__ __forceinline__ void kload2(bf16x8*kf,lds_cptr kp,int j){ kf[2*j]=*(const __attribute__((address_space(3))) bf16x8*)(kp+j*2048); kf[2*j+1]=*(const __attribute__((address_space(3))) bf16x8*)(kp+j*2048+512); }
__device__ __forceinline__ s16x4 vtr(lds_cptr p){ return __builtin_bit_cast(s16x4,__builtin_amdgcn_ds_read_tr16_b64_v4i16((__attribute__((address_space(3))) v4i16_t*)p)); }
__device__ __forceinline__ float rowmax(const f32x16&p0,const f32x16&p1){
  float a=max3f(p0[0],p0[1],p1[0]),b=max3f(p0[2],p0[3],p1[1]);a=max3f(a,p1[2],p1[3]);
  #pragma unroll
  for(int r=4;r<16;r+=4){a=max3f(a,p0[r],p0[r+1]);b=max3f(b,p0[r+2],p0[r+3]);a=max3f(a,p1[r],p1[r+1]);b=max3f(b,p1[r+2],p1[r+3]);}
  const float m=max2f(a,b);
  auto rr=__builtin_amdgcn_permlane32_swap(__float_as_uint(m),__float_as_uint(m),false,false);
  return max2f(__uint_as_float(rr[0]),__uint_as_float(rr[1]));
}
__device__ __forceinline__ void pv(f32x16*o,int vb,bf16x8 pa0,bf16x8 pa1,bf16x8 pa2,bf16x8 pa3){
  #pragma unroll
  for(int d0=0;d0<2;++d0){s16x4 lo[4],hi[4];
    #pragma unroll
    for(int ks=0;ks<4;++ks){
      asm volatile("ds_read_b64_tr_b16 %0,%1 offset:%c2":"=&v"(lo[ks]):"v"(vb),"i"(d0*4096+ks*1024):"memory");
      asm volatile("ds_read_b64_tr_b16 %0,%1 offset:%c2":"=&v"(hi[ks]):"v"(vb),"i"(d0*4096+ks*1024+512):"memory");}
    asm volatile("s_waitcnt lgkmcnt(0)":::"memory");SBAR();
    #define PK(k) (bf16x8){lo[k][0],lo[k][1],lo[k][2],lo[k][3],hi[k][0],hi[k][1],hi[k][2],hi[k][3]}
    o[d0]=__builtin_amdgcn_mfma_f32_32x32x16_bf16(pa0,PK(0),o[d0],0,0,0);
    o[d0]=__builtin_amdgcn_mfma_f32_32x32x16_bf16(pa1,PK(1),o[d0],0,0,0);
    o[d0]=__builtin_amdgcn_mfma_f32_32x32x16_bf16(pa2,PK(2),o[d0],0,0,0);
    o[d0]=__builtin_amdgcn_mfma_f32_32x32x16_bf16(pa3,PK(3),o[d0],0,0,0);
    #undef PK
  }
}
template<int THRL,int KP,int OP,bool MOBA> __device__ __forceinline__ void attn_unit(const bf16*Qu,const bf16*__restrict__ Kh,const bf16*__restrict__ Vh,bf16*Ou,const int NT,const int nblk,const float*kmean,char*shm){
  const int tid=opaque((int)threadIdx.x),lane=tid&63,r32=lane&31,hi=lane>>5; const int wid=__builtin_amdgcn_readfirstlane(tid>>6);
  const bf16*Qw=Qu+(long)(wid*QBLK)*KP;
  const unsigned lds0=(unsigned)(uintptr_t)shm;
  float*wsf=(float*)(shm+LDS_WS)+wid*64;
  const bf16*ksrc=Kh+(long)lane*KP+wid*8;
  const bf16*vsrc=Vh+(long)(16*(wid&3)+(lane>>2))*KP+(wid>>2)*32+(lane&3)*8;
  const unsigned kdst=lds0+LDS_K+wid*1024, vdst=lds0+LDS_V+wid*1024;
  #define DMA_K(t,slot) glds16(ksrc+(long)(t)*KVBLK*KP,(unsigned)__builtin_amdgcn_readfirstlane(kdst+(slot)))
  #define DMA_V(t,slot) glds16(vsrc+(long)(t)*KVBLK*KP,(unsigned)__builtin_amdgcn_readfirstlane(vdst+(slot)))
  const int vb0=(int)(lds0+LDS_V)+((lane>>4)&1)*32+(lane&3)*8+(4*hi+((lane&15)>>2))*64;
  const char*Kbase=shm+LDS_K; bf16x8 kf[8];
  const lds_cptr shm3=(lds_cptr)shm; const lds_cptr kp0=shm3+LDS_K+hi*1024+r32*16; const lds_cptr vp0=shm3+LDS_V+((lane>>4)&1)*32+(lane&3)*8+(4*hi+((lane&15)>>2))*64;
  DMA_K(0,0);DMA_V(0,0);DMA_K(1,SLOTB);
  bf16x8 qr[4];
  #pragma unroll
  for(int d0=0;d0<4;++d0)qr[d0]=*reinterpret_cast<const bf16x8*>(&Qw[(long)r32*KP+d0*16+hi*8]);
  unsigned bmask=0xffffffffu;
  if(MOBA){
    bmask=1u<<nblk;
    float g0=-3e38f,g1=-3e38f,g2=-3e38f; int i0=-1,i1=-1,i2=-1;
    for(int j=0;j<nblk;++j){
      const float*km=kmean+(long)j*512+8*hi; float g=0.f;
      #pragma unroll
      for(int d0=0;d0<4;++d0){ const f32x4 a=*(const f32x4*)(km+16*d0),b=*(const f32x4*)(km+16*d0+4);
        g+=bf2f((unsigned short)qr[d0][0])*a[0]+bf2f((unsigned short)qr[d0][1])*a[1]+bf2f((unsigned short)qr[d0][2])*a[2]+bf2f((unsigned short)qr[d0][3])*a[3];
        g+=bf2f((unsigned short)qr[d0][4])*b[0]+bf2f((unsigned short)qr[d0][5])*b[1]+bf2f((unsigned short)qr[d0][6])*b[2]+bf2f((unsigned short)qr[d0][7])*b[3]; }
      g+=__shfl_xor(g,32);
      if(g>g0){g2=g1;i2=i1;g1=g0;i1=i0;g0=g;i0=j;} else if(g>g1){g2=g1;i2=i1;g1=g;i1=j;} else if(g>g2){g2=g;i2=j;}
    }
    if(i0>=0)bmask|=1u<<i0; if(i1>=0)bmask|=1u<<i1; if(i2>=0)bmask|=1u<<i2;
  }
  #define NEGM_FOR(t) (MOBA ? (((bmask>>((t)>>2))&1u) ? -mhat : -INFINITY) : -mhat)
  float mhat=0.f,l_reg=0.f;f32x16 o[2];o[0]=f32x16{};o[1]=f32x16{};f32x16 negm;
  { const float nm=NEGM_FOR(0);
    #pragma unroll
    for(int r=0;r<16;++r)negm[r]=nm; }
  asm volatile("":"+v"(negm));
  const int qrel=wid*QBLK+r32;
  #define CMASK(P0,P1,t) do{ if(MOBA){int jb_=(t)-(NT-4); if(jb_>=0)cmask(P0,P1,jb_,qrel,hi);} }while(0)
  bool resc=false;
  #define START(P0,P1) do{ const float rm=rowmax(P0,P1); resc=false; \
    { const float dl=(MOBA&&rm==-INFINITY)?0.f:rm; mhat=fadd_s(mhat,dl); \
      _Pragma("unroll") for(int r=0;r<16;++r){P0[r]=fsub_s(P0[r],dl);P1[r]=fsub_s(P1[r],dl);} \
      { const float nm=NEGM_FOR(1); _Pragma("unroll") for(int r=0;r<16;++r)negm[r]=nm; } asm volatile("":"+v"(negm)); } \
    _Pragma("unroll") for(int r=0;r<16;++r)P0[r]=__builtin_amdgcn_exp2f(P0[r]); }while(0)
  #define RESC() do{ if(resc){ asm volatile("s_waitcnt lgkmcnt(0)":::"memory"); \
      _Pragma("unroll") for(int d_=0;d_<2;++d_) _Pragma("unroll") for(int r=0;r<16;++r)o[d_][r]*=wsf[crow(r,hi)]; } }while(0)
  f32x16 pA0,pA1,pB0,pB1;
  int sl_prev=0,sl_cur=0,sl_next=SLOTB;
  #define ROT() do{sl_prev=sl_cur;sl_cur=sl_next;sl_next=(sl_next==(NSLOT-1)*SLOTB)?0:sl_next+SLOTB;}while(0)
  DMA_K(2,2*SLOTB);
  WAIT_BAR(3);
  qkt(pA0,pA1,Kbase,qr,negm,r32,hi);asm volatile("s_nop 15\n\ts_nop 7":"+v"(pA0),"+v"(pA1));CMASK(pA0,pA1,0);
  START(pA0,pA1);
  _Pragma("unroll") for(int r=0;r<16;++r)pA1[r]=__builtin_amdgcn_exp2f(pA1[r]);
  WAIT_BAR(0);
  DMA_K(3,0);DMA_V(1,SLOTB);
  ROT();
  kload8(kf,kp0+sl_cur);
  WAIT_BAR(2);
  s16x4 vlo[8],vhi[8]; u32x4 pw0,pw1,pw2,pw3;
  #define PKW(P,B) cvtpk_s(P[B],P[B+1])
  #define PAF(k) __builtin_bit_cast(bf16x8,pw##k)
  #define VFR(i) (bf16x8){vlo[i][0],vlo[i][1],vlo[i][2],vlo[i][3],vhi[i][0],vhi[i][1],vhi[i][2],vhi[i][3]}
  #define PIN(x) asm volatile("":"+v"(x))
  #define MX3(a,b,c) __builtin_fmaxf(__builtin_fmaxf((a),(b)),(c))
  #define GAPA(MF,A0,A1,A2,A3,W0,W1,PW) do{ MF; sacc+=A0; sacc+=A1; sacc+=A2; sacc+=A3; PIN(sacc); W0; W1; PIN(PW); SBAR(); }while(0)
  #define EX(v) __builtin_amdgcn_exp2f(v)
  #define GAPB(MF,X,B) do{ MF; X[B]=EX(X[B]); X[B+1]=EX(X[B+1]); X[B+2]=EX(X[B+2]); X[B+3]=EX(X[B+3]); PIN(X); SBAR(); }while(0)
  #define VRD(i) do{ vlo[i]=vtr(vp_+(((i)>>2)*4096+((i)&3)*1024)); vhi[i]=vtr(vp_+(((i)>>2)*4096+((i)&3)*1024+512)); }while(0)
  #define KRD(G,j) do{ if(G){ kload2(kf,kp0+sl_next,j); SBAR(); } }while(0)
  #define STEP(C0,C1,P0,P1,t,GK,GV,GL) do{ SBAR(); \
    const lds_cptr vp_=vp0+sl_prev; \
    VRD(0); SBAR(); float sacc=(P0[0]+P0[1]); \
    GAPA(C0=__builtin_amdgcn_mfma_f32_32x32x16_bf16(kf[0],qr[0],negm,0,0,0), P0[2],P0[3],P0[4],P0[5],     pw0[0]=PKW(P0,0), pw0[1]=PKW(P0,2), pw0); \
    VRD(4); SBAR(); GAPA(C1=__builtin_amdgcn_mfma_f32_32x32x16_bf16(kf[1],qr[0],negm,0,0,0), P0[6],P0[7],P0[8],P0[9],     pw0[2]=PKW(P0,4), pw0[3]=PKW(P0,6), pw0); \
    VRD(1); SBAR(); GAPA(C0=__builtin_amdgcn_mfma_f32_32x32x16_bf16(kf[2],qr[1],C0,0,0,0),   P0[10],P0[11],P0[12],P0[13], pw1[0]=PKW(P0,8), pw1[1]=PKW(P0,10), pw1); \
    VRD(5); SBAR(); GAPA(C1=__builtin_amdgcn_mfma_f32_32x32x16_bf16(kf[3],qr[1],C1,0,0,0),   P0[14],P0[15],P1[0],P1[1],   pw1[2]=PKW(P0,12),pw1[3]=PKW(P0,14), pw1); \
    VRD(2); SBAR(); GAPA(C0=__builtin_amdgcn_mfma_f32_32x32x16_bf16(kf[4],qr[2],C0,0,0,0),   P1[2],P1[3],P1[4],P1[5],     pw2[0]=PKW(P1,0), pw2[1]=PKW(P1,2), pw2); \
    VRD(6); SBAR(); GAPA(C1=__builtin_amdgcn_mfma_f32_32x32x16_bf16(kf[5],qr[2],C1,0,0,0),   P1[6],P1[7],P1[8],P1[9],     pw2[2]=PKW(P1,4), pw2[3]=PKW(P1,6), pw2); \
    VRD(3); SBAR(); GAPA(C0=__builtin_amdgcn_mfma_f32_32x32x16_bf16(kf[6],qr[3],C0,0,0,0),   P1[10],P1[11],P1[12],P1[13], pw3[0]=PKW(P1,8), pw3[1]=PKW(P1,10), pw3); \
    VRD(7); SBAR(); GAPA(C1=__builtin_amdgcn_mfma_f32_32x32x16_bf16(kf[7],qr[3],C1,0,0,0),   P1[14],P1[15],0.f,0.f,       pw3[2]=PKW(P1,12),pw3[3]=PKW(P1,14), pw3); \
    l_reg+=sacc; \
    if(GK){DMA_K((t)+3,sl_cur);} if(GV){DMA_V((t)+1,sl_next);} \
    CMASK(C0,C1,t); \
    { float a=MX3(C0[0],C0[1],C1[0]),b=MX3(C0[2],C0[3],C1[1]); a=MX3(a,C1[2],C1[3]); \
      _Pragma("unroll") for(int r=4;r<16;r+=4){a=MX3(a,C0[r],C0[r+1]);b=MX3(b,C0[r+2],C0[r+3]);a=MX3(a,C1[r],C1[r+1]);b=MX3(b,C1[r+2],C1[r+3]);} \
      float rm=__builtin_fmaxf(a,b); { auto rr=__builtin_amdgcn_permlane32_swap(__float_as_uint(rm),__float_as_uint(rm),false,false); rm=__builtin_fmaxf(__uint_as_float(rr[0]),__uint_as_float(rr[1])); } \
      resc=false; \
      if(__builtin_expect(__any(rm>(float)THRL),0)){ const float dl=__builtin_fmaxf(rm,0.f); mhat+=dl; \
        _Pragma("unroll") for(int r=0;r<16;++r){C0[r]-=dl;C1[r]-=dl;} \
        if(!MOBA){ _Pragma("unroll") for(int r=0;r<16;++r)negm[r]=-mhat; asm volatile("":"+v"(negm)); } \
        const float f=__builtin_amdgcn_exp2f(-dl); l_reg*=f; if(hi==0)wsf[r32]=f; resc=true; } \
      if(MOBA){ if(resc||((((t)+1)&3)==0)){ const float nm=NEGM_FOR((t)+1); _Pragma("unroll") for(int r=0;r<16;++r)negm[r]=nm; asm volatile("":"+v"(negm)); } } } \
    SBAR(); \
    GAPB(o[0]=__builtin_amdgcn_mfma_f32_32x32x16_bf16(PAF(0),VFR(0),o[0],0,0,0), C0,0); \
    GAPB(o[1]=__builtin_amdgcn_mfma_f32_32x32x16_bf16(PAF(0),VFR(4),o[1],0,0,0), C0,4); \
    KRD(GL,0); GAPB(o[0]=__builtin_amdgcn_mfma_f32_32x32x16_bf16(PAF(1),VFR(1),o[0],0,0,0), C0,8); \
    KRD(GL,1); GAPB(o[1]=__builtin_amdgcn_mfma_f32_32x32x16_bf16(PAF(1),VFR(5),o[1],0,0,0), C0,12); \
    KRD(GL,2); GAPB(o[0]=__builtin_amdgcn_mfma_f32_32x32x16_bf16(PAF(2),VFR(2),o[0],0,0,0), C1,0); \
    KRD(GL,3); GAPB(o[1]=__builtin_amdgcn_mfma_f32_32x32x16_bf16(PAF(2),VFR(6),o[1],0,0,0), C1,4); \
    GAPB(o[0]=__builtin_amdgcn_mfma_f32_32x32x16_bf16(PAF(3),VFR(3),o[0],0,0,0), C1,8); \
    GAPB(o[1]=__builtin_amdgcn_mfma_f32_32x32x16_bf16(PAF(3),VFR(7),o[1],0,0,0), C1,12); \
    }while(0)
  int t=1;
  #undef CMASK
  #define CMASK(P0,P1,t) do{}while(0)
  for(;t+5<NT;t+=2){
    STEP(pB0,pB1,pA0,pA1,t,true,true,true);     WAIT_BAR(2); RESC(); ROT();
    STEP(pA0,pA1,pB0,pB1,t+1,true,true,true);   WAIT_BAR(2); RESC(); ROT();
  }
  #undef CMASK
  #define CMASK(P0,P1,t) do{ if(MOBA){int jb_=(t)-(NT-4); if(jb_>=0)cmask(P0,P1,jb_,qrel,hi);} }while(0)
  #define ENDW(tt) do{ if((tt)+3<NT){WAIT_BAR(2);} else if((tt)+2<NT){WAIT_BAR(1);} else {WAIT_BAR(0);} }while(0)
  for(;t+1<NT;t+=2){
    STEP(pB0,pB1,pA0,pA1,t,(t+3<NT),(t+1<NT),(t+1<NT));       ENDW(t);   RESC(); ROT();
    STEP(pA0,pA1,pB0,pB1,t+1,(t+4<NT),(t+2<NT),(t+2<NT));     ENDW(t+1); RESC(); ROT();
  }
  STEP(pB0,pB1,pA0,pA1,NT-1,false,false,false); RESC();
  { float sacc=pB0[0]+pB0[1]; _Pragma("unroll") for(int r=2;r<16;++r)sacc+=pB0[r]; _Pragma("unroll") for(int r=0;r<16;++r)sacc+=pB1[r]; l_reg+=sacc;
    pw0=(u32x4){PKW(pB0,0),PKW(pB0,2),PKW(pB0,4),PKW(pB0,6)};pw1=(u32x4){PKW(pB0,8),PKW(pB0,10),PKW(pB0,12),PKW(pB0,14)};pw2=(u32x4){PKW(pB1,0),PKW(pB1,2),PKW(pB1,4),PKW(pB1,6)};pw3=(u32x4){PKW(pB1,8),PKW(pB1,10),PKW(pB1,12),PKW(pB1,14)};
    SBAR(); pv(o,vb0+sl_cur,PAF(0),PAF(1),PAF(2),PAF(3)); }
  #undef PKW
  #undef PAF
  #undef VFR
  #undef PIN
  #undef MX3
  #undef GAPA
  #undef GAPB
  #undef EX
  #undef VRD
  #undef KRD
  #undef STEP
  #undef ENDW
  {auto rr=__builtin_amdgcn_permlane32_swap(__float_as_uint(l_reg),__float_as_uint(l_reg),false,false);l_reg=__uint_as_float(rr[0])+__uint_as_float(rr[1]);}
  if(hi==0)wsf[32+r32]=l_reg;asm volatile("s_waitcnt lgkmcnt(0)":::"memory");
  float rli[16];
  #pragma unroll
  for(int r=0;r<16;++r)rli[r]=__builtin_amdgcn_rcpf(wsf[32+crow(r,hi)]);
  bf16*Ow=Ou+(long)(wid*QBLK)*OP;
  { bf16*stg=(bf16*)(shm+LDS_OST)+wid*2048;
    #pragma unroll
    for(int r=0;r<16;++r){const int orow=crow(r,hi);
      #pragma unroll
      for(int d0=0;d0<2;++d0)stg[orow*64+d0*32+r32]=(bf16)(cvtpk(o[d0][r]*rli[r],0.f)&0xffffu);}
    asm volatile("s_waitcnt lgkmcnt(0)":::"memory");
    #pragma unroll
    for(int i=0;i<4;++i){const int row=i*8+(lane>>3),ch=lane&7; const u32x4 v=*(const u32x4*)(stg+row*64+ch*8); *(u32x4*)(Ow+(long)row*OP+ch*8)=v;} }
  asm volatile("s_waitcnt lgkmcnt(0)\n\ts_barrier":::"memory");
  #undef DMA_K
  #undef DMA_V
  #undef CMASK
  #undef START
  #undef RESC
  #undef ROT
  #undef NEGM_FOR
}
#undef SBAR
#undef WAIT_BAR
}

namespace ret_body {
using attn_body::s16x4; using attn_body::f32x16; using attn_body::glds16; using attn_body::pv; using attn_body::crow;
constexpr int KVF_BYTES = 64 * 64 * 4;
__device__ __forceinline__ void kv_unit(const bf16* KR, const bf16* VR, float* KVF, int b, int h, int cp, char* shm) {
  const int tid = opaque((int)threadIdx.x), lane = tid & 63, r32 = lane & 31, hi = lane >> 5; const int wid = __builtin_amdgcn_readfirstlane(tid >> 6);
  const unsigned lds0 = (unsigned)(uintptr_t)shm;
  const size_t rowb = (size_t)b * SEQ + (size_t)cp * 256;
  const long voff = (long)(16 * (wid & 3) + (lane >> 2)) * 256 + h * 64 + (wid >> 2) * 32 + (lane & 3) * 8;
#pragma unroll
  for (int c = 0; c < 2; ++c)
#pragma unroll
    for (int tl = 0; tl < 2; ++tl) {
      const size_t r0 = rowb + c * 128 + tl * 64;
      glds16(KR + r0 * 256 + voff, (unsigned)__builtin_amdgcn_readfirstlane(lds0 + ((c * 2 + 0) * 2 + tl) * 8192 + wid * 1024));
      glds16(VR + r0 * 256 + voff, (unsigned)__builtin_amdgcn_readfirstlane(lds0 + ((c * 2 + 1) * 2 + tl) * 8192 + wid * 1024));
    }
  asm volatile("s_waitcnt vmcnt(0) lgkmcnt(0)\n\ts_barrier" ::: "memory");
  const int c = wid >> 2, dkb = (wid >> 1) & 1, dvb = wid & 1;
  const int vb = (int)lds0 + ((lane >> 4) & 1) * 32 + (lane & 3) * 8 + (4 * hi + ((lane & 15) >> 2)) * 64;
  f32x16 acc = f32x16{};
#pragma unroll
  for (int tl = 0; tl < 2; ++tl) {
    s16x4 alo[4], ahi[4], blo[4], bhi[4];
    const int ka = vb + ((c * 2 + 0) * 2 + tl) * 8192 + dkb * 4096, va = vb + ((c * 2 + 1) * 2 + tl) * 8192 + dvb * 4096;
#pragma unroll
    for (int ks = 0; ks < 4; ++ks) {
      asm volatile("ds_read_b64_tr_b16 %0,%1 offset:%c2" : "=&v"(alo[ks]) : "v"(ka), "i"(ks * 1024) : "memory");
      asm volatile("ds_read_b64_tr_b16 %0,%1 offset:%c2" : "=&v"(ahi[ks]) : "v"(ka), "i"(ks * 1024 + 512) : "memory");
      asm volatile("ds_read_b64_tr_b16 %0,%1 offset:%c2" : "=&v"(blo[ks]) : "v"(va), "i"(ks * 1024) : "memory");
      asm volatile("ds_read_b64_tr_b16 %0,%1 offset:%c2" : "=&v"(bhi[ks]) : "v"(va), "i"(ks * 1024 + 512) : "memory");
    }
    asm volatile("s_waitcnt lgkmcnt(0)" ::: "memory"); __builtin_amdgcn_sched_barrier(0);
#pragma unroll
    for (int ks = 0; ks < 4; ++ks) {
      const bf16x8 af = (bf16x8){alo[ks][0], alo[ks][1], alo[ks][2], alo[ks][3], ahi[ks][0], ahi[ks][1], ahi[ks][2], ahi[ks][3]};
      const bf16x8 bfr = (bf16x8){blo[ks][0], blo[ks][1], blo[ks][2], blo[ks][3], bhi[ks][0], bhi[ks][1], bhi[ks][2], bhi[ks][3]};
      acc = __builtin_amdgcn_mfma_f32_32x32x16_bf16(af, bfr, acc, 0, 0, 0);
    }
  }
  const float lgam = __builtin_amdgcn_logf(1.0f - __builtin_amdgcn_exp2f(-5.0f - (float)h));
  const float g127 = __builtin_amdgcn_exp2f(lgam * 127.0f);
  float* outp = KVF + ((size_t)((b * 4 + h) * 32 + cp * 2 + c)) * 4096 + dvb * 32 + r32;
#pragma unroll
  for (int r = 0; r < 16; ++r) outp[(size_t)(dkb * 32 + crow(r, hi)) * 64] = acc[r] * g127;
  asm volatile("s_waitcnt lgkmcnt(0)\n\ts_barrier" ::: "memory");
}

__device__ __forceinline__ void out_unit(const bf16* QR, const bf16* KR, const bf16* VR, const bf16* GR, const float* KVF, const float* rgain, bf16* Y, int b, int h, int cp, char* shm) {
  const int tid = opaque((int)threadIdx.x), lane = tid & 63, r32 = lane & 31, hi = lane >> 5; const int wid = __builtin_amdgcn_readfirstlane(tid >> 6);
  const unsigned lds0 = (unsigned)(uintptr_t)shm;
  constexpr int L_K = 0, L_V = 32768, L_S = 65536, L_O = 81920;
  const size_t rowb = (size_t)b * SEQ + (size_t)cp * 256;
  const long koff = (long)lane * 256 + h * 64 + wid * 8;
  const long voff = (long)(16 * (wid & 3) + (lane >> 2)) * 256 + h * 64 + (wid >> 2) * 32 + (lane & 3) * 8;
#pragma unroll
  for (int tl = 0; tl < 4; ++tl) {
    const size_t r0 = rowb + tl * 64;
    glds16(KR + r0 * 256 + koff, (unsigned)__builtin_amdgcn_readfirstlane(lds0 + L_K + tl * 8192 + wid * 1024));
    glds16(VR + r0 * 256 + voff, (unsigned)__builtin_amdgcn_readfirstlane(lds0 + L_V + tl * 8192 + wid * 1024));
  }
  {
    const float lgam = __builtin_amdgcn_logf(1.0f - __builtin_amdgcn_exp2f(-5.0f - (float)h));
    const float lgc = lgam * 128.0f;
    const int n0 = 2 * cp;
    int mlo = n0 - 1 - (int)(34.0f / (-lgc)); if (mlo < 0) mlo = 0;
    const float* kvp = KVF + ((size_t)((b * 4 + h) * 32)) * 4096 + tid * 8;
    f32x4 s0 = {0.f, 0.f, 0.f, 0.f}, s1 = {0.f, 0.f, 0.f, 0.f};
    int m = mlo;
    for (; m + 8 <= n0; m += 8) {
      f32x4 a[8], c4[8];
#pragma unroll
      for (int q = 0; q < 8; ++q) { a[q] = *(const f32x4*)(kvp + (size_t)(m + q) * 4096); c4[q] = *(const f32x4*)(kvp + (size_t)(m + q) * 4096 + 4); }
#pragma unroll
      for (int q = 0; q < 8; ++q) { const float w = __builtin_amdgcn_exp2f(lgc * (float)(n0 - 1 - m - q)); s0 += a[q] * w; s1 += c4[q] * w; }
    }
    for (; m + 4 <= n0; m += 4) {
      f32x4 a[4], c4[4];
#pragma unroll
      for (int q = 0; q < 4; ++q) { a[q] = *(const f32x4*)(kvp + (size_t)(m + q) * 4096); c4[q] = *(const f32x4*)(kvp + (size_t)(m + q) * 4096 + 4); }
#pragma unroll
      for (int q = 0; q < 4; ++q) { const float w = __builtin_amdgcn_exp2f(lgc * (float)(n0 - 1 - m - q)); s0 += a[q] * w; s1 += c4[q] * w; }
    }
    for (; m < n0; ++m) {
      const float w = __builtin_amdgcn_exp2f(lgc * (float)(n0 - 1 - m));
      const f32x4 a = *(const f32x4*)(kvp + (size_t)m * 4096), c4 = *(const f32x4*)(kvp + (size_t)m * 4096 + 4);
      s0 += a * w; s1 += c4 * w;
    }
    const int dk = tid >> 3, dv = 8 * (tid & 7);
    char* sp = shm + L_S + (dv >> 5) * 4096 + dk * 64 + (dv & 31) * 2;
    u32x4 w0; w0.x = cvtpk(s0[0], s0[1]); w0.y = cvtpk(s0[2], s0[3]); w0.z = cvtpk(s1[0], s1[1]); w0.w = cvtpk(s1[2], s1[3]);
    *(u32x4*)sp = w0;
    const float dc = __builtin_amdgcn_exp2f(lgc);
    const f32x4 a = *(const f32x4*)(kvp + (size_t)n0 * 4096), c4 = *(const f32x4*)(kvp + (size_t)n0 * 4096 + 4);
    s0 = s0 * dc + a; s1 = s1 * dc + c4;
    u32x4 w1; w1.x = cvtpk(s0[0], s0[1]); w1.y = cvtpk(s0[2], s0[3]); w1.z = cvtpk(s1[0], s1[1]); w1.w = cvtpk(s1[2], s1[3]);
    *(u32x4*)(sp + 8192) = w1;
  }
  const int c = wid >> 2, wq = wid & 3;
  const bf16* Qw = QR + (rowb + c * 128 + wq * 32 + r32) * 256 + h * 64;
  bf16x8 qr[4]; u32x4 qa[4];
#pragma unroll
  for (int d0 = 0; d0 < 4; ++d0) qr[d0] = *reinterpret_cast<const bf16x8*>(Qw + d0 * 16 + hi * 8);
#pragma unroll
  for (int k = 0; k < 4; ++k) { const u32x2 lo = *(const u32x2*)(Qw + 16 * k + 4 * hi), hi2 = *(const u32x2*)(Qw + 16 * k + 8 + 4 * hi); qa[k] = (u32x4){lo.x, lo.y, hi2.x, hi2.y}; }
  asm volatile("s_waitcnt vmcnt(0) lgkmcnt(0)\n\ts_barrier" ::: "memory");
  const int vb = (int)lds0 + ((lane >> 4) & 1) * 32 + (lane & 3) * 8 + (4 * hi + ((lane & 15) >> 2)) * 64;
  f32x16 o[2]; o[0] = f32x16{}; o[1] = f32x16{};
  pv(o, vb + L_S + c * 8192, __builtin_bit_cast(bf16x8, qa[0]), __builtin_bit_cast(bf16x8, qa[1]), __builtin_bit_cast(bf16x8, qa[2]), __builtin_bit_cast(bf16x8, qa[3]));
  { const float gam = 1.0f - __builtin_amdgcn_exp2f(-5.0f - (float)h);
#pragma unroll
    for (int d0 = 0; d0 < 2; ++d0)
#pragma unroll
      for (int r = 0; r < 16; ++r) o[d0][r] *= gam; }
  const f32x16 zero = f32x16{};
  const int irow = wq * 32 + r32;
  for (int tl = 0; tl <= (wq >> 1); ++tl) {
    f32x16 p0, p1;
    attn_body::qkt(p0, p1, shm + L_K + (c * 2 + tl) * 8192, qr, zero, r32, hi);
    asm volatile("s_nop 15\n\ts_nop 7" : "+v"(p0), "+v"(p1));
#pragma unroll
    for (int r = 0; r < 16; ++r) { const int kj = 64 * tl + crow(r, hi); if (kj > irow) p0[r] = 0.f; if (kj + 32 > irow) p1[r] = 0.f; }
    u32x4 pw0, pw1, pw2, pw3;
    pw0 = (u32x4){cvtpk(p0[0], p0[1]), cvtpk(p0[2], p0[3]), cvtpk(p0[4], p0[5]), cvtpk(p0[6], p0[7])}; pw1 = (u32x4){cvtpk(p0[8], p0[9]), cvtpk(p0[10], p0[11]), cvtpk(p0[12], p0[13]), cvtpk(p0[14], p0[15])};
    pw2 = (u32x4){cvtpk(p1[0], p1[1]), cvtpk(p1[2], p1[3]), cvtpk(p1[4], p1[5]), cvtpk(p1[6], p1[7])}; pw3 = (u32x4){cvtpk(p1[8], p1[9]), cvtpk(p1[10], p1[11]), cvtpk(p1[12], p1[13]), cvtpk(p1[14], p1[15])};
    __builtin_amdgcn_sched_barrier(0);
    pv(o, vb + L_V + (c * 2 + tl) * 8192, __builtin_bit_cast(bf16x8, pw0), __builtin_bit_cast(bf16x8, pw1), __builtin_bit_cast(bf16x8, pw2), __builtin_bit_cast(bf16x8, pw3));
  }
  asm volatile("s_waitcnt lgkmcnt(0)\n\ts_barrier" ::: "memory");
  { float* stg = (float*)(shm + L_O) + wid * 2048;
#pragma unroll
    for (int r = 0; r < 16; ++r) { const int orow = crow(r, hi);
#pragma unroll
      for (int d0 = 0; d0 < 2; ++d0) stg[orow * 64 + d0 * 32 + r32] = o[d0][r]; }
    asm volatile("s_waitcnt lgkmcnt(0)" ::: "memory");
    const int row = lane >> 1, half = lane & 1;
    const f32x4* sr = (const f32x4*)(stg + row * 64 + half * 32);
    f32x4 v[8]; float ss = 0.f;
#pragma unroll
    for (int i = 0; i < 8; ++i) { v[i] = sr[i]; ss += (v[i][0] * v[i][0] + v[i][1] * v[i][1]) + (v[i][2] * v[i][2] + v[i][3] * v[i][3]); }
    ss += __shfl_xor(ss, 1);
    const float rstd = 1.0f / sqrtf(ss * (1.0f / 64.0f) + EPS);
    const size_t grow = rowb + c * 128 + wq * 32 + row;
    const u32x4* gp = (const u32x4*)(GR + grow * 256 + h * 64 + half * 32);
    const f32x4* rg = (const f32x4*)(rgain + h * 64 + half * 32);
    u32x4* yp = (u32x4*)(Y + grow * DM + 512 + h * 64 + half * 32);
#pragma unroll
    for (int i = 0; i < 4; ++i) {
      const u32x4 gw = gp[i]; const f32x4 g0 = rg[2 * i], g1 = rg[2 * i + 1]; const f32x4 a = v[2 * i] * rstd * g0, c4 = v[2 * i + 1] * rstd * g1;
      u32x4 w; w.x = cvtpk(a[0] * bflo(gw.x), a[1] * bfhi(gw.x)); w.y = cvtpk(a[2] * bflo(gw.y), a[3] * bfhi(gw.y)); w.z = cvtpk(c4[0] * bflo(gw.z), c4[1] * bfhi(gw.z)); w.w = cvtpk(c4[2] * bflo(gw.w), c4[3] * bfhi(gw.w));
      yp[i] = w;
    }
  }
  asm volatile("s_waitcnt lgkmcnt(0)\n\ts_barrier" ::: "memory");
}
}

#define XB_TMO      128
#define XB_XCNT(j)  (256  + 64 * (j))
#define XB_XSUB(j)  (1280 + 64 * (j))
#define XB_XGEN(j)  (2304 + 64 * (j))
#define XB_TOP      3328
#define XB_TOPGEN   3392
#define XCD_BAR_WORDS 3456
#define XB_SPIN_CAP (1u << 18)
__device__ __forceinline__ unsigned xb_ld(unsigned* p)              { return __hip_atomic_load(p, __ATOMIC_RELAXED, __HIP_MEMORY_SCOPE_AGENT); }
__device__ __forceinline__ unsigned xb_add(unsigned* p, unsigned v) { return __hip_atomic_fetch_add(p, v, __ATOMIC_RELAXED, __HIP_MEMORY_SCOPE_AGENT); }
__device__ __forceinline__ unsigned xb_xcc_id() { return (unsigned)__builtin_amdgcn_s_getreg((3 << 11) | 20) & 0xFu; }
#define XB_SPIN(cond, bar) do { unsigned _sp = 0; while (cond) { __builtin_amdgcn_s_sleep(1); \
    if ((++_sp & 255u) == 0u) { if (xb_ld(&(bar)[XB_TMO])) break; if (_sp > XB_SPIN_CAP) { atomicAdd(&(bar)[XB_TMO], 1u); break; } } } } while (0)
struct XcdBarrier { unsigned* bar; unsigned x; volatile LAS unsigned* st; };
__device__ __forceinline__ XcdBarrier xcd_barrier_post(unsigned* bar, volatile LAS unsigned* st) {
    XcdBarrier b; b.bar = bar; b.x = xb_xcc_id(); b.st = st;
    if (threadIdx.x == 0) (void)xb_add(&bar[XB_XCNT(b.x)], 1u);
    return b;
}
__device__ __forceinline__ void xcd_barrier_complete(unsigned* bar, unsigned x, unsigned& nloc, unsigned& nx) {
    const unsigned G = gridDim.x * gridDim.y * gridDim.z;
    unsigned sum, cnt, mine, sp = 0u;
    for (;;) {
        sum = 0u; cnt = 0u; mine = 0u;
#pragma unroll
        for (unsigned j = 0; j < 16; ++j) { const unsigned c = xb_ld(&bar[XB_XCNT(j)]); sum += c; cnt += (c > 0u) ? 1u : 0u; mine = (j == x) ? c : mine; }
        if (sum == G) break;
        __builtin_amdgcn_s_sleep(1);
        if ((++sp & 255u) == 0u) { if (xb_ld(&bar[XB_TMO])) break; if (sp > XB_SPIN_CAP) { atomicAdd(&bar[XB_TMO], 1u); break; } }
    }
    nloc = mine > 0u ? mine : 1u; nx = cnt > 0u ? cnt : 1u;
}
__device__ __forceinline__ void xcd_barrier(const XcdBarrier& b) {
    asm volatile("s_waitcnt vmcnt(0)" ::: "memory");
    __syncthreads();
    if (threadIdx.x == 0) {
        unsigned* bar = b.bar;
        __builtin_amdgcn_s_waitcnt(0);
        unsigned nloc = b.st[0], nx = b.st[1];
        if (nloc == 0u) { xcd_barrier_complete(bar, b.x, nloc, nx); b.st[0] = nloc; b.st[1] = nx; }
        const unsigned old = xb_add(&bar[XB_XSUB(b.x)], 1u);
        const unsigned gen = old / nloc;
        if (old + 1u == (gen + 1u) * nloc) {
            __builtin_amdgcn_fence(__ATOMIC_RELEASE, "agent");
            asm volatile("s_waitcnt vmcnt(0)" ::: "memory");
            const unsigned og = xb_add(&bar[XB_TOP], 1u);
            const unsigned tg = og / nx;
            if (og + 1u == (tg + 1u) * nx) xb_add(&bar[XB_TOPGEN], 1u);
            else XB_SPIN(xb_ld(&bar[XB_TOPGEN]) == tg, bar);
            __builtin_amdgcn_fence(__ATOMIC_ACQUIRE, "agent");
            xb_add(&bar[XB_XGEN(b.x)], 1u);
            asm volatile("s_waitcnt vmcnt(0)" ::: "memory");
        } else {
            XB_SPIN(xb_ld(&bar[XB_XGEN(b.x)]) == gen, bar);
            __builtin_amdgcn_fence(__ATOMIC_ACQUIRE, "agent");
            asm volatile("s_waitcnt vmcnt(0)" ::: "memory");
        }
    }
    __syncthreads();
}

__global__ void __launch_bounds__(NTHREADS, 2) fwd_kernel(Args args) {
    extern __shared__ __attribute__((aligned(16))) unsigned char lds_raw[];
    LAS unsigned char* lds = (LAS unsigned char*)lds_raw;
    cg::grid_group grid = cg::this_grid();
    const int tid0 = threadIdx.x, wave = __builtin_amdgcn_readfirstlane(tid0 >> 6);
#define PHASE_LANES const int tid = opaque(tid0), lane = tid & 63; (void)lane; (void)tid
    const int G = gridDim.x, bx = blockIdx.x;
    const int vcu = (G % 8 == 0) ? (bx % 8) * (G / 8) + bx / 8 : bx;
    const int gw = vcu * NWAVES + wave, NGW = G * NWAVES;
    unsigned char* const ws = args.ws;
#define WSP(type, off) ((type*)(ws + (off)))
    if (tid0 < 64) ((LAS unsigned*)(lds + LDS_MISC))[tid0] = 0u;
    __syncthreads();
    unsigned long long tsA_ = 0, tsB_ = 0; (void)tsA_; (void)tsB_;
    TSTAMP(0);
    const XcdBarrier xbar = xcd_barrier_post(WSP(unsigned, WS_BAR), (volatile LAS unsigned*)(lds + LDS_MISC));
#define GRID_BAR() xcd_barrier(xbar)
    REPN(0) {
        PHASE_LANES;
        LAS float* scr = (LAS float*)(lds + wave * 16384);
        const float* x = args.in[0]; const float* mem = args.in[1]; const float* g_attn = args.in[2]; const float* w_in = args.in[3]; const float* g_mem = args.in[7];
        const float* w_mem_kv = args.in[8]; const float* w_out = args.in[11]; const float* g_ffn = args.in[12]; const float* w_router = args.in[13];
        bf16* WIN_T = WSP(bf16, WS_WIN); bf16* WMEM_T = WSP(bf16, WS_WMEM); bf16* WOUT_T = WSP(bf16, WS_WOUT);
        bf16* XN = WSP(bf16, WS_XN); bf16* MEMN = WSP(bf16, WS_MEMN); float* WRG = WSP(float, WS_WRG);
        constexpr int I0 = 16 * 88, I1 = 16 * 16, I2 = 16 * 32, NIT = I0 + I1 + I2;
        for (int it = gw; it < NIT; it += NGW) {
            int r = it;
            if (r < I0) { const int nb = r % 88, kb = r / 88; transpose_item(w_in, NIN, WIN_T, headperm_row(nb * 32), scr, kb * 64, nb * 32, lane); continue; } r -= I0;
            if (r < I1) { const int nb = r % 16, kb = r / 16; transpose_item(w_mem_kv, 512, WMEM_T, headperm_row(nb * 32), scr, kb * 64, nb * 32, lane); continue; } r -= I1;
            { const int nb = r % 32, kb = r / 32; transpose_item(w_out, 1024, WOUT_T, nb * 32, scr, kb * 64, nb * 32, lane); }
        }
        for (int m = gw * 2; m < T + MROWS; m += NGW * 2) {
            if (m < T) rms_row2_to_bf16(x + (size_t)m * DM, g_attn, XN + (size_t)m * DM, lane, WSP(float, WS_IRS) + m);
            else rms_row2_to_bf16(mem + (size_t)(m - T) * DM, g_mem, MEMN + (size_t)(m - T) * DM, lane, nullptr);
        }
        for (int i = bx * NTHREADS + tid; i < DM * NEXP; i += G * NTHREADS) WRG[i] = g_ffn[i >> 5] * w_router[i];
        for (int i = bx * NTHREADS + tid; i < NB * 16 * 8 * 64; i += G * NTHREADS) WSP(float, WS_KMEAN)[i] = 0.f;
    }
    if (args.pad0 == 0x7fffffff) grid.sync();
    GRID_BAR();
    TSTAMP(1);

    REPN(1) {
        EpiProj E{ws, args.in[4], args.in[5], args.in[9], args.in[10]};
        if (G == 256) {
            SchedProj10 S{G, bx, (const char*)(ws + WS_XN), (const char*)(ws + WS_WIN)};
            pg8::gemm_phase<EpiProj, SchedProj10>(lds, S, E);
        } else {
            SchedProj S{G, bx, (const char*)(ws + WS_XN), (const char*)(ws + WS_MEMN), (const char*)(ws + WS_WIN), (const char*)(ws + WS_WMEM)};
            pg8::gemm_phase<EpiProj, SchedProj>(lds, S, E);
        }
    }
    GRID_BAR();
    TSTAMP(2);

#ifndef NAIVE_RET
    REPN(2) {
        if (G == 256) {
            if (bx < 144) {
                SchedProjOne S{bx, (const char*)(ws + WS_XN), (const char*)(ws + WS_MEMN), (const char*)(ws + WS_WIN), (const char*)(ws + WS_WMEM)};
                EpiProj E{ws, args.in[4], args.in[5], args.in[9], args.in[10]};
                pg8::gemm_phase<EpiProj, SchedProjOne>(lds, S, E);
            } else {
                for (int u = bx - 144; u < 512; u += 112) { const int bh = u >> 4, cp = u & 15;
                    ret_body::kv_unit(WSP(bf16, WS_KR), WSP(bf16, WS_VR), WSP(float, WS_RET), bh >> 2, bh & 3, cp, (char*)lds_raw); }
            }
        } else {
            for (int i = 0; i < 2; ++i) { const int u = vcu * 2 + i, bh = u >> 4, cp = u & 15;
                ret_body::kv_unit(WSP(bf16, WS_KR), WSP(bf16, WS_VR), WSP(float, WS_RET), bh >> 2, bh & 3, cp, (char*)lds_raw); }
        }
    }
    GRID_BAR();
    TSTAMP(3);
#endif
    REPN(20) { PHASE_LANES;
#if defined(NAIVE_MOBA) || defined(NAIVE_RET) || defined(NAIVE_MEM)
#error naive mixers are no longer wired in
#endif
    unsigned* qmix = WSP(unsigned, WS_CTL) + 64 + 256 * rep_; unsigned* qconv = WSP(unsigned, WS_CTL) + 128 + 256 * rep_;
    volatile LAS int* qslot = (volatile LAS int*)(lds + LDS_MISC + 64);
    const bool conv_first = (vcu & 3) == 3;
    bool mix_done = false, conv_done = false;
    while (!(mix_done && conv_done)) {
        const int kind = conv_first ? (conv_done ? 0 : 1) : (mix_done ? 1 : 0);
        if (tid == 0) qslot[0] = (int)__hip_atomic_fetch_add(kind ? qconv : qmix, 1u, __ATOMIC_RELAXED, __HIP_MEMORY_SCOPE_AGENT);
        __syncthreads();
        const int u = qslot[0];
        __syncthreads();
        if (kind == 1) {
            if (u >= 1536) { conv_done = true; continue; }
            convert_chunk(u, args.in[15], args.in[17], WSP(unsigned char, WS_W1), WSP(unsigned char, WS_W2), (LAS float*)(lds + wave * 16384), wave, lane);
            __syncthreads();
        } else if (u >= 2048) { mix_done = true; }
        else if (u < 1024) {
            const int nb = 15 - (u >> 6), bh = u & 63, b = bh >> 3, h = bh & 7;
            const size_t row0 = (size_t)b * SEQ + (size_t)nb * 256;
            attn_body::attn_unit<8, 512, 1024, true>(WSP(bf16, WS_QA) + row0 * 512 + h * 64, WSP(bf16, WS_KA) + (size_t)b * SEQ * 512 + h * 64, WSP(bf16, WS_VA) + (size_t)b * SEQ * 512 + h * 64,
                                                     WSP(bf16, WS_Y) + row0 * DM + h * 64, 4 * nb + 4, nb, WSP(float, WS_KMEAN) + ((size_t)b * 16 * 8 + h) * 64, (char*)lds_raw);
        } else if (u < 1536) {
            const int idx = u - 1024, bh = idx >> 4, cp = idx & 15;
            ret_body::out_unit(WSP(bf16, WS_QR), WSP(bf16, WS_KR), WSP(bf16, WS_VR), WSP(bf16, WS_GR), WSP(float, WS_RET), args.in[6], WSP(bf16, WS_Y), bh >> 2, bh & 3, cp, (char*)lds_raw);
        } else {
            const int idx = u - 1536, bh = idx >> 4, qb = idx & 15, b = bh >> 2, h = bh & 3;
            const size_t row0 = (size_t)b * SEQ + (size_t)qb * 256;
            attn_body::attn_unit<8, 256, 1024, false>(WSP(bf16, WS_QM) + row0 * 256 + h * 64, WSP(bf16, WS_MK) + (size_t)b * MEMLEN * 256 + h * 64, WSP(bf16, WS_MV) + (size_t)b * MEMLEN * 256 + h * 64,
                                                      WSP(bf16, WS_Y) + row0 * DM + 768 + h * 64, 4, 0, nullptr, (char*)lds_raw);
        }
    }
    }
    GRID_BAR();
    TSTAMP(4);

    REPN(3) {
        SchedPlain S{G, bx, 128, 4, (const char*)(ws + WS_Y), (const char*)(ws + WS_WOUT)};
        EpiOut E{WSP(bf16, WS_XN), WSP(float, WS_IRS), args.in[2], WSP(bf16, WS_X1B), WSP(float, WS_SSQ)};
#ifndef NO_G2
        pg8::gemm_phase<EpiOut, SchedPlain>(lds, S, E);
#endif
    }
    GRID_BAR();
    TSTAMP(5);

    REPN(4) {
        PHASE_LANES;
        const bf16* x1b = WSP(bf16, WS_X1B); const float* b_router = args.in[14];
        float* WRG = WSP(float, WS_WRG); float* SSQ = WSP(float, WS_SSQ); int* TOPI = WSP(int, WS_TOPI); float* TOPW = WSP(float, WS_TOPW); int* LRANK = WSP(int, WS_LRANK); int* LCOUNT = WSP(int, WS_LCOUNT);
        unsigned char* XN2 = WSP(unsigned char, WS_XN2); const float* g_ffn = args.in[12];
        if (bx == 0 && tid < 64) ((u32x4*)(XN2 + (size_t)T * DM))[tid] = (u32x4){0u, 0u, 0u, 0u};
        LAS float* wl = (LAS float*)(lds);
        LAS float* lg = (LAS float*)(lds + 131072) + wave * (16 * 33);
        LAS int* hist = (LAS int*)(lds + 131072 + 16896);
        { f32x4 w4[16];
#pragma unroll
          for (int q = 0; q < 16; ++q) w4[q] = ((const f32x4*)WRG)[tid + q * NTHREADS];
#pragma unroll
          for (int q = 0; q < 16; ++q) { const int i4 = tid + q * NTHREADS, r = i4 >> 3, e = (i4 & 7) * 4; *(LAS f32x4*)(wl + r * 32 + (e ^ (((r >> 5) & 1) << 4))) = w4[q]; } }
        if (tid < 32) hist[tid] = 0;
        __syncthreads();
        const int tpw = T / (G * NWAVES);
        for (int tb = 0; tb < tpw; tb += 16) {
            const int t0 = (bx * NWAVES + wave) * tpw + tb;
            const int i = lane & 15, kq = lane >> 4;
            f32x4 a0 = {0.f, 0.f, 0.f, 0.f}, a1 = {0.f, 0.f, 0.f, 0.f};
            const bf16* xr = x1b + (size_t)(t0 + i) * DM + 32 * kq;
            const LAS float* wb = wl + (32 * kq) * 32 + (i ^ ((kq & 1) << 4));
            const LAS float* wb1 = wl + (32 * kq) * 32 + ((i ^ ((kq & 1) << 4)) ^ 16);
            float rstd;
            { const f32x4* sp = (const f32x4*)(SSQ + (size_t)(t0 + i) * 16); const f32x4 s0 = sp[0], s1 = sp[1], s2 = sp[2], s3 = sp[3];
              const float ss = ((s0[0] + s0[1]) + (s0[2] + s0[3])) + ((s1[0] + s1[1]) + (s1[2] + s1[3])) + ((s2[0] + s2[1]) + (s2[2] + s2[3])) + ((s3[0] + s3[1]) + (s3[2] + s3[3]));
              rstd = 1.0f / sqrtf(ss * (1.0f / DM) + EPS); }
            unsigned char* xo = XN2 + (size_t)(t0 + i) * DM + 16 * kq;
            const float* gp = g_ffn + 32 * kq;
#pragma unroll 2
            for (int c = 0; c < 8; ++c) {
                float av[32];
#pragma unroll
                for (int j = 0; j < 4; ++j) { const u32x4 xw = *(const u32x4*)(xr + 128 * c + 8 * j);
                    av[8 * j] = bflo(xw.x); av[8 * j + 1] = bfhi(xw.x); av[8 * j + 2] = bflo(xw.y); av[8 * j + 3] = bfhi(xw.y); av[8 * j + 4] = bflo(xw.z); av[8 * j + 5] = bfhi(xw.z); av[8 * j + 6] = bflo(xw.w); av[8 * j + 7] = bfhi(xw.w); }
                { float nv[32];
#pragma unroll
                  for (int j = 0; j < 8; ++j) { const f32x4 g = *(const f32x4*)(gp + 128 * c + 4 * j); nv[4 * j] = av[4 * j] * rstd * g[0]; nv[4 * j + 1] = av[4 * j + 1] * rstd * g[1]; nv[4 * j + 2] = av[4 * j + 2] * rstd * g[2]; nv[4 * j + 3] = av[4 * j + 3] * rstd * g[3]; }
                  u32x4 p0, p1; fp6_pack32(nv, p0, p1);
                  *(u32x4*)(xo + 128 * c) = p0; *(u32x4*)(xo + 128 * c + 64) = p1; }
#pragma unroll
                for (int q = 0; q < 32; ++q) {
                    const float b0 = wb[(128 * c + q) * 32], b1v = wb1[(128 * c + q) * 32];
                    a0 = __builtin_amdgcn_mfma_f32_16x16x4f32(av[q], b0, a0, 0, 0, 0);
                    a1 = __builtin_amdgcn_mfma_f32_16x16x4f32(av[q], b1v, a1, 0, 0, 0);
                }
            }
#pragma unroll
            for (int r = 0; r < 4; ++r) { lg[(4 * kq + r) * 33 + i] = a0[r]; lg[(4 * kq + r) * 33 + 16 + i] = a1[r]; }
            LDS_WAIT(); asm volatile("" ::: "memory");
            if (lane < 16) {
                const int t = t0 + lane;
                float v[32];
#pragma unroll
                for (int e = 0; e < 32; ++e) v[e] = lg[lane * 33 + e] * rstd + b_router[e];
                int bi[4]; float bvv[4];
#pragma unroll
                for (int k = 0; k < 4; ++k) {
                    float best = -3e38f; int be = 0;
#pragma unroll
                    for (int e = 0; e < 32; ++e) { const bool take = v[e] > best; best = take ? v[e] : best; be = take ? e : be; }
                    bi[k] = be; bvv[k] = best;
#pragma unroll
                    for (int e = 0; e < 32; ++e) v[e] = (e == be) ? -3e38f : v[e];
                }
                const float e1 = __expf(bvv[1] - bvv[0]), e2 = __expf(bvv[2] - bvv[0]), e3 = __expf(bvv[3] - bvv[0]);
                const float inv = 1.0f / (1.0f + e1 + e2 + e3);
                const float wv[4] = {inv, e1 * inv, e2 * inv, e3 * inv};
#pragma unroll
                for (int k = 0; k < 4; ++k) {
                    const int rk = atomicAdd((int*)&hist[bi[k]], 1);
                    TOPI[t * 4 + k] = bi[k]; TOPW[t * 4 + k] = wv[k]; LRANK[t * 4 + k] = rk;
                }
            }
            LDS_WAIT(); asm volatile("" ::: "memory");
        }
        __syncthreads();
        if (tid < 32) LCOUNT[bx * 32 + tid] = hist[tid];
    }
    GRID_BAR();
    TSTAMP(6);

    REPN(5) {
        PHASE_LANES;
        int* TOPI = WSP(int, WS_TOPI); float* TOPW = WSP(float, WS_TOPW); int* LRANK = WSP(int, WS_LRANK); int* LCOUNT = WSP(int, WS_LCOUNT);
        int* POS = WSP(int, WS_POS); float* ROWW = WSP(float, WS_ROWW); int* PSTART = WSP(int, WS_PSTART); int* TILEEXP = WSP(int, WS_TILEEXP);
        LAS int* part = (LAS int*)(lds);
        LAS int* base = (LAS int*)(lds + 8192);
        {
            const int e = tid & 31, p = tid >> 5; int c = 0, pre = 0;
            const int wpp = (G + 15) / 16;
            for (int w = p * wpp; w < (p + 1) * wpp && w < G; ++w) { const int v = LCOUNT[w * 32 + e]; c += v; pre += (w < bx) ? v : 0; }
            part[p * 32 + e] = c; part[512 + p * 32 + e] = pre;
        }
        __syncthreads();
        if (tid < 32) { int c = 0, pre = 0; for (int p = 0; p < 16; ++p) { c += part[p * 32 + tid]; pre += part[512 + p * 32 + tid]; } part[1024 + tid] = c; part[1056 + tid] = pre; }
        __syncthreads();
        if (tid == 0) {
            int ps = 0;
            for (int e = 0; e < 32; ++e) {
                const int c = part[1024 + e], nt_ = (c + 255) >> 8;
                base[32 + e] = ps; base[e] = ps + part[1056 + e];
                if (bx == 0) PSTART[e] = ps;
                ps += nt_ * 256;
            }
            base[64] = ps; if (bx == 0) PSTART[32] = ps;
        }
        __syncthreads();
        if (bx == 1) {
            const int ntl = base[64] >> 8;
            for (int tl = tid; tl < ntl; tl += NTHREADS) { int e = 0;
#pragma unroll
                for (int q = 1; q < 32; ++q) e += (base[32 + q] <= tl * 256) ? 1 : 0;
                TILEEXP[tl] = e; }
        }
        int* ROWTOK = WSP(int, WS_ROWTOK);
        if (bx < 32) {
            const int c = part[1024 + bx], r0 = base[32 + bx] + c, r1 = base[32 + bx] + (((c + 255) >> 8) << 8);
            for (int r = r0 + tid; r < r1; r += NTHREADS) { ROWTOK[r] = T; ROWW[r] = 0.f; }
        }
        for (int a = tid; a < (T / G) * 4; a += NTHREADS) {
            const int ta = (bx * (T / G)) * 4 + a;
            const int e = TOPI[ta]; const int pos = base[e] + LRANK[ta];
            POS[ta] = pos; ROWTOK[pos] = ta >> 2; ROWW[pos] = TOPW[ta];
        }
    }
    GRID_BAR();
    TSTAMP(7);

    const int ntiles = WSP(int, WS_PSTART)[32] >> 8;
    REPN(6) {
        SchedMoe S{G, vcu, 8, ntiles, WSP(int, WS_TILEEXP), (const char*)(ws + WS_XN2), (const char*)(ws + WS_W1), (size_t)2048 * 1024, WSP(int, WS_ROWTOK)};
        EpiSwiglu E{args.in[16], WSP(unsigned char, WS_H)};
#ifndef NO_G3
        pg8::gemm_phase<EpiSwiglu, SchedMoe, true, true, true>(lds, S, E);
#endif
    }
    GRID_BAR();
    TSTAMP(8);
    REPN(7) {
        SchedMoe S{G, vcu, 4, ntiles, WSP(int, WS_TILEEXP), (const char*)(ws + WS_H), (const char*)(ws + WS_W2), (size_t)1024 * 1024, nullptr};
        EpiDown E{args.in[18], WSP(float, WS_ROWW), WSP(unsigned char, WS_XG)};
#ifndef NO_G4
        pg8::gemm_phase<EpiDown, SchedMoe, false, true>(lds, S, E);
#endif
    }
    GRID_BAR();
    TSTAMP(9);
    if (REP_PHASE == 9) { GRID_BAR(); GRID_BAR(); GRID_BAR(); GRID_BAR(); }
    REPN(8) { PHASE_LANES;
    float* out = args.out; const int* POS = WSP(int, WS_POS); const unsigned char* YE = WSP(unsigned char, WS_XG); const bf16* x1b = WSP(bf16, WS_X1B);
    float* dst = (REP_PHASE == 8 && rep_ == 0) ? WSP(float, WS_H) + 64 * 1024 * 1024 : out;
#define CMB_LOAD(t, xv, yw) do { const u32x2* xrow = (const u32x2*)(x1b + (size_t)(t) * DM) + lane; \
        _Pragma("unroll") for (int j = 0; j < 4; ++j) xv[j] = __builtin_nontemporal_load(xrow + 64 * j); \
        _Pragma("unroll") for (int k = 0; k < 4; ++k) { const int pos = POS[(t) * 4 + k]; const unsigned* yr = (const unsigned*)(YE + (size_t)pos * 1024) + lane; \
            _Pragma("unroll") for (int j = 0; j < 4; ++j) yw[k][j] = __builtin_nontemporal_load(yr + 64 * j); } } while (0)
#define CMB_FIN(t, xv, yw) do { f32x4 s[4]; f32x4* drow = (f32x4*)(dst + (size_t)(t) * DM) + lane; \
        _Pragma("unroll") for (int j = 0; j < 4; ++j) s[j] = (f32x4){0.f, 0.f, 0.f, 0.f}; \
        _Pragma("unroll") for (int k = 0; k < 4; ++k) _Pragma("unroll") for (int j = 0; j < 4; ++j) { \
            const f32x2 lo = __builtin_amdgcn_cvt_pk_f32_fp8((int)yw[k][j], false), hi = __builtin_amdgcn_cvt_pk_f32_fp8((int)yw[k][j], true); \
            s[j].x += lo.x; s[j].y += lo.y; s[j].z += hi.x; s[j].w += hi.y; } \
        _Pragma("unroll") for (int j = 0; j < 4; ++j) __builtin_nontemporal_store((f32x4){bflo(xv[j].x), bfhi(xv[j].x), bflo(xv[j].y), bfhi(xv[j].y)} + s[j] * 0.0625f, drow + 64 * j); } while (0)
    u32x2 xa[4], xb[4]; unsigned ya[4][4], yb[4][4];
    if (gw < T) CMB_LOAD(gw, xa, ya);
    for (int t = gw; t < T; t += 2 * NGW) {
        const bool h1 = t + NGW < T, h2 = t + 2 * NGW < T;
        if (h1) CMB_LOAD(t + NGW, xb, yb);
        CMB_FIN(t, xa, ya);
        if (h1) { if (h2) CMB_LOAD(t + 2 * NGW, xa, ya); CMB_FIN(t + NGW, xb, yb); }
    }
#undef CMB_LOAD
#undef CMB_FIN
    }
    TSTAMP(10);
    if (REP_PHASE >= 100 && bx == 0 && tid0 == 0) {
        const unsigned long long t0_ = __builtin_amdgcn_s_memrealtime(), want = 9ull * (tsB_ - tsA_);
        while (__builtin_amdgcn_s_memrealtime() - t0_ < want) __builtin_amdgcn_s_sleep(32);
    }
}

extern "C" void kernel_launch(void* const* d_in, const int* in_sizes, int n_in, void* d_out, int out_size, void* d_ws, size_t ws_size, hipStream_t stream) {
    static int grid = 0;
    if (grid == 0) {
        if (n_in != 19 || out_size != T * DM || ws_size < WS_END) { fprintf(stderr, "kernel_launch: unexpected shapes (n_in %d out %d ws %zu)\n", n_in, out_size, ws_size); grid = -1; return; }
        int dev = 0, cus = 0, per_cu = 0;
        hipGetDevice(&dev); hipDeviceGetAttribute(&cus, hipDeviceAttributeMultiprocessorCount, dev);
        hipFuncSetAttribute((const void*)fwd_kernel, hipFuncAttributeMaxDynamicSharedMemorySize, LDS_BYTES);
        hipOccupancyMaxActiveBlocksPerMultiprocessor(&per_cu, (const void*)fwd_kernel, NTHREADS, LDS_BYTES);
        if (per_cu < 1) { fprintf(stderr, "kernel_launch: occupancy query says %d blocks per CU\n", per_cu); per_cu = 1; }
        (void)hipGetLastError();
        grid = cus * 1;
        if (grid % 8 != 0 || T % (grid * NWAVES * 16) != 0) { fprintf(stderr, "kernel_launch: grid %d unsupported\n", grid); grid = -1; return; }
    }
    if (grid < 0) return;
    hipMemsetAsync((char*)d_ws + WS_CTL, 0, CTL_ZERO_BYTES, stream);
    Args a{};
    for (int i = 0; i < 19; ++i) a.in[i] = (const float*)d_in[i];
    a.out = (float*)d_out; a.ws = (unsigned char*)d_ws;
    void* kargs[] = {&a};
    hipError_t e = hipLaunchCooperativeKernel((const void*)fwd_kernel, dim3(grid), dim3(NTHREADS), kargs, LDS_BYTES, stream);
    if (e != hipSuccess) fprintf(stderr, "cooperative launch failed: %s (grid %d)\n", hipGetErrorString(e), grid);
}
```

```cpp
#include <hip/hip_runtime.h>
#include <hip/hip_cooperative_groups.h>
#include <cstdio>
#include <cstdint>
namespace cg = cooperative_groups;

#define GAS __attribute__((address_space(1)))
#define LAS __attribute__((address_space(3)))
typedef unsigned short bf16;
typedef short bf16x8 __attribute__((ext_vector_type(8)));
typedef float f32x4 __attribute__((ext_vector_type(4)));
typedef float f32x2 __attribute__((ext_vector_type(2)));
typedef unsigned u32x4 __attribute__((ext_vector_type(4)));
typedef unsigned u32x2 __attribute__((ext_vector_type(2)));
typedef __bf16 bf16x2_t __attribute__((ext_vector_type(2)));

constexpr int NB = 8, SEQ = 4096, DM = 1024, T = NB * SEQ;
constexpr int NIN = 2816, NEXP = 32, TOPK = 4;
constexpr int MEMLEN = 256, MROWS = NB * MEMLEN;
constexpr float EPS = 1e-6f;
constexpr float C2 = 0.125f * 1.4426950408889634f;
constexpr int MAXTILES = 544, PROWS = MAXTILES * 256;
constexpr int NWAVES = 8, NTHREADS = 512;
#ifndef REP_PHASE
#define REP_PHASE -1
#endif
#define TSTAMP(i) do { if (REP_PHASE == 100 + (i)) tsA_ = __builtin_amdgcn_s_memrealtime(); if (REP_PHASE == 99 + (i)) tsB_ = __builtin_amdgcn_s_memrealtime(); } while (0)
#define REPN(k) for (int rep_ = 0; rep_ < ((REP_PHASE == (k)) ? 2 : 1); ++rep_)
constexpr int LDS_MISC = 150016;
constexpr int LDS_BYTES = 150016 + 256;

constexpr size_t MiB = 1u << 20;
constexpr size_t WS_CTL = 0, CTL_ZERO_BYTES = 131072;
constexpr size_t WS_BAR = 65536;
constexpr size_t WS_KMEAN = 1 * MiB;
constexpr size_t WS_WRG = 2 * MiB;
constexpr size_t WS_SSQ = 3 * MiB;
constexpr size_t WS_TOPI = 5 * MiB, WS_TOPW = 5 * MiB + 512 * 1024, WS_LRANK = 6 * MiB, WS_POS = 6 * MiB + 512 * 1024;
constexpr size_t WS_ROWW = 7 * MiB;
constexpr size_t WS_LCOUNT = 8 * MiB, WS_PSTART = 8 * MiB + 65536, WS_TILEEXP = 8 * MiB + 131072;
constexpr size_t WS_WIN = 16 * MiB, WS_WMEM = 22 * MiB, WS_WOUT = 24 * MiB, WS_W1 = 32 * MiB, WS_W2 = 160 * MiB;
constexpr size_t WS_XN = 224 * MiB, WS_MEMN = 288 * MiB;
constexpr size_t WS_QA = 292 * MiB, WS_KA = 324 * MiB, WS_VA = 356 * MiB;
constexpr size_t WS_QR = 388 * MiB, WS_KR = 404 * MiB, WS_VR = 420 * MiB, WS_GR = 436 * MiB, WS_QM = 452 * MiB;
constexpr size_t WS_MK = 468 * MiB, WS_MV = 469 * MiB;
constexpr size_t WS_Y = 470 * MiB, WS_RET = 534 * MiB;
constexpr size_t WS_XG = 224 * MiB;
constexpr size_t WS_XN2 = 496 * MiB;
constexpr size_t WS_X1B = 388 * MiB;
constexpr size_t WS_IRS = 10 * MiB;
constexpr size_t WS_ROWTOK = 9 * MiB;
constexpr size_t WS_H = 566 * MiB;
constexpr size_t WS_END = 838 * MiB;

struct Args {
    const float* in[19]; float* out; unsigned char* ws; int pad0, pad1;
};

__device__ __forceinline__ unsigned cvtpk(float lo, float hi) { f32x2 v = {lo, hi}; bf16x2_t b = __builtin_convertvector(v, bf16x2_t); return __builtin_bit_cast(unsigned, b); }
__device__ __forceinline__ float bf2f(unsigned short b) { return __uint_as_float(((unsigned)b) << 16); }
__device__ __forceinline__ float bflo(unsigned w) { return __uint_as_float(w << 16); }
__device__ __forceinline__ float bfhi(unsigned w) { return __uint_as_float(w & 0xffff0000u); }
__device__ __forceinline__ float wave_sum(float v) {
#pragma unroll
    for (int o = 1; o < 64; o <<= 1) v += __shfl_xor(v, o);
    return v;
}
#define LDS_WAIT() asm volatile("s_waitcnt lgkmcnt(0)" ::: "memory")
typedef unsigned v6u_t __attribute__((ext_vector_type(6)));
typedef float v16f_t __attribute__((ext_vector_type(16)));
#ifndef FP6_SCALE_DIV
#define FP6_SCALE_DIV 1
#endif
__device__ __forceinline__ void fp6_pack32(const float (&v)[32], u32x4& p0, u32x4& p1) {
    float mx = 1e-30f;
#pragma unroll
    for (int i = 0; i < 32; ++i) mx = fmaxf(mx, fabsf(v[i]));
    const unsigned bits = __float_as_uint(mx * (1.0f / 7.5f));
    int e = (int)((bits + 0x7FFFFFu) >> 23) - 127;
    e = e < -126 ? -126 : (e > 126 ? 126 : e);
    const float sc = __uint_as_float((unsigned)((FP6_SCALE_DIV ? e : -e) + 127) << 23);
    v16f_t lo, hi;
#pragma unroll
    for (int i = 0; i < 16; ++i) { lo[i] = v[i]; hi[i] = v[16 + i]; }
    const v6u_t w = __builtin_amdgcn_cvt_scalef32_2xpk16_fp6_f32(lo, hi, sc);
    p0 = (u32x4){w[0], w[1], w[2], w[3]}; p1 = (u32x4){w[4], w[5], (unsigned)(e + 127), 0u};
}
__device__ __forceinline__ int opaque(int v) { asm volatile("" : "+v"(v)); return v; }

namespace pg8 {
constexpr int BM = 256, BK = 64, HALF = 128, HTB = HALF * BK * 2, STAGE_BYTES = 8 * HTB, NXCD = 8, WGM = 8, K = 1024;
__host__ __device__ __forceinline__ int lds_byte(int r, int c) { const int st = (r >> 4) * 2 + (c >> 5), rr = r & 15, cc = c & 31, ob = rr * 64 + cc * 2; return st * 1024 + (ob ^ (((ob >> 9) & 1) << 5)); }
__host__ __device__ __forceinline__ void stage_rc(int b, int& R, int& C) { const int st = b / 1024, sb = b % 1024, swz = sb ^ (((sb >> 9) & 1) << 5); R = (st >> 1) * 16 + swz / 64; C = (st & 1) * 32 + (swz % 64) / 2; }
__host__ __device__ __forceinline__ int perm32(int rho) { const int n = rho >> 4, i = rho & 15; return 8 * (i >> 2) + 4 * n + (i & 3); }
struct Unit { int pm, pn, aux; };

__device__ __forceinline__ bool static_order(int L, int nM, int nN, int& pm, int& pn) {
    const int nwg = nM * nN; if (L >= nwg) return false;
    int wgid = L; { const int q = nwg / NXCD, r = nwg % NXCD, xcd = wgid % NXCD, off = wgid / NXCD; wgid = (xcd < r ? xcd * (q + 1) : r * (q + 1) + (xcd - r) * q) + off; }
    const int nig = WGM * nN, gid = wgid / nig, fm = gid * WGM, gsz = (nM - fm) < WGM ? (nM - fm) : WGM;
    pm = fm + ((wgid % nig) % gsz); pn = (wgid % nig) / gsz; return true;
}

typedef int v8i_t __attribute__((ext_vector_type(8)));
typedef int v4i_t __attribute__((ext_vector_type(4)));
__device__ __forceinline__ v8i_t cat8(bf16x8 lo, bf16x8 hi) { const v4i_t a = __builtin_bit_cast(v4i_t, lo), b = __builtin_bit_cast(v4i_t, hi); return __builtin_shufflevector(a, b, 0, 1, 2, 3, 4, 5, 6, 7); }
typedef int v6i_t __attribute__((ext_vector_type(6)));
__device__ __forceinline__ v6i_t cat6(bf16x8 lo, bf16x8 hi) { const v4i_t a = __builtin_bit_cast(v4i_t, lo), b = __builtin_bit_cast(v4i_t, hi); return __builtin_shufflevector(a, b, 0, 1, 2, 3, 4, 5); }
__device__ __forceinline__ int scl6(bf16x8 hi) { return __builtin_bit_cast(v4i_t, hi)[2]; }
constexpr int PRE_LDS = 133120;
template <class T, class = void> struct pre_kib { static constexpr int value = 0; };
template <class T> struct pre_kib<T, decltype((void)T::PRE_KIB)> { static constexpr int value = T::PRE_KIB; };
template <class Epi, class Sched, bool GATHER = false, bool FP8 = false, bool FP6 = false>
__device__ __forceinline__ void gemm_phase(LAS unsigned char* lds, const Sched& S, const Epi& E) {
    constexpr int PRE = pre_kib<Epi>::value;
#define PG8_PRE(unit, par) do { if constexpr (PRE > 0) { if (wid == 0) { _Pragma("unroll") for (int _k = 0; _k < PRE; ++_k) \
        __builtin_amdgcn_global_load_lds((const unsigned*)E.pre_src(unit, _k, lane), (LAS unsigned*)(lds + PRE_LDS + (par) * 2048 + _k * 1024), 16, 0, 0); } } } while (0)
    constexpr int PITCH = FP8 ? 1024 : 2048;
    const int tid = opaque((int)threadIdx.x), wid = __builtin_amdgcn_readfirstlane(tid >> 6), lane = tid & 63, wr = wid >> 2, wc = wid & 3, fr = lane & 15, fq = lane >> 4;
    constexpr int nt = PITCH / 128;
    unsigned voffA[2], voffB[2];
#pragma unroll
    for (int i = 0; i < 2; ++i) { int R, C; stage_rc(tid * 16 + i * 8192, R, C); const int Rb = (R & ~31) + perm32(R & 31);
        voffA[i] = (unsigned)(R * PITCH + C * 2); voffB[i] = (unsigned)(Rb * PITCH + C * 2); }
    const size_t kstep = (size_t)(BK * 2);
    const size_t hstep = (size_t)HALF * PITCH;
    const unsigned ldsw = (unsigned)wid * 1024u;
    const int aoff = lds_byte(wr * 64 + fr, fq * 8), boff = lds_byte(wc * 32 + fr, fq * 8);
#define PG8_SA(b, h) (((b) * 2 + (h)) * HTB)
#define PG8_SB(b, h) ((4 + (b) * 2 + (h)) * HTB)
#define PG8_STAGE(bufoff, gbase, voff) do { _Pragma("unroll") for (int _i = 0; _i < 2; ++_i) \
        __builtin_amdgcn_global_load_lds((const unsigned*)((const char*)(gbase) + (voff)[_i]), (LAS unsigned*)(lds + (bufoff) + ldsw + _i * 8192), 16, 0, 0); } while (0)
#define PG8_LDA(dst, b, h) do { _Pragma("unroll") for (int m = 0; m < 4; ++m) _Pragma("unroll") for (int k = 0; k < 2; ++k) dst[m][k] = *(const LAS bf16x8*)(lds + PG8_SA(b, h) + aoff + m * 2048 + k * 1024); } while (0)
#define PG8_LDB(dst, b, h) do { _Pragma("unroll") for (int n = 0; n < 2; ++n) _Pragma("unroll") for (int k = 0; k < 2; ++k) dst[n][k] = *(const LAS bf16x8*)(lds + PG8_SB(b, h) + boff + n * 2048 + k * 1024); } while (0)
#define PG8_MMA(ai, bj, At, Bt) do { __builtin_amdgcn_s_setprio(1); \
        if constexpr (FP6) { _Pragma("unroll") for (int m = 0; m < 4; ++m) _Pragma("unroll") for (int n = 0; n < 2; ++n) \
            asm volatile("s_nop 1\n\tv_mfma_scale_f32_16x16x128_f8f6f4 %0, %1, %2, %0, %3, %4 op_sel_hi:[0,0,0] cbsz:2 blgp:2" : "+v"(acc[ai][bj][m][n]) : "v"(cat6(Bt[n][0], Bt[n][1])), "v"(cat6(At[m][0], At[m][1])), "v"(scl6(Bt[n][1])), "v"(scl6(At[m][1]))); } \
        else if constexpr (FP8) { _Pragma("unroll") for (int m = 0; m < 4; ++m) _Pragma("unroll") for (int n = 0; n < 2; ++n) \
            asm volatile("v_mfma_scale_f32_16x16x128_f8f6f4 %0, %1, %2, %0, %3, %3 op_sel_hi:[0,0,0]" : "+v"(acc[ai][bj][m][n]) : "v"(cat8(Bt[n][0], Bt[n][1])), "v"(cat8(At[m][0], At[m][1])), "v"(0x7f7f7f7f)); } \
        else { _Pragma("unroll") for (int m = 0; m < 4; ++m) _Pragma("unroll") for (int n = 0; n < 2; ++n) _Pragma("unroll") for (int k = 0; k < 2; ++k) \
            acc[ai][bj][m][n] = __builtin_amdgcn_mfma_f32_16x16x32_bf16(Bt[n][k], At[m][k], acc[ai][bj][m][n], 0, 0, 0); } \
        __builtin_amdgcn_s_setprio(0); } while (0)
#define PG8_WAIT_V(n) asm volatile("s_waitcnt vmcnt(" #n ")" ::: "memory")
#define PG8_WAIT_L(n) asm volatile("s_waitcnt lgkmcnt(" #n ")" ::: "memory")
#define PG8_BAR __builtin_amdgcn_s_barrier()
#define PG8_SCHED __builtin_amdgcn_sched_barrier(0)
    Unit cur, nxt; int ui = 0;
    if (!S.next(0, cur)) return;
    PG8_PRE(cur, 0);
    unsigned vGc[2][2], vGn[2][2]; int gR[2], gC[2];
    const char* gA = nullptr;
    if constexpr (GATHER) {
        gA = S.abase();
#pragma unroll
        for (int i = 0; i < 2; ++i) { stage_rc(tid * 16 + i * 8192, gR[i], gC[i]); }
        if (wid == 0) __builtin_amdgcn_global_load_lds((const unsigned*)(S.tokptr(cur) + lane * 16), (LAS unsigned*)(lds + 131072), 16, 0, 0);
        asm volatile("s_waitcnt vmcnt(0)" ::: "memory"); __builtin_amdgcn_s_barrier(); asm volatile("" ::: "memory");
#pragma unroll
        for (int h = 0; h < 2; ++h)
#pragma unroll
            for (int i = 0; i < 2; ++i) { const int tok = ((const LAS int*)(lds + 131072))[h * 128 + gR[i]]; vGc[h][i] = (unsigned)tok * (unsigned)PITCH + (unsigned)gC[i] * 2u; vGn[h][i] = vGc[h][i]; }
    }
    f32x4 acc[2][2][4][2];
#pragma unroll
    for (int a = 0; a < 2; ++a)
#pragma unroll
        for (int b = 0; b < 2; ++b)
#pragma unroll
            for (int m = 0; m < 4; ++m)
#pragma unroll
                for (int n = 0; n < 2; ++n) acc[a][b][m][n] = (f32x4){0.f, 0.f, 0.f, 0.f};
    bf16x8 At[4][2], B0[2][2], B1[2][2];
    const char* cA = GATHER ? gA : S.aptr(cur); const char* cB = S.bptr(cur);
    const size_t ahstep = GATHER ? (size_t)0 : hstep;
    {
        PG8_STAGE(PG8_SB(0, 0), cB, voffB); PG8_STAGE(PG8_SB(0, 1), cB + hstep, voffB);
        if constexpr (GATHER) { PG8_STAGE(PG8_SA(0, 0), cA, vGc[0]); PG8_STAGE(PG8_SA(0, 1), cA, vGc[1]); } else { PG8_STAGE(PG8_SA(0, 0), cA, voffA); PG8_STAGE(PG8_SA(0, 1), cA + hstep, voffA); }
        if (wr == 1) PG8_BAR;
        PG8_WAIT_V(2); PG8_BAR;
        PG8_STAGE(PG8_SB(1, 0), cB + kstep, voffB);
        if constexpr (GATHER) { PG8_STAGE(PG8_SA(1, 0), cA + kstep, vGc[0]); } else { PG8_STAGE(PG8_SA(1, 0), cA + kstep, voffA); }
        PG8_STAGE(PG8_SB(1, 1), cB + hstep + kstep, voffB);
        PG8_WAIT_V(6); PG8_BAR;
    }
    for (;;) {
        const bool has_next = S.next(ui + 1, nxt);
        const char* nA = GATHER ? gA : (has_next ? S.aptr(nxt) : cA); const char* nB = has_next ? S.bptr(nxt) : cB;
        if constexpr (GATHER) { if (has_next && wid == 0) __builtin_amdgcn_global_load_lds((const unsigned*)(S.tokptr(nxt) + lane * 16), (LAS unsigned*)(lds + 131072 + ((ui + 1) & 1) * 1024), 16, 0, 0); }
#pragma nounroll
        for (int t = 0; t < nt; t += 2) {
            const bool last = (t == nt - 2);
            const char* a1 = cA + (size_t)(t + 1) * kstep;
            const char* a2 = last ? nA : cA + (size_t)(t + 2) * kstep; const char* b2 = last ? nB : cB + (size_t)(t + 2) * kstep;
            const char* a3 = a2 + kstep; const char* b3 = b2 + kstep;
            unsigned v2h0[2], v2h1[2];
            if constexpr (GATHER) {
                if (last && has_next) {
                    const LAS int* tk = (const LAS int*)(lds + 131072 + ((ui + 1) & 1) * 1024);
#pragma unroll
                    for (int h = 0; h < 2; ++h)
#pragma unroll
                        for (int i = 0; i < 2; ++i) vGn[h][i] = (unsigned)tk[h * 128 + gR[i]] * (unsigned)PITCH + (unsigned)gC[i] * 2u;
                }
#pragma unroll
                for (int i = 0; i < 2; ++i) { v2h0[i] = last ? vGn[0][i] : vGc[0][i]; v2h1[i] = last ? vGn[1][i] : vGc[1][i]; }
            } else {
#pragma unroll
                for (int i = 0; i < 2; ++i) { v2h0[i] = voffA[i]; v2h1[i] = voffA[i]; }
            }
            PG8_LDB(B0, 0, 0); PG8_LDB(B1, 0, 1); PG8_SCHED; PG8_LDA(At, 0, 0);
            if constexpr (GATHER) { PG8_STAGE(PG8_SA(1, 1), a1, vGc[1]); } else { PG8_STAGE(PG8_SA(1, 1), a1 + hstep, voffA); }
            PG8_WAIT_V(8); PG8_WAIT_L(0); PG8_BAR; PG8_MMA(0, 0, At, B0); PG8_MMA(0, 1, At, B1); PG8_BAR; PG8_SCHED;
            PG8_LDA(At, 0, 1); PG8_STAGE(PG8_SB(0, 0), b2, voffB); PG8_STAGE(PG8_SB(0, 1), b2 + hstep, voffB); PG8_STAGE(PG8_SA(0, 0), a2, v2h0);
            PG8_WAIT_V(8); PG8_WAIT_L(0); PG8_BAR; PG8_MMA(1, 0, At, B0); PG8_MMA(1, 1, At, B1); PG8_BAR; PG8_SCHED;
            PG8_LDB(B0, 1, 0); PG8_LDB(B1, 1, 1); PG8_SCHED; PG8_LDA(At, 1, 0); PG8_STAGE(PG8_SA(0, 1), a2 + ahstep, v2h1);
            PG8_WAIT_V(8); PG8_WAIT_L(0); PG8_BAR; PG8_MMA(0, 0, At, B0); PG8_MMA(0, 1, At, B1); PG8_BAR; PG8_SCHED;
            PG8_LDA(At, 1, 1); PG8_STAGE(PG8_SB(1, 0), b3, voffB); PG8_STAGE(PG8_SB(1, 1), b3 + hstep, voffB); PG8_STAGE(PG8_SA(1, 0), a3, v2h0);
            PG8_WAIT_V(8); PG8_WAIT_L(0); PG8_BAR; PG8_MMA(1, 0, At, B0); PG8_MMA(1, 1, At, B1); PG8_BAR; PG8_SCHED;
        }
        if (wr == 0) PG8_BAR;
        if constexpr (FP8) asm volatile("s_nop 15\n\ts_nop 7" ::: "memory");
        if constexpr (PRE > 0) E(acc, cur, wr, wc, fr, fq, (const LAS float*)(lds + PRE_LDS + (ui & 1) * 2048)); else E(acc, cur, wr, wc, fr, fq);
        if (!has_next) break;
#pragma unroll
        for (int a = 0; a < 2; ++a)
#pragma unroll
            for (int b = 0; b < 2; ++b)
#pragma unroll
                for (int m = 0; m < 4; ++m)
#pragma unroll
                    for (int n = 0; n < 2; ++n) acc[a][b][m][n] = (f32x4){0.f, 0.f, 0.f, 0.f};
        cur = nxt; cA = nA; cB = nB; ++ui;
        PG8_PRE(cur, ui & 1);
        if constexpr (GATHER) {
#pragma unroll
            for (int h = 0; h < 2; ++h)
#pragma unroll
                for (int i = 0; i < 2; ++i) vGc[h][i] = vGn[h][i];
        }
        if (wr == 1) PG8_BAR;
    }
    PG8_WAIT_V(0);
    PG8_BAR;
#undef PG8_PRE
#undef PG8_SA
#undef PG8_SB
#undef PG8_STAGE
#undef PG8_LDA
#undef PG8_LDB
#undef PG8_MMA
#undef PG8_WAIT_V
#undef PG8_WAIT_L
#undef PG8_BAR
#undef PG8_SCHED
}
}
using pg8::Unit;

struct SchedProj {
    int G, c; const char *XN, *MEMN, *WIN, *WMEM;
    __device__ __forceinline__ bool next(int i, Unit& u) const {
        const int L = i * G + c;
        if (L < 1408) { u.aux = 0; return pg8::static_order(L, 128, 11, u.pm, u.pn); }
        if (L < 1424) { const int j = L - 1408; u.pm = j >> 1; u.pn = j & 1; u.aux = 1; return true; }
        return false;
    }
    __device__ __forceinline__ const char* aptr(const Unit& u) const { return (u.aux ? MEMN : XN) + (size_t)u.pm * (256 * 2048); }
    __device__ __forceinline__ const char* bptr(const Unit& u) const { return (u.aux ? WMEM : WIN) + (size_t)u.pn * (256 * 2048); }
};
struct SchedProj10 {
    int G, c; const char *XN, *WIN;
    __device__ __forceinline__ bool next(int i, Unit& u) const { int j; u.aux = 0; if (!pg8::static_order(i * G + c, 128, 10, u.pm, j)) return false; u.pn = j < 9 ? j : 10; return true; }
    __device__ __forceinline__ const char* aptr(const Unit& u) const { return XN + (size_t)u.pm * (256 * 2048); }
    __device__ __forceinline__ const char* bptr(const Unit& u) const { return WIN + (size_t)u.pn * (256 * 2048); }
};
struct SchedProjOne {
    int c; const char *XN, *MEMN, *WIN, *WMEM;
    __device__ __forceinline__ bool next(int i, Unit& u) const {
        if (i != 0 || c >= 144) return false;
        if (c < 128) { u.pm = c; u.pn = 9; u.aux = 0; } else { const int j = c - 128; u.pm = j >> 1; u.pn = j & 1; u.aux = 1; }
        return true;
    }
    __device__ __forceinline__ const char* aptr(const Unit& u) const { return (u.aux ? MEMN : XN) + (size_t)u.pm * (256 * 2048); }
    __device__ __forceinline__ const char* bptr(const Unit& u) const { return (u.aux ? WMEM : WIN) + (size_t)u.pn * (256 * 2048); }
};
struct SchedPlain {
    int G, c, nM, nN; const char *A, *B;
    __device__ __forceinline__ bool next(int i, Unit& u) const { u.aux = 0; return pg8::static_order(i * G + c, nM, nN, u.pm, u.pn); }
    __device__ __forceinline__ const char* aptr(const Unit& u) const { return A + (size_t)u.pm * (256 * 2048); }
    __device__ __forceinline__ const char* bptr(const Unit& u) const { return B + (size_t)u.pn * (256 * 2048); }
};
struct SchedMoe {
    int G, vcu, npn, ntiles; const int* tile_exp; const char *A, *B; size_t bexp;
    __device__ __forceinline__ bool next(int i, Unit& u) const {
        const int L = i * G + vcu, tile = L / npn; if (tile >= ntiles) return false;
        u.pm = tile; u.pn = L - tile * npn; u.aux = __builtin_amdgcn_readfirstlane(tile_exp[tile]); return true;
    }
    __device__ __forceinline__ const char* aptr(const Unit& u) const { return A + (size_t)u.pm * (256 * 1024); }
    __device__ __forceinline__ const char* bptr(const Unit& u) const { return B + (size_t)u.aux * bexp + (size_t)u.pn * (256 * 1024); }
    const int* rowtok;
    __device__ __forceinline__ const char* abase() const { return A; }
    __device__ __forceinline__ const char* tokptr(const Unit& u) const { return (const char*)(rowtok + (size_t)u.pm * 256); }
};

struct EpiProj {
    unsigned char* ws;
    const float *gq, *gk, *gmq, *gmk;
    __device__ __forceinline__ void operator()(const f32x4 (&acc)[2][2][4][2], const Unit& u, int wr, int wc, int fr, int fq) const {
        int mode = 0; bf16* out; int ld = 256, coff = 0; const float* gain = nullptr; float scale = 1.f; bool kmean = false;
        if (u.aux == 0) {
            switch (u.pn) {
                case 0: case 1: out = (bf16*)(ws + WS_QA); ld = 512; coff = u.pn * 256; mode = 1; gain = gq; scale = C2; break;
                case 2: case 3: out = (bf16*)(ws + WS_KA); ld = 512; coff = (u.pn - 2) * 256; mode = 1; gain = gk; kmean = true; break;
                case 4: case 5: out = (bf16*)(ws + WS_VA); ld = 512; coff = (u.pn - 4) * 256; break;
                case 6: out = (bf16*)(ws + WS_QR); mode = 2; break;
                case 7: out = (bf16*)(ws + WS_KR); mode = 2; scale = 0.125f; break;
                case 8: out = (bf16*)(ws + WS_VR); break;
                case 9: out = (bf16*)(ws + WS_GR); mode = 3; break;
                default: out = (bf16*)(ws + WS_QM); mode = 1; gain = gmq; scale = C2; break;
            }
        } else {
            if (u.pn == 0) { out = (bf16*)(ws + WS_MK); mode = 1; gain = gmk; } else { out = (bf16*)(ws + WS_MV); }
        }
        const int row0 = u.pm * 256 + wr * 64 + fr;
        const int colb = coff + wc * 64 + 8 * fq;
        if (gain == nullptr) gain = gq;
        f32x4 gv[2][2];
#pragma unroll
        for (int bj = 0; bj < 2; ++bj)
#pragma unroll
            for (int n = 0; n < 2; ++n) gv[bj][n] = *(const f32x4*)(gain + bj * 32 + 8 * fq + 4 * n);
        f32x4 ks[2][2];
#pragma unroll
        for (int bj = 0; bj < 2; ++bj)
#pragma unroll
            for (int n = 0; n < 2; ++n) ks[bj][n] = (f32x4){0.f, 0.f, 0.f, 0.f};
#pragma unroll
        for (int ai = 0; ai < 2; ++ai)
#pragma unroll
            for (int m = 0; m < 4; ++m) {
                const int row = row0 + ai * 128 + m * 16;
                f32x4 v[2][2];
#pragma unroll
                for (int bj = 0; bj < 2; ++bj)
#pragma unroll
                    for (int n = 0; n < 2; ++n) v[bj][n] = acc[ai][bj][m][n];
                if (mode == 1) {
                    float ss = 0.f;
#pragma unroll
                    for (int bj = 0; bj < 2; ++bj)
#pragma unroll
                        for (int n = 0; n < 2; ++n) { const f32x4 x = v[bj][n]; ss += (x[0] * x[0] + x[1] * x[1]) + (x[2] * x[2] + x[3] * x[3]); }
                    ss += __shfl_xor(ss, 16); ss += __shfl_xor(ss, 32);
                    const float r = scale / sqrtf(ss * (1.0f / 64.0f) + EPS);
#pragma unroll
                    for (int bj = 0; bj < 2; ++bj)
#pragma unroll
                        for (int n = 0; n < 2; ++n) v[bj][n] = v[bj][n] * r * gv[bj][n];
                } else if (mode == 2) {
                    const float pos = (float)(row & (SEQ - 1));
                    const float lgam = __builtin_amdgcn_logf(1.0f - __builtin_amdgcn_exp2f(-5.0f - (float)wc));
                    const float rsc = scale * __builtin_amdgcn_exp2f(((u.pn == 6) ? lgam : -lgam) * (float)(row & 127));
#pragma unroll
                    for (int n = 0; n < 2; ++n)
#pragma unroll
                        for (int j = 0; j < 4; ++j) {
                            const float fre = __builtin_amdgcn_exp2f((float)(8 * fq + 4 * n + j) * (-13.287712379549449f / 31.0f)) * 0.15915494309189535f;
                            float tt = pos * fre; tt = tt - floorf(tt);
                            const float sn = __builtin_amdgcn_sinf(tt), cs = __builtin_amdgcn_cosf(tt);
                            const float t1 = v[0][n][j], t2 = v[1][n][j];
                            v[0][n][j] = (t1 * cs - t2 * sn) * rsc; v[1][n][j] = (t2 * cs + t1 * sn) * rsc;
                        }
                } else if (mode == 3) {
#pragma unroll
                    for (int bj = 0; bj < 2; ++bj)
#pragma unroll
                        for (int n = 0; n < 2; ++n)
#pragma unroll
                            for (int j = 0; j < 4; ++j) { const float x = v[bj][n][j]; v[bj][n][j] = x / (1.0f + __expf(-x)); }
                }
                if (kmean) {
#pragma unroll
                    for (int bj = 0; bj < 2; ++bj)
#pragma unroll
                        for (int n = 0; n < 2; ++n) ks[bj][n] += v[bj][n];
                }
                bf16* rowp = out + (size_t)row * ld + colb;
#pragma unroll
                for (int bj = 0; bj < 2; ++bj) { u32x4 w; w.x = cvtpk(v[bj][0][0], v[bj][0][1]); w.y = cvtpk(v[bj][0][2], v[bj][0][3]); w.z = cvtpk(v[bj][1][0], v[bj][1][1]); w.w = cvtpk(v[bj][1][2], v[bj][1][3]);
                    *(u32x4*)(rowp + bj * 32) = w; }
            }
        if (kmean) {
            float* kp = (float*)(ws + WS_KMEAN) + ((size_t)u.pm * 8 + (u.pn - 2) * 4 + wc) * 64 + 8 * fq;
#pragma unroll
            for (int bj = 0; bj < 2; ++bj)
#pragma unroll
                for (int n = 0; n < 2; ++n)
#pragma unroll
                    for (int j = 0; j < 4; ++j) {
                        float s = ks[bj][n][j];
                        s += __shfl_xor(s, 1); s += __shfl_xor(s, 2); s += __shfl_xor(s, 4); s += __shfl_xor(s, 8);
                        if (fr == 0) atomicAdd(kp + bj * 32 + 4 * n + j, s * (1.0f / 256.0f));
                    }
        }
    }
};

struct EpiOut {
    const bf16* xn; const float* irs; const float* gattn; bf16* out; float* ssq;
    static constexpr int PRE_KIB = 2;
    __device__ __forceinline__ const char* pre_src(const Unit& u, int k, int lane) const { return (const char*)(k == 0 ? gattn + u.pn * 256 : irs + (size_t)u.pm * 256) + lane * 16; }
    __device__ __forceinline__ void operator()(const f32x4 (&acc)[2][2][4][2], const Unit& u, int wr, int wc, int fr, int fq, const LAS float* pre) const {
        const int row0 = u.pm * 256 + wr * 64 + fr, col0 = u.pn * 256 + wc * 32 + 8 * fq;
        f32x4 ig[2][2];
#pragma unroll
        for (int bj = 0; bj < 2; ++bj)
#pragma unroll
            for (int n = 0; n < 2; ++n) { const f32x4 g = *(const LAS f32x4*)(pre + wc * 32 + 8 * fq + bj * 128 + 4 * n); ig[bj][n] = (f32x4){1.0f / g[0], 1.0f / g[1], 1.0f / g[2], 1.0f / g[3]}; }
#pragma unroll
        for (int ai = 0; ai < 2; ++ai) {
            u32x4 xwv[4][2]; float irv[4];
#pragma unroll
            for (int m = 0; m < 4; ++m) { const int row = row0 + ai * 128 + m * 16; irv[m] = pre[256 + wr * 64 + fr + ai * 128 + m * 16];
#pragma unroll
                for (int bj = 0; bj < 2; ++bj) xwv[m][bj] = __builtin_nontemporal_load((const u32x4*)(xn + (size_t)row * DM + col0 + bj * 128)); }
#pragma unroll
            for (int m = 0; m < 4; ++m) {
                const int row = row0 + ai * 128 + m * 16; const size_t off = (size_t)row * DM + col0; float ss = 0.f; const float ir = irv[m];
#pragma unroll
                for (int bj = 0; bj < 2; ++bj) {
                    const u32x4 xw = xwv[m][bj];
                    const f32x4 o0 = (f32x4){bflo(xw.x), bfhi(xw.x), bflo(xw.y), bfhi(xw.y)} * ig[bj][0] * ir + acc[ai][bj][m][0], o1 = (f32x4){bflo(xw.z), bfhi(xw.z), bflo(xw.w), bfhi(xw.w)} * ig[bj][1] * ir + acc[ai][bj][m][1];
                    ss += ((o0[0] * o0[0] + o0[1] * o0[1]) + (o0[2] * o0[2] + o0[3] * o0[3])) + ((o1[0] * o1[0] + o1[1] * o1[1]) + (o1[2] * o1[2] + o1[3] * o1[3]));
                    u32x4 w; w.x = cvtpk(o0[0], o0[1]); w.y = cvtpk(o0[2], o0[3]); w.z = cvtpk(o1[0], o1[1]); w.w = cvtpk(o1[2], o1[3]);
                    *(u32x4*)(out + off + bj * 128) = w; }
                ss += __shfl_xor(ss, 16); ss += __shfl_xor(ss, 32);
                if (fq == 0) ssq[(size_t)row * 16 + u.pn * 4 + wc] = ss;
            }
        }
    }
};

struct EpiSwiglu {
    static constexpr int PRE_KIB = 1;
    const float* b1; unsigned char* H;
    __device__ __forceinline__ const char* pre_src(const Unit& u, int k, int lane) const { return (const char*)(b1 + (size_t)u.aux * 2048 + u.pn * 256) + lane * 16; }
    __device__ __forceinline__ void operator()(const f32x4 (&acc)[2][2][4][2], const Unit& u, int wr, int wc, int fr, int fq, const LAS float* pre) const {
        const int row0 = u.pm * 256 + wr * 64 + fr, p0 = u.pn * 128 + wc * 32 + 8 * fq;
        const LAS float* bp = pre + 2 * (wc * 32 + 8 * fq);
        f32x4 bv[4];
#pragma unroll
        for (int i = 0; i < 4; ++i) bv[i] = *(const LAS f32x4*)(bp + 4 * i);
#pragma unroll
        for (int ai = 0; ai < 2; ++ai)
#pragma unroll
            for (int m = 0; m < 4; ++m) {
                const int row = row0 + ai * 128 + m * 16;
                float h[8];
#pragma unroll
                for (int n = 0; n < 2; ++n)
#pragma unroll
                    for (int j = 0; j < 4; ++j) {
                        const int i = 4 * n + j;
                        const float g = fminf(acc[ai][0][m][n][j] + bv[i >> 1][(i & 1) * 2], 7.0f);
                        const float l = fminf(fmaxf(acc[ai][1][m][n][j] + bv[i >> 1][(i & 1) * 2 + 1], -7.0f), 7.0f);
                        h[i] = g * __builtin_amdgcn_rcpf(1.0f + __builtin_amdgcn_exp2f(-1.702f * 1.4426950408889634f * g)) * (l + 1.0f);
                    }
                int w0 = 0, w1 = 0;
                w0 = __builtin_amdgcn_cvt_pk_fp8_f32(h[0], h[1], w0, false); w0 = __builtin_amdgcn_cvt_pk_fp8_f32(h[2], h[3], w0, true);
                w1 = __builtin_amdgcn_cvt_pk_fp8_f32(h[4], h[5], w1, false); w1 = __builtin_amdgcn_cvt_pk_fp8_f32(h[6], h[7], w1, true);
                *(u32x2*)(H + (size_t)row * 1024 + p0) = (u32x2){(unsigned)w0, (unsigned)w1};
            }
    }
};

struct EpiDown {
    static constexpr int PRE_KIB = 2;
    const float* b2; const float* roww; unsigned char* YE;
    __device__ __forceinline__ const char* pre_src(const Unit& u, int k, int lane) const {
        return (const char*)(k == 0 ? b2 + (size_t)u.aux * 1024 + u.pn * 256 : roww + (size_t)u.pm * 256) + lane * 16; }
    __device__ __forceinline__ void operator()(const f32x4 (&acc)[2][2][4][2], const Unit& u, int wr, int wc, int fr, int fq, const LAS float* pre) const {
        const int row0 = u.pm * 256 + wr * 64 + fr, c0 = u.pn * 256 + wc * 32 + 8 * fq;
        const LAS float* bp = pre + wc * 32 + 8 * fq;
        f32x4 bv[2][2];
#pragma unroll
        for (int bj = 0; bj < 2; ++bj)
#pragma unroll
            for (int n = 0; n < 2; ++n) bv[bj][n] = *(const LAS f32x4*)(bp + bj * 128 + 4 * n);
        float w8v[2][4];
#pragma unroll
        for (int ai = 0; ai < 2; ++ai)
#pragma unroll
            for (int m = 0; m < 4; ++m) w8v[ai][m] = pre[256 + wr * 64 + fr + ai * 128 + m * 16] * 16.0f;
#pragma unroll
        for (int ai = 0; ai < 2; ++ai)
#pragma unroll
            for (int m = 0; m < 4; ++m) {
                const int row = row0 + ai * 128 + m * 16; const float w8 = w8v[ai][m];
#pragma unroll
                for (int bj = 0; bj < 2; ++bj) {
                    const f32x4 y0 = (acc[ai][bj][m][0] * 0.03125f + bv[bj][0]) * w8, y1 = (acc[ai][bj][m][1] * 0.03125f + bv[bj][1]) * w8;
                    int w0 = 0, w1 = 0;
                    w0 = __builtin_amdgcn_cvt_pk_fp8_f32(y0[0], y0[1], w0, false); w0 = __builtin_amdgcn_cvt_pk_fp8_f32(y0[2], y0[3], w0, true);
                    w1 = __builtin_amdgcn_cvt_pk_fp8_f32(y1[0], y1[1], w1, false); w1 = __builtin_amdgcn_cvt_pk_fp8_f32(y1[2], y1[3], w1, true);
                    *(u32x2*)(YE + (size_t)row * 1024 + c0 + bj * 128) = (u32x2){(unsigned)w0, (unsigned)w1};
                }
            }
    }
};

__device__ __forceinline__ void transpose_item(const float* W, int N, bf16* WT, int drow0, LAS float* scr, int k0, int n0, int lane) {
    float ld_[32];
#pragma unroll
    for (int i = 0; i < 32; ++i) { const int kk = 2 * i + (lane >> 5); ld_[i] = __builtin_nontemporal_load(W + (size_t)(k0 + kk) * N + n0 + (lane & 31)); }
#pragma unroll
    for (int i = 0; i < 32; ++i) { const int kk = 2 * i + (lane >> 5); scr[kk * 33 + (lane & 31)] = ld_[i]; }
    LDS_WAIT(); asm volatile("" ::: "memory");
    const int c = lane & 7;
#pragma unroll
    for (int j = 0; j < 4; ++j) { const int n = (lane >> 3) + 8 * j; const LAS float* s = scr + (8 * c) * 33 + n;
        u32x4 o; o.x = cvtpk(s[0 * 33], s[1 * 33]); o.y = cvtpk(s[2 * 33], s[3 * 33]); o.z = cvtpk(s[4 * 33], s[5 * 33]); o.w = cvtpk(s[6 * 33], s[7 * 33]);
        *(u32x4*)(WT + (size_t)(drow0 + n) * 1024 + k0 + 8 * c) = o; }
    LDS_WAIT(); asm volatile("" ::: "memory");
}
template <bool GLU>
__device__ __forceinline__ void transpose_item_fp8(const float* W, int N, unsigned char* W8, LAS float* scr, int k0, int n0, int lane) {
    float ld_[32];
#pragma unroll
    for (int i = 0; i < 32; ++i) { const int kk = 2 * i + (lane >> 5); ld_[i] = __builtin_nontemporal_load(W + (size_t)(k0 + kk) * N + n0 + (lane & 31)); }
#pragma unroll
    for (int i = 0; i < 32; ++i) { const int kk = 2 * i + (lane >> 5); scr[kk * 33 + (lane & 31)] = ld_[i]; }
    LDS_WAIT(); asm volatile("" ::: "memory");
    const int c = lane & 3;
#pragma unroll
    for (int j = 0; j < 2; ++j) { const int n = (lane >> 2) + 16 * j; const LAS float* s = scr + (16 * c) * 33 + n;
        int w[4];
#pragma unroll
        for (int q = 0; q < 4; ++q) { int t = 0; t = __builtin_amdgcn_cvt_pk_fp8_f32(s[(4 * q) * 33] * 32.0f, s[(4 * q + 1) * 33] * 32.0f, t, false); t = __builtin_amdgcn_cvt_pk_fp8_f32(s[(4 * q + 2) * 33] * 32.0f, s[(4 * q + 3) * 33] * 32.0f, t, true); w[q] = t; }
        const int col = n0 + n; const int p = col >> 1;
        const int drow = GLU ? ((p >> 7) * 256 + (col & 1) * 128 + (p & 127)) : col;
        *(u32x4*)(W8 + (size_t)drow * 1024 + k0 + 16 * c) = (u32x4){(unsigned)w[0], (unsigned)w[1], (unsigned)w[2], (unsigned)w[3]}; }
    LDS_WAIT(); asm volatile("" ::: "memory");
}
struct ConvItem { const float* W; unsigned char* W8; int N, k0, n0; bool glu; };
__device__ __forceinline__ ConvItem conv_decode(int it, const float* w1, const float* w2, unsigned char* W1_8, unsigned char* W2_8) {
    ConvItem c;
    if (it < 32768) { const int e = it >> 10, rr = it & 1023, nb = rr & 63, kb = rr >> 6; c.W = w1 + (size_t)e * 1024 * 2048; c.W8 = W1_8 + (size_t)e * 2048 * 1024; c.N = 2048; c.k0 = kb * 64; c.n0 = nb * 32; c.glu = true; }
    else { const int r = it - 32768, e = r >> 9, rr = r & 511, nb = rr & 31, kb = rr >> 5; c.W = w2 + (size_t)e * 1024 * 1024; c.W8 = W2_8 + (size_t)e * 1024 * 1024; c.N = 1024; c.k0 = kb * 64; c.n0 = nb * 32; c.glu = false; }
    return c;
}
__device__ __forceinline__ void conv_load(const ConvItem& c, f32x4 (&r)[8], int lane) {
    const float* base = c.W + (size_t)c.k0 * c.N + c.n0;
    const int lo = (lane >> 3) * c.N + (lane & 7) * 4;
#pragma unroll
    for (int i = 0; i < 8; ++i) r[i] = __builtin_nontemporal_load((const f32x4*)(base + (size_t)(8 * i) * c.N + lo));
}
__device__ __forceinline__ void conv_finish(const ConvItem& c, const f32x4 (&r)[8], LAS float* scr, int lane) {
#pragma unroll
    for (int i = 0; i < 8; ++i) *(LAS f32x4*)(scr + (8 * i + (lane >> 3)) * 36 + (lane & 7) * 4) = r[i];
    LDS_WAIT(); asm volatile("" ::: "memory");
    if (c.glu) {
        const int n = lane & 31, half = lane >> 5; const LAS float* s = scr + (32 * half) * 36 + n;
        float v[32];
#pragma unroll
        for (int i = 0; i < 32; ++i) v[i] = s[i * 36];
        u32x4 p0, p1; fp6_pack32(v, p0, p1);
        const int col = c.n0 + n; const int p = col >> 1;
        const int drow = (p >> 7) * 256 + (col & 1) * 128 + (p & 127);
        unsigned char* dst = c.W8 + (size_t)drow * 1024 + (c.k0 >> 7) * 128 + 16 * (((c.k0 & 127) >> 5) + half);
        *(u32x4*)dst = p0; *(u32x4*)(dst + 64) = p1;
        LDS_WAIT(); asm volatile("" ::: "memory");
        return;
    }
    const int cc = lane & 3;
#pragma unroll
    for (int j = 0; j < 2; ++j) { const int n = (lane >> 2) + 16 * j; const LAS float* s = scr + (16 * cc) * 36 + n;
        int w[4];
#pragma unroll
        for (int q = 0; q < 4; ++q) { int t = 0; t = __builtin_amdgcn_cvt_pk_fp8_f32(s[(4 * q) * 36] * 32.0f, s[(4 * q + 1) * 36] * 32.0f, t, false); t = __builtin_amdgcn_cvt_pk_fp8_f32(s[(4 * q + 2) * 36] * 32.0f, s[(4 * q + 3) * 36] * 32.0f, t, true); w[q] = t; }
        const int col = c.n0 + n; const int p = col >> 1;
        const int drow = c.glu ? ((p >> 7) * 256 + (col & 1) * 128 + (p & 127)) : col;
        *(u32x4*)(c.W8 + (size_t)drow * 1024 + c.k0 + 16 * cc) = (u32x4){(unsigned)w[0], (unsigned)w[1], (unsigned)w[2], (unsigned)w[3]}; }
    LDS_WAIT(); asm volatile("" ::: "memory");
}
__device__ __forceinline__ void convert_chunk(int chunk, const float* w1, const float* w2, unsigned char* W1_8, unsigned char* W2_8, LAS float* scr, int wave, int lane) {
    const int base = chunk * 32 + wave;
    f32x4 ra[8], rb[8];
    ConvItem ca = conv_decode(base, w1, w2, W1_8, W2_8), cb;
    conv_load(ca, ra, lane);
#pragma unroll 1
    for (int j = 0; j < 4; j += 2) {
        cb = conv_decode(base + 8 * (j + 1), w1, w2, W1_8, W2_8); conv_load(cb, rb, lane);
        conv_finish(ca, ra, scr, lane);
        if (j + 2 < 4) { ca = conv_decode(base + 8 * (j + 2), w1, w2, W1_8, W2_8); conv_load(ca, ra, lane); }
        conv_finish(cb, rb, scr, lane);
    }
}
__device__ __forceinline__ int headperm_row(int n0) { const int pn = n0 >> 8, c = n0 & 255, hh = c >> 6, dh = (c & 63) >> 5; return pn * 256 + dh * 128 + hh * 32; }
__device__ __forceinline__ void rms_row_to_bf16(const float* xrow, const float* gain, bf16* orow, int lane) {
    const f32x4* xr = (const f32x4*)xrow + lane; const f32x4* gr = (const f32x4*)gain + lane;
    f32x4 v[4]; float s = 0.f;
#pragma unroll
    for (int j = 0; j < 4; ++j) { v[j] = xr[64 * j]; s += (v[j].x * v[j].x + v[j].y * v[j].y) + (v[j].z * v[j].z + v[j].w * v[j].w); }
    const float rstd = 1.0f / sqrtf(wave_sum(s) * (1.f / DM) + EPS);
    u32x2* o8 = (u32x2*)orow + lane;
#pragma unroll
    for (int j = 0; j < 4; ++j) { const f32x4 gg = gr[64 * j]; u32x2 w; w.x = cvtpk(v[j].x * rstd * gg.x, v[j].y * rstd * gg.y); w.y = cvtpk(v[j].z * rstd * gg.z, v[j].w * rstd * gg.w); o8[64 * j] = w; }
}

__device__ __forceinline__ void rms_row2_to_bf16(const float* xrow, const float* gain, bf16* orow, int lane, float* irs) {
    const f32x4* xr = (const f32x4*)xrow + lane; const f32x4* gr = (const f32x4*)gain + lane;
    f32x4 v[8]; float s0 = 0.f, s1 = 0.f;
#pragma unroll
    for (int j = 0; j < 8; ++j) v[j] = __builtin_nontemporal_load(xr + 64 * j);
#pragma unroll
    for (int j = 0; j < 4; ++j) { s0 += (v[j].x * v[j].x + v[j].y * v[j].y) + (v[j].z * v[j].z + v[j].w * v[j].w); s1 += (v[4 + j].x * v[4 + j].x + v[4 + j].y * v[4 + j].y) + (v[4 + j].z * v[4 + j].z + v[4 + j].w * v[4 + j].w); }
    const float q0 = sqrtf(wave_sum(s0) * (1.f / DM) + EPS), q1 = sqrtf(wave_sum(s1) * (1.f / DM) + EPS); const float r0 = 1.0f / q0, r1 = 1.0f / q1;
    if (irs != nullptr && lane == 0) { irs[0] = q0; irs[1] = q1; }
    u32x2* o8 = (u32x2*)orow + lane;
#pragma unroll
    for (int j = 0; j < 4; ++j) { const f32x4 gg = gr[64 * j]; u32x2 w; w.x = cvtpk(v[j].x * r0 * gg.x, v[j].y * r0 * gg.y); w.y = cvtpk(v[j].z * r0 * gg.z, v[j].w * r0 * gg.w); o8[64 * j] = w;
        u32x2 w2; w2.x = cvtpk(v[4 + j].x * r1 * gg.x, v[4 + j].y * r1 * gg.y); w2.y = cvtpk(v[4 + j].z * r1 * gg.z, v[4 + j].w * r1 * gg.w); o8[256 + 64 * j] = w2; }
}

#include <hip/hip_bf16.h>
namespace attn_body {
using s16x4=__attribute__((ext_vector_type(4)))short;
using f32x16=__attribute__((ext_vector_type(16)))float;
constexpr int D=64,NW=8,QBLK=32,QB=QBLK*NW,KVBLK=64;
__device__ __forceinline__ int crow(int r,int hi){return (r&3)+8*(r>>2)+4*hi;}
#define SBAR() __builtin_amdgcn_sched_barrier(0)
__device__ __forceinline__ void cmask(f32x16&p0,f32x16&p1,int jb,int qrel,int hi){
  const float NEG=-INFINITY; int kb=64*jb+4*hi;
  #pragma unroll
  for(int r=0;r<16;++r){int kv=kb+(r&3)+8*(r>>2); if(kv>qrel)p0[r]=NEG; if(kv+32>qrel)p1[r]=NEG;}
}
constexpr int NSLOT=3, SLOTB=8192;
constexpr int LDS_K=0, LDS_V=NSLOT*SLOTB, LDS_WS=2*NSLOT*SLOTB, LDS_OST=LDS_WS+NW*64*4, ATT_LDS_BYTES=LDS_OST+NW*4096;
__device__ __forceinline__ void glds16(const void*gsrc,unsigned lds_dst){unsigned keep;
  asm volatile("s_mov_b32 %0, m0\n\ts_mov_b32 m0, %2\n\ts_nop 0\n\tglobal_load_lds_dwordx4 %1, off\n\ts_mov_b32 m0, %0":"=&s"(keep):"v"(gsrc),"s"(lds_dst):"memory");}
__device__ __forceinline__ float max3f(float a,float b,float c){float r;asm("v_max3_f32 %0, %1, %2, %3":"=v"(r):"v"(a),"v"(b),"v"(c));return r;}
__device__ __forceinline__ float max2f(float a,float b){float r;asm("v_max_f32_e32 %0, %1, %2":"=v"(r):"v"(a),"v"(b));return r;}
__device__ __forceinline__ float fadd_s(float a,float b){float r;asm("v_add_f32_e32 %0, %1, %2":"=v"(r):"v"(a),"v"(b));return r;}
__device__ __forceinline__ float fsub_s(float a,float b){float r;asm("v_sub_f32_e32 %0, %1, %2":"=v"(r):"v"(a),"v"(b));return r;}
__device__ __forceinline__ unsigned cvtpk_s(float lo,float hi){return cvtpk(lo,hi);}
#define WAIT_BAR(N) asm volatile("s_waitcnt vmcnt(" #N ") lgkmcnt(0)\n\ts_barrier":::"memory")
__device__ __forceinline__ void qkt(f32x16&p0,f32x16&p1,const char*Kslot,const bf16x8*qr,const f32x16&negm,int r32,int hi){
  const char*kb=Kslot+hi*1024+r32*16;
  #pragma unroll
  for(int d0=0;d0<4;++d0){
    const bf16x8 b0=*reinterpret_cast<const bf16x8*>(kb+d0*2048);
    const bf16x8 b1=*reinterpret_cast<const bf16x8*>(kb+d0*2048+512);
    if(d0==0){p0=__builtin_amdgcn_mfma_f32_32x32x16_bf16(b0,qr[0],negm,0,0,0);p1=__builtin_amdgcn_mfma_f32_32x32x16_bf16(b1,qr[0],negm,0,0,0);}
    else{p0=__builtin_amdgcn_mfma_f32_32x32x16_bf16(b0,qr[d0],p0,0,0,0);p1=__builtin_amdgcn_mfma_f32_32x32x16_bf16(b1,qr[d0],p1,0,0,0);}}
}
typedef __attribute__((address_space(3))) const char* lds_cptr;
typedef short v4i16_t __attribute__((ext_vector_type(4)));
__device__ __forceinline__ void kload8(bf16x8*kf,lds_cptr kp){
  kf[0]=*(const __attribute__((address_space(3))) bf16x8*)(kp);      kf[1]=*(const __attribute__((address_space(3))) bf16x8*)(kp+512);
  kf[2]=*(const __attribute__((address_space(3))) bf16x8*)(kp+2048); kf[3]=*(const __attribute__((address_space(3))) bf16x8*)(kp+2560);
  kf[4]=*(const __attribute__((address_space(3))) bf16x8*)(kp+4096); kf[5]=*(const __attribute__((address_space(3))) bf16x8*)(kp+4608);
  kf[6]=*(const __attribute__((address_space(3))) bf16x8*)(kp+6144); kf[7]=*(const __attribute__((address_space(3))) bf16x8*)(kp+6656);
}
__device__ __forceinline__ void kload2(bf16x8*kf,lds_cptr kp,int j){ kf[2*j]=*(const __attribute__((address_space(3))) bf16x8*)(kp+j*2048); kf[2*j+1]=*(const __attribute__((address_space(3))) bf16x8*)(kp+j*2048+512); }
__device__ __forceinline__ s16x4 vtr(lds_cptr p){ return __builtin_bit_cast(s16x4,__builtin_amdgcn_ds_read_tr16_b64_v4i16((__attribute__((address_space(3))) v4i16_t*)p)); }
__device__ __forceinline__ float rowmax(const f32x16&p0,const f32x16&p1){
  float a=max3f(p0[0],p0[1],p1[0]),b=max3f(p0[2],p0[3],p1[1]);a=max3f(a,p1[2],p1[3]);
  #pragma unroll
  for(int r=4;r<16;r+=4){a=max3f(a,p0[r],p0[r+1]);b=max3f(b,p0[r+2],p0[r+3]);a=max3f(a,p1[r],p1[r+1]);b=max3f(b,p1[r+2],p1[r+3]);}
  const float m=max2f(a,b);
  auto rr=__builtin_amdgcn_permlane32_swap(__float_as_uint(m),__float_as_uint(m),false,false);
  return max2f(__uint_as_float(rr[0]),__uint_as_float(rr[1]));
}
__device__ __forceinline__ void pv(f32x16*o,int vb,bf16x8 pa0,bf16x8 pa1,bf16x8 pa2,bf16x8 pa3){
  #pragma unroll
  for(int d0=0;d0<2;++d0){s16x4 lo[4],hi[4];
    #pragma unroll
    for(int ks=0;ks<4;++ks){
      asm volatile("ds_read_b64_tr_b16 %0,%1 offset:%c2":"=&v"(lo[ks]):"v"(vb),"i"(d0*4096+ks*1024):"memory");
      asm volatile("ds_read_b64_tr_b16 %0,%1 offset:%c2":"=&v"(hi[ks]):"v"(vb),"i"(d0*4096+ks*1024+512):"memory");}
    asm volatile("s_waitcnt lgkmcnt(0)":::"memory");SBAR();
    #define PK(k) (bf16x8){lo[k][0],lo[k][1],lo[k][2],lo[k][3],hi[k][0],hi[k][1],hi[k][2],hi[k][3]}
    o[d0]=__builtin_amdgcn_mfma_f32_32x32x16_bf16(pa0,PK(0),o[d0],0,0,0);
    o[d0]=__builtin_amdgcn_mfma_f32_32x32x16_bf16(pa1,PK(1),o[d0],0,0,0);
    o[d0]=__builtin_amdgcn_mfma_f32_32x32x16_bf16(pa2,PK(2),o[d0],0,0,0);
    o[d0]=__builtin_amdgcn_mfma_f32_32x32x16_bf16(pa3,PK(3),o[d0],0,0,0);
    #undef PK
  }
}
template<int THRL,int KP,int OP,bool MOBA> __device__ __forceinline__ void attn_unit(const bf16*Qu,const bf16*__restrict__ Kh,const bf16*__restrict__ Vh,bf16*Ou,const int NT,const int nblk,const float*kmean,char*shm){
  const int tid=opaque((int)threadIdx.x),lane=tid&63,r32=lane&31,hi=lane>>5; const int wid=__builtin_amdgcn_readfirstlane(tid>>6);
  const bf16*Qw=Qu+(long)(wid*QBLK)*KP;
  const unsigned lds0=(unsigned)(uintptr_t)shm;
  float*wsf=(float*)(shm+LDS_WS)+wid*64;
  const bf16*ksrc=Kh+(long)lane*KP+wid*8;
  const bf16*vsrc=Vh+(long)(16*(wid&3)+(lane>>2))*KP+(wid>>2)*32+(lane&3)*8;
  const unsigned kdst=lds0+LDS_K+wid*1024, vdst=lds0+LDS_V+wid*1024;
  #define DMA_K(t,slot) glds16(ksrc+(long)(t)*KVBLK*KP,(unsigned)__builtin_amdgcn_readfirstlane(kdst+(slot)))
  #define DMA_V(t,slot) glds16(vsrc+(long)(t)*KVBLK*KP,(unsigned)__builtin_amdgcn_readfirstlane(vdst+(slot)))
  const int vb0=(int)(lds0+LDS_V)+((lane>>4)&1)*32+(lane&3)*8+(4*hi+((lane&15)>>2))*64;
  const char*Kbase=shm+LDS_K; bf16x8 kf[8];
  const lds_cptr shm3=(lds_cptr)shm; const lds_cptr kp0=shm3+LDS_K+hi*1024+r32*16; const lds_cptr vp0=shm3+LDS_V+((lane>>4)&1)*32+(lane&3)*8+(4*hi+((lane&15)>>2))*64;
  if(MOBA){ if(wid<4) glds16(kmean+(long)(4*wid+(lane>>4))*512+(lane&15)*4,(unsigned)__builtin_amdgcn_readfirstlane(lds0+ATT_LDS_BYTES+wid*1024)); }
  DMA_K(0,0);DMA_V(0,0);DMA_K(1,SLOTB);
  bf16x8 qr[4];
  #pragma unroll
  for(int d0=0;d0<4;++d0)qr[d0]=*reinterpret_cast<const bf16x8*>(&Qw[(long)r32*KP+d0*16+hi*8]);
  unsigned bmask=0xffffffffu;
  if(MOBA){
    bmask=1u<<nblk;
    float g0=-3e38f,g1=-3e38f,g2=-3e38f; int i0=-1,i1=-1,i2=-1;
    asm volatile("s_waitcnt vmcnt(0)\n\ts_barrier":::"memory");
    const __attribute__((address_space(3))) float*kml=(const __attribute__((address_space(3))) float*)(shm3+ATT_LDS_BYTES)+8*hi;
    for(int j=0;j<nblk;++j){
      const __attribute__((address_space(3))) float*km=kml+j*64; float g=0.f;
      #pragma unroll
      for(int d0=0;d0<4;++d0){ const f32x4 a=*(const __attribute__((address_space(3))) f32x4*)(km+16*d0),b=*(const __attribute__((address_space(3))) f32x4*)(km+16*d0+4);
        g+=bf2f((unsigned short)qr[d0][0])*a[0]+bf2f((unsigned short)qr[d0][1])*a[1]+bf2f((unsigned short)qr[d0][2])*a[2]+bf2f((unsigned short)qr[d0][3])*a[3];
        g+=bf2f((unsigned short)qr[d0][4])*b[0]+bf2f((unsigned short)qr[d0][5])*b[1]+bf2f((unsigned short)qr[d0][6])*b[2]+bf2f((unsigned short)qr[d0][7])*b[3]; }
      g+=__shfl_xor(g,32);
      if(g>g0){g2=g1;i2=i1;g1=g0;i1=i0;g0=g;i0=j;} else if(g>g1){g2=g1;i2=i1;g1=g;i1=j;} else if(g>g2){g2=g;i2=j;}
    }
    if(i0>=0)bmask|=1u<<i0; if(i1>=0)bmask|=1u<<i1; if(i2>=0)bmask|=1u<<i2;
  }
  #define NEGM_FOR(t) (MOBA ? (((bmask>>((t)>>2))&1u) ? -mhat : -INFINITY) : -mhat)
  float mhat=0.f,l_reg=0.f;f32x16 o[2];o[0]=f32x16{};o[1]=f32x16{};f32x16 negm;
  { const float nm=NEGM_FOR(0);
    #pragma unroll
    for(int r=0;r<16;++r)negm[r]=nm; }
  asm volatile("":"+v"(negm));
  const int qrel=wid*QBLK+r32;
  #define CMASK(P0,P1,t) do{ if(MOBA){int jb_=(t)-(NT-4); if(jb_>=0)cmask(P0,P1,jb_,qrel,hi);} }while(0)
  bool resc=false;
  #define START(P0,P1) do{ const float rm=rowmax(P0,P1); resc=false; \
    { const float dl=(MOBA&&rm==-INFINITY)?0.f:rm; mhat=fadd_s(mhat,dl); \
      _Pragma("unroll") for(int r=0;r<16;++r){P0[r]=fsub_s(P0[r],dl);P1[r]=fsub_s(P1[r],dl);} \
      { const float nm=NEGM_FOR(1); _Pragma("unroll") for(int r=0;r<16;++r)negm[r]=nm; } asm volatile("":"+v"(negm)); } \
    _Pragma("unroll") for(int r=0;r<16;++r)P0[r]=__builtin_amdgcn_exp2f(P0[r]); }while(0)
  #define RESC() do{ if(resc){ asm volatile("s_waitcnt lgkmcnt(0)":::"memory"); \
      _Pragma("unroll") for(int d_=0;d_<2;++d_) _Pragma("unroll") for(int r=0;r<16;++r)o[d_][r]*=wsf[crow(r,hi)]; } }while(0)
  f32x16 pA0,pA1,pB0,pB1;
  int sl_prev=0,sl_cur=0,sl_next=SLOTB;
  #define ROT() do{sl_prev=sl_cur;sl_cur=sl_next;sl_next=(sl_next==(NSLOT-1)*SLOTB)?0:sl_next+SLOTB;}while(0)
  DMA_K(2,2*SLOTB);
  WAIT_BAR(3);
  qkt(pA0,pA1,Kbase,qr,negm,r32,hi);asm volatile("s_nop 15\n\ts_nop 7":"+v"(pA0),"+v"(pA1));CMASK(pA0,pA1,0);
  START(pA0,pA1);
  _Pragma("unroll") for(int r=0;r<16;++r)pA1[r]=__builtin_amdgcn_exp2f(pA1[r]);
  WAIT_BAR(0);
  DMA_K(3,0);DMA_V(1,SLOTB);
  ROT();
  kload8(kf,kp0+sl_cur);
  WAIT_BAR(2);
  s16x4 vlo[8],vhi[8]; u32x4 pw0,pw1,pw2,pw3;
  #define PKW(P,B) cvtpk_s(P[B],P[B+1])
  #define PAF(k) __builtin_bit_cast(bf16x8,pw##k)
  #define VFR(i) (bf16x8){vlo[i][0],vlo[i][1],vlo[i][2],vlo[i][3],vhi[i][0],vhi[i][1],vhi[i][2],vhi[i][3]}
  #define PIN(x) asm volatile("":"+v"(x))
  #define MX3(a,b,c) __builtin_fmaxf(__builtin_fmaxf((a),(b)),(c))
  #define GAPA(MF,A0,A1,A2,A3,W0,W1,PW) do{ MF; sacc+=A0; sacc+=A1; sacc+=A2; sacc+=A3; PIN(sacc); W0; W1; PIN(PW); SBAR(); }while(0)
  #define EX(v) __builtin_amdgcn_exp2f(v)
  #define GAPB(MF,X,B) do{ MF; X[B]=EX(X[B]); X[B+1]=EX(X[B+1]); X[B+2]=EX(X[B+2]); X[B+3]=EX(X[B+3]); PIN(X); SBAR(); }while(0)
  #define VRD(i) do{ vlo[i]=vtr(vp_+(((i)>>2)*4096+((i)&3)*1024)); vhi[i]=vtr(vp_+(((i)>>2)*4096+((i)&3)*1024+512)); }while(0)
  #define KRD(G,j) do{ if(G){ kload2(kf,kp0+sl_next,j); SBAR(); } }while(0)
  #define STEP(C0,C1,P0,P1,t,GK,GV,GL) do{ SBAR(); \
    const lds_cptr vp_=vp0+sl_prev; \
    VRD(0); SBAR(); float sacc=(P0[0]+P0[1]); \
    GAPA(C0=__builtin_amdgcn_mfma_f32_32x32x16_bf16(kf[0],qr[0],negm,0,0,0), P0[2],P0[3],P0[4],P0[5],     pw0[0]=PKW(P0,0), pw0[1]=PKW(P0,2), pw0); \
    VRD(4); SBAR(); GAPA(C1=__builtin_amdgcn_mfma_f32_32x32x16_bf16(kf[1],qr[0],negm,0,0,0), P0[6],P0[7],P0[8],P0[9],     pw0[2]=PKW(P0,4), pw0[3]=PKW(P0,6), pw0); \
    VRD(1); SBAR(); GAPA(C0=__builtin_amdgcn_mfma_f32_32x32x16_bf16(kf[2],qr[1],C0,0,0,0),   P0[10],P0[11],P0[12],P0[13], pw1[0]=PKW(P0,8), pw1[1]=PKW(P0,10), pw1); \
    VRD(5); SBAR(); GAPA(C1=__builtin_amdgcn_mfma_f32_32x32x16_bf16(kf[3],qr[1],C1,0,0,0),   P0[14],P0[15],P1[0],P1[1],   pw1[2]=PKW(P0,12),pw1[3]=PKW(P0,14), pw1); \
    VRD(2); SBAR(); GAPA(C0=__builtin_amdgcn_mfma_f32_32x32x16_bf16(kf[4],qr[2],C0,0,0,0),   P1[2],P1[3],P1[4],P1[5],     pw2[0]=PKW(P1,0), pw2[1]=PKW(P1,2), pw2); \
    VRD(6); SBAR(); GAPA(C1=__builtin_amdgcn_mfma_f32_32x32x16_bf16(kf[5],qr[2],C1,0,0,0),   P1[6],P1[7],P1[8],P1[9],     pw2[2]=PKW(P1,4), pw2[3]=PKW(P1,6), pw2); \
    VRD(3); SBAR(); GAPA(C0=__builtin_amdgcn_mfma_f32_32x32x16_bf16(kf[6],qr[3],C0,0,0,0),   P1[10],P1[11],P1[12],P1[13], pw3[0]=PKW(P1,8), pw3[1]=PKW(P1,10), pw3); \
    VRD(7); SBAR(); GAPA(C1=__builtin_amdgcn_mfma_f32_32x32x16_bf16(kf[7],qr[3],C1,0,0,0),   P1[14],P1[15],0.f,0.f,       pw3[2]=PKW(P1,12),pw3[3]=PKW(P1,14), pw3); \
    l_reg+=sacc; \
    if(GK){DMA_K((t)+3,sl_cur);} if(GV){DMA_V((t)+1,sl_next);} \
    CMASK(C0,C1,t); \
    { float a=MX3(C0[0],C0[1],C1[0]),b=MX3(C0[2],C0[3],C1[1]); a=MX3(a,C1[2],C1[3]); \
      _Pragma("unroll") for(int r=4;r<16;r+=4){a=MX3(a,C0[r],C0[r+1]);b=MX3(b,C0[r+2],C0[r+3]);a=MX3(a,C1[r],C1[r+1]);b=MX3(b,C1[r+2],C1[r+3]);} \
      float rm=__builtin_fmaxf(a,b); { auto rr=__builtin_amdgcn_permlane32_swap(__float_as_uint(rm),__float_as_uint(rm),false,false); rm=__builtin_fmaxf(__uint_as_float(rr[0]),__uint_as_float(rr[1])); } \
      resc=false; \
      if(__builtin_expect(__any(rm>(float)THRL),0)){ const float dl=__builtin_fmaxf(rm,0.f); mhat+=dl; \
        _Pragma("unroll") for(int r=0;r<16;++r){C0[r]-=dl;C1[r]-=dl;} \
        if(!MOBA){ _Pragma("unroll") for(int r=0;r<16;++r)negm[r]=-mhat; asm volatile("":"+v"(negm)); } \
        const float f=__builtin_amdgcn_exp2f(-dl); l_reg*=f; if(hi==0)wsf[r32]=f; resc=true; } \
      if(MOBA){ if(resc||((((t)+1)&3)==0)){ const float nm=NEGM_FOR((t)+1); _Pragma("unroll") for(int r=0;r<16;++r)negm[r]=nm; asm volatile("":"+v"(negm)); } } } \
    SBAR(); \
    GAPB(o[0]=__builtin_amdgcn_mfma_f32_32x32x16_bf16(PAF(0),VFR(0),o[0],0,0,0), C0,0); \
    GAPB(o[1]=__builtin_amdgcn_mfma_f32_32x32x16_bf16(PAF(0),VFR(4),o[1],0,0,0), C0,4); \
    KRD(GL,0); GAPB(o[0]=__builtin_amdgcn_mfma_f32_32x32x16_bf16(PAF(1),VFR(1),o[0],0,0,0), C0,8); \
    KRD(GL,1); GAPB(o[1]=__builtin_amdgcn_mfma_f32_32x32x16_bf16(PAF(1),VFR(5),o[1],0,0,0), C0,12); \
    KRD(GL,2); GAPB(o[0]=__builtin_amdgcn_mfma_f32_32x32x16_bf16(PAF(2),VFR(2),o[0],0,0,0), C1,0); \
    KRD(GL,3); GAPB(o[1]=__builtin_amdgcn_mfma_f32_32x32x16_bf16(PAF(2),VFR(6),o[1],0,0,0), C1,4); \
    GAPB(o[0]=__builtin_amdgcn_mfma_f32_32x32x16_bf16(PAF(3),VFR(3),o[0],0,0,0), C1,8); \
    GAPB(o[1]=__builtin_amdgcn_mfma_f32_32x32x16_bf16(PAF(3),VFR(7),o[1],0,0,0), C1,12); \
    }while(0)
  int t=1;
  #undef CMASK
  #define CMASK(P0,P1,t) do{}while(0)
  for(;t+5<NT;t+=2){
    STEP(pB0,pB1,pA0,pA1,t,true,true,true);     WAIT_BAR(2); RESC(); ROT();
    STEP(pA0,pA1,pB0,pB1,t+1,true,true,true);   WAIT_BAR(2); RESC(); ROT();
  }
  #undef CMASK
  #define CMASK(P0,P1,t) do{ if(MOBA){int jb_=(t)-(NT-4); if(jb_>=0)cmask(P0,P1,jb_,qrel,hi);} }while(0)
  #define ENDW(tt) do{ if((tt)+3<NT){WAIT_BAR(2);} else if((tt)+2<NT){WAIT_BAR(1);} else {WAIT_BAR(0);} }while(0)
  for(;t+1<NT;t+=2){
    STEP(pB0,pB1,pA0,pA1,t,(t+3<NT),(t+1<NT),(t+1<NT));       ENDW(t);   RESC(); ROT();
    STEP(pA0,pA1,pB0,pB1,t+1,(t+4<NT),(t+2<NT),(t+2<NT));     ENDW(t+1); RESC(); ROT();
  }
  STEP(pB0,pB1,pA0,pA1,NT-1,false,false,false); RESC();
  { float sacc=pB0[0]+pB0[1]; _Pragma("unroll") for(int r=2;r<16;++r)sacc+=pB0[r]; _Pragma("unroll") for(int r=0;r<16;++r)sacc+=pB1[r]; l_reg+=sacc;
    pw0=(u32x4){PKW(pB0,0),PKW(pB0,2),PKW(pB0,4),PKW(pB0,6)};pw1=(u32x4){PKW(pB0,8),PKW(pB0,10),PKW(pB0,12),PKW(pB0,14)};pw2=(u32x4){PKW(pB1,0),PKW(pB1,2),PKW(pB1,4),PKW(pB1,6)};pw3=(u32x4){PKW(pB1,8),PKW(pB1,10),PKW(pB1,12),PKW(pB1,14)};
    SBAR(); pv(o,vb0+sl_cur,PAF(0),PAF(1),PAF(2),PAF(3)); }
  #undef PKW
  #undef PAF
  #undef VFR
  #undef PIN
  #undef MX3
  #undef GAPA
  #undef GAPB
  #undef EX
  #undef VRD
  #undef KRD
  #undef STEP
  #undef ENDW
  {auto rr=__builtin_amdgcn_permlane32_swap(__float_as_uint(l_reg),__float_as_uint(l_reg),false,false);l_reg=__uint_as_float(rr[0])+__uint_as_float(rr[1]);}
  if(hi==0)wsf[32+r32]=l_reg;asm volatile("s_waitcnt lgkmcnt(0)":::"memory");
  float rli[16];
  #pragma unroll
  for(int r=0;r<16;++r)rli[r]=__builtin_amdgcn_rcpf(wsf[32+crow(r,hi)]);
  bf16*Ow=Ou+(long)(wid*QBLK)*OP;
  { bf16*stg=(bf16*)(shm+LDS_OST)+wid*2048;
    #pragma unroll
    for(int r=0;r<16;++r){const int orow=crow(r,hi);
      #pragma unroll
      for(int d0=0;d0<2;++d0)stg[orow*64+d0*32+r32]=(bf16)(cvtpk(o[d0][r]*rli[r],0.f)&0xffffu);}
    asm volatile("s_waitcnt lgkmcnt(0)":::"memory");
    #pragma unroll
    for(int i=0;i<4;++i){const int row=i*8+(lane>>3),ch=lane&7; const u32x4 v=*(const u32x4*)(stg+row*64+ch*8); *(u32x4*)(Ow+(long)row*OP+ch*8)=v;} }
  asm volatile("s_waitcnt lgkmcnt(0)\n\ts_barrier":::"memory");
  #undef DMA_K
  #undef DMA_V
  #undef CMASK
  #undef START
  #undef RESC
  #undef ROT
  #undef NEGM_FOR
}
#undef SBAR
#undef WAIT_BAR
}

namespace ret_body {
using attn_body::s16x4; using attn_body::f32x16; using attn_body::glds16; using attn_body::pv; using attn_body::crow;
constexpr int KVF_BYTES = 64 * 64 * 4;
__device__ __forceinline__ void kv_unit(const bf16* KR, const bf16* VR, float* KVF, int b, int h, int cp, char* shm) {
  const int tid = opaque((int)threadIdx.x), lane = tid & 63, r32 = lane & 31, hi = lane >> 5; const int wid = __builtin_amdgcn_readfirstlane(tid >> 6);
  const unsigned lds0 = (unsigned)(uintptr_t)shm;
  const size_t rowb = (size_t)b * SEQ + (size_t)cp * 256;
  const long voff = (long)(16 * (wid & 3) + (lane >> 2)) * 256 + h * 64 + (wid >> 2) * 32 + (lane & 3) * 8;
#pragma unroll
  for (int c = 0; c < 2; ++c)
#pragma unroll
    for (int tl = 0; tl < 2; ++tl) {
      const size_t r0 = rowb + c * 128 + tl * 64;
      glds16(KR + r0 * 256 + voff, (unsigned)__builtin_amdgcn_readfirstlane(lds0 + ((c * 2 + 0) * 2 + tl) * 8192 + wid * 1024));
      glds16(VR + r0 * 256 + voff, (unsigned)__builtin_amdgcn_readfirstlane(lds0 + ((c * 2 + 1) * 2 + tl) * 8192 + wid * 1024));
    }
  asm volatile("s_waitcnt vmcnt(0) lgkmcnt(0)\n\ts_barrier" ::: "memory");
  const int c = wid >> 2, dkb = (wid >> 1) & 1, dvb = wid & 1;
  const int vb = (int)lds0 + ((lane >> 4) & 1) * 32 + (lane & 3) * 8 + (4 * hi + ((lane & 15) >> 2)) * 64;
  f32x16 acc = f32x16{};
#pragma unroll
  for (int tl = 0; tl < 2; ++tl) {
    s16x4 alo[4], ahi[4], blo[4], bhi[4];
    const int ka = vb + ((c * 2 + 0) * 2 + tl) * 8192 + dkb * 4096, va = vb + ((c * 2 + 1) * 2 + tl) * 8192 + dvb * 4096;
#pragma unroll
    for (int ks = 0; ks < 4; ++ks) {
      asm volatile("ds_read_b64_tr_b16 %0,%1 offset:%c2" : "=&v"(alo[ks]) : "v"(ka), "i"(ks * 1024) : "memory");
      asm volatile("ds_read_b64_tr_b16 %0,%1 offset:%c2" : "=&v"(ahi[ks]) : "v"(ka), "i"(ks * 1024 + 512) : "memory");
      asm volatile("ds_read_b64_tr_b16 %0,%1 offset:%c2" : "=&v"(blo[ks]) : "v"(va), "i"(ks * 1024) : "memory");
      asm volatile("ds_read_b64_tr_b16 %0,%1 offset:%c2" : "=&v"(bhi[ks]) : "v"(va), "i"(ks * 1024 + 512) : "memory");
    }
    asm volatile("s_waitcnt lgkmcnt(0)" ::: "memory"); __builtin_amdgcn_sched_barrier(0);
#pragma unroll
    for (int ks = 0; ks < 4; ++ks) {
      const bf16x8 af = (bf16x8){alo[ks][0], alo[ks][1], alo[ks][2], alo[ks][3], ahi[ks][0], ahi[ks][1], ahi[ks][2], ahi[ks][3]};
      const bf16x8 bfr = (bf16x8){blo[ks][0], blo[ks][1], blo[ks][2], blo[ks][3], bhi[ks][0], bhi[ks][1], bhi[ks][2], bhi[ks][3]};
      acc = __builtin_amdgcn_mfma_f32_32x32x16_bf16(af, bfr, acc, 0, 0, 0);
    }
  }
  const float lgam = __builtin_amdgcn_logf(1.0f - __builtin_amdgcn_exp2f(-5.0f - (float)h));
  const float g127 = __builtin_amdgcn_exp2f(lgam * 127.0f);
  float* outp = KVF + ((size_t)((b * 4 + h) * 32 + cp * 2 + c)) * 4096 + dvb * 32 + r32;
#pragma unroll
  for (int r = 0; r < 16; ++r) outp[(size_t)(dkb * 32 + crow(r, hi)) * 64] = acc[r] * g127;
  asm volatile("s_waitcnt lgkmcnt(0)\n\ts_barrier" ::: "memory");
}

__device__ __forceinline__ void out_unit(const bf16* QR, const bf16* KR, const bf16* VR, const bf16* GR, const float* KVF, const float* rgain, bf16* Y, int b, int h, int cp, char* shm) {
  const int tid = opaque((int)threadIdx.x), lane = tid & 63, r32 = lane & 31, hi = lane >> 5; const int wid = __builtin_amdgcn_readfirstlane(tid >> 6);
  const unsigned lds0 = (unsigned)(uintptr_t)shm;
  constexpr int L_K = 0, L_V = 32768, L_S = 65536, L_O = 81920;
  const size_t rowb = (size_t)b * SEQ + (size_t)cp * 256;
  const long koff = (long)lane * 256 + h * 64 + wid * 8;
  const long voff = (long)(16 * (wid & 3) + (lane >> 2)) * 256 + h * 64 + (wid >> 2) * 32 + (lane & 3) * 8;
#pragma unroll
  for (int tl = 0; tl < 4; ++tl) {
    const size_t r0 = rowb + tl * 64;
    glds16(KR + r0 * 256 + koff, (unsigned)__builtin_amdgcn_readfirstlane(lds0 + L_K + tl * 8192 + wid * 1024));
    glds16(VR + r0 * 256 + voff, (unsigned)__builtin_amdgcn_readfirstlane(lds0 + L_V + tl * 8192 + wid * 1024));
  }
  {
    const float lgam = __builtin_amdgcn_logf(1.0f - __builtin_amdgcn_exp2f(-5.0f - (float)h));
    const float lgc = lgam * 128.0f;
    const int n0 = 2 * cp;
    int mlo = n0 - 1 - (int)(34.0f / (-lgc)); if (mlo < 0) mlo = 0;
    const float* kvp = KVF + ((size_t)((b * 4 + h) * 32)) * 4096 + tid * 8;
    f32x4 s0 = {0.f, 0.f, 0.f, 0.f}, s1 = {0.f, 0.f, 0.f, 0.f};
    int m = mlo;
    for (; m + 8 <= n0; m += 8) {
      f32x4 a[8], c4[8];
#pragma unroll
      for (int q = 0; q < 8; ++q) { a[q] = *(const f32x4*)(kvp + (size_t)(m + q) * 4096); c4[q] = *(const f32x4*)(kvp + (size_t)(m + q) * 4096 + 4); }
#pragma unroll
      for (int q = 0; q < 8; ++q) { const float w = __builtin_amdgcn_exp2f(lgc * (float)(n0 - 1 - m - q)); s0 += a[q] * w; s1 += c4[q] * w; }
    }
    for (; m + 4 <= n0; m += 4) {
      f32x4 a[4], c4[4];
#pragma unroll
      for (int q = 0; q < 4; ++q) { a[q] = *(const f32x4*)(kvp + (size_t)(m + q) * 4096); c4[q] = *(const f32x4*)(kvp + (size_t)(m + q) * 4096 + 4); }
#pragma unroll
      for (int q = 0; q < 4; ++q) { const float w = __builtin_amdgcn_exp2f(lgc * (float)(n0 - 1 - m - q)); s0 += a[q] * w; s1 += c4[q] * w; }
    }
    for (; m < n0; ++m) {
      const float w = __builtin_amdgcn_exp2f(lgc * (float)(n0 - 1 - m));
      const f32x4 a = *(const f32x4*)(kvp + (size_t)m * 4096), c4 = *(const f32x4*)(kvp + (size_t)m * 4096 + 4);
      s0 += a * w; s1 += c4 * w;
    }
    const int dk = tid >> 3, dv = 8 * (tid & 7);
    char* sp = shm + L_S + (dv >> 5) * 4096 + dk * 64 + (dv & 31) * 2;
    u32x4 w0; w0.x = cvtpk(s0[0], s0[1]); w0.y = cvtpk(s0[2], s0[3]); w0.z = cvtpk(s1[0], s1[1]); w0.w = cvtpk(s1[2], s1[3]);
    *(u32x4*)sp = w0;
    const float dc = __builtin_amdgcn_exp2f(lgc);
    const f32x4 a = *(const f32x4*)(kvp + (size_t)n0 * 4096), c4 = *(const f32x4*)(kvp + (size_t)n0 * 4096 + 4);
    s0 = s0 * dc + a; s1 = s1 * dc + c4;
    u32x4 w1; w1.x = cvtpk(s0[0], s0[1]); w1.y = cvtpk(s0[2], s0[3]); w1.z = cvtpk(s1[0], s1[1]); w1.w = cvtpk(s1[2], s1[3]);
    *(u32x4*)(sp + 8192) = w1;
  }
  const int c = wid >> 2, wq = wid & 3;
  const bf16* Qw = QR + (rowb + c * 128 + wq * 32 + r32) * 256 + h * 64;
  bf16x8 qr[4]; u32x4 qa[4];
#pragma unroll
  for (int d0 = 0; d0 < 4; ++d0) qr[d0] = *reinterpret_cast<const bf16x8*>(Qw + d0 * 16 + hi * 8);
#pragma unroll
  for (int k = 0; k < 4; ++k) { const u32x2 lo = *(const u32x2*)(Qw + 16 * k + 4 * hi), hi2 = *(const u32x2*)(Qw + 16 * k + 8 + 4 * hi); qa[k] = (u32x4){lo.x, lo.y, hi2.x, hi2.y}; }
  asm volatile("s_waitcnt vmcnt(0) lgkmcnt(0)\n\ts_barrier" ::: "memory");
  const int vb = (int)lds0 + ((lane >> 4) & 1) * 32 + (lane & 3) * 8 + (4 * hi + ((lane & 15) >> 2)) * 64;
  f32x16 o[2]; o[0] = f32x16{}; o[1] = f32x16{};
  pv(o, vb + L_S + c * 8192, __builtin_bit_cast(bf16x8, qa[0]), __builtin_bit_cast(bf16x8, qa[1]), __builtin_bit_cast(bf16x8, qa[2]), __builtin_bit_cast(bf16x8, qa[3]));
  { const float gam = 1.0f - __builtin_amdgcn_exp2f(-5.0f - (float)h);
#pragma unroll
    for (int d0 = 0; d0 < 2; ++d0)
#pragma unroll
      for (int r = 0; r < 16; ++r) o[d0][r] *= gam; }
  const f32x16 zero = f32x16{};
  const int irow = wq * 32 + r32;
  for (int tl = 0; tl <= (wq >> 1); ++tl) {
    f32x16 p0, p1;
    attn_body::qkt(p0, p1, shm + L_K + (c * 2 + tl) * 8192, qr, zero, r32, hi);
    asm volatile("s_nop 15\n\ts_nop 7" : "+v"(p0), "+v"(p1));
#pragma unroll
    for (int r = 0; r < 16; ++r) { const int kj = 64 * tl + crow(r, hi); if (kj > irow) p0[r] = 0.f; if (kj + 32 > irow) p1[r] = 0.f; }
    u32x4 pw0, pw1, pw2, pw3;
    pw0 = (u32x4){cvtpk(p0[0], p0[1]), cvtpk(p0[2], p0[3]), cvtpk(p0[4], p0[5]), cvtpk(p0[6], p0[7])}; pw1 = (u32x4){cvtpk(p0[8], p0[9]), cvtpk(p0[10], p0[11]), cvtpk(p0[12], p0[13]), cvtpk(p0[14], p0[15])};
    pw2 = (u32x4){cvtpk(p1[0], p1[1]), cvtpk(p1[2], p1[3]), cvtpk(p1[4], p1[5]), cvtpk(p1[6], p1[7])}; pw3 = (u32x4){cvtpk(p1[8], p1[9]), cvtpk(p1[10], p1[11]), cvtpk(p1[12], p1[13]), cvtpk(p1[14], p1[15])};
    __builtin_amdgcn_sched_barrier(0);
    pv(o, vb + L_V + (c * 2 + tl) * 8192, __builtin_bit_cast(bf16x8, pw0), __builtin_bit_cast(bf16x8, pw1), __builtin_bit_cast(bf16x8, pw2), __builtin_bit_cast(bf16x8, pw3));
  }
  asm volatile("s_waitcnt lgkmcnt(0)\n\ts_barrier" ::: "memory");
  { float* stg = (float*)(shm + L_O) + wid * 2048;
#pragma unroll
    for (int r = 0; r < 16; ++r) { const int orow = crow(r, hi);
#pragma unroll
      for (int d0 = 0; d0 < 2; ++d0) stg[orow * 64 + d0 * 32 + r32] = o[d0][r]; }
    asm volatile("s_waitcnt lgkmcnt(0)" ::: "memory");
    const int row = lane >> 1, half = lane & 1;
    const f32x4* sr = (const f32x4*)(stg + row * 64 + half * 32);
    f32x4 v[8]; float ss = 0.f;
#pragma unroll
    for (int i = 0; i < 8; ++i) { v[i] = sr[i]; ss += (v[i][0] * v[i][0] + v[i][1] * v[i][1]) + (v[i][2] * v[i][2] + v[i][3] * v[i][3]); }
    ss += __shfl_xor(ss, 1);
    const float rstd = 1.0f / sqrtf(ss * (1.0f / 64.0f) + EPS);
    const size_t grow = rowb + c * 128 + wq * 32 + row;
    const u32x4* gp = (const u32x4*)(GR + grow * 256 + h * 64 + half * 32);
    const f32x4* rg = (const f32x4*)(rgain + h * 64 + half * 32);
    u32x4* yp = (u32x4*)(Y + grow * DM + 512 + h * 64 + half * 32);
#pragma unroll
    for (int i = 0; i < 4; ++i) {
      const u32x4 gw = gp[i]; const f32x4 g0 = rg[2 * i], g1 = rg[2 * i + 1]; const f32x4 a = v[2 * i] * rstd * g0, c4 = v[2 * i + 1] * rstd * g1;
      u32x4 w; w.x = cvtpk(a[0] * bflo(gw.x), a[1] * bfhi(gw.x)); w.y = cvtpk(a[2] * bflo(gw.y), a[3] * bfhi(gw.y)); w.z = cvtpk(c4[0] * bflo(gw.z), c4[1] * bfhi(gw.z)); w.w = cvtpk(c4[2] * bflo(gw.w), c4[3] * bfhi(gw.w));
      yp[i] = w;
    }
  }
  asm volatile("s_waitcnt lgkmcnt(0)\n\ts_barrier" ::: "memory");
}
}

#define XB_TMO      128
#define XB_XCNT(j)  (256  + 64 * (j))
#define XB_XSUB(j)  (1280 + 64 * (j))
#define XB_XGEN(j)  (2304 + 64 * (j))
#define XB_TOP      3328
#define XB_TOPGEN   3392
#define XCD_BAR_WORDS 3456
#define XB_SPIN_CAP (1u << 18)
__device__ __forceinline__ unsigned xb_ld(unsigned* p)              { return __hip_atomic_load(p, __ATOMIC_RELAXED, __HIP_MEMORY_SCOPE_AGENT); }
__device__ __forceinline__ unsigned xb_add(unsigned* p, unsigned v) { return __hip_atomic_fetch_add(p, v, __ATOMIC_RELAXED, __HIP_MEMORY_SCOPE_AGENT); }
__device__ __forceinline__ unsigned xb_xcc_id() { return (unsigned)__builtin_amdgcn_s_getreg((3 << 11) | 20) & 0xFu; }
#define XB_SPIN(cond, bar) do { unsigned _sp = 0; while (cond) { __builtin_amdgcn_s_sleep(1); \
    if ((++_sp & 255u) == 0u) { if (xb_ld(&(bar)[XB_TMO])) break; if (_sp > XB_SPIN_CAP) { atomicAdd(&(bar)[XB_TMO], 1u); break; } } } } while (0)
struct XcdBarrier { unsigned* bar; unsigned x; volatile LAS unsigned* st; };
__device__ __forceinline__ XcdBarrier xcd_barrier_post(unsigned* bar, volatile LAS unsigned* st) {
    XcdBarrier b; b.bar = bar; b.x = xb_xcc_id(); b.st = st;
    if (threadIdx.x == 0) (void)xb_add(&bar[XB_XCNT(b.x)], 1u);
    return b;
}
__device__ __forceinline__ void xcd_barrier_complete(unsigned* bar, unsigned x, unsigned& nloc, unsigned& nx) {
    const unsigned G = gridDim.x * gridDim.y * gridDim.z;
    unsigned sum, cnt, mine, sp = 0u;
    for (;;) {
        sum = 0u; cnt = 0u; mine = 0u;
#pragma unroll
        for (unsigned j = 0; j < 16; ++j) { const unsigned c = xb_ld(&bar[XB_XCNT(j)]); sum += c; cnt += (c > 0u) ? 1u : 0u; mine = (j == x) ? c : mine; }
        if (sum == G) break;
        __builtin_amdgcn_s_sleep(1);
        if ((++sp & 255u) == 0u) { if (xb_ld(&bar[XB_TMO])) break; if (sp > XB_SPIN_CAP) { atomicAdd(&bar[XB_TMO], 1u); break; } }
    }
    nloc = mine > 0u ? mine : 1u; nx = cnt > 0u ? cnt : 1u;
}
__device__ __forceinline__ void xcd_barrier(const XcdBarrier& b) {
    asm volatile("s_waitcnt vmcnt(0)" ::: "memory");
    __syncthreads();
    if (threadIdx.x == 0) {
        unsigned* bar = b.bar;
        __builtin_amdgcn_s_waitcnt(0);
        unsigned nloc = b.st[0], nx = b.st[1];
        if (nloc == 0u) { xcd_barrier_complete(bar, b.x, nloc, nx); b.st[0] = nloc; b.st[1] = nx; }
        const unsigned old = xb_add(&bar[XB_XSUB(b.x)], 1u);
        const unsigned gen = old / nloc;
        if (old + 1u == (gen + 1u) * nloc) {
            __builtin_amdgcn_fence(__ATOMIC_RELEASE, "agent");
            asm volatile("s_waitcnt vmcnt(0)" ::: "memory");
            const unsigned og = xb_add(&bar[XB_TOP], 1u);
            const unsigned tg = og / nx;
            if (og + 1u == (tg + 1u) * nx) xb_add(&bar[XB_TOPGEN], 1u);
            else XB_SPIN(xb_ld(&bar[XB_TOPGEN]) == tg, bar);
            __builtin_amdgcn_fence(__ATOMIC_ACQUIRE, "agent");
            xb_add(&bar[XB_XGEN(b.x)], 1u);
            asm volatile("s_waitcnt vmcnt(0)" ::: "memory");
        } else {
            XB_SPIN(xb_ld(&bar[XB_XGEN(b.x)]) == gen, bar);
            __builtin_amdgcn_fence(__ATOMIC_ACQUIRE, "agent");
            asm volatile("s_waitcnt vmcnt(0)" ::: "memory");
        }
    }
    __syncthreads();
}

__global__ void __launch_bounds__(NTHREADS, 2) fwd_kernel(Args args) {
    extern __shared__ __attribute__((aligned(16))) unsigned char lds_raw[];
    LAS unsigned char* lds = (LAS unsigned char*)lds_raw;
    cg::grid_group grid = cg::this_grid();
    const int tid0 = threadIdx.x, wave = __builtin_amdgcn_readfirstlane(tid0 >> 6);
#define PHASE_LANES const int tid = opaque(tid0), lane = tid & 63; (void)lane; (void)tid
    const int G = gridDim.x, bx = blockIdx.x;
    const int vcu = (G % 8 == 0) ? (bx % 8) * (G / 8) + bx / 8 : bx;
    const int gw = vcu * NWAVES + wave, NGW = G * NWAVES;
    unsigned char* const ws = args.ws;
#define WSP(type, off) ((type*)(ws + (off)))
    if (tid0 < 64) ((LAS unsigned*)(lds + LDS_MISC))[tid0] = 0u;
    __syncthreads();
    unsigned long long tsA_ = 0, tsB_ = 0; (void)tsA_; (void)tsB_;
    TSTAMP(0);
    const XcdBarrier xbar = xcd_barrier_post(WSP(unsigned, WS_BAR), (volatile LAS unsigned*)(lds + LDS_MISC));
#define GRID_BAR() xcd_barrier(xbar)
    REPN(0) {
        PHASE_LANES;
        LAS float* scr = (LAS float*)(lds + wave * 16384);
        const float* x = args.in[0]; const float* mem = args.in[1]; const float* g_attn = args.in[2]; const float* w_in = args.in[3]; const float* g_mem = args.in[7];
        const float* w_mem_kv = args.in[8]; const float* w_out = args.in[11]; const float* g_ffn = args.in[12]; const float* w_router = args.in[13];
        bf16* WIN_T = WSP(bf16, WS_WIN); bf16* WMEM_T = WSP(bf16, WS_WMEM); bf16* WOUT_T = WSP(bf16, WS_WOUT);
        bf16* XN = WSP(bf16, WS_XN); bf16* MEMN = WSP(bf16, WS_MEMN); float* WRG = WSP(float, WS_WRG);
        constexpr int I0 = 16 * 88, I1 = 16 * 16, I2 = 16 * 32, NIT = I0 + I1 + I2;
        for (int it = gw; it < NIT; it += NGW) {
            int r = it;
            if (r < I0) { const int nb = r % 88, kb = r / 88; transpose_item(w_in, NIN, WIN_T, headperm_row(nb * 32), scr, kb * 64, nb * 32, lane); continue; } r -= I0;
            if (r < I1) { const int nb = r % 16, kb = r / 16; transpose_item(w_mem_kv, 512, WMEM_T, headperm_row(nb * 32), scr, kb * 64, nb * 32, lane); continue; } r -= I1;
            { const int nb = r % 32, kb = r / 32; transpose_item(w_out, 1024, WOUT_T, nb * 32, scr, kb * 64, nb * 32, lane); }
        }
        for (int m = gw * 2; m < T + MROWS; m += NGW * 2) {
            if (m < T) rms_row2_to_bf16(x + (size_t)m * DM, g_attn, XN + (size_t)m * DM, lane, WSP(float, WS_IRS) + m);
            else rms_row2_to_bf16(mem + (size_t)(m - T) * DM, g_mem, MEMN + (size_t)(m - T) * DM, lane, nullptr);
        }
        for (int i = bx * NTHREADS + tid; i < DM * NEXP; i += G * NTHREADS) WRG[i] = g_ffn[i >> 5] * w_router[i];
        for (int i = bx * NTHREADS + tid; i < NB * 16 * 8 * 64; i += G * NTHREADS) WSP(float, WS_KMEAN)[i] = 0.f;
    }
    if (args.pad0 == 0x7fffffff) grid.sync();
    GRID_BAR();
    TSTAMP(1);

    REPN(1) {
        EpiProj E{ws, args.in[4], args.in[5], args.in[9], args.in[10]};
        if (G == 256) {
            SchedProj10 S{G, bx, (const char*)(ws + WS_XN), (const char*)(ws + WS_WIN)};
            pg8::gemm_phase<EpiProj, SchedProj10>(lds, S, E);
        } else {
            SchedProj S{G, bx, (const char*)(ws + WS_XN), (const char*)(ws + WS_MEMN), (const char*)(ws + WS_WIN), (const char*)(ws + WS_WMEM)};
            pg8::gemm_phase<EpiProj, SchedProj>(lds, S, E);
        }
    }
    GRID_BAR();
    TSTAMP(2);

#ifndef NAIVE_RET
    REPN(2) {
        if (G == 256) {
            if (bx < 144) {
                SchedProjOne S{bx, (const char*)(ws + WS_XN), (const char*)(ws + WS_MEMN), (const char*)(ws + WS_WIN), (const char*)(ws + WS_WMEM)};
                EpiProj E{ws, args.in[4], args.in[5], args.in[9], args.in[10]};
                pg8::gemm_phase<EpiProj, SchedProjOne>(lds, S, E);
            } else {
                for (int u = bx - 144; u < 512; u += 112) { const int bh = u >> 4, cp = u & 15;
                    ret_body::kv_unit(WSP(bf16, WS_KR), WSP(bf16, WS_VR), WSP(float, WS_RET), bh >> 2, bh & 3, cp, (char*)lds_raw); }
            }
        } else {
            for (int i = 0; i < 2; ++i) { const int u = vcu * 2 + i, bh = u >> 4, cp = u & 15;
                ret_body::kv_unit(WSP(bf16, WS_KR), WSP(bf16, WS_VR), WSP(float, WS_RET), bh >> 2, bh & 3, cp, (char*)lds_raw); }
        }
    }
    GRID_BAR();
    TSTAMP(3);
#endif
    REPN(20) { PHASE_LANES;
#if defined(NAIVE_MOBA) || defined(NAIVE_RET) || defined(NAIVE_MEM)
#error naive mixers are no longer wired in
#endif
    unsigned* qmix = WSP(unsigned, WS_CTL) + 64 + 256 * rep_; unsigned* qconv = WSP(unsigned, WS_CTL) + 128 + 256 * rep_;
    volatile LAS int* qslot = (volatile LAS int*)(lds + LDS_MISC + 64);
    const bool conv_first = (vcu & 3) == 3;
    bool mix_done = false, conv_done = false;
    while (!(mix_done && conv_done)) {
        const int kind = conv_first ? (conv_done ? 0 : 1) : (mix_done ? 1 : 0);
        if (tid == 0) qslot[0] = (int)__hip_atomic_fetch_add(kind ? qconv : qmix, 1u, __ATOMIC_RELAXED, __HIP_MEMORY_SCOPE_AGENT);
        __syncthreads();
        const int u = qslot[0];
        __syncthreads();
        if (kind == 1) {
            if (u >= 1536) { conv_done = true; continue; }
            convert_chunk(u, args.in[15], args.in[17], WSP(unsigned char, WS_W1), WSP(unsigned char, WS_W2), (LAS float*)(lds + wave * 16384), wave, lane);
            __syncthreads();
        } else if (u >= 2048) { mix_done = true; }
        else if (u < 1024) {
            const int nb = 15 - (u >> 6), bh = u & 63, b = bh >> 3, h = bh & 7;
            const size_t row0 = (size_t)b * SEQ + (size_t)nb * 256;
            attn_body::attn_unit<8, 512, 1024, true>(WSP(bf16, WS_QA) + row0 * 512 + h * 64, WSP(bf16, WS_KA) + (size_t)b * SEQ * 512 + h * 64, WSP(bf16, WS_VA) + (size_t)b * SEQ * 512 + h * 64,
                                                     WSP(bf16, WS_Y) + row0 * DM + h * 64, 4 * nb + 4, nb, WSP(float, WS_KMEAN) + ((size_t)b * 16 * 8 + h) * 64, (char*)lds_raw);
        } else if (u < 1536) {
            const int idx = u - 1024, bh = idx >> 4, cp = idx & 15;
            ret_body::out_unit(WSP(bf16, WS_QR), WSP(bf16, WS_KR), WSP(bf16, WS_VR), WSP(bf16, WS_GR), WSP(float, WS_RET), args.in[6], WSP(bf16, WS_Y), bh >> 2, bh & 3, cp, (char*)lds_raw);
        } else {
            const int idx = u - 1536, bh = idx >> 4, qb = idx & 15, b = bh >> 2, h = bh & 3;
            const size_t row0 = (size_t)b * SEQ + (size_t)qb * 256;
            attn_body::attn_unit<8, 256, 1024, false>(WSP(bf16, WS_QM) + row0 * 256 + h * 64, WSP(bf16, WS_MK) + (size_t)b * MEMLEN * 256 + h * 64, WSP(bf16, WS_MV) + (size_t)b * MEMLEN * 256 + h * 64,
                                                      WSP(bf16, WS_Y) + row0 * DM + 768 + h * 64, 4, 0, nullptr, (char*)lds_raw);
        }
    }
    }
    GRID_BAR();
    TSTAMP(4);

    REPN(3) {
        SchedPlain S{G, bx, 128, 4, (const char*)(ws + WS_Y), (const char*)(ws + WS_WOUT)};
        EpiOut E{WSP(bf16, WS_XN), WSP(float, WS_IRS), args.in[2], WSP(bf16, WS_X1B), WSP(float, WS_SSQ)};
#ifndef NO_G2
        pg8::gemm_phase<EpiOut, SchedPlain>(lds, S, E);
#endif
    }
    GRID_BAR();
    TSTAMP(5);

    REPN(4) {
        PHASE_LANES;
        const bf16* x1b = WSP(bf16, WS_X1B); const float* b_router = args.in[14];
        float* WRG = WSP(float, WS_WRG); float* SSQ = WSP(float, WS_SSQ); int* TOPI = WSP(int, WS_TOPI); float* TOPW = WSP(float, WS_TOPW); int* LRANK = WSP(int, WS_LRANK); int* LCOUNT = WSP(int, WS_LCOUNT);
        unsigned char* XN2 = WSP(unsigned char, WS_XN2); const float* g_ffn = args.in[12];
        if (bx == 0 && tid < 64) ((u32x4*)(XN2 + (size_t)T * DM))[tid] = (u32x4){0u, 0u, 0u, 0u};
        LAS float* wl = (LAS float*)(lds);
        LAS float* lg = (LAS float*)(lds + 131072) + wave * (16 * 33);
        LAS int* hist = (LAS int*)(lds + 131072 + 16896);
        { f32x4 w4[16];
#pragma unroll
          for (int q = 0; q < 16; ++q) w4[q] = ((const f32x4*)WRG)[tid + q * NTHREADS];
#pragma unroll
          for (int q = 0; q < 16; ++q) { const int i4 = tid + q * NTHREADS, r = i4 >> 3, e = (i4 & 7) * 4; *(LAS f32x4*)(wl + r * 32 + (e ^ (((r >> 5) & 1) << 4))) = w4[q]; } }
        if (tid < 32) hist[tid] = 0;
        __syncthreads();
        const int tpw = T / (G * NWAVES);
        for (int tb = 0; tb < tpw; tb += 16) {
            const int t0 = (bx * NWAVES + wave) * tpw + tb;
            const int i = lane & 15, kq = lane >> 4;
            f32x4 a0 = {0.f, 0.f, 0.f, 0.f}, a1 = {0.f, 0.f, 0.f, 0.f};
            const bf16* xr = x1b + (size_t)(t0 + i) * DM + 32 * kq;
            const LAS float* wb = wl + (32 * kq) * 32 + (i ^ ((kq & 1) << 4));
            const LAS float* wb1 = wl + (32 * kq) * 32 + ((i ^ ((kq & 1) << 4)) ^ 16);
            float rstd;
            { const f32x4* sp = (const f32x4*)(SSQ + (size_t)(t0 + i) * 16); const f32x4 s0 = sp[0], s1 = sp[1], s2 = sp[2], s3 = sp[3];
              const float ss = ((s0[0] + s0[1]) + (s0[2] + s0[3])) + ((s1[0] + s1[1]) + (s1[2] + s1[3])) + ((s2[0] + s2[1]) + (s2[2] + s2[3])) + ((s3[0] + s3[1]) + (s3[2] + s3[3]));
              rstd = 1.0f / sqrtf(ss * (1.0f / DM) + EPS); }
            unsigned char* xo = XN2 + (size_t)(t0 + i) * DM + 16 * kq;
            const float* gp = g_ffn + 32 * kq;
#pragma unroll 2
            for (int c = 0; c < 8; ++c) {
                float av[32];
#pragma unroll
                for (int j = 0; j < 4; ++j) { const u32x4 xw = *(const u32x4*)(xr + 128 * c + 8 * j);
                    av[8 * j] = bflo(xw.x); av[8 * j + 1] = bfhi(xw.x); av[8 * j + 2] = bflo(xw.y); av[8 * j + 3] = bfhi(xw.y); av[8 * j + 4] = bflo(xw.z); av[8 * j + 5] = bfhi(xw.z); av[8 * j + 6] = bflo(xw.w); av[8 * j + 7] = bfhi(xw.w); }
                { float nv[32];
#pragma unroll
                  for (int j = 0; j < 8; ++j) { const f32x4 g = *(const f32x4*)(gp + 128 * c + 4 * j); nv[4 * j] = av[4 * j] * rstd * g[0]; nv[4 * j + 1] = av[4 * j + 1] * rstd * g[1]; nv[4 * j + 2] = av[4 * j + 2] * rstd * g[2]; nv[4 * j + 3] = av[4 * j + 3] * rstd * g[3]; }
                  u32x4 p0, p1; fp6_pack32(nv, p0, p1);
                  *(u32x4*)(xo + 128 * c) = p0; *(u32x4*)(xo + 128 * c + 64) = p1; }
#pragma unroll
                for (int q = 0; q < 32; ++q) {
                    const float b0 = wb[(128 * c + q) * 32], b1v = wb1[(128 * c + q) * 32];
                    a0 = __builtin_amdgcn_mfma_f32_16x16x4f32(av[q], b0, a0, 0, 0, 0);
                    a1 = __builtin_amdgcn_mfma_f32_16x16x4f32(av[q], b1v, a1, 0, 0, 0);
                }
            }
#pragma unroll
            for (int r = 0; r < 4; ++r) { lg[(4 * kq + r) * 33 + i] = a0[r]; lg[(4 * kq + r) * 33 + 16 + i] = a1[r]; }
            LDS_WAIT(); asm volatile("" ::: "memory");
            if (lane < 16) {
                const int t = t0 + lane;
                float v[32];
#pragma unroll
                for (int e = 0; e < 32; ++e) v[e] = lg[lane * 33 + e] * rstd + b_router[e];
                int bi[4]; float bvv[4];
#pragma unroll
                for (int k = 0; k < 4; ++k) {
                    float best = -3e38f; int be = 0;
#pragma unroll
                    for (int e = 0; e < 32; ++e) { const bool take = v[e] > best; best = take ? v[e] : best; be = take ? e : be; }
                    bi[k] = be; bvv[k] = best;
#pragma unroll
                    for (int e = 0; e < 32; ++e) v[e] = (e == be) ? -3e38f : v[e];
                }
                const float e1 = __expf(bvv[1] - bvv[0]), e2 = __expf(bvv[2] - bvv[0]), e3 = __expf(bvv[3] - bvv[0]);
                const float inv = 1.0f / (1.0f + e1 + e2 + e3);
                const float wv[4] = {inv, e1 * inv, e2 * inv, e3 * inv};
#pragma unroll
                for (int k = 0; k < 4; ++k) {
                    const int rk = atomicAdd((int*)&hist[bi[k]], 1);
                    TOPI[t * 4 + k] = bi[k]; TOPW[t * 4 + k] = wv[k]; LRANK[t * 4 + k] = rk;
                }
            }
            LDS_WAIT(); asm volatile("" ::: "memory");
        }
        __syncthreads();
        if (tid < 32) LCOUNT[bx * 32 + tid] = hist[tid];
    }
    GRID_BAR();
    TSTAMP(6);

    REPN(5) {
        PHASE_LANES;
        int* TOPI = WSP(int, WS_TOPI); float* TOPW = WSP(float, WS_TOPW); int* LRANK = WSP(int, WS_LRANK); int* LCOUNT = WSP(int, WS_LCOUNT);
        int* POS = WSP(int, WS_POS); float* ROWW = WSP(float, WS_ROWW); int* PSTART = WSP(int, WS_PSTART); int* TILEEXP = WSP(int, WS_TILEEXP);
        LAS int* part = (LAS int*)(lds);
        LAS int* base = (LAS int*)(lds + 8192);
        {
            const int e = tid & 31, p = tid >> 5; int c = 0, pre = 0;
            const int wpp = (G + 15) / 16;
            for (int w = p * wpp; w < (p + 1) * wpp && w < G; ++w) { const int v = LCOUNT[w * 32 + e]; c += v; pre += (w < bx) ? v : 0; }
            part[p * 32 + e] = c; part[512 + p * 32 + e] = pre;
        }
        __syncthreads();
        if (tid < 32) { int c = 0, pre = 0; for (int p = 0; p < 16; ++p) { c += part[p * 32 + tid]; pre += part[512 + p * 32 + tid]; } part[1024 + tid] = c; part[1056 + tid] = pre; }
        __syncthreads();
        if (tid == 0) {
            int ps = 0;
            for (int e = 0; e < 32; ++e) {
                const int c = part[1024 + e], nt_ = (c + 255) >> 8;
                base[32 + e] = ps; base[e] = ps + part[1056 + e];
                if (bx == 0) PSTART[e] = ps;
                ps += nt_ * 256;
            }
            base[64] = ps; if (bx == 0) PSTART[32] = ps;
        }
        __syncthreads();
        if (bx == 1) {
            const int ntl = base[64] >> 8;
            for (int tl = tid; tl < ntl; tl += NTHREADS) { int e = 0;
#pragma unroll
                for (int q = 1; q < 32; ++q) e += (base[32 + q] <= tl * 256) ? 1 : 0;
                TILEEXP[tl] = e; }
        }
        int* ROWTOK = WSP(int, WS_ROWTOK);
        if (bx < 32) {
            const int c = part[1024 + bx], r0 = base[32 + bx] + c, r1 = base[32 + bx] + (((c + 255) >> 8) << 8);
            for (int r = r0 + tid; r < r1; r += NTHREADS) { ROWTOK[r] = T; ROWW[r] = 0.f; }
        }
        for (int a = tid; a < (T / G) * 4; a += NTHREADS) {
            const int ta = (bx * (T / G)) * 4 + a;
            const int e = TOPI[ta]; const int pos = base[e] + LRANK[ta];
            POS[ta] = pos; ROWTOK[pos] = ta >> 2; ROWW[pos] = TOPW[ta];
        }
    }
    GRID_BAR();
    TSTAMP(7);

    const int ntiles = WSP(int, WS_PSTART)[32] >> 8;
    REPN(6) {
        SchedMoe S{G, vcu, 8, ntiles, WSP(int, WS_TILEEXP), (const char*)(ws + WS_XN2), (const char*)(ws + WS_W1), (size_t)2048 * 1024, WSP(int, WS_ROWTOK)};
        EpiSwiglu E{args.in[16], WSP(unsigned char, WS_H)};
#ifndef NO_G3
        pg8::gemm_phase<EpiSwiglu, SchedMoe, true, true, true>(lds, S, E);
#endif
    }
    GRID_BAR();
    TSTAMP(8);
    REPN(7) {
        SchedMoe S{G, vcu, 4, ntiles, WSP(int, WS_TILEEXP), (const char*)(ws + WS_H), (const char*)(ws + WS_W2), (size_t)1024 * 1024, nullptr};
        EpiDown E{args.in[18], WSP(float, WS_ROWW), WSP(unsigned char, WS_XG)};
#ifndef NO_G4
        pg8::gemm_phase<EpiDown, SchedMoe, false, true>(lds, S, E);
#endif
    }
    GRID_BAR();
    TSTAMP(9);
    if (REP_PHASE == 9) { GRID_BAR(); GRID_BAR(); GRID_BAR(); GRID_BAR(); }
    REPN(8) { PHASE_LANES;
    float* out = args.out; const int* POS = WSP(int, WS_POS); const unsigned char* YE = WSP(unsigned char, WS_XG); const bf16* x1b = WSP(bf16, WS_X1B);
    float* dst = (REP_PHASE == 8 && rep_ == 0) ? WSP(float, WS_H) + 64 * 1024 * 1024 : out;
#define CMB_LOAD(t, xv, yw) do { const u32x2* xrow = (const u32x2*)(x1b + (size_t)(t) * DM) + lane; \
        _Pragma("unroll") for (int j = 0; j < 4; ++j) xv[j] = __builtin_nontemporal_load(xrow + 64 * j); \
        _Pragma("unroll") for (int k = 0; k < 4; ++k) { const int pos = POS[(t) * 4 + k]; const unsigned* yr = (const unsigned*)(YE + (size_t)pos * 1024) + lane; \
            _Pragma("unroll") for (int j = 0; j < 4; ++j) yw[k][j] = __builtin_nontemporal_load(yr + 64 * j); } } while (0)
#define CMB_FIN(t, xv, yw) do { f32x4 s[4]; f32x4* drow = (f32x4*)(dst + (size_t)(t) * DM) + lane; \
        _Pragma("unroll") for (int j = 0; j < 4; ++j) s[j] = (f32x4){0.f, 0.f, 0.f, 0.f}; \
        _Pragma("unroll") for (int k = 0; k < 4; ++k) _Pragma("unroll") for (int j = 0; j < 4; ++j) { \
            const f32x2 lo = __builtin_amdgcn_cvt_pk_f32_fp8((int)yw[k][j], false), hi = __builtin_amdgcn_cvt_pk_f32_fp8((int)yw[k][j], true); \
            s[j].x += lo.x; s[j].y += lo.y; s[j].z += hi.x; s[j].w += hi.y; } \
        _Pragma("unroll") for (int j = 0; j < 4; ++j) __builtin_nontemporal_store((f32x4){bflo(xv[j].x), bfhi(xv[j].x), bflo(xv[j].y), bfhi(xv[j].y)} + s[j] * 0.0625f, drow + 64 * j); } while (0)
    u32x2 xa[4], xb[4]; unsigned ya[4][4], yb[4][4];
    if (gw < T) CMB_LOAD(gw, xa, ya);
    for (int t = gw; t < T; t += 2 * NGW) {
        const bool h1 = t + NGW < T, h2 = t + 2 * NGW < T;
        if (h1) CMB_LOAD(t + NGW, xb, yb);
        CMB_FIN(t, xa, ya);
        if (h1) { if (h2) CMB_LOAD(t + 2 * NGW, xa, ya); CMB_FIN(t + NGW, xb, yb); }
    }
#undef CMB_LOAD
#undef CMB_FIN
    }
    TSTAMP(10);
    if (REP_PHASE >= 100 && bx == 0 && tid0 == 0) {
        const unsigned long long t0_ = __builtin_amdgcn_s_memrealtime(), want = 9ull * (tsB_ - tsA_);
        while (__builtin_amdgcn_s_memrealtime() - t0_ < want) __builtin_amdgcn_s_sleep(32);
    }
}

extern "C" void kernel_launch(void* const* d_in, const int* in_sizes, int n_in, void* d_out, int out_size, void* d_ws, size_t ws_size, hipStream_t stream) {
    static int grid = 0;
    if (grid == 0) {
        if (n_in != 19 || out_size != T * DM || ws_size < WS_END) { fprintf(stderr, "kernel_launch: unexpected shapes (n_in %d out %d ws %zu)\n", n_in, out_size, ws_size); grid = -1; return; }
        int dev = 0, cus = 0, per_cu = 0;
        hipGetDevice(&dev); hipDeviceGetAttribute(&cus, hipDeviceAttributeMultiprocessorCount, dev);
        hipFuncSetAttribute((const void*)fwd_kernel, hipFuncAttributeMaxDynamicSharedMemorySize, LDS_BYTES);
        hipOccupancyMaxActiveBlocksPerMultiprocessor(&per_cu, (const void*)fwd_kernel, NTHREADS, LDS_BYTES);
        if (per_cu < 1) { fprintf(stderr, "kernel_launch: occupancy query says %d blocks per CU\n", per_cu); per_cu = 1; }
        (void)hipGetLastError();
        grid = cus * 1;
        if (grid % 8 != 0 || T % (grid * NWAVES * 16) != 0) { fprintf(stderr, "kernel_launch: grid %d unsupported\n", grid); grid = -1; return; }
    }
    if (grid < 0) return;
    hipMemsetAsync((char*)d_ws + WS_CTL, 0, CTL_ZERO_BYTES, stream);
    Args a{};
    for (int i = 0; i < 19; ++i) a.in[i] = (const float*)d_in[i];
    a.out = (float*)d_out; a.ws = (unsigned char*)d_ws;
    void* kargs[] = {&a};
    hipError_t e = hipLaunchCooperativeKernel((const void*)fwd_kernel, dim3(grid), dim3(NTHREADS), kargs, LDS_BYTES, stream);
    if (e != hipSuccess) fprintf(stderr, "cooperative launch failed: %s (grid %d)\n", hipGetErrorString(e), grid);
}
```

```cpp
#include <hip/hip_runtime.h>
#include <hip/hip_cooperative_groups.h>
#include <cstdio>
#include <cstdint>
namespace cg = cooperative_groups;

#define GAS __attribute__((address_space(1)))
#define LAS __attribute__((address_space(3)))
typedef unsigned short bf16;
typedef short bf16x8 __attribute__((ext_vector_type(8)));
typedef float f32x4 __attribute__((ext_vector_type(4)));
typedef float f32x2 __attribute__((ext_vector_type(2)));
typedef unsigned u32x4 __attribute__((ext_vector_type(4)));
typedef unsigned u32x2 __attribute__((ext_vector_type(2)));
typedef __bf16 bf16x2_t __attribute__((ext_vector_type(2)));

constexpr int NB = 8, SEQ = 4096, DM = 1024, T = NB * SEQ;
constexpr int NIN = 2816, NEXP = 32, TOPK = 4;
constexpr int MEMLEN = 256, MROWS = NB * MEMLEN;
constexpr float EPS = 1e-6f;
constexpr float C2 = 0.125f * 1.4426950408889634f;
constexpr int MAXTILES = 544, PROWS = MAXTILES * 256;
constexpr int NWAVES = 8, NTHREADS = 512;
#ifndef REP_PHASE
#define REP_PHASE -1
#endif
#define TSTAMP(i) do { if (REP_PHASE == 100 + (i)) tsA_ = __builtin_amdgcn_s_memrealtime(); if (REP_PHASE == 99 + (i)) tsB_ = __builtin_amdgcn_s_memrealtime(); } while (0)
#define REPN(k) for (int rep_ = 0; rep_ < ((REP_PHASE == (k)) ? 2 : 1); ++rep_)
constexpr int LDS_MISC = 150016;
constexpr int LDS_BYTES = 150016 + 256;

constexpr size_t MiB = 1u << 20;
constexpr size_t WS_CTL = 0, CTL_ZERO_BYTES = 131072;
constexpr size_t WS_BAR = 65536;
constexpr size_t WS_KMEAN = 1 * MiB;
constexpr size_t WS_WRG = 2 * MiB;
constexpr size_t WS_SSQ = 3 * MiB;
constexpr size_t WS_TOPI = 5 * MiB, WS_TOPW = 5 * MiB + 512 * 1024, WS_LRANK = 6 * MiB, WS_POS = 6 * MiB + 512 * 1024;
constexpr size_t WS_ROWW = 7 * MiB;
constexpr size_t WS_LCOUNT = 8 * MiB, WS_PSTART = 8 * MiB + 65536, WS_TILEEXP = 8 * MiB + 131072;
constexpr size_t WS_WIN = 16 * MiB, WS_WMEM = 22 * MiB, WS_WOUT = 24 * MiB, WS_W1 = 32 * MiB, WS_W2 = 160 * MiB;
constexpr size_t WS_XN = 224 * MiB, WS_MEMN = 288 * MiB;
constexpr size_t WS_QA = 292 * MiB, WS_KA = 324 * MiB, WS_VA = 356 * MiB;
constexpr size_t WS_QR = 388 * MiB, WS_KR = 404 * MiB, WS_VR = 420 * MiB, WS_GR = 436 * MiB, WS_QM = 452 * MiB;
constexpr size_t WS_MK = 468 * MiB, WS_MV = 469 * MiB;
constexpr size_t WS_Y = 470 * MiB, WS_RET = 534 * MiB;
constexpr size_t WS_XG = 224 * MiB;
constexpr size_t WS_XN2 = 496 * MiB;
constexpr size_t WS_X1B = 388 * MiB;
constexpr size_t WS_IRS = 10 * MiB;
constexpr size_t WS_ROWTOK = 9 * MiB;
constexpr size_t WS_H = 566 * MiB;
constexpr size_t WS_END = 838 * MiB;

struct Args {
    const float* in[19]; float* out; unsigned char* ws; int pad0, pad1;
};

__device__ __forceinline__ unsigned cvtpk(float lo, float hi) { f32x2 v = {lo, hi}; bf16x2_t b = __builtin_convertvector(v, bf16x2_t); return __builtin_bit_cast(unsigned, b); }
__device__ __forceinline__ float bf2f(unsigned short b) { return __uint_as_float(((unsigned)b) << 16); }
__device__ __forceinline__ float bflo(unsigned w) { return __uint_as_float(w << 16); }
__device__ __forceinline__ float bfhi(unsigned w) { return __uint_as_float(w & 0xffff0000u); }
__device__ __forceinline__ float wave_sum(float v) {
#pragma unroll
    for (int o = 1; o < 64; o <<= 1) v += __shfl_xor(v, o);
    return v;
}
#define LDS_WAIT() asm volatile("s_waitcnt lgkmcnt(0)" ::: "memory")
typedef unsigned v6u_t __attribute__((ext_vector_type(6)));
typedef float v16f_t __attribute__((ext_vector_type(16)));
#ifndef FP6_SCALE_DIV
#define FP6_SCALE_DIV 1
#endif
__device__ __forceinline__ void fp6_pack32(const float (&v)[32], u32x4& p0, u32x4& p1) {
    float mx = 1e-30f;
#pragma unroll
    for (int i = 0; i < 32; ++i) mx = fmaxf(mx, fabsf(v[i]));
    const unsigned bits = __float_as_uint(mx * (1.0f / 7.5f));
    int e = (int)((bits + 0x7FFFFFu) >> 23) - 127;
    e = e < -126 ? -126 : (e > 126 ? 126 : e);
    const float sc = __uint_as_float((unsigned)((FP6_SCALE_DIV ? e : -e) + 127) << 23);
    v16f_t lo, hi;
#pragma unroll
    for (int i = 0; i < 16; ++i) { lo[i] = v[i]; hi[i] = v[16 + i]; }
    const v6u_t w = __builtin_amdgcn_cvt_scalef32_2xpk16_fp6_f32(lo, hi, sc);
    p0 = (u32x4){w[0], w[1], w[2], w[3]}; p1 = (u32x4){w[4], w[5], (unsigned)(e + 127), 0u};
}
__device__ __forceinline__ int opaque(int v) { asm volatile("" : "+v"(v)); return v; }

namespace pg8 {
constexpr int BM = 256, BK = 64, HALF = 128, HTB = HALF * BK * 2, STAGE_BYTES = 8 * HTB, NXCD = 8, WGM = 8, K = 1024;
__host__ __device__ __forceinline__ int lds_byte(int r, int c) { const int st = (r >> 4) * 2 + (c >> 5), rr = r & 15, cc = c & 31, ob = rr * 64 + cc * 2; return st * 1024 + (ob ^ (((ob >> 9) & 1) << 5)); }
__host__ __device__ __forceinline__ void stage_rc(int b, int& R, int& C) { const int st = b / 1024, sb = b % 1024, swz = sb ^ (((sb >> 9) & 1) << 5); R = (st >> 1) * 16 + swz / 64; C = (st & 1) * 32 + (swz % 64) / 2; }
__host__ __device__ __forceinline__ int perm32(int rho) { const int n = rho >> 4, i = rho & 15; return 8 * (i >> 2) + 4 * n + (i & 3); }
struct Unit { int pm, pn, aux; };

__device__ __forceinline__ bool static_order(int L, int nM, int nN, int& pm, int& pn) {
    const int nwg = nM * nN; if (L >= nwg) return false;
    int wgid = L; { const int q = nwg / NXCD, r = nwg % NXCD, xcd = wgid % NXCD, off = wgid / NXCD; wgid = (xcd < r ? xcd * (q + 1) : r * (q + 1) + (xcd - r) * q) + off; }
    const int nig = WGM * nN, gid = wgid / nig, fm = gid * WGM, gsz = (nM - fm) < WGM ? (nM - fm) : WGM;
    pm = fm + ((wgid % nig) % gsz); pn = (wgid % nig) / gsz; return true;
}

typedef int v8i_t __attribute__((ext_vector_type(8)));
typedef int v4i_t __attribute__((ext_vector_type(4)));
__device__ __forceinline__ v8i_t cat8(bf16x8 lo, bf16x8 hi) { const v4i_t a = __builtin_bit_cast(v4i_t, lo), b = __builtin_bit_cast(v4i_t, hi); return __builtin_shufflevector(a, b, 0, 1, 2, 3, 4, 5, 6, 7); }
typedef int v6i_t __attribute__((ext_vector_type(6)));
__device__ __forceinline__ v6i_t cat6(bf16x8 lo, bf16x8 hi) { const v4i_t a = __builtin_bit_cast(v4i_t, lo), b = __builtin_bit_cast(v4i_t, hi); return __builtin_shufflevector(a, b, 0, 1, 2, 3, 4, 5); }
__device__ __forceinline__ int scl6(bf16x8 hi) { return __builtin_bit_cast(v4i_t, hi)[2]; }
constexpr int PRE_LDS = 133120;
template <class T, class = void> struct pre_kib { static constexpr int value = 0; };
template <class T> struct pre_kib<T, decltype((void)T::PRE_KIB)> { static constexpr int value = T::PRE_KIB; };
template <class Epi, class Sched, bool GATHER = false, bool FP8 = false, bool FP6 = false>
__device__ __forceinline__ void gemm_phase(LAS unsigned char* lds, const Sched& S, const Epi& E) {
    constexpr int PRE = pre_kib<Epi>::value;
#define PG8_PRE(unit, par) do { if constexpr (PRE > 0) { if (wid == 0) { _Pragma("unroll") for (int _k = 0; _k < PRE; ++_k) \
        __builtin_amdgcn_global_load_lds((const unsigned*)E.pre_src(unit, _k, lane), (LAS unsigned*)(lds + PRE_LDS + (par) * 2048 + _k * 1024), 16, 0, 0); } } } while (0)
    constexpr int PITCH = FP8 ? 1024 : 2048;
    const int tid = opaque((int)threadIdx.x), wid = __builtin_amdgcn_readfirstlane(tid >> 6), lane = tid & 63, wr = wid >> 2, wc = wid & 3, fr = lane & 15, fq = lane >> 4;
    constexpr int nt = PITCH / 128;
    unsigned voffA[2], voffB[2];
#pragma unroll
    for (int i = 0; i < 2; ++i) { int R, C; stage_rc(tid * 16 + i * 8192, R, C); const int Rb = (R & ~31) + perm32(R & 31);
        voffA[i] = (unsigned)(R * PITCH + C * 2); voffB[i] = (unsigned)(Rb * PITCH + C * 2); }
    const size_t kstep = (size_t)(BK * 2);
    const size_t hstep = (size_t)HALF * PITCH;
    const unsigned ldsw = (unsigned)wid * 1024u;
    const int aoff = lds_byte(wr * 64 + fr, fq * 8), boff = lds_byte(wc * 32 + fr, fq * 8);
#define PG8_SA(b, h) (((b) * 2 + (h)) * HTB)
#define PG8_SB(b, h) ((4 + (b) * 2 + (h)) * HTB)
#define PG8_STAGE(bufoff, gbase, voff) do { _Pragma("unroll") for (int _i = 0; _i < 2; ++_i) \
        __builtin_amdgcn_global_load_lds((const unsigned*)((const char*)(gbase) + (voff)[_i]), (LAS unsigned*)(lds + (bufoff) + ldsw + _i * 8192), 16, 0, 0); } while (0)
#define PG8_LDA(dst, b, h) do { _Pragma("unroll") for (int m = 0; m < 4; ++m) _Pragma("unroll") for (int k = 0; k < 2; ++k) dst[m][k] = *(const LAS bf16x8*)(lds + PG8_SA(b, h) + aoff + m * 2048 + k * 1024); } while (0)
#define PG8_LDB(dst, b, h) do { _Pragma("unroll") for (int n = 0; n < 2; ++n) _Pragma("unroll") for (int k = 0; k < 2; ++k) dst[n][k] = *(const LAS bf16x8*)(lds + PG8_SB(b, h) + boff + n * 2048 + k * 1024); } while (0)
#define PG8_MMA(ai, bj, At, Bt) do { __builtin_amdgcn_s_setprio(1); \
        if constexpr (FP6) { _Pragma("unroll") for (int m = 0; m < 4; ++m) _Pragma("unroll") for (int n = 0; n < 2; ++n) \
            asm volatile("s_nop 1\n\tv_mfma_scale_f32_16x16x128_f8f6f4 %0, %1, %2, %0, %3, %4 op_sel_hi:[0,0,0] cbsz:2 blgp:2" : "+v"(acc[ai][bj][m][n]) : "v"(cat6(Bt[n][0], Bt[n][1])), "v"(cat6(At[m][0], At[m][1])), "v"(scl6(Bt[n][1])), "v"(scl6(At[m][1]))); } \
        else if constexpr (FP8) { _Pragma("unroll") for (int m = 0; m < 4; ++m) _Pragma("unroll") for (int n = 0; n < 2; ++n) \
            asm volatile("v_mfma_scale_f32_16x16x128_f8f6f4 %0, %1, %2, %0, %3, %3 op_sel_hi:[0,0,0]" : "+v"(acc[ai][bj][m][n]) : "v"(cat8(Bt[n][0], Bt[n][1])), "v"(cat8(At[m][0], At[m][1])), "v"(0x7f7f7f7f)); } \
        else { _Pragma("unroll") for (int m = 0; m < 4; ++m) _Pragma("unroll") for (int n = 0; n < 2; ++n) _Pragma("unroll") for (int k = 0; k < 2; ++k) \
            acc[ai][bj][m][n] = __builtin_amdgcn_mfma_f32_16x16x32_bf16(Bt[n][k], At[m][k], acc[ai][bj][m][n], 0, 0, 0); } \
        __builtin_amdgcn_s_setprio(0); } while (0)
#define PG8_WAIT_V(n) asm volatile("s_waitcnt vmcnt(" #n ")" ::: "memory")
#define PG8_WAIT_L(n) asm volatile("s_waitcnt lgkmcnt(" #n ")" ::: "memory")
#define PG8_BAR __builtin_amdgcn_s_barrier()
#define PG8_SCHED __builtin_amdgcn_sched_barrier(0)
    Unit cur, nxt; int ui = 0;
    if (!S.next(0, cur)) return;
    PG8_PRE(cur, 0);
    unsigned vGc[2][2], vGn[2][2]; int gR[2], gC[2];
    const char* gA = nullptr;
    if constexpr (GATHER) {
        gA = S.abase();
#pragma unroll
        for (int i = 0; i < 2; ++i) { stage_rc(tid * 16 + i * 8192, gR[i], gC[i]); }
        if (wid == 0) __builtin_amdgcn_global_load_lds((const unsigned*)(S.tokptr(cur) + lane * 16), (LAS unsigned*)(lds + 131072), 16, 0, 0);
        asm volatile("s_waitcnt vmcnt(0)" ::: "memory"); __builtin_amdgcn_s_barrier(); asm volatile("" ::: "memory");
#pragma unroll
        for (int h = 0; h < 2; ++h)
#pragma unroll
            for (int i = 0; i < 2; ++i) { const int tok = ((const LAS int*)(lds + 131072))[h * 128 + gR[i]]; vGc[h][i] = (unsigned)tok * (unsigned)PITCH + (unsigned)gC[i] * 2u; vGn[h][i] = vGc[h][i]; }
    }
    f32x4 acc[2][2][4][2];
#pragma unroll
    for (int a = 0; a < 2; ++a)
#pragma unroll
        for (int b = 0; b < 2; ++b)
#pragma unroll
            for (int m = 0; m < 4; ++m)
#pragma unroll
                for (int n = 0; n < 2; ++n) acc[a][b][m][n] = (f32x4){0.f, 0.f, 0.f, 0.f};
    bf16x8 At[4][2], B0[2][2], B1[2][2];
    const char* cA = GATHER ? gA : S.aptr(cur); const char* cB = S.bptr(cur);
    const size_t ahstep = GATHER ? (size_t)0 : hstep;
    {
        PG8_STAGE(PG8_SB(0, 0), cB, voffB); PG8_STAGE(PG8_SB(0, 1), cB + hstep, voffB);
        if constexpr (GATHER) { PG8_STAGE(PG8_SA(0, 0), cA, vGc[0]); PG8_STAGE(PG8_SA(0, 1), cA, vGc[1]); } else { PG8_STAGE(PG8_SA(0, 0), cA, voffA); PG8_STAGE(PG8_SA(0, 1), cA + hstep, voffA); }
        if (wr == 1) PG8_BAR;
        PG8_WAIT_V(2); PG8_BAR;
        PG8_STAGE(PG8_SB(1, 0), cB + kstep, voffB);
        if constexpr (GATHER) { PG8_STAGE(PG8_SA(1, 0), cA + kstep, vGc[0]); } else { PG8_STAGE(PG8_SA(1, 0), cA + kstep, voffA); }
        PG8_STAGE(PG8_SB(1, 1), cB + hstep + kstep, voffB);
        PG8_WAIT_V(6); PG8_BAR;
    }
    for (;;) {
        const bool has_next = S.next(ui + 1, nxt);
        const char* nA = GATHER ? gA : (has_next ? S.aptr(nxt) : cA); const char* nB = has_next ? S.bptr(nxt) : cB;
        if constexpr (GATHER) { if (has_next && wid == 0) __builtin_amdgcn_global_load_lds((const unsigned*)(S.tokptr(nxt) + lane * 16), (LAS unsigned*)(lds + 131072 + ((ui + 1) & 1) * 1024), 16, 0, 0); }
#pragma nounroll
        for (int t = 0; t < nt; t += 2) {
            const bool last = (t == nt - 2);
            const char* a1 = cA + (size_t)(t + 1) * kstep;
            const char* a2 = last ? nA : cA + (size_t)(t + 2) * kstep; const char* b2 = last ? nB : cB + (size_t)(t + 2) * kstep;
            const char* a3 = a2 + kstep; const char* b3 = b2 + kstep;
            unsigned v2h0[2], v2h1[2];
            if constexpr (GATHER) {
                if (last && has_next) {
                    const LAS int* tk = (const LAS int*)(lds + 131072 + ((ui + 1) & 1) * 1024);
#pragma unroll
                    for (int h = 0; h < 2; ++h)
#pragma unroll
                        for (int i = 0; i < 2; ++i) vGn[h][i] = (unsigned)tk[h * 128 + gR[i]] * (unsigned)PITCH + (unsigned)gC[i] * 2u;
                }
#pragma unroll
                for (int i = 0; i < 2; ++i) { v2h0[i] = last ? vGn[0][i] : vGc[0][i]; v2h1[i] = last ? vGn[1][i] : vGc[1][i]; }
            } else {
#pragma unroll
                for (int i = 0; i < 2; ++i) { v2h0[i] = voffA[i]; v2h1[i] = voffA[i]; }
            }
            PG8_LDB(B0, 0, 0); PG8_LDB(B1, 0, 1); PG8_SCHED; PG8_LDA(At, 0, 0);
            if constexpr (GATHER) { PG8_STAGE(PG8_SA(1, 1), a1, vGc[1]); } else { PG8_STAGE(PG8_SA(1, 1), a1 + hstep, voffA); }
            PG8_WAIT_V(8); PG8_WAIT_L(0); PG8_BAR; PG8_MMA(0, 0, At, B0); PG8_MMA(0, 1, At, B1); PG8_BAR; PG8_SCHED;
            PG8_LDA(At, 0, 1); PG8_STAGE(PG8_SB(0, 0), b2, voffB); PG8_STAGE(PG8_SB(0, 1), b2 + hstep, voffB); PG8_STAGE(PG8_SA(0, 0), a2, v2h0);
            PG8_WAIT_V(8); PG8_WAIT_L(0); PG8_BAR; PG8_MMA(1, 0, At, B0); PG8_MMA(1, 1, At, B1); PG8_BAR; PG8_SCHED;
            PG8_LDB(B0, 1, 0); PG8_LDB(B1, 1, 1); PG8_SCHED; PG8_LDA(At, 1, 0); PG8_STAGE(PG8_SA(0, 1), a2 + ahstep, v2h1);
            PG8_WAIT_V(8); PG8_WAIT_L(0); PG8_BAR; PG8_MMA(0, 0, At, B0); PG8_MMA(0, 1, At, B1); PG8_BAR; PG8_SCHED;
            PG8_LDA(At, 1, 1); PG8_STAGE(PG8_SB(1, 0), b3, voffB); PG8_STAGE(PG8_SB(1, 1), b3 + hstep, voffB); PG8_STAGE(PG8_SA(1, 0), a3, v2h0);
            PG8_WAIT_V(8); PG8_WAIT_L(0); PG8_BAR; PG8_MMA(1, 0, At, B0); PG8_MMA(1, 1, At, B1); PG8_BAR; PG8_SCHED;
        }
        if (wr == 0) PG8_BAR;
        if constexpr (FP8) asm volatile("s_nop 15\n\ts_nop 7" ::: "memory");
        if constexpr (PRE > 0) E(acc, cur, wr, wc, fr, fq, (const LAS float*)(lds + PRE_LDS + (ui & 1) * 2048)); else E(acc, cur, wr, wc, fr, fq);
        if (!has_next) break;
#pragma unroll
        for (int a = 0; a < 2; ++a)
#pragma unroll
            for (int b = 0; b < 2; ++b)
#pragma unroll
                for (int m = 0; m < 4; ++m)
#pragma unroll
                    for (int n = 0; n < 2; ++n) acc[a][b][m][n] = (f32x4){0.f, 0.f, 0.f, 0.f};
        cur = nxt; cA = nA; cB = nB; ++ui;
        PG8_PRE(cur, ui & 1);
        if constexpr (GATHER) {
#pragma unroll
            for (int h = 0; h < 2; ++h)
#pragma unroll
                for (int i = 0; i < 2; ++i) vGc[h][i] = vGn[h][i];
        }
        if (wr == 1) PG8_BAR;
    }
    PG8_WAIT_V(0);
    PG8_BAR;
#undef PG8_PRE
#undef PG8_SA
#undef PG8_SB
#undef PG8_STAGE
#undef PG8_LDA
#undef PG8_LDB
#undef PG8_MMA
#undef PG8_WAIT_V
#undef PG8_WAIT_L
#undef PG8_BAR
#undef PG8_SCHED
}
}
using pg8::Unit;

struct SchedProj {
    int G, c; const char *XN, *MEMN, *WIN, *WMEM;
    __device__ __forceinline__ bool next(int i, Unit& u) const {
        const int L = i * G + c;
        if (L < 1408) { u.aux = 0; return pg8::static_order(L, 128, 11, u.pm, u.pn); }
        if (L < 1424) { const int j = L - 1408; u.pm = j >> 1; u.pn = j & 1; u.aux = 1; return true; }
        return false;
    }
    __device__ __forceinline__ const char* aptr(const Unit& u) const { return (u.aux ? MEMN : XN) + (size_t)u.pm * (256 * 2048); }
    __device__ __forceinline__ const char* bptr(const Unit& u) const { return (u.aux ? WMEM : WIN) + (size_t)u.pn * (256 * 2048); }
};
struct SchedProj10 {
    int G, c; const char *XN, *WIN;
    __device__ __forceinline__ bool next(int i, Unit& u) const { int j; u.aux = 0; if (!pg8::static_order(i * G + c, 128, 10, u.pm, j)) return false; u.pn = j < 9 ? j : 10; return true; }
    __device__ __forceinline__ const char* aptr(const Unit& u) const { return XN + (size_t)u.pm * (256 * 2048); }
    __device__ __forceinline__ const char* bptr(const Unit& u) const { return WIN + (size_t)u.pn * (256 * 2048); }
};
struct SchedProjOne {
    int c; const char *XN, *MEMN, *WIN, *WMEM;
    __device__ __forceinline__ bool next(int i, Unit& u) const {
        if (i != 0 || c >= 144) return false;
        if (c < 128) { u.pm = c; u.pn = 9; u.aux = 0; } else { const int j = c - 128; u.pm = j >> 1; u.pn = j & 1; u.aux = 1; }
        return true;
    }
    __device__ __forceinline__ const char* aptr(const Unit& u) const { return (u.aux ? MEMN : XN) + (size_t)u.pm * (256 * 2048); }
    __device__ __forceinline__ const char* bptr(const Unit& u) const { return (u.aux ? WMEM : WIN) + (size_t)u.pn * (256 * 2048); }
};
struct SchedPlain {
    int G, c, nM, nN; const char *A, *B;
    __device__ __forceinline__ bool next(int i, Unit& u) const { u.aux = 0; return pg8::static_order(i * G + c, nM, nN, u.pm, u.pn); }
    __device__ __forceinline__ const char* aptr(const Unit& u) const { return A + (size_t)u.pm * (256 * 2048); }
    __device__ __forceinline__ const char* bptr(const Unit& u) const { return B + (size_t)u.pn * (256 * 2048); }
};
struct SchedMoe {
    int G, vcu, npn, ntiles; const int* tile_exp; const char *A, *B; size_t bexp;
    __device__ __forceinline__ bool next(int i, Unit& u) const {
        const int L = i * G + vcu, tile = L / npn; if (tile >= ntiles) return false;
        u.pm = tile; u.pn = L - tile * npn; u.aux = __builtin_amdgcn_readfirstlane(tile_exp[tile]); return true;
    }
    __device__ __forceinline__ const char* aptr(const Unit& u) const { return A + (size_t)u.pm * (256 * 1024); }
    __device__ __forceinline__ const char* bptr(const Unit& u) const { return B + (size_t)u.aux * bexp + (size_t)u.pn * (256 * 1024); }
    const int* rowtok;
    __device__ __forceinline__ const char* abase() const { return A; }
    __device__ __forceinline__ const char* tokptr(const Unit& u) const { return (const char*)(rowtok + (size_t)u.pm * 256); }
};

struct EpiProj {
    unsigned char* ws;
    const float *gq, *gk, *gmq, *gmk;
    __device__ __forceinline__ void operator()(const f32x4 (&acc)[2][2][4][2], const Unit& u, int wr, int wc, int fr, int fq) const {
        int mode = 0; bf16* out; int ld = 256, coff = 0; const float* gain = nullptr; float scale = 1.f; bool kmean = false;
        if (u.aux == 0) {
            switch (u.pn) {
                case 0: case 1: out = (bf16*)(ws + WS_QA); ld = 512; coff = u.pn * 256; mode = 1; gain = gq; scale = C2; break;
                case 2: case 3: out = (bf16*)(ws + WS_KA); ld = 512; coff = (u.pn - 2) * 256; mode = 1; gain = gk; kmean = true; break;
                case 4: case 5: out = (bf16*)(ws + WS_VA); ld = 512; coff = (u.pn - 4) * 256; break;
                case 6: out = (bf16*)(ws + WS_QR); mode = 2; break;
                case 7: out = (bf16*)(ws + WS_KR); mode = 2; scale = 0.125f; break;
                case 8: out = (bf16*)(ws + WS_VR); break;
                case 9: out = (bf16*)(ws + WS_GR); mode = 3; break;
                default: out = (bf16*)(ws + WS_QM); mode = 1; gain = gmq; scale = C2; break;
            }
        } else {
            if (u.pn == 0) { out = (bf16*)(ws + WS_MK); mode = 1; gain = gmk; } else { out = (bf16*)(ws + WS_MV); }
        }
        const int row0 = u.pm * 256 + wr * 64 + fr;
        const int colb = coff + wc * 64 + 8 * fq;
        if (gain == nullptr) gain = gq;
        f32x4 gv[2][2];
#pragma unroll
        for (int bj = 0; bj < 2; ++bj)
#pragma unroll
            for (int n = 0; n < 2; ++n) gv[bj][n] = *(const f32x4*)(gain + bj * 32 + 8 * fq + 4 * n);
        f32x4 ks[2][2];
#pragma unroll
        for (int bj = 0; bj < 2; ++bj)
#pragma unroll
            for (int n = 0; n < 2; ++n) ks[bj][n] = (f32x4){0.f, 0.f, 0.f, 0.f};
#pragma unroll
        for (int ai = 0; ai < 2; ++ai)
#pragma unroll
            for (int m = 0; m < 4; ++m) {
                const int row = row0 + ai * 128 + m * 16;
                f32x4 v[2][2];
#pragma unroll
                for (int bj = 0; bj < 2; ++bj)
#pragma unroll
                    for (int n = 0; n < 2; ++n) v[bj][n] = acc[ai][bj][m][n];
                if (mode == 1) {
                    float ss = 0.f;
#pragma unroll
                    for (int bj = 0; bj < 2; ++bj)
#pragma unroll
                        for (int n = 0; n < 2; ++n) { const f32x4 x = v[bj][n]; ss += (x[0] * x[0] + x[1] * x[1]) + (x[2] * x[2] + x[3] * x[3]); }
                    ss += __shfl_xor(ss, 16); ss += __shfl_xor(ss, 32);
                    const float r = scale / sqrtf(ss * (1.0f / 64.0f) + EPS);
#pragma unroll
                    for (int bj = 0; bj < 2; ++bj)
#pragma unroll
                        for (int n = 0; n < 2; ++n) v[bj][n] = v[bj][n] * r * gv[bj][n];
                } else if (mode == 2) {
                    const float pos = (float)(row & (SEQ - 1));
                    const float lgam = __builtin_amdgcn_logf(1.0f - __builtin_amdgcn_exp2f(-5.0f - (float)wc));
                    const float rsc = scale * __builtin_amdgcn_exp2f(((u.pn == 6) ? lgam : -lgam) * (float)(row & 127));
#pragma unroll
                    for (int n = 0; n < 2; ++n)
#pragma unroll
                        for (int j = 0; j < 4; ++j) {
                            const float fre = __builtin_amdgcn_exp2f((float)(8 * fq + 4 * n + j) * (-13.287712379549449f / 31.0f)) * 0.15915494309189535f;
                            float tt = pos * fre; tt = tt - floorf(tt);
                            const float sn = __builtin_amdgcn_sinf(tt), cs = __builtin_amdgcn_cosf(tt);
                            const float t1 = v[0][n][j], t2 = v[1][n][j];
                            v[0][n][j] = (t1 * cs - t2 * sn) * rsc; v[1][n][j] = (t2 * cs + t1 * sn) * rsc;
                        }
                } else if (mode == 3) {
#pragma unroll
                    for (int bj = 0; bj < 2; ++bj)
#pragma unroll
                        for (int n = 0; n < 2; ++n)
#pragma unroll
                            for (int j = 0; j < 4; ++j) { const float x = v[bj][n][j]; v[bj][n][j] = x / (1.0f + __expf(-x)); }
                }
                if (kmean) {
#pragma unroll
                    for (int bj = 0; bj < 2; ++bj)
#pragma unroll
                        for (int n = 0; n < 2; ++n) ks[bj][n] += v[bj][n];
                }
                bf16* rowp = out + (size_t)row * ld + colb;
#pragma unroll
                for (int bj = 0; bj < 2; ++bj) { u32x4 w; w.x = cvtpk(v[bj][0][0], v[bj][0][1]); w.y = cvtpk(v[bj][0][2], v[bj][0][3]); w.z = cvtpk(v[bj][1][0], v[bj][1][1]); w.w = cvtpk(v[bj][1][2], v[bj][1][3]);
                    *(u32x4*)(rowp + bj * 32) = w; }
            }
        if (kmean) {
            float* kp = (float*)(ws + WS_KMEAN) + ((size_t)u.pm * 8 + (u.pn - 2) * 4 + wc) * 64 + 8 * fq;
#pragma unroll
            for (int bj = 0; bj < 2; ++bj)
#pragma unroll
                for (int n = 0; n < 2; ++n)
#pragma unroll
                    for (int j = 0; j < 4; ++j) {
                        float s = ks[bj][n][j];
                        s += __shfl_xor(s, 1); s += __shfl_xor(s, 2); s += __shfl_xor(s, 4); s += __shfl_xor(s, 8);
                        if (fr == 0) atomicAdd(kp + bj * 32 + 4 * n + j, s * (1.0f / 256.0f));
                    }
        }
    }
};

struct EpiOut {
    const bf16* xn; const float* irs; const float* gattn; bf16* out; float* ssq;
    static constexpr int PRE_KIB = 2;
    __device__ __forceinline__ const char* pre_src(const Unit& u, int k, int lane) const { return (const char*)(k == 0 ? gattn + u.pn * 256 : irs + (size_t)u.pm * 256) + lane * 16; }
    __device__ __forceinline__ void operator()(const f32x4 (&acc)[2][2][4][2], const Unit& u, int wr, int wc, int fr, int fq, const LAS float* pre) const {
        const int row0 = u.pm * 256 + wr * 64 + fr, col0 = u.pn * 256 + wc * 32 + 8 * fq;
        f32x4 ig[2][2];
#pragma unroll
        for (int bj = 0; bj < 2; ++bj)
#pragma unroll
            for (int n = 0; n < 2; ++n) { const f32x4 g = *(const LAS f32x4*)(pre + wc * 32 + 8 * fq + bj * 128 + 4 * n); ig[bj][n] = (f32x4){1.0f / g[0], 1.0f / g[1], 1.0f / g[2], 1.0f / g[3]}; }
#pragma unroll
        for (int ai = 0; ai < 2; ++ai) {
            u32x4 xwv[4][2]; float irv[4];
#pragma unroll
            for (int m = 0; m < 4; ++m) { const int row = row0 + ai * 128 + m * 16; irv[m] = pre[256 + wr * 64 + fr + ai * 128 + m * 16];
#pragma unroll
                for (int bj = 0; bj < 2; ++bj) xwv[m][bj] = __builtin_nontemporal_load((const u32x4*)(xn + (size_t)row * DM + col0 + bj * 128)); }
#pragma unroll
            for (int m = 0; m < 4; ++m) {
                const int row = row0 + ai * 128 + m * 16; const size_t off = (size_t)row * DM + col0; float ss = 0.f; const float ir = irv[m];
#pragma unroll
                for (int bj = 0; bj < 2; ++bj) {
                    const u32x4 xw = xwv[m][bj];
                    const f32x4 o0 = (f32x4){bflo(xw.x), bfhi(xw.x), bflo(xw.y), bfhi(xw.y)} * ig[bj][0] * ir + acc[ai][bj][m][0], o1 = (f32x4){bflo(xw.z), bfhi(xw.z), bflo(xw.w), bfhi(xw.w)} * ig[bj][1] * ir + acc[ai][bj][m][1];
                    ss += ((o0[0] * o0[0] + o0[1] * o0[1]) + (o0[2] * o0[2] + o0[3] * o0[3])) + ((o1[0] * o1[0] + o1[1] * o1[1]) + (o1[2] * o1[2] + o1[3] * o1[3]));
                    u32x4 w; w.x = cvtpk(o0[0], o0[1]); w.y = cvtpk(o0[2], o0[3]); w.z = cvtpk(o1[0], o1[1]); w.w = cvtpk(o1[2], o1[3]);
                    *(u32x4*)(out + off + bj * 128) = w; }
                ss += __shfl_xor(ss, 16); ss += __shfl_xor(ss, 32);
                if (fq == 0) ssq[(size_t)row * 16 + u.pn * 4 + wc] = ss;
            }
        }
    }
};

struct EpiSwiglu {
    static constexpr int PRE_KIB = 1;
    const float* b1; unsigned char* H;
    __device__ __forceinline__ const char* pre_src(const Unit& u, int k, int lane) const { return (const char*)(b1 + (size_t)u.aux * 2048 + u.pn * 256) + lane * 16; }
    __device__ __forceinline__ void operator()(const f32x4 (&acc)[2][2][4][2], const Unit& u, int wr, int wc, int fr, int fq, const LAS float* pre) const {
        const int row0 = u.pm * 256 + wr * 64 + fr, p0 = u.pn * 128 + wc * 32 + 8 * fq;
        const LAS float* bp = pre + 2 * (wc * 32 + 8 * fq);
        f32x4 bv[4];
#pragma unroll
        for (int i = 0; i < 4; ++i) bv[i] = *(const LAS f32x4*)(bp + 4 * i);
#pragma unroll
        for (int ai = 0; ai < 2; ++ai)
#pragma unroll
            for (int m = 0; m < 4; ++m) {
                const int row = row0 + ai * 128 + m * 16;
                float h[8];
#pragma unroll
                for (int n = 0; n < 2; ++n)
#pragma unroll
                    for (int j = 0; j < 4; ++j) {
                        const int i = 4 * n + j;
                        const float g = fminf(acc[ai][0][m][n][j] + bv[i >> 1][(i & 1) * 2], 7.0f);
                        const float l = fminf(fmaxf(acc[ai][1][m][n][j] + bv[i >> 1][(i & 1) * 2 + 1], -7.0f), 7.0f);
                        h[i] = g * __builtin_amdgcn_rcpf(1.0f + __builtin_amdgcn_exp2f(-1.702f * 1.4426950408889634f * g)) * (l + 1.0f);
                    }
                int w0 = 0, w1 = 0;
                w0 = __builtin_amdgcn_cvt_pk_fp8_f32(h[0], h[1], w0, false); w0 = __builtin_amdgcn_cvt_pk_fp8_f32(h[2], h[3], w0, true);
                w1 = __builtin_amdgcn_cvt_pk_fp8_f32(h[4], h[5], w1, false); w1 = __builtin_amdgcn_cvt_pk_fp8_f32(h[6], h[7], w1, true);
                *(u32x2*)(H + (size_t)row * 1024 + p0) = (u32x2){(unsigned)w0, (unsigned)w1};
            }
    }
};

struct EpiDown {
    static constexpr int PRE_KIB = 2;
    const float* b2; const float* roww; unsigned char* YE;
    __device__ __forceinline__ const char* pre_src(const Unit& u, int k, int lane) const {
        return (const char*)(k == 0 ? b2 + (size_t)u.aux * 1024 + u.pn * 256 : roww + (size_t)u.pm * 256) + lane * 16; }
    __device__ __forceinline__ void operator()(const f32x4 (&acc)[2][2][4][2], const Unit& u, int wr, int wc, int fr, int fq, const LAS float* pre) const {
        const int row0 = u.pm * 256 + wr * 64 + fr, c0 = u.pn * 256 + wc * 32 + 8 * fq;
        const LAS float* bp = pre + wc * 32 + 8 * fq;
        f32x4 bv[2][2];
#pragma unroll
        for (int bj = 0; bj < 2; ++bj)
#pragma unroll
            for (int n = 0; n < 2; ++n) bv[bj][n] = *(const LAS f32x4*)(bp + bj * 128 + 4 * n);
        float w8v[2][4];
#pragma unroll
        for (int ai = 0; ai < 2; ++ai)
#pragma unroll
            for (int m = 0; m < 4; ++m) w8v[ai][m] = pre[256 + wr * 64 + fr + ai * 128 + m * 16] * 16.0f;
#pragma unroll
        for (int ai = 0; ai < 2; ++ai)
#pragma unroll
            for (int m = 0; m < 4; ++m) {
                const int row = row0 + ai * 128 + m * 16; const float w8 = w8v[ai][m];
#pragma unroll
                for (int bj = 0; bj < 2; ++bj) {
                    const f32x4 y0 = (acc[ai][bj][m][0] * 0.03125f + bv[bj][0]) * w8, y1 = (acc[ai][bj][m][1] * 0.03125f + bv[bj][1]) * w8;
                    int w0 = 0, w1 = 0;
                    w0 = __builtin_amdgcn_cvt_pk_fp8_f32(y0[0], y0[1], w0, false); w0 = __builtin_amdgcn_cvt_pk_fp8_f32(y0[2], y0[3], w0, true);
                    w1 = __builtin_amdgcn_cvt_pk_fp8_f32(y1[0], y1[1], w1, false); w1 = __builtin_amdgcn_cvt_pk_fp8_f32(y1[2], y1[3], w1, true);
                    *(u32x2*)(YE + (size_t)row * 1024 + c0 + bj * 128) = (u32x2){(unsigned)w0, (unsigned)w1};
                }
            }
    }
};

__device__ __forceinline__ void transpose_item(const float* W, int N, bf16* WT, int drow0, LAS float* scr, int k0, int n0, int lane) {
    float ld_[32];
#pragma unroll
    for (int i = 0; i < 32; ++i) { const int kk = 2 * i + (lane >> 5); ld_[i] = __builtin_nontemporal_load(W + (size_t)(k0 + kk) * N + n0 + (lane & 31)); }
#pragma unroll
    for (int i = 0; i < 32; ++i) { const int kk = 2 * i + (lane >> 5); scr[kk * 33 + (lane & 31)] = ld_[i]; }
    LDS_WAIT(); asm volatile("" ::: "memory");
    const int c = lane & 7;
#pragma unroll
    for (int j = 0; j < 4; ++j) { const int n = (lane >> 3) + 8 * j; const LAS float* s = scr + (8 * c) * 33 + n;
        u32x4 o; o.x = cvtpk(s[0 * 33], s[1 * 33]); o.y = cvtpk(s[2 * 33], s[3 * 33]); o.z = cvtpk(s[4 * 33], s[5 * 33]); o.w = cvtpk(s[6 * 33], s[7 * 33]);
        *(u32x4*)(WT + (size_t)(drow0 + n) * 1024 + k0 + 8 * c) = o; }
    LDS_WAIT(); asm volatile("" ::: "memory");
}
template <bool GLU>
__device__ __forceinline__ void transpose_item_fp8(const float* W, int N, unsigned char* W8, LAS float* scr, int k0, int n0, int lane) {
    float ld_[32];
#pragma unroll
    for (int i = 0; i < 32; ++i) { const int kk = 2 * i + (lane >> 5); ld_[i] = __builtin_nontemporal_load(W + (size_t)(k0 + kk) * N + n0 + (lane & 31)); }
#pragma unroll
    for (int i = 0; i < 32; ++i) { const int kk = 2 * i + (lane >> 5); scr[kk * 33 + (lane & 31)] = ld_[i]; }
    LDS_WAIT(); asm volatile("" ::: "memory");
    const int c = lane & 3;
#pragma unroll
    for (int j = 0; j < 2; ++j) { const int n = (lane >> 2) + 16 * j; const LAS float* s = scr + (16 * c) * 33 + n;
        int w[4];
#pragma unroll
        for (int q = 0; q < 4; ++q) { int t = 0; t = __builtin_amdgcn_cvt_pk_fp8_f32(s[(4 * q) * 33] * 32.0f, s[(4 * q + 1) * 33] * 32.0f, t, false); t = __builtin_amdgcn_cvt_pk_fp8_f32(s[(4 * q + 2) * 33] * 32.0f, s[(4 * q + 3) * 33] * 32.0f, t, true); w[q] = t; }
        const int col = n0 + n; const int p = col >> 1;
        const int drow = GLU ? ((p >> 7) * 256 + (col & 1) * 128 + (p & 127)) : col;
        *(u32x4*)(W8 + (size_t)drow * 1024 + k0 + 16 * c) = (u32x4){(unsigned)w[0], (unsigned)w[1], (unsigned)w[2], (unsigned)w[3]}; }
    LDS_WAIT(); asm volatile("" ::: "memory");
}
struct ConvItem { const float* W; unsigned char* W8; int N, k0, n0; bool glu; };
__device__ __forceinline__ ConvItem conv_decode(int it, const float* w1, const float* w2, unsigned char* W1_8, unsigned char* W2_8) {
    ConvItem c;
    if (it < 32768) { const int e = it >> 10, rr = it & 1023, nb = rr & 63, kb = rr >> 6; c.W = w1 + (size_t)e * 1024 * 2048; c.W8 = W1_8 + (size_t)e * 2048 * 1024; c.N = 2048; c.k0 = kb * 64; c.n0 = nb * 32; c.glu = true; }
    else { const int r = it - 32768, e = r >> 9, rr = r & 511, nb = rr & 31, kb = rr >> 5; c.W = w2 + (size_t)e * 1024 * 1024; c.W8 = W2_8 + (size_t)e * 1024 * 1024; c.N = 1024; c.k0 = kb * 64; c.n0 = nb * 32; c.glu = false; }
    return c;
}
__device__ __forceinline__ void conv_load(const ConvItem& c, f32x4 (&r)[8], int lane) {
    const float* base = c.W + (size_t)c.k0 * c.N + c.n0;
    const int lo = (lane >> 3) * c.N + (lane & 7) * 4;
#pragma unroll
    for (int i = 0; i < 8; ++i) r[i] = __builtin_nontemporal_load((const f32x4*)(base + (size_t)(8 * i) * c.N + lo));
}
__device__ __forceinline__ void conv_finish(const ConvItem& c, const f32x4 (&r)[8], LAS float* scr, int lane) {
#pragma unroll
    for (int i = 0; i < 8; ++i) *(LAS f32x4*)(scr + (8 * i + (lane >> 3)) * 36 + (lane & 7) * 4) = r[i];
    LDS_WAIT(); asm volatile("" ::: "memory");
    if (c.glu) {
        const int n = lane & 31, half = lane >> 5; const LAS float* s = scr + (32 * half) * 36 + n;
        float v[32];
#pragma unroll
        for (int i = 0; i < 32; ++i) v[i] = s[i * 36];
        u32x4 p0, p1; fp6_pack32(v, p0, p1);
        const int col = c.n0 + n; const int p = col >> 1;
        const int drow = (p >> 7) * 256 + (col & 1) * 128 + (p & 127);
        unsigned char* dst = c.W8 + (size_t)drow * 1024 + (c.k0 >> 7) * 128 + 16 * (((c.k0 & 127) >> 5) + half);
        *(u32x4*)dst = p0; *(u32x4*)(dst + 64) = p1;
        LDS_WAIT(); asm volatile("" ::: "memory");
        return;
    }
    const int cc = lane & 3;
#pragma unroll
    for (int j = 0; j < 2; ++j) { const int n = (lane >> 2) + 16 * j; const LAS float* s = scr + (16 * cc) * 36 + n;
        int w[4];
#pragma unroll
        for (int q = 0; q < 4; ++q) { int t = 0; t = __builtin_amdgcn_cvt_pk_fp8_f32(s[(4 * q) * 36] * 32.0f, s[(4 * q + 1) * 36] * 32.0f, t, false); t = __builtin_amdgcn_cvt_pk_fp8_f32(s[(4 * q + 2) * 36] * 32.0f, s[(4 * q + 3) * 36] * 32.0f, t, true); w[q] = t; }
        const int col = c.n0 + n; const int p = col >> 1;
        const int drow = c.glu ? ((p >> 7) * 256 + (col & 1) * 128 + (p & 127)) : col;
        *(u32x4*)(c.W8 + (size_t)drow * 1024 + c.k0 + 16 * cc) = (u32x4){(unsigned)w[0], (unsigned)w[1], (unsigned)w[2], (unsigned)w[3]}; }
    LDS_WAIT(); asm volatile("" ::: "memory");
}
__device__ __forceinline__ void convert_chunk(int chunk, const float* w1, const float* w2, unsigned char* W1_8, unsigned char* W2_8, LAS float* scr, int wave, int lane) {
    const int base = chunk * 32 + wave;
    f32x4 ra[8], rb[8];
    ConvItem ca = conv_decode(base, w1, w2, W1_8, W2_8), cb;
    conv_load(ca, ra, lane);
#pragma unroll 1
    for (int j = 0; j < 4; j += 2) {
        cb = conv_decode(base + 8 * (j + 1), w1, w2, W1_8, W2_8); conv_load(cb, rb, lane);
        conv_finish(ca, ra, scr, lane);
        if (j + 2 < 4) { ca = conv_decode(base + 8 * (j + 2), w1, w2, W1_8, W2_8); conv_load(ca, ra, lane); }
        conv_finish(cb, rb, scr, lane);
    }
}
__device__ __forceinline__ int headperm_row(int n0) { const int pn = n0 >> 8, c = n0 & 255, hh = c >> 6, dh = (c & 63) >> 5; return pn * 256 + dh * 128 + hh * 32; }
__device__ __forceinline__ void rms_row_to_bf16(const float* xrow, const float* gain, bf16* orow, int lane) {
    const f32x4* xr = (const f32x4*)xrow + lane; const f32x4* gr = (const f32x4*)gain + lane;
    f32x4 v[4]; float s = 0.f;
#pragma unroll
    for (int j = 0; j < 4; ++j) { v[j] = xr[64 * j]; s += (v[j].x * v[j].x + v[j].y * v[j].y) + (v[j].z * v[j].z + v[j].w * v[j].w); }
    const float rstd = 1.0f / sqrtf(wave_sum(s) * (1.f / DM) + EPS);
    u32x2* o8 = (u32x2*)orow + lane;
#pragma unroll
    for (int j = 0; j < 4; ++j) { const f32x4 gg = gr[64 * j]; u32x2 w; w.x = cvtpk(v[j].x * rstd * gg.x, v[j].y * rstd * gg.y); w.y = cvtpk(v[j].z * rstd * gg.z, v[j].w * rstd * gg.w); o8[64 * j] = w; }
}

__device__ __forceinline__ void rms_row2_to_bf16(const float* xrow, const float* gain, bf16* orow, int lane, float* irs) {
    const f32x4* xr = (const f32x4*)xrow + lane; const f32x4* gr = (const f32x4*)gain + lane;
    f32x4 v[8]; float s0 = 0.f, s1 = 0.f;
#pragma unroll
    for (int j = 0; j < 8; ++j) v[j] = __builtin_nontemporal_load(xr + 64 * j);
#pragma unroll
    for (int j = 0; j < 4; ++j) { s0 += (v[j].x * v[j].x + v[j].y * v[j].y) + (v[j].z * v[j].z + v[j].w * v[j].w); s1 += (v[4 + j].x * v[4 + j].x + v[4 + j].y * v[4 + j].y) + (v[4 + j].z * v[4 + j].z + v[4 + j].w * v[4 + j].w); }
    const float q0 = sqrtf(wave_sum(s0) * (1.f / DM) + EPS), q1 = sqrtf(wave_sum(s1) * (1.f / DM) + EPS); const float r0 = 1.0f / q0, r1 = 1.0f / q1;
    if (irs != nullptr && lane == 0) { irs[0] = q0; irs[1] = q1; }
    u32x2* o8 = (u32x2*)orow + lane;
#pragma unroll
    for (int j = 0; j < 4; ++j) { const f32x4 gg = gr[64 * j]; u32x2 w; w.x = cvtpk(v[j].x * r0 * gg.x, v[j].y * r0 * gg.y); w.y = cvtpk(v[j].z * r0 * gg.z, v[j].w * r0 * gg.w); o8[64 * j] = w;
        u32x2 w2; w2.x = cvtpk(v[4 + j].x * r1 * gg.x, v[4 + j].y * r1 * gg.y); w2.y = cvtpk(v[4 + j].z * r1 * gg.z, v[4 + j].w * r1 * gg.w); o8[256 + 64 * j] = w2; }
}

#include <hip/hip_bf16.h>
namespace attn_body {
using s16x4=__attribute__((ext_vector_type(4)))short;
using f32x16=__attribute__((ext_vector_type(16)))float;
constexpr int D=64,NW=8,QBLK=32,QB=QBLK*NW,KVBLK=64;
__device__ __forceinline__ int crow(int r,int hi){return (r&3)+8*(r>>2)+4*hi;}
#define SBAR() __builtin_amdgcn_sched_barrier(0)
__device__ __forceinline__ void cmask(f32x16&p0,f32x16&p1,int jb,int qrel,int hi){
  const float NEG=-INFINITY; int kb=64*jb+4*hi;
  #pragma unroll
  for(int r=0;r<16;++r){int kv=kb+(r&3)+8*(r>>2); if(kv>qrel)p0[r]=NEG; if(kv+32>qrel)p1[r]=NEG;}
}
constexpr int NSLOT=3, SLOTB=8192;
constexpr int LDS_K=0, LDS_V=NSLOT*SLOTB, LDS_WS=2*NSLOT*SLOTB, LDS_OST=LDS_WS+NW*64*4, ATT_LDS_BYTES=LDS_OST+NW*4096;
__device__ __forceinline__ void glds16(const void*gsrc,unsigned lds_dst){unsigned keep;
  asm volatile("s_mov_b32 %0, m0\n\ts_mov_b32 m0, %2\n\ts_nop 0\n\tglobal_load_lds_dwordx4 %1, off\n\ts_mov_b32 m0, %0":"=&s"(keep):"v"(gsrc),"s"(lds_dst):"memory");}
__device__ __forceinline__ float max3f(float a,float b,float c){float r;asm("v_max3_f32 %0, %1, %2, %3":"=v"(r):"v"(a),"v"(b),"v"(c));return r;}
__device__ __forceinline__ float max2f(float a,float b){float r;asm("v_max_f32_e32 %0, %1, %2":"=v"(r):"v"(a),"v"(b));return r;}
__device__ __forceinline__ float fadd_s(float a,float b){float r;asm("v_add_f32_e32 %0, %1, %2":"=v"(r):"v"(a),"v"(b));return r;}
__device__ __forceinline__ float fsub_s(float a,float b){float r;asm("v_sub_f32_e32 %0, %1, %2":"=v"(r):"v"(a),"v"(b));return r;}
__device__ __forceinline__ unsigned cvtpk_s(float lo,float hi){return cvtpk(lo,hi);}
#define WAIT_BAR(N) asm volatile("s_waitcnt vmcnt(" #N ") lgkmcnt(0)\n\ts_barrier":::"memory")
__device__ __forceinline__ void qkt(f32x16&p0,f32x16&p1,const char*Kslot,const bf16x8*qr,const f32x16&negm,int r32,int hi){
  const char*kb=Kslot+hi*1024+r32*16;
  #pragma unroll
  for(int d0=0;d0<4;++d0){
    const bf16x8 b0=*reinterpret_cast<const bf16x8*>(kb+d0*2048);
    const bf16x8 b1=*reinterpret_cast<const bf16x8*>(kb+d0*2048+512);
    if(d0==0){p0=__builtin_amdgcn_mfma_f32_32x32x16_bf16(b0,qr[0],negm,0,0,0);p1=__builtin_amdgcn_mfma_f32_32x32x16_bf16(b1,qr[0],negm,0,0,0);}
    else{p0=__builtin_amdgcn_mfma_f32_32x32x16_bf16(b0,qr[d0],p0,0,0,0);p1=__builtin_amdgcn_mfma_f32_32x32x16_bf16(b1,qr[d0],p1,0,0,0);}}
}
typedef __attribute__((address_space(3))) const char* lds_cptr;
typedef short v4i16_t __attribute__((ext_vector_type(4)));
__device__ __forceinline__ void kload8(bf16x8*kf,lds_cptr kp){
  kf[0]=*(const __attribute__((address_space(3))) bf16x8*)(kp);      kf[1]=*(const __attribute__((address_space(3))) bf16x8*)(kp+512);
  kf[2]=*(const __attribute__((address_space(3))) bf16x8*)(kp+2048); kf[3]=*(const __attribute__((address_space(3))) bf16x8*)(kp+2560);
  kf[4]=*(const __attribute__((address_space(3))) bf16x8*)(kp+4096); kf[5]=*(const __attribute__((address_space(3))) bf16x8*)(kp+4608);
  kf[6]=*(const __attribute__((address_space(3))) bf16x8*)(kp+6144); kf[7]=*(const __attribute__((address_space(3))) bf16x8*)(kp+6656);
}
__device__ __forceinline__ void kload2(bf16x8*kf,lds_cptr kp,int j){ kf[2*j]=*(const __attribute__((address_space(3))) bf16x8*)(kp+j*2048); kf[2*j+1]=*(const __attribute__((address_space(3))) bf16x8*)(kp+j*2048+512); }
__device__ __forceinline__ s16x4 vtr(lds_cptr p){ return __builtin_bit_cast(s16x4,__builtin_amdgcn_ds_read_tr16_b64_v4i16((__attribute__((address_space(3))) v4i16_t*)p)); }
__device__ __forceinline__ float rowmax(const f32x16&p0,const f32x16&p1){
  float a=max3f(p0[0],p0[1],p1[0]),b=max3f(p0[2],p0[3],p1[1]);a=max3f(a,p1[2],p1[3]);
  #pragma unroll
  for(int r=4;r<16;r+=4){a=max3f(a,p0[r],p0[r+1]);b=max3f(b,p0[r+2],p0[r+3]);a=max3f(a,p1[r],p1[r+1]);b=max3f(b,p1[r+2],p1[r+3]);}
  const float m=max2f(a,b);
  auto rr=__builtin_amdgcn_permlane32_swap(__float_as_uint(m),__float_as_uint(m),false,false);
  return max2f(__uint_as_float(rr[0]),__uint_as_float(rr[1]));
}
__device__ __forceinline__ void pv(f32x16*o,int vb,bf16x8 pa0,bf16x8 pa1,bf16x8 pa2,bf16x8 pa3){
  #pragma unroll
  for(int d0=0;d0<2;++d0){s16x4 lo[4],hi[4];
    #pragma unroll
    for(int ks=0;ks<4;++ks){
      asm volatile("ds_read_b64_tr_b16 %0,%1 offset:%c2":"=&v"(lo[ks]):"v"(vb),"i"(d0*4096+ks*1024):"memory");
      asm volatile("ds_read_b64_tr_b16 %0,%1 offset:%c2":"=&v"(hi[ks]):"v"(vb),"i"(d0*4096+ks*1024+512):"memory");}
    asm volatile("s_waitcnt lgkmcnt(0)":::"memory");SBAR();
    #define PK(k) (bf16x8){lo[k][0],lo[k][1],lo[k][2],lo[k][3],hi[k][0],hi[k][1],hi[k][2],hi[k][3]}
    o[d0]=__builtin_amdgcn_mfma_f32_32x32x16_bf16(pa0,PK(0),o[d0],0,0,0);
    o[d0]=__builtin_amdgcn_mfma_f32_32x32x16_bf16(pa1,PK(1),o[d0],0,0,0);
    o[d0]=__builtin_amdgcn_mfma_f32_32x32x16_bf16(pa2,PK(2),o[d0],0,0,0);
    o[d0]=__builtin_amdgcn_mfma_f32_32x32x16_bf16(pa3,PK(3),o[d0],0,0,0);
    #undef PK
  }
}
template<int THRL,int KP,int OP,bool MOBA> __device__ __forceinline__ void attn_unit(const bf16*Qu,const bf16*__restrict__ Kh,const bf16*__restrict__ Vh,bf16*Ou,const int NT,const int nblk,const float*kmean,char*shm){
  const int tid=opaque((int)threadIdx.x),lane=tid&63,r32=lane&31,hi=lane>>5; const int wid=__builtin_amdgcn_readfirstlane(tid>>6);
  const bf16*Qw=Qu+(long)(wid*QBLK)*KP;
  const unsigned lds0=(unsigned)(uintptr_t)shm;
  float*wsf=(float*)(shm+LDS_WS)+wid*64;
  const bf16*ksrc=Kh+(long)lane*KP+wid*8;
  const bf16*vsrc=Vh+(long)(16*(wid&3)+(lane>>2))*KP+(wid>>2)*32+(lane&3)*8;
  const unsigned kdst=lds0+LDS_K+wid*1024, vdst=lds0+LDS_V+wid*1024;
  #define DMA_K(t,slot) glds16(ksrc+(long)(t)*KVBLK*KP,(unsigned)__builtin_amdgcn_readfirstlane(kdst+(slot)))
  #define DMA_V(t,slot) glds16(vsrc+(long)(t)*KVBLK*KP,(unsigned)__builtin_amdgcn_readfirstlane(vdst+(slot)))
  const int vb0=(int)(lds0+LDS_V)+((lane>>4)&1)*32+(lane&3)*8+(4*hi+((lane&15)>>2))*64;
  const char*Kbase=shm+LDS_K; bf16x8 kf[8];
  const lds_cptr shm3=(lds_cptr)shm; const lds_cptr kp0=shm3+LDS_K+hi*1024+r32*16; const lds_cptr vp0=shm3+LDS_V+((lane>>4)&1)*32+(lane&3)*8+(4*hi+((lane&15)>>2))*64;
  if(MOBA){ if(wid<4) glds16(kmean+(long)(4*wid+(lane>>4))*512+(lane&15)*4,(unsigned)__builtin_amdgcn_readfirstlane(lds0+ATT_LDS_BYTES+wid*1024)); }
  DMA_K(0,0);DMA_V(0,0);DMA_K(1,SLOTB);
  bf16x8 qr[4];
  #pragma unroll
  for(int d0=0;d0<4;++d0)qr[d0]=*reinterpret_cast<const bf16x8*>(&Qw[(long)r32*KP+d0*16+hi*8]);
  unsigned bmask=0xffffffffu;
  if(MOBA){
    bmask=1u<<nblk;
    float g0=-3e38f,g1=-3e38f,g2=-3e38f; int i0=-1,i1=-1,i2=-1;
    asm volatile("s_waitcnt vmcnt(0)\n\ts_barrier":::"memory");
    const __attribute__((address_space(3))) float*kml=(const __attribute__((address_space(3))) float*)(shm3+ATT_LDS_BYTES)+8*hi;
    for(int j=0;j<nblk;++j){
      const __attribute__((address_space(3))) float*km=kml+j*64; float g=0.f;
      #pragma unroll
      for(int d0=0;d0<4;++d0){ const f32x4 a=*(const __attribute__((address_space(3))) f32x4*)(km+16*d0),b=*(const __attribute__((address_space(3))) f32x4*)(km+16*d0+4);
        g+=bf2f((unsigned short)qr[d0][0])*a[0]+bf2f((unsigned short)qr[d0][1])*a[1]+bf2f((unsigned short)qr[d0][2])*a[2]+bf2f((unsigned short)qr[d0][3])*a[3];
        g+=bf2f((unsigned short)qr[d0][4])*b[0]+bf2f((unsigned short)qr[d0][5])*b[1]+bf2f((unsigned short)qr[d0][6])*b[2]+bf2f((unsigned short)qr[d0][7])*b[3]; }
      g+=__shfl_xor(g,32);
      if(g>g0){g2=g1;i2=i1;g1=g0;i1=i0;g0=g;i0=j;} else if(g>g1){g2=g1;i2=i1;g1=g;i1=j;} else if(g>g2){g2=g;i2=j;}
    }
    if(i0>=0)bmask|=1u<<i0; if(i1>=0)bmask|=1u<<i1; if(i2>=0)bmask|=1u<<i2;
  }
  #define NEGM_FOR(t) (MOBA ? (((bmask>>((t)>>2))&1u) ? -mhat : -INFINITY) : -mhat)
  float mhat=0.f,l_reg=0.f;f32x16 o[2];o[0]=f32x16{};o[1]=f32x16{};f32x16 negm;
  { const float nm=NEGM_FOR(0);
    #pragma unroll
    for(int r=0;r<16;++r)negm[r]=nm; }
  asm volatile("":"+v"(negm));
  const int qrel=wid*QBLK+r32;
  #define CMASK(P0,P1,t) do{ if(MOBA){int jb_=(t)-(NT-4); if(jb_>=0)cmask(P0,P1,jb_,qrel,hi);} }while(0)
  bool resc=false;
  #define START(P0,P1) do{ const float rm=rowmax(P0,P1); resc=false; \
    { const float dl=(MOBA&&rm==-INFINITY)?0.f:rm; mhat=fadd_s(mhat,dl); \
      _Pragma("unroll") for(int r=0;r<16;++r){P0[r]=fsub_s(P0[r],dl);P1[r]=fsub_s(P1[r],dl);} \
      { const float nm=NEGM_FOR(1); _Pragma("unroll") for(int r=0;r<16;++r)negm[r]=nm; } asm volatile("":"+v"(negm)); } \
    _Pragma("unroll") for(int r=0;r<16;++r)P0[r]=__builtin_amdgcn_exp2f(P0[r]); }while(0)
  #define RESC() do{ if(resc){ asm volatile("s_waitcnt lgkmcnt(0)":::"memory"); \
      _Pragma("unroll") for(int d_=0;d_<2;++d_) _Pragma("unroll") for(int r=0;r<16;++r)o[d_][r]*=wsf[crow(r,hi)]; } }while(0)
  f32x16 pA0,pA1,pB0,pB1;
  int sl_prev=0,sl_cur=0,sl_next=SLOTB;
  #define ROT() do{sl_prev=sl_cur;sl_cur=sl_next;sl_next=(sl_next==(NSLOT-1)*SLOTB)?0:sl_next+SLOTB;}while(0)
  DMA_K(2,2*SLOTB);
  WAIT_BAR(3);
  qkt(pA0,pA1,Kbase,qr,negm,r32,hi);asm volatile("s_nop 15\n\ts_nop 7":"+v"(pA0),"+v"(pA1));CMASK(pA0,pA1,0);
  START(pA0,pA1);
  _Pragma("unroll") for(int r=0;r<16;++r)pA1[r]=__builtin_amdgcn_exp2f(pA1[r]);
  WAIT_BAR(0);
  DMA_K(3,0);DMA_V(1,SLOTB);
  ROT();
  kload8(kf,kp0+sl_cur);
  WAIT_BAR(2);
  s16x4 vlo[8],vhi[8]; u32x4 pw0,pw1,pw2,pw3;
  #define PKW(P,B) cvtpk_s(P[B],P[B+1])
  #define PAF(k) __builtin_bit_cast(bf16x8,pw##k)
  #define VFR(i) (bf16x8){vlo[i][0],vlo[i][1],vlo[i][2],vlo[i][3],vhi[i][0],vhi[i][1],vhi[i][2],vhi[i][3]}
  #define PIN(x) asm volatile("":"+v"(x))
  #define MX3(a,b,c) __builtin_fmaxf(__builtin_fmaxf((a),(b)),(c))
  #define GAPA(MF,A0,A1,A2,A3,W0,W1,PW) do{ MF; sacc+=A0; sacc+=A1; sacc+=A2; sacc+=A3; PIN(sacc); W0; W1; PIN(PW); SBAR(); }while(0)
  #define EX(v) __builtin_amdgcn_exp2f(v)
  #define GAPB(MF,X,B) do{ MF; X[B]=EX(X[B]); X[B+1]=EX(X[B+1]); X[B+2]=EX(X[B+2]); X[B+3]=EX(X[B+3]); PIN(X); SBAR(); }while(0)
  #define VRD(i) do{ vlo[i]=vtr(vp_+(((i)>>2)*4096+((i)&3)*1024)); vhi[i]=vtr(vp_+(((i)>>2)*4096+((i)&3)*1024+512)); }while(0)
  #define KRD(G,j) do{ if(G){ kload2(kf,kp0+sl_next,j); SBAR(); } }while(0)
  #define STEP(C0,C1,P0,P1,t,GK,GV,GL) do{ SBAR(); \
    const lds_cptr vp_=vp0+sl_prev; \
    VRD(0); SBAR(); float sacc=(P0[0]+P0[1]); \
    GAPA(C0=__builtin_amdgcn_mfma_f32_32x32x16_bf16(kf[0],qr[0],negm,0,0,0), P0[2],P0[3],P0[4],P0[5],     pw0[0]=PKW(P0,0), pw0[1]=PKW(P0,2), pw0); \
    VRD(4); SBAR(); GAPA(C1=__builtin_amdgcn_mfma_f32_32x32x16_bf16(kf[1],qr[0],negm,0,0,0), P0[6],P0[7],P0[8],P0[9],     pw0[2]=PKW(P0,4), pw0[3]=PKW(P0,6), pw0); \
    VRD(1); SBAR(); GAPA(C0=__builtin_amdgcn_mfma_f32_32x32x16_bf16(kf[2],qr[1],C0,0,0,0),   P0[10],P0[11],P0[12],P0[13], pw1[0]=PKW(P0,8), pw1[1]=PKW(P0,10), pw1); \
    VRD(5); SBAR(); GAPA(C1=__builtin_amdgcn_mfma_f32_32x32x16_bf16(kf[3],qr[1],C1,0,0,0),   P0[14],P0[15],P1[0],P1[1],   pw1[2]=PKW(P0,12),pw1[3]=PKW(P0,14), pw1); \
    VRD(2); SBAR(); GAPA(C0=__builtin_amdgcn_mfma_f32_32x32x16_bf16(kf[4],qr[2],C0,0,0,0),   P1[2],P1[3],P1[4],P1[5],     pw2[0]=PKW(P1,0), pw2[1]=PKW(P1,2), pw2); \
    VRD(6); SBAR(); GAPA(C1=__builtin_amdgcn_mfma_f32_32x32x16_bf16(kf[5],qr[2],C1,0,0,0),   P1[6],P1[7],P1[8],P1[9],     pw2[2]=PKW(P1,4), pw2[3]=PKW(P1,6), pw2); \
    VRD(3); SBAR(); GAPA(C0=__builtin_amdgcn_mfma_f32_32x32x16_bf16(kf[6],qr[3],C0,0,0,0),   P1[10],P1[11],P1[12],P1[13], pw3[0]=PKW(P1,8), pw3[1]=PKW(P1,10), pw3); \
    VRD(7); SBAR(); GAPA(C1=__builtin_amdgcn_mfma_f32_32x32x16_bf16(kf[7],qr[3],C1,0,0,0),   P1[14],P1[15],0.f,0.f,       pw3[2]=PKW(P1,12),pw3[3]=PKW(P1,14), pw3); \
    l_reg+=sacc; \
    if(GK){DMA_K((t)+3,sl_cur);} if(GV){DMA_V((t)+1,sl_next);} \
    CMASK(C0,C1,t); \
    { float a=MX3(C0[0],C0[1],C1[0]),b=MX3(C0[2],C0[3],C1[1]); a=MX3(a,C1[2],C1[3]); \
      _Pragma("unroll") for(int r=4;r<16;r+=4){a=MX3(a,C0[r],C0[r+1]);b=MX3(b,C0[r+2],C0[r+3]);a=MX3(a,C1[r],C1[r+1]);b=MX3(b,C1[r+2],C1[r+3]);} \
      float rm=__builtin_fmaxf(a,b); { auto rr=__builtin_amdgcn_permlane32_swap(__float_as_uint(rm),__float_as_uint(rm),false,false); rm=__builtin_fmaxf(__uint_as_float(rr[0]),__uint_as_float(rr[1])); } \
      resc=false; \
      if(__builtin_expect(__any(rm>(float)THRL),0)){ const float dl=__builtin_fmaxf(rm,0.f); mhat+=dl; \
        _Pragma("unroll") for(int r=0;r<16;++r){C0[r]-=dl;C1[r]-=dl;} \
        if(!MOBA){ _Pragma("unroll") for(int r=0;r<16;++r)negm[r]=-mhat; asm volatile("":"+v"(negm)); } \
        const float f=__builtin_amdgcn_exp2f(-dl); l_reg*=f; if(hi==0)wsf[r32]=f; resc=true; } \
      if(MOBA){ if(resc||((((t)+1)&3)==0)){ const float nm=NEGM_FOR((t)+1); _Pragma("unroll") for(int r=0;r<16;++r)negm[r]=nm; asm volatile("":"+v"(negm)); } } } \
    SBAR(); \
    GAPB(o[0]=__builtin_amdgcn_mfma_f32_32x32x16_bf16(PAF(0),VFR(0),o[0],0,0,0), C0,0); \
    GAPB(o[1]=__builtin_amdgcn_mfma_f32_32x32x16_bf16(PAF(0),VFR(4),o[1],0,0,0), C0,4); \
    KRD(GL,0); GAPB(o[0]=__builtin_amdgcn_mfma_f32_32x32x16_bf16(PAF(1),VFR(1),o[0],0,0,0), C0,8); \
    KRD(GL,1); GAPB(o[1]=__builtin_amdgcn_mfma_f32_32x32x16_bf16(PAF(1),VFR(5),o[1],0,0,0), C0,12); \
    KRD(GL,2); GAPB(o[0]=__builtin_amdgcn_mfma_f32_32x32x16_bf16(PAF(2),VFR(2),o[0],0,0,0), C1,0); \
    KRD(GL,3); GAPB(o[1]=__builtin_amdgcn_mfma_f32_32x32x16_bf16(PAF(2),VFR(6),o[1],0,0,0), C1,4); \
    GAPB(o[0]=__builtin_amdgcn_mfma_f32_32x32x16_bf16(PAF(3),VFR(3),o[0],0,0,0), C1,8); \
    GAPB(o[1]=__builtin_amdgcn_mfma_f32_32x32x16_bf16(PAF(3),VFR(7),o[1],0,0,0), C1,12); \
    }while(0)
  int t=1;
  #undef CMASK
  #define CMASK(P0,P1,t) do{}while(0)
  for(;t+5<NT;t+=2){
    STEP(pB0,pB1,pA0,pA1,t,true,true,true);     WAIT_BAR(2); RESC(); ROT();
    STEP(pA0,pA1,pB0,pB1,t+1,true,true,true);   WAIT_BAR(2); RESC(); ROT();
  }
  #undef CMASK
  #define CMASK(P0,P1,t) do{ if(MOBA){int jb_=(t)-(NT-4); if(jb_>=0)cmask(P0,P1,jb_,qrel,hi);} }while(0)
  #define ENDW(tt) do{ if((tt)+3<NT){WAIT_BAR(2);} else if((tt)+2<NT){WAIT_BAR(1);} else {WAIT_BAR(0);} }while(0)
  for(;t+1<NT;t+=2){
    STEP(pB0,pB1,pA0,pA1,t,(t+3<NT),(t+1<NT),(t+1<NT));       ENDW(t);   RESC(); ROT();
    STEP(pA0,pA1,pB0,pB1,t+1,(t+4<NT),(t+2<NT),(t+2<NT));     ENDW(t+1); RESC(); ROT();
  }
  STEP(pB0,pB1,pA0,pA1,NT-1,false,false,false); RESC();
  { float sacc=pB0[0]+pB0[1]; _Pragma("unroll") for(int r=2;r<16;++r)sacc+=pB0[r]; _Pragma("unroll") for(int r=0;r<16;++r)sacc+=pB1[r]; l_reg+=sacc;
    pw0=(u32x4){PKW(pB0,0),PKW(pB0,2),PKW(pB0,4),PKW(pB0,6)};pw1=(u32x4){PKW(pB0,8),PKW(pB0,10),PKW(pB0,12),PKW(pB0,14)};pw2=(u32x4){PKW(pB1,0),PKW(pB1,2),PKW(pB1,4),PKW(pB1,6)};pw3=(u32x4){PKW(pB1,8),PKW(pB1,10),PKW(pB1,12),PKW(pB1,14)};
    SBAR(); pv(o,vb0+sl_cur,PAF(0),PAF(1),PAF(2),PAF(3)); }
  #undef PKW
  #undef PAF
  #undef VFR
  #undef PIN
  #undef MX3
  #undef GAPA
  #undef GAPB
  #undef EX
  #undef VRD
  #undef KRD
  #undef STEP
  #undef ENDW
  {auto rr=__builtin_amdgcn_permlane32_swap(__float_as_uint(l_reg),__float_as_uint(l_reg),false,false);l_reg=__uint_as_float(rr[0])+__uint_as_float(rr[1]);}
  if(hi==0)wsf[32+r32]=l_reg;asm volatile("s_waitcnt lgkmcnt(0)":::"memory");
  float rli[16];
  #pragma unroll
  for(int r=0;r<16;++r)rli[r]=__builtin_amdgcn_rcpf(wsf[32+crow(r,hi)]);
  bf16*Ow=Ou+(long)(wid*QBLK)*OP;
  { bf16*stg=(bf16*)(shm+LDS_OST)+wid*2048;
    #pragma unroll
    for(int r=0;r<16;++r){const int orow=crow(r,hi);
      #pragma unroll
      for(int d0=0;d0<2;++d0)stg[orow*64+d0*32+r32]=(bf16)(cvtpk(o[d0][r]*rli[r],0.f)&0xffffu);}
    asm volatile("s_waitcnt lgkmcnt(0)":::"memory");
    #pragma unroll
    for(int i=0;i<4;++i){const int row=i*8+(lane>>3),ch=lane&7; const u32x4 v=*(const u32x4*)(stg+row*64+ch*8); *(u32x4*)(Ow+(long)row*OP+ch*8)=v;} }
  asm volatile("s_waitcnt lgkmcnt(0)\n\ts_barrier":::"memory");
  #undef DMA_K
  #undef DMA_V
  #undef CMASK
  #undef START
  #undef RESC
  #undef ROT
  #undef NEGM_FOR
}
#undef SBAR
#undef WAIT_BAR
}

namespace ret_body {
using attn_body::s16x4; using attn_body::f32x16; using attn_body::glds16; using attn_body::pv; using attn_body::crow;
constexpr int KVF_BYTES = 64 * 64 * 4;
__device__ __forceinline__ void kv_unit(const bf16* KR, const bf16* VR, float* KVF, int b, int h, int cp, char* shm) {
  const int tid = opaque((int)threadIdx.x), lane = tid & 63, r32 = lane & 31, hi = lane >> 5; const int wid = __builtin_amdgcn_readfirstlane(tid >> 6);
  const unsigned lds0 = (unsigned)(uintptr_t)shm;
  const size_t rowb = (size_t)b * SEQ + (size_t)cp * 256;
  const long voff = (long)(16 * (wid & 3) + (lane >> 2)) * 256 + h * 64 + (wid >> 2) * 32 + (lane & 3) * 8;
#pragma unroll
  for (int c = 0; c < 2; ++c)
#pragma unroll
    for (int tl = 0; tl < 2; ++tl) {
      const size_t r0 = rowb + c * 128 + tl * 64;
      glds16(KR + r0 * 256 + voff, (unsigned)__builtin_amdgcn_readfirstlane(lds0 + ((c * 2 + 0) * 2 + tl) * 8192 + wid * 1024));
      glds16(VR + r0 * 256 + voff, (unsigned)__builtin_amdgcn_readfirstlane(lds0 + ((c * 2 + 1) * 2 + tl) * 8192 + wid * 1024));
    }
  asm volatile("s_waitcnt vmcnt(0) lgkmcnt(0)\n\ts_barrier" ::: "memory");
  const int c = wid >> 2, dkb = (wid >> 1) & 1, dvb = wid & 1;
  const int vb = (int)lds0 + ((lane >> 4) & 1) * 32 + (lane & 3) * 8 + (4 * hi + ((lane & 15) >> 2)) * 64;
  f32x16 acc = f32x16{};
#pragma unroll
  for (int tl = 0; tl < 2; ++tl) {
    s16x4 alo[4], ahi[4], blo[4], bhi[4];
    const int ka = vb + ((c * 2 + 0) * 2 + tl) * 8192 + dkb * 4096, va = vb + ((c * 2 + 1) * 2 + tl) * 8192 + dvb * 4096;
#pragma unroll
    for (int ks = 0; ks < 4; ++ks) {
      asm volatile("ds_read_b64_tr_b16 %0,%1 offset:%c2" : "=&v"(alo[ks]) : "v"(ka), "i"(ks * 1024) : "memory");
      asm volatile("ds_read_b64_tr_b16 %0,%1 offset:%c2" : "=&v"(ahi[ks]) : "v"(ka), "i"(ks * 1024 + 512) : "memory");
      asm volatile("ds_read_b64_tr_b16 %0,%1 offset:%c2" : "=&v"(blo[ks]) : "v"(va), "i"(ks * 1024) : "memory");
      asm volatile("ds_read_b64_tr_b16 %0,%1 offset:%c2" : "=&v"(bhi[ks]) : "v"(va), "i"(ks * 1024 + 512) : "memory");
    }
    asm volatile("s_waitcnt lgkmcnt(0)" ::: "memory"); __builtin_amdgcn_sched_barrier(0);
#pragma unroll
    for (int ks = 0; ks < 4; ++ks) {
      const bf16x8 af = (bf16x8){alo[ks][0], alo[ks][1], alo[ks][2], alo[ks][3], ahi[ks][0], ahi[ks][1], ahi[ks][2], ahi[ks][3]};
      const bf16x8 bfr = (bf16x8){blo[ks][0], blo[ks][1], blo[ks][2], blo[ks][3], bhi[ks][0], bhi[ks][1], bhi[ks][2], bhi[ks][3]};
      acc = __builtin_amdgcn_mfma_f32_32x32x16_bf16(af, bfr, acc, 0, 0, 0);
    }
  }
  const float lgam = __builtin_amdgcn_logf(1.0f - __builtin_amdgcn_exp2f(-5.0f - (float)h));
  const float g127 = __builtin_amdgcn_exp2f(lgam * 127.0f);
  float* outp = KVF + ((size_t)((b * 4 + h) * 32 + cp * 2 + c)) * 4096 + dvb * 32 + r32;
#pragma unroll
  for (int r = 0; r < 16; ++r) outp[(size_t)(dkb * 32 + crow(r, hi)) * 64] = acc[r] * g127;
  asm volatile("s_waitcnt lgkmcnt(0)\n\ts_barrier" ::: "memory");
}

__device__ __forceinline__ void out_unit(const bf16* QR, const bf16* KR, const bf16* VR, const bf16* GR, const float* KVF, const float* rgain, bf16* Y, int b, int h, int cp, char* shm) {
  const int tid = opaque((int)threadIdx.x), lane = tid & 63, r32 = lane & 31, hi = lane >> 5; const int wid = __builtin_amdgcn_readfirstlane(tid >> 6);
  const unsigned lds0 = (unsigned)(uintptr_t)shm;
  constexpr int L_K = 0, L_V = 32768, L_S = 65536, L_O = 81920;
  const size_t rowb = (size_t)b * SEQ + (size_t)cp * 256;
  const long koff = (long)lane * 256 + h * 64 + wid * 8;
  const long voff = (long)(16 * (wid & 3) + (lane >> 2)) * 256 + h * 64 + (wid >> 2) * 32 + (lane & 3) * 8;
#pragma unroll
  for (int tl = 0; tl < 4; ++tl) {
    const size_t r0 = rowb + tl * 64;
    glds16(KR + r0 * 256 + koff, (unsigned)__builtin_amdgcn_readfirstlane(lds0 + L_K + tl * 8192 + wid * 1024));
    glds16(VR + r0 * 256 + voff, (unsigned)__builtin_amdgcn_readfirstlane(lds0 + L_V + tl * 8192 + wid * 1024));
  }
  const int c = wid >> 2, wq = wid & 3;
  const bf16* Qw = QR + (rowb + c * 128 + wq * 32 + r32) * 256 + h * 64;
  bf16x8 qr[4]; u32x4 qa[4];
#pragma unroll
  for (int d0 = 0; d0 < 4; ++d0) qr[d0] = *reinterpret_cast<const bf16x8*>(Qw + d0 * 16 + hi * 8);
#pragma unroll
  for (int k = 0; k < 4; ++k) { const u32x2 lo = *(const u32x2*)(Qw + 16 * k + 4 * hi), hi2 = *(const u32x2*)(Qw + 16 * k + 8 + 4 * hi); qa[k] = (u32x4){lo.x, lo.y, hi2.x, hi2.y}; }
  {
    const float lgam = __builtin_amdgcn_logf(1.0f - __builtin_amdgcn_exp2f(-5.0f - (float)h));
    const float lgc = lgam * 128.0f;
    const int n0 = 2 * cp;
    int mlo = n0 - 1 - (int)(34.0f / (-lgc)); if (mlo < 0) mlo = 0;
    const float* kvp = KVF + ((size_t)((b * 4 + h) * 32)) * 4096 + tid * 8;
    const f32x4 an0 = *(const f32x4*)(kvp + (size_t)n0 * 4096), cn0 = *(const f32x4*)(kvp + (size_t)n0 * 4096 + 4);
    f32x4 s0 = {0.f, 0.f, 0.f, 0.f}, s1 = {0.f, 0.f, 0.f, 0.f};
    int m = mlo;
    for (; m + 8 <= n0; m += 8) {
      f32x4 a[8], c4[8];
#pragma unroll
      for (int q = 0; q < 8; ++q) { a[q] = *(const f32x4*)(kvp + (size_t)(m + q) * 4096); c4[q] = *(const f32x4*)(kvp + (size_t)(m + q) * 4096 + 4); }
#pragma unroll
      for (int q = 0; q < 8; ++q) { const float w = __builtin_amdgcn_exp2f(lgc * (float)(n0 - 1 - m - q)); s0 += a[q] * w; s1 += c4[q] * w; }
    }
    for (; m + 4 <= n0; m += 4) {
      f32x4 a[4], c4[4];
#pragma unroll
      for (int q = 0; q < 4; ++q) { a[q] = *(const f32x4*)(kvp + (size_t)(m + q) * 4096); c4[q] = *(const f32x4*)(kvp + (size_t)(m + q) * 4096 + 4); }
#pragma unroll
      for (int q = 0; q < 4; ++q) { const float w = __builtin_amdgcn_exp2f(lgc * (float)(n0 - 1 - m - q)); s0 += a[q] * w; s1 += c4[q] * w; }
    }
    for (; m < n0; ++m) {
      const float w = __builtin_amdgcn_exp2f(lgc * (float)(n0 - 1 - m));
      const f32x4 a = *(const f32x4*)(kvp + (size_t)m * 4096), c4 = *(const f32x4*)(kvp + (size_t)m * 4096 + 4);
      s0 += a * w; s1 += c4 * w;
    }
    const int dk = tid >> 3, dv = 8 * (tid & 7);
    char* sp = shm + L_S + (dv >> 5) * 4096 + dk * 64 + (dv & 31) * 2;
    u32x4 w0; w0.x = cvtpk(s0[0], s0[1]); w0.y = cvtpk(s0[2], s0[3]); w0.z = cvtpk(s1[0], s1[1]); w0.w = cvtpk(s1[2], s1[3]);
    *(u32x4*)sp = w0;
    const float dc = __builtin_amdgcn_exp2f(lgc);
    s0 = s0 * dc + an0; s1 = s1 * dc + cn0;
    u32x4 w1; w1.x = cvtpk(s0[0], s0[1]); w1.y = cvtpk(s0[2], s0[3]); w1.z = cvtpk(s1[0], s1[1]); w1.w = cvtpk(s1[2], s1[3]);
    *(u32x4*)(sp + 8192) = w1;
  }
  asm volatile("s_waitcnt vmcnt(0) lgkmcnt(0)\n\ts_barrier" ::: "memory");
  const int vb = (int)lds0 + ((lane >> 4) & 1) * 32 + (lane & 3) * 8 + (4 * hi + ((lane & 15) >> 2)) * 64;
  f32x16 o[2]; o[0] = f32x16{}; o[1] = f32x16{};
  pv(o, vb + L_S + c * 8192, __builtin_bit_cast(bf16x8, qa[0]), __builtin_bit_cast(bf16x8, qa[1]), __builtin_bit_cast(bf16x8, qa[2]), __builtin_bit_cast(bf16x8, qa[3]));
  { const float gam = 1.0f - __builtin_amdgcn_exp2f(-5.0f - (float)h);
#pragma unroll
    for (int d0 = 0; d0 < 2; ++d0)
#pragma unroll
      for (int r = 0; r < 16; ++r) o[d0][r] *= gam; }
  const f32x16 zero = f32x16{};
  const int irow = wq * 32 + r32;
  for (int tl = 0; tl <= (wq >> 1); ++tl) {
    f32x16 p0, p1;
    attn_body::qkt(p0, p1, shm + L_K + (c * 2 + tl) * 8192, qr, zero, r32, hi);
    asm volatile("s_nop 15\n\ts_nop 7" : "+v"(p0), "+v"(p1));
#pragma unroll
    for (int r = 0; r < 16; ++r) { const int kj = 64 * tl + crow(r, hi); if (kj > irow) p0[r] = 0.f; if (kj + 32 > irow) p1[r] = 0.f; }
    u32x4 pw0, pw1, pw2, pw3;
    pw0 = (u32x4){cvtpk(p0[0], p0[1]), cvtpk(p0[2], p0[3]), cvtpk(p0[4], p0[5]), cvtpk(p0[6], p0[7])}; pw1 = (u32x4){cvtpk(p0[8], p0[9]), cvtpk(p0[10], p0[11]), cvtpk(p0[12], p0[13]), cvtpk(p0[14], p0[15])};
    pw2 = (u32x4){cvtpk(p1[0], p1[1]), cvtpk(p1[2], p1[3]), cvtpk(p1[4], p1[5]), cvtpk(p1[6], p1[7])}; pw3 = (u32x4){cvtpk(p1[8], p1[9]), cvtpk(p1[10], p1[11]), cvtpk(p1[12], p1[13]), cvtpk(p1[14], p1[15])};
    __builtin_amdgcn_sched_barrier(0);
    pv(o, vb + L_V + (c * 2 + tl) * 8192, __builtin_bit_cast(bf16x8, pw0), __builtin_bit_cast(bf16x8, pw1), __builtin_bit_cast(bf16x8, pw2), __builtin_bit_cast(bf16x8, pw3));
  }
  asm volatile("s_waitcnt lgkmcnt(0)\n\ts_barrier" ::: "memory");
  { float* stg = (float*)(shm + L_O) + wid * 2048;
#pragma unroll
    for (int r = 0; r < 16; ++r) { const int orow = crow(r, hi);
#pragma unroll
      for (int d0 = 0; d0 < 2; ++d0) stg[orow * 64 + d0 * 32 + r32] = o[d0][r]; }
    asm volatile("s_waitcnt lgkmcnt(0)" ::: "memory");
    const int row = lane >> 1, half = lane & 1;
    const f32x4* sr = (const f32x4*)(stg + row * 64 + half * 32);
    f32x4 v[8]; float ss = 0.f;
#pragma unroll
    for (int i = 0; i < 8; ++i) { v[i] = sr[i]; ss += (v[i][0] * v[i][0] + v[i][1] * v[i][1]) + (v[i][2] * v[i][2] + v[i][3] * v[i][3]); }
    ss += __shfl_xor(ss, 1);
    const float rstd = 1.0f / sqrtf(ss * (1.0f / 64.0f) + EPS);
    const size_t grow = rowb + c * 128 + wq * 32 + row;
    const u32x4* gp = (const u32x4*)(GR + grow * 256 + h * 64 + half * 32);
    const f32x4* rg = (const f32x4*)(rgain + h * 64 + half * 32);
    u32x4* yp = (u32x4*)(Y + grow * DM + 512 + h * 64 + half * 32);
    u32x4 gwv[4]; f32x4 rgv[8];
#pragma unroll
    for (int i = 0; i < 4; ++i) { gwv[i] = gp[i]; rgv[2 * i] = rg[2 * i]; rgv[2 * i + 1] = rg[2 * i + 1]; }
#pragma unroll
    for (int i = 0; i < 4; ++i) {
      const u32x4 gw = gwv[i]; const f32x4 g0 = rgv[2 * i], g1 = rgv[2 * i + 1]; const f32x4 a = v[2 * i] * rstd * g0, c4 = v[2 * i + 1] * rstd * g1;
      u32x4 w; w.x = cvtpk(a[0] * bflo(gw.x), a[1] * bfhi(gw.x)); w.y = cvtpk(a[2] * bflo(gw.y), a[3] * bfhi(gw.y)); w.z = cvtpk(c4[0] * bflo(gw.z), c4[1] * bfhi(gw.z)); w.w = cvtpk(c4[2] * bflo(gw.w), c4[3] * bfhi(gw.w));
      yp[i] = w;
    }
  }
  asm volatile("s_waitcnt lgkmcnt(0)\n\ts_barrier" ::: "memory");
}
}

#define XB_TMO      128
#define XB_XCNT(j)  (256  + 64 * (j))
#define XB_XSUB(j)  (1280 + 64 * (j))
#define XB_XGEN(j)  (2304 + 64 * (j))
#define XB_TOP      3328
#define XB_TOPGEN   3392
#define XCD_BAR_WORDS 3456
#define XB_SPIN_CAP (1u << 18)
__device__ __forceinline__ unsigned xb_ld(unsigned* p)              { return __hip_atomic_load(p, __ATOMIC_RELAXED, __HIP_MEMORY_SCOPE_AGENT); }
__device__ __forceinline__ unsigned xb_add(unsigned* p, unsigned v) { return __hip_atomic_fetch_add(p, v, __ATOMIC_RELAXED, __HIP_MEMORY_SCOPE_AGENT); }
__device__ __forceinline__ unsigned xb_xcc_id() { return (unsigned)__builtin_amdgcn_s_getreg((3 << 11) | 20) & 0xFu; }
#define XB_SPIN(cond, bar) do { unsigned _sp = 0; while (cond) { __builtin_amdgcn_s_sleep(1); \
    if ((++_sp & 255u) == 0u) { if (xb_ld(&(bar)[XB_TMO])) break; if (_sp > XB_SPIN_CAP) { atomicAdd(&(bar)[XB_TMO], 1u); break; } } } } while (0)
struct XcdBarrier { unsigned* bar; unsigned x; volatile LAS unsigned* st; };
__device__ __forceinline__ XcdBarrier xcd_barrier_post(unsigned* bar, volatile LAS unsigned* st) {
    XcdBarrier b; b.bar = bar; b.x = xb_xcc_id(); b.st = st;
    if (threadIdx.x == 0) (void)xb_add(&bar[XB_XCNT(b.x)], 1u);
    return b;
}
__device__ __forceinline__ void xcd_barrier_complete(unsigned* bar, unsigned x, unsigned& nloc, unsigned& nx) {
    const unsigned G = gridDim.x * gridDim.y * gridDim.z;
    unsigned sum, cnt, mine, sp = 0u;
    for (;;) {
        sum = 0u; cnt = 0u; mine = 0u;
#pragma unroll
        for (unsigned j = 0; j < 16; ++j) { const unsigned c = xb_ld(&bar[XB_XCNT(j)]); sum += c; cnt += (c > 0u) ? 1u : 0u; mine = (j == x) ? c : mine; }
        if (sum == G) break;
        __builtin_amdgcn_s_sleep(1);
        if ((++sp & 255u) == 0u) { if (xb_ld(&bar[XB_TMO])) break; if (sp > XB_SPIN_CAP) { atomicAdd(&bar[XB_TMO], 1u); break; } }
    }
    nloc = mine > 0u ? mine : 1u; nx = cnt > 0u ? cnt : 1u;
}
__device__ __forceinline__ void xcd_barrier(const XcdBarrier& b) {
    asm volatile("s_waitcnt vmcnt(0)" ::: "memory");
    __syncthreads();
    if (threadIdx.x == 0) {
        unsigned* bar = b.bar;
        __builtin_amdgcn_s_waitcnt(0);
        unsigned nloc = b.st[0], nx = b.st[1];
        if (nloc == 0u) { xcd_barrier_complete(bar, b.x, nloc, nx); b.st[0] = nloc; b.st[1] = nx; }
        const unsigned old = xb_add(&bar[XB_XSUB(b.x)], 1u);
        const unsigned gen = old / nloc;
        if (old + 1u == (gen + 1u) * nloc) {
            __builtin_amdgcn_fence(__ATOMIC_RELEASE, "agent");
            asm volatile("s_waitcnt vmcnt(0)" ::: "memory");
            const unsigned og = xb_add(&bar[XB_TOP], 1u);
            const unsigned tg = og / nx;
            if (og + 1u == (tg + 1u) * nx) xb_add(&bar[XB_TOPGEN], 1u);
            else XB_SPIN(xb_ld(&bar[XB_TOPGEN]) == tg, bar);
            __builtin_amdgcn_fence(__ATOMIC_ACQUIRE, "agent");
            xb_add(&bar[XB_XGEN(b.x)], 1u);
            asm volatile("s_waitcnt vmcnt(0)" ::: "memory");
        } else {
            XB_SPIN(xb_ld(&bar[XB_XGEN(b.x)]) == gen, bar);
            __builtin_amdgcn_fence(__ATOMIC_ACQUIRE, "agent");
            asm volatile("s_waitcnt vmcnt(0)" ::: "memory");
        }
    }
    __syncthreads();
}

__global__ void __launch_bounds__(NTHREADS, 2) fwd_kernel(Args args) {
    extern __shared__ __attribute__((aligned(16))) unsigned char lds_raw[];
    LAS unsigned char* lds = (LAS unsigned char*)lds_raw;
    cg::grid_group grid = cg::this_grid();
    const int tid0 = threadIdx.x, wave = __builtin_amdgcn_readfirstlane(tid0 >> 6);
#define PHASE_LANES const int tid = opaque(tid0), lane = tid & 63; (void)lane; (void)tid
    const int G = gridDim.x, bx = blockIdx.x;
    const int vcu = (G % 8 == 0) ? (bx % 8) * (G / 8) + bx / 8 : bx;
    const int gw = vcu * NWAVES + wave, NGW = G * NWAVES;
    unsigned char* const ws = args.ws;
#define WSP(type, off) ((type*)(ws + (off)))
    if (tid0 < 64) ((LAS unsigned*)(lds + LDS_MISC))[tid0] = 0u;
    __syncthreads();
    unsigned long long tsA_ = 0, tsB_ = 0; (void)tsA_; (void)tsB_;
    TSTAMP(0);
    const XcdBarrier xbar = xcd_barrier_post(WSP(unsigned, WS_BAR), (volatile LAS unsigned*)(lds + LDS_MISC));
#define GRID_BAR() xcd_barrier(xbar)
    REPN(0) {
        PHASE_LANES;
        LAS float* scr = (LAS float*)(lds + wave * 16384);
        const float* x = args.in[0]; const float* mem = args.in[1]; const float* g_attn = args.in[2]; const float* w_in = args.in[3]; const float* g_mem = args.in[7];
        const float* w_mem_kv = args.in[8]; const float* w_out = args.in[11]; const float* g_ffn = args.in[12]; const float* w_router = args.in[13];
        bf16* WIN_T = WSP(bf16, WS_WIN); bf16* WMEM_T = WSP(bf16, WS_WMEM); bf16* WOUT_T = WSP(bf16, WS_WOUT);
        bf16* XN = WSP(bf16, WS_XN); bf16* MEMN = WSP(bf16, WS_MEMN); float* WRG = WSP(float, WS_WRG);
        constexpr int I0 = 16 * 88, I1 = 16 * 16, I2 = 16 * 32, NIT = I0 + I1 + I2;
        for (int it = gw; it < NIT; it += NGW) {
            int r = it;
            if (r < I0) { const int nb = r % 88, kb = r / 88; transpose_item(w_in, NIN, WIN_T, headperm_row(nb * 32), scr, kb * 64, nb * 32, lane); continue; } r -= I0;
            if (r < I1) { const int nb = r % 16, kb = r / 16; transpose_item(w_mem_kv, 512, WMEM_T, headperm_row(nb * 32), scr, kb * 64, nb * 32, lane); continue; } r -= I1;
            { const int nb = r % 32, kb = r / 32; transpose_item(w_out, 1024, WOUT_T, nb * 32, scr, kb * 64, nb * 32, lane); }
        }
        for (int m = gw * 2; m < T + MROWS; m += NGW * 2) {
            if (m < T) rms_row2_to_bf16(x + (size_t)m * DM, g_attn, XN + (size_t)m * DM, lane, WSP(float, WS_IRS) + m);
            else rms_row2_to_bf16(mem + (size_t)(m - T) * DM, g_mem, MEMN + (size_t)(m - T) * DM, lane, nullptr);
        }
        for (int i = bx * NTHREADS + tid; i < DM * NEXP; i += G * NTHREADS) WRG[i] = g_ffn[i >> 5] * w_router[i];
        for (int i = bx * NTHREADS + tid; i < NB * 16 * 8 * 64; i += G * NTHREADS) WSP(float, WS_KMEAN)[i] = 0.f;
    }
    if (args.pad0 == 0x7fffffff) grid.sync();
    GRID_BAR();
    TSTAMP(1);

    REPN(1) {
        EpiProj E{ws, args.in[4], args.in[5], args.in[9], args.in[10]};
        if (G == 256) {
            SchedProj10 S{G, bx, (const char*)(ws + WS_XN), (const char*)(ws + WS_WIN)};
            pg8::gemm_phase<EpiProj, SchedProj10>(lds, S, E);
        } else {
            SchedProj S{G, bx, (const char*)(ws + WS_XN), (const char*)(ws + WS_MEMN), (const char*)(ws + WS_WIN), (const char*)(ws + WS_WMEM)};
            pg8::gemm_phase<EpiProj, SchedProj>(lds, S, E);
        }
    }
    GRID_BAR();
    TSTAMP(2);

#ifndef NAIVE_RET
    REPN(2) {
        if (G == 256) {
            if (bx < 144) {
                SchedProjOne S{bx, (const char*)(ws + WS_XN), (const char*)(ws + WS_MEMN), (const char*)(ws + WS_WIN), (const char*)(ws + WS_WMEM)};
                EpiProj E{ws, args.in[4], args.in[5], args.in[9], args.in[10]};
                pg8::gemm_phase<EpiProj, SchedProjOne>(lds, S, E);
            } else {
                for (int u = bx - 144; u < 512; u += 112) { const int bh = u >> 4, cp = u & 15;
                    ret_body::kv_unit(WSP(bf16, WS_KR), WSP(bf16, WS_VR), WSP(float, WS_RET), bh >> 2, bh & 3, cp, (char*)lds_raw); }
            }
        } else {
            for (int i = 0; i < 2; ++i) { const int u = vcu * 2 + i, bh = u >> 4, cp = u & 15;
                ret_body::kv_unit(WSP(bf16, WS_KR), WSP(bf16, WS_VR), WSP(float, WS_RET), bh >> 2, bh & 3, cp, (char*)lds_raw); }
        }
    }
    GRID_BAR();
    TSTAMP(3);
#endif
    REPN(20) { PHASE_LANES;
#if defined(NAIVE_MOBA) || defined(NAIVE_RET) || defined(NAIVE_MEM)
#error naive mixers are no longer wired in
#endif
    unsigned* qmix = WSP(unsigned, WS_CTL) + 64 + 256 * rep_; unsigned* qconv = WSP(unsigned, WS_CTL) + 128 + 256 * rep_;
    volatile LAS int* qslot = (volatile LAS int*)(lds + LDS_MISC + 64);
    const bool conv_first = (vcu & 3) == 3;
    bool mix_done = false, conv_done = false;
    while (!(mix_done && conv_done)) {
        const int kind = conv_first ? (conv_done ? 0 : 1) : (mix_done ? 1 : 0);
        if (tid == 0) qslot[0] = (int)__hip_atomic_fetch_add(kind ? qconv : qmix, 1u, __ATOMIC_RELAXED, __HIP_MEMORY_SCOPE_AGENT);
        __syncthreads();
        const int u = qslot[0];
        __syncthreads();
        if (kind == 1) {
            if (u >= 1536) { conv_done = true; continue; }
            convert_chunk(u, args.in[15], args.in[17], WSP(unsigned char, WS_W1), WSP(unsigned char, WS_W2), (LAS float*)(lds + wave * 16384), wave, lane);
            __syncthreads();
        } else if (u >= 2048) { mix_done = true; }
        else if (u < 1024) {
            const int nb = 15 - (u >> 6), bh = u & 63, b = bh >> 3, h = bh & 7;
            const size_t row0 = (size_t)b * SEQ + (size_t)nb * 256;
            attn_body::attn_unit<8, 512, 1024, true>(WSP(bf16, WS_QA) + row0 * 512 + h * 64, WSP(bf16, WS_KA) + (size_t)b * SEQ * 512 + h * 64, WSP(bf16, WS_VA) + (size_t)b * SEQ * 512 + h * 64,
                                                     WSP(bf16, WS_Y) + row0 * DM + h * 64, 4 * nb + 4, nb, WSP(float, WS_KMEAN) + ((size_t)b * 16 * 8 + h) * 64, (char*)lds_raw);
        } else if (u < 1536) {
            const int idx = u - 1024, bh = idx >> 4, cp = idx & 15;
            ret_body::out_unit(WSP(bf16, WS_QR), WSP(bf16, WS_KR), WSP(bf16, WS_VR), WSP(bf16, WS_GR), WSP(float, WS_RET), args.in[6], WSP(bf16, WS_Y), bh >> 2, bh & 3, cp, (char*)lds_raw);
        } else {
            const int idx = u - 1536, bh = idx >> 4, qb = idx & 15, b = bh >> 2, h = bh & 3;
            const size_t row0 = (size_t)b * SEQ + (size_t)qb * 256;
            attn_body::attn_unit<8, 256, 1024, false>(WSP(bf16, WS_QM) + row0 * 256 + h * 64, WSP(bf16, WS_MK) + (size_t)b * MEMLEN * 256 + h * 64, WSP(bf16, WS_MV) + (size_t)b * MEMLEN * 256 + h * 64,
                                                      WSP(bf16, WS_Y) + row0 * DM + 768 + h * 64, 4, 0, nullptr, (char*)lds_raw);
        }
    }
    }
    GRID_BAR();
    TSTAMP(4);

    REPN(3) {
        SchedPlain S{G, bx, 128, 4, (const char*)(ws + WS_Y), (const char*)(ws + WS_WOUT)};
        EpiOut E{WSP(bf16, WS_XN), WSP(float, WS_IRS), args.in[2], WSP(bf16, WS_X1B), WSP(float, WS_SSQ)};
#ifndef NO_G2
        pg8::gemm_phase<EpiOut, SchedPlain>(lds, S, E);
#endif
    }
    GRID_BAR();
    TSTAMP(5);

    REPN(4) {
        PHASE_LANES;
        const bf16* x1b = WSP(bf16, WS_X1B); const float* b_router = args.in[14];
        float* WRG = WSP(float, WS_WRG); float* SSQ = WSP(float, WS_SSQ); int* TOPI = WSP(int, WS_TOPI); float* TOPW = WSP(float, WS_TOPW); int* LRANK = WSP(int, WS_LRANK); int* LCOUNT = WSP(int, WS_LCOUNT);
        unsigned char* XN2 = WSP(unsigned char, WS_XN2); const float* g_ffn = args.in[12];
        if (bx == 0 && tid < 64) ((u32x4*)(XN2 + (size_t)T * DM))[tid] = (u32x4){0u, 0u, 0u, 0u};
        LAS float* wl = (LAS float*)(lds);
        LAS float* lg = (LAS float*)(lds + 131072) + wave * (16 * 33);
        LAS int* hist = (LAS int*)(lds + 131072 + 16896);
        { f32x4 w4[16];
#pragma unroll
          for (int q = 0; q < 16; ++q) w4[q] = ((const f32x4*)WRG)[tid + q * NTHREADS];
#pragma unroll
          for (int q = 0; q < 16; ++q) { const int i4 = tid + q * NTHREADS, r = i4 >> 3, e = (i4 & 7) * 4; *(LAS f32x4*)(wl + r * 32 + (e ^ (((r >> 5) & 1) << 4))) = w4[q]; } }
        if (tid < 32) hist[tid] = 0;
        __syncthreads();
        const int tpw = T / (G * NWAVES);
        for (int tb = 0; tb < tpw; tb += 16) {
            const int t0 = (bx * NWAVES + wave) * tpw + tb;
            const int i = lane & 15, kq = lane >> 4;
            f32x4 a0 = {0.f, 0.f, 0.f, 0.f}, a1 = {0.f, 0.f, 0.f, 0.f};
            const bf16* xr = x1b + (size_t)(t0 + i) * DM + 32 * kq;
            const LAS float* wb = wl + (32 * kq) * 32 + (i ^ ((kq & 1) << 4));
            const LAS float* wb1 = wl + (32 * kq) * 32 + ((i ^ ((kq & 1) << 4)) ^ 16);
            float rstd;
            { const f32x4* sp = (const f32x4*)(SSQ + (size_t)(t0 + i) * 16); const f32x4 s0 = sp[0], s1 = sp[1], s2 = sp[2], s3 = sp[3];
              const float ss = ((s0[0] + s0[1]) + (s0[2] + s0[3])) + ((s1[0] + s1[1]) + (s1[2] + s1[3])) + ((s2[0] + s2[1]) + (s2[2] + s2[3])) + ((s3[0] + s3[1]) + (s3[2] + s3[3]));
              rstd = 1.0f / sqrtf(ss * (1.0f / DM) + EPS); }
            unsigned char* xo = XN2 + (size_t)(t0 + i) * DM + 16 * kq;
            const float* gp = g_ffn + 32 * kq;
#define RT_LOAD(xq, gq, c) do { _Pragma("unroll") for (int j = 0; j < 4; ++j) xq[j] = *(const u32x4*)(xr + 128 * (c) + 8 * j); \
                _Pragma("unroll") for (int j = 0; j < 8; ++j) gq[j] = *(const f32x4*)(gp + 128 * (c) + 4 * j); } while (0)
#define RT_PACK(xq, gq, c) do { \
                _Pragma("unroll") for (int j = 0; j < 4; ++j) { const u32x4 xw = xq[j]; \
                    av[8 * j] = bflo(xw.x); av[8 * j + 1] = bfhi(xw.x); av[8 * j + 2] = bflo(xw.y); av[8 * j + 3] = bfhi(xw.y); av[8 * j + 4] = bflo(xw.z); av[8 * j + 5] = bfhi(xw.z); av[8 * j + 6] = bflo(xw.w); av[8 * j + 7] = bfhi(xw.w); } \
                { float nv[32]; \
                  _Pragma("unroll") for (int j = 0; j < 8; ++j) { const f32x4 g = gq[j]; nv[4 * j] = av[4 * j] * rstd * g[0]; nv[4 * j + 1] = av[4 * j + 1] * rstd * g[1]; nv[4 * j + 2] = av[4 * j + 2] * rstd * g[2]; nv[4 * j + 3] = av[4 * j + 3] * rstd * g[3]; } \
                  u32x4 p0, p1; fp6_pack32(nv, p0, p1); \
                  *(u32x4*)(xo + 128 * (c)) = p0; *(u32x4*)(xo + 128 * (c) + 64) = p1; } } while (0)
#define RT_MMA(c) do { _Pragma("unroll") for (int q = 0; q < 32; ++q) { \
                    const float b0 = wb[(128 * (c) + q) * 32], b1v = wb1[(128 * (c) + q) * 32]; \
                    a0 = __builtin_amdgcn_mfma_f32_16x16x4f32(av[q], b0, a0, 0, 0, 0); \
                    a1 = __builtin_amdgcn_mfma_f32_16x16x4f32(av[q], b1v, a1, 0, 0, 0); } } while (0)
            u32x4 xqa[4]; f32x4 gqa[8]; float av[32];
            RT_LOAD(xqa, gqa, 0);
#pragma unroll 1
            for (int c = 0; c < 8; ++c) {
                RT_PACK(xqa, gqa, c);
                asm volatile("" ::: "memory");
                if (c + 1 < 8) RT_LOAD(xqa, gqa, c + 1);
                RT_MMA(c);
            }
#undef RT_LOAD
#undef RT_PACK
#undef RT_MMA
#pragma unroll
            for (int r = 0; r < 4; ++r) { lg[(4 * kq + r) * 33 + i] = a0[r]; lg[(4 * kq + r) * 33 + 16 + i] = a1[r]; }
            LDS_WAIT(); asm volatile("" ::: "memory");
            if (lane < 16) {
                const int t = t0 + lane;
                float v[32];
#pragma unroll
                for (int e = 0; e < 32; ++e) v[e] = lg[lane * 33 + e] * rstd + b_router[e];
                int bi[4]; float bvv[4];
#pragma unroll
                for (int k = 0; k < 4; ++k) {
                    float best = -3e38f; int be = 0;
#pragma unroll
                    for (int e = 0; e < 32; ++e) { const bool take = v[e] > best; best = take ? v[e] : best; be = take ? e : be; }
                    bi[k] = be; bvv[k] = best;
#pragma unroll
                    for (int e = 0; e < 32; ++e) v[e] = (e == be) ? -3e38f : v[e];
                }
                const float e1 = __expf(bvv[1] - bvv[0]), e2 = __expf(bvv[2] - bvv[0]), e3 = __expf(bvv[3] - bvv[0]);
                const float inv = 1.0f / (1.0f + e1 + e2 + e3);
                const float wv[4] = {inv, e1 * inv, e2 * inv, e3 * inv};
#pragma unroll
                for (int k = 0; k < 4; ++k) {
                    const int rk = atomicAdd((int*)&hist[bi[k]], 1);
                    TOPI[t * 4 + k] = bi[k]; TOPW[t * 4 + k] = wv[k]; LRANK[t * 4 + k] = rk;
                }
            }
            LDS_WAIT(); asm volatile("" ::: "memory");
        }
        __syncthreads();
        if (tid < 32) LCOUNT[bx * 32 + tid] = hist[tid];
    }
    GRID_BAR();
    TSTAMP(6);

    REPN(5) {
        PHASE_LANES;
        int* TOPI = WSP(int, WS_TOPI); float* TOPW = WSP(float, WS_TOPW); int* LRANK = WSP(int, WS_LRANK); int* LCOUNT = WSP(int, WS_LCOUNT);
        int* POS = WSP(int, WS_POS); float* ROWW = WSP(float, WS_ROWW); int* PSTART = WSP(int, WS_PSTART); int* TILEEXP = WSP(int, WS_TILEEXP);
        LAS int* part = (LAS int*)(lds);
        LAS int* base = (LAS int*)(lds + 8192);
        {
            const int e = tid & 31, p = tid >> 5; int c = 0, pre = 0;
            const int wpp = (G + 15) / 16;
            for (int w = p * wpp; w < (p + 1) * wpp && w < G; ++w) { const int v = LCOUNT[w * 32 + e]; c += v; pre += (w < bx) ? v : 0; }
            part[p * 32 + e] = c; part[512 + p * 32 + e] = pre;
        }
        __syncthreads();
        if (tid < 32) { int c = 0, pre = 0; for (int p = 0; p < 16; ++p) { c += part[p * 32 + tid]; pre += part[512 + p * 32 + tid]; } part[1024 + tid] = c; part[1056 + tid] = pre; }
        __syncthreads();
        if (tid == 0) {
            int ps = 0;
            for (int e = 0; e < 32; ++e) {
                const int c = part[1024 + e], nt_ = (c + 255) >> 8;
                base[32 + e] = ps; base[e] = ps + part[1056 + e];
                if (bx == 0) PSTART[e] = ps;
                ps += nt_ * 256;
            }
            base[64] = ps; if (bx == 0) PSTART[32] = ps;
        }
        __syncthreads();
        if (bx == 1) {
            const int ntl = base[64] >> 8;
            for (int tl = tid; tl < ntl; tl += NTHREADS) { int e = 0;
#pragma unroll
                for (int q = 1; q < 32; ++q) e += (base[32 + q] <= tl * 256) ? 1 : 0;
                TILEEXP[tl] = e; }
        }
        int* ROWTOK = WSP(int, WS_ROWTOK);
        if (bx < 32) {
            const int c = part[1024 + bx], r0 = base[32 + bx] + c, r1 = base[32 + bx] + (((c + 255) >> 8) << 8);
            for (int r = r0 + tid; r < r1; r += NTHREADS) { ROWTOK[r] = T; ROWW[r] = 0.f; }
        }
        for (int a = tid; a < (T / G) * 4; a += NTHREADS) {
            const int ta = (bx * (T / G)) * 4 + a;
            const int e = TOPI[ta]; const int pos = base[e] + LRANK[ta];
            POS[ta] = pos; ROWTOK[pos] = ta >> 2; ROWW[pos] = TOPW[ta];
        }
    }
    GRID_BAR();
    TSTAMP(7);

    const int ntiles = WSP(int, WS_PSTART)[32] >> 8;
    REPN(6) {
        SchedMoe S{G, vcu, 8, ntiles, WSP(int, WS_TILEEXP), (const char*)(ws + WS_XN2), (const char*)(ws + WS_W1), (size_t)2048 * 1024, WSP(int, WS_ROWTOK)};
        EpiSwiglu E{args.in[16], WSP(unsigned char, WS_H)};
#ifndef NO_G3
        pg8::gemm_phase<EpiSwiglu, SchedMoe, true, true, true>(lds, S, E);
#endif
    }
    GRID_BAR();
    TSTAMP(8);
    REPN(7) {
        SchedMoe S{G, vcu, 4, ntiles, WSP(int, WS_TILEEXP), (const char*)(ws + WS_H), (const char*)(ws + WS_W2), (size_t)1024 * 1024, nullptr};
        EpiDown E{args.in[18], WSP(float, WS_ROWW), WSP(unsigned char, WS_XG)};
#ifndef NO_G4
        pg8::gemm_phase<EpiDown, SchedMoe, false, true>(lds, S, E);
#endif
    }
    GRID_BAR();
    TSTAMP(9);
    if (REP_PHASE == 9) { GRID_BAR(); GRID_BAR(); GRID_BAR(); GRID_BAR(); }
    REPN(8) { PHASE_LANES;
    for (int t = gw; t < T; t += NGW) {
        float* out = args.out; const int* POS = WSP(int, WS_POS); const unsigned char* YE = WSP(unsigned char, WS_XG); const bf16* x1b = WSP(bf16, WS_X1B);
        float* dst = (REP_PHASE == 8 && rep_ == 0) ? WSP(float, WS_H) + 64 * 1024 * 1024 : out;
        const u32x2* xrow = (const u32x2*)(x1b + (size_t)t * DM) + lane; f32x4* drow = (f32x4*)(dst + (size_t)t * DM) + lane;
        u32x2 xv[4]; f32x4 s[4];
#pragma unroll
        for (int j = 0; j < 4; ++j) { xv[j] = __builtin_nontemporal_load(xrow + 64 * j); s[j] = (f32x4){0.f, 0.f, 0.f, 0.f}; }
        unsigned yw[4][4];
#pragma unroll
        for (int k = 0; k < 4; ++k) {
            const int pos = POS[t * 4 + k]; const unsigned* yr = (const unsigned*)(YE + (size_t)pos * 1024) + lane;
#pragma unroll
            for (int j = 0; j < 4; ++j) yw[k][j] = __builtin_nontemporal_load(yr + 64 * j);
        }
#pragma unroll
        for (int k = 0; k < 4; ++k)
#pragma unroll
            for (int j = 0; j < 4; ++j) {
                const f32x2 lo = __builtin_amdgcn_cvt_pk_f32_fp8((int)yw[k][j], false), hi = __builtin_amdgcn_cvt_pk_f32_fp8((int)yw[k][j], true);
                s[j].x += lo.x; s[j].y += lo.y; s[j].z += hi.x; s[j].w += hi.y;
            }
#pragma unroll
        for (int j = 0; j < 4; ++j) __builtin_nontemporal_store((f32x4){bflo(xv[j].x), bfhi(xv[j].x), bflo(xv[j].y), bfhi(xv[j].y)} + s[j] * 0.0625f, drow + 64 * j);
    }
    }
    TSTAMP(10);
    if (REP_PHASE >= 100 && bx == 0 && tid0 == 0) {
        const unsigned long long t0_ = __builtin_amdgcn_s_memrealtime(), want = 9ull * (tsB_ - tsA_);
        while (__builtin_amdgcn_s_memrealtime() - t0_ < want) __builtin_amdgcn_s_sleep(32);
    }
}

extern "C" void kernel_launch(void* const* d_in, const int* in_sizes, int n_in, void* d_out, int out_size, void* d_ws, size_t ws_size, hipStream_t stream) {
    static int grid = 0;
    if (grid == 0) {
        if (n_in != 19 || out_size != T * DM || ws_size < WS_END) { fprintf(stderr, "kernel_launch: unexpected shapes (n_in %d out %d ws %zu)\n", n_in, out_size, ws_size); grid = -1; return; }
        int dev = 0, cus = 0, per_cu = 0;
        hipGetDevice(&dev); hipDeviceGetAttribute(&cus, hipDeviceAttributeMultiprocessorCount, dev);
        hipFuncSetAttribute((const void*)fwd_kernel, hipFuncAttributeMaxDynamicSharedMemorySize, LDS_BYTES);
        hipOccupancyMaxActiveBlocksPerMultiprocessor(&per_cu, (const void*)fwd_kernel, NTHREADS, LDS_BYTES);
        if (per_cu < 1) { fprintf(stderr, "kernel_launch: occupancy query says %d blocks per CU\n", per_cu); per_cu = 1; }
        (void)hipGetLastError();
        grid = cus * 1;
        if (grid % 8 != 0 || T % (grid * NWAVES * 16) != 0) { fprintf(stderr, "kernel_launch: grid %d unsupported\n", grid); grid = -1; return; }
    }
    if (grid < 0) return;
    hipMemsetAsync((char*)d_ws + WS_CTL, 0, CTL_ZERO_BYTES, stream);
    Args a{};
    for (int i = 0; i < 19; ++i) a.in[i] = (const float*)d_in[i];
    a.out = (float*)d_out; a.ws = (unsigned char*)d_ws;
    void* kargs[] = {&a};
    hipError_t e = hipLaunchCooperativeKernel((const void*)fwd_kernel, dim3(grid), dim3(NTHREADS), kargs, LDS_BYTES, stream);
    if (e != hipSuccess) fprintf(stderr, "cooperative launch failed: %s (grid %d)\n", hipGetErrorString(e), grid);
}
```

```cpp
#include <hip/hip_runtime.h>
#include <hip/hip_cooperative_groups.h>
#include <cstdio>
#include <cstdint>
namespace cg = cooperative_groups;

#define GAS __attribute__((address_space(1)))
#define LAS __attribute__((address_space(3)))
typedef unsigned short bf16;
typedef short bf16x8 __attribute__((ext_vector_type(8)));
typedef float f32x4 __attribute__((ext_vector_type(4)));
typedef float f32x2 __attribute__((ext_vector_type(2)));
typedef unsigned u32x4 __attribute__((ext_vector_type(4)));
typedef unsigned u32x2 __attribute__((ext_vector_type(2)));
typedef __bf16 bf16x2_t __attribute__((ext_vector_type(2)));

constexpr int NB = 8, SEQ = 4096, DM = 1024, T = NB * SEQ;
constexpr int NIN = 2816, NEXP = 32, TOPK = 4;
constexpr int MEMLEN = 256, MROWS = NB * MEMLEN;
constexpr float EPS = 1e-6f;
constexpr float C2 = 0.125f * 1.4426950408889634f;
constexpr int MAXTILES = 544, PROWS = MAXTILES * 256;
constexpr int NWAVES = 8, NTHREADS = 512;
#ifndef REP_PHASE
#define REP_PHASE -1
#endif
#define TSTAMP(i) do { if (REP_PHASE == 100 + (i)) tsA_ = __builtin_amdgcn_s_memrealtime(); if (REP_PHASE == 99 + (i)) tsB_ = __builtin_amdgcn_s_memrealtime(); } while (0)
#define REPN(k) for (int rep_ = 0; rep_ < ((REP_PHASE == (k)) ? 2 : 1); ++rep_)
constexpr int LDS_MISC = 150016;
constexpr int LDS_BYTES = 150016 + 256;

constexpr size_t MiB = 1u << 20;
constexpr size_t WS_CTL = 0, CTL_ZERO_BYTES = 131072;
constexpr size_t WS_BAR = 65536;
constexpr size_t WS_KMEAN = 1 * MiB;
constexpr size_t WS_WRG = 2 * MiB;
constexpr size_t WS_SSQ = 3 * MiB;
constexpr size_t WS_TOPI = 5 * MiB, WS_TOPW = 5 * MiB + 512 * 1024, WS_LRANK = 6 * MiB, WS_POS = 6 * MiB + 512 * 1024;
constexpr size_t WS_ROWW = 7 * MiB;
constexpr size_t WS_LCOUNT = 8 * MiB, WS_PSTART = 8 * MiB + 65536, WS_TILEEXP = 8 * MiB + 131072;
constexpr size_t WS_WIN = 16 * MiB, WS_WMEM = 22 * MiB, WS_WOUT = 24 * MiB, WS_W1 = 32 * MiB, WS_W2 = 160 * MiB;
constexpr size_t WS_XN = 224 * MiB, WS_MEMN = 288 * MiB;
constexpr size_t WS_QA = 292 * MiB, WS_KA = 324 * MiB, WS_VA = 356 * MiB;
constexpr size_t WS_QR = 388 * MiB, WS_KR = 404 * MiB, WS_VR = 420 * MiB, WS_GR = 436 * MiB, WS_QM = 452 * MiB;
constexpr size_t WS_MK = 468 * MiB, WS_MV = 469 * MiB;
constexpr size_t WS_Y = 470 * MiB, WS_RET = 534 * MiB;
constexpr size_t WS_XG = 224 * MiB;
constexpr size_t WS_XN2 = 496 * MiB;
constexpr size_t WS_X1B = 388 * MiB;
constexpr size_t WS_IRS = 10 * MiB;
constexpr size_t WS_ROWTOK = 9 * MiB;
constexpr size_t WS_H = 566 * MiB;
constexpr size_t WS_END = 838 * MiB;

struct Args {
    const float* in[19]; float* out; unsigned char* ws; int pad0, pad1;
};

__device__ __forceinline__ unsigned cvtpk(float lo, float hi) { f32x2 v = {lo, hi}; bf16x2_t b = __builtin_convertvector(v, bf16x2_t); return __builtin_bit_cast(unsigned, b); }
__device__ __forceinline__ float bf2f(unsigned short b) { return __uint_as_float(((unsigned)b) << 16); }
__device__ __forceinline__ float bflo(unsigned w) { return __uint_as_float(w << 16); }
__device__ __forceinline__ float bfhi(unsigned w) { return __uint_as_float(w & 0xffff0000u); }
__device__ __forceinline__ float wave_sum(float v) {
#pragma unroll
    for (int o = 1; o < 64; o <<= 1) v += __shfl_xor(v, o);
    return v;
}
#define LDS_WAIT() asm volatile("s_waitcnt lgkmcnt(0)" ::: "memory")
typedef unsigned v6u_t __attribute__((ext_vector_type(6)));
typedef float v16f_t __attribute__((ext_vector_type(16)));
#ifndef FP6_SCALE_DIV
#define FP6_SCALE_DIV 1
#endif
__device__ __forceinline__ void fp6_pack32(const float (&v)[32], u32x4& p0, u32x4& p1) {
    float mx = 1e-30f;
#pragma unroll
    for (int i = 0; i < 32; ++i) mx = fmaxf(mx, fabsf(v[i]));
    const unsigned bits = __float_as_uint(mx * (1.0f / 7.5f));
    int e = (int)((bits + 0x7FFFFFu) >> 23) - 127;
    e = e < -126 ? -126 : (e > 126 ? 126 : e);
    const float sc = __uint_as_float((unsigned)((FP6_SCALE_DIV ? e : -e) + 127) << 23);
    v16f_t lo, hi;
#pragma unroll
    for (int i = 0; i < 16; ++i) { lo[i] = v[i]; hi[i] = v[16 + i]; }
    const v6u_t w = __builtin_amdgcn_cvt_scalef32_2xpk16_fp6_f32(lo, hi, sc);
    p0 = (u32x4){w[0], w[1], w[2], w[3]}; p1 = (u32x4){w[4], w[5], (unsigned)(e + 127), 0u};
}
__device__ __forceinline__ int opaque(int v) { asm volatile("" : "+v"(v)); return v; }

namespace pg8 {
constexpr int BM = 256, BK = 64, HALF = 128, HTB = HALF * BK * 2, STAGE_BYTES = 8 * HTB, NXCD = 8, WGM = 8, K = 1024;
__host__ __device__ __forceinline__ int lds_byte(int r, int c) { const int st = (r >> 4) * 2 + (c >> 5), rr = r & 15, cc = c & 31, ob = rr * 64 + cc * 2; return st * 1024 + (ob ^ (((ob >> 9) & 1) << 5)); }
__host__ __device__ __forceinline__ void stage_rc(int b, int& R, int& C) { const int st = b / 1024, sb = b % 1024, swz = sb ^ (((sb >> 9) & 1) << 5); R = (st >> 1) * 16 + swz / 64; C = (st & 1) * 32 + (swz % 64) / 2; }
__host__ __device__ __forceinline__ int perm32(int rho) { const int n = rho >> 4, i = rho & 15; return 8 * (i >> 2) + 4 * n + (i & 3); }
struct Unit { int pm, pn, aux; };

__device__ __forceinline__ bool static_order(int L, int nM, int nN, int& pm, int& pn) {
    const int nwg = nM * nN; if (L >= nwg) return false;
    int wgid = L; { const int q = nwg / NXCD, r = nwg % NXCD, xcd = wgid % NXCD, off = wgid / NXCD; wgid = (xcd < r ? xcd * (q + 1) : r * (q + 1) + (xcd - r) * q) + off; }
    const int nig = WGM * nN, gid = wgid / nig, fm = gid * WGM, gsz = (nM - fm) < WGM ? (nM - fm) : WGM;
    pm = fm + ((wgid % nig) % gsz); pn = (wgid % nig) / gsz; return true;
}

typedef int v8i_t __attribute__((ext_vector_type(8)));
typedef int v4i_t __attribute__((ext_vector_type(4)));
__device__ __forceinline__ v8i_t cat8(bf16x8 lo, bf16x8 hi) { const v4i_t a = __builtin_bit_cast(v4i_t, lo), b = __builtin_bit_cast(v4i_t, hi); return __builtin_shufflevector(a, b, 0, 1, 2, 3, 4, 5, 6, 7); }
typedef int v6i_t __attribute__((ext_vector_type(6)));
__device__ __forceinline__ v6i_t cat6(bf16x8 lo, bf16x8 hi) { const v4i_t a = __builtin_bit_cast(v4i_t, lo), b = __builtin_bit_cast(v4i_t, hi); return __builtin_shufflevector(a, b, 0, 1, 2, 3, 4, 5); }
__device__ __forceinline__ int scl6(bf16x8 hi) { return __builtin_bit_cast(v4i_t, hi)[2]; }
constexpr int PRE_LDS = 133120;
template <class T, class = void> struct pre_kib { static constexpr int value = 0; };
template <class T> struct pre_kib<T, decltype((void)T::PRE_KIB)> { static constexpr int value = T::PRE_KIB; };
template <class Epi, class Sched, bool GATHER = false, bool FP8 = false, bool FP6 = false>
__device__ __forceinline__ void gemm_phase(LAS unsigned char* lds, const Sched& S, const Epi& E) {
    constexpr int PRE = pre_kib<Epi>::value;
#define PG8_PRE(unit, par) do { if constexpr (PRE > 0) { if (wid == 0) { _Pragma("unroll") for (int _k = 0; _k < PRE; ++_k) \
        __builtin_amdgcn_global_load_lds((const unsigned*)E.pre_src(unit, _k, lane), (LAS unsigned*)(lds + PRE_LDS + (par) * 2048 + _k * 1024), 16, 0, 0); } } } while (0)
    constexpr int PITCH = FP8 ? 1024 : 2048;
    const int tid = opaque((int)threadIdx.x), wid = __builtin_amdgcn_readfirstlane(tid >> 6), lane = tid & 63, wr = wid >> 2, wc = wid & 3, fr = lane & 15, fq = lane >> 4;
    constexpr int nt = PITCH / 128;
    unsigned voffA[2], voffB[2];
#pragma unroll
    for (int i = 0; i < 2; ++i) { int R, C; stage_rc(tid * 16 + i * 8192, R, C); const int Rb = (R & ~31) + perm32(R & 31);
        voffA[i] = (unsigned)(R * PITCH + C * 2); voffB[i] = (unsigned)(Rb * PITCH + C * 2); }
    const size_t kstep = (size_t)(BK * 2);
    const size_t hstep = (size_t)HALF * PITCH;
    const unsigned ldsw = (unsigned)wid * 1024u;
    const int aoff = lds_byte(wr * 64 + fr, fq * 8), boff = lds_byte(wc * 32 + fr, fq * 8);
#define PG8_SA(b, h) (((b) * 2 + (h)) * HTB)
#define PG8_SB(b, h) ((4 + (b) * 2 + (h)) * HTB)
#define PG8_STAGE(bufoff, gbase, voff) do { _Pragma("unroll") for (int _i = 0; _i < 2; ++_i) \
        __builtin_amdgcn_global_load_lds((const unsigned*)((const char*)(gbase) + (voff)[_i]), (LAS unsigned*)(lds + (bufoff) + ldsw + _i * 8192), 16, 0, 0); } while (0)
#define PG8_LDA(dst, b, h) do { _Pragma("unroll") for (int m = 0; m < 4; ++m) _Pragma("unroll") for (int k = 0; k < 2; ++k) dst[m][k] = *(const LAS bf16x8*)(lds + PG8_SA(b, h) + aoff + m * 2048 + k * 1024); } while (0)
#define PG8_LDB(dst, b, h) do { _Pragma("unroll") for (int n = 0; n < 2; ++n) _Pragma("unroll") for (int k = 0; k < 2; ++k) dst[n][k] = *(const LAS bf16x8*)(lds + PG8_SB(b, h) + boff + n * 2048 + k * 1024); } while (0)
#define PG8_MMA(ai, bj, At, Bt) do { __builtin_amdgcn_s_setprio(1); \
        if constexpr (FP6) { _Pragma("unroll") for (int m = 0; m < 4; ++m) _Pragma("unroll") for (int n = 0; n < 2; ++n) \
            asm volatile("s_nop 1\n\tv_mfma_scale_f32_16x16x128_f8f6f4 %0, %1, %2, %0, %3, %4 op_sel_hi:[0,0,0] cbsz:2 blgp:2" : "+v"(acc[ai][bj][m][n]) : "v"(cat6(Bt[n][0], Bt[n][1])), "v"(cat6(At[m][0], At[m][1])), "v"(scl6(Bt[n][1])), "v"(scl6(At[m][1]))); } \
        else if constexpr (FP8) { _Pragma("unroll") for (int m = 0; m < 4; ++m) _Pragma("unroll") for (int n = 0; n < 2; ++n) \
            asm volatile("v_mfma_scale_f32_16x16x128_f8f6f4 %0, %1, %2, %0, %3, %3 op_sel_hi:[0,0,0]" : "+v"(acc[ai][bj][m][n]) : "v"(cat8(Bt[n][0], Bt[n][1])), "v"(cat8(At[m][0], At[m][1])), "v"(0x7f7f7f7f)); } \
        else { _Pragma("unroll") for (int m = 0; m < 4; ++m) _Pragma("unroll") for (int n = 0; n < 2; ++n) _Pragma("unroll") for (int k = 0; k < 2; ++k) \
            acc[ai][bj][m][n] = __builtin_amdgcn_mfma_f32_16x16x32_bf16(Bt[n][k], At[m][k], acc[ai][bj][m][n], 0, 0, 0); } \
        __builtin_amdgcn_s_setprio(0); } while (0)
#define PG8_WAIT_V(n) asm volatile("s_waitcnt vmcnt(" #n ")" ::: "memory")
#define PG8_WAIT_L(n) asm volatile("s_waitcnt lgkmcnt(" #n ")" ::: "memory")
#define PG8_BAR __builtin_amdgcn_s_barrier()
#define PG8_SCHED __builtin_amdgcn_sched_barrier(0)
    Unit cur, nxt; int ui = 0;
    if (!S.next(0, cur)) return;
    PG8_PRE(cur, 0);
    unsigned vGc[2][2], vGn[2][2]; int gR[2], gC[2];
    const char* gA = nullptr;
    if constexpr (GATHER) {
        gA = S.abase();
#pragma unroll
        for (int i = 0; i < 2; ++i) { stage_rc(tid * 16 + i * 8192, gR[i], gC[i]); }
        if (wid == 0) __builtin_amdgcn_global_load_lds((const unsigned*)(S.tokptr(cur) + lane * 16), (LAS unsigned*)(lds + 131072), 16, 0, 0);
        asm volatile("s_waitcnt vmcnt(0)" ::: "memory"); __builtin_amdgcn_s_barrier(); asm volatile("" ::: "memory");
#pragma unroll
        for (int h = 0; h < 2; ++h)
#pragma unroll
            for (int i = 0; i < 2; ++i) { const int tok = ((const LAS int*)(lds + 131072))[h * 128 + gR[i]]; vGc[h][i] = (unsigned)tok * (unsigned)PITCH + (unsigned)gC[i] * 2u; vGn[h][i] = vGc[h][i]; }
    }
    f32x4 acc[2][2][4][2];
#pragma unroll
    for (int a = 0; a < 2; ++a)
#pragma unroll
        for (int b = 0; b < 2; ++b)
#pragma unroll
            for (int m = 0; m < 4; ++m)
#pragma unroll
                for (int n = 0; n < 2; ++n) acc[a][b][m][n] = (f32x4){0.f, 0.f, 0.f, 0.f};
    bf16x8 At[4][2], B0[2][2], B1[2][2];
    const char* cA = GATHER ? gA : S.aptr(cur); const char* cB = S.bptr(cur);
    const size_t ahstep = GATHER ? (size_t)0 : hstep;
    {
        PG8_STAGE(PG8_SB(0, 0), cB, voffB); PG8_STAGE(PG8_SB(0, 1), cB + hstep, voffB);
        if constexpr (GATHER) { PG8_STAGE(PG8_SA(0, 0), cA, vGc[0]); PG8_STAGE(PG8_SA(0, 1), cA, vGc[1]); } else { PG8_STAGE(PG8_SA(0, 0), cA, voffA); PG8_STAGE(PG8_SA(0, 1), cA + hstep, voffA); }
        if (wr == 1) PG8_BAR;
        PG8_WAIT_V(2); PG8_BAR;
        PG8_STAGE(PG8_SB(1, 0), cB + kstep, voffB);
        if constexpr (GATHER) { PG8_STAGE(PG8_SA(1, 0), cA + kstep, vGc[0]); } else { PG8_STAGE(PG8_SA(1, 0), cA + kstep, voffA); }
        PG8_STAGE(PG8_SB(1, 1), cB + hstep + kstep, voffB);
        PG8_WAIT_V(6); PG8_BAR;
    }
    for (;;) {
        const bool has_next = S.next(ui + 1, nxt);
        const char* nA = GATHER ? gA : (has_next ? S.aptr(nxt) : cA); const char* nB = has_next ? S.bptr(nxt) : cB;
        if constexpr (GATHER) { if (has_next && wid == 0) __builtin_amdgcn_global_load_lds((const unsigned*)(S.tokptr(nxt) + lane * 16), (LAS unsigned*)(lds + 131072 + ((ui + 1) & 1) * 1024), 16, 0, 0); }
#pragma nounroll
        for (int t = 0; t < nt; t += 2) {
            const bool last = (t == nt - 2);
            const char* a1 = cA + (size_t)(t + 1) * kstep;
            const char* a2 = last ? nA : cA + (size_t)(t + 2) * kstep; const char* b2 = last ? nB : cB + (size_t)(t + 2) * kstep;
            const char* a3 = a2 + kstep; const char* b3 = b2 + kstep;
            unsigned v2h0[2], v2h1[2];
            if constexpr (GATHER) {
                if (last && has_next) {
                    const LAS int* tk = (const LAS int*)(lds + 131072 + ((ui + 1) & 1) * 1024);
#pragma unroll
                    for (int h = 0; h < 2; ++h)
#pragma unroll
                        for (int i = 0; i < 2; ++i) vGn[h][i] = (unsigned)tk[h * 128 + gR[i]] * (unsigned)PITCH + (unsigned)gC[i] * 2u;
                }
#pragma unroll
                for (int i = 0; i < 2; ++i) { v2h0[i] = last ? vGn[0][i] : vGc[0][i]; v2h1[i] = last ? vGn[1][i] : vGc[1][i]; }
            } else {
#pragma unroll
                for (int i = 0; i < 2; ++i) { v2h0[i] = voffA[i]; v2h1[i] = voffA[i]; }
            }
            PG8_LDB(B0, 0, 0); PG8_LDB(B1, 0, 1); PG8_SCHED; PG8_LDA(At, 0, 0);
            if constexpr (GATHER) { PG8_STAGE(PG8_SA(1, 1), a1, vGc[1]); } else { PG8_STAGE(PG8_SA(1, 1), a1 + hstep, voffA); }
            PG8_WAIT_V(8); PG8_WAIT_L(0); PG8_BAR; PG8_MMA(0, 0, At, B0); PG8_MMA(0, 1, At, B1); PG8_BAR; PG8_SCHED;
            PG8_LDA(At, 0, 1); PG8_STAGE(PG8_SB(0, 0), b2, voffB); PG8_STAGE(PG8_SB(0, 1), b2 + hstep, voffB); PG8_STAGE(PG8_SA(0, 0), a2, v2h0);
            PG8_WAIT_V(8); PG8_WAIT_L(0); PG8_BAR; PG8_MMA(1, 0, At, B0); PG8_MMA(1, 1, At, B1); PG8_BAR; PG8_SCHED;
            PG8_LDB(B0, 1, 0); PG8_LDB(B1, 1, 1); PG8_SCHED; PG8_LDA(At, 1, 0); PG8_STAGE(PG8_SA(0, 1), a2 + ahstep, v2h1);
            PG8_WAIT_V(8); PG8_WAIT_L(0); PG8_BAR; PG8_MMA(0, 0, At, B0); PG8_MMA(0, 1, At, B1); PG8_BAR; PG8_SCHED;
            PG8_LDA(At, 1, 1); PG8_STAGE(PG8_SB(1, 0), b3, voffB); PG8_STAGE(PG8_SB(1, 1), b3 + hstep, voffB); PG8_STAGE(PG8_SA(1, 0), a3, v2h0);
            PG8_WAIT_V(8); PG8_WAIT_L(0); PG8_BAR; PG8_MMA(1, 0, At, B0); PG8_MMA(1, 1, At, B1); PG8_BAR; PG8_SCHED;
        }
        if (wr == 0) PG8_BAR;
        if constexpr (FP8) asm volatile("s_nop 15\n\ts_nop 7" ::: "memory");
        if constexpr (PRE > 0) E(acc, cur, wr, wc, fr, fq, (const LAS float*)(lds + PRE_LDS + (ui & 1) * 2048)); else E(acc, cur, wr, wc, fr, fq);
        if (!has_next) break;
#pragma unroll
        for (int a = 0; a < 2; ++a)
#pragma unroll
            for (int b = 0; b < 2; ++b)
#pragma unroll
                for (int m = 0; m < 4; ++m)
#pragma unroll
                    for (int n = 0; n < 2; ++n) acc[a][b][m][n] = (f32x4){0.f, 0.f, 0.f, 0.f};
        cur = nxt; cA = nA; cB = nB; ++ui;
        PG8_PRE(cur, ui & 1);
        if constexpr (GATHER) {
#pragma unroll
            for (int h = 0; h < 2; ++h)
#pragma unroll
                for (int i = 0; i < 2; ++i) vGc[h][i] = vGn[h][i];
        }
        if (wr == 1) PG8_BAR;
    }
    PG8_WAIT_V(0);
    PG8_BAR;
#undef PG8_PRE
#undef PG8_SA
#undef PG8_SB
#undef PG8_STAGE
#undef PG8_LDA
#undef PG8_LDB
#undef PG8_MMA
#undef PG8_WAIT_V
#undef PG8_WAIT_L
#undef PG8_BAR
#undef PG8_SCHED
}
}
using pg8::Unit;

struct SchedProj {
    int G, c; const char *XN, *MEMN, *WIN, *WMEM;
    __device__ __forceinline__ bool next(int i, Unit& u) const {
        const int L = i * G + c;
        if (L < 1408) { u.aux = 0; return pg8::static_order(L, 128, 11, u.pm, u.pn); }
        if (L < 1424) { const int j = L - 1408; u.pm = j >> 1; u.pn = j & 1; u.aux = 1; return true; }
        return false;
    }
    __device__ __forceinline__ const char* aptr(const Unit& u) const { return (u.aux ? MEMN : XN) + (size_t)u.pm * (256 * 2048); }
    __device__ __forceinline__ const char* bptr(const Unit& u) const { return (u.aux ? WMEM : WIN) + (size_t)u.pn * (256 * 2048); }
};
struct SchedProj10 {
    int G, c; const char *XN, *WIN;
    __device__ __forceinline__ bool next(int i, Unit& u) const { int j; u.aux = 0; if (!pg8::static_order(i * G + c, 128, 10, u.pm, j)) return false; u.pn = j < 9 ? j : 10; return true; }
    __device__ __forceinline__ const char* aptr(const Unit& u) const { return XN + (size_t)u.pm * (256 * 2048); }
    __device__ __forceinline__ const char* bptr(const Unit& u) const { return WIN + (size_t)u.pn * (256 * 2048); }
};
struct SchedProjOne {
    int c; const char *XN, *MEMN, *WIN, *WMEM;
    __device__ __forceinline__ bool next(int i, Unit& u) const {
        if (i != 0 || c >= 144) return false;
        if (c < 128) { u.pm = c; u.pn = 9; u.aux = 0; } else { const int j = c - 128; u.pm = j >> 1; u.pn = j & 1; u.aux = 1; }
        return true;
    }
    __device__ __forceinline__ const char* aptr(const Unit& u) const { return (u.aux ? MEMN : XN) + (size_t)u.pm * (256 * 2048); }
    __device__ __forceinline__ const char* bptr(const Unit& u) const { return (u.aux ? WMEM : WIN) + (size_t)u.pn * (256 * 2048); }
};
struct SchedPlain {
    int G, c, nM, nN; const char *A, *B;
    __device__ __forceinline__ bool next(int i, Unit& u) const { u.aux = 0; return pg8::static_order(i * G + c, nM, nN, u.pm, u.pn); }
    __device__ __forceinline__ const char* aptr(const Unit& u) const { return A + (size_t)u.pm * (256 * 2048); }
    __device__ __forceinline__ const char* bptr(const Unit& u) const { return B + (size_t)u.pn * (256 * 2048); }
};
struct SchedMoe {
    int G, vcu, npn, ntiles; const int* tile_exp; const char *A, *B; size_t bexp;
    __device__ __forceinline__ bool next(int i, Unit& u) const {
        const int L = i * G + vcu, tile = L / npn; if (tile >= ntiles) return false;
        u.pm = tile; u.pn = L - tile * npn; u.aux = __builtin_amdgcn_readfirstlane(tile_exp[tile]); return true;
    }
    __device__ __forceinline__ const char* aptr(const Unit& u) const { return A + (size_t)u.pm * (256 * 1024); }
    __device__ __forceinline__ const char* bptr(const Unit& u) const { return B + (size_t)u.aux * bexp + (size_t)u.pn * (256 * 1024); }
    const int* rowtok;
    __device__ __forceinline__ const char* abase() const { return A; }
    __device__ __forceinline__ const char* tokptr(const Unit& u) const { return (const char*)(rowtok + (size_t)u.pm * 256); }
};

struct EpiProj {
    unsigned char* ws;
    const float *gq, *gk, *gmq, *gmk;
    __device__ __forceinline__ void operator()(const f32x4 (&acc)[2][2][4][2], const Unit& u, int wr, int wc, int fr, int fq) const {
        int mode = 0; bf16* out; int ld = 256, coff = 0; const float* gain = nullptr; float scale = 1.f; bool kmean = false;
        if (u.aux == 0) {
            switch (u.pn) {
                case 0: case 1: out = (bf16*)(ws + WS_QA); ld = 512; coff = u.pn * 256; mode = 1; gain = gq; scale = C2; break;
                case 2: case 3: out = (bf16*)(ws + WS_KA); ld = 512; coff = (u.pn - 2) * 256; mode = 1; gain = gk; kmean = true; break;
                case 4: case 5: out = (bf16*)(ws + WS_VA); ld = 512; coff = (u.pn - 4) * 256; break;
                case 6: out = (bf16*)(ws + WS_QR); mode = 2; break;
                case 7: out = (bf16*)(ws + WS_KR); mode = 2; scale = 0.125f; break;
                case 8: out = (bf16*)(ws + WS_VR); break;
                case 9: out = (bf16*)(ws + WS_GR); mode = 3; break;
                default: out = (bf16*)(ws + WS_QM); mode = 1; gain = gmq; scale = C2; break;
            }
        } else {
            if (u.pn == 0) { out = (bf16*)(ws + WS_MK); mode = 1; gain = gmk; } else { out = (bf16*)(ws + WS_MV); }
        }
        const int row0 = u.pm * 256 + wr * 64 + fr;
        const int colb = coff + wc * 64 + 8 * fq;
        if (gain == nullptr) gain = gq;
        f32x4 gv[2][2];
#pragma unroll
        for (int bj = 0; bj < 2; ++bj)
#pragma unroll
            for (int n = 0; n < 2; ++n) gv[bj][n] = *(const f32x4*)(gain + bj * 32 + 8 * fq + 4 * n);
        f32x4 ks[2][2];
#pragma unroll
        for (int bj = 0; bj < 2; ++bj)
#pragma unroll
            for (int n = 0; n < 2; ++n) ks[bj][n] = (f32x4){0.f, 0.f, 0.f, 0.f};
#pragma unroll
        for (int ai = 0; ai < 2; ++ai)
#pragma unroll
            for (int m = 0; m < 4; ++m) {
                const int row = row0 + ai * 128 + m * 16;
                f32x4 v[2][2];
#pragma unroll
                for (int bj = 0; bj < 2; ++bj)
#pragma unroll
                    for (int n = 0; n < 2; ++n) v[bj][n] = acc[ai][bj][m][n];
                if (mode == 1) {
                    float ss = 0.f;
#pragma unroll
                    for (int bj = 0; bj < 2; ++bj)
#pragma unroll
                        for (int n = 0; n < 2; ++n) { const f32x4 x = v[bj][n]; ss += (x[0] * x[0] + x[1] * x[1]) + (x[2] * x[2] + x[3] * x[3]); }
                    ss += __shfl_xor(ss, 16); ss += __shfl_xor(ss, 32);
                    const float r = scale / sqrtf(ss * (1.0f / 64.0f) + EPS);
#pragma unroll
                    for (int bj = 0; bj < 2; ++bj)
#pragma unroll
                        for (int n = 0; n < 2; ++n) v[bj][n] = v[bj][n] * r * gv[bj][n];
                } else if (mode == 2) {
                    const float pos = (float)(row & (SEQ - 1));
                    const float lgam = __builtin_amdgcn_logf(1.0f - __builtin_amdgcn_exp2f(-5.0f - (float)wc));
                    const float rsc = scale * __builtin_amdgcn_exp2f(((u.pn == 6) ? lgam : -lgam) * (float)(row & 127));
#pragma unroll
                    for (int n = 0; n < 2; ++n)
#pragma unroll
                        for (int j = 0; j < 4; ++j) {
                            const float fre = __builtin_amdgcn_exp2f((float)(8 * fq + 4 * n + j) * (-13.287712379549449f / 31.0f)) * 0.15915494309189535f;
                            float tt = pos * fre; tt = tt - floorf(tt);
                            const float sn = __builtin_amdgcn_sinf(tt), cs = __builtin_amdgcn_cosf(tt);
                            const float t1 = v[0][n][j], t2 = v[1][n][j];
                            v[0][n][j] = (t1 * cs - t2 * sn) * rsc; v[1][n][j] = (t2 * cs + t1 * sn) * rsc;
                        }
                } else if (mode == 3) {
#pragma unroll
                    for (int bj = 0; bj < 2; ++bj)
#pragma unroll
                        for (int n = 0; n < 2; ++n)
#pragma unroll
                            for (int j = 0; j < 4; ++j) { const float x = v[bj][n][j]; v[bj][n][j] = x / (1.0f + __expf(-x)); }
                }
                if (kmean) {
#pragma unroll
                    for (int bj = 0; bj < 2; ++bj)
#pragma unroll
                        for (int n = 0; n < 2; ++n) ks[bj][n] += v[bj][n];
                }
                bf16* rowp = out + (size_t)row * ld + colb;
#pragma unroll
                for (int bj = 0; bj < 2; ++bj) { u32x4 w; w.x = cvtpk(v[bj][0][0], v[bj][0][1]); w.y = cvtpk(v[bj][0][2], v[bj][0][3]); w.z = cvtpk(v[bj][1][0], v[bj][1][1]); w.w = cvtpk(v[bj][1][2], v[bj][1][3]);
                    *(u32x4*)(rowp + bj * 32) = w; }
            }
        if (kmean) {
            float* kp = (float*)(ws + WS_KMEAN) + ((size_t)u.pm * 8 + (u.pn - 2) * 4 + wc) * 64 + 8 * fq;
#pragma unroll
            for (int bj = 0; bj < 2; ++bj)
#pragma unroll
                for (int n = 0; n < 2; ++n)
#pragma unroll
                    for (int j = 0; j < 4; ++j) {
                        float s = ks[bj][n][j];
                        s += __shfl_xor(s, 1); s += __shfl_xor(s, 2); s += __shfl_xor(s, 4); s += __shfl_xor(s, 8);
                        if (fr == 0) atomicAdd(kp + bj * 32 + 4 * n + j, s * (1.0f / 256.0f));
                    }
        }
    }
};

struct EpiOut {
    const bf16* xn; const float* irs; const float* gattn; bf16* out; float* ssq;
    static constexpr int PRE_KIB = 2;
    __device__ __forceinline__ const char* pre_src(const Unit& u, int k, int lane) const { return (const char*)(k == 0 ? gattn + u.pn * 256 : irs + (size_t)u.pm * 256) + lane * 16; }
    __device__ __forceinline__ void operator()(const f32x4 (&acc)[2][2][4][2], const Unit& u, int wr, int wc, int fr, int fq, const LAS float* pre) const {
        const int row0 = u.pm * 256 + wr * 64 + fr, col0 = u.pn * 256 + wc * 32 + 8 * fq;
        f32x4 ig[2][2];
#pragma unroll
        for (int bj = 0; bj < 2; ++bj)
#pragma unroll
            for (int n = 0; n < 2; ++n) { const f32x4 g = *(const LAS f32x4*)(pre + wc * 32 + 8 * fq + bj * 128 + 4 * n); ig[bj][n] = (f32x4){1.0f / g[0], 1.0f / g[1], 1.0f / g[2], 1.0f / g[3]}; }
#pragma unroll
        for (int ai = 0; ai < 2; ++ai) {
            u32x4 xwv[4][2]; float irv[4];
#pragma unroll
            for (int m = 0; m < 4; ++m) { const int row = row0 + ai * 128 + m * 16; irv[m] = pre[256 + wr * 64 + fr + ai * 128 + m * 16];
#pragma unroll
                for (int bj = 0; bj < 2; ++bj) xwv[m][bj] = __builtin_nontemporal_load((const u32x4*)(xn + (size_t)row * DM + col0 + bj * 128)); }
#pragma unroll
            for (int m = 0; m < 4; ++m) {
                const int row = row0 + ai * 128 + m * 16; const size_t off = (size_t)row * DM + col0; float ss = 0.f; const float ir = irv[m];
#pragma unroll
                for (int bj = 0; bj < 2; ++bj) {
                    const u32x4 xw = xwv[m][bj];
                    const f32x4 o0 = (f32x4){bflo(xw.x), bfhi(xw.x), bflo(xw.y), bfhi(xw.y)} * ig[bj][0] * ir + acc[ai][bj][m][0], o1 = (f32x4){bflo(xw.z), bfhi(xw.z), bflo(xw.w), bfhi(xw.w)} * ig[bj][1] * ir + acc[ai][bj][m][1];
                    ss += ((o0[0] * o0[0] + o0[1] * o0[1]) + (o0[2] * o0[2] + o0[3] * o0[3])) + ((o1[0] * o1[0] + o1[1] * o1[1]) + (o1[2] * o1[2] + o1[3] * o1[3]));
                    u32x4 w; w.x = cvtpk(o0[0], o0[1]); w.y = cvtpk(o0[2], o0[3]); w.z = cvtpk(o1[0], o1[1]); w.w = cvtpk(o1[2], o1[3]);
                    *(u32x4*)(out + off + bj * 128) = w; }
                ss += __shfl_xor(ss, 16); ss += __shfl_xor(ss, 32);
                if (fq == 0) ssq[(size_t)row * 16 + u.pn * 4 + wc] = ss;
            }
        }
    }
};

struct EpiSwiglu {
    static constexpr int PRE_KIB = 1;
    const float* b1; unsigned char* H;
    __device__ __forceinline__ const char* pre_src(const Unit& u, int k, int lane) const { return (const char*)(b1 + (size_t)u.aux * 2048 + u.pn * 256) + lane * 16; }
    __device__ __forceinline__ void operator()(const f32x4 (&acc)[2][2][4][2], const Unit& u, int wr, int wc, int fr, int fq, const LAS float* pre) const {
        const int row0 = u.pm * 256 + wr * 64 + fr, p0 = u.pn * 128 + wc * 32 + 8 * fq;
        const LAS float* bp = pre + 2 * (wc * 32 + 8 * fq);
        f32x4 bv[4];
#pragma unroll
        for (int i = 0; i < 4; ++i) bv[i] = *(const LAS f32x4*)(bp + 4 * i);
#pragma unroll
        for (int ai = 0; ai < 2; ++ai)
#pragma unroll
            for (int m = 0; m < 4; ++m) {
                const int row = row0 + ai * 128 + m * 16;
                float h[8];
#pragma unroll
                for (int n = 0; n < 2; ++n)
#pragma unroll
                    for (int j = 0; j < 4; ++j) {
                        const int i = 4 * n + j;
                        const float g = fminf(acc[ai][0][m][n][j] + bv[i >> 1][(i & 1) * 2], 7.0f);
                        const float l = fminf(fmaxf(acc[ai][1][m][n][j] + bv[i >> 1][(i & 1) * 2 + 1], -7.0f), 7.0f);
                        h[i] = g * __builtin_amdgcn_rcpf(1.0f + __builtin_amdgcn_exp2f(-1.702f * 1.4426950408889634f * g)) * (l + 1.0f);
                    }
                int w0 = 0, w1 = 0;
                w0 = __builtin_amdgcn_cvt_pk_fp8_f32(h[0], h[1], w0, false); w0 = __builtin_amdgcn_cvt_pk_fp8_f32(h[2], h[3], w0, true);
                w1 = __builtin_amdgcn_cvt_pk_fp8_f32(h[4], h[5], w1, false); w1 = __builtin_amdgcn_cvt_pk_fp8_f32(h[6], h[7], w1, true);
                *(u32x2*)(H + (size_t)row * 1024 + p0) = (u32x2){(unsigned)w0, (unsigned)w1};
            }
    }
};

struct EpiDown {
    static constexpr int PRE_KIB = 2;
    const float* b2; const float* roww; unsigned char* YE;
    __device__ __forceinline__ const char* pre_src(const Unit& u, int k, int lane) const {
        return (const char*)(k == 0 ? b2 + (size_t)u.aux * 1024 + u.pn * 256 : roww + (size_t)u.pm * 256) + lane * 16; }
    __device__ __forceinline__ void operator()(const f32x4 (&acc)[2][2][4][2], const Unit& u, int wr, int wc, int fr, int fq, const LAS float* pre) const {
        const int row0 = u.pm * 256 + wr * 64 + fr, c0 = u.pn * 256 + wc * 32 + 8 * fq;
        const LAS float* bp = pre + wc * 32 + 8 * fq;
        f32x4 bv[2][2];
#pragma unroll
        for (int bj = 0; bj < 2; ++bj)
#pragma unroll
            for (int n = 0; n < 2; ++n) bv[bj][n] = *(const LAS f32x4*)(bp + bj * 128 + 4 * n);
        float w8v[2][4];
#pragma unroll
        for (int ai = 0; ai < 2; ++ai)
#pragma unroll
            for (int m = 0; m < 4; ++m) w8v[ai][m] = pre[256 + wr * 64 + fr + ai * 128 + m * 16] * 16.0f;
#pragma unroll
        for (int ai = 0; ai < 2; ++ai)
#pragma unroll
            for (int m = 0; m < 4; ++m) {
                const int row = row0 + ai * 128 + m * 16; const float w8 = w8v[ai][m];
#pragma unroll
                for (int bj = 0; bj < 2; ++bj) {
                    const f32x4 y0 = (acc[ai][bj][m][0] * 0.03125f + bv[bj][0]) * w8, y1 = (acc[ai][bj][m][1] * 0.03125f + bv[bj][1]) * w8;
                    int w0 = 0, w1 = 0;
                    w0 = __builtin_amdgcn_cvt_pk_fp8_f32(y0[0], y0[1], w0, false); w0 = __builtin_amdgcn_cvt_pk_fp8_f32(y0[2], y0[3], w0, true);
                    w1 = __builtin_amdgcn_cvt_pk_fp8_f32(y1[0], y1[1], w1, false); w1 = __builtin_amdgcn_cvt_pk_fp8_f32(y1[2], y1[3], w1, true);
                    *(u32x2*)(YE + (size_t)row * 1024 + c0 + bj * 128) = (u32x2){(unsigned)w0, (unsigned)w1};
                }
            }
    }
};

__device__ __forceinline__ void transpose_item(const float* W, int N, bf16* WT, int drow0, LAS float* scr, int k0, int n0, int lane) {
    float ld_[32];
#pragma unroll
    for (int i = 0; i < 32; ++i) { const int kk = 2 * i + (lane >> 5); ld_[i] = __builtin_nontemporal_load(W + (size_t)(k0 + kk) * N + n0 + (lane & 31)); }
#pragma unroll
    for (int i = 0; i < 32; ++i) { const int kk = 2 * i + (lane >> 5); scr[kk * 33 + (lane & 31)] = ld_[i]; }
    LDS_WAIT(); asm volatile("" ::: "memory");
    const int c = lane & 7;
#pragma unroll
    for (int j = 0; j < 4; ++j) { const int n = (lane >> 3) + 8 * j; const LAS float* s = scr + (8 * c) * 33 + n;
        u32x4 o; o.x = cvtpk(s[0 * 33], s[1 * 33]); o.y = cvtpk(s[2 * 33], s[3 * 33]); o.z = cvtpk(s[4 * 33], s[5 * 33]); o.w = cvtpk(s[6 * 33], s[7 * 33]);
        *(u32x4*)(WT + (size_t)(drow0 + n) * 1024 + k0 + 8 * c) = o; }
    LDS_WAIT(); asm volatile("" ::: "memory");
}
template <bool GLU>
__device__ __forceinline__ void transpose_item_fp8(const float* W, int N, unsigned char* W8, LAS float* scr, int k0, int n0, int lane) {
    float ld_[32];
#pragma unroll
    for (int i = 0; i < 32; ++i) { const int kk = 2 * i + (lane >> 5); ld_[i] = __builtin_nontemporal_load(W + (size_t)(k0 + kk) * N + n0 + (lane & 31)); }
#pragma unroll
    for (int i = 0; i < 32; ++i) { const int kk = 2 * i + (lane >> 5); scr[kk * 33 + (lane & 31)] = ld_[i]; }
    LDS_WAIT(); asm volatile("" ::: "memory");
    const int c = lane & 3;
#pragma unroll
    for (int j = 0; j < 2; ++j) { const int n = (lane >> 2) + 16 * j; const LAS float* s = scr + (16 * c) * 33 + n;
        int w[4];
#pragma unroll
        for (int q = 0; q < 4; ++q) { int t = 0; t = __builtin_amdgcn_cvt_pk_fp8_f32(s[(4 * q) * 33] * 32.0f, s[(4 * q + 1) * 33] * 32.0f, t, false); t = __builtin_amdgcn_cvt_pk_fp8_f32(s[(4 * q + 2) * 33] * 32.0f, s[(4 * q + 3) * 33] * 32.0f, t, true); w[q] = t; }
        const int col = n0 + n; const int p = col >> 1;
        const int drow = GLU ? ((p >> 7) * 256 + (col & 1) * 128 + (p & 127)) : col;
        *(u32x4*)(W8 + (size_t)drow * 1024 + k0 + 16 * c) = (u32x4){(unsigned)w[0], (unsigned)w[1], (unsigned)w[2], (unsigned)w[3]}; }
    LDS_WAIT(); asm volatile("" ::: "memory");
}
struct ConvItem { const float* W; unsigned char* W8; int N, k0, n0; bool glu; };
__device__ __forceinline__ ConvItem conv_decode(int it, const float* w1, const float* w2, unsigned char* W1_8, unsigned char* W2_8) {
    ConvItem c;
    if (it < 32768) { const int e = it >> 10, rr = it & 1023, nb = rr & 63, kb = rr >> 6; c.W = w1 + (size_t)e * 1024 * 2048; c.W8 = W1_8 + (size_t)e * 2048 * 1024; c.N = 2048; c.k0 = kb * 64; c.n0 = nb * 32; c.glu = true; }
    else { const int r = it - 32768, e = r >> 9, rr = r & 511, nb = rr & 31, kb = rr >> 5; c.W = w2 + (size_t)e * 1024 * 1024; c.W8 = W2_8 + (size_t)e * 1024 * 1024; c.N = 1024; c.k0 = kb * 64; c.n0 = nb * 32; c.glu = false; }
    return c;
}
__device__ __forceinline__ void conv_load(const ConvItem& c, f32x4 (&r)[8], int lane) {
    const float* base = c.W + (size_t)c.k0 * c.N + c.n0;
    const int lo = (lane >> 3) * c.N + (lane & 7) * 4;
#pragma unroll
    for (int i = 0; i < 8; ++i) r[i] = __builtin_nontemporal_load((const f32x4*)(base + (size_t)(8 * i) * c.N + lo));
}
__device__ __forceinline__ void conv_finish(const ConvItem& c, const f32x4 (&r)[8], LAS float* scr, int lane) {
#pragma unroll
    for (int i = 0; i < 8; ++i) *(LAS f32x4*)(scr + (8 * i + (lane >> 3)) * 36 + (lane & 7) * 4) = r[i];
    LDS_WAIT(); asm volatile("" ::: "memory");
    if (c.glu) {
        const int n = lane & 31, half = lane >> 5; const LAS float* s = scr + (32 * half) * 36 + n;
        float v[32];
#pragma unroll
        for (int i = 0; i < 32; ++i) v[i] = s[i * 36];
        u32x4 p0, p1; fp6_pack32(v, p0, p1);
        const int col = c.n0 + n; const int p = col >> 1;
        const int drow = (p >> 7) * 256 + (col & 1) * 128 + (p & 127);
        unsigned char* dst = c.W8 + (size_t)drow * 1024 + (c.k0 >> 7) * 128 + 16 * (((c.k0 & 127) >> 5) + half);
        *(u32x4*)dst = p0; *(u32x4*)(dst + 64) = p1;
        LDS_WAIT(); asm volatile("" ::: "memory");
        return;
    }
    const int cc = lane & 3;
#pragma unroll
    for (int j = 0; j < 2; ++j) { const int n = (lane >> 2) + 16 * j; const LAS float* s = scr + (16 * cc) * 36 + n;
        int w[4];
#pragma unroll
        for (int q = 0; q < 4; ++q) { int t = 0; t = __builtin_amdgcn_cvt_pk_fp8_f32(s[(4 * q) * 36] * 32.0f, s[(4 * q + 1) * 36] * 32.0f, t, false); t = __builtin_amdgcn_cvt_pk_fp8_f32(s[(4 * q + 2) * 36] * 32.0f, s[(4 * q + 3) * 36] * 32.0f, t, true); w[q] = t; }
        const int col = c.n0 + n; const int p = col >> 1;
        const int drow = c.glu ? ((p >> 7) * 256 + (col & 1) * 128 + (p & 127)) : col;
        *(u32x4*)(c.W8 + (size_t)drow * 1024 + c.k0 + 16 * cc) = (u32x4){(unsigned)w[0], (unsigned)w[1], (unsigned)w[2], (unsigned)w[3]}; }
    LDS_WAIT(); asm volatile("" ::: "memory");
}
__device__ __forceinline__ void convert_chunk(int chunk, const float* w1, const float* w2, unsigned char* W1_8, unsigned char* W2_8, LAS float* scr, int wave, int lane) {
    const int base = chunk * 32 + wave;
    f32x4 ra[8], rb[8];
    ConvItem ca = conv_decode(base, w1, w2, W1_8, W2_8), cb;
    conv_load(ca, ra, lane);
#pragma unroll 1
    for (int j = 0; j < 4; j += 2) {
        cb = conv_decode(base + 8 * (j + 1), w1, w2, W1_8, W2_8); conv_load(cb, rb, lane);
        conv_finish(ca, ra, scr, lane);
        if (j + 2 < 4) { ca = conv_decode(base + 8 * (j + 2), w1, w2, W1_8, W2_8); conv_load(ca, ra, lane); }
        conv_finish(cb, rb, scr, lane);
    }
}
__device__ __forceinline__ int headperm_row(int n0) { const int pn = n0 >> 8, c = n0 & 255, hh = c >> 6, dh = (c & 63) >> 5; return pn * 256 + dh * 128 + hh * 32; }
__device__ __forceinline__ void rms_row_to_bf16(const float* xrow, const float* gain, bf16* orow, int lane) {
    const f32x4* xr = (const f32x4*)xrow + lane; const f32x4* gr = (const f32x4*)gain + lane;
    f32x4 v[4]; float s = 0.f;
#pragma unroll
    for (int j = 0; j < 4; ++j) { v[j] = xr[64 * j]; s += (v[j].x * v[j].x + v[j].y * v[j].y) + (v[j].z * v[j].z + v[j].w * v[j].w); }
    const float rstd = 1.0f / sqrtf(wave_sum(s) * (1.f / DM) + EPS);
    u32x2* o8 = (u32x2*)orow + lane;
#pragma unroll
    for (int j = 0; j < 4; ++j) { const f32x4 gg = gr[64 * j]; u32x2 w; w.x = cvtpk(v[j].x * rstd * gg.x, v[j].y * rstd * gg.y); w.y = cvtpk(v[j].z * rstd * gg.z, v[j].w * rstd * gg.w); o8[64 * j] = w; }
}

__device__ __forceinline__ void rms_row2_to_bf16(const float* xrow, const float* gain, bf16* orow, int lane, float* irs) {
    const f32x4* xr = (const f32x4*)xrow + lane; const f32x4* gr = (const f32x4*)gain + lane;
    f32x4 v[8]; float s0 = 0.f, s1 = 0.f;
#pragma unroll
    for (int j = 0; j < 8; ++j) v[j] = __builtin_nontemporal_load(xr + 64 * j);
#pragma unroll
    for (int j = 0; j < 4; ++j) { s0 += (v[j].x * v[j].x + v[j].y * v[j].y) + (v[j].z * v[j].z + v[j].w * v[j].w); s1 += (v[4 + j].x * v[4 + j].x + v[4 + j].y * v[4 + j].y) + (v[4 + j].z * v[4 + j].z + v[4 + j].w * v[4 + j].w); }
    const float q0 = sqrtf(wave_sum(s0) * (1.f / DM) + EPS), q1 = sqrtf(wave_sum(s1) * (1.f / DM) + EPS); const float r0 = 1.0f / q0, r1 = 1.0f / q1;
    if (irs != nullptr && lane == 0) { irs[0] = q0; irs[1] = q1; }
    u32x2* o8 = (u32x2*)orow + lane;
#pragma unroll
    for (int j = 0; j < 4; ++j) { const f32x4 gg = gr[64 * j]; u32x2 w; w.x = cvtpk(v[j].x * r0 * gg.x, v[j].y * r0 * gg.y); w.y = cvtpk(v[j].z * r0 * gg.z, v[j].w * r0 * gg.w); o8[64 * j] = w;
        u32x2 w2; w2.x = cvtpk(v[4 + j].x * r1 * gg.x, v[4 + j].y * r1 * gg.y); w2.y = cvtpk(v[4 + j].z * r1 * gg.z, v[4 + j].w * r1 * gg.w); o8[256 + 64 * j] = w2; }
}

#include <hip/hip_bf16.h>
namespace attn_body {
using s16x4=__attribute__((ext_vector_type(4)))short;
using f32x16=__attribute__((ext_vector_type(16)))float;
constexpr int D=64,NW=8,QBLK=32,QB=QBLK*NW,KVBLK=64;
__device__ __forceinline__ int crow(int r,int hi){return (r&3)+8*(r>>2)+4*hi;}
#define SBAR() __builtin_amdgcn_sched_barrier(0)
__device__ __forceinline__ void cmask(f32x16&p0,f32x16&p1,int jb,int qrel,int hi){
  const float NEG=-INFINITY; int kb=64*jb+4*hi;
  #pragma unroll
  for(int r=0;r<16;++r){int kv=kb+(r&3)+8*(r>>2); if(kv>qrel)p0[r]=NEG; if(kv+32>qrel)p1[r]=NEG;}
}
constexpr int NSLOT=3, SLOTB=8192;
constexpr int LDS_K=0, LDS_V=NSLOT*SLOTB, LDS_WS=2*NSLOT*SLOTB, LDS_OST=LDS_WS+NW*64*4, ATT_LDS_BYTES=LDS_OST+NW*4096;
__device__ __forceinline__ void glds16(const void*gsrc,unsigned lds_dst){unsigned keep;
  asm volatile("s_mov_b32 %0, m0\n\ts_mov_b32 m0, %2\n\ts_nop 0\n\tglobal_load_lds_dwordx4 %1, off\n\ts_mov_b32 m0, %0":"=&s"(keep):"v"(gsrc),"s"(lds_dst):"memory");}
__device__ __forceinline__ float max3f(float a,float b,float c){float r;asm("v_max3_f32 %0, %1, %2, %3":"=v"(r):"v"(a),"v"(b),"v"(c));return r;}
__device__ __forceinline__ float max2f(float a,float b){float r;asm("v_max_f32_e32 %0, %1, %2":"=v"(r):"v"(a),"v"(b));return r;}
__device__ __forceinline__ float fadd_s(float a,float b){float r;asm("v_add_f32_e32 %0, %1, %2":"=v"(r):"v"(a),"v"(b));return r;}
__device__ __forceinline__ float fsub_s(float a,float b){float r;asm("v_sub_f32_e32 %0, %1, %2":"=v"(r):"v"(a),"v"(b));return r;}
__device__ __forceinline__ unsigned cvtpk_s(float lo,float hi){return cvtpk(lo,hi);}
#define WAIT_BAR(N) asm volatile("s_waitcnt vmcnt(" #N ") lgkmcnt(0)\n\ts_barrier":::"memory")
__device__ __forceinline__ void qkt(f32x16&p0,f32x16&p1,const char*Kslot,const bf16x8*qr,const f32x16&negm,int r32,int hi){
  const char*kb=Kslot+hi*1024+r32*16;
  #pragma unroll
  for(int d0=0;d0<4;++d0){
    const bf16x8 b0=*reinterpret_cast<const bf16x8*>(kb+d0*2048);
    const bf16x8 b1=*reinterpret_cast<const bf16x8*>(kb+d0*2048+512);
    if(d0==0){p0=__builtin_amdgcn_mfma_f32_32x32x16_bf16(b0,qr[0],negm,0,0,0);p1=__builtin_amdgcn_mfma_f32_32x32x16_bf16(b1,qr[0],negm,0,0,0);}
    else{p0=__builtin_amdgcn_mfma_f32_32x32x16_bf16(b0,qr[d0],p0,0,0,0);p1=__builtin_amdgcn_mfma_f32_32x32x16_bf16(b1,qr[d0],p1,0,0,0);}}
}
typedef __attribute__((address_space(3))) const char* lds_cptr;
typedef short v4i16_t __attribute__((ext_vector_type(4)));
__device__ __forceinline__ void kload8(bf16x8*kf,lds_cptr kp){
  kf[0]=*(const __attribute__((address_space(3))) bf16x8*)(kp);      kf[1]=*(const __attribute__((address_space(3))) bf16x8*)(kp+512);
  kf[2]=*(const __attribute__((address_space(3))) bf16x8*)(kp+2048); kf[3]=*(const __attribute__((address_space(3))) bf16x8*)(kp+2560);
  kf[4]=*(const __attribute__((address_space(3))) bf16x8*)(kp+4096); kf[5]=*(const __attribute__((address_space(3))) bf16x8*)(kp+4608);
  kf[6]=*(const __attribute__((address_space(3))) bf16x8*)(kp+6144); kf[7]=*(const __attribute__((address_space(3))) bf16x8*)(kp+6656);
}
__device__ __forceinline__ void kload2(bf16x8*kf,lds_cptr kp,int j){ kf[2*j]=*(const __attribute__((address_space(3))) bf16x8*)(kp+j*2048); kf[2*j+1]=*(const __attribute__((address_space(3))) bf16x8*)(kp+j*2048+512); }
__device__ __forceinline__ s16x4 vtr(lds_cptr p){ return __builtin_bit_cast(s16x4,__builtin_amdgcn_ds_read_tr16_b64_v4i16((__attribute__((address_space(3))) v4i16_t*)p)); }
__device__ __forceinline__ float rowmax(const f32x16&p0,const f32x16&p1){
  float a=max3f(p0[0],p0[1],p1[0]),b=max3f(p0[2],p0[3],p1[1]);a=max3f(a,p1[2],p1[3]);
  #pragma unroll
  for(int r=4;r<16;r+=4){a=max3f(a,p0[r],p0[r+1]);b=max3f(b,p0[r+2],p0[r+3]);a=max3f(a,p1[r],p1[r+1]);b=max3f(b,p1[r+2],p1[r+3]);}
  const float m=max2f(a,b);
  auto rr=__builtin_amdgcn_permlane32_swap(__float_as_uint(m),__float_as_uint(m),false,false);
  return max2f(__uint_as_float(rr[0]),__uint_as_float(rr[1]));
}
__device__ __forceinline__ void pv(f32x16*o,int vb,bf16x8 pa0,bf16x8 pa1,bf16x8 pa2,bf16x8 pa3){
  #pragma unroll
  for(int d0=0;d0<2;++d0){s16x4 lo[4],hi[4];
    #pragma unroll
    for(int ks=0;ks<4;++ks){
      asm volatile("ds_read_b64_tr_b16 %0,%1 offset:%c2":"=&v"(lo[ks]):"v"(vb),"i"(d0*4096+ks*1024):"memory");
      asm volatile("ds_read_b64_tr_b16 %0,%1 offset:%c2":"=&v"(hi[ks]):"v"(vb),"i"(d0*4096+ks*1024+512):"memory");}
    asm volatile("s_waitcnt lgkmcnt(0)":::"memory");SBAR();
    #define PK(k) (bf16x8){lo[k][0],lo[k][1],lo[k][2],lo[k][3],hi[k][0],hi[k][1],hi[k][2],hi[k][3]}
    o[d0]=__builtin_amdgcn_mfma_f32_32x32x16_bf16(pa0,PK(0),o[d0],0,0,0);
    o[d0]=__builtin_amdgcn_mfma_f32_32x32x16_bf16(pa1,PK(1),o[d0],0,0,0);
    o[d0]=__builtin_amdgcn_mfma_f32_32x32x16_bf16(pa2,PK(2),o[d0],0,0,0);
    o[d0]=__builtin_amdgcn_mfma_f32_32x32x16_bf16(pa3,PK(3),o[d0],0,0,0);
    #undef PK
  }
}
template<int THRL,int KP,int OP,bool MOBA> __device__ __forceinline__ void attn_unit(const bf16*Qu,const bf16*__restrict__ Kh,const bf16*__restrict__ Vh,bf16*Ou,const int NT,const int nblk,const float*kmean,char*shm){
  const int tid=opaque((int)threadIdx.x),lane=tid&63,r32=lane&31,hi=lane>>5; const int wid=__builtin_amdgcn_readfirstlane(tid>>6);
  const bf16*Qw=Qu+(long)(wid*QBLK)*KP;
  const unsigned lds0=(unsigned)(uintptr_t)shm;
  float*wsf=(float*)(shm+LDS_WS)+wid*64;
  const bf16*ksrc=Kh+(long)lane*KP+wid*8;
  const bf16*vsrc=Vh+(long)(16*(wid&3)+(lane>>2))*KP+(wid>>2)*32+(lane&3)*8;
  const unsigned kdst=lds0+LDS_K+wid*1024, vdst=lds0+LDS_V+wid*1024;
  #define DMA_K(t,slot) glds16(ksrc+(long)(t)*KVBLK*KP,(unsigned)__builtin_amdgcn_readfirstlane(kdst+(slot)))
  #define DMA_V(t,slot) glds16(vsrc+(long)(t)*KVBLK*KP,(unsigned)__builtin_amdgcn_readfirstlane(vdst+(slot)))
  const int vb0=(int)(lds0+LDS_V)+((lane>>4)&1)*32+(lane&3)*8+(4*hi+((lane&15)>>2))*64;
  const char*Kbase=shm+LDS_K; bf16x8 kf[8];
  const lds_cptr shm3=(lds_cptr)shm; const lds_cptr kp0=shm3+LDS_K+hi*1024+r32*16; const lds_cptr vp0=shm3+LDS_V+((lane>>4)&1)*32+(lane&3)*8+(4*hi+((lane&15)>>2))*64;
  if(MOBA){ if(wid<4) glds16(kmean+(long)(4*wid+(lane>>4))*512+(lane&15)*4,(unsigned)__builtin_amdgcn_readfirstlane(lds0+ATT_LDS_BYTES+wid*1024)); }
  DMA_K(0,0);DMA_V(0,0);DMA_K(1,SLOTB);
  bf16x8 qr[4];
  #pragma unroll
  for(int d0=0;d0<4;++d0)qr[d0]=*reinterpret_cast<const bf16x8*>(&Qw[(long)r32*KP+d0*16+hi*8]);
  unsigned bmask=0xffffffffu;
  if(MOBA){
    bmask=1u<<nblk;
    float g0=-3e38f,g1=-3e38f,g2=-3e38f; int i0=-1,i1=-1,i2=-1;
    asm volatile("s_waitcnt vmcnt(0)\n\ts_barrier":::"memory");
    const __attribute__((address_space(3))) float*kml=(const __attribute__((address_space(3))) float*)(shm3+ATT_LDS_BYTES)+8*hi;
    for(int j=0;j<nblk;++j){
      const __attribute__((address_space(3))) float*km=kml+j*64; float g=0.f;
      #pragma unroll
      for(int d0=0;d0<4;++d0){ const f32x4 a=*(const __attribute__((address_space(3))) f32x4*)(km+16*d0),b=*(const __attribute__((address_space(3))) f32x4*)(km+16*d0+4);
        g+=bf2f((unsigned short)qr[d0][0])*a[0]+bf2f((unsigned short)qr[d0][1])*a[1]+bf2f((unsigned short)qr[d0][2])*a[2]+bf2f((unsigned short)qr[d0][3])*a[3];
        g+=bf2f((unsigned short)qr[d0][4])*b[0]+bf2f((unsigned short)qr[d0][5])*b[1]+bf2f((unsigned short)qr[d0][6])*b[2]+bf2f((unsigned short)qr[d0][7])*b[3]; }
      g+=__shfl_xor(g,32);
      if(g>g0){g2=g1;i2=i1;g1=g0;i1=i0;g0=g;i0=j;} else if(g>g1){g2=g1;i2=i1;g1=g;i1=j;} else if(g>g2){g2=g;i2=j;}
    }
    if(i0>=0)bmask|=1u<<i0; if(i1>=0)bmask|=1u<<i1; if(i2>=0)bmask|=1u<<i2;
  }
  #define NEGM_FOR(t) (MOBA ? (((bmask>>((t)>>2))&1u) ? -mhat : -INFINITY) : -mhat)
  float mhat=0.f,l_reg=0.f;f32x16 o[2];o[0]=f32x16{};o[1]=f32x16{};f32x16 negm;
  { const float nm=NEGM_FOR(0);
    #pragma unroll
    for(int r=0;r<16;++r)negm[r]=nm; }
  asm volatile("":"+v"(negm));
  const int qrel=wid*QBLK+r32;
  #define CMASK(P0,P1,t) do{ if(MOBA){int jb_=(t)-(NT-4); if(jb_>=0)cmask(P0,P1,jb_,qrel,hi);} }while(0)
  bool resc=false;
  #define START(P0,P1) do{ const float rm=rowmax(P0,P1); resc=false; \
    { const float dl=(MOBA&&rm==-INFINITY)?0.f:rm; mhat=fadd_s(mhat,dl); \
      _Pragma("unroll") for(int r=0;r<16;++r){P0[r]=fsub_s(P0[r],dl);P1[r]=fsub_s(P1[r],dl);} \
      { const float nm=NEGM_FOR(1); _Pragma("unroll") for(int r=0;r<16;++r)negm[r]=nm; } asm volatile("":"+v"(negm)); } \
    _Pragma("unroll") for(int r=0;r<16;++r)P0[r]=__builtin_amdgcn_exp2f(P0[r]); }while(0)
  #define RESC() do{ if(resc){ asm volatile("s_waitcnt lgkmcnt(0)":::"memory"); \
      _Pragma("unroll") for(int d_=0;d_<2;++d_) _Pragma("unroll") for(int r=0;r<16;++r)o[d_][r]*=wsf[crow(r,hi)]; } }while(0)
  f32x16 pA0,pA1,pB0,pB1;
  int sl_prev=0,sl_cur=0,sl_next=SLOTB;
  #define ROT() do{sl_prev=sl_cur;sl_cur=sl_next;sl_next=(sl_next==(NSLOT-1)*SLOTB)?0:sl_next+SLOTB;}while(0)
  DMA_K(2,2*SLOTB);
  WAIT_BAR(3);
  qkt(pA0,pA1,Kbase,qr,negm,r32,hi);asm volatile("s_nop 15\n\ts_nop 7":"+v"(pA0),"+v"(pA1));CMASK(pA0,pA1,0);
  START(pA0,pA1);
  _Pragma("unroll") for(int r=0;r<16;++r)pA1[r]=__builtin_amdgcn_exp2f(pA1[r]);
  WAIT_BAR(0);
  DMA_K(3,0);DMA_V(1,SLOTB);
  ROT();
  kload8(kf,kp0+sl_cur);
  WAIT_BAR(2);
  s16x4 vlo[8],vhi[8]; u32x4 pw0,pw1,pw2,pw3;
  #define PKW(P,B) cvtpk_s(P[B],P[B+1])
  #define PAF(k) __builtin_bit_cast(bf16x8,pw##k)
  #define VFR(i) (bf16x8){vlo[i][0],vlo[i][1],vlo[i][2],vlo[i][3],vhi[i][0],vhi[i][1],vhi[i][2],vhi[i][3]}
  #define PIN(x) asm volatile("":"+v"(x))
  #define MX3(a,b,c) __builtin_fmaxf(__builtin_fmaxf((a),(b)),(c))
  #define GAPA(MF,A0,A1,A2,A3,W0,W1,PW) do{ MF; sacc+=A0; sacc+=A1; sacc+=A2; sacc+=A3; PIN(sacc); W0; W1; PIN(PW); SBAR(); }while(0)
  #define EX(v) __builtin_amdgcn_exp2f(v)
  #define GAPB(MF,X,B) do{ MF; X[B]=EX(X[B]); X[B+1]=EX(X[B+1]); X[B+2]=EX(X[B+2]); X[B+3]=EX(X[B+3]); PIN(X); SBAR(); }while(0)
  #define VRD(i) do{ vlo[i]=vtr(vp_+(((i)>>2)*4096+((i)&3)*1024)); vhi[i]=vtr(vp_+(((i)>>2)*4096+((i)&3)*1024+512)); }while(0)
  #define KRD(G,j) do{ if(G){ kload2(kf,kp0+sl_next,j); SBAR(); } }while(0)
  #define STEP(C0,C1,P0,P1,t,GK,GV,GL) do{ SBAR(); \
    const lds_cptr vp_=vp0+sl_prev; \
    VRD(0); SBAR(); float sacc=(P0[0]+P0[1]); \
    GAPA(C0=__builtin_amdgcn_mfma_f32_32x32x16_bf16(kf[0],qr[0],negm,0,0,0), P0[2],P0[3],P0[4],P0[5],     pw0[0]=PKW(P0,0), pw0[1]=PKW(P0,2), pw0); \
    VRD(4); SBAR(); GAPA(C1=__builtin_amdgcn_mfma_f32_32x32x16_bf16(kf[1],qr[0],negm,0,0,0), P0[6],P0[7],P0[8],P0[9],     pw0[2]=PKW(P0,4), pw0[3]=PKW(P0,6), pw0); \
    VRD(1); SBAR(); GAPA(C0=__builtin_amdgcn_mfma_f32_32x32x16_bf16(kf[2],qr[1],C0,0,0,0),   P0[10],P0[11],P0[12],P0[13], pw1[0]=PKW(P0,8), pw1[1]=PKW(P0,10), pw1); \
    VRD(5); SBAR(); GAPA(C1=__builtin_amdgcn_mfma_f32_32x32x16_bf16(kf[3],qr[1],C1,0,0,0),   P0[14],P0[15],P1[0],P1[1],   pw1[2]=PKW(P0,12),pw1[3]=PKW(P0,14), pw1); \
    VRD(2); SBAR(); GAPA(C0=__builtin_amdgcn_mfma_f32_32x32x16_bf16(kf[4],qr[2],C0,0,0,0),   P1[2],P1[3],P1[4],P1[5],     pw2[0]=PKW(P1,0), pw2[1]=PKW(P1,2), pw2); \
    VRD(6); SBAR(); GAPA(C1=__builtin_amdgcn_mfma_f32_32x32x16_bf16(kf[5],qr[2],C1,0,0,0),   P1[6],P1[7],P1[8],P1[9],     pw2[2]=PKW(P1,4), pw2[3]=PKW(P1,6), pw2); \
    VRD(3); SBAR(); GAPA(C0=__builtin_amdgcn_mfma_f32_32x32x16_bf16(kf[6],qr[3],C0,0,0,0),   P1[10],P1[11],P1[12],P1[13], pw3[0]=PKW(P1,8), pw3[1]=PKW(P1,10), pw3); \
    VRD(7); SBAR(); GAPA(C1=__builtin_amdgcn_mfma_f32_32x32x16_bf16(kf[7],qr[3],C1,0,0,0),   P1[14],P1[15],0.f,0.f,       pw3[2]=PKW(P1,12),pw3[3]=PKW(P1,14), pw3); \
    l_reg+=sacc; \
    if(GK){DMA_K((t)+3,sl_cur);} if(GV){DMA_V((t)+1,sl_next);} \
    CMASK(C0,C1,t); \
    { float a=MX3(C0[0],C0[1],C1[0]),b=MX3(C0[2],C0[3],C1[1]); a=MX3(a,C1[2],C1[3]); \
      _Pragma("unroll") for(int r=4;r<16;r+=4){a=MX3(a,C0[r],C0[r+1]);b=MX3(b,C0[r+2],C0[r+3]);a=MX3(a,C1[r],C1[r+1]);b=MX3(b,C1[r+2],C1[r+3]);} \
      float rm=__builtin_fmaxf(a,b); { auto rr=__builtin_amdgcn_permlane32_swap(__float_as_uint(rm),__float_as_uint(rm),false,false); rm=__builtin_fmaxf(__uint_as_float(rr[0]),__uint_as_float(rr[1])); } \
      resc=false; \
      if(__builtin_expect(__any(rm>(float)THRL),0)){ const float dl=__builtin_fmaxf(rm,0.f); mhat+=dl; \
        _Pragma("unroll") for(int r=0;r<16;++r){C0[r]-=dl;C1[r]-=dl;} \
        if(!MOBA){ _Pragma("unroll") for(int r=0;r<16;++r)negm[r]=-mhat; asm volatile("":"+v"(negm)); } \
        const float f=__builtin_amdgcn_exp2f(-dl); l_reg*=f; if(hi==0)wsf[r32]=f; resc=true; } \
      if(MOBA){ if(resc||((((t)+1)&3)==0)){ const float nm=NEGM_FOR((t)+1); _Pragma("unroll") for(int r=0;r<16;++r)negm[r]=nm; asm volatile("":"+v"(negm)); } } } \
    SBAR(); \
    GAPB(o[0]=__builtin_amdgcn_mfma_f32_32x32x16_bf16(PAF(0),VFR(0),o[0],0,0,0), C0,0); \
    GAPB(o[1]=__builtin_amdgcn_mfma_f32_32x32x16_bf16(PAF(0),VFR(4),o[1],0,0,0), C0,4); \
    KRD(GL,0); GAPB(o[0]=__builtin_amdgcn_mfma_f32_32x32x16_bf16(PAF(1),VFR(1),o[0],0,0,0), C0,8); \
    KRD(GL,1); GAPB(o[1]=__builtin_amdgcn_mfma_f32_32x32x16_bf16(PAF(1),VFR(5),o[1],0,0,0), C0,12); \
    KRD(GL,2); GAPB(o[0]=__builtin_amdgcn_mfma_f32_32x32x16_bf16(PAF(2),VFR(2),o[0],0,0,0), C1,0); \
    KRD(GL,3); GAPB(o[1]=__builtin_amdgcn_mfma_f32_32x32x16_bf16(PAF(2),VFR(6),o[1],0,0,0), C1,4); \
    GAPB(o[0]=__builtin_amdgcn_mfma_f32_32x32x16_bf16(PAF(3),VFR(3),o[0],0,0,0), C1,8); \
    GAPB(o[1]=__builtin_amdgcn_mfma_f32_32x32x16_bf16(PAF(3),VFR(7),o[1],0,0,0), C1,12); \
    }while(0)
  int t=1;
  #undef CMASK
  #define CMASK(P0,P1,t) do{}while(0)
  for(;t+5<NT;t+=2){
    STEP(pB0,pB1,pA0,pA1,t,true,true,true);     WAIT_BAR(2); RESC(); ROT();
    STEP(pA0,pA1,pB0,pB1,t+1,true,true,true);   WAIT_BAR(2); RESC(); ROT();
  }
  #undef CMASK
  #define CMASK(P0,P1,t) do{ if(MOBA){int jb_=(t)-(NT-4); if(jb_>=0)cmask(P0,P1,jb_,qrel,hi);} }while(0)
  #define ENDW(tt) do{ if((tt)+3<NT){WAIT_BAR(2);} else if((tt)+2<NT){WAIT_BAR(1);} else {WAIT_BAR(0);} }while(0)
  for(;t+1<NT;t+=2){
    STEP(pB0,pB1,pA0,pA1,t,(t+3<NT),(t+1<NT),(t+1<NT));       ENDW(t);   RESC(); ROT();
    STEP(pA0,pA1,pB0,pB1,t+1,(t+4<NT),(t+2<NT),(t+2<NT));     ENDW(t+1); RESC(); ROT();
  }
  STEP(pB0,pB1,pA0,pA1,NT-1,false,false,false); RESC();
  { float sacc=pB0[0]+pB0[1]; _Pragma("unroll") for(int r=2;r<16;++r)sacc+=pB0[r]; _Pragma("unroll") for(int r=0;r<16;++r)sacc+=pB1[r]; l_reg+=sacc;
    pw0=(u32x4){PKW(pB0,0),PKW(pB0,2),PKW(pB0,4),PKW(pB0,6)};pw1=(u32x4){PKW(pB0,8),PKW(pB0,10),PKW(pB0,12),PKW(pB0,14)};pw2=(u32x4){PKW(pB1,0),PKW(pB1,2),PKW(pB1,4),PKW(pB1,6)};pw3=(u32x4){PKW(pB1,8),PKW(pB1,10),PKW(pB1,12),PKW(pB1,14)};
    SBAR(); pv(o,vb0+sl_cur,PAF(0),PAF(1),PAF(2),PAF(3)); }
  #undef PKW
  #undef PAF
  #undef VFR
  #undef PIN
  #undef MX3
  #undef GAPA
  #undef GAPB
  #undef EX
  #undef VRD
  #undef KRD
  #undef STEP
  #undef ENDW
  {auto rr=__builtin_amdgcn_permlane32_swap(__float_as_uint(l_reg),__float_as_uint(l_reg),false,false);l_reg=__uint_as_float(rr[0])+__uint_as_float(rr[1]);}
  if(hi==0)wsf[32+r32]=l_reg;asm volatile("s_waitcnt lgkmcnt(0)":::"memory");
  float rli[16];
  #pragma unroll
  for(int r=0;r<16;++r)rli[r]=__builtin_amdgcn_rcpf(wsf[32+crow(r,hi)]);
  bf16*Ow=Ou+(long)(wid*QBLK)*OP;
  { bf16*stg=(bf16*)(shm+LDS_OST)+wid*2048;
    #pragma unroll
    for(int r=0;r<16;++r){const int orow=crow(r,hi);
      #pragma unroll
      for(int d0=0;d0<2;++d0)stg[orow*64+d0*32+r32]=(bf16)(cvtpk(o[d0][r]*rli[r],0.f)&0xffffu);}
    asm volatile("s_waitcnt lgkmcnt(0)":::"memory");
    #pragma unroll
    for(int i=0;i<4;++i){const int row=i*8+(lane>>3),ch=lane&7; const u32x4 v=*(const u32x4*)(stg+row*64+ch*8); *(u32x4*)(Ow+(long)row*OP+ch*8)=v;} }
  asm volatile("s_waitcnt lgkmcnt(0)\n\ts_barrier":::"memory");
  #undef DMA_K
  #undef DMA_V
  #undef CMASK
  #undef START
  #undef RESC
  #undef ROT
  #undef NEGM_FOR
}
#undef SBAR
#undef WAIT_BAR
}

namespace ret_body {
using attn_body::s16x4; using attn_body::f32x16; using attn_body::glds16; using attn_body::pv; using attn_body::crow;
constexpr int KVF_BYTES = 64 * 64 * 4;
__device__ __forceinline__ void kv_unit(const bf16* KR, const bf16* VR, float* KVF, int b, int h, int cp, char* shm) {
  const int tid = opaque((int)threadIdx.x), lane = tid & 63, r32 = lane & 31, hi = lane >> 5; const int wid = __builtin_amdgcn_readfirstlane(tid >> 6);
  const unsigned lds0 = (unsigned)(uintptr_t)shm;
  const size_t rowb = (size_t)b * SEQ + (size_t)cp * 256;
  const long voff = (long)(16 * (wid & 3) + (lane >> 2)) * 256 + h * 64 + (wid >> 2) * 32 + (lane & 3) * 8;
#pragma unroll
  for (int c = 0; c < 2; ++c)
#pragma unroll
    for (int tl = 0; tl < 2; ++tl) {
      const size_t r0 = rowb + c * 128 + tl * 64;
      glds16(KR + r0 * 256 + voff, (unsigned)__builtin_amdgcn_readfirstlane(lds0 + ((c * 2 + 0) * 2 + tl) * 8192 + wid * 1024));
      glds16(VR + r0 * 256 + voff, (unsigned)__builtin_amdgcn_readfirstlane(lds0 + ((c * 2 + 1) * 2 + tl) * 8192 + wid * 1024));
    }
  asm volatile("s_waitcnt vmcnt(0) lgkmcnt(0)\n\ts_barrier" ::: "memory");
  const int c = wid >> 2, dkb = (wid >> 1) & 1, dvb = wid & 1;
  const int vb = (int)lds0 + ((lane >> 4) & 1) * 32 + (lane & 3) * 8 + (4 * hi + ((lane & 15) >> 2)) * 64;
  f32x16 acc = f32x16{};
#pragma unroll
  for (int tl = 0; tl < 2; ++tl) {
    s16x4 alo[4], ahi[4], blo[4], bhi[4];
    const int ka = vb + ((c * 2 + 0) * 2 + tl) * 8192 + dkb * 4096, va = vb + ((c * 2 + 1) * 2 + tl) * 8192 + dvb * 4096;
#pragma unroll
    for (int ks = 0; ks < 4; ++ks) {
      asm volatile("ds_read_b64_tr_b16 %0,%1 offset:%c2" : "=&v"(alo[ks]) : "v"(ka), "i"(ks * 1024) : "memory");
      asm volatile("ds_read_b64_tr_b16 %0,%1 offset:%c2" : "=&v"(ahi[ks]) : "v"(ka), "i"(ks * 1024 + 512) : "memory");
      asm volatile("ds_read_b64_tr_b16 %0,%1 offset:%c2" : "=&v"(blo[ks]) : "v"(va), "i"(ks * 1024) : "memory");
      asm volatile("ds_read_b64_tr_b16 %0,%1 offset:%c2" : "=&v"(bhi[ks]) : "v"(va), "i"(ks * 1024 + 512) : "memory");
    }
    asm volatile("s_waitcnt lgkmcnt(0)" ::: "memory"); __builtin_amdgcn_sched_barrier(0);
#pragma unroll
    for (int ks = 0; ks < 4; ++ks) {
      const bf16x8 af = (bf16x8){alo[ks][0], alo[ks][1], alo[ks][2], alo[ks][3], ahi[ks][0], ahi[ks][1], ahi[ks][2], ahi[ks][3]};
      const bf16x8 bfr = (bf16x8){blo[ks][0], blo[ks][1], blo[ks][2], blo[ks][3], bhi[ks][0], bhi[ks][1], bhi[ks][2], bhi[ks][3]};
      acc = __builtin_amdgcn_mfma_f32_32x32x16_bf16(af, bfr, acc, 0, 0, 0);
    }
  }
  const float lgam = __builtin_amdgcn_logf(1.0f - __builtin_amdgcn_exp2f(-5.0f - (float)h));
  const float g127 = __builtin_amdgcn_exp2f(lgam * 127.0f);
  float* outp = KVF + ((size_t)((b * 4 + h) * 32 + cp * 2 + c)) * 4096 + dvb * 32 + r32;
#pragma unroll
  for (int r = 0; r < 16; ++r) outp[(size_t)(dkb * 32 + crow(r, hi)) * 64] = acc[r] * g127;
  asm volatile("s_waitcnt lgkmcnt(0)\n\ts_barrier" ::: "memory");
}

__device__ __forceinline__ void out_unit(const bf16* QR, const bf16* KR, const bf16* VR, const bf16* GR, const float* KVF, const float* rgain, bf16* Y, int b, int h, int cp, char* shm) {
  const int tid = opaque((int)threadIdx.x), lane = tid & 63, r32 = lane & 31, hi = lane >> 5; const int wid = __builtin_amdgcn_readfirstlane(tid >> 6);
  const unsigned lds0 = (unsigned)(uintptr_t)shm;
  constexpr int L_K = 0, L_V = 32768, L_S = 65536, L_O = 81920;
  const size_t rowb = (size_t)b * SEQ + (size_t)cp * 256;
  const long koff = (long)lane * 256 + h * 64 + wid * 8;
  const long voff = (long)(16 * (wid & 3) + (lane >> 2)) * 256 + h * 64 + (wid >> 2) * 32 + (lane & 3) * 8;
#pragma unroll
  for (int tl = 0; tl < 4; ++tl) {
    const size_t r0 = rowb + tl * 64;
    glds16(KR + r0 * 256 + koff, (unsigned)__builtin_amdgcn_readfirstlane(lds0 + L_K + tl * 8192 + wid * 1024));
    glds16(VR + r0 * 256 + voff, (unsigned)__builtin_amdgcn_readfirstlane(lds0 + L_V + tl * 8192 + wid * 1024));
  }
  const int c = wid >> 2, wq = wid & 3;
  const bf16* Qw = QR + (rowb + c * 128 + wq * 32 + r32) * 256 + h * 64;
  bf16x8 qr[4]; u32x4 qa[4];
#pragma unroll
  for (int d0 = 0; d0 < 4; ++d0) qr[d0] = *reinterpret_cast<const bf16x8*>(Qw + d0 * 16 + hi * 8);
#pragma unroll
  for (int k = 0; k < 4; ++k) { const u32x2 lo = *(const u32x2*)(Qw + 16 * k + 4 * hi), hi2 = *(const u32x2*)(Qw + 16 * k + 8 + 4 * hi); qa[k] = (u32x4){lo.x, lo.y, hi2.x, hi2.y}; }
  {
    const float lgam = __builtin_amdgcn_logf(1.0f - __builtin_amdgcn_exp2f(-5.0f - (float)h));
    const float lgc = lgam * 128.0f;
    const int n0 = 2 * cp;
    int mlo = n0 - 1 - (int)(34.0f / (-lgc)); if (mlo < 0) mlo = 0;
    const float* kvp = KVF + ((size_t)((b * 4 + h) * 32)) * 4096 + tid * 8;
    const f32x4 an0 = *(const f32x4*)(kvp + (size_t)n0 * 4096), cn0 = *(const f32x4*)(kvp + (size_t)n0 * 4096 + 4);
    f32x4 s0 = {0.f, 0.f, 0.f, 0.f}, s1 = {0.f, 0.f, 0.f, 0.f};
    int m = mlo;
    for (; m + 8 <= n0; m += 8) {
      f32x4 a[8], c4[8];
#pragma unroll
      for (int q = 0; q < 8; ++q) { a[q] = *(const f32x4*)(kvp + (size_t)(m + q) * 4096); c4[q] = *(const f32x4*)(kvp + (size_t)(m + q) * 4096 + 4); }
#pragma unroll
      for (int q = 0; q < 8; ++q) { const float w = __builtin_amdgcn_exp2f(lgc * (float)(n0 - 1 - m - q)); s0 += a[q] * w; s1 += c4[q] * w; }
    }
    for (; m + 4 <= n0; m += 4) {
      f32x4 a[4], c4[4];
#pragma unroll
      for (int q = 0; q < 4; ++q) { a[q] = *(const f32x4*)(kvp + (size_t)(m + q) * 4096); c4[q] = *(const f32x4*)(kvp + (size_t)(m + q) * 4096 + 4); }
#pragma unroll
      for (int q = 0; q < 4; ++q) { const float w = __builtin_amdgcn_exp2f(lgc * (float)(n0 - 1 - m - q)); s0 += a[q] * w; s1 += c4[q] * w; }
    }
    for (; m < n0; ++m) {
      const float w = __builtin_amdgcn_exp2f(lgc * (float)(n0 - 1 - m));
      const f32x4 a = *(const f32x4*)(kvp + (size_t)m * 4096), c4 = *(const f32x4*)(kvp + (size_t)m * 4096 + 4);
      s0 += a * w; s1 += c4 * w;
    }
    const int dk = tid >> 3, dv = 8 * (tid & 7);
    char* sp = shm + L_S + (dv >> 5) * 4096 + dk * 64 + (dv & 31) * 2;
    u32x4 w0; w0.x = cvtpk(s0[0], s0[1]); w0.y = cvtpk(s0[2], s0[3]); w0.z = cvtpk(s1[0], s1[1]); w0.w = cvtpk(s1[2], s1[3]);
    *(u32x4*)sp = w0;
    const float dc = __builtin_amdgcn_exp2f(lgc);
    s0 = s0 * dc + an0; s1 = s1 * dc + cn0;
    u32x4 w1; w1.x = cvtpk(s0[0], s0[1]); w1.y = cvtpk(s0[2], s0[3]); w1.z = cvtpk(s1[0], s1[1]); w1.w = cvtpk(s1[2], s1[3]);
    *(u32x4*)(sp + 8192) = w1;
  }
  asm volatile("s_waitcnt vmcnt(0) lgkmcnt(0)\n\ts_barrier" ::: "memory");
  const int vb = (int)lds0 + ((lane >> 4) & 1) * 32 + (lane & 3) * 8 + (4 * hi + ((lane & 15) >> 2)) * 64;
  f32x16 o[2]; o[0] = f32x16{}; o[1] = f32x16{};
  pv(o, vb + L_S + c * 8192, __builtin_bit_cast(bf16x8, qa[0]), __builtin_bit_cast(bf16x8, qa[1]), __builtin_bit_cast(bf16x8, qa[2]), __builtin_bit_cast(bf16x8, qa[3]));
  { const float gam = 1.0f - __builtin_amdgcn_exp2f(-5.0f - (float)h);
#pragma unroll
    for (int d0 = 0; d0 < 2; ++d0)
#pragma unroll
      for (int r = 0; r < 16; ++r) o[d0][r] *= gam; }
  const f32x16 zero = f32x16{};
  const int irow = wq * 32 + r32;
  for (int tl = 0; tl <= (wq >> 1); ++tl) {
    f32x16 p0, p1;
    attn_body::qkt(p0, p1, shm + L_K + (c * 2 + tl) * 8192, qr, zero, r32, hi);
    asm volatile("s_nop 15\n\ts_nop 7" : "+v"(p0), "+v"(p1));
#pragma unroll
    for (int r = 0; r < 16; ++r) { const int kj = 64 * tl + crow(r, hi); if (kj > irow) p0[r] = 0.f; if (kj + 32 > irow) p1[r] = 0.f; }
    u32x4 pw0, pw1, pw2, pw3;
    pw0 = (u32x4){cvtpk(p0[0], p0[1]), cvtpk(p0[2], p0[3]), cvtpk(p0[4], p0[5]), cvtpk(p0[6], p0[7])}; pw1 = (u32x4){cvtpk(p0[8], p0[9]), cvtpk(p0[10], p0[11]), cvtpk(p0[12], p0[13]), cvtpk(p0[14], p0[15])};
    pw2 = (u32x4){cvtpk(p1[0], p1[1]), cvtpk(p1[2], p1[3]), cvtpk(p1[4], p1[5]), cvtpk(p1[6], p1[7])}; pw3 = (u32x4){cvtpk(p1[8], p1[9]), cvtpk(p1[10], p1[11]), cvtpk(p1[12], p1[13]), cvtpk(p1[14], p1[15])};
    __builtin_amdgcn_sched_barrier(0);
    pv(o, vb + L_V + (c * 2 + tl) * 8192, __builtin_bit_cast(bf16x8, pw0), __builtin_bit_cast(bf16x8, pw1), __builtin_bit_cast(bf16x8, pw2), __builtin_bit_cast(bf16x8, pw3));
  }
  asm volatile("s_waitcnt lgkmcnt(0)\n\ts_barrier" ::: "memory");
  { float* stg = (float*)(shm + L_O) + wid * 2048;
#pragma unroll
    for (int r = 0; r < 16; ++r) { const int orow = crow(r, hi);
#pragma unroll
      for (int d0 = 0; d0 < 2; ++d0) stg[orow * 64 + d0 * 32 + r32] = o[d0][r]; }
    asm volatile("s_waitcnt lgkmcnt(0)" ::: "memory");
    const int row = lane >> 1, half = lane & 1;
    const f32x4* sr = (const f32x4*)(stg + row * 64 + half * 32);
    f32x4 v[8]; float ss = 0.f;
#pragma unroll
    for (int i = 0; i < 8; ++i) { v[i] = sr[i]; ss += (v[i][0] * v[i][0] + v[i][1] * v[i][1]) + (v[i][2] * v[i][2] + v[i][3] * v[i][3]); }
    ss += __shfl_xor(ss, 1);
    const float rstd = 1.0f / sqrtf(ss * (1.0f / 64.0f) + EPS);
    const size_t grow = rowb + c * 128 + wq * 32 + row;
    const u32x4* gp = (const u32x4*)(GR + grow * 256 + h * 64 + half * 32);
    const f32x4* rg = (const f32x4*)(rgain + h * 64 + half * 32);
    u32x4* yp = (u32x4*)(Y + grow * DM + 512 + h * 64 + half * 32);
    u32x4 gwv[4]; f32x4 rgv[8];
#pragma unroll
    for (int i = 0; i < 4; ++i) { gwv[i] = gp[i]; rgv[2 * i] = rg[2 * i]; rgv[2 * i + 1] = rg[2 * i + 1]; }
#pragma unroll
    for (int i = 0; i < 4; ++i) {
      const u32x4 gw = gwv[i]; const f32x4 g0 = rgv[2 * i], g1 = rgv[2 * i + 1]; const f32x4 a = v[2 * i] * rstd * g0, c4 = v[2 * i + 1] * rstd * g1;
      u32x4 w; w.x = cvtpk(a[0] * bflo(gw.x), a[1] * bfhi(gw.x)); w.y = cvtpk(a[2] * bflo(gw.y), a[3] * bfhi(gw.y)); w.z = cvtpk(c4[0] * bflo(gw.z), c4[1] * bfhi(gw.z)); w.w = cvtpk(c4[2] * bflo(gw.w), c4[3] * bfhi(gw.w));
      yp[i] = w;
    }
  }
  asm volatile("s_waitcnt lgkmcnt(0)\n\ts_barrier" ::: "memory");
}
}

#define XB_TMO      128
#define XB_XCNT(j)  (256  + 64 * (j))
#define XB_XSUB(j)  (1280 + 64 * (j))
#define XB_XGEN(j)  (2304 + 64 * (j))
#define XB_TOP      3328
#define XB_TOPGEN   3392
#define XCD_BAR_WORDS 3456
#define XB_SPIN_CAP (1u << 18)
__device__ __forceinline__ unsigned xb_ld(unsigned* p)              { return __hip_atomic_load(p, __ATOMIC_RELAXED, __HIP_MEMORY_SCOPE_AGENT); }
__device__ __forceinline__ unsigned xb_add(unsigned* p, unsigned v) { return __hip_atomic_fetch_add(p, v, __ATOMIC_RELAXED, __HIP_MEMORY_SCOPE_AGENT); }
__device__ __forceinline__ unsigned xb_xcc_id() { return (unsigned)__builtin_amdgcn_s_getreg((3 << 11) | 20) & 0xFu; }
#define XB_SPIN(cond, bar) do { unsigned _sp = 0; while (cond) { __builtin_amdgcn_s_sleep(1); \
    if ((++_sp & 255u) == 0u) { if (xb_ld(&(bar)[XB_TMO])) break; if (_sp > XB_SPIN_CAP) { atomicAdd(&(bar)[XB_TMO], 1u); break; } } } } while (0)
struct XcdBarrier { unsigned* bar; unsigned x; volatile LAS unsigned* st; };
__device__ __forceinline__ XcdBarrier xcd_barrier_post(unsigned* bar, volatile LAS unsigned* st) {
    XcdBarrier b; b.bar = bar; b.x = xb_xcc_id(); b.st = st;
    if (threadIdx.x == 0) (void)xb_add(&bar[XB_XCNT(b.x)], 1u);
    return b;
}
__device__ __forceinline__ void xcd_barrier_complete(unsigned* bar, unsigned x, unsigned& nloc, unsigned& nx) {
    const unsigned G = gridDim.x * gridDim.y * gridDim.z;
    unsigned sum, cnt, mine, sp = 0u;
    for (;;) {
        sum = 0u; cnt = 0u; mine = 0u;
#pragma unroll
        for (unsigned j = 0; j < 16; ++j) { const unsigned c = xb_ld(&bar[XB_XCNT(j)]); sum += c; cnt += (c > 0u) ? 1u : 0u; mine = (j == x) ? c : mine; }
        if (sum == G) break;
        __builtin_amdgcn_s_sleep(1);
        if ((++sp & 255u) == 0u) { if (xb_ld(&bar[XB_TMO])) break; if (sp > XB_SPIN_CAP) { atomicAdd(&bar[XB_TMO], 1u); break; } }
    }
    nloc = mine > 0u ? mine : 1u; nx = cnt > 0u ? cnt : 1u;
}
__device__ __forceinline__ void xcd_barrier(const XcdBarrier& b) {
    asm volatile("s_waitcnt vmcnt(0)" ::: "memory");
    __syncthreads();
    if (threadIdx.x == 0) {
        unsigned* bar = b.bar;
        __builtin_amdgcn_s_waitcnt(0);
        unsigned nloc = b.st[0], nx = b.st[1];
        if (nloc == 0u) { xcd_barrier_complete(bar, b.x, nloc, nx); b.st[0] = nloc; b.st[1] = nx; }
        const unsigned old = xb_add(&bar[XB_XSUB(b.x)], 1u);
        const unsigned gen = old / nloc;
        if (old + 1u == (gen + 1u) * nloc) {
            __builtin_amdgcn_fence(__ATOMIC_RELEASE, "agent");
            asm volatile("s_waitcnt vmcnt(0)" ::: "memory");
            const unsigned og = xb_add(&bar[XB_TOP], 1u);
            const unsigned tg = og / nx;
            if (og + 1u == (tg + 1u) * nx) xb_add(&bar[XB_TOPGEN], 1u);
            else XB_SPIN(xb_ld(&bar[XB_TOPGEN]) == tg, bar);
            __builtin_amdgcn_fence(__ATOMIC_ACQUIRE, "agent");
            xb_add(&bar[XB_XGEN(b.x)], 1u);
            asm volatile("s_waitcnt vmcnt(0)" ::: "memory");
        } else {
            XB_SPIN(xb_ld(&bar[XB_XGEN(b.x)]) == gen, bar);
            __builtin_amdgcn_fence(__ATOMIC_ACQUIRE, "agent");
            asm volatile("s_waitcnt vmcnt(0)" ::: "memory");
        }
    }
    __syncthreads();
}

__global__ void __launch_bounds__(NTHREADS, 2) fwd_kernel(Args args) {
    extern __shared__ __attribute__((aligned(16))) unsigned char lds_raw[];
    LAS unsigned char* lds = (LAS unsigned char*)lds_raw;
    cg::grid_group grid = cg::this_grid();
    const int tid0 = threadIdx.x, wave = __builtin_amdgcn_readfirstlane(tid0 >> 6);
#define PHASE_LANES const int tid = opaque(tid0), lane = tid & 63; (void)lane; (void)tid
    const int G = gridDim.x, bx = blockIdx.x;
    const int vcu = (G % 8 == 0) ? (bx % 8) * (G / 8) + bx / 8 : bx;
    const int gw = vcu * NWAVES + wave, NGW = G * NWAVES;
    unsigned char* const ws = args.ws;
#define WSP(type, off) ((type*)(ws + (off)))
    if (tid0 < 64) ((LAS unsigned*)(lds + LDS_MISC))[tid0] = 0u;
    __syncthreads();
    unsigned long long tsA_ = 0, tsB_ = 0; (void)tsA_; (void)tsB_;
    TSTAMP(0);
    const XcdBarrier xbar = xcd_barrier_post(WSP(unsigned, WS_BAR), (volatile LAS unsigned*)(lds + LDS_MISC));
#define GRID_BAR() xcd_barrier(xbar)
    REPN(0) {
        PHASE_LANES;
        LAS float* scr = (LAS float*)(lds + wave * 16384);
        const float* x = args.in[0]; const float* mem = args.in[1]; const float* g_attn = args.in[2]; const float* w_in = args.in[3]; const float* g_mem = args.in[7];
        const float* w_mem_kv = args.in[8]; const float* w_out = args.in[11]; const float* g_ffn = args.in[12]; const float* w_router = args.in[13];
        bf16* WIN_T = WSP(bf16, WS_WIN); bf16* WMEM_T = WSP(bf16, WS_WMEM); bf16* WOUT_T = WSP(bf16, WS_WOUT);
        bf16* XN = WSP(bf16, WS_XN); bf16* MEMN = WSP(bf16, WS_MEMN); float* WRG = WSP(float, WS_WRG);
        constexpr int I0 = 16 * 88, I1 = 16 * 16, I2 = 16 * 32, NIT = I0 + I1 + I2;
        for (int it = gw; it < NIT; it += NGW) {
            int r = it;
            if (r < I0) { const int nb = r % 88, kb = r / 88; transpose_item(w_in, NIN, WIN_T, headperm_row(nb * 32), scr, kb * 64, nb * 32, lane); continue; } r -= I0;
            if (r < I1) { const int nb = r % 16, kb = r / 16; transpose_item(w_mem_kv, 512, WMEM_T, headperm_row(nb * 32), scr, kb * 64, nb * 32, lane); continue; } r -= I1;
            { const int nb = r % 32, kb = r / 32; transpose_item(w_out, 1024, WOUT_T, nb * 32, scr, kb * 64, nb * 32, lane); }
        }
        for (int m = gw * 2; m < T + MROWS; m += NGW * 2) {
            if (m < T) rms_row2_to_bf16(x + (size_t)m * DM, g_attn, XN + (size_t)m * DM, lane, WSP(float, WS_IRS) + m);
            else rms_row2_to_bf16(mem + (size_t)(m - T) * DM, g_mem, MEMN + (size_t)(m - T) * DM, lane, nullptr);
        }
        for (int i = bx * NTHREADS + tid; i < DM * NEXP; i += G * NTHREADS) WRG[i] = g_ffn[i >> 5] * w_router[i];
        for (int i = bx * NTHREADS + tid; i < NB * 16 * 8 * 64; i += G * NTHREADS) WSP(float, WS_KMEAN)[i] = 0.f;
    }
    if (args.pad0 == 0x7fffffff) grid.sync();
    GRID_BAR();
    TSTAMP(1);

    REPN(1) {
        EpiProj E{ws, args.in[4], args.in[5], args.in[9], args.in[10]};
        if (G == 256) {
            SchedProj10 S{G, bx, (const char*)(ws + WS_XN), (const char*)(ws + WS_WIN)};
            pg8::gemm_phase<EpiProj, SchedProj10>(lds, S, E);
        } else {
            SchedProj S{G, bx, (const char*)(ws + WS_XN), (const char*)(ws + WS_MEMN), (const char*)(ws + WS_WIN), (const char*)(ws + WS_WMEM)};
            pg8::gemm_phase<EpiProj, SchedProj>(lds, S, E);
        }
    }
    GRID_BAR();
    TSTAMP(2);

#ifndef NAIVE_RET
    REPN(2) {
        if (G == 256) {
            if (bx < 144) {
                SchedProjOne S{bx, (const char*)(ws + WS_XN), (const char*)(ws + WS_MEMN), (const char*)(ws + WS_WIN), (const char*)(ws + WS_WMEM)};
                EpiProj E{ws, args.in[4], args.in[5], args.in[9], args.in[10]};
                pg8::gemm_phase<EpiProj, SchedProjOne>(lds, S, E);
            } else {
                for (int u = bx - 144; u < 512; u += 112) { const int bh = u >> 4, cp = u & 15;
                    ret_body::kv_unit(WSP(bf16, WS_KR), WSP(bf16, WS_VR), WSP(float, WS_RET), bh >> 2, bh & 3, cp, (char*)lds_raw); }
            }
        } else {
            for (int i = 0; i < 2; ++i) { const int u = vcu * 2 + i, bh = u >> 4, cp = u & 15;
                ret_body::kv_unit(WSP(bf16, WS_KR), WSP(bf16, WS_VR), WSP(float, WS_RET), bh >> 2, bh & 3, cp, (char*)lds_raw); }
        }
    }
    GRID_BAR();
    TSTAMP(3);
#endif
    REPN(20) { PHASE_LANES;
#if defined(NAIVE_MOBA) || defined(NAIVE_RET) || defined(NAIVE_MEM)
#error naive mixers are no longer wired in
#endif
    unsigned* qmix = WSP(unsigned, WS_CTL) + 64 + 256 * rep_; unsigned* qconv = WSP(unsigned, WS_CTL) + 128 + 256 * rep_;
    volatile LAS int* qslot = (volatile LAS int*)(lds + LDS_MISC + 64);
    const bool conv_first = (vcu & 3) == 3;
    bool mix_done = false, conv_done = false;
    while (!(mix_done && conv_done)) {
        const int kind = conv_first ? (conv_done ? 0 : 1) : (mix_done ? 1 : 0);
        if (tid == 0) qslot[0] = (int)__hip_atomic_fetch_add(kind ? qconv : qmix, 1u, __ATOMIC_RELAXED, __HIP_MEMORY_SCOPE_AGENT);
        __syncthreads();
        const int u = qslot[0];
        __syncthreads();
        if (kind == 1) {
            if (u >= 1536) { conv_done = true; continue; }
            convert_chunk(u, args.in[15], args.in[17], WSP(unsigned char, WS_W1), WSP(unsigned char, WS_W2), (LAS float*)(lds + wave * 16384), wave, lane);
            __syncthreads();
        } else if (u >= 2048) { mix_done = true; }
        else if (u < 1024) {
            const int nb = 15 - (u >> 6), bh = u & 63, b = bh >> 3, h = bh & 7;
            const size_t row0 = (size_t)b * SEQ + (size_t)nb * 256;
            attn_body::attn_unit<8, 512, 1024, true>(WSP(bf16, WS_QA) + row0 * 512 + h * 64, WSP(bf16, WS_KA) + (size_t)b * SEQ * 512 + h * 64, WSP(bf16, WS_VA) + (size_t)b * SEQ * 512 + h * 64,
                                                     WSP(bf16, WS_Y) + row0 * DM + h * 64, 4 * nb + 4, nb, WSP(float, WS_KMEAN) + ((size_t)b * 16 * 8 + h) * 64, (char*)lds_raw);
        } else if (u < 1536) {
            const int idx = u - 1024, bh = idx >> 4, cp = idx & 15;
            ret_body::out_unit(WSP(bf16, WS_QR), WSP(bf16, WS_KR), WSP(bf16, WS_VR), WSP(bf16, WS_GR), WSP(float, WS_RET), args.in[6], WSP(bf16, WS_Y), bh >> 2, bh & 3, cp, (char*)lds_raw);
        } else {
            const int idx = u - 1536, bh = idx >> 4, qb = idx & 15, b = bh >> 2, h = bh & 3;
            const size_t row0 = (size_t)b * SEQ + (size_t)qb * 256;
            attn_body::attn_unit<8, 256, 1024, false>(WSP(bf16, WS_QM) + row0 * 256 + h * 64, WSP(bf16, WS_MK) + (size_t)b * MEMLEN * 256 + h * 64, WSP(bf16, WS_MV) + (size_t)b * MEMLEN * 256 + h * 64,
                                                      WSP(bf16, WS_Y) + row0 * DM + 768 + h * 64, 4, 0, nullptr, (char*)lds_raw);
        }
    }
    }
    GRID_BAR();
    TSTAMP(4);

    REPN(3) {
        SchedPlain S{G, bx, 128, 4, (const char*)(ws + WS_Y), (const char*)(ws + WS_WOUT)};
        EpiOut E{WSP(bf16, WS_XN), WSP(float, WS_IRS), args.in[2], WSP(bf16, WS_X1B), WSP(float, WS_SSQ)};
#ifndef NO_G2
        pg8::gemm_phase<EpiOut, SchedPlain>(lds, S, E);
#endif
    }
    GRID_BAR();
    TSTAMP(5);

    REPN(4) {
        PHASE_LANES;
        const bf16* x1b = WSP(bf16, WS_X1B); const float* b_router = args.in[14];
        float* WRG = WSP(float, WS_WRG); float* SSQ = WSP(float, WS_SSQ); int* TOPI = WSP(int, WS_TOPI); float* TOPW = WSP(float, WS_TOPW); int* LRANK = WSP(int, WS_LRANK); int* LCOUNT = WSP(int, WS_LCOUNT);
        unsigned char* XN2 = WSP(unsigned char, WS_XN2); const float* g_ffn = args.in[12];
        if (bx == 0 && tid < 64) ((u32x4*)(XN2 + (size_t)T * DM))[tid] = (u32x4){0u, 0u, 0u, 0u};
        LAS float* wl = (LAS float*)(lds);
        LAS float* lg = (LAS float*)(lds + 131072) + wave * (16 * 33);
        LAS int* hist = (LAS int*)(lds + 131072 + 16896);
        { f32x4 w4[16];
#pragma unroll
          for (int q = 0; q < 16; ++q) w4[q] = ((const f32x4*)WRG)[tid + q * NTHREADS];
#pragma unroll
          for (int q = 0; q < 16; ++q) { const int i4 = tid + q * NTHREADS, r = i4 >> 3, e = (i4 & 7) * 4; *(LAS f32x4*)(wl + r * 32 + (e ^ (((r >> 5) & 1) << 4))) = w4[q]; } }
        if (tid < 32) hist[tid] = 0;
        __syncthreads();
        const int tpw = T / (G * NWAVES);
        for (int tb = 0; tb < tpw; tb += 16) {
            const int t0 = (bx * NWAVES + wave) * tpw + tb;
            const int i = lane & 15, kq = lane >> 4;
            f32x4 a0 = {0.f, 0.f, 0.f, 0.f}, a1 = {0.f, 0.f, 0.f, 0.f};
            const bf16* xr = x1b + (size_t)(t0 + i) * DM + 32 * kq;
            const LAS float* wb = wl + (32 * kq) * 32 + (i ^ ((kq & 1) << 4));
            const LAS float* wb1 = wl + (32 * kq) * 32 + ((i ^ ((kq & 1) << 4)) ^ 16);
            float rstd;
            { const f32x4* sp = (const f32x4*)(SSQ + (size_t)(t0 + i) * 16); const f32x4 s0 = sp[0], s1 = sp[1], s2 = sp[2], s3 = sp[3];
              const float ss = ((s0[0] + s0[1]) + (s0[2] + s0[3])) + ((s1[0] + s1[1]) + (s1[2] + s1[3])) + ((s2[0] + s2[1]) + (s2[2] + s2[3])) + ((s3[0] + s3[1]) + (s3[2] + s3[3]));
              rstd = 1.0f / sqrtf(ss * (1.0f / DM) + EPS); }
            unsigned char* xo = XN2 + (size_t)(t0 + i) * DM + 16 * kq;
            const float* gp = g_ffn + 32 * kq;
#define RT_LOAD(xq, gq, c) do { _Pragma("unroll") for (int j = 0; j < 4; ++j) xq[j] = *(const u32x4*)(xr + 128 * (c) + 8 * j); \
                _Pragma("unroll") for (int j = 0; j < 8; ++j) gq[j] = *(const f32x4*)(gp + 128 * (c) + 4 * j); } while (0)
#define RT_PACK(xq, gq, c) do { \
                _Pragma("unroll") for (int j = 0; j < 4; ++j) { const u32x4 xw = xq[j]; \
                    av[8 * j] = bflo(xw.x); av[8 * j + 1] = bfhi(xw.x); av[8 * j + 2] = bflo(xw.y); av[8 * j + 3] = bfhi(xw.y); av[8 * j + 4] = bflo(xw.z); av[8 * j + 5] = bfhi(xw.z); av[8 * j + 6] = bflo(xw.w); av[8 * j + 7] = bfhi(xw.w); } \
                { float nv[32]; \
                  _Pragma("unroll") for (int j = 0; j < 8; ++j) { const f32x4 g = gq[j]; nv[4 * j] = av[4 * j] * rstd * g[0]; nv[4 * j + 1] = av[4 * j + 1] * rstd * g[1]; nv[4 * j + 2] = av[4 * j + 2] * rstd * g[2]; nv[4 * j + 3] = av[4 * j + 3] * rstd * g[3]; } \
                  u32x4 p0, p1; fp6_pack32(nv, p0, p1); \
                  *(u32x4*)(xo + 128 * (c)) = p0; *(u32x4*)(xo + 128 * (c) + 64) = p1; } } while (0)
#define RT_MMA(c) do { _Pragma("unroll") for (int q = 0; q < 32; ++q) { \
                    const float b0 = wb[(128 * (c) + q) * 32], b1v = wb1[(128 * (c) + q) * 32]; \
                    a0 = __builtin_amdgcn_mfma_f32_16x16x4f32(av[q], b0, a0, 0, 0, 0); \
                    a1 = __builtin_amdgcn_mfma_f32_16x16x4f32(av[q], b1v, a1, 0, 0, 0); } } while (0)
            u32x4 xqa[4]; f32x4 gqa[8]; float av[32];
            RT_LOAD(xqa, gqa, 0);
#pragma unroll 1
            for (int c = 0; c < 8; ++c) {
                RT_PACK(xqa, gqa, c);
                asm volatile("" ::: "memory");
                if (c + 1 < 8) RT_LOAD(xqa, gqa, c + 1);
                RT_MMA(c);
            }
#undef RT_LOAD
#undef RT_PACK
#undef RT_MMA
#pragma unroll
            for (int r = 0; r < 4; ++r) { lg[(4 * kq + r) * 33 + i] = a0[r]; lg[(4 * kq + r) * 33 + 16 + i] = a1[r]; }
            LDS_WAIT(); asm volatile("" ::: "memory");
            if (lane < 16) {
                const int t = t0 + lane;
                float v[32];
#pragma unroll
                for (int e = 0; e < 32; ++e) v[e] = lg[lane * 33 + e] * rstd + b_router[e];
                int bi[4]; float bvv[4];
#pragma unroll
                for (int k = 0; k < 4; ++k) {
                    float best = -3e38f; int be = 0;
#pragma unroll
                    for (int e = 0; e < 32; ++e) { const bool take = v[e] > best; best = take ? v[e] : best; be = take ? e : be; }
                    bi[k] = be; bvv[k] = best;
#pragma unroll
                    for (int e = 0; e < 32; ++e) v[e] = (e == be) ? -3e38f : v[e];
                }
                const float e1 = __expf(bvv[1] - bvv[0]), e2 = __expf(bvv[2] - bvv[0]), e3 = __expf(bvv[3] - bvv[0]);
                const float inv = 1.0f / (1.0f + e1 + e2 + e3);
                const float wv[4] = {inv, e1 * inv, e2 * inv, e3 * inv};
#pragma unroll
                for (int k = 0; k < 4; ++k) {
                    const int rk = atomicAdd((int*)&hist[bi[k]], 1);
                    TOPI[t * 4 + k] = bi[k]; TOPW[t * 4 + k] = wv[k]; LRANK[t * 4 + k] = rk;
                }
            }
            LDS_WAIT(); asm volatile("" ::: "memory");
        }
        __syncthreads();
        if (tid < 32) LCOUNT[bx * 32 + tid] = hist[tid];
    }
    GRID_BAR();
    TSTAMP(6);

    REPN(5) {
        PHASE_LANES;
        int* TOPI = WSP(int, WS_TOPI); float* TOPW = WSP(float, WS_TOPW); int* LRANK = WSP(int, WS_LRANK); int* LCOUNT = WSP(int, WS_LCOUNT);
        int* POS = WSP(int, WS_POS); float* ROWW = WSP(float, WS_ROWW); int* PSTART = WSP(int, WS_PSTART); int* TILEEXP = WSP(int, WS_TILEEXP);
        LAS int* part = (LAS int*)(lds);
        LAS int* base = (LAS int*)(lds + 8192);
        {
            const int e = tid & 31, p = tid >> 5; int c = 0, pre = 0;
            const int wpp = (G + 15) / 16;
            if (wpp == 16) {
                int v[16];
#pragma unroll
                for (int k = 0; k < 16; ++k) { const int w = p * 16 + k; v[k] = (w < G) ? LCOUNT[w * 32 + e] : 0; }
#pragma unroll
                for (int k = 0; k < 16; ++k) { const int w = p * 16 + k; c += v[k]; pre += (w < bx) ? v[k] : 0; }
            } else
            for (int w = p * wpp; w < (p + 1) * wpp && w < G; ++w) { const int v = LCOUNT[w * 32 + e]; c += v; pre += (w < bx) ? v : 0; }
            part[p * 32 + e] = c; part[512 + p * 32 + e] = pre;
        }
        __syncthreads();
        if (tid < 32) { int c = 0, pre = 0; for (int p = 0; p < 16; ++p) { c += part[p * 32 + tid]; pre += part[512 + p * 32 + tid]; } part[1024 + tid] = c; part[1056 + tid] = pre; }
        __syncthreads();
        if (tid == 0) {
            int ps = 0;
            for (int e = 0; e < 32; ++e) {
                const int c = part[1024 + e], nt_ = (c + 255) >> 8;
                base[32 + e] = ps; base[e] = ps + part[1056 + e];
                if (bx == 0) PSTART[e] = ps;
                ps += nt_ * 256;
            }
            base[64] = ps; if (bx == 0) PSTART[32] = ps;
        }
        __syncthreads();
        if (bx == 1) {
            const int ntl = base[64] >> 8;
            for (int tl = tid; tl < ntl; tl += NTHREADS) { int e = 0;
#pragma unroll
                for (int q = 1; q < 32; ++q) e += (base[32 + q] <= tl * 256) ? 1 : 0;
                TILEEXP[tl] = e; }
        }
        int* ROWTOK = WSP(int, WS_ROWTOK);
        if (bx < 32) {
            const int c = part[1024 + bx], r0 = base[32 + bx] + c, r1 = base[32 + bx] + (((c + 255) >> 8) << 8);
            for (int r = r0 + tid; r < r1; r += NTHREADS) { ROWTOK[r] = T; ROWW[r] = 0.f; }
        }
        for (int a = tid; a < (T / G) * 4; a += NTHREADS) {
            const int ta = (bx * (T / G)) * 4 + a;
            const int e = TOPI[ta]; const int pos = base[e] + LRANK[ta];
            POS[ta] = pos; ROWTOK[pos] = ta >> 2; ROWW[pos] = TOPW[ta];
        }
    }
    GRID_BAR();
    TSTAMP(7);

    const int ntiles = WSP(int, WS_PSTART)[32] >> 8;
    REPN(6) {
        SchedMoe S{G, vcu, 8, ntiles, WSP(int, WS_TILEEXP), (const char*)(ws + WS_XN2), (const char*)(ws + WS_W1), (size_t)2048 * 1024, WSP(int, WS_ROWTOK)};
        EpiSwiglu E{args.in[16], WSP(unsigned char, WS_H)};
#ifndef NO_G3
        pg8::gemm_phase<EpiSwiglu, SchedMoe, true, true, true>(lds, S, E);
#endif
    }
    GRID_BAR();
    TSTAMP(8);
    REPN(7) {
        SchedMoe S{G, vcu, 4, ntiles, WSP(int, WS_TILEEXP), (const char*)(ws + WS_H), (const char*)(ws + WS_W2), (size_t)1024 * 1024, nullptr};
        EpiDown E{args.in[18], WSP(float, WS_ROWW), WSP(unsigned char, WS_XG)};
#ifndef NO_G4
        pg8::gemm_phase<EpiDown, SchedMoe, false, true>(lds, S, E);
#endif
    }
    GRID_BAR();
    TSTAMP(9);
    if (REP_PHASE == 9) { GRID_BAR(); GRID_BAR(); GRID_BAR(); GRID_BAR(); }
    REPN(8) { PHASE_LANES;
    float* out = args.out; const int* POS = WSP(int, WS_POS); const unsigned char* YE = WSP(unsigned char, WS_XG); const bf16* x1b = WSP(bf16, WS_X1B);
    float* dst = (REP_PHASE == 8 && rep_ == 0) ? WSP(float, WS_H) + 64 * 1024 * 1024 : out;
    for (int t0 = gw; t0 < T; t0 += 2 * NGW) {
        const bool two = t0 + NGW < T; const int t1 = two ? t0 + NGW : t0;
        u32x2 xv[2][4]; unsigned yw[2][4][4];
#pragma unroll
        for (int h = 0; h < 2; ++h) { const int t = h ? t1 : t0; const u32x2* xrow = (const u32x2*)(x1b + (size_t)t * DM) + lane;
#pragma unroll
            for (int j = 0; j < 4; ++j) xv[h][j] = __builtin_nontemporal_load(xrow + 64 * j);
#pragma unroll
            for (int k = 0; k < 4; ++k) { const int pos = POS[t * 4 + k]; const unsigned* yr = (const unsigned*)(YE + (size_t)pos * 1024) + lane;
#pragma unroll
                for (int j = 0; j < 4; ++j) yw[h][k][j] = __builtin_nontemporal_load(yr + 64 * j); } }
        f32x4 s[2][4];
#pragma unroll
        for (int h = 0; h < 2; ++h) {
#pragma unroll
            for (int j = 0; j < 4; ++j) s[h][j] = (f32x4){0.f, 0.f, 0.f, 0.f};
#pragma unroll
            for (int k = 0; k < 4; ++k)
#pragma unroll
                for (int j = 0; j < 4; ++j) {
                    const f32x2 lo = __builtin_amdgcn_cvt_pk_f32_fp8((int)yw[h][k][j], false), hi = __builtin_amdgcn_cvt_pk_f32_fp8((int)yw[h][k][j], true);
                    s[h][j].x += lo.x; s[h][j].y += lo.y; s[h][j].z += hi.x; s[h][j].w += hi.y;
                }
        }
        asm volatile("s_waitcnt vmcnt(0)" ::: "memory");
#pragma unroll
        for (int h = 0; h < 2; ++h) { if (h == 1 && !two) break; const int t = h ? t1 : t0; f32x4* drow = (f32x4*)(dst + (size_t)t * DM) + lane;
#pragma unroll
            for (int j = 0; j < 4; ++j) __builtin_nontemporal_store((f32x4){bflo(xv[h][j].x), bfhi(xv[h][j].x), bflo(xv[h][j].y), bfhi(xv[h][j].y)} + s[h][j] * 0.0625f, drow + 64 * j); }
    }
    }
    TSTAMP(10);
    if (REP_PHASE >= 100 && bx == 0 && tid0 == 0) {
        const unsigned long long t0_ = __builtin_amdgcn_s_memrealtime(), want = 9ull * (tsB_ - tsA_);
        while (__builtin_amdgcn_s_memrealtime() - t0_ < want) __builtin_amdgcn_s_sleep(32);
    }
}

extern "C" void kernel_launch(void* const* d_in, const int* in_sizes, int n_in, void* d_out, int out_size, void* d_ws, size_t ws_size, hipStream_t stream) {
    static int grid = 0;
    if (grid == 0) {
        if (n_in != 19 || out_size != T * DM || ws_size < WS_END) { fprintf(stderr, "kernel_launch: unexpected shapes (n_in %d out %d ws %zu)\n", n_in, out_size, ws_size); grid = -1; return; }
        int dev = 0, cus = 0, per_cu = 0;
        hipGetDevice(&dev); hipDeviceGetAttribute(&cus, hipDeviceAttributeMultiprocessorCount, dev);
        hipFuncSetAttribute((const void*)fwd_kernel, hipFuncAttributeMaxDynamicSharedMemorySize, LDS_BYTES);
        hipOccupancyMaxActiveBlocksPerMultiprocessor(&per_cu, (const void*)fwd_kernel, NTHREADS, LDS_BYTES);
        if (per_cu < 1) { fprintf(stderr, "kernel_launch: occupancy query says %d blocks per CU\n", per_cu); per_cu = 1; }
        (void)hipGetLastError();
        grid = cus * 1;
        if (grid % 8 != 0 || T % (grid * NWAVES * 16) != 0) { fprintf(stderr, "kernel_launch: grid %d unsupported\n", grid); grid = -1; return; }
    }
    if (grid < 0) return;
    hipMemsetAsync((char*)d_ws + WS_CTL, 0, CTL_ZERO_BYTES, stream);
    Args a{};
    for (int i = 0; i < 19; ++i) a.in[i] = (const float*)d_in[i];
    a.out = (float*)d_out; a.ws = (unsigned char*)d_ws;
    void* kargs[] = {&a};
    hipError_t e = hipLaunchCooperativeKernel((const void*)fwd_kernel, dim3(grid), dim3(NTHREADS), kargs, LDS_BYTES, stream);
    if (e != hipSuccess) fprintf(stderr, "cooperative launch failed: %s (grid %d)\n", hipGetErrorString(e), grid);
}
```

```cpp
#include <hip/hip_runtime.h>
#include <hip/hip_cooperative_groups.h>
#include <cstdio>
#include <cstdint>
namespace cg = cooperative_groups;

#define GAS __attribute__((address_space(1)))
#define LAS __attribute__((address_space(3)))
typedef unsigned short bf16;
typedef short bf16x8 __attribute__((ext_vector_type(8)));
typedef float f32x4 __attribute__((ext_vector_type(4)));
typedef float f32x2 __attribute__((ext_vector_type(2)));
typedef unsigned u32x4 __attribute__((ext_vector_type(4)));
typedef unsigned u32x2 __attribute__((ext_vector_type(2)));
typedef __bf16 bf16x2_t __attribute__((ext_vector_type(2)));

constexpr int NB = 8, SEQ = 4096, DM = 1024, T = NB * SEQ;
constexpr int NIN = 2816, NEXP = 32, TOPK = 4;
constexpr int MEMLEN = 256, MROWS = NB * MEMLEN;
constexpr float EPS = 1e-6f;
constexpr float C2 = 0.125f * 1.4426950408889634f;
constexpr int MAXTILES = 544, PROWS = MAXTILES * 256;
constexpr int NWAVES = 8, NTHREADS = 512;
#ifndef REP_PHASE
#define REP_PHASE -1
#endif
#define TSTAMP(i) do { if (REP_PHASE == 100 + (i)) tsA_ = __builtin_amdgcn_s_memrealtime(); if (REP_PHASE == 99 + (i)) tsB_ = __builtin_amdgcn_s_memrealtime(); } while (0)
#define REPN(k) for (int rep_ = 0; rep_ < ((REP_PHASE == (k)) ? 2 : 1); ++rep_)
constexpr int LDS_MISC = 150016;
constexpr int LDS_G = 150016 + 256;
constexpr int LDS_BYTES = 150016 + 256 + 4096;

constexpr size_t MiB = 1u << 20;
constexpr size_t WS_CTL = 0, CTL_ZERO_BYTES = 131072;
constexpr size_t WS_BAR = 65536;
constexpr size_t WS_KMEAN = 1 * MiB;
constexpr size_t WS_WRG = 2 * MiB;
constexpr size_t WS_SSQ = 3 * MiB;
constexpr size_t WS_TOPI = 5 * MiB, WS_TOPW = 5 * MiB + 512 * 1024, WS_LRANK = 6 * MiB, WS_POS = 6 * MiB + 512 * 1024;
constexpr size_t WS_ROWW = 7 * MiB;
constexpr size_t WS_LCOUNT = 8 * MiB, WS_PSTART = 8 * MiB + 65536, WS_TILEEXP = 8 * MiB + 131072;
constexpr size_t WS_WIN = 16 * MiB, WS_WMEM = 22 * MiB, WS_WOUT = 24 * MiB, WS_W1 = 32 * MiB, WS_W2 = 160 * MiB;
constexpr size_t WS_XN = 224 * MiB, WS_MEMN = 288 * MiB;
constexpr size_t WS_LIST = 100 * MiB, WS_WLIST = 104 * MiB;
constexpr int ECAP = 32768;
constexpr size_t WS_QA = 292 * MiB, WS_KA = 324 * MiB, WS_VA = 356 * MiB;
constexpr size_t WS_QR = 388 * MiB, WS_KR = 404 * MiB, WS_VR = 420 * MiB, WS_GR = 436 * MiB, WS_QM = 452 * MiB;
constexpr size_t WS_MK = 468 * MiB, WS_MV = 469 * MiB;
constexpr size_t WS_Y = 470 * MiB, WS_RET = 534 * MiB;
constexpr size_t WS_XG = 224 * MiB;
constexpr size_t WS_XN2 = 496 * MiB;
constexpr size_t WS_X1B = 388 * MiB;
constexpr size_t WS_IRS = 10 * MiB;
constexpr size_t WS_ROWTOK = 9 * MiB;
constexpr size_t WS_H = 566 * MiB;
constexpr size_t WS_END = 838 * MiB;

struct Args {
    const float* in[19]; float* out; unsigned char* ws; int pad0, pad1;
};

__device__ __forceinline__ unsigned cvtpk(float lo, float hi) { f32x2 v = {lo, hi}; bf16x2_t b = __builtin_convertvector(v, bf16x2_t); return __builtin_bit_cast(unsigned, b); }
__device__ __forceinline__ float bf2f(unsigned short b) { return __uint_as_float(((unsigned)b) << 16); }
__device__ __forceinline__ float bflo(unsigned w) { return __uint_as_float(w << 16); }
__device__ __forceinline__ float bfhi(unsigned w) { return __uint_as_float(w & 0xffff0000u); }
__device__ __forceinline__ float wave_sum(float v) {
#pragma unroll
    for (int o = 1; o < 64; o <<= 1) v += __shfl_xor(v, o);
    return v;
}
#define LDS_WAIT() asm volatile("s_waitcnt lgkmcnt(0)" ::: "memory")
typedef unsigned v6u_t __attribute__((ext_vector_type(6)));
typedef float v16f_t __attribute__((ext_vector_type(16)));
#ifndef FP6_SCALE_DIV
#define FP6_SCALE_DIV 1
#endif
__device__ __forceinline__ void fp6_pack32(const float (&v)[32], u32x4& p0, u32x4& p1) {
    float mx = 1e-30f;
#pragma unroll
    for (int i = 0; i < 32; ++i) mx = fmaxf(mx, fabsf(v[i]));
    const unsigned bits = __float_as_uint(mx * (1.0f / 7.5f));
    int e = (int)((bits + 0x7FFFFFu) >> 23) - 127;
    e = e < -126 ? -126 : (e > 126 ? 126 : e);
    const float sc = __uint_as_float((unsigned)((FP6_SCALE_DIV ? e : -e) + 127) << 23);
    v16f_t lo, hi;
#pragma unroll
    for (int i = 0; i < 16; ++i) { lo[i] = v[i]; hi[i] = v[16 + i]; }
    const v6u_t w = __builtin_amdgcn_cvt_scalef32_2xpk16_fp6_f32(lo, hi, sc);
    p0 = (u32x4){w[0], w[1], w[2], w[3]}; p1 = (u32x4){w[4], w[5], (unsigned)(e + 127), 0u};
}
__device__ __forceinline__ int opaque(int v) { asm volatile("" : "+v"(v)); return v; }

namespace pg8 {
constexpr int BM = 256, BK = 64, HALF = 128, HTB = HALF * BK * 2, STAGE_BYTES = 8 * HTB, NXCD = 8, WGM = 8, K = 1024;
__host__ __device__ __forceinline__ int lds_byte(int r, int c) { const int st = (r >> 4) * 2 + (c >> 5), rr = r & 15, cc = c & 31, ob = rr * 64 + cc * 2; return st * 1024 + (ob ^ (((ob >> 9) & 1) << 5)); }
__host__ __device__ __forceinline__ void stage_rc(int b, int& R, int& C) { const int st = b / 1024, sb = b % 1024, swz = sb ^ (((sb >> 9) & 1) << 5); R = (st >> 1) * 16 + swz / 64; C = (st & 1) * 32 + (swz % 64) / 2; }
__host__ __device__ __forceinline__ int perm32(int rho) { const int n = rho >> 4, i = rho & 15; return 8 * (i >> 2) + 4 * n + (i & 3); }
struct Unit { int pm, pn, aux; };

__device__ __forceinline__ bool static_order(int L, int nM, int nN, int& pm, int& pn) {
    const int nwg = nM * nN; if (L >= nwg) return false;
    int wgid = L; { const int q = nwg / NXCD, r = nwg % NXCD, xcd = wgid % NXCD, off = wgid / NXCD; wgid = (xcd < r ? xcd * (q + 1) : r * (q + 1) + (xcd - r) * q) + off; }
    const int nig = WGM * nN, gid = wgid / nig, fm = gid * WGM, gsz = (nM - fm) < WGM ? (nM - fm) : WGM;
    pm = fm + ((wgid % nig) % gsz); pn = (wgid % nig) / gsz; return true;
}

typedef int v8i_t __attribute__((ext_vector_type(8)));
typedef int v4i_t __attribute__((ext_vector_type(4)));
__device__ __forceinline__ v8i_t cat8(bf16x8 lo, bf16x8 hi) { const v4i_t a = __builtin_bit_cast(v4i_t, lo), b = __builtin_bit_cast(v4i_t, hi); return __builtin_shufflevector(a, b, 0, 1, 2, 3, 4, 5, 6, 7); }
typedef int v6i_t __attribute__((ext_vector_type(6)));
__device__ __forceinline__ v6i_t cat6(bf16x8 lo, bf16x8 hi) { const v4i_t a = __builtin_bit_cast(v4i_t, lo), b = __builtin_bit_cast(v4i_t, hi); return __builtin_shufflevector(a, b, 0, 1, 2, 3, 4, 5); }
__device__ __forceinline__ int scl6(bf16x8 hi) { return __builtin_bit_cast(v4i_t, hi)[2]; }
constexpr int PRE_LDS = 133120;
template <class T, class = void> struct pre_kib { static constexpr int value = 0; };
template <class T> struct pre_kib<T, decltype((void)T::PRE_KIB)> { static constexpr int value = T::PRE_KIB; };
template <class Epi, class Sched, bool GATHER = false, bool FP8 = false, bool FP6 = false>
__device__ __forceinline__ void gemm_phase(LAS unsigned char* lds, const Sched& S, const Epi& E) {
    constexpr int PRE = pre_kib<Epi>::value;
#define PG8_PRE(unit, par) do { if constexpr (PRE > 0) { if (wid == 0) { _Pragma("unroll") for (int _k = 0; _k < PRE; ++_k) \
        __builtin_amdgcn_global_load_lds((const unsigned*)E.pre_src(unit, _k, lane), (LAS unsigned*)(lds + PRE_LDS + (par) * 2048 + _k * 1024), 16, 0, 0); } } } while (0)
    constexpr int PITCH = FP8 ? 1024 : 2048;
    const int tid = opaque((int)threadIdx.x), wid = __builtin_amdgcn_readfirstlane(tid >> 6), lane = tid & 63, wr = wid >> 2, wc = wid & 3, fr = lane & 15, fq = lane >> 4;
    constexpr int nt = PITCH / 128;
    unsigned voffA[2], voffB[2];
#pragma unroll
    for (int i = 0; i < 2; ++i) { int R, C; stage_rc(tid * 16 + i * 8192, R, C); const int Rb = (R & ~31) + perm32(R & 31);
        voffA[i] = (unsigned)(R * PITCH + C * 2); voffB[i] = (unsigned)(Rb * PITCH + C * 2); }
    const size_t kstep = (size_t)(BK * 2);
    const size_t hstep = (size_t)HALF * PITCH;
    const unsigned ldsw = (unsigned)wid * 1024u;
    const int aoff = lds_byte(wr * 64 + fr, fq * 8), boff = lds_byte(wc * 32 + fr, fq * 8);
#define PG8_SA(b, h) (((b) * 2 + (h)) * HTB)
#define PG8_SB(b, h) ((4 + (b) * 2 + (h)) * HTB)
#define PG8_STAGE(bufoff, gbase, voff) do { _Pragma("unroll") for (int _i = 0; _i < 2; ++_i) \
        __builtin_amdgcn_global_load_lds((const unsigned*)((const char*)(gbase) + (voff)[_i]), (LAS unsigned*)(lds + (bufoff) + ldsw + _i * 8192), 16, 0, 0); } while (0)
#define PG8_LDA(dst, b, h) do { _Pragma("unroll") for (int m = 0; m < 4; ++m) _Pragma("unroll") for (int k = 0; k < 2; ++k) dst[m][k] = *(const LAS bf16x8*)(lds + PG8_SA(b, h) + aoff + m * 2048 + k * 1024); } while (0)
#define PG8_LDB(dst, b, h) do { _Pragma("unroll") for (int n = 0; n < 2; ++n) _Pragma("unroll") for (int k = 0; k < 2; ++k) dst[n][k] = *(const LAS bf16x8*)(lds + PG8_SB(b, h) + boff + n * 2048 + k * 1024); } while (0)
#define PG8_MMA(ai, bj, At, Bt) do { __builtin_amdgcn_s_setprio(1); \
        if constexpr (FP6) { _Pragma("unroll") for (int m = 0; m < 4; ++m) _Pragma("unroll") for (int n = 0; n < 2; ++n) \
            asm volatile("s_nop 1\n\tv_mfma_scale_f32_16x16x128_f8f6f4 %0, %1, %2, %0, %3, %4 op_sel_hi:[0,0,0] cbsz:2 blgp:2" : "+v"(acc[ai][bj][m][n]) : "v"(cat6(Bt[n][0], Bt[n][1])), "v"(cat6(At[m][0], At[m][1])), "v"(scl6(Bt[n][1])), "v"(scl6(At[m][1]))); } \
        else if constexpr (FP8) { _Pragma("unroll") for (int m = 0; m < 4; ++m) _Pragma("unroll") for (int n = 0; n < 2; ++n) \
            asm volatile("v_mfma_scale_f32_16x16x128_f8f6f4 %0, %1, %2, %0, %3, %3 op_sel_hi:[0,0,0]" : "+v"(acc[ai][bj][m][n]) : "v"(cat8(Bt[n][0], Bt[n][1])), "v"(cat8(At[m][0], At[m][1])), "v"(0x7f7f7f7f)); } \
        else { _Pragma("unroll") for (int m = 0; m < 4; ++m) _Pragma("unroll") for (int n = 0; n < 2; ++n) _Pragma("unroll") for (int k = 0; k < 2; ++k) \
            acc[ai][bj][m][n] = __builtin_amdgcn_mfma_f32_16x16x32_bf16(Bt[n][k], At[m][k], acc[ai][bj][m][n], 0, 0, 0); } \
        __builtin_amdgcn_s_setprio(0); } while (0)
#define PG8_WAIT_V(n) asm volatile("s_waitcnt vmcnt(" #n ")" ::: "memory")
#define PG8_WAIT_L(n) asm volatile("s_waitcnt lgkmcnt(" #n ")" ::: "memory")
#define PG8_BAR __builtin_amdgcn_s_barrier()
#define PG8_SCHED __builtin_amdgcn_sched_barrier(0)
    Unit cur, nxt; int ui = 0;
    if (!S.next(0, cur)) return;
    PG8_PRE(cur, 0);
    unsigned vGc[2][2], vGn[2][2]; int gR[2], gC[2];
    const char* gA = nullptr;
    if constexpr (GATHER) {
        gA = S.abase();
#pragma unroll
        for (int i = 0; i < 2; ++i) { stage_rc(tid * 16 + i * 8192, gR[i], gC[i]); }
        if (wid == 0) __builtin_amdgcn_global_load_lds((const unsigned*)(S.tokptr(cur) + lane * 16), (LAS unsigned*)(lds + 131072), 16, 0, 0);
        asm volatile("s_waitcnt vmcnt(0)" ::: "memory"); __builtin_amdgcn_s_barrier(); asm volatile("" ::: "memory");
#pragma unroll
        for (int h = 0; h < 2; ++h)
#pragma unroll
            for (int i = 0; i < 2; ++i) { unsigned tok = (unsigned)((const LAS int*)(lds + 131072))[h * 128 + gR[i]]; tok = tok > (unsigned)T ? (unsigned)T : tok; vGc[h][i] = tok * (unsigned)PITCH + (unsigned)gC[i] * 2u; vGn[h][i] = vGc[h][i]; }
    }
    f32x4 acc[2][2][4][2];
#pragma unroll
    for (int a = 0; a < 2; ++a)
#pragma unroll
        for (int b = 0; b < 2; ++b)
#pragma unroll
            for (int m = 0; m < 4; ++m)
#pragma unroll
                for (int n = 0; n < 2; ++n) acc[a][b][m][n] = (f32x4){0.f, 0.f, 0.f, 0.f};
    bf16x8 At[4][2], B0[2][2], B1[2][2];
    const char* cA = GATHER ? gA : S.aptr(cur); const char* cB = S.bptr(cur);
    const size_t ahstep = GATHER ? (size_t)0 : hstep;
    {
        PG8_STAGE(PG8_SB(0, 0), cB, voffB); PG8_STAGE(PG8_SB(0, 1), cB + hstep, voffB);
        if constexpr (GATHER) { PG8_STAGE(PG8_SA(0, 0), cA, vGc[0]); PG8_STAGE(PG8_SA(0, 1), cA, vGc[1]); } else { PG8_STAGE(PG8_SA(0, 0), cA, voffA); PG8_STAGE(PG8_SA(0, 1), cA + hstep, voffA); }
        if (wr == 1) PG8_BAR;
        PG8_WAIT_V(2); PG8_BAR;
        PG8_STAGE(PG8_SB(1, 0), cB + kstep, voffB);
        if constexpr (GATHER) { PG8_STAGE(PG8_SA(1, 0), cA + kstep, vGc[0]); } else { PG8_STAGE(PG8_SA(1, 0), cA + kstep, voffA); }
        PG8_STAGE(PG8_SB(1, 1), cB + hstep + kstep, voffB);
        PG8_WAIT_V(6); PG8_BAR;
    }
    for (;;) {
        const bool has_next = S.next(ui + 1, nxt);
        const char* nA = GATHER ? gA : (has_next ? S.aptr(nxt) : cA); const char* nB = has_next ? S.bptr(nxt) : cB;
        if constexpr (GATHER) { if (has_next && wid == 0) __builtin_amdgcn_global_load_lds((const unsigned*)(S.tokptr(nxt) + lane * 16), (LAS unsigned*)(lds + 131072 + ((ui + 1) & 1) * 1024), 16, 0, 0); }
#pragma nounroll
        for (int t = 0; t < nt; t += 2) {
            const bool last = (t == nt - 2);
            const char* a1 = cA + (size_t)(t + 1) * kstep;
            const char* a2 = last ? nA : cA + (size_t)(t + 2) * kstep; const char* b2 = last ? nB : cB + (size_t)(t + 2) * kstep;
            const char* a3 = a2 + kstep; const char* b3 = b2 + kstep;
            unsigned v2h0[2], v2h1[2];
            if constexpr (GATHER) {
                if (last && has_next) {
                    const LAS int* tk = (const LAS int*)(lds + 131072 + ((ui + 1) & 1) * 1024);
#pragma unroll
                    for (int h = 0; h < 2; ++h)
#pragma unroll
                        for (int i = 0; i < 2; ++i) { unsigned tok = (unsigned)tk[h * 128 + gR[i]]; tok = tok > (unsigned)T ? (unsigned)T : tok; vGn[h][i] = tok * (unsigned)PITCH + (unsigned)gC[i] * 2u; }
                }
#pragma unroll
                for (int i = 0; i < 2; ++i) { v2h0[i] = last ? vGn[0][i] : vGc[0][i]; v2h1[i] = last ? vGn[1][i] : vGc[1][i]; }
            } else {
#pragma unroll
                for (int i = 0; i < 2; ++i) { v2h0[i] = voffA[i]; v2h1[i] = voffA[i]; }
            }
            PG8_LDB(B0, 0, 0); PG8_LDB(B1, 0, 1); PG8_SCHED; PG8_LDA(At, 0, 0);
            if constexpr (GATHER) { PG8_STAGE(PG8_SA(1, 1), a1, vGc[1]); } else { PG8_STAGE(PG8_SA(1, 1), a1 + hstep, voffA); }
            PG8_WAIT_V(8); PG8_WAIT_L(0); PG8_BAR; PG8_MMA(0, 0, At, B0); PG8_MMA(0, 1, At, B1); PG8_BAR; PG8_SCHED;
            PG8_LDA(At, 0, 1); PG8_STAGE(PG8_SB(0, 0), b2, voffB); PG8_STAGE(PG8_SB(0, 1), b2 + hstep, voffB); PG8_STAGE(PG8_SA(0, 0), a2, v2h0);
            PG8_WAIT_V(8); PG8_WAIT_L(0); PG8_BAR; PG8_MMA(1, 0, At, B0); PG8_MMA(1, 1, At, B1); PG8_BAR; PG8_SCHED;
            PG8_LDB(B0, 1, 0); PG8_LDB(B1, 1, 1); PG8_SCHED; PG8_LDA(At, 1, 0); PG8_STAGE(PG8_SA(0, 1), a2 + ahstep, v2h1);
            PG8_WAIT_V(8); PG8_WAIT_L(0); PG8_BAR; PG8_MMA(0, 0, At, B0); PG8_MMA(0, 1, At, B1); PG8_BAR; PG8_SCHED;
            PG8_LDA(At, 1, 1); PG8_STAGE(PG8_SB(1, 0), b3, voffB); PG8_STAGE(PG8_SB(1, 1), b3 + hstep, voffB); PG8_STAGE(PG8_SA(1, 0), a3, v2h0);
            PG8_WAIT_V(8); PG8_WAIT_L(0); PG8_BAR; PG8_MMA(1, 0, At, B0); PG8_MMA(1, 1, At, B1); PG8_BAR; PG8_SCHED;
        }
        if (wr == 0) PG8_BAR;
        if constexpr (FP8) asm volatile("s_nop 15\n\ts_nop 7" ::: "memory");
        if constexpr (PRE > 0) E(acc, cur, wr, wc, fr, fq, (const LAS float*)(lds + PRE_LDS + (ui & 1) * 2048)); else E(acc, cur, wr, wc, fr, fq);
        if (!has_next) break;
#pragma unroll
        for (int a = 0; a < 2; ++a)
#pragma unroll
            for (int b = 0; b < 2; ++b)
#pragma unroll
                for (int m = 0; m < 4; ++m)
#pragma unroll
                    for (int n = 0; n < 2; ++n) acc[a][b][m][n] = (f32x4){0.f, 0.f, 0.f, 0.f};
        cur = nxt; cA = nA; cB = nB; ++ui;
        PG8_PRE(cur, ui & 1);
        if constexpr (GATHER) {
#pragma unroll
            for (int h = 0; h < 2; ++h)
#pragma unroll
                for (int i = 0; i < 2; ++i) vGc[h][i] = vGn[h][i];
        }
        if (wr == 1) PG8_BAR;
    }
    PG8_WAIT_V(0);
    PG8_BAR;
#undef PG8_PRE
#undef PG8_SA
#undef PG8_SB
#undef PG8_STAGE
#undef PG8_LDA
#undef PG8_LDB
#undef PG8_MMA
#undef PG8_WAIT_V
#undef PG8_WAIT_L
#undef PG8_BAR
#undef PG8_SCHED
}
}
using pg8::Unit;

struct SchedProj {
    int G, c; const char *XN, *MEMN, *WIN, *WMEM;
    __device__ __forceinline__ bool next(int i, Unit& u) const {
        const int L = i * G + c;
        if (L < 1408) { u.aux = 0; return pg8::static_order(L, 128, 11, u.pm, u.pn); }
        if (L < 1424) { const int j = L - 1408; u.pm = j >> 1; u.pn = j & 1; u.aux = 1; return true; }
        return false;
    }
    __device__ __forceinline__ const char* aptr(const Unit& u) const { return (u.aux ? MEMN : XN) + (size_t)u.pm * (256 * 2048); }
    __device__ __forceinline__ const char* bptr(const Unit& u) const { return (u.aux ? WMEM : WIN) + (size_t)u.pn * (256 * 2048); }
};
struct SchedProj10 {
    int G, c; const char *XN, *WIN;
    __device__ __forceinline__ bool next(int i, Unit& u) const { int j; u.aux = 0; if (!pg8::static_order(i * G + c, 128, 10, u.pm, j)) return false; u.pn = j < 9 ? j : 10; return true; }
    __device__ __forceinline__ const char* aptr(const Unit& u) const { return XN + (size_t)u.pm * (256 * 2048); }
    __device__ __forceinline__ const char* bptr(const Unit& u) const { return WIN + (size_t)u.pn * (256 * 2048); }
};
struct SchedProjOne {
    int c; const char *XN, *MEMN, *WIN, *WMEM;
    __device__ __forceinline__ bool next(int i, Unit& u) const {
        if (i != 0 || c >= 144) return false;
        if (c < 128) { u.pm = c; u.pn = 9; u.aux = 0; } else { const int j = c - 128; u.pm = j >> 1; u.pn = j & 1; u.aux = 1; }
        return true;
    }
    __device__ __forceinline__ const char* aptr(const Unit& u) const { return (u.aux ? MEMN : XN) + (size_t)u.pm * (256 * 2048); }
    __device__ __forceinline__ const char* bptr(const Unit& u) const { return (u.aux ? WMEM : WIN) + (size_t)u.pn * (256 * 2048); }
};
struct SchedPlain {
    int G, c, nM, nN; const char *A, *B;
    __device__ __forceinline__ bool next(int i, Unit& u) const { u.aux = 0; return pg8::static_order(i * G + c, nM, nN, u.pm, u.pn); }
    __device__ __forceinline__ const char* aptr(const Unit& u) const { return A + (size_t)u.pm * (256 * 2048); }
    __device__ __forceinline__ const char* bptr(const Unit& u) const { return B + (size_t)u.pn * (256 * 2048); }
};
struct SchedPlain8 {
    int G, c, nM, nN; const char *A, *B;
    __device__ __forceinline__ bool next(int i, Unit& u) const { u.aux = 0; return pg8::static_order(i * G + c, nM, nN, u.pm, u.pn); }
    __device__ __forceinline__ const char* aptr(const Unit& u) const { return A + (size_t)u.pm * (256 * 1024); }
    __device__ __forceinline__ const char* bptr(const Unit& u) const { return B + (size_t)u.pn * (256 * 1024); }
};
struct SchedMoe {
    int G, vcu, npn, ntiles; const LAS int* tile_exp; const char *A, *B; size_t bexp;
    __device__ __forceinline__ bool next(int i, Unit& u) const {
        const int L = i * G + vcu, tile = L / npn; if (tile >= ntiles) return false;
        u.pm = tile; u.pn = L - tile * npn; u.aux = __builtin_amdgcn_readfirstlane(tile_exp[tile]); return true;
    }
    __device__ __forceinline__ const char* aptr(const Unit& u) const { return A + (size_t)u.pm * (256 * 1024); }
    __device__ __forceinline__ const char* bptr(const Unit& u) const { return B + (size_t)u.aux * bexp + (size_t)u.pn * (256 * 1024); }
    const int* rowtok; const LAS int* tstart;
    __device__ __forceinline__ const char* abase() const { return A; }
    __device__ __forceinline__ const char* tokptr(const Unit& u) const { return (const char*)(rowtok + (size_t)u.aux * ECAP + (size_t)(u.pm - tstart[u.aux]) * 256); }
};

struct SchedMoeOwn : SchedMoe { int x, c, F;
    __device__ __forceinline__ bool next(int i, Unit& u) const {
        const int L = i * 32 + c; if (L >= (F >> 1)) return false;
        const int j = L >> 2, tile = 32 * (j >> 2) + 4 * x + (j & 3);
        u.pm = tile; u.pn = L & 3; u.aux = __builtin_amdgcn_readfirstlane(tile_exp[tile]); return true; }
};
struct SchedMoeTail : SchedMoe { int cc, stride, F, R4;
    __device__ __forceinline__ bool next(int i, Unit& u) const {
        const int U = cc + i * stride; if (U >= R4) return false;
        const int tile = F + (U >> 2);
        u.pm = tile; u.pn = U & 3; u.aux = __builtin_amdgcn_readfirstlane(tile_exp[tile]); return true; }
};
struct EpiProj {
    unsigned char* ws;
    const float *gq, *gk, *gmq, *gmk;
    __device__ __forceinline__ void operator()(const f32x4 (&acc)[2][2][4][2], const Unit& u, int wr, int wc, int fr, int fq) const {
        int mode = 0; bf16* out; int ld = 256, coff = 0; const float* gain = nullptr; float scale = 1.f; bool kmean = false;
        if (u.aux == 0) {
            switch (u.pn) {
                case 0: case 1: out = (bf16*)(ws + WS_QA); ld = 512; coff = u.pn * 256; mode = 1; gain = gq; scale = C2; break;
                case 2: case 3: out = (bf16*)(ws + WS_KA); ld = 512; coff = (u.pn - 2) * 256; mode = 1; gain = gk; kmean = true; break;
                case 4: case 5: out = (bf16*)(ws + WS_VA); ld = 512; coff = (u.pn - 4) * 256; break;
                case 6: out = (bf16*)(ws + WS_QR); mode = 2; break;
                case 7: out = (bf16*)(ws + WS_KR); mode = 2; scale = 0.125f; break;
                case 8: out = (bf16*)(ws + WS_VR); break;
                case 9: out = (bf16*)(ws + WS_GR); mode = 3; break;
                default: out = (bf16*)(ws + WS_QM); mode = 1; gain = gmq; scale = C2; break;
            }
        } else {
            if (u.pn == 0) { out = (bf16*)(ws + WS_MK); mode = 1; gain = gmk; } else { out = (bf16*)(ws + WS_MV); }
        }
        const int row0 = u.pm * 256 + wr * 64 + fr;
        const int colb = coff + wc * 64 + 8 * fq;
        if (gain == nullptr) gain = gq;
        f32x4 gv[2][2];
#pragma unroll
        for (int bj = 0; bj < 2; ++bj)
#pragma unroll
            for (int n = 0; n < 2; ++n) gv[bj][n] = *(const f32x4*)(gain + bj * 32 + 8 * fq + 4 * n);
        f32x4 ks[2][2];
#pragma unroll
        for (int bj = 0; bj < 2; ++bj)
#pragma unroll
            for (int n = 0; n < 2; ++n) ks[bj][n] = (f32x4){0.f, 0.f, 0.f, 0.f};
#pragma unroll
        for (int ai = 0; ai < 2; ++ai)
#pragma unroll
            for (int m = 0; m < 4; ++m) {
                const int row = row0 + ai * 128 + m * 16;
                f32x4 v[2][2];
#pragma unroll
                for (int bj = 0; bj < 2; ++bj)
#pragma unroll
                    for (int n = 0; n < 2; ++n) v[bj][n] = acc[ai][bj][m][n];
                if (mode == 1) {
                    float ss = 0.f;
#pragma unroll
                    for (int bj = 0; bj < 2; ++bj)
#pragma unroll
                        for (int n = 0; n < 2; ++n) { const f32x4 x = v[bj][n]; ss += (x[0] * x[0] + x[1] * x[1]) + (x[2] * x[2] + x[3] * x[3]); }
                    ss += __shfl_xor(ss, 16); ss += __shfl_xor(ss, 32);
                    const float r = scale / sqrtf(ss * (1.0f / 64.0f) + EPS);
#pragma unroll
                    for (int bj = 0; bj < 2; ++bj)
#pragma unroll
                        for (int n = 0; n < 2; ++n) v[bj][n] = v[bj][n] * r * gv[bj][n];
                } else if (mode == 2) {
                    const float pos = (float)(row & (SEQ - 1));
                    const float lgam = __builtin_amdgcn_logf(1.0f - __builtin_amdgcn_exp2f(-5.0f - (float)wc));
                    const float rsc = scale * __builtin_amdgcn_exp2f(((u.pn == 6) ? lgam : -lgam) * (float)(row & 127));
#pragma unroll
                    for (int n = 0; n < 2; ++n)
#pragma unroll
                        for (int j = 0; j < 4; ++j) {
                            const float fre = __builtin_amdgcn_exp2f((float)(8 * fq + 4 * n + j) * (-13.287712379549449f / 31.0f)) * 0.15915494309189535f;
                            float tt = pos * fre; tt = tt - floorf(tt);
                            const float sn = __builtin_amdgcn_sinf(tt), cs = __builtin_amdgcn_cosf(tt);
                            const float t1 = v[0][n][j], t2 = v[1][n][j];
                            v[0][n][j] = (t1 * cs - t2 * sn) * rsc; v[1][n][j] = (t2 * cs + t1 * sn) * rsc;
                        }
                } else if (mode == 3) {
#pragma unroll
                    for (int bj = 0; bj < 2; ++bj)
#pragma unroll
                        for (int n = 0; n < 2; ++n)
#pragma unroll
                            for (int j = 0; j < 4; ++j) { const float x = v[bj][n][j]; v[bj][n][j] = x / (1.0f + __expf(-x)); }
                }
                if (kmean) {
#pragma unroll
                    for (int bj = 0; bj < 2; ++bj)
#pragma unroll
                        for (int n = 0; n < 2; ++n) ks[bj][n] += v[bj][n];
                }
                bf16* rowp = out + (size_t)row * ld + colb;
#pragma unroll
                for (int bj = 0; bj < 2; ++bj) { u32x4 w; w.x = cvtpk(v[bj][0][0], v[bj][0][1]); w.y = cvtpk(v[bj][0][2], v[bj][0][3]); w.z = cvtpk(v[bj][1][0], v[bj][1][1]); w.w = cvtpk(v[bj][1][2], v[bj][1][3]);
                    *(u32x4*)(rowp + bj * 32) = w; }
            }
        if (kmean) {
            float* kp = (float*)(ws + WS_KMEAN) + ((size_t)u.pm * 8 + (u.pn - 2) * 4 + wc) * 64 + 8 * fq;
#pragma unroll
            for (int bj = 0; bj < 2; ++bj)
#pragma unroll
                for (int n = 0; n < 2; ++n)
#pragma unroll
                    for (int j = 0; j < 4; ++j) {
                        float s = ks[bj][n][j];
                        s += __shfl_xor(s, 1); s += __shfl_xor(s, 2); s += __shfl_xor(s, 4); s += __shfl_xor(s, 8);
                        if (fr == 0) atomicAdd(kp + bj * 32 + 4 * n + j, s * (1.0f / 256.0f));
                    }
        }
    }
};

struct EpiOut {
    const bf16* xn; const float* irs; const float* gattn; bf16* out; float* ssq;
    static constexpr int PRE_KIB = 2;
    __device__ __forceinline__ const char* pre_src(const Unit& u, int k, int lane) const { return (const char*)(k == 0 ? gattn + u.pn * 256 : irs + (size_t)u.pm * 256) + lane * 16; }
    __device__ __forceinline__ void operator()(const f32x4 (&acc)[2][2][4][2], const Unit& u, int wr, int wc, int fr, int fq, const LAS float* pre) const {
        const int row0 = u.pm * 256 + wr * 64 + fr, col0 = u.pn * 256 + wc * 32 + 8 * fq;
        f32x4 ig[2][2];
#pragma unroll
        for (int bj = 0; bj < 2; ++bj)
#pragma unroll
            for (int n = 0; n < 2; ++n) { const f32x4 g = *(const LAS f32x4*)(pre + wc * 32 + 8 * fq + bj * 128 + 4 * n); ig[bj][n] = (f32x4){1.0f / g[0], 1.0f / g[1], 1.0f / g[2], 1.0f / g[3]}; }
#pragma unroll
        for (int ai = 0; ai < 2; ++ai) {
            u32x4 xwv[4][2]; float irv[4];
#pragma unroll
            for (int m = 0; m < 4; ++m) { const int row = row0 + ai * 128 + m * 16; irv[m] = pre[256 + wr * 64 + fr + ai * 128 + m * 16];
#pragma unroll
                for (int bj = 0; bj < 2; ++bj) xwv[m][bj] = *((const u32x4*)(xn + (size_t)row * DM + col0 + bj * 128)); }
#pragma unroll
            for (int m = 0; m < 4; ++m) {
                const int row = row0 + ai * 128 + m * 16; const size_t off = (size_t)row * DM + col0; float ss = 0.f; const float ir = irv[m];
#pragma unroll
                for (int bj = 0; bj < 2; ++bj) {
                    const u32x4 xw = xwv[m][bj];
                    const f32x4 o0 = (f32x4){bflo(xw.x), bfhi(xw.x), bflo(xw.y), bfhi(xw.y)} * ig[bj][0] * ir + acc[ai][bj][m][0] * 0.0078125f, o1 = (f32x4){bflo(xw.z), bfhi(xw.z), bflo(xw.w), bfhi(xw.w)} * ig[bj][1] * ir + acc[ai][bj][m][1] * 0.0078125f;
                    ss += ((o0[0] * o0[0] + o0[1] * o0[1]) + (o0[2] * o0[2] + o0[3] * o0[3])) + ((o1[0] * o1[0] + o1[1] * o1[1]) + (o1[2] * o1[2] + o1[3] * o1[3]));
                    u32x4 w; w.x = cvtpk(o0[0], o0[1]); w.y = cvtpk(o0[2], o0[3]); w.z = cvtpk(o1[0], o1[1]); w.w = cvtpk(o1[2], o1[3]);
                    *(u32x4*)(out + off + bj * 128) = w; }
                ss += __shfl_xor(ss, 16); ss += __shfl_xor(ss, 32);
                if (fq == 0) ssq[(size_t)row * 16 + u.pn * 4 + wc] = ss;
            }
        }
    }
};

struct EpiSwiglu {
    static constexpr int PRE_KIB = 1;
    const float* b1; unsigned char* H;
    __device__ __forceinline__ const char* pre_src(const Unit& u, int k, int lane) const { return (const char*)(b1 + (size_t)u.aux * 2048 + u.pn * 256) + lane * 16; }
    __device__ __forceinline__ void operator()(const f32x4 (&acc)[2][2][4][2], const Unit& u, int wr, int wc, int fr, int fq, const LAS float* pre) const {
        const int row0 = u.pm * 256 + wr * 64 + fr, p0 = u.pn * 128 + wc * 32 + 8 * fq;
        const LAS float* bp = pre + 2 * (wc * 32 + 8 * fq);
        f32x2 bg[4], bl[4];
#pragma unroll
        for (int q = 0; q < 4; ++q) { const f32x4 b = *(const LAS f32x4*)(bp + 4 * q); bg[q] = (f32x2){b[0], b[2]}; bl[q] = (f32x2){b[1], b[3]}; }
#pragma unroll
        for (int ai = 0; ai < 2; ++ai)
#pragma unroll
            for (int m = 0; m < 4; ++m) {
                const int row = row0 + ai * 128 + m * 16;
                float h[8];
#pragma unroll
                for (int q = 0; q < 4; ++q) {
                    const int n = q >> 1, j = (q & 1) * 2;
                    f32x2 g2 = (f32x2){acc[ai][0][m][n][j], acc[ai][0][m][n][j + 1]} + bg[q];
                    g2 = (f32x2){fminf(g2[0], 7.0f), fminf(g2[1], 7.0f)};
                    f32x2 l2 = (f32x2){acc[ai][1][m][n][j], acc[ai][1][m][n][j + 1]} + bl[q];
                    l2 = (f32x2){fminf(fmaxf(l2[0], -7.0f), 7.0f), fminf(fmaxf(l2[1], -7.0f), 7.0f)};
                    const f32x2 t2 = g2 * (f32x2){-1.702f * 1.4426950408889634f, -1.702f * 1.4426950408889634f};
                    const f32x2 d2 = (f32x2){__builtin_amdgcn_exp2f(t2[0]), __builtin_amdgcn_exp2f(t2[1])} + (f32x2){1.0f, 1.0f};
                    const f32x2 gr = g2 * (f32x2){__builtin_amdgcn_rcpf(d2[0]), __builtin_amdgcn_rcpf(d2[1])};
                    const f32x2 h2 = __builtin_elementwise_fma(gr, l2, gr);
                    h[2 * q] = h2[0]; h[2 * q + 1] = h2[1];
                }
                int w0 = 0, w1 = 0;
                w0 = __builtin_amdgcn_cvt_pk_fp8_f32(h[0], h[1], w0, false); w0 = __builtin_amdgcn_cvt_pk_fp8_f32(h[2], h[3], w0, true);
                w1 = __builtin_amdgcn_cvt_pk_fp8_f32(h[4], h[5], w1, false); w1 = __builtin_amdgcn_cvt_pk_fp8_f32(h[6], h[7], w1, true);
                __builtin_nontemporal_store((u32x2){(unsigned)w0, (unsigned)w1}, (u32x2*)(H + (size_t)row * 1024 + p0));
            }
    }
};

struct EpiDown {
    static constexpr int PRE_KIB = 2;
    const float* b2; const float* roww; unsigned char* YE; const LAS int* tstart;
    __device__ __forceinline__ const char* pre_src(const Unit& u, int k, int lane) const {
        return (const char*)(k == 0 ? b2 + (size_t)u.aux * 1024 + u.pn * 256 : roww + (size_t)u.aux * ECAP + (size_t)(u.pm - tstart[u.aux]) * 256) + lane * 16; }
    __device__ __forceinline__ void operator()(const f32x4 (&acc)[2][2][4][2], const Unit& u, int wr, int wc, int fr, int fq, const LAS float* pre) const {
        const int row0 = u.pm * 256 + wr * 64 + fr, c0 = u.pn * 256 + wc * 32 + 8 * fq;
        const LAS float* bp = pre + wc * 32 + 8 * fq;
        f32x4 bv[2][2];
#pragma unroll
        for (int bj = 0; bj < 2; ++bj)
#pragma unroll
            for (int n = 0; n < 2; ++n) bv[bj][n] = *(const LAS f32x4*)(bp + bj * 128 + 4 * n);
        float w8v[2][4];
#pragma unroll
        for (int ai = 0; ai < 2; ++ai)
#pragma unroll
            for (int m = 0; m < 4; ++m) w8v[ai][m] = pre[256 + wr * 64 + fr + ai * 128 + m * 16] * 16.0f;
#pragma unroll
        for (int ai = 0; ai < 2; ++ai)
#pragma unroll
            for (int m = 0; m < 4; ++m) {
                const int row = row0 + ai * 128 + m * 16; const float w8 = w8v[ai][m];
                unsigned wq[4];
#pragma unroll
                for (int bj = 0; bj < 2; ++bj) {
                    const f32x4 y0 = (acc[ai][bj][m][0] * 0.03125f + bv[bj][0]) * w8, y1 = (acc[ai][bj][m][1] * 0.03125f + bv[bj][1]) * w8;
                    int w0 = 0, w1 = 0;
                    w0 = __builtin_amdgcn_cvt_pk_fp8_f32(y0[0], y0[1], w0, false); w0 = __builtin_amdgcn_cvt_pk_fp8_f32(y0[2], y0[3], w0, true);
                    w1 = __builtin_amdgcn_cvt_pk_fp8_f32(y1[0], y1[1], w1, false); w1 = __builtin_amdgcn_cvt_pk_fp8_f32(y1[2], y1[3], w1, true);
                    wq[2 * bj] = (unsigned)w0; wq[2 * bj + 1] = (unsigned)w1;
                }
                *(u32x4*)(YE + (size_t)row * 1024 + u.pn * 256 + wc * 64 + fq * 16) = (u32x4){wq[0], wq[1], wq[2], wq[3]};
            }
    }
};

__device__ __forceinline__ void transpose_item(const float* W, int N, bf16* WT, int drow0, LAS float* scr, int k0, int n0, int lane) {
    float ld_[32];
#pragma unroll
    for (int i = 0; i < 32; ++i) { const int kk = 2 * i + (lane >> 5); ld_[i] = __builtin_nontemporal_load(W + (size_t)(k0 + kk) * N + n0 + (lane & 31)); }
#pragma unroll
    for (int i = 0; i < 32; ++i) { const int kk = 2 * i + (lane >> 5); scr[kk * 33 + (lane & 31)] = ld_[i]; }
    LDS_WAIT(); asm volatile("" ::: "memory");
    const int c = lane & 7;
#pragma unroll
    for (int j = 0; j < 4; ++j) { const int n = (lane >> 3) + 8 * j; const LAS float* s = scr + (8 * c) * 33 + n;
        u32x4 o; o.x = cvtpk(s[0 * 33], s[1 * 33]); o.y = cvtpk(s[2 * 33], s[3 * 33]); o.z = cvtpk(s[4 * 33], s[5 * 33]); o.w = cvtpk(s[6 * 33], s[7 * 33]);
        *(u32x4*)(WT + (size_t)(drow0 + n) * 1024 + k0 + 8 * c) = o; }
    LDS_WAIT(); asm volatile("" ::: "memory");
}
template <bool GLU>
__device__ __forceinline__ void transpose_item_fp8(const float* W, int N, unsigned char* W8, LAS float* scr, int k0, int n0, int lane) {
    float ld_[32];
#pragma unroll
    for (int i = 0; i < 32; ++i) { const int kk = 2 * i + (lane >> 5); ld_[i] = __builtin_nontemporal_load(W + (size_t)(k0 + kk) * N + n0 + (lane & 31)); }
#pragma unroll
    for (int i = 0; i < 32; ++i) { const int kk = 2 * i + (lane >> 5); scr[kk * 33 + (lane & 31)] = ld_[i]; }
    LDS_WAIT(); asm volatile("" ::: "memory");
    const int c = lane & 3;
#pragma unroll
    for (int j = 0; j < 2; ++j) { const int n = (lane >> 2) + 16 * j; const LAS float* s = scr + (16 * c) * 33 + n;
        int w[4];
#pragma unroll
        for (int q = 0; q < 4; ++q) { int t = 0; t = __builtin_amdgcn_cvt_pk_fp8_f32(s[(4 * q) * 33] * 32.0f, s[(4 * q + 1) * 33] * 32.0f, t, false); t = __builtin_amdgcn_cvt_pk_fp8_f32(s[(4 * q + 2) * 33] * 32.0f, s[(4 * q + 3) * 33] * 32.0f, t, true); w[q] = t; }
        const int col = n0 + n; const int p = col >> 1;
        const int drow = GLU ? ((p >> 7) * 256 + (col & 1) * 128 + (p & 127)) : col;
        *(u32x4*)(W8 + (size_t)drow * 1024 + k0 + 16 * c) = (u32x4){(unsigned)w[0], (unsigned)w[1], (unsigned)w[2], (unsigned)w[3]}; }
    LDS_WAIT(); asm volatile("" ::: "memory");
}
struct ConvItem { const float* W; unsigned char* W8; int N, k0, n0; bool glu; };
__device__ __forceinline__ ConvItem conv_decode(int it, const float* w1, const float* w2, unsigned char* W1_8, unsigned char* W2_8) {
    ConvItem c;
    if (it < 32768) { const int e = it >> 10, rr = it & 1023, nb = rr & 63, kb = rr >> 6; c.W = w1 + (size_t)e * 1024 * 2048; c.W8 = W1_8 + (size_t)e * 2048 * 1024; c.N = 2048; c.k0 = kb * 64; c.n0 = nb * 32; c.glu = true; }
    else { const int r = it - 32768, e = r >> 9, rr = r & 511, nb = rr & 31, kb = rr >> 5; c.W = w2 + (size_t)e * 1024 * 1024; c.W8 = W2_8 + (size_t)e * 1024 * 1024; c.N = 1024; c.k0 = kb * 64; c.n0 = nb * 32; c.glu = false; }
    return c;
}
__device__ __forceinline__ void conv_load(const ConvItem& c, f32x4 (&r)[8], int lane) {
    const float* base = c.W + (size_t)c.k0 * c.N + c.n0;
    const int lo = (lane >> 3) * c.N + (lane & 7) * 4;
#pragma unroll
    for (int i = 0; i < 8; ++i) r[i] = __builtin_nontemporal_load((const f32x4*)(base + (size_t)(8 * i) * c.N + lo));
}
__device__ __forceinline__ void conv_finish(const ConvItem& c, const f32x4 (&r)[8], LAS float* scr, int lane) {
#pragma unroll
    for (int i = 0; i < 8; ++i) *(LAS f32x4*)(scr + (8 * i + (lane >> 3)) * 36 + (lane & 7) * 4) = r[i];
    LDS_WAIT(); asm volatile("" ::: "memory");
    if (c.glu) {
        const int n = lane & 31, half = lane >> 5; const LAS float* s = scr + (32 * half) * 36 + n;
        float v[32];
#pragma unroll
        for (int i = 0; i < 32; ++i) v[i] = s[i * 36];
        u32x4 p0, p1; fp6_pack32(v, p0, p1);
        const int col = c.n0 + n; const int p = col >> 1;
        const int drow = (p >> 7) * 256 + (col & 1) * 128 + (p & 127);
        unsigned char* dst = c.W8 + (size_t)drow * 1024 + (c.k0 >> 7) * 128 + 16 * (((c.k0 & 127) >> 5) + half);
        *(u32x4*)dst = p0; *(u32x4*)(dst + 64) = p1;
        LDS_WAIT(); asm volatile("" ::: "memory");
        return;
    }
    const int cc = lane & 3;
#pragma unroll
    for (int j = 0; j < 2; ++j) { const int n = (lane >> 2) + 16 * j; const LAS float* s = scr + (16 * cc) * 36 + n;
        int w[4];
#pragma unroll
        for (int q = 0; q < 4; ++q) { int t = 0; t = __builtin_amdgcn_cvt_pk_fp8_f32(s[(4 * q) * 36] * 32.0f, s[(4 * q + 1) * 36] * 32.0f, t, false); t = __builtin_amdgcn_cvt_pk_fp8_f32(s[(4 * q + 2) * 36] * 32.0f, s[(4 * q + 3) * 36] * 32.0f, t, true); w[q] = t; }
        const int col = c.n0 + n; const int p = col >> 1;
        const int drow = c.glu ? ((p >> 7) * 256 + (col & 1) * 128 + (p & 127)) : col;
        *(u32x4*)(c.W8 + (size_t)drow * 1024 + c.k0 + 16 * cc) = (u32x4){(unsigned)w[0], (unsigned)w[1], (unsigned)w[2], (unsigned)w[3]}; }
    LDS_WAIT(); asm volatile("" ::: "memory");
}
__device__ __forceinline__ void convert_chunk(int chunk, const float* w1, const float* w2, unsigned char* W1_8, unsigned char* W2_8, LAS float* scr, int wave, int lane) {
    const int base = chunk * 32 + wave;
    f32x4 ra[8], rb[8];
    ConvItem ca = conv_decode(base, w1, w2, W1_8, W2_8), cb;
    conv_load(ca, ra, lane);
#pragma unroll 1
    for (int j = 0; j < 4; j += 2) {
        cb = conv_decode(base + 8 * (j + 1), w1, w2, W1_8, W2_8); conv_load(cb, rb, lane);
        conv_finish(ca, ra, scr, lane);
        if (j + 2 < 4) { ca = conv_decode(base + 8 * (j + 2), w1, w2, W1_8, W2_8); conv_load(ca, ra, lane); }
        conv_finish(cb, rb, scr, lane);
    }
}
__device__ __forceinline__ int headperm_row(int n0) { const int pn = n0 >> 8, c = n0 & 255, hh = c >> 6, dh = (c & 63) >> 5; return pn * 256 + dh * 128 + hh * 32; }
__device__ __forceinline__ void rms_row_to_bf16(const float* xrow, const float* gain, bf16* orow, int lane) {
    const f32x4* xr = (const f32x4*)xrow + lane; const f32x4* gr = (const f32x4*)gain + lane;
    f32x4 v[4]; float s = 0.f;
#pragma unroll
    for (int j = 0; j < 4; ++j) { v[j] = xr[64 * j]; s += (v[j].x * v[j].x + v[j].y * v[j].y) + (v[j].z * v[j].z + v[j].w * v[j].w); }
    const float rstd = 1.0f / sqrtf(wave_sum(s) * (1.f / DM) + EPS);
    u32x2* o8 = (u32x2*)orow + lane;
#pragma unroll
    for (int j = 0; j < 4; ++j) { const f32x4 gg = gr[64 * j]; u32x2 w; w.x = cvtpk(v[j].x * rstd * gg.x, v[j].y * rstd * gg.y); w.y = cvtpk(v[j].z * rstd * gg.z, v[j].w * rstd * gg.w); o8[64 * j] = w; }
}

__device__ __forceinline__ void rms_row2_to_bf16(const float* xrow, const float* gain, bf16* orow, int lane, float* irs) {
    const f32x4* xr = (const f32x4*)xrow + lane; const f32x4* gr = (const f32x4*)gain + lane;
    f32x4 v[8]; float s0 = 0.f, s1 = 0.f;
#pragma unroll
    for (int j = 0; j < 8; ++j) v[j] = __builtin_nontemporal_load(xr + 64 * j);
#pragma unroll
    for (int j = 0; j < 4; ++j) { s0 += (v[j].x * v[j].x + v[j].y * v[j].y) + (v[j].z * v[j].z + v[j].w * v[j].w); s1 += (v[4 + j].x * v[4 + j].x + v[4 + j].y * v[4 + j].y) + (v[4 + j].z * v[4 + j].z + v[4 + j].w * v[4 + j].w); }
    const float q0 = sqrtf(wave_sum(s0) * (1.f / DM) + EPS), q1 = sqrtf(wave_sum(s1) * (1.f / DM) + EPS); const float r0 = 1.0f / q0, r1 = 1.0f / q1;
    if (irs != nullptr && lane == 0) { irs[0] = q0; irs[1] = q1; }
    const bool odd = (lane & 1) != 0;
#pragma unroll
    for (int p2 = 0; p2 < 2; ++p2) {
        const int a = 2 * p2, b = a + 1; const f32x4 ga = gr[64 * a], gb = gr[64 * b];
        u32x4* o16 = (u32x4*)(orow + (odd ? 256 * b + 4 * (lane - 1) : 256 * a + 4 * lane));
#pragma unroll
        for (int r = 0; r < 2; ++r) {
            const float rr = r ? r1 : r0; const f32x4 va = v[4 * r + a], vb = v[4 * r + b];
            const unsigned wa0 = cvtpk(va.x * rr * ga.x, va.y * rr * ga.y), wa1 = cvtpk(va.z * rr * ga.z, va.w * rr * ga.w);
            const unsigned wb0 = cvtpk(vb.x * rr * gb.x, vb.y * rr * gb.y), wb1 = cvtpk(vb.z * rr * gb.z, vb.w * rr * gb.w);
            const unsigned s0_ = odd ? wa0 : wb0, s1_ = odd ? wa1 : wb1;
            const unsigned q0_ = (unsigned)__builtin_amdgcn_update_dpp(0, (int)s0_, 0xB1, 0xF, 0xF, true), q1_ = (unsigned)__builtin_amdgcn_update_dpp(0, (int)s1_, 0xB1, 0xF, 0xF, true);
            u32x4 w; w.x = odd ? q0_ : wa0; w.y = odd ? q1_ : wa1; w.z = odd ? wb0 : q0_; w.w = odd ? wb1 : q1_;
            o16[r * (DM / 8)] = w;
        }
    }
}

#include <hip/hip_bf16.h>
namespace attn_body {
using s16x4=__attribute__((ext_vector_type(4)))short;
using f32x16=__attribute__((ext_vector_type(16)))float;
constexpr int D=64,NW=8,QBLK=32,QB=QBLK*NW,KVBLK=64;
__device__ __forceinline__ int crow(int r,int hi){return (r&3)+8*(r>>2)+4*hi;}
#define SBAR() __builtin_amdgcn_sched_barrier(0)
__device__ __forceinline__ void cmask(f32x16&p0,f32x16&p1,int jb,int qrel,int hi){
  const float NEG=-INFINITY; int kb=64*jb+4*hi;
  #pragma unroll
  for(int r=0;r<16;++r){int kv=kb+(r&3)+8*(r>>2); if(kv>qrel)p0[r]=NEG; if(kv+32>qrel)p1[r]=NEG;}
}
constexpr int NSLOT=3, SLOTB=8192;
constexpr int LDS_K=0, LDS_V=NSLOT*SLOTB, LDS_WS=2*NSLOT*SLOTB, LDS_OST=LDS_WS+NW*64*4, ATT_LDS_BYTES=LDS_OST+NW*4096;
__device__ __forceinline__ void glds16(const void*gsrc,unsigned lds_dst){unsigned keep;
  asm volatile("s_mov_b32 %0, m0\n\ts_mov_b32 m0, %2\n\ts_nop 0\n\tglobal_load_lds_dwordx4 %1, off\n\ts_mov_b32 m0, %0":"=&s"(keep):"v"(gsrc),"s"(lds_dst):"memory");}
__device__ __forceinline__ float max3f(float a,float b,float c){float r;asm("v_max3_f32 %0, %1, %2, %3":"=v"(r):"v"(a),"v"(b),"v"(c));return r;}
__device__ __forceinline__ float max2f(float a,float b){float r;asm("v_max_f32_e32 %0, %1, %2":"=v"(r):"v"(a),"v"(b));return r;}
__device__ __forceinline__ float fadd_s(float a,float b){float r;asm("v_add_f32_e32 %0, %1, %2":"=v"(r):"v"(a),"v"(b));return r;}
__device__ __forceinline__ float fsub_s(float a,float b){float r;asm("v_sub_f32_e32 %0, %1, %2":"=v"(r):"v"(a),"v"(b));return r;}
__device__ __forceinline__ unsigned cvtpk_s(float lo,float hi){return cvtpk(lo,hi);}
#define WAIT_BAR(N) asm volatile("s_waitcnt vmcnt(" #N ") lgkmcnt(0)\n\ts_barrier":::"memory")
__device__ __forceinline__ void qkt(f32x16&p0,f32x16&p1,const char*Kslot,const bf16x8*qr,const f32x16&negm,int r32,int hi){
  const char*kb=Kslot+hi*1024+r32*16;
  #pragma unroll
  for(int d0=0;d0<4;++d0){
    const bf16x8 b0=*reinterpret_cast<const bf16x8*>(kb+d0*2048);
    const bf16x8 b1=*reinterpret_cast<const bf16x8*>(kb+d0*2048+512);
    if(d0==0){p0=__builtin_amdgcn_mfma_f32_32x32x16_bf16(b0,qr[0],negm,0,0,0);p1=__builtin_amdgcn_mfma_f32_32x32x16_bf16(b1,qr[0],negm,0,0,0);}
    else{p0=__builtin_amdgcn_mfma_f32_32x32x16_bf16(b0,qr[d0],p0,0,0,0);p1=__builtin_amdgcn_mfma_f32_32x32x16_bf16(b1,qr[d0],p1,0,0,0);}}
}
typedef __attribute__((address_space(3))) const char* lds_cptr;
typedef short v4i16_t __attribute__((ext_vector_type(4)));
__device__ __forceinline__ void kload8(bf16x8*kf,lds_cptr kp){
  kf[0]=*(const __attribute__((address_space(3))) bf16x8*)(kp);      kf[1]=*(const __attribute__((address_space(3))) bf16x8*)(kp+512);
  kf[2]=*(const __attribute__((address_space(3))) bf16x8*)(kp+2048); kf[3]=*(const __attribute__((address_space(3))) bf16x8*)(kp+2560);
  kf[4]=*(const __attribute__((address_space(3))) bf16x8*)(kp+4096); kf[5]=*(const __attribute__((address_space(3))) bf16x8*)(kp+4608);
  kf[6]=*(const __attribute__((address_space(3))) bf16x8*)(kp+6144); kf[7]=*(const __attribute__((address_space(3))) bf16x8*)(kp+6656);
}
__device__ __forceinline__ void kload2(bf16x8*kf,lds_cptr kp,int j){ kf[2*j]=*(const __attribute__((address_space(3))) bf16x8*)(kp+j*2048); kf[2*j+1]=*(const __attribute__((address_space(3))) bf16x8*)(kp+j*2048+512); }
__device__ __forceinline__ s16x4 vtr(lds_cptr p){ return __builtin_bit_cast(s16x4,__builtin_amdgcn_ds_read_tr16_b64_v4i16((__attribute__((address_space(3))) v4i16_t*)p)); }
__device__ __forceinline__ float rowmax(const f32x16&p0,const f32x16&p1){
  float a=max3f(p0[0],p0[1],p1[0]),b=max3f(p0[2],p0[3],p1[1]);a=max3f(a,p1[2],p1[3]);
  #pragma unroll
  for(int r=4;r<16;r+=4){a=max3f(a,p0[r],p0[r+1]);b=max3f(b,p0[r+2],p0[r+3]);a=max3f(a,p1[r],p1[r+1]);b=max3f(b,p1[r+2],p1[r+3]);}
  const float m=max2f(a,b);
  auto rr=__builtin_amdgcn_permlane32_swap(__float_as_uint(m),__float_as_uint(m),false,false);
  return max2f(__uint_as_float(rr[0]),__uint_as_float(rr[1]));
}
__device__ __forceinline__ void pv(f32x16*o,int vb,bf16x8 pa0,bf16x8 pa1,bf16x8 pa2,bf16x8 pa3){
  #pragma unroll
  for(int d0=0;d0<2;++d0){s16x4 lo[4],hi[4];
    #pragma unroll
    for(int ks=0;ks<4;++ks){
      asm volatile("ds_read_b64_tr_b16 %0,%1 offset:%c2":"=&v"(lo[ks]):"v"(vb),"i"(d0*4096+ks*1024):"memory");
      asm volatile("ds_read_b64_tr_b16 %0,%1 offset:%c2":"=&v"(hi[ks]):"v"(vb),"i"(d0*4096+ks*1024+512):"memory");}
    asm volatile("s_waitcnt lgkmcnt(0)":::"memory");SBAR();
    #define PK(k) (bf16x8){lo[k][0],lo[k][1],lo[k][2],lo[k][3],hi[k][0],hi[k][1],hi[k][2],hi[k][3]}
    o[d0]=__builtin_amdgcn_mfma_f32_32x32x16_bf16(pa0,PK(0),o[d0],0,0,0);
    o[d0]=__builtin_amdgcn_mfma_f32_32x32x16_bf16(pa1,PK(1),o[d0],0,0,0);
    o[d0]=__builtin_amdgcn_mfma_f32_32x32x16_bf16(pa2,PK(2),o[d0],0,0,0);
    o[d0]=__builtin_amdgcn_mfma_f32_32x32x16_bf16(pa3,PK(3),o[d0],0,0,0);
    #undef PK
  }
}
template<int THRL,int KP,int OP,bool MOBA> __device__ __forceinline__ void attn_unit(const bf16*Qu,const bf16*__restrict__ Kh,const bf16*__restrict__ Vh,unsigned char*Ou,const int NT,const int nblk,const float*kmean,char*shm){
  const int tid=opaque((int)threadIdx.x),lane=tid&63,r32=lane&31,hi=lane>>5; const int wid=__builtin_amdgcn_readfirstlane(tid>>6);
  const bf16*Qw=Qu+(long)(wid*QBLK)*KP;
  const unsigned lds0=(unsigned)(uintptr_t)shm;
  float*wsf=(float*)(shm+LDS_WS)+wid*64;
  const bf16*ksrc=Kh+(long)lane*KP+wid*8;
  const bf16*vsrc=Vh+(long)(16*(wid&3)+(lane>>2))*KP+(wid>>2)*32+(lane&3)*8;
  const unsigned kdst=lds0+LDS_K+wid*1024, vdst=lds0+LDS_V+wid*1024;
  #define DMA_K(t,slot) glds16(ksrc+(long)(t)*KVBLK*KP,(unsigned)__builtin_amdgcn_readfirstlane(kdst+(slot)))
  #define DMA_V(t,slot) glds16(vsrc+(long)(t)*KVBLK*KP,(unsigned)__builtin_amdgcn_readfirstlane(vdst+(slot)))
  const int vb0=(int)(lds0+LDS_V)+((lane>>4)&1)*32+(lane&3)*8+(4*hi+((lane&15)>>2))*64;
  const char*Kbase=shm+LDS_K; bf16x8 kf[8];
  const lds_cptr shm3=(lds_cptr)shm; const lds_cptr kp0=shm3+LDS_K+hi*1024+r32*16; const lds_cptr vp0=shm3+LDS_V+((lane>>4)&1)*32+(lane&3)*8+(4*hi+((lane&15)>>2))*64;
  if(MOBA){ if(wid<4) glds16(kmean+(long)(4*wid+(lane>>4))*512+(lane&15)*4,(unsigned)__builtin_amdgcn_readfirstlane(lds0+ATT_LDS_BYTES+wid*1024)); }
  DMA_K(0,0);DMA_V(0,0);DMA_K(1,SLOTB);
  bf16x8 qr[4];
  #pragma unroll
  for(int d0=0;d0<4;++d0)qr[d0]=*reinterpret_cast<const bf16x8*>(&Qw[(long)r32*KP+d0*16+hi*8]);
  unsigned bmask=0xffffffffu;
  if(MOBA){
    bmask=1u<<nblk;
    float g0=-3e38f,g1=-3e38f,g2=-3e38f; int i0=-1,i1=-1,i2=-1;
    asm volatile("s_waitcnt vmcnt(0)\n\ts_barrier":::"memory");
    const __attribute__((address_space(3))) float*kml=(const __attribute__((address_space(3))) float*)(shm3+ATT_LDS_BYTES)+8*hi;
    for(int j=0;j<nblk;++j){
      const __attribute__((address_space(3))) float*km=kml+j*64; float g=0.f;
      #pragma unroll
      for(int d0=0;d0<4;++d0){ const f32x4 a=*(const __attribute__((address_space(3))) f32x4*)(km+16*d0),b=*(const __attribute__((address_space(3))) f32x4*)(km+16*d0+4);
        g+=bf2f((unsigned short)qr[d0][0])*a[0]+bf2f((unsigned short)qr[d0][1])*a[1]+bf2f((unsigned short)qr[d0][2])*a[2]+bf2f((unsigned short)qr[d0][3])*a[3];
        g+=bf2f((unsigned short)qr[d0][4])*b[0]+bf2f((unsigned short)qr[d0][5])*b[1]+bf2f((unsigned short)qr[d0][6])*b[2]+bf2f((unsigned short)qr[d0][7])*b[3]; }
      g+=__shfl_xor(g,32);
      if(g>g0){g2=g1;i2=i1;g1=g0;i1=i0;g0=g;i0=j;} else if(g>g1){g2=g1;i2=i1;g1=g;i1=j;} else if(g>g2){g2=g;i2=j;}
    }
    if(i0>=0)bmask|=1u<<i0; if(i1>=0)bmask|=1u<<i1; if(i2>=0)bmask|=1u<<i2;
  }
  #define NEGM_FOR(t) (MOBA ? (((bmask>>((t)>>2))&1u) ? -mhat : -INFINITY) : -mhat)
  float mhat=0.f,l_reg=0.f;f32x16 o[2];o[0]=f32x16{};o[1]=f32x16{};f32x16 negm;
  { const float nm=NEGM_FOR(0);
    #pragma unroll
    for(int r=0;r<16;++r)negm[r]=nm; }
  asm volatile("":"+v"(negm));
  const int qrel=wid*QBLK+r32;
  #define CMASK(P0,P1,t) do{ if(MOBA){int jb_=(t)-(NT-4); if(jb_>=0)cmask(P0,P1,jb_,qrel,hi);} }while(0)
  bool resc=false;
  #define START(P0,P1) do{ const float rm=rowmax(P0,P1); resc=false; \
    { const float dl=(MOBA&&rm==-INFINITY)?0.f:rm; mhat=fadd_s(mhat,dl); \
      _Pragma("unroll") for(int r=0;r<16;++r){P0[r]=fsub_s(P0[r],dl);P1[r]=fsub_s(P1[r],dl);} \
      { const float nm=NEGM_FOR(1); _Pragma("unroll") for(int r=0;r<16;++r)negm[r]=nm; } asm volatile("":"+v"(negm)); } \
    _Pragma("unroll") for(int r=0;r<16;++r)P0[r]=__builtin_amdgcn_exp2f(P0[r]); }while(0)
  #define RESC() do{ if(resc){ asm volatile("s_waitcnt lgkmcnt(0)":::"memory"); \
      _Pragma("unroll") for(int d_=0;d_<2;++d_) _Pragma("unroll") for(int r=0;r<16;++r)o[d_][r]*=wsf[crow(r,hi)]; } }while(0)
  f32x16 pA0,pA1,pB0,pB1;
  int sl_prev=0,sl_cur=0,sl_next=SLOTB;
  #define ROT() do{sl_prev=sl_cur;sl_cur=sl_next;sl_next=(sl_next==(NSLOT-1)*SLOTB)?0:sl_next+SLOTB;}while(0)
  DMA_K(2,2*SLOTB);
  WAIT_BAR(3);
  qkt(pA0,pA1,Kbase,qr,negm,r32,hi);asm volatile("s_nop 15\n\ts_nop 7":"+v"(pA0),"+v"(pA1));CMASK(pA0,pA1,0);
  START(pA0,pA1);
  _Pragma("unroll") for(int r=0;r<16;++r)pA1[r]=__builtin_amdgcn_exp2f(pA1[r]);
  WAIT_BAR(0);
  DMA_K(3,0);DMA_V(1,SLOTB);
  ROT();
  kload8(kf,kp0+sl_cur);
  WAIT_BAR(2);
  s16x4 vlo[8],vhi[8]; u32x4 pw0,pw1,pw2,pw3;
  #define PKW(P,B) cvtpk_s(P[B],P[B+1])
  #define PAF(k) __builtin_bit_cast(bf16x8,pw##k)
  #define VFR(i) (bf16x8){vlo[i][0],vlo[i][1],vlo[i][2],vlo[i][3],vhi[i][0],vhi[i][1],vhi[i][2],vhi[i][3]}
  #define PIN(x) asm volatile("":"+v"(x))
  #define MX3(a,b,c) __builtin_fmaxf(__builtin_fmaxf((a),(b)),(c))
  #define GAPA(MF,A0,A1,A2,A3,W0,W1,PW) do{ MF; sacc+=A0; sacc+=A1; sacc+=A2; sacc+=A3; PIN(sacc); W0; W1; PIN(PW); SBAR(); }while(0)
  #define EX(v) __builtin_amdgcn_exp2f(v)
  #define GAPB(MF,X,B) do{ MF; X[B]=EX(X[B]); X[B+1]=EX(X[B+1]); X[B+2]=EX(X[B+2]); X[B+3]=EX(X[B+3]); PIN(X); SBAR(); }while(0)
  #define VRD(i) do{ vlo[i]=vtr(vp_+(((i)>>2)*4096+((i)&3)*1024)); vhi[i]=vtr(vp_+(((i)>>2)*4096+((i)&3)*1024+512)); }while(0)
  #define KRD(G,j) do{ if(G){ kload2(kf,kp0+sl_next,j); SBAR(); } }while(0)
  #define STEP(C0,C1,P0,P1,t,GK,GV,GL) do{ SBAR(); \
    const lds_cptr vp_=vp0+sl_prev; \
    VRD(0); SBAR(); float sacc=(P0[0]+P0[1]); \
    GAPA(C0=__builtin_amdgcn_mfma_f32_32x32x16_bf16(kf[0],qr[0],negm,0,0,0), P0[2],P0[3],P0[4],P0[5],     pw0[0]=PKW(P0,0), pw0[1]=PKW(P0,2), pw0); \
    VRD(4); SBAR(); GAPA(C1=__builtin_amdgcn_mfma_f32_32x32x16_bf16(kf[1],qr[0],negm,0,0,0), P0[6],P0[7],P0[8],P0[9],     pw0[2]=PKW(P0,4), pw0[3]=PKW(P0,6), pw0); \
    VRD(1); SBAR(); GAPA(C0=__builtin_amdgcn_mfma_f32_32x32x16_bf16(kf[2],qr[1],C0,0,0,0),   P0[10],P0[11],P0[12],P0[13], pw1[0]=PKW(P0,8), pw1[1]=PKW(P0,10), pw1); \
    VRD(5); SBAR(); GAPA(C1=__builtin_amdgcn_mfma_f32_32x32x16_bf16(kf[3],qr[1],C1,0,0,0),   P0[14],P0[15],P1[0],P1[1],   pw1[2]=PKW(P0,12),pw1[3]=PKW(P0,14), pw1); \
    VRD(2); SBAR(); GAPA(C0=__builtin_amdgcn_mfma_f32_32x32x16_bf16(kf[4],qr[2],C0,0,0,0),   P1[2],P1[3],P1[4],P1[5],     pw2[0]=PKW(P1,0), pw2[1]=PKW(P1,2), pw2); \
    VRD(6); SBAR(); GAPA(C1=__builtin_amdgcn_mfma_f32_32x32x16_bf16(kf[5],qr[2],C1,0,0,0),   P1[6],P1[7],P1[8],P1[9],     pw2[2]=PKW(P1,4), pw2[3]=PKW(P1,6), pw2); \
    VRD(3); SBAR(); GAPA(C0=__builtin_amdgcn_mfma_f32_32x32x16_bf16(kf[6],qr[3],C0,0,0,0),   P1[10],P1[11],P1[12],P1[13], pw3[0]=PKW(P1,8), pw3[1]=PKW(P1,10), pw3); \
    VRD(7); SBAR(); GAPA(C1=__builtin_amdgcn_mfma_f32_32x32x16_bf16(kf[7],qr[3],C1,0,0,0),   P1[14],P1[15],0.f,0.f,       pw3[2]=PKW(P1,12),pw3[3]=PKW(P1,14), pw3); \
    l_reg+=sacc; \
    if(GK){DMA_K((t)+3,sl_cur);} if(GV){DMA_V((t)+1,sl_next);} \
    CMASK(C0,C1,t); \
    { float a=MX3(C0[0],C0[1],C1[0]),b=MX3(C0[2],C0[3],C1[1]); a=MX3(a,C1[2],C1[3]); \
      _Pragma("unroll") for(int r=4;r<16;r+=4){a=MX3(a,C0[r],C0[r+1]);b=MX3(b,C0[r+2],C0[r+3]);a=MX3(a,C1[r],C1[r+1]);b=MX3(b,C1[r+2],C1[r+3]);} \
      float rm=__builtin_fmaxf(a,b); { auto rr=__builtin_amdgcn_permlane32_swap(__float_as_uint(rm),__float_as_uint(rm),false,false); rm=__builtin_fmaxf(__uint_as_float(rr[0]),__uint_as_float(rr[1])); } \
      resc=false; \
      if(__builtin_expect(__any(rm>(float)THRL),0)){ const float dl=__builtin_fmaxf(rm,0.f); mhat+=dl; \
        _Pragma("unroll") for(int r=0;r<16;++r){C0[r]-=dl;C1[r]-=dl;} \
        if(!MOBA){ _Pragma("unroll") for(int r=0;r<16;++r)negm[r]=-mhat; asm volatile("":"+v"(negm)); } \
        const float f=__builtin_amdgcn_exp2f(-dl); l_reg*=f; if(hi==0)wsf[r32]=f; resc=true; } \
      if(MOBA){ if(resc||((((t)+1)&3)==0)){ const float nm=NEGM_FOR((t)+1); _Pragma("unroll") for(int r=0;r<16;++r)negm[r]=nm; asm volatile("":"+v"(negm)); } } } \
    SBAR(); \
    GAPB(o[0]=__builtin_amdgcn_mfma_f32_32x32x16_bf16(PAF(0),VFR(0),o[0],0,0,0), C0,0); \
    GAPB(o[1]=__builtin_amdgcn_mfma_f32_32x32x16_bf16(PAF(0),VFR(4),o[1],0,0,0), C0,4); \
    KRD(GL,0); GAPB(o[0]=__builtin_amdgcn_mfma_f32_32x32x16_bf16(PAF(1),VFR(1),o[0],0,0,0), C0,8); \
    KRD(GL,1); GAPB(o[1]=__builtin_amdgcn_mfma_f32_32x32x16_bf16(PAF(1),VFR(5),o[1],0,0,0), C0,12); \
    KRD(GL,2); GAPB(o[0]=__builtin_amdgcn_mfma_f32_32x32x16_bf16(PAF(2),VFR(2),o[0],0,0,0), C1,0); \
    KRD(GL,3); GAPB(o[1]=__builtin_amdgcn_mfma_f32_32x32x16_bf16(PAF(2),VFR(6),o[1],0,0,0), C1,4); \
    GAPB(o[0]=__builtin_amdgcn_mfma_f32_32x32x16_bf16(PAF(3),VFR(3),o[0],0,0,0), C1,8); \
    GAPB(o[1]=__builtin_amdgcn_mfma_f32_32x32x16_bf16(PAF(3),VFR(7),o[1],0,0,0), C1,12); \
    }while(0)
  int t=1;
  #undef CMASK
  #define CMASK(P0,P1,t) do{}while(0)
  for(;t+5<NT;t+=2){
    STEP(pB0,pB1,pA0,pA1,t,true,true,true);     WAIT_BAR(2); RESC(); ROT();
    STEP(pA0,pA1,pB0,pB1,t+1,true,true,true);   WAIT_BAR(2); RESC(); ROT();
  }
  #undef CMASK
  #define CMASK(P0,P1,t) do{ if(MOBA){int jb_=(t)-(NT-4); if(jb_>=0)cmask(P0,P1,jb_,qrel,hi);} }while(0)
  #define ENDW(tt) do{ if((tt)+3<NT){WAIT_BAR(2);} else if((tt)+2<NT){WAIT_BAR(1);} else {WAIT_BAR(0);} }while(0)
  for(;t+1<NT;t+=2){
    STEP(pB0,pB1,pA0,pA1,t,(t+3<NT),(t+1<NT),(t+1<NT));       ENDW(t);   RESC(); ROT();
    STEP(pA0,pA1,pB0,pB1,t+1,(t+4<NT),(t+2<NT),(t+2<NT));     ENDW(t+1); RESC(); ROT();
  }
  STEP(pB0,pB1,pA0,pA1,NT-1,false,false,false); RESC();
  { float sacc=pB0[0]+pB0[1]; _Pragma("unroll") for(int r=2;r<16;++r)sacc+=pB0[r]; _Pragma("unroll") for(int r=0;r<16;++r)sacc+=pB1[r]; l_reg+=sacc;
    pw0=(u32x4){PKW(pB0,0),PKW(pB0,2),PKW(pB0,4),PKW(pB0,6)};pw1=(u32x4){PKW(pB0,8),PKW(pB0,10),PKW(pB0,12),PKW(pB0,14)};pw2=(u32x4){PKW(pB1,0),PKW(pB1,2),PKW(pB1,4),PKW(pB1,6)};pw3=(u32x4){PKW(pB1,8),PKW(pB1,10),PKW(pB1,12),PKW(pB1,14)};
    SBAR(); pv(o,vb0+sl_cur,PAF(0),PAF(1),PAF(2),PAF(3)); }
  #undef PKW
  #undef PAF
  #undef VFR
  #undef PIN
  #undef MX3
  #undef GAPA
  #undef GAPB
  #undef EX
  #undef VRD
  #undef KRD
  #undef STEP
  #undef ENDW
  {auto rr=__builtin_amdgcn_permlane32_swap(__float_as_uint(l_reg),__float_as_uint(l_reg),false,false);l_reg=__uint_as_float(rr[0])+__uint_as_float(rr[1]);}
  if(hi==0)wsf[32+r32]=l_reg;asm volatile("s_waitcnt lgkmcnt(0)":::"memory");
  float rli[16];
  #pragma unroll
  for(int r=0;r<16;++r)rli[r]=__builtin_amdgcn_rcpf(wsf[32+crow(r,hi)]);
  unsigned char*Ow=Ou+(long)(wid*QBLK)*OP;
  { unsigned char*stg=(unsigned char*)(shm+LDS_OST)+wid*2048;
    #pragma unroll
    for(int r=0;r<16;++r){const int orow=crow(r,hi);
      #pragma unroll
      for(int d0=0;d0<2;++d0){ const float v=__builtin_fminf(__builtin_fmaxf(o[d0][r]*rli[r]*4.0f,-448.f),448.f); stg[orow*64+d0*32+r32]=(unsigned char)(__builtin_amdgcn_cvt_pk_fp8_f32(v,0.f,0,false)&0xff); }}
    asm volatile("s_waitcnt lgkmcnt(0)":::"memory");
    #pragma unroll
    for(int i=0;i<2;++i){const int row=i*16+(lane>>2),ch=lane&3; const u32x4 v=*(const u32x4*)(stg+row*64+ch*16); *(u32x4*)(Ow+(long)row*OP+ch*16)=v;} }
  asm volatile("s_waitcnt lgkmcnt(0)\n\ts_barrier":::"memory");
  #undef DMA_K
  #undef DMA_V
  #undef CMASK
  #undef START
  #undef RESC
  #undef ROT
  #undef NEGM_FOR
}
#undef SBAR
#undef WAIT_BAR
}

namespace ret_body {
using attn_body::s16x4; using attn_body::f32x16; using attn_body::glds16; using attn_body::pv; using attn_body::crow;
constexpr int KVF_BYTES = 64 * 64 * 4;
__device__ __forceinline__ void kv_unit(const bf16* KR, const bf16* VR, float* KVF, int b, int h, int cp, char* shm) {
  const int tid = opaque((int)threadIdx.x), lane = tid & 63, r32 = lane & 31, hi = lane >> 5; const int wid = __builtin_amdgcn_readfirstlane(tid >> 6);
  const unsigned lds0 = (unsigned)(uintptr_t)shm;
  const size_t rowb = (size_t)b * SEQ + (size_t)cp * 256;
  const long voff = (long)(16 * (wid & 3) + (lane >> 2)) * 256 + h * 64 + (wid >> 2) * 32 + (lane & 3) * 8;
#pragma unroll
  for (int c = 0; c < 2; ++c)
#pragma unroll
    for (int tl = 0; tl < 2; ++tl) {
      const size_t r0 = rowb + c * 128 + tl * 64;
      glds16(KR + r0 * 256 + voff, (unsigned)__builtin_amdgcn_readfirstlane(lds0 + ((c * 2 + 0) * 2 + tl) * 8192 + wid * 1024));
      glds16(VR + r0 * 256 + voff, (unsigned)__builtin_amdgcn_readfirstlane(lds0 + ((c * 2 + 1) * 2 + tl) * 8192 + wid * 1024));
    }
  asm volatile("s_waitcnt vmcnt(0) lgkmcnt(0)\n\ts_barrier" ::: "memory");
  const int c = wid >> 2, dkb = (wid >> 1) & 1, dvb = wid & 1;
  const int vb = (int)lds0 + ((lane >> 4) & 1) * 32 + (lane & 3) * 8 + (4 * hi + ((lane & 15) >> 2)) * 64;
  f32x16 acc = f32x16{};
#pragma unroll
  for (int tl = 0; tl < 2; ++tl) {
    s16x4 alo[4], ahi[4], blo[4], bhi[4];
    const int ka = vb + ((c * 2 + 0) * 2 + tl) * 8192 + dkb * 4096, va = vb + ((c * 2 + 1) * 2 + tl) * 8192 + dvb * 4096;
#pragma unroll
    for (int ks = 0; ks < 4; ++ks) {
      asm volatile("ds_read_b64_tr_b16 %0,%1 offset:%c2" : "=&v"(alo[ks]) : "v"(ka), "i"(ks * 1024) : "memory");
      asm volatile("ds_read_b64_tr_b16 %0,%1 offset:%c2" : "=&v"(ahi[ks]) : "v"(ka), "i"(ks * 1024 + 512) : "memory");
      asm volatile("ds_read_b64_tr_b16 %0,%1 offset:%c2" : "=&v"(blo[ks]) : "v"(va), "i"(ks * 1024) : "memory");
      asm volatile("ds_read_b64_tr_b16 %0,%1 offset:%c2" : "=&v"(bhi[ks]) : "v"(va), "i"(ks * 1024 + 512) : "memory");
    }
    asm volatile("s_waitcnt lgkmcnt(0)" ::: "memory"); __builtin_amdgcn_sched_barrier(0);
#pragma unroll
    for (int ks = 0; ks < 4; ++ks) {
      const bf16x8 af = (bf16x8){alo[ks][0], alo[ks][1], alo[ks][2], alo[ks][3], ahi[ks][0], ahi[ks][1], ahi[ks][2], ahi[ks][3]};
      const bf16x8 bfr = (bf16x8){blo[ks][0], blo[ks][1], blo[ks][2], blo[ks][3], bhi[ks][0], bhi[ks][1], bhi[ks][2], bhi[ks][3]};
      acc = __builtin_amdgcn_mfma_f32_32x32x16_bf16(af, bfr, acc, 0, 0, 0);
    }
  }
  const float lgam = __builtin_amdgcn_logf(1.0f - __builtin_amdgcn_exp2f(-5.0f - (float)h));
  const float g127 = __builtin_amdgcn_exp2f(lgam * 127.0f);
  float* outp = KVF + ((size_t)((b * 4 + h) * 32 + cp * 2 + c)) * 4096 + dvb * 32 + r32;
#pragma unroll
  for (int r = 0; r < 16; ++r) outp[(size_t)(dkb * 32 + crow(r, hi)) * 64] = acc[r] * g127;
  asm volatile("s_waitcnt lgkmcnt(0)\n\ts_barrier" ::: "memory");
}

__device__ __forceinline__ void out_unit(const bf16* QR, const bf16* KR, const bf16* VR, const bf16* GR, const float* KVF, const float* rgain, unsigned char* Y, int b, int h, int cp, char* shm) {
  const int tid = opaque((int)threadIdx.x), lane = tid & 63, r32 = lane & 31, hi = lane >> 5; const int wid = __builtin_amdgcn_readfirstlane(tid >> 6);
  const unsigned lds0 = (unsigned)(uintptr_t)shm;
  constexpr int L_K = 0, L_V = 32768, L_S = 65536, L_O = 81920;
  const size_t rowb = (size_t)b * SEQ + (size_t)cp * 256;
  const long koff = (long)lane * 256 + h * 64 + wid * 8;
  const long voff = (long)(16 * (wid & 3) + (lane >> 2)) * 256 + h * 64 + (wid >> 2) * 32 + (lane & 3) * 8;
#pragma unroll
  for (int tl = 0; tl < 4; ++tl) {
    const size_t r0 = rowb + tl * 64;
    glds16(KR + r0 * 256 + koff, (unsigned)__builtin_amdgcn_readfirstlane(lds0 + L_K + tl * 8192 + wid * 1024));
    glds16(VR + r0 * 256 + voff, (unsigned)__builtin_amdgcn_readfirstlane(lds0 + L_V + tl * 8192 + wid * 1024));
  }
  const int c = wid >> 2, wq = wid & 3;
  const bf16* Qw = QR + (rowb + c * 128 + wq * 32 + r32) * 256 + h * 64;
  bf16x8 qr[4]; u32x4 qa[4];
#pragma unroll
  for (int d0 = 0; d0 < 4; ++d0) qr[d0] = *reinterpret_cast<const bf16x8*>(Qw + d0 * 16 + hi * 8);
#pragma unroll
  for (int k = 0; k < 4; ++k) { const u32x2 lo = *(const u32x2*)(Qw + 16 * k + 4 * hi), hi2 = *(const u32x2*)(Qw + 16 * k + 8 + 4 * hi); qa[k] = (u32x4){lo.x, lo.y, hi2.x, hi2.y}; }
  {
    const float lgam = __builtin_amdgcn_logf(1.0f - __builtin_amdgcn_exp2f(-5.0f - (float)h));
    const float lgc = lgam * 128.0f;
    const int n0 = 2 * cp;
    int mlo = n0 - 1 - (int)(34.0f / (-lgc)); if (mlo < 0) mlo = 0;
    const float* kvp = KVF + ((size_t)((b * 4 + h) * 32)) * 4096 + tid * 8;
    const f32x4 an0 = *(const f32x4*)(kvp + (size_t)n0 * 4096), cn0 = *(const f32x4*)(kvp + (size_t)n0 * 4096 + 4);
    f32x4 s0 = {0.f, 0.f, 0.f, 0.f}, s1 = {0.f, 0.f, 0.f, 0.f};
    int m = mlo;
    for (; m + 8 <= n0; m += 8) {
      f32x4 a[8], c4[8];
#pragma unroll
      for (int q = 0; q < 8; ++q) { a[q] = *(const f32x4*)(kvp + (size_t)(m + q) * 4096); c4[q] = *(const f32x4*)(kvp + (size_t)(m + q) * 4096 + 4); }
#pragma unroll
      for (int q = 0; q < 8; ++q) { const float w = __builtin_amdgcn_exp2f(lgc * (float)(n0 - 1 - m - q)); s0 += a[q] * w; s1 += c4[q] * w; }
    }
    for (; m + 4 <= n0; m += 4) {
      f32x4 a[4], c4[4];
#pragma unroll
      for (int q = 0; q < 4; ++q) { a[q] = *(const f32x4*)(kvp + (size_t)(m + q) * 4096); c4[q] = *(const f32x4*)(kvp + (size_t)(m + q) * 4096 + 4); }
#pragma unroll
      for (int q = 0; q < 4; ++q) { const float w = __builtin_amdgcn_exp2f(lgc * (float)(n0 - 1 - m - q)); s0 += a[q] * w; s1 += c4[q] * w; }
    }
    for (; m < n0; ++m) {
      const float w = __builtin_amdgcn_exp2f(lgc * (float)(n0 - 1 - m));
      const f32x4 a = *(const f32x4*)(kvp + (size_t)m * 4096), c4 = *(const f32x4*)(kvp + (size_t)m * 4096 + 4);
      s0 += a * w; s1 += c4 * w;
    }
    const int dk = tid >> 3, dv = 8 * (tid & 7);
    char* sp = shm + L_S + (dv >> 5) * 4096 + dk * 64 + (dv & 31) * 2;
    u32x4 w0; w0.x = cvtpk(s0[0], s0[1]); w0.y = cvtpk(s0[2], s0[3]); w0.z = cvtpk(s1[0], s1[1]); w0.w = cvtpk(s1[2], s1[3]);
    *(u32x4*)sp = w0;
    const float dc = __builtin_amdgcn_exp2f(lgc);
    s0 = s0 * dc + an0; s1 = s1 * dc + cn0;
    u32x4 w1; w1.x = cvtpk(s0[0], s0[1]); w1.y = cvtpk(s0[2], s0[3]); w1.z = cvtpk(s1[0], s1[1]); w1.w = cvtpk(s1[2], s1[3]);
    *(u32x4*)(sp + 8192) = w1;
  }
  asm volatile("s_waitcnt vmcnt(0) lgkmcnt(0)\n\ts_barrier" ::: "memory");
  const int vb = (int)lds0 + ((lane >> 4) & 1) * 32 + (lane & 3) * 8 + (4 * hi + ((lane & 15) >> 2)) * 64;
  f32x16 o[2]; o[0] = f32x16{}; o[1] = f32x16{};
  pv(o, vb + L_S + c * 8192, __builtin_bit_cast(bf16x8, qa[0]), __builtin_bit_cast(bf16x8, qa[1]), __builtin_bit_cast(bf16x8, qa[2]), __builtin_bit_cast(bf16x8, qa[3]));
  { const float gam = 1.0f - __builtin_amdgcn_exp2f(-5.0f - (float)h);
#pragma unroll
    for (int d0 = 0; d0 < 2; ++d0)
#pragma unroll
      for (int r = 0; r < 16; ++r) o[d0][r] *= gam; }
  const f32x16 zero = f32x16{};
  const int irow = wq * 32 + r32;
  for (int tl = 0; tl <= (wq >> 1); ++tl) {
    f32x16 p0, p1;
    attn_body::qkt(p0, p1, shm + L_K + (c * 2 + tl) * 8192, qr, zero, r32, hi);
    asm volatile("s_nop 15\n\ts_nop 7" : "+v"(p0), "+v"(p1));
#pragma unroll
    for (int r = 0; r < 16; ++r) { const int kj = 64 * tl + crow(r, hi); if (kj > irow) p0[r] = 0.f; if (kj + 32 > irow) p1[r] = 0.f; }
    u32x4 pw0, pw1, pw2, pw3;
    pw0 = (u32x4){cvtpk(p0[0], p0[1]), cvtpk(p0[2], p0[3]), cvtpk(p0[4], p0[5]), cvtpk(p0[6], p0[7])}; pw1 = (u32x4){cvtpk(p0[8], p0[9]), cvtpk(p0[10], p0[11]), cvtpk(p0[12], p0[13]), cvtpk(p0[14], p0[15])};
    pw2 = (u32x4){cvtpk(p1[0], p1[1]), cvtpk(p1[2], p1[3]), cvtpk(p1[4], p1[5]), cvtpk(p1[6], p1[7])}; pw3 = (u32x4){cvtpk(p1[8], p1[9]), cvtpk(p1[10], p1[11]), cvtpk(p1[12], p1[13]), cvtpk(p1[14], p1[15])};
    __builtin_amdgcn_sched_barrier(0);
    pv(o, vb + L_V + (c * 2 + tl) * 8192, __builtin_bit_cast(bf16x8, pw0), __builtin_bit_cast(bf16x8, pw1), __builtin_bit_cast(bf16x8, pw2), __builtin_bit_cast(bf16x8, pw3));
  }
  asm volatile("s_waitcnt lgkmcnt(0)\n\ts_barrier" ::: "memory");
  { float* stg = (float*)(shm + L_O) + wid * 2048;
#pragma unroll
    for (int r = 0; r < 16; ++r) { const int orow = crow(r, hi);
#pragma unroll
      for (int d0 = 0; d0 < 2; ++d0) stg[orow * 64 + d0 * 32 + r32] = o[d0][r]; }
    asm volatile("s_waitcnt lgkmcnt(0)" ::: "memory");
    const int row = lane >> 1, half = lane & 1;
    const f32x4* sr = (const f32x4*)(stg + row * 64 + half * 32);
    f32x4 v[8]; float ss = 0.f;
#pragma unroll
    for (int i = 0; i < 8; ++i) { v[i] = sr[i]; ss += (v[i][0] * v[i][0] + v[i][1] * v[i][1]) + (v[i][2] * v[i][2] + v[i][3] * v[i][3]); }
    ss += __shfl_xor(ss, 1);
    const float rstd = 1.0f / sqrtf(ss * (1.0f / 64.0f) + EPS);
    const size_t grow = rowb + c * 128 + wq * 32 + row;
    const u32x4* gp = (const u32x4*)(GR + grow * 256 + h * 64 + half * 32);
    const f32x4* rg = (const f32x4*)(rgain + h * 64 + half * 32);
    u32x4* yp = (u32x4*)(Y + grow * DM + 512 + h * 64 + half * 32);
    unsigned yw8[8];
    u32x4 gwv[4]; f32x4 rgv[8];
#pragma unroll
    for (int i = 0; i < 4; ++i) { gwv[i] = gp[i]; rgv[2 * i] = rg[2 * i]; rgv[2 * i + 1] = rg[2 * i + 1]; }
#pragma unroll
    for (int i = 0; i < 4; ++i) {
      const u32x4 gw = gwv[i]; const f32x4 g0 = rgv[2 * i], g1 = rgv[2 * i + 1]; const f32x4 a = v[2 * i] * rstd * g0, c4 = v[2 * i + 1] * rstd * g1;
#define Y8C(v) __builtin_fminf(__builtin_fmaxf((v) * 4.0f, -448.f), 448.f)
      int t0 = 0, t1 = 0;
      t0 = __builtin_amdgcn_cvt_pk_fp8_f32(Y8C(a[0] * bflo(gw.x)), Y8C(a[1] * bfhi(gw.x)), t0, false); t0 = __builtin_amdgcn_cvt_pk_fp8_f32(Y8C(a[2] * bflo(gw.y)), Y8C(a[3] * bfhi(gw.y)), t0, true);
      t1 = __builtin_amdgcn_cvt_pk_fp8_f32(Y8C(c4[0] * bflo(gw.z)), Y8C(c4[1] * bfhi(gw.z)), t1, false); t1 = __builtin_amdgcn_cvt_pk_fp8_f32(Y8C(c4[2] * bflo(gw.w)), Y8C(c4[3] * bfhi(gw.w)), t1, true);
#undef Y8C
      yw8[2 * i] = (unsigned)t0; yw8[2 * i + 1] = (unsigned)t1;
    }
    yp[0] = (u32x4){yw8[0], yw8[1], yw8[2], yw8[3]}; yp[1] = (u32x4){yw8[4], yw8[5], yw8[6], yw8[7]};
  }
  asm volatile("s_waitcnt lgkmcnt(0)\n\ts_barrier" ::: "memory");
}
}

#define XB_TMO      128
#define XB_XCNT(j)  (256  + 64 * (j))
#define XB_XSUB(j)  (1280 + 64 * (j))
#define XB_XGEN(j)  (2304 + 64 * (j))
#define XB_TOP      3328
#define XB_TOPGEN   3392
#define XCD_BAR_WORDS 3456
#define XB_SPIN_CAP (1u << 18)
__device__ __forceinline__ unsigned xb_ld(unsigned* p)              { return __hip_atomic_load(p, __ATOMIC_RELAXED, __HIP_MEMORY_SCOPE_AGENT); }
__device__ __forceinline__ unsigned xb_add(unsigned* p, unsigned v) { return __hip_atomic_fetch_add(p, v, __ATOMIC_RELAXED, __HIP_MEMORY_SCOPE_AGENT); }
__device__ __forceinline__ unsigned xb_xcc_id() { return (unsigned)__builtin_amdgcn_s_getreg((3 << 11) | 20) & 0xFu; }
#define XB_SPIN(cond, bar) do { unsigned _sp = 0; while (cond) { __builtin_amdgcn_s_sleep(1); \
    if ((++_sp & 255u) == 0u) { if (xb_ld(&(bar)[XB_TMO])) break; if (_sp > XB_SPIN_CAP) { atomicAdd(&(bar)[XB_TMO], 1u); break; } } } } while (0)
struct XcdBarrier { unsigned* bar; unsigned x; volatile LAS unsigned* st; };
__device__ __forceinline__ XcdBarrier xcd_barrier_post(unsigned* bar, volatile LAS unsigned* st) {
    XcdBarrier b; b.bar = bar; b.x = xb_xcc_id(); b.st = st;
    if (threadIdx.x == 0) st[2] = xb_add(&bar[XB_XCNT(b.x)], 1u);
    return b;
}
__device__ __forceinline__ void xcd_barrier_complete(unsigned* bar, unsigned x, unsigned& nloc, unsigned& nx) {
    const unsigned G = gridDim.x * gridDim.y * gridDim.z;
    unsigned sum, cnt, mine, sp = 0u;
    for (;;) {
        sum = 0u; cnt = 0u; mine = 0u;
#pragma unroll
        for (unsigned j = 0; j < 16; ++j) { const unsigned c = xb_ld(&bar[XB_XCNT(j)]); sum += c; cnt += (c > 0u) ? 1u : 0u; mine = (j == x) ? c : mine; }
        if (sum == G) break;
        __builtin_amdgcn_s_sleep(1);
        if ((++sp & 255u) == 0u) { if (xb_ld(&bar[XB_TMO])) break; if (sp > XB_SPIN_CAP) { atomicAdd(&bar[XB_TMO], 1u); break; } }
    }
    nloc = mine > 0u ? mine : 1u; nx = cnt > 0u ? cnt : 1u;
}
__device__ __forceinline__ void xcd_barrier(const XcdBarrier& b) {
    asm volatile("s_waitcnt vmcnt(0)" ::: "memory");
    __syncthreads();
    if (threadIdx.x == 0) {
        unsigned* bar = b.bar;
        __builtin_amdgcn_s_waitcnt(0);
        unsigned nloc = b.st[0], nx = b.st[1];
        if (nloc == 0u) { xcd_barrier_complete(bar, b.x, nloc, nx); b.st[0] = nloc; b.st[1] = nx; }
        const unsigned old = xb_add(&bar[XB_XSUB(b.x)], 1u);
        const unsigned gen = old / nloc;
        if (old + 1u == (gen + 1u) * nloc) {
            __builtin_amdgcn_fence(__ATOMIC_RELEASE, "agent");
            asm volatile("s_waitcnt vmcnt(0)" ::: "memory");
            const unsigned og = xb_add(&bar[XB_TOP], 1u);
            const unsigned tg = og / nx;
            if (og + 1u == (tg + 1u) * nx) xb_add(&bar[XB_TOPGEN], 1u);
            else XB_SPIN(xb_ld(&bar[XB_TOPGEN]) == tg, bar);
            __builtin_amdgcn_fence(__ATOMIC_ACQUIRE, "agent");
            xb_add(&bar[XB_XGEN(b.x)], 1u);
            asm volatile("s_waitcnt vmcnt(0)" ::: "memory");
        } else {
            XB_SPIN(xb_ld(&bar[XB_XGEN(b.x)]) == gen, bar);
            __builtin_amdgcn_fence(__ATOMIC_ACQUIRE, "agent");
            asm volatile("s_waitcnt vmcnt(0)" ::: "memory");
        }
    }
    __syncthreads();
}

__global__ void __launch_bounds__(NTHREADS, 2) fwd_kernel(Args args) {
    extern __shared__ __attribute__((aligned(16))) unsigned char lds_raw[];
    LAS unsigned char* lds = (LAS unsigned char*)lds_raw;
    cg::grid_group grid = cg::this_grid();
    const int tid0 = threadIdx.x, wave = __builtin_amdgcn_readfirstlane(tid0 >> 6);
#define PHASE_LANES const int tid = opaque(tid0), lane = tid & 63; (void)lane; (void)tid
    const int G = gridDim.x, bx = blockIdx.x;
    const int vcu = (G % 8 == 0) ? (bx % 8) * (G / 8) + bx / 8 : bx;
    const int gw = vcu * NWAVES + wave, NGW = G * NWAVES;
    unsigned char* const ws = args.ws;
#define WSP(type, off) ((type*)(ws + (off)))
    if (tid0 < 64) ((LAS unsigned*)(lds + LDS_MISC))[tid0] = 0u;
    __syncthreads();
    unsigned long long tsA_ = 0, tsB_ = 0; (void)tsA_; (void)tsB_;
    TSTAMP(0);
    const XcdBarrier xbar = xcd_barrier_post(WSP(unsigned, WS_BAR), (volatile LAS unsigned*)(lds + LDS_MISC));
#define GRID_BAR() xcd_barrier(xbar)
    REPN(0) {
        PHASE_LANES;
        LAS float* scr = (LAS float*)(lds + wave * 16384);
        const float* x = args.in[0]; const float* mem = args.in[1]; const float* g_attn = args.in[2]; const float* w_in = args.in[3]; const float* g_mem = args.in[7];
        const float* w_mem_kv = args.in[8]; const float* w_out = args.in[11]; const float* g_ffn = args.in[12]; const float* w_router = args.in[13];
        bf16* WIN_T = WSP(bf16, WS_WIN); bf16* WMEM_T = WSP(bf16, WS_WMEM); bf16* WOUT_T = WSP(bf16, WS_WOUT);
        bf16* XN = WSP(bf16, WS_XN); bf16* MEMN = WSP(bf16, WS_MEMN); float* WRG = WSP(float, WS_WRG);
        constexpr int I0 = 16 * 88, I1 = 16 * 16, I2 = 16 * 32, NIT = I0 + I1 + I2;
        const int gwp = wave * G + vcu;
        for (int it = gwp; it < NIT; it += NGW) {
            int r = it;
            if (r < I0) { const int nb = r % 88, kb = r / 88; transpose_item(w_in, NIN, WIN_T, headperm_row(nb * 32), scr, kb * 64, nb * 32, lane); continue; } r -= I0;
            if (r < I1) { const int nb = r % 16, kb = r / 16; transpose_item(w_mem_kv, 512, WMEM_T, headperm_row(nb * 32), scr, kb * 64, nb * 32, lane); continue; } r -= I1;
            { const int nb = r % 32, kb = r / 32; transpose_item_fp8<false>(w_out, 1024, (unsigned char*)WOUT_T, scr, kb * 64, nb * 32, lane); }
        }
        for (int m = gwp * 2; m < T + MROWS; m += NGW * 2) {
            if (m < T) rms_row2_to_bf16(x + (size_t)m * DM, g_attn, XN + (size_t)m * DM, lane, WSP(float, WS_IRS) + m);
            else rms_row2_to_bf16(mem + (size_t)(m - T) * DM, g_mem, MEMN + (size_t)(m - T) * DM, lane, nullptr);
        }
        for (int i = bx * NTHREADS + tid; i < DM * NEXP; i += G * NTHREADS) {
            const float v = g_ffn[i >> 5] * w_router[i]; const unsigned hi = cvtpk(v, 0.f) & 0xffffu; const unsigned lo = cvtpk(v - bflo(hi), 0.f) & 0xffffu;
            unsigned short* wt = (unsigned short*)WRG + (size_t)(i & 31) * DM + (i >> 5);
            wt[0] = (unsigned short)hi; wt[32 * DM] = (unsigned short)lo;
        }
        for (int i = bx * NTHREADS + tid; i < NB * 16 * 8 * 64; i += G * NTHREADS) WSP(float, WS_KMEAN)[i] = 0.f;
    }
    if (args.pad0 == 0x7fffffff) grid.sync();
    GRID_BAR();
    TSTAMP(1);

    REPN(1) {
        EpiProj E{ws, args.in[4], args.in[5], args.in[9], args.in[10]};
        if (G == 256) {
            SchedProj10 S{G, bx, (const char*)(ws + WS_XN), (const char*)(ws + WS_WIN)};
            pg8::gemm_phase<EpiProj, SchedProj10>(lds, S, E);
        } else {
            SchedProj S{G, bx, (const char*)(ws + WS_XN), (const char*)(ws + WS_MEMN), (const char*)(ws + WS_WIN), (const char*)(ws + WS_WMEM)};
            pg8::gemm_phase<EpiProj, SchedProj>(lds, S, E);
        }
    }
    GRID_BAR();
    TSTAMP(2);

#ifndef NAIVE_RET
    REPN(2) {
        if (G == 256) {
            if (bx < 144) {
                SchedProjOne S{bx, (const char*)(ws + WS_XN), (const char*)(ws + WS_MEMN), (const char*)(ws + WS_WIN), (const char*)(ws + WS_WMEM)};
                EpiProj E{ws, args.in[4], args.in[5], args.in[9], args.in[10]};
                pg8::gemm_phase<EpiProj, SchedProjOne>(lds, S, E);
            } else {
                for (int u = bx - 144; u < 512; u += 112) { const int bh = u >> 4, cp = u & 15;
                    ret_body::kv_unit(WSP(bf16, WS_KR), WSP(bf16, WS_VR), WSP(float, WS_RET), bh >> 2, bh & 3, cp, (char*)lds_raw); }
            }
            asm volatile("s_waitcnt vmcnt(0)" ::: "memory");
            __syncthreads();
            if (tid0 == 0) {
                unsigned* PC = WSP(unsigned, WS_CTL) + 1024; const unsigned nloc_ = xbar.st[0];
                const unsigned old_ = xb_add(PC + 64 * (1 + xbar.x), 1u);
                if ((old_ + 1u) % nloc_ == 0u) { __builtin_amdgcn_fence(__ATOMIC_RELEASE, "agent"); asm volatile("s_waitcnt vmcnt(0)" ::: "memory"); xb_add(PC, 1u); }
            }
        } else {
            for (int i = 0; i < 2; ++i) { const int u = vcu * 2 + i, bh = u >> 4, cp = u & 15;
                ret_body::kv_unit(WSP(bf16, WS_KR), WSP(bf16, WS_VR), WSP(float, WS_RET), bh >> 2, bh & 3, cp, (char*)lds_raw); }
        }
    }
    if (G != 256) GRID_BAR();
    TSTAMP(3);
#endif
    REPN(20) { PHASE_LANES;
#if defined(NAIVE_MOBA) || defined(NAIVE_RET) || defined(NAIVE_MEM)
#error naive mixers are no longer wired in
#endif
    unsigned* qmix = WSP(unsigned, WS_CTL) + 64 + 256 * rep_; unsigned* qconv = WSP(unsigned, WS_CTL) + 128 + 256 * rep_;
    volatile LAS int* qslot = (volatile LAS int*)(lds + LDS_MISC + 64);
    const bool conv_first = (G == 256) ? (bx < 80) : ((vcu % 10) < 3);
    bool mix_done = false, conv_done = false, pre_ok = (G != 256);
    while (!(mix_done && conv_done)) {
        const int kind = conv_first ? (conv_done ? 0 : 1) : (mix_done ? 1 : 0);
        if (tid == 0) qslot[0] = (int)__hip_atomic_fetch_add(kind ? qconv : qmix, 1u, __ATOMIC_RELAXED, __HIP_MEMORY_SCOPE_AGENT);
        __syncthreads();
        const int u = qslot[0];
        __syncthreads();
        if (kind == 1) {
            if (u >= 1536) { conv_done = true; continue; }
            convert_chunk(u, args.in[15], args.in[17], WSP(unsigned char, WS_W1), WSP(unsigned char, WS_W2), (LAS float*)(lds + wave * 16384), wave, lane);
            __syncthreads();
        } else if (u >= 2048) { mix_done = true; }
        else if (u < 1024) {
            const int nb = 15 - (u >> 6), bh = u & 63, b = bh >> 3, h = bh & 7;
            const size_t row0 = (size_t)b * SEQ + (size_t)nb * 256;
            attn_body::attn_unit<8, 512, 1024, true>(WSP(bf16, WS_QA) + row0 * 512 + h * 64, WSP(bf16, WS_KA) + (size_t)b * SEQ * 512 + h * 64, WSP(bf16, WS_VA) + (size_t)b * SEQ * 512 + h * 64,
                                                     WSP(unsigned char, WS_Y) + row0 * DM + h * 64, 4 * nb + 4, nb, WSP(float, WS_KMEAN) + ((size_t)b * 16 * 8 + h) * 64, (char*)lds_raw);
        } else {
            if (!pre_ok) {
                if (tid == 0) { XB_SPIN(xb_ld(WSP(unsigned, WS_CTL) + 1024) < xbar.st[1], WSP(unsigned, WS_BAR)); __builtin_amdgcn_fence(__ATOMIC_ACQUIRE, "agent"); asm volatile("s_waitcnt vmcnt(0)" ::: "memory"); }
                __syncthreads(); pre_ok = true;
            }
            if (u < 1536) {
            const int idx = u - 1024, bh = idx >> 4, cp = idx & 15;
            ret_body::out_unit(WSP(bf16, WS_QR), WSP(bf16, WS_KR), WSP(bf16, WS_VR), WSP(bf16, WS_GR), WSP(float, WS_RET), args.in[6], WSP(unsigned char, WS_Y), bh >> 2, bh & 3, cp, (char*)lds_raw);
        } else {
            const int idx = u - 1536, bh = idx >> 4, qb = idx & 15, b = bh >> 2, h = bh & 3;
            const size_t row0 = (size_t)b * SEQ + (size_t)qb * 256;
            attn_body::attn_unit<8, 256, 1024, false>(WSP(bf16, WS_QM) + row0 * 256 + h * 64, WSP(bf16, WS_MK) + (size_t)b * MEMLEN * 256 + h * 64, WSP(bf16, WS_MV) + (size_t)b * MEMLEN * 256 + h * 64,
                                                      WSP(unsigned char, WS_Y) + row0 * DM + 768 + h * 64, 4, 0, nullptr, (char*)lds_raw);
        } }
    }
    }
    GRID_BAR();
    TSTAMP(4);

    REPN(3) {
        SchedPlain8 S{G, bx, 128, 4, (const char*)(ws + WS_Y), (const char*)(ws + WS_WOUT)};
        EpiOut E{WSP(bf16, WS_XN), WSP(float, WS_IRS), args.in[2], WSP(bf16, WS_X1B), WSP(float, WS_SSQ)};
#ifndef NO_G2
        pg8::gemm_phase<EpiOut, SchedPlain8, false, true>(lds, S, E);
#endif
    }
    GRID_BAR();
    TSTAMP(5);

    REPN(4) {
        PHASE_LANES;
        const bf16* x1b = WSP(bf16, WS_X1B); const float* b_router = args.in[14];
        float* WRG = WSP(float, WS_WRG); float* SSQ = WSP(float, WS_SSQ); int* TOPI = WSP(int, WS_TOPI); float* TOPW = WSP(float, WS_TOPW); int* LRANK = WSP(int, WS_LRANK); int* LCOUNT = WSP(int, WS_LCOUNT);
        unsigned char* XN2 = WSP(unsigned char, WS_XN2); const float* g_ffn = args.in[12];
        if (bx == 0 && tid < 64) ((u32x4*)(XN2 + (size_t)T * DM))[tid] = (u32x4){0u, 0u, 0u, 0u};
        constexpr int RW_PITCH = 2064, RW_PART = 32 * RW_PITCH;
        LAS float* lg = (LAS float*)(lds + 2 * RW_PART) + wave * (16 * 33);
        LAS int* hist = (LAS int*)(lds + 2 * RW_PART + 16896);
        {
#pragma unroll
            for (int q = 0; q < 16; ++q) { const int row = wave * 8 + (q >> 1), hh = q & 1;
                __builtin_amdgcn_global_load_lds((const unsigned*)((const char*)WRG + (size_t)row * 2048 + hh * 1024 + lane * 16), (LAS unsigned*)(lds + (row >> 5) * RW_PART + (row & 31) * RW_PITCH + hh * 1024), 16, 0, 0); }
            if (wave == 0) {
#pragma unroll
                for (int q = 0; q < 4; ++q) __builtin_amdgcn_global_load_lds((const unsigned*)((const char*)g_ffn + q * 1024 + lane * 16), (LAS unsigned*)(lds + LDS_G + q * 1024), 16, 0, 0); }
            asm volatile("s_waitcnt vmcnt(0)" ::: "memory");
        }
        if (tid < 32) hist[tid] = 0;
        __syncthreads();
        const int tpw = T / (G * NWAVES);
        int bi[4] = {0, 0, 0, 0}, rkk[4] = {0, 0, 0, 0}; float wvv[4] = {0.f, 0.f, 0.f, 0.f};
        for (int tb = 0; tb < tpw; tb += 16) {
            const int t0 = (bx * NWAVES + wave) * tpw + tb;
            const int i = lane & 15, kq = lane >> 4;
            f32x4 a0 = {0.f, 0.f, 0.f, 0.f}, a1 = {0.f, 0.f, 0.f, 0.f};
            const bf16* xr = x1b + (size_t)(t0 + i) * DM + 32 * kq;
            const LAS unsigned char* wbh = lds + i * RW_PITCH + 64 * kq;
            const LAS unsigned char* wbl = wbh + RW_PART;
            float rstd;
            { const f32x4* sp = (const f32x4*)(SSQ + (size_t)(t0 + i) * 16); const f32x4 s0 = sp[0], s1 = sp[1], s2 = sp[2], s3 = sp[3];
              const float ss = ((s0[0] + s0[1]) + (s0[2] + s0[3])) + ((s1[0] + s1[1]) + (s1[2] + s1[3])) + ((s2[0] + s2[1]) + (s2[2] + s2[3])) + ((s3[0] + s3[1]) + (s3[2] + s3[3]));
              rstd = 1.0f / sqrtf(ss * (1.0f / DM) + EPS); }
            unsigned char* xo = XN2 + (size_t)(t0 + i) * DM + 16 * kq;
            const LAS float* gl = (const LAS float*)(lds + LDS_G) + 32 * kq;
#define RT_XLOAD(xq, c) do { _Pragma("unroll") for (int j = 0; j < 4; ++j) asm volatile("global_load_dwordx4 %0, %1, off offset:%2" : "=v"(xq[j]) : "v"(xr), "n"(256 * (c) + 16 * j) : "memory"); } while (0)
#define RT_XWAIT(N, xq) asm volatile("s_waitcnt vmcnt(" #N ")" : "+v"(xq[0]), "+v"(xq[1]), "+v"(xq[2]), "+v"(xq[3]) :: "memory")
#define RT_PACK(xq, c) do { \
                _Pragma("unroll") for (int j = 0; j < 4; ++j) { const u32x4 xw = xq[j]; xa[j] = xw; \
                    av[8 * j] = bflo(xw.x); av[8 * j + 1] = bfhi(xw.x); av[8 * j + 2] = bflo(xw.y); av[8 * j + 3] = bfhi(xw.y); av[8 * j + 4] = bflo(xw.z); av[8 * j + 5] = bfhi(xw.z); av[8 * j + 6] = bflo(xw.w); av[8 * j + 7] = bfhi(xw.w); } \
                { float nv[32]; \
                  _Pragma("unroll") for (int j = 0; j < 8; ++j) { const f32x4 g = *(const LAS f32x4*)(gl + 128 * (c) + 4 * j); nv[4 * j] = av[4 * j] * rstd * g[0]; nv[4 * j + 1] = av[4 * j + 1] * rstd * g[1]; nv[4 * j + 2] = av[4 * j + 2] * rstd * g[2]; nv[4 * j + 3] = av[4 * j + 3] * rstd * g[3]; } \
                  u32x4 p0, p1; fp6_pack32(nv, p0, p1); \
                  *(u32x4*)(xo + 128 * (c)) = p0; *(u32x4*)(xo + 128 * (c) + 64) = p1; } } while (0)
#define RT_MMA(c) do { _Pragma("unroll") for (int j = 0; j < 4; ++j) { const bf16x8 xf = __builtin_bit_cast(bf16x8, xa[j]); const int o = 256 * (c) + 16 * j; \
                    a0 = __builtin_amdgcn_mfma_f32_16x16x32_bf16(xf, *(const LAS bf16x8*)(wbh + o), a0, 0, 0, 0); \
                    a0 = __builtin_amdgcn_mfma_f32_16x16x32_bf16(xf, *(const LAS bf16x8*)(wbl + o), a0, 0, 0, 0); \
                    a1 = __builtin_amdgcn_mfma_f32_16x16x32_bf16(xf, *(const LAS bf16x8*)(wbh + 16 * RW_PITCH + o), a1, 0, 0, 0); \
                    a1 = __builtin_amdgcn_mfma_f32_16x16x32_bf16(xf, *(const LAS bf16x8*)(wbl + 16 * RW_PITCH + o), a1, 0, 0, 0); } } while (0)
#define RT_CHUNK(c, N, xq) do { RT_XWAIT(N, xq); RT_PACK(xq, c); if ((c) + 4 < 8) RT_XLOAD(xq, (c) + 4); RT_MMA(c); } while (0)
            u32x4 xq0[4], xq1[4], xq2[4], xq3[4], xa[4]; float av[32];
            asm volatile("s_waitcnt vmcnt(0)" ::: "memory");
            RT_XLOAD(xq0, 0); RT_XLOAD(xq1, 1); RT_XLOAD(xq2, 2); RT_XLOAD(xq3, 3);
            RT_CHUNK(0, 12, xq0); RT_CHUNK(1, 12, xq1); RT_CHUNK(2, 12, xq2); RT_CHUNK(3, 12, xq3);
            RT_CHUNK(4, 12, xq0); RT_CHUNK(5, 8, xq1);  RT_CHUNK(6, 4, xq2);  RT_CHUNK(7, 0, xq3);
#undef RT_XLOAD
#undef RT_XWAIT
#undef RT_PACK
#undef RT_MMA
#undef RT_CHUNK
#pragma unroll
            for (int r = 0; r < 4; ++r) { lg[(4 * kq + r) * 33 + i] = a0[r]; lg[(4 * kq + r) * 33 + 16 + i] = a1[r]; }
            LDS_WAIT(); asm volatile("" ::: "memory");
            if (lane < 16) {
                const int t = t0 + lane;
                float v[32];
#pragma unroll
                for (int e = 0; e < 32; ++e) v[e] = lg[lane * 33 + e] * rstd + b_router[e];
                float bvv[4];
#pragma unroll
                for (int k = 0; k < 4; ++k) {
                    float best = -3e38f; int be = 0;
#pragma unroll
                    for (int e = 0; e < 32; ++e) { const bool take = v[e] > best; best = take ? v[e] : best; be = take ? e : be; }
                    bi[k] = be; bvv[k] = best;
#pragma unroll
                    for (int e = 0; e < 32; ++e) v[e] = (e == be) ? -3e38f : v[e];
                }
                const float e1 = __expf(bvv[1] - bvv[0]), e2 = __expf(bvv[2] - bvv[0]), e3 = __expf(bvv[3] - bvv[0]);
                const float inv = 1.0f / (1.0f + e1 + e2 + e3);
                wvv[0] = inv; wvv[1] = e1 * inv; wvv[2] = e2 * inv; wvv[3] = e3 * inv;
#pragma unroll
                for (int k = 0; k < 4; ++k) rkk[k] = atomicAdd((int*)&hist[bi[k]], 1);
                (void)t;
            }
            LDS_WAIT(); asm volatile("" ::: "memory");
        }
        __syncthreads();
        LAS int* wgb = hist + 32;
        if (tid < 32) wgb[tid] = atomicAdd(WSP(int, WS_CTL) + 2048 + tid, hist[tid]);
        __syncthreads();
        if (lane < 16) {
            const int t = (bx * NWAVES + wave) * tpw + lane;
            int* LIST = WSP(int, WS_LIST); float* WLIST = WSP(float, WS_WLIST);
#pragma unroll
            for (int k = 0; k < 4; ++k) { const int e = bi[k], gr = wgb[e] + rkk[k];
                TOPI[t * 4 + k] = e; LRANK[t * 4 + k] = gr; LIST[(size_t)e * ECAP + gr] = t; WLIST[(size_t)e * ECAP + gr] = wvv[k]; }
        }
        (void)TOPW; (void)LCOUNT;
    }
    GRID_BAR();
    TSTAMP(6);

    TSTAMP(7);

    LAS int* const tel = (LAS int*)(lds + 146432); LAS int* const tst = tel + MAXTILES;
    { PHASE_LANES; const int* GC = WSP(int, WS_CTL) + 2048;
      if (tid < 32) { const int c = GC[tid]; tst[40 + tid] = (c + 255) >> 8; }
      __syncthreads();
      if (tid == 0) { int ts = 0; for (int e = 0; e < 32; ++e) { const int n = tst[40 + e]; tst[e] = ts; ts += n; } tst[32] = ts; }
      __syncthreads();
      const int ntl = tst[32];
      for (int tl = tid; tl < MAXTILES; tl += NTHREADS) { int e = 0;
#pragma unroll
          for (int q = 1; q < 32; ++q) e += (tst[q] <= tl) ? 1 : 0;
          tel[tl] = (tl < ntl) ? e : 0; }
      __syncthreads(); }
    const int ntiles = tst[32];
    volatile LAS unsigned* const xst = (volatile LAS unsigned*)(lds + LDS_MISC);
    if (tid0 == 0) { unsigned ok = (G == 256) ? 1u : 0u; for (int j = 0; j < 16; ++j) { const unsigned c_ = xb_ld(WSP(unsigned, WS_BAR) + XB_XCNT(j)); ok &= (c_ == (j < 8 ? 32u : 0u)) ? 1u : 0u; } xst[3] = ok; }
    __syncthreads();
    const int Ft = ntiles & ~31, Rt = ntiles - Ft, px = (Rt + 3) >> 2, nx = 8 - px;
    const bool xloc = xst[3] != 0u && (Rt == 0 || nx > 0);
    const int vx = xloc ? (int)xbar.x : (vcu >> 5), vc = xloc ? (int)xst[2] : (vcu & 31), vcu2 = vx * 32 + vc;
    REPN(6) {
        SchedMoe S{G, vcu2, 8, ntiles, tel, (const char*)(ws + WS_XN2), (const char*)(ws + WS_W1), (size_t)2048 * 1024, WSP(int, WS_LIST), tst};
        EpiSwiglu E{args.in[16], WSP(unsigned char, WS_H)};
#ifndef NO_G3
        pg8::gemm_phase<EpiSwiglu, SchedMoe, true, true, true>(lds, S, E);
#endif
    }
    TSTAMP(8);
    if (!xloc) {
        GRID_BAR();
        SchedMoe S{G, vcu, 4, ntiles, tel, (const char*)(ws + WS_H), (const char*)(ws + WS_W2), (size_t)1024 * 1024, nullptr, tst};
        EpiDown E{args.in[18], WSP(float, WS_WLIST), WSP(unsigned char, WS_XG), tst};
        pg8::gemm_phase<EpiDown, SchedMoe, false, true>(lds, S, E);
    } else {
        unsigned* XC = WSP(unsigned, WS_CTL) + 4096;
        const int rem = (ntiles * 8) & 255;
        asm volatile("s_waitcnt vmcnt(0)" ::: "memory");
        __syncthreads();
        if (tid0 == 0) {
            if (vcu2 < rem) { __builtin_amdgcn_fence(__ATOMIC_RELEASE, "agent"); asm volatile("s_waitcnt vmcnt(0)" ::: "memory"); xb_add(XC, 1u); }
            xb_add(XC + 64 * (1 + vx), 1u);
            XB_SPIN(xb_ld(XC + 64 * (1 + vx)) < 32u, WSP(unsigned, WS_BAR));
        }
        __syncthreads();
        EpiDown E{args.in[18], WSP(float, WS_WLIST), WSP(unsigned char, WS_XG), tst};
        { SchedMoeOwn S{{G, 0, 4, ntiles, tel, (const char*)(ws + WS_H), (const char*)(ws + WS_W2), (size_t)1024 * 1024, nullptr, tst}, vx, vc, Ft};
          pg8::gemm_phase<EpiDown, SchedMoeOwn, false, true>(lds, S, E); }
        if (Rt > 0 && vx >= px) {
            const int cc = (vx - px) * 32 + vc;
            if (cc < 4 * Rt) {
                if (tid0 == 0) { XB_SPIN(xb_ld(XC) < (unsigned)rem, WSP(unsigned, WS_BAR)); __builtin_amdgcn_fence(__ATOMIC_ACQUIRE, "agent"); asm volatile("s_waitcnt vmcnt(0)" ::: "memory"); }
                __syncthreads();
                SchedMoeTail S{{G, 0, 4, ntiles, tel, (const char*)(ws + WS_H), (const char*)(ws + WS_W2), (size_t)1024 * 1024, nullptr, tst}, cc, nx * 32, Ft, 4 * Rt};
                pg8::gemm_phase<EpiDown, SchedMoeTail, false, true>(lds, S, E);
            }
        }
    }
    GRID_BAR();
    TSTAMP(9);
    if (REP_PHASE == 9) { GRID_BAR(); GRID_BAR(); GRID_BAR(); GRID_BAR(); }
    REPN(8) { PHASE_LANES;
    float* out = args.out; const int* TOPI_ = WSP(int, WS_TOPI); const int* GRANK_ = WSP(int, WS_LRANK); const unsigned char* YE = WSP(unsigned char, WS_XG); const bf16* x1b = WSP(bf16, WS_X1B);
    float* dst = (REP_PHASE == 8 && rep_ == 0) ? WSP(float, WS_H) + 64 * 1024 * 1024 : out;
    for (int t0 = gw; t0 < T; t0 += 2 * NGW) {
        const bool two = t0 + NGW < T; const int t1 = two ? t0 + NGW : t0;
        u32x2 xv[2][4]; unsigned yw[2][4][4];
        const int yperm = 64 * ((lane >> 3) & 3) + 16 * ((lane >> 1) & 3) + 8 * (lane >> 5) + 4 * (lane & 1);
#pragma unroll
        for (int h = 0; h < 2; ++h) { const int t = h ? t1 : t0; const u32x2* xrow = (const u32x2*)(x1b + (size_t)t * DM) + lane;
#pragma unroll
            for (int j = 0; j < 4; ++j) xv[h][j] = __builtin_nontemporal_load(xrow + 64 * j);
#pragma unroll
            for (int k = 0; k < 4; ++k) { const int pos = tst[TOPI_[t * 4 + k]] * 256 + GRANK_[t * 4 + k]; const unsigned* yr = (const unsigned*)(YE + (size_t)pos * 1024 + yperm);
#pragma unroll
                for (int j = 0; j < 4; ++j) yw[h][k][j] = __builtin_nontemporal_load(yr + 64 * j); } }
        f32x4 s[2][4];
#pragma unroll
        for (int h = 0; h < 2; ++h) {
#pragma unroll
            for (int j = 0; j < 4; ++j) s[h][j] = (f32x4){0.f, 0.f, 0.f, 0.f};
#pragma unroll
            for (int k = 0; k < 4; ++k)
#pragma unroll
                for (int j = 0; j < 4; ++j) {
                    const f32x2 lo = __builtin_amdgcn_cvt_pk_f32_fp8((int)yw[h][k][j], false), hi = __builtin_amdgcn_cvt_pk_f32_fp8((int)yw[h][k][j], true);
                    s[h][j].x += lo.x; s[h][j].y += lo.y; s[h][j].z += hi.x; s[h][j].w += hi.y;
                }
        }
        asm volatile("s_waitcnt vmcnt(0)" ::: "memory");
#pragma unroll
        for (int h = 0; h < 2; ++h) { if (h == 1 && !two) break; const int t = h ? t1 : t0; f32x4* drow = (f32x4*)(dst + (size_t)t * DM) + lane;
#pragma unroll
            for (int j = 0; j < 4; ++j) __builtin_nontemporal_store((f32x4){bflo(xv[h][j].x), bfhi(xv[h][j].x), bflo(xv[h][j].y), bfhi(xv[h][j].y)} + s[h][j] * 0.0625f, drow + 64 * j); }
    }
    }
    TSTAMP(10);
    if (REP_PHASE >= 100 && bx == 0 && tid0 == 0) {
        const unsigned long long t0_ = __builtin_amdgcn_s_memrealtime(), want = 9ull * (tsB_ - tsA_);
        while (__builtin_amdgcn_s_memrealtime() - t0_ < want) __builtin_amdgcn_s_sleep(32);
    }
}

extern "C" void kernel_launch(void* const* d_in, const int* in_sizes, int n_in, void* d_out, int out_size, void* d_ws, size_t ws_size, hipStream_t stream) {
    static int grid = 0;
    if (grid == 0) {
        if (n_in != 19 || out_size != T * DM || ws_size < WS_END) { fprintf(stderr, "kernel_launch: unexpected shapes (n_in %d out %d ws %zu)\n", n_in, out_size, ws_size); grid = -1; return; }
        int dev = 0, cus = 0, per_cu = 0;
        hipGetDevice(&dev); hipDeviceGetAttribute(&cus, hipDeviceAttributeMultiprocessorCount, dev);
        hipFuncSetAttribute((const void*)fwd_kernel, hipFuncAttributeMaxDynamicSharedMemorySize, LDS_BYTES);
        hipOccupancyMaxActiveBlocksPerMultiprocessor(&per_cu, (const void*)fwd_kernel, NTHREADS, LDS_BYTES);
        if (per_cu < 1) { fprintf(stderr, "kernel_launch: occupancy query says %d blocks per CU\n", per_cu); per_cu = 1; }
        (void)hipGetLastError();
        grid = cus * 1;
        if (grid != 256 || T % (grid * NWAVES * 16) != 0) { fprintf(stderr, "kernel_launch: grid %d unsupported\n", grid); grid = -1; return; }
    }
    if (grid < 0) return;
    hipMemsetAsync((char*)d_ws + WS_CTL, 0, CTL_ZERO_BYTES, stream);
    Args a{};
    for (int i = 0; i < 19; ++i) a.in[i] = (const float*)d_in[i];
    a.out = (float*)d_out; a.ws = (unsigned char*)d_ws;
    void* kargs[] = {&a};
    hipError_t e = hipLaunchCooperativeKernel((const void*)fwd_kernel, dim3(grid), dim3(NTHREADS), kargs, LDS_BYTES, stream);
    if (e != hipSuccess) fprintf(stderr, "cooperative launch failed: %s (grid %d)\n", hipGetErrorString(e), grid);
}
```
